# Optimizing an MI355X kernel written in HIP

```python
import jax
import jax.numpy as jnp
from jax import lax
import numpy as np

D_MODEL = 2048
BATCH = 4
SEQ = 2048
DEPTH = 1

GRID_W = 64
CTX_LEN = 256
HGRN_HEADS = 8
HGRN_HEAD_DIM = 128
HGRN_WIDTH = HGRN_HEADS * HGRN_HEAD_DIM
HGRN_CHUNK = 64
NA_HEADS = 8
NA_HEAD_DIM = 128
NA_WIDTH = NA_HEADS * NA_HEAD_DIM
WIN_R = 8
WIN_C = 16
ROPE_THETA = 10000.0
FFN_HIDDEN = 5632
CONV_W = 3
N_MOD = 6
EPS = 1e-6
IN_COLS = 5 * HGRN_WIDTH + 3 * NA_WIDTH + 2 * D_MODEL

kernel_name = 'hybrid_hgrn2_natten_convffn_dit'


def rmsnorm(x, g):
    xf = x.astype(jnp.float32)
    y = xf * lax.rsqrt(jnp.mean(xf * xf, axis=-1, keepdims=True) + EPS)
    return (y * g.astype(jnp.float32)).astype(x.dtype)


def modulate(h, shift, scale):
    return h * (1.0 + scale) + shift


def split_heads(t, n_heads):
    return t.reshape(t.shape[:-1] + (n_heads, t.shape[-1] // n_heads))


def split_columns(p):
    sizes = (HGRN_WIDTH,) * 5 + (NA_WIDTH,) * 3 + (D_MODEL, D_MODEL)
    outs, off = [], 0
    for s in sizes:
        outs.append(p[..., off:off + s])
        off += s
    return outs


def hgrn2_chunk_scan(q, logf, k, v, s0):
    bsz, L, nh, d = q.shape
    nc = L // HGRN_CHUNK

    def to_chunks(t):
        return t.reshape(bsz, nc, HGRN_CHUNK, nh, d).transpose(1, 0, 3, 2, 4)

    causal = jnp.tril(jnp.ones((HGRN_CHUNK, HGRN_CHUNK), dtype=bool))[:, :, None]

    def step(S, inp):
        qc, gc, kc, vc = inp
        cum = jnp.cumsum(gc, axis=2)
        o_inter = jnp.einsum('bhtk,bhkv->bhtv', qc * jnp.exp(cum), S)
        diff = cum[:, :, :, None, :] - cum[:, :, None, :, :]
        decay = jnp.where(causal, jnp.exp(jnp.where(causal, diff, 0.0)), 0.0)
        scores = jnp.einsum('bhtk,bhsk,bhtsk->bhts', qc, kc, decay)
        o_intra = jnp.einsum('bhts,bhsv->bhtv', scores, vc)
        last = cum[:, :, -1:, :]
        S_new = jnp.exp(last[:, :, 0, :])[..., None] * S + jnp.einsum('bhsk,bhsv->bhkv', kc * jnp.exp(last - cum), vc)
        return S_new, o_inter + o_intra

    s_fin, o = lax.scan(step, s0, (to_chunks(q), to_chunks(logf), to_chunks(k), to_chunks(v)))
    return o.transpose(1, 0, 3, 2, 4).reshape(bsz, L, nh, d), s_fin


def hgrn2_prep(q, f_logit, i_val, lb):
    f = lb + (1.0 - lb) * jax.nn.sigmoid(f_logit.astype(jnp.float32))
    return (split_heads(q.astype(jnp.float32), HGRN_HEADS),
            split_heads(jnp.log(f), HGRN_HEADS),
            split_heads(1.0 - f, HGRN_HEADS),
            split_heads(i_val.astype(jnp.float32), HGRN_HEADS))


def hgrn2_direction(ctx_in, lat_in, lb, reverse):
    ctx_t = hgrn2_prep(ctx_in[0], ctx_in[1], ctx_in[2], lb)
    lat_t = hgrn2_prep(lat_in[0], lat_in[1], lat_in[2], lb)
    if reverse:
        ctx_t = tuple(jnp.flip(t, axis=1) for t in ctx_t)
        lat_t = tuple(jnp.flip(t, axis=1) for t in lat_t)
    bsz = lat_t[0].shape[0]
    s0 = jnp.zeros((bsz, HGRN_HEADS, HGRN_HEAD_DIM, HGRN_HEAD_DIM), jnp.float32)
    o_ctx, s_ctx = hgrn2_chunk_scan(ctx_t[0], ctx_t[1], ctx_t[2], ctx_t[3], s0)
    o_lat, _ = hgrn2_chunk_scan(lat_t[0], lat_t[1], lat_t[2], lat_t[3], s_ctx)
    if reverse:
        o_ctx = jnp.flip(o_ctx, axis=1)
        o_lat = jnp.flip(o_lat, axis=1)
    return o_lat, o_ctx


def hgrn2_readout(o, g, norm_g, dtype):
    on = o * lax.rsqrt(jnp.mean(o * o, axis=-1, keepdims=True) + EPS) * norm_g.astype(jnp.float32)
    y = on.reshape(o.shape[:2] + (HGRN_WIDTH,)) * jax.nn.silu(g.astype(jnp.float32))
    return y.astype(dtype)


def qk_norm(t, g):
    tf = t.astype(jnp.float32)
    return tf * lax.rsqrt(jnp.mean(tf * tf, axis=-1, keepdims=True) + EPS) * g.astype(jnp.float32)


def axial_rope(t):
    L, d = t.shape[1], t.shape[-1]
    pos = jnp.arange(L, dtype=jnp.int32)
    row = (pos // GRID_W).astype(jnp.float32)
    col = (pos % GRID_W).astype(jnp.float32)
    half = d // 2
    nf = half // 2
    inv = ROPE_THETA ** (-jnp.arange(nf, dtype=jnp.float32) / nf)

    def rot(u, p):
        ang = p[:, None] * inv[None, :]
        cos = jnp.cos(ang)[None, :, None, :]
        sin = jnp.sin(ang)[None, :, None, :]
        u1, u2 = u[..., :nf], u[..., nf:]
        return jnp.concatenate([u1 * cos - u2 * sin, u1 * sin + u2 * cos], axis=-1)

    return jnp.concatenate([rot(t[..., :half], row), rot(t[..., half:], col)], axis=-1)


def neighbourhood_attention(q, k, v, k_ctx, v_ctx, rel_bias):
    bsz, L, nh, d = q.shape
    rows = L // GRID_W
    kr = min(WIN_R, rows)
    scale = d ** -0.5
    r = jnp.arange(rows)
    w = jnp.arange(GRID_W)
    row_start = jnp.clip(r - WIN_R // 2, 0, rows - kr)
    row_idx = row_start[:, None] + jnp.arange(kr)[None, :]
    col_start = jnp.clip(w - WIN_C // 2, 0, GRID_W - WIN_C)
    col_in = (w[None, :] >= col_start[:, None]) & (w[None, :] < col_start[:, None] + WIN_C)
    qg = q.reshape(bsz, rows, GRID_W, nh, d)
    kg = k.reshape(bsz, rows, GRID_W, nh, d)[:, row_idx]
    vg = v.reshape(bsz, rows, GRID_W, nh, d)[:, row_idx]
    s_band = jnp.einsum('brchd,brjwhd->bhrcjw', qg, kg).astype(jnp.float32) * scale
    dr = row_idx - r[:, None]
    dc = jnp.clip(w[None, :] - w[:, None], -(WIN_C - 1), WIN_C - 1)
    bias = rel_bias[:, (dr + WIN_R - 1)[:, None, :, None], (dc + WIN_C - 1)[None, :, None, :]]
    s_band = jnp.where(col_in[:, None, :], s_band + bias.astype(jnp.float32)[None], -jnp.inf)
    s_ctx = jnp.einsum('brchd,bnhd->bhrcn', qg, k_ctx).astype(jnp.float32) * scale
    n_band = kr * GRID_W
    s = jnp.concatenate([s_band.reshape(bsz, nh, rows, GRID_W, n_band), s_ctx], axis=-1)
    p = jax.nn.softmax(s, axis=-1)
    p_band = p[..., :n_band].reshape(bsz, nh, rows, GRID_W, kr, GRID_W)
    p_ctx = p[..., n_band:]
    o = jnp.einsum('bhrcjw,brjwhd->brchd', p_band, vg) + jnp.einsum('bhrcn,bnhd->brchd', p_ctx, v_ctx)
    return o.reshape(bsz, L, nh * d)


def context_attention(q, k, v):
    bsz, n, nh, d = q.shape
    s = jnp.einsum('bnhd,bmhd->bhnm', q, k).astype(jnp.float32) * (d ** -0.5)
    p = jax.nn.softmax(s, axis=-1)
    return jnp.einsum('bhnm,bmhd->bnhd', p, v).reshape(bsz, n, nh * d)


def branch_merge(y_a, y_b, gate_a, gate_b, w_a, w_b, w_o):
    z = jax.nn.sigmoid(gate_a) * (y_a @ w_a) + jax.nn.sigmoid(gate_b) * (y_b @ w_b)
    return z @ w_o


def dwconv_centred(u, w, b):
    L = u.shape[1]
    up = jnp.pad(u, ((0, 0), (1, 1), (0, 0)))
    return up[:, 0:L] * w[0] + up[:, 1:L + 1] * w[1] + up[:, 2:L + 2] * w[2] + b


def conv_ffn(h, w1, w3, cw, cb, w2):
    u = dwconv_centred(h @ w1, cw, cb)
    return (jax.nn.silu(u) * (h @ w3)) @ w2


def setup_inputs(seed: int = 0) -> dict:
    key = jax.random.key(seed)
    ks = jax.random.split(key, 24)

    def nrm(k, shape, scale):
        return jax.random.normal(k, shape, jnp.float32) * scale

    return {
        'x': nrm(ks[0], (BATCH, SEQ, D_MODEL), 1.0),
        'c': nrm(ks[1], (BATCH, D_MODEL), 1.0),
        'ctx': nrm(ks[2], (BATCH, CTX_LEN, D_MODEL), 1.0),
        'c_ctx': nrm(ks[3], (D_MODEL,), 1.0),
        'ada_w': nrm(ks[4], (DEPTH, D_MODEL, N_MOD * D_MODEL), D_MODEL ** -0.5),
        'ada_b': nrm(ks[5], (DEPTH, N_MOD * D_MODEL), 0.01),
        'norm1_g': 1.0 + nrm(ks[6], (DEPTH, D_MODEL), 0.02),
        'norm2_g': 1.0 + nrm(ks[7], (DEPTH, D_MODEL), 0.02),
        'w_in': nrm(ks[8], (DEPTH, D_MODEL, IN_COLS), D_MODEL ** -0.5),
        'hgrn_lb_logits': nrm(ks[9], (2, DEPTH + 1, HGRN_WIDTH), 0.5),
        'hgrn_norm_g': 1.0 + nrm(ks[10], (DEPTH, HGRN_HEAD_DIM), 0.02),
        'na_q_norm_g': 1.0 + nrm(ks[11], (DEPTH, NA_HEAD_DIM), 0.02),
        'na_k_norm_g': 1.0 + nrm(ks[12], (DEPTH, NA_HEAD_DIM), 0.02),
        'na_rel_bias': nrm(ks[13], (DEPTH, NA_HEADS, 2 * WIN_R - 1, 2 * WIN_C - 1), 0.1),
        'w_branch_a': nrm(ks[14], (DEPTH, HGRN_WIDTH, D_MODEL), HGRN_WIDTH ** -0.5),
        'w_branch_b': nrm(ks[15], (DEPTH, NA_WIDTH, D_MODEL), NA_WIDTH ** -0.5),
        'w_out': nrm(ks[16], (DEPTH, D_MODEL, D_MODEL), D_MODEL ** -0.5),
        'ffn_w1': nrm(ks[17], (DEPTH, D_MODEL, FFN_HIDDEN), D_MODEL ** -0.5),
        'ffn_w3': nrm(ks[18], (DEPTH, D_MODEL, FFN_HIDDEN), D_MODEL ** -0.5),
        'ffn_conv_w': nrm(ks[19], (DEPTH, CONV_W, FFN_HIDDEN), CONV_W ** -0.5),
        'ffn_conv_b': nrm(ks[20], (DEPTH, FFN_HIDDEN), 0.01),
        'ffn_w2': nrm(ks[21], (DEPTH, FFN_HIDDEN, D_MODEL), FFN_HIDDEN ** -0.5),
    }


def reference(x, c, ctx, c_ctx, ada_w, ada_b, norm1_g, norm2_g, w_in, hgrn_lb_logits, hgrn_norm_g,
              na_q_norm_g, na_k_norm_g, na_rel_bias, w_branch_a, w_branch_b, w_out,
              ffn_w1, ffn_w3, ffn_conv_w, ffn_conv_b, ffn_w2):
    lower_bounds = jnp.cumsum(jax.nn.softmax(hgrn_lb_logits.astype(jnp.float32), axis=1), axis=1)
    xc = ctx
    for l in range(DEPTH):
        last_layer = l == DEPTH - 1
        mod_l = jax.nn.silu(c) @ ada_w[l] + ada_b[l]
        mod_c = jax.nn.silu(c_ctx) @ ada_w[l] + ada_b[l]
        sh1, sc1, g1, sh2, sc2, g2 = [m[:, None, :] for m in jnp.split(mod_l, N_MOD, axis=-1)]
        sh1c, sc1c, g1c, sh2c, sc2c, g2c = jnp.split(mod_c, N_MOD, axis=-1)

        h = modulate(rmsnorm(x, norm1_g[l]), sh1, sc1)
        hc = modulate(rmsnorm(xc, norm1_g[l]), sh1c, sc1c)
        qa, fwa, fba, ia, ga, qn, kn, vn, gta, gtb = split_columns(h @ w_in[l])
        qa_c, fwa_c, fba_c, ia_c, ga_c, qn_c, kn_c, vn_c, gta_c, gtb_c = split_columns(hc @ w_in[l])

        o_lf, o_cf = hgrn2_direction((qa_c, fwa_c, ia_c), (qa, fwa, ia), lower_bounds[0, l], False)
        o_lb, o_cb = hgrn2_direction((qa_c, fba_c, ia_c), (qa, fba, ia), lower_bounds[1, l], True)
        y_a = hgrn2_readout(o_lf + o_lb, ga, hgrn_norm_g[l], x.dtype)

        q_n = axial_rope(qk_norm(split_heads(qn, NA_HEADS), na_q_norm_g[l]))
        k_n = axial_rope(qk_norm(split_heads(kn, NA_HEADS), na_k_norm_g[l]))
        v_n = split_heads(vn, NA_HEADS)
        k_c = qk_norm(split_heads(kn_c, NA_HEADS), na_k_norm_g[l])
        v_c = split_heads(vn_c, NA_HEADS)
        y_b = neighbourhood_attention(q_n, k_n, v_n, k_c, v_c, na_rel_bias[l]).astype(x.dtype)

        x_mid = x + g1 * branch_merge(y_a, y_b, gta, gtb, w_branch_a[l], w_branch_b[l], w_out[l])

        h2 = modulate(rmsnorm(x_mid, norm2_g[l]), sh2, sc2)
        x_new = x_mid + g2 * conv_ffn(h2, ffn_w1[l], ffn_w3[l], ffn_conv_w[l], ffn_conv_b[l], ffn_w2[l])

        if not last_layer:
            y_a_c = hgrn2_readout(o_cf + o_cb, ga_c, hgrn_norm_g[l], x.dtype)
            q_c = qk_norm(split_heads(qn_c, NA_HEADS), na_q_norm_g[l])
            y_b_c = context_attention(q_c, k_c, v_c).astype(x.dtype)
            xc_mid = xc + g1c * branch_merge(y_a_c, y_b_c, gta_c, gtb_c, w_branch_a[l], w_branch_b[l], w_out[l])
            h2c = modulate(rmsnorm(xc_mid, norm2_g[l]), sh2c, sc2c)
            xc = xc_mid + g2c * conv_ffn(h2c, ffn_w1[l], ffn_w3[l], ffn_conv_w[l], ffn_conv_b[l], ffn_w2[l])
        x = x_new
    return x
```

```cpp
#include <hip/hip_runtime.h>
#include <cstdio>
#include <cstdint>
#include <cmath>
namespace pg8 {
#define PG8_LAS __attribute__((address_space(3)))
typedef unsigned short bf16_t;
typedef short bf16x8 __attribute__((ext_vector_type(8)));
typedef float f32x4 __attribute__((ext_vector_type(4)));
typedef unsigned u32x4 __attribute__((ext_vector_type(4)));
constexpr int BM = 256, BK = 64, HALF = 128, HTB = HALF * BK * 2  , STAGE_BYTES = 8 * HTB, NXCD = 8, WGM = 8;

__host__ __device__ __forceinline__ int lds_byte(int r, int c) { const int st = (r >> 4) * 2 + (c >> 5), rr = r & 15, cc = c & 31, ob = rr * 64 + cc * 2; return st * 1024 + (ob ^ (((ob >> 9) & 1) << 5)); }
__host__ __device__ __forceinline__ void stage_rc(int b, int& R, int& C) { const int st = b / 1024, sb = b % 1024, swz = sb ^ (((sb >> 9) & 1) << 5); R = (st >> 1) * 16 + swz / 64; C = (st & 1) * 32 + (swz % 64) / 2; }
__host__ __device__ __forceinline__ int perm32(int rho) { const int n = rho >> 4, i = rho & 15; return 8 * (i >> 2) + 4 * n + (i & 3); }

struct Unit { int pm, pn; };
struct Gemm { const bf16_t* A; const bf16_t* Bt; int M, N, K; };

struct StaticOrder {
    int nM, nN, nwg, G, c;
    __host__ __device__ void init(int M, int N, int G_, int c_) { nM = M / BM; nN = N / BM; nwg = nM * nN; G = G_; c = c_; }
    __host__ __device__ bool next(int i, Unit& u) const {
        const long L = (long)i * G + c; if (L >= nwg) return false;
        int wgid = (int)L; { const int q = nwg / NXCD, r = nwg % NXCD, xcd = wgid % NXCD, off = wgid / NXCD; wgid = (xcd < r ? xcd * (q + 1) : r * (q + 1) + (xcd - r) * q) + off; }
        const int nig = WGM * nN, gid = wgid / nig, fm = gid * WGM, gsz = (nM - fm) < WGM ? (nM - fm) : WGM;
        u.pm = fm + ((wgid % nig) % gsz); u.pn = (wgid % nig) / gsz; return true;
    }
    __device__ __forceinline__ void a_ready(const Unit&) const {}
    __device__ __forceinline__ void done(const Unit&) const {}
};

template <class Epi, class Sched, bool ALIGN_EPI = false, bool SP2 = false>
__device__ __forceinline__ void gemm_phase(PG8_LAS unsigned char* lds, const Gemm g, const Sched& S, const Epi& E) {
    const int tid = threadIdx.x, wid = __builtin_amdgcn_readfirstlane(tid >> 6), lane = tid & 63, wr = wid >> 2, wc = wid & 3, fr = lane & 15, fq = lane >> 4;
    const int K = g.K, nt = K / BK;
    unsigned voffA[2], voffB[2];
#pragma unroll
    for (int i = 0; i < 2; ++i) { int R, C; stage_rc(tid * 16 + i * 8192, R, C); const int Rb = Epi::PERM ? ((R & ~31) + perm32(R & 31)) : R;
        voffA[i] = (unsigned)(R * K + C) * 2u; voffB[i] = (unsigned)(Rb * K + C) * 2u; }
    const size_t kstep = (size_t)(BK * 2);
    const size_t hstep = (size_t)HALF * K * 2;
    const size_t tstep = 2 * hstep;
    const unsigned ldsw = (unsigned)wid * 1024u;
    const int aoff = lds_byte(wr * 64 + fr, fq * 8), boff = lds_byte(wc * 32 + fr, fq * 8);
#define PG8_SA(b, h) (((b) * 2 + (h)) * HTB)
#define PG8_SB(b, h) ((4 + (b) * 2 + (h)) * HTB)
#define PG8_STAGE(bufoff, gbase, voff) do { _Pragma("unroll") for (int _i = 0; _i < 2; ++_i) \
        __builtin_amdgcn_global_load_lds((const unsigned*)((const char*)(gbase) + (voff)[_i]), (PG8_LAS unsigned*)(lds + (bufoff) + ldsw + _i * 8192), 16, 0, 0); } while (0)
#define PG8_LDA(dst, b, h) do { _Pragma("unroll") for (int m = 0; m < 4; ++m) _Pragma("unroll") for (int k = 0; k < 2; ++k) dst[m][k] = *(const PG8_LAS bf16x8*)(lds + PG8_SA(b, h) + aoff + m * 2048 + k * 1024); } while (0)
#define PG8_LDB(dst, b, h) do { _Pragma("unroll") for (int n = 0; n < 2; ++n) _Pragma("unroll") for (int k = 0; k < 2; ++k) dst[n][k] = *(const PG8_LAS bf16x8*)(lds + PG8_SB(b, h) + boff + n * 2048 + k * 1024); } while (0)
#define PG8_MMA(ai, bj, At, Bt) do { __builtin_amdgcn_s_setprio(1); _Pragma("unroll") for (int m = 0; m < 4; ++m) _Pragma("unroll") for (int n = 0; n < 2; ++n) _Pragma("unroll") for (int k = 0; k < 2; ++k) \
        acc[ai][bj][m][n] = __builtin_amdgcn_mfma_f32_16x16x32_bf16(Bt[n][k], At[m][k], acc[ai][bj][m][n], 0, 0, 0); __builtin_amdgcn_s_setprio(0); } while (0)
#define PG8_WAIT_V(n) asm volatile("s_waitcnt vmcnt(" #n ")" ::: "memory")
#define PG8_WAIT_L(n) asm volatile("s_waitcnt lgkmcnt(" #n ")" ::: "memory")
#define PG8_BAR __builtin_amdgcn_s_barrier()
#define PG8_SCHED __builtin_amdgcn_sched_barrier(0)
    Unit cur, nxt; int ui = 0;
    if (!S.next(0, cur)) return;
    f32x4 acc[2][2][4][2];
#pragma unroll
    for (int a = 0; a < 2; ++a)
#pragma unroll
        for (int b = 0; b < 2; ++b)
#pragma unroll
            for (int m = 0; m < 4; ++m)
#pragma unroll
                for (int n = 0; n < 2; ++n) acc[a][b][m][n] = (f32x4){0.f, 0.f, 0.f, 0.f};
    bf16x8 At[4][2], B0[2][2], B1[2][2];
    const char* cA = (const char*)g.A + (size_t)cur.pm * tstep; const char* cB = (const char*)g.Bt + (size_t)cur.pn * tstep;
    S.a_ready(cur);
    if constexpr (SP2) {
        PG8_STAGE(PG8_SB(0, 0), cB, voffB); PG8_STAGE(PG8_SB(0, 1), cB + hstep, voffB); PG8_STAGE(PG8_SA(0, 0), cA, voffA); PG8_STAGE(PG8_SA(0, 1), cA + hstep, voffA);
        if (wr == 1) PG8_BAR;
        PG8_WAIT_V(2); PG8_BAR;
        PG8_STAGE(PG8_SB(1, 0), cB + kstep, voffB); PG8_STAGE(PG8_SA(1, 0), cA + kstep, voffA); PG8_STAGE(PG8_SB(1, 1), cB + hstep + kstep, voffB);
        PG8_WAIT_V(6); PG8_BAR;
    } else {
        PG8_STAGE(PG8_SB(0, 0), cB, voffB); PG8_STAGE(PG8_SA(0, 0), cA, voffA); PG8_STAGE(PG8_SB(0, 1), cB + hstep, voffB); PG8_STAGE(PG8_SA(0, 1), cA + hstep, voffA);
        if (wr == 1) PG8_BAR;
        PG8_WAIT_V(4); PG8_BAR;
        PG8_STAGE(PG8_SB(1, 0), cB + kstep, voffB); PG8_STAGE(PG8_SA(1, 0), cA + kstep, voffA); PG8_STAGE(PG8_SB(1, 1), cB + hstep + kstep, voffB);
        PG8_WAIT_V(6); PG8_BAR;
    }
    for (;;) {
        const bool has_next = S.next(ui + 1, nxt);
        const char* nA = has_next ? (const char*)g.A + (size_t)nxt.pm * tstep : cA; const char* nB = has_next ? (const char*)g.Bt + (size_t)nxt.pn * tstep : cB;
        for (int t = 0; t < nt; t += 2) {
            const bool last = (t == nt - 2);
            const char* a1 = cA + (size_t)(t + 1) * kstep;
            const char* a2 = last ? nA : cA + (size_t)(t + 2) * kstep; const char* b2 = last ? nB : cB + (size_t)(t + 2) * kstep;
            const char* a3 = a2 + kstep; const char* b3 = b2 + kstep;
            if (last && has_next) S.a_ready(nxt);
            if constexpr (SP2) {
            PG8_LDB(B0, 0, 0); PG8_LDB(B1, 0, 1); PG8_SCHED; PG8_LDA(At, 0, 0); PG8_STAGE(PG8_SA(1, 1), a1 + hstep, voffA);
            PG8_WAIT_V(8); PG8_WAIT_L(0); PG8_BAR; PG8_MMA(0, 0, At, B0); PG8_MMA(0, 1, At, B1); PG8_BAR; PG8_SCHED;
            PG8_LDA(At, 0, 1); PG8_STAGE(PG8_SB(0, 0), b2, voffB); PG8_STAGE(PG8_SB(0, 1), b2 + hstep, voffB); PG8_STAGE(PG8_SA(0, 0), a2, voffA);
            PG8_WAIT_V(8); PG8_WAIT_L(0); PG8_BAR; PG8_MMA(1, 0, At, B0); PG8_MMA(1, 1, At, B1); PG8_BAR; PG8_SCHED;
            PG8_LDB(B0, 1, 0); PG8_LDB(B1, 1, 1); PG8_SCHED; PG8_LDA(At, 1, 0); PG8_STAGE(PG8_SA(0, 1), a2 + hstep, voffA);
            PG8_WAIT_V(8); PG8_WAIT_L(0); PG8_BAR; PG8_MMA(0, 0, At, B0); PG8_MMA(0, 1, At, B1); PG8_BAR; PG8_SCHED;
            PG8_LDA(At, 1, 1); PG8_STAGE(PG8_SB(1, 0), b3, voffB); PG8_STAGE(PG8_SB(1, 1), b3 + hstep, voffB); PG8_STAGE(PG8_SA(1, 0), a3, voffA);
            PG8_WAIT_V(8); PG8_WAIT_L(0); PG8_BAR; PG8_MMA(1, 0, At, B0); PG8_MMA(1, 1, At, B1); PG8_BAR; PG8_SCHED;
            } else {
            PG8_LDB(B0, 0, 0); PG8_SCHED; PG8_LDA(At, 0, 0); PG8_STAGE(PG8_SA(1, 1), a1 + hstep, voffA);
            PG8_WAIT_L(8); PG8_BAR; PG8_WAIT_L(0); PG8_MMA(0, 0, At, B0); PG8_BAR; PG8_SCHED;
            PG8_LDB(B1, 0, 1); PG8_STAGE(PG8_SB(0, 0), b2, voffB);
            PG8_BAR; PG8_WAIT_L(0); PG8_MMA(0, 1, At, B1); PG8_BAR;
            PG8_LDA(At, 0, 1); PG8_STAGE(PG8_SA(0, 0), a2, voffA);
            PG8_BAR; PG8_WAIT_L(0); PG8_MMA(1, 0, At, B0); PG8_BAR; PG8_SCHED;
            PG8_STAGE(PG8_SB(0, 1), b2 + hstep, voffB);
            PG8_WAIT_V(6); PG8_BAR; PG8_MMA(1, 1, At, B1); PG8_BAR;
            PG8_LDB(B0, 1, 0); PG8_SCHED; PG8_LDA(At, 1, 0); PG8_STAGE(PG8_SA(0, 1), a2 + hstep, voffA);
            PG8_WAIT_L(8); PG8_BAR; PG8_WAIT_L(0); PG8_MMA(0, 0, At, B0); PG8_BAR; PG8_SCHED;
            PG8_LDB(B1, 1, 1); PG8_STAGE(PG8_SB(1, 0), b3, voffB);
            PG8_BAR; PG8_WAIT_L(0); PG8_MMA(0, 1, At, B1); PG8_BAR;
            PG8_LDA(At, 1, 1); PG8_STAGE(PG8_SA(1, 0), a3, voffA);
            PG8_BAR; PG8_WAIT_L(0); PG8_MMA(1, 0, At, B0); PG8_BAR; PG8_SCHED;
            PG8_STAGE(PG8_SB(1, 1), b3 + hstep, voffB);
            PG8_WAIT_V(6); PG8_BAR; PG8_MMA(1, 1, At, B1); PG8_BAR;
            }
        }
        if constexpr (ALIGN_EPI) { if (wr == 0) PG8_BAR; }
        if constexpr (!Epi::AFTER_DRAIN) { E(acc, cur, wr, wc, fr, fq); S.done(cur); }
        if (!has_next) break;
#pragma unroll
        for (int a = 0; a < 2; ++a)
#pragma unroll
            for (int b = 0; b < 2; ++b)
#pragma unroll
                for (int m = 0; m < 4; ++m)
#pragma unroll
                    for (int n = 0; n < 2; ++n) acc[a][b][m][n] = (f32x4){0.f, 0.f, 0.f, 0.f};
        cur = nxt; cA = nA; cB = nB; ++ui;
        if constexpr (ALIGN_EPI) { if (wr == 1) PG8_BAR; }
    }
    PG8_WAIT_V(0);
    if constexpr (!ALIGN_EPI) { if (wr == 0) PG8_BAR; }
    PG8_BAR;
    if constexpr (Epi::AFTER_DRAIN) { E.fused(acc, cur, wr, wc, fr, fq, lds, wid, lane); S.done(cur); }
#undef PG8_SA
#undef PG8_SB
#undef PG8_STAGE
#undef PG8_LDA
#undef PG8_LDB
#undef PG8_MMA
#undef PG8_WAIT_V
#undef PG8_WAIT_L
#undef PG8_BAR
#undef PG8_SCHED
}
}

constexpr int D_MODEL = 2048, BATCH = 4, SEQ = 2048, CTX = 256, GRID_W = 64, NHEAD = 8, HD = 128, WA = 1024;
constexpr int FFN = 5632, IN_COLS = 12288, NMOD = 6;
constexpr int ML = BATCH * SEQ;
constexpr int MC = BATCH * CTX;
constexpr int MT = ML + MC;
constexpr float EPS = 1e-6f;
constexpr int NTHREADS = 512;

typedef unsigned short bf16;
typedef float f32x4 __attribute__((ext_vector_type(4)));
typedef unsigned u32x2 __attribute__((ext_vector_type(2)));
typedef unsigned u32x4 __attribute__((ext_vector_type(4)));
#define LAS __attribute__((address_space(3)))

__device__ __forceinline__ unsigned f2bf(float f) { unsigned u = __builtin_bit_cast(unsigned, f); return (u + 0x7fffu + ((u >> 16) & 1u)) >> 16; }
__device__ __forceinline__ unsigned pk2(float lo, float hi) { return f2bf(lo) | (f2bf(hi) << 16); }
__device__ __forceinline__ float bf2f(unsigned short h) { return __builtin_bit_cast(float, (unsigned)h << 16); }
__device__ __forceinline__ float bflo(unsigned w) { return __builtin_bit_cast(float, w << 16); }
__device__ __forceinline__ float bfhi(unsigned w) { return __builtin_bit_cast(float, w & 0xffff0000u); }
__device__ __forceinline__ float sigmoidf_(float x) { return 1.0f / (1.0f + __expf(-x)); }
__device__ __forceinline__ float siluf_(float x) { return x / (1.0f + __expf(-x)); }
__device__ __forceinline__ float wave_sum(float v) {
#pragma unroll
    for (int o = 1; o < 64; o <<= 1) v += __shfl_xor(v, o);
    return v;
}
__device__ __forceinline__ float wave_max(float v) {
#pragma unroll
    for (int o = 1; o < 64; o <<= 1) v = fmaxf(v, __shfl_xor(v, o));
    return v;
}

constexpr size_t al256(size_t x) { return (x + 255) & ~(size_t)255; }
constexpr size_t WS_CTL   = 0;
constexpr size_t CTL_ZERO_BYTES = 1u << 20;
constexpr size_t WS_ROWSQ = 64 * 1024;
constexpr size_t WS_BIAS2 = WS_ROWSQ + (size_t)ML * 4;
static_assert(WS_BIAS2 + (size_t)4 * 2 * FFN * 4 <= CTL_ZERO_BYTES, "ctl");
constexpr size_t WS_MOD   = CTL_ZERO_BYTES;
constexpr size_t WS_LB    = al256(WS_MOD + (size_t)5 * IN_COLS * 4);
constexpr size_t WS_SMALL_END = al256(WS_LB + 2 * WA * 4);
constexpr size_t WS_W13T  = al256(WS_SMALL_END);
constexpr size_t WS_W2T   = WS_W13T + (size_t)2 * FFN * D_MODEL * 2;
constexpr size_t WS_WAT   = WS_W2T + (size_t)D_MODEL * FFN * 2;
constexpr size_t WS_WBT   = WS_WAT + (size_t)D_MODEL * WA * 2;
constexpr size_t WS_WOT   = WS_WBT + (size_t)D_MODEL * WA * 2;
constexpr size_t WS_A_END = WS_WOT + (size_t)D_MODEL * D_MODEL * 2;
constexpr size_t SEGB = (size_t)MT * WA * 2;
constexpr size_t WS_QA  = WS_A_END;
constexpr size_t WS_FW  = WS_QA + SEGB;
constexpr size_t WS_FB  = WS_FW + 2 * SEGB;
constexpr size_t WS_IA  = WS_FB + 2 * SEGB;
constexpr size_t WS_GA  = WS_IA + SEGB;
constexpr size_t WS_QN  = WS_GA + (size_t)ML * WA * 2;
constexpr size_t WS_KN  = WS_QN + (size_t)ML * WA * 2;
constexpr size_t WS_VN  = WS_KN + SEGB;
constexpr size_t WS_GTA = WS_VN + SEGB;
constexpr size_t WS_GTB = WS_GTA + (size_t)ML * D_MODEL * 2;
constexpr size_t WS_D_END = WS_GTB + (size_t)ML * D_MODEL * 2;
constexpr size_t WS_WINT = WS_D_END;
constexpr size_t WS_OF   = WS_WINT;
constexpr size_t WS_OB   = WS_OF + (size_t)ML * WA * 2;
constexpr size_t WS_B_END = WS_WINT + (size_t)IN_COLS * D_MODEL * 2;
static_assert(WS_OB + (size_t)ML * WA * 2 <= WS_B_END, "B");
constexpr size_t WS_H   = WS_B_END;
constexpr size_t WS_YA  = WS_H;
constexpr size_t WS_YB  = WS_YA + (size_t)ML * WA * 2;
constexpr size_t WS_C_END = WS_H + (size_t)MT * D_MODEL * 2;
constexpr size_t WS_ACT_END = WS_D_END + (size_t)ML * FFN * 2;
constexpr size_t WS_END = WS_C_END > WS_ACT_END ? WS_C_END : WS_ACT_END;
static_assert(WS_END <= 445000000, "ws budget");
constexpr size_t WS_Z   = WS_QA;
constexpr size_t WS_XMG = WS_GTB;
constexpr size_t WS_A13 = WS_QA;
static_assert(WS_A13 + (size_t)ML * 2 * FFN * 2 <= WS_XMG, "A13 overlay");
constexpr size_t WS_ACT = WS_WINT;
static_assert(WS_ACT + (size_t)ML * FFN * 2 <= WS_END, "ACT overlay");

struct Params {
    const float *x, *c, *ctx, *c_ctx, *ada_w, *ada_b, *norm1_g, *norm2_g, *w_in, *lb_logits, *hgrn_norm_g, *q_norm_g, *k_norm_g, *rel_bias,
                *w_a, *w_b, *w_o, *w1, *w3, *conv_w, *conv_b, *w2;
    float* out;
    unsigned char* ws;
};

__device__ __forceinline__ void transpose_item(const float* W, int K, int N, bf16* WT, int row_off, LAS float* scr, int item, int lane) {
    const int nblk = N / 32, kb = item / nblk, nb = item % nblk, k0 = 64 * kb, n0 = 32 * nb;
#pragma unroll 8
    for (int i = 0; i < 32; ++i) { const int kk = 2 * i + (lane >> 5); scr[kk * 33 + (lane & 31)] = W[(size_t)(k0 + kk) * N + n0 + (lane & 31)]; }
    asm volatile("s_waitcnt lgkmcnt(0)" ::: "memory");
    const int c = lane & 7;
#pragma unroll
    for (int j = 0; j < 4; ++j) { const int n = (lane >> 3) + 8 * j; const LAS float* s = scr + (8 * c) * 33 + n;
        u32x4 o; o.x = pk2(s[0 * 33], s[1 * 33]); o.y = pk2(s[2 * 33], s[3 * 33]); o.z = pk2(s[4 * 33], s[5 * 33]); o.w = pk2(s[6 * 33], s[7 * 33]);
        *(u32x4*)(WT + (size_t)(row_off + n0 + n) * K + k0 + 8 * c) = o; }
    asm volatile("s_waitcnt lgkmcnt(0)" ::: "memory");
}
__device__ __forceinline__ void phase_wconv(const Params& p, LAS unsigned char* lds, int vb, int nb) {
    const int tid = threadIdx.x, lane = tid & 63, wave = tid >> 6;
    LAS float* scr = (LAS float*)(lds + wave * 16384);
    const int gw = vb * 8 + wave, NGW = nb * 8;
    constexpr int I_IN = (D_MODEL / 64) * (IN_COLS / 32), I_A = (WA / 64) * (D_MODEL / 32), I_O = (D_MODEL / 64) * (D_MODEL / 32),
                  I_1 = (D_MODEL / 64) * (FFN / 32), I_2 = (FFN / 64) * (D_MODEL / 32);
    constexpr int NITEMS = I_IN + 2 * I_A + I_O + 2 * I_1 + I_2;
    unsigned char* ws = p.ws;
    for (int it = gw; it < NITEMS; it += NGW) {
        int r = it;
        if (r < I_IN) { transpose_item(p.w_in, D_MODEL, IN_COLS, (bf16*)(ws + WS_WINT), 0, scr, r, lane); continue; } r -= I_IN;
        if (r < I_A) { transpose_item(p.w_a, WA, D_MODEL, (bf16*)(ws + WS_WAT), 0, scr, r, lane); continue; } r -= I_A;
        if (r < I_A) { transpose_item(p.w_b, WA, D_MODEL, (bf16*)(ws + WS_WBT), 0, scr, r, lane); continue; } r -= I_A;
        if (r < I_O) { transpose_item(p.w_o, D_MODEL, D_MODEL, (bf16*)(ws + WS_WOT), 0, scr, r, lane); continue; } r -= I_O;
        if (r < I_1) { transpose_item(p.w1, D_MODEL, FFN, (bf16*)(ws + WS_W13T), 0, scr, r, lane); continue; } r -= I_1;
        if (r < I_1) { transpose_item(p.w3, D_MODEL, FFN, (bf16*)(ws + WS_W13T), FFN, scr, r, lane); continue; } r -= I_1;
        transpose_item(p.w2, FFN, D_MODEL, (bf16*)(ws + WS_W2T), 0, scr, r, lane);
    }
}

__device__ __forceinline__ void phase_mod(const Params& p, LAS unsigned char* lds, int vb, int nb) {
    const int tid = threadIdx.x;
    LAS float* sc = (LAS float*)lds;
    LAS float* red = (LAS float*)(lds + 5 * 2048 * 4);
    for (int i = tid; i < 5 * D_MODEL; i += NTHREADS) { const int r = i / D_MODEL, k = i % D_MODEL; const float v = (r < 4) ? p.c[r * D_MODEL + k] : p.c_ctx[k]; sc[i] = siluf_(v); }
    __syncthreads();
    float* mod = (float*)(p.ws + WS_MOD);
    const int c4 = tid & 15, kp = tid >> 4;
    for (int item = vb; item < IN_COLS / 64; item += nb) {
        const int n0 = item * 64 + c4 * 4;
        f32x4 acc[5];
#pragma unroll
        for (int r = 0; r < 5; ++r) acc[r] = (f32x4){0.f, 0.f, 0.f, 0.f};
#pragma unroll 4
        for (int k = kp; k < D_MODEL; k += 32) {
            const f32x4 w = *(const f32x4*)(p.ada_w + (size_t)k * IN_COLS + n0);
#pragma unroll
            for (int r = 0; r < 5; ++r) acc[r] += w * sc[r * D_MODEL + k];
        }
#pragma unroll
        for (int r = 0; r < 5; ++r) *(LAS f32x4*)(red + (kp * 5 + r) * 64 + c4 * 4) = acc[r];
        __syncthreads();
        if (tid < 320) { const int r = tid / 64, cidx = tid % 64; float s = 0.f;
            for (int q = 0; q < 32; ++q) s += red[(q * 5 + r) * 64 + cidx];
            mod[r * IN_COLS + item * 64 + cidx] = s + p.ada_b[item * 64 + cidx]; }
        __syncthreads();
    }
    if (vb == 0) { float* lb = (float*)(p.ws + WS_LB);
        for (int i = tid; i < 2 * WA; i += NTHREADS) { const int d = i / WA, cc = i % WA; const float l0 = p.lb_logits[d * 2 * WA + cc], l1 = p.lb_logits[d * 2 * WA + WA + cc]; lb[i] = 1.0f / (1.0f + expf(l1 - l0)); } }
}

__device__ __forceinline__ void phase_h(const Params& p, int vb, int nb) {
    const int tid = threadIdx.x, lane = tid & 63, wave = tid >> 6;
    const float* mod = (const float*)(p.ws + WS_MOD);
    bf16* H = (bf16*)(p.ws + WS_H);
    for (int m = vb * 8 + wave; m < MT; m += nb * 8) {
        const float* xr = (m < ML) ? p.x + (size_t)m * D_MODEL : p.ctx + (size_t)(m - ML) * D_MODEL;
        const int mr = (m < ML) ? (m / SEQ) : 4;
        const float* sh = mod + (size_t)mr * IN_COLS, *scl = sh + D_MODEL;
        f32x4 v[8]; float s = 0.f;
#pragma unroll
        for (int j = 0; j < 8; ++j) { v[j] = *(const f32x4*)(xr + 4 * lane + 256 * j); s += (v[j].x * v[j].x + v[j].y * v[j].y) + (v[j].z * v[j].z + v[j].w * v[j].w); }
        const float rstd = 1.0f / sqrtf(wave_sum(s) * (1.0f / D_MODEL) + EPS);
#pragma unroll
        for (int j = 0; j < 8; ++j) { const int k = 4 * lane + 256 * j;
            const f32x4 g = *(const f32x4*)(p.norm1_g + k), a = *(const f32x4*)(scl + k), b = *(const f32x4*)(sh + k);
            const f32x4 h = v[j] * rstd * g * (a + 1.0f) + b;
            u32x2 o; o.x = pk2(h.x, h.y); o.y = pk2(h.z, h.w);
            *(u32x2*)(H + (size_t)m * D_MODEL + k) = o; }
    }
}

#define EPI_LOOP_BEGIN \
    _Pragma("unroll") for (int ai = 0; ai < 2; ++ai) _Pragma("unroll") for (int m = 0; m < 4; ++m) { const int row = u.pm * 256 + ai * 128 + wr * 64 + m * 16 + fr; \
    _Pragma("unroll") for (int bj = 0; bj < 2; ++bj) _Pragma("unroll") for (int n = 0; n < 2; ++n) { const int col = u.pn * 256 + bj * 128 + wc * 32 + n * 16 + fq * 4; const f32x4 v = acc[ai][bj][m][n];
#define EPI_LOOP_END } }

struct EpiInProj {
    static constexpr bool PERM = false, AFTER_DRAIN = false;
    unsigned char* ws;
    __device__ __forceinline__ void operator()(const f32x4 (&acc)[2][2][4][2], const pg8::Unit& u, int wr, int wc, int fr, int fq) const {
        const int seg = u.pn >> 2;
        const bool ctxrow = u.pm >= ML / 256;
        const float* lb = (const float*)(ws + WS_LB);
        if (seg == 1 || seg == 2) {
            float* F = (float*)(ws + (seg == 1 ? WS_FW : WS_FB)); const float* lbd = lb + (seg - 1) * WA;
            EPI_LOOP_BEGIN
                const int c = col - seg * WA; const f32x4 l = *(const f32x4*)(lbd + c); f32x4 o;
                o.x = logf(l.x + (1.0f - l.x) * sigmoidf_(v.x)); o.y = logf(l.y + (1.0f - l.y) * sigmoidf_(v.y));
                o.z = logf(l.z + (1.0f - l.z) * sigmoidf_(v.z)); o.w = logf(l.w + (1.0f - l.w) * sigmoidf_(v.w));
                *(f32x4*)(F + (size_t)row * WA + c) = o;
            EPI_LOOP_END
        } else if (seg == 0 || seg == 3 || seg == 6 || seg == 7) {
            if (ctxrow && seg == 0) return;
            bf16* O = (bf16*)(ws + (seg == 0 ? WS_QA : seg == 3 ? WS_IA : seg == 6 ? WS_KN : WS_VN));
            EPI_LOOP_BEGIN
                const int c = col - seg * WA; u32x2 o; o.x = pk2(v.x, v.y); o.y = pk2(v.z, v.w);
                *(u32x2*)(O + (size_t)row * WA + c) = o;
            EPI_LOOP_END
        } else if (seg == 4) {
            if (ctxrow) return;
            bf16* O = (bf16*)(ws + WS_GA);
            EPI_LOOP_BEGIN
                const int c = col - seg * WA; u32x2 o; o.x = pk2(siluf_(v.x), siluf_(v.y)); o.y = pk2(siluf_(v.z), siluf_(v.w));
                *(u32x2*)(O + (size_t)row * WA + c) = o;
            EPI_LOOP_END
        } else if (seg == 5) {
            if (ctxrow) return;
            bf16* O = (bf16*)(ws + WS_QN);
            EPI_LOOP_BEGIN
                const int c = col - seg * WA; u32x2 o; o.x = pk2(v.x, v.y); o.y = pk2(v.z, v.w);
                *(u32x2*)(O + (size_t)row * WA + c) = o;
            EPI_LOOP_END
        } else {
            if (ctxrow) return;
            const bool isa = seg < 10;
            bf16* O = (bf16*)(ws + (isa ? WS_GTA : WS_GTB)); const int cbase = isa ? 8 * WA : 10 * WA;
            EPI_LOOP_BEGIN
                const int c = col - cbase; u32x2 o; o.x = pk2(sigmoidf_(v.x), sigmoidf_(v.y)); o.y = pk2(sigmoidf_(v.z), sigmoidf_(v.w));
                *(u32x2*)(O + (size_t)row * D_MODEL + c) = o;
            EPI_LOOP_END
        }
    }
};

struct EpiMergeA {
    static constexpr bool PERM = false, AFTER_DRAIN = false;
    unsigned char* ws; float* tmp;
    __device__ __forceinline__ void operator()(const f32x4 (&acc)[2][2][4][2], const pg8::Unit& u, int wr, int wc, int fr, int fq) const {
        const bf16* G = (const bf16*)(ws + WS_GTA);
        EPI_LOOP_BEGIN
            const u32x2 g = *(const u32x2*)(G + (size_t)row * D_MODEL + col);
            f32x4 o; o.x = bflo(g.x) * v.x; o.y = bfhi(g.x) * v.y; o.z = bflo(g.y) * v.z; o.w = bfhi(g.y) * v.w;
            *(f32x4*)(tmp + (size_t)row * D_MODEL + col) = o;
        EPI_LOOP_END
    }
};
struct EpiMergeB {
    static constexpr bool PERM = false, AFTER_DRAIN = false;
    unsigned char* ws; const float* tmp;
    __device__ __forceinline__ void operator()(const f32x4 (&acc)[2][2][4][2], const pg8::Unit& u, int wr, int wc, int fr, int fq) const {
        const bf16* G = (const bf16*)(ws + WS_GTB); bf16* Z = (bf16*)(ws + WS_Z);
        EPI_LOOP_BEGIN
            const u32x2 g = *(const u32x2*)(G + (size_t)row * D_MODEL + col);
            const f32x4 t = *(const f32x4*)(tmp + (size_t)row * D_MODEL + col);
            u32x2 o; o.x = pk2(t.x + bflo(g.x) * v.x, t.y + bfhi(g.x) * v.y); o.y = pk2(t.z + bflo(g.y) * v.z, t.w + bfhi(g.y) * v.w);
            *(u32x2*)(Z + (size_t)row * D_MODEL + col) = o;
        EPI_LOOP_END
    }
};
struct EpiOutProj {
    static constexpr bool PERM = false, AFTER_DRAIN = false;
    unsigned char* ws; const float* x; const float* norm2_g; float* out;
    __device__ __forceinline__ void operator()(const f32x4 (&acc)[2][2][4][2], const pg8::Unit& u, int wr, int wc, int fr, int fq) const {
        const float* mod = (const float*)(ws + WS_MOD); bf16* XMG = (bf16*)(ws + WS_XMG); float* rowsq = (float*)(ws + WS_ROWSQ);
        const int b = (u.pm * 256) / SEQ;
        const float* g1 = mod + (size_t)b * IN_COLS + 2 * D_MODEL, *sc2 = mod + (size_t)b * IN_COLS + 4 * D_MODEL;
#pragma unroll
        for (int ai = 0; ai < 2; ++ai)
#pragma unroll
            for (int m = 0; m < 4; ++m) { const int row = u.pm * 256 + ai * 128 + wr * 64 + m * 16 + fr; float ss = 0.f;
#pragma unroll
                for (int bj = 0; bj < 2; ++bj)
#pragma unroll
                    for (int n = 0; n < 2; ++n) { const int col = u.pn * 256 + bj * 128 + wc * 32 + n * 16 + fq * 4; const f32x4 v = acc[ai][bj][m][n];
                        const f32x4 xv = *(const f32x4*)(x + (size_t)row * D_MODEL + col), g = *(const f32x4*)(g1 + col);
                        const f32x4 xm = xv + g * v;
                        *(f32x4*)(out + (size_t)row * D_MODEL + col) = xm;
                        ss += (xm.x * xm.x + xm.y * xm.y) + (xm.z * xm.z + xm.w * xm.w);
                        const f32x4 ng = *(const f32x4*)(norm2_g + col), s2 = *(const f32x4*)(sc2 + col);
                        const f32x4 h = xm * ng * (s2 + 1.0f);
                        u32x2 o; o.x = pk2(h.x, h.y); o.y = pk2(h.z, h.w);
                        *(u32x2*)(XMG + (size_t)row * D_MODEL + col) = o; }
                ss += __shfl_xor(ss, 16); ss += __shfl_xor(ss, 32);
                if (fq == 0) atomicAdd(rowsq + row, ss); }
    }
};
struct EpiFfnUp {
    static constexpr bool PERM = false, AFTER_DRAIN = false;
    unsigned char* ws;
    __device__ __forceinline__ void operator()(const f32x4 (&acc)[2][2][4][2], const pg8::Unit& u, int wr, int wc, int fr, int fq) const {
        const float* rowsq = (const float*)(ws + WS_ROWSQ); bf16* A13 = (bf16*)(ws + WS_A13);
        const int b = (u.pm * 256) / SEQ; const float* bias2 = (const float*)(ws + WS_BIAS2) + (size_t)b * 2 * FFN;
#pragma unroll
        for (int ai = 0; ai < 2; ++ai)
#pragma unroll
            for (int m = 0; m < 4; ++m) { const int row = u.pm * 256 + ai * 128 + wr * 64 + m * 16 + fr;
                const float rstd = 1.0f / sqrtf(__builtin_nontemporal_load(rowsq + row) * (1.0f / D_MODEL) + EPS);
#pragma unroll
                for (int bj = 0; bj < 2; ++bj)
#pragma unroll
                    for (int n = 0; n < 2; ++n) { const int col = u.pn * 256 + bj * 128 + wc * 32 + n * 16 + fq * 4; const f32x4 v = acc[ai][bj][m][n];
                        const f32x4 bb = *(const f32x4*)(bias2 + col); const f32x4 r = v * rstd + bb;
                        u32x2 o; o.x = pk2(r.x, r.y); o.y = pk2(r.z, r.w);
                        *(u32x2*)(A13 + (size_t)row * (2 * FFN) + col) = o; } }
    }
};
struct EpiFfnDown {
    static constexpr bool PERM = false, AFTER_DRAIN = false;
    unsigned char* ws; float* out;
    __device__ __forceinline__ void operator()(const f32x4 (&acc)[2][2][4][2], const pg8::Unit& u, int wr, int wc, int fr, int fq) const {
        const float* mod = (const float*)(ws + WS_MOD); const int b = (u.pm * 256) / SEQ; const float* g2 = mod + (size_t)b * IN_COLS + 5 * D_MODEL;
        EPI_LOOP_BEGIN
            float* o = out + (size_t)row * D_MODEL + col; const f32x4 xm = *(const f32x4*)o, g = *(const f32x4*)(g2 + col);
            *(f32x4*)o = xm + g * v;
        EPI_LOOP_END
    }
};

__device__ __forceinline__ void phase_qkrope(const Params& p, int vb, int nb) {
    const int tid = threadIdx.x, lane = tid & 63, wave = tid >> 6;
    bf16* QN = (bf16*)(p.ws + WS_QN); bf16* KN = (bf16*)(p.ws + WS_KN);
    const int j = lane & 31;
    const float inv = exp2f(-(float)j * (13.287712379549449f / 32.0f));
    const int NI = (ML + MT) * NHEAD;
    for (int it = vb * 8 + wave; it < NI; it += nb * 8) {
        const bool isq = it < ML * NHEAD; const int r = isq ? it : it - ML * NHEAD; const int row = r / NHEAD, h = r % NHEAD;
        bf16* ptr = (isq ? QN : KN) + (size_t)row * WA + h * HD; const float* g = isq ? p.q_norm_g : p.k_norm_g;
        float a = bf2f(ptr[lane]), b = bf2f(ptr[64 + lane]);
        const float rstd = 1.0f / sqrtf(wave_sum(a * a + b * b) * (1.0f / HD) + EPS);
        a = a * rstd * g[lane]; b = b * rstd * g[64 + lane];
        if (row < ML) {
            const int pos = row % SEQ; const float prow = (float)(pos / GRID_W), pcol = (float)(pos % GRID_W);
            float sa, ca, sb, cb; sincosf(prow * inv, &sa, &ca); sincosf(pcol * inv, &sb, &cb);
            const float ao = __shfl_xor(a, 32), bo = __shfl_xor(b, 32);
            a = (lane < 32) ? (a * ca - ao * sa) : (ao * sa + a * ca);
            b = (lane < 32) ? (b * cb - bo * sb) : (bo * sb + b * cb);
        }
        ptr[lane] = (bf16)f2bf(a); ptr[64 + lane] = (bf16)f2bf(b);
    }
}

__device__ __forceinline__ void phase_attn_naive(const Params& p, LAS unsigned char* lds, int vb, int nb) {
    const int tid = threadIdx.x, lane = tid & 63, wave = tid >> 6;
    LAS float* qs = (LAS float*)(lds + wave * 4096);
    LAS float* ps = qs + 128;
    const bf16* QN = (const bf16*)(p.ws + WS_QN); const bf16* KN = (const bf16*)(p.ws + WS_KN); const bf16* VN = (const bf16*)(p.ws + WS_VN);
    bf16* YB = (bf16*)(p.ws + WS_YB);
    const float scale = 0.08838834764831845f;
    for (int it = vb * 8 + wave; it < ML * NHEAD; it += nb * 8) {
        const int h = it % NHEAD, row = it / NHEAD, b = row / SEQ, pos = row % SEQ, r = pos / GRID_W, cq = pos % GRID_W;
        const int rs = min(max(r - 4, 0), 24), cs = min(max(cq - 8, 0), 48);
        { const unsigned w = *(const unsigned*)(QN + (size_t)row * WA + h * HD + 2 * lane); qs[2 * lane] = bflo(w); qs[2 * lane + 1] = bfhi(w); }
        asm volatile("s_waitcnt lgkmcnt(0)" ::: "memory");
        float s[6]; float mx = -1e30f;
#pragma unroll
        for (int i = 0; i < 6; ++i) {
            const int ki = lane + 64 * i; size_t krow; float bias = 0.f;
            if (i < 2) { const int jr = ki >> 4, w = ki & 15; const int kr = rs + jr, kc = cs + w; krow = (size_t)b * SEQ + kr * GRID_W + kc;
                bias = p.rel_bias[(h * 15 + (kr - r + 7)) * 31 + (kc - cq + 15)]; }
            else krow = (size_t)ML + b * CTX + (ki - 128);
            const u32x4* kp = (const u32x4*)(KN + krow * WA + h * HD); float d = 0.f;
#pragma unroll
            for (int c = 0; c < 16; ++c) { const u32x4 kv = kp[c]; const LAS float* q = qs + 8 * c;
                d += bflo(kv.x) * q[0] + bfhi(kv.x) * q[1] + bflo(kv.y) * q[2] + bfhi(kv.y) * q[3] + bflo(kv.z) * q[4] + bfhi(kv.z) * q[5] + bflo(kv.w) * q[6] + bfhi(kv.w) * q[7]; }
            s[i] = d * scale + bias; mx = fmaxf(mx, s[i]);
        }
        mx = wave_max(mx); float sum = 0.f;
#pragma unroll
        for (int i = 0; i < 6; ++i) { s[i] = __expf(s[i] - mx); sum += s[i]; }
        sum = wave_sum(sum); const float rinv = 1.0f / sum;
#pragma unroll
        for (int i = 0; i < 6; ++i) ps[lane + 64 * i] = s[i] * rinv;
        asm volatile("s_waitcnt lgkmcnt(0)" ::: "memory");
        float o0 = 0.f, o1 = 0.f;
        for (int ki = 0; ki < 384; ++ki) {
            size_t krow;
            if (ki < 128) krow = (size_t)b * SEQ + (rs + (ki >> 4)) * GRID_W + cs + (ki & 15); else krow = (size_t)ML + b * CTX + (ki - 128);
            const unsigned w = *(const unsigned*)(VN + krow * WA + h * HD + 2 * lane); const float pv = ps[ki];
            o0 += pv * bflo(w); o1 += pv * bfhi(w);
        }
        *(unsigned*)(YB + (size_t)row * WA + h * HD + 2 * lane) = pk2(o0, o1);
        asm volatile("s_waitcnt lgkmcnt(0)" ::: "memory");
    }
}

__device__ __forceinline__ void phase_hgrn_naive(const Params& p, LAS unsigned char* lds, int vb, int nb) {
    const int tid = threadIdx.x; const int v = tid >> 2, kq = tid & 3;
    LAS float* F = (LAS float*)lds; LAS float* KK = F + 16 * 128; LAS float* Q = KK + 16 * 128; LAS float* V = Q + 16 * 128;
    const bf16* QA = (const bf16*)(p.ws + WS_QA); const bf16* IA = (const bf16*)(p.ws + WS_IA);
    for (int item = vb; item < 2 * BATCH * NHEAD; item += nb) {
        const int dir = item / (BATCH * NHEAD), b = (item / NHEAD) % BATCH, h = item % NHEAD;
        const float* LF = (const float*)(p.ws + (dir == 0 ? WS_FW : WS_FB)); bf16* O = (bf16*)(p.ws + (dir == 0 ? WS_OF : WS_OB));
        float S[32];
#pragma unroll
        for (int i = 0; i < 32; ++i) S[i] = 0.f;
        for (int t0 = 0; t0 < CTX + SEQ; t0 += 16) {
            __syncthreads();
            for (int e = tid; e < 16 * 128; e += NTHREADS) { const int tt = e >> 7, c = e & 127; const int t = t0 + tt;
                size_t row; if (t < CTX) row = (size_t)ML + b * CTX + (dir == 0 ? t : CTX - 1 - t); else row = (size_t)b * SEQ + (dir == 0 ? (t - CTX) : (SEQ - 1 - (t - CTX)));
                const float f = expf(LF[row * WA + h * HD + c]); F[e] = f; KK[e] = 1.0f - f;
                Q[e] = (t < CTX) ? 0.f : bf2f(QA[row * WA + h * HD + c]); V[e] = bf2f(IA[row * WA + h * HD + c]); }
            __syncthreads();
            for (int tt = 0; tt < 16; ++tt) {
                const float vv = V[tt * 128 + v]; float o = 0.f;
#pragma unroll
                for (int i = 0; i < 32; i += 4) {
                    const f32x4 f4 = *(const LAS f32x4*)(F + tt * 128 + kq * 32 + i), k4 = *(const LAS f32x4*)(KK + tt * 128 + kq * 32 + i), q4 = *(const LAS f32x4*)(Q + tt * 128 + kq * 32 + i);
                    S[i] = f4.x * S[i] + k4.x * vv; o += S[i] * q4.x;
                    S[i + 1] = f4.y * S[i + 1] + k4.y * vv; o += S[i + 1] * q4.y;
                    S[i + 2] = f4.z * S[i + 2] + k4.z * vv; o += S[i + 2] * q4.z;
                    S[i + 3] = f4.w * S[i + 3] + k4.w * vv; o += S[i + 3] * q4.w;
                }
                o += __shfl_xor(o, 1); o += __shfl_xor(o, 2);
                const int t = t0 + tt;
                if (t >= CTX && kq == 0) { const size_t row = (size_t)b * SEQ + (dir == 0 ? (t - CTX) : (SEQ - 1 - (t - CTX))); O[row * WA + h * HD + v] = (bf16)f2bf(o); }
            }
        }
    }
}

__device__ __forceinline__ void phase_readout(const Params& p, int vb, int nb) {
    const int tid = threadIdx.x, lane = tid & 63, wave = tid >> 6;
    const bf16* OF = (const bf16*)(p.ws + WS_OF); const bf16* OB = (const bf16*)(p.ws + WS_OB); const bf16* GA = (const bf16*)(p.ws + WS_GA);
    bf16* YA = (bf16*)(p.ws + WS_YA);
    for (int it = vb * 8 + wave; it < ML * NHEAD; it += nb * 8) {
        const int row = it / NHEAD, h = it % NHEAD; const size_t off = (size_t)row * WA + h * HD + 2 * lane;
        const unsigned a = *(const unsigned*)(OF + off), b = *(const unsigned*)(OB + off), g = *(const unsigned*)(GA + off);
        const float o0 = bflo(a) + bflo(b), o1 = bfhi(a) + bfhi(b);
        const float rstd = 1.0f / sqrtf(wave_sum(o0 * o0 + o1 * o1) * (1.0f / HD) + EPS);
        const float y0 = o0 * rstd * p.hgrn_norm_g[2 * lane] * bflo(g), y1 = o1 * rstd * p.hgrn_norm_g[2 * lane + 1] * bfhi(g);
        *(unsigned*)(YA + off) = pk2(y0, y1);
    }
}

__device__ __forceinline__ void phase_bias2(const Params& p, int vb, int nb) {
    const int tid = threadIdx.x; const float* mod = (const float*)(p.ws + WS_MOD); float* bias2 = (float*)(p.ws + WS_BIAS2);
    constexpr int NCC = 2 * FFN / 512, NKC = D_MODEL / 64;
    for (int item = vb; item < NCC * NKC; item += nb) {
        const int cc = item % NCC, kc = item / NCC; const int col = cc * 512 + tid;
        const float* W = (col < FFN) ? p.w1 + col : p.w3 + (col - FFN);
        float a0 = 0.f, a1 = 0.f, a2 = 0.f, a3 = 0.f;
#pragma unroll 8
        for (int k = kc * 64; k < kc * 64 + 64; ++k) { const float w = W[(size_t)k * FFN];
            a0 += w * mod[0 * IN_COLS + 3 * D_MODEL + k]; a1 += w * mod[1 * IN_COLS + 3 * D_MODEL + k]; a2 += w * mod[2 * IN_COLS + 3 * D_MODEL + k]; a3 += w * mod[3 * IN_COLS + 3 * D_MODEL + k]; }
        atomicAdd(bias2 + 0 * 2 * FFN + col, a0); atomicAdd(bias2 + 1 * 2 * FFN + col, a1); atomicAdd(bias2 + 2 * 2 * FFN + col, a2); atomicAdd(bias2 + 3 * 2 * FFN + col, a3);
    }
}

__device__ __forceinline__ void phase_conv(const Params& p, int vb, int nb) {
    const int tid = threadIdx.x; const bf16* A13 = (const bf16*)(p.ws + WS_A13); bf16* ACT = (bf16*)(p.ws + WS_ACT);
    constexpr int CPR = FFN / 8;
    const size_t total = (size_t)ML * CPR;
    for (size_t i = (size_t)vb * NTHREADS + tid; i < total; i += (size_t)nb * NTHREADS) {
        const int row = (int)(i / CPR), c = (int)(i % CPR) * 8; const int t = row % SEQ;
        const bf16* ap = A13 + (size_t)row * (2 * FFN) + c;
        const u32x4 a1 = *(const u32x4*)ap; const u32x4 g = *(const u32x4*)(ap + FFN);
        u32x4 a0 = (u32x4){0u, 0u, 0u, 0u}, a2 = (u32x4){0u, 0u, 0u, 0u};
        if (t > 0) a0 = *(const u32x4*)(ap - 2 * FFN);
        if (t < SEQ - 1) a2 = *(const u32x4*)(ap + 2 * FFN);
        float w0[8], w1[8], w2[8], cb[8];
#pragma unroll
        for (int e = 0; e < 8; ++e) { w0[e] = p.conv_w[c + e]; w1[e] = p.conv_w[FFN + c + e]; w2[e] = p.conv_w[2 * FFN + c + e]; cb[e] = p.conv_b[c + e]; }
        float r[8];
#pragma unroll
        for (int q = 0; q < 4; ++q) {
            const unsigned x0 = a0[q], x1 = a1[q], x2 = a2[q], gg = g[q];
            const float u0 = bflo(x0) * w0[2 * q] + bflo(x1) * w1[2 * q] + bflo(x2) * w2[2 * q] + cb[2 * q];
            const float u1 = bfhi(x0) * w0[2 * q + 1] + bfhi(x1) * w1[2 * q + 1] + bfhi(x2) * w2[2 * q + 1] + cb[2 * q + 1];
            r[2 * q] = siluf_(u0) * bflo(gg); r[2 * q + 1] = siluf_(u1) * bfhi(gg);
        }
        u32x4 o; o.x = pk2(r[0], r[1]); o.y = pk2(r[2], r[3]); o.z = pk2(r[4], r[5]); o.w = pk2(r[6], r[7]);
        *(u32x4*)(ACT + (size_t)row * FFN + c) = o;
    }
}

constexpr int LDS_BYTES = 131072 + 1024;
enum { PH_MOD = 0, PH_WCONV, PH_H, PH_BIAS2, PH_INPROJ, PH_QKROPE, PH_ATTN, PH_HGRN, PH_READOUT, PH_MERGEA, PH_MERGEB, PH_OUTPROJ, PH_FFNUP, PH_CONV, PH_FFNDOWN };

template <int PH>
__global__ void __launch_bounds__(NTHREADS, 2) phase_kernel(Params p) {
    extern __shared__ __attribute__((aligned(16))) unsigned char lds_raw[];
    LAS unsigned char* lds = (LAS unsigned char*)lds_raw;
    const int vb = blockIdx.x, nb = gridDim.x;
    unsigned char* ws = p.ws;
    if constexpr (PH == PH_MOD) phase_mod(p, lds, vb, nb);
    else if constexpr (PH == PH_WCONV) phase_wconv(p, lds, vb, nb);
    else if constexpr (PH == PH_H) phase_h(p, vb, nb);
    else if constexpr (PH == PH_BIAS2) phase_bias2(p, vb, nb);
    else if constexpr (PH == PH_INPROJ) {
        pg8::Gemm g{(const bf16*)(ws + WS_H), (const bf16*)(ws + WS_WINT), MT, IN_COLS, D_MODEL}; pg8::StaticOrder S; S.init(MT, IN_COLS, nb, vb);
        EpiInProj E{ws}; pg8::gemm_phase<EpiInProj, pg8::StaticOrder, true, true>(lds, g, S, E);
    }
    else if constexpr (PH == PH_QKROPE) phase_qkrope(p, vb, nb);
    else if constexpr (PH == PH_ATTN) phase_attn_naive(p, lds, vb, nb);
    else if constexpr (PH == PH_HGRN) phase_hgrn_naive(p, lds, vb, nb);
    else if constexpr (PH == PH_READOUT) phase_readout(p, vb, nb);
    else if constexpr (PH == PH_MERGEA) {
        pg8::Gemm g{(const bf16*)(ws + WS_YA), (const bf16*)(ws + WS_WAT), ML, D_MODEL, WA}; pg8::StaticOrder S; S.init(ML, D_MODEL, nb, vb);
        EpiMergeA E{ws, p.out}; pg8::gemm_phase<EpiMergeA, pg8::StaticOrder, true, true>(lds, g, S, E);
    }
    else if constexpr (PH == PH_MERGEB) {
        pg8::Gemm g{(const bf16*)(ws + WS_YB), (const bf16*)(ws + WS_WBT), ML, D_MODEL, WA}; pg8::StaticOrder S; S.init(ML, D_MODEL, nb, vb);
        EpiMergeB E{ws, p.out}; pg8::gemm_phase<EpiMergeB, pg8::StaticOrder, true, true>(lds, g, S, E);
    }
    else if constexpr (PH == PH_OUTPROJ) {
        pg8::Gemm g{(const bf16*)(ws + WS_Z), (const bf16*)(ws + WS_WOT), ML, D_MODEL, D_MODEL}; pg8::StaticOrder S; S.init(ML, D_MODEL, nb, vb);
        EpiOutProj E{ws, p.x, p.norm2_g, p.out}; pg8::gemm_phase<EpiOutProj, pg8::StaticOrder, true, true>(lds, g, S, E);
    }
    else if constexpr (PH == PH_FFNUP) {
        pg8::Gemm g{(const bf16*)(ws + WS_XMG), (const bf16*)(ws + WS_W13T), ML, 2 * FFN, D_MODEL}; pg8::StaticOrder S; S.init(ML, 2 * FFN, nb, vb);
        EpiFfnUp E{ws}; pg8::gemm_phase<EpiFfnUp, pg8::StaticOrder, true, true>(lds, g, S, E);
    }
    else if constexpr (PH == PH_CONV) phase_conv(p, vb, nb);
    else if constexpr (PH == PH_FFNDOWN) {
        pg8::Gemm g{(const bf16*)(ws + WS_ACT), (const bf16*)(ws + WS_W2T), ML, D_MODEL, FFN}; pg8::StaticOrder S; S.init(ML, D_MODEL, nb, vb);
        EpiFfnDown E{ws, p.out}; pg8::gemm_phase<EpiFfnDown, pg8::StaticOrder, true, true>(lds, g, S, E);
    }
}

template <int PH> static void launch_phase(const Params& p, int grid, hipStream_t stream) {
    static bool attr = false;
    if (!attr) { (void)hipFuncSetAttribute((const void*)phase_kernel<PH>, hipFuncAttributeMaxDynamicSharedMemorySize, LDS_BYTES); attr = true; }
    hipLaunchKernelGGL(phase_kernel<PH>, dim3(grid), dim3(NTHREADS), LDS_BYTES, stream, p);
}

extern "C" void kernel_launch(void* const* d_in, const int* in_sizes, int n_in, void* d_out, int out_size, void* d_ws, size_t ws_size, hipStream_t stream) {
    if (n_in != 22 || ws_size < WS_END) { fprintf(stderr, "kernel_launch: bad inputs (n_in %d, ws %zu, need %zu)\n", n_in, ws_size, (size_t)WS_END); return; }
    Params p{};
    const float** f = (const float**)&p;
    for (int i = 0; i < 22; ++i) f[i] = (const float*)d_in[i];
    p.out = (float*)d_out; p.ws = (unsigned char*)d_ws;
    (void)hipMemsetAsync((char*)d_ws + WS_CTL, 0, CTL_ZERO_BYTES, stream);
    const int G = 256;
    launch_phase<PH_MOD>(p, G, stream);
    launch_phase<PH_WCONV>(p, G, stream);
    launch_phase<PH_H>(p, G, stream);
    launch_phase<PH_BIAS2>(p, G, stream);
    launch_phase<PH_INPROJ>(p, G, stream);
    launch_phase<PH_QKROPE>(p, G, stream);
    launch_phase<PH_ATTN>(p, G, stream);
    launch_phase<PH_HGRN>(p, G, stream);
    launch_phase<PH_READOUT>(p, G, stream);
    launch_phase<PH_MERGEA>(p, G, stream);
    launch_phase<PH_MERGEB>(p, G, stream);
    launch_phase<PH_OUTPROJ>(p, G, stream);
    launch_phase<PH_FFNUP>(p, G, stream);
    launch_phase<PH_CONV>(p, G, stream);
    launch_phase<PH_FFNDOWN>(p, G, stream);
}
```

```cpp
#include <hip/hip_runtime.h>
#include <cstdio>
#include <cstdint>
#include <cmath>
namespace pg8 {
#define PG8_LAS __attribute__((address_space(3)))
typedef unsigned short bf16_t;
typedef short bf16x8 __attribute__((ext_vector_type(8)));
typedef float f32x4 __attribute__((ext_vector_type(4)));
typedef unsigned u32x4 __attribute__((ext_vector_type(4)));
constexpr int BM = 256, BK = 64, HALF = 128, HTB = HALF * BK * 2  , STAGE_BYTES = 8 * HTB, NXCD = 8, WGM = 8;

__host__ __device__ __forceinline__ int lds_byte(int r, int c) { const int st = (r >> 4) * 2 + (c >> 5), rr = r & 15, cc = c & 31, ob = rr * 64 + cc * 2; return st * 1024 + (ob ^ (((ob >> 9) & 1) << 5)); }
__host__ __device__ __forceinline__ void stage_rc(int b, int& R, int& C) { const int st = b / 1024, sb = b % 1024, swz = sb ^ (((sb >> 9) & 1) << 5); R = (st >> 1) * 16 + swz / 64; C = (st & 1) * 32 + (swz % 64) / 2; }
__host__ __device__ __forceinline__ int perm32(int rho) { const int n = rho >> 4, i = rho & 15; return 8 * (i >> 2) + 4 * n + (i & 3); }

struct Unit { int pm, pn; };
struct Gemm { const bf16_t* A; const bf16_t* Bt; int M, N, K; };

struct StaticOrder {
    int nM, nN, nwg, G, c;
    __host__ __device__ void init(int M, int N, int G_, int c_) { nM = M / BM; nN = N / BM; nwg = nM * nN; G = G_; c = c_; }
    __host__ __device__ bool next(int i, Unit& u) const {
        const long L = (long)i * G + c; if (L >= nwg) return false;
        int wgid = (int)L; { const int q = nwg / NXCD, r = nwg % NXCD, xcd = wgid % NXCD, off = wgid / NXCD; wgid = (xcd < r ? xcd * (q + 1) : r * (q + 1) + (xcd - r) * q) + off; }
        const int nig = WGM * nN, gid = wgid / nig, fm = gid * WGM, gsz = (nM - fm) < WGM ? (nM - fm) : WGM;
        u.pm = fm + ((wgid % nig) % gsz); u.pn = (wgid % nig) / gsz; return true;
    }
    __device__ __forceinline__ void a_ready(const Unit&) const {}
    __device__ __forceinline__ void done(const Unit&) const {}
};

template <class Epi, class Sched, bool ALIGN_EPI = false, bool SP2 = false>
__device__ __forceinline__ void gemm_phase(PG8_LAS unsigned char* lds, const Gemm g, const Sched& S, const Epi& E) {
    const int tid = threadIdx.x, wid = __builtin_amdgcn_readfirstlane(tid >> 6), lane = tid & 63, wr = wid >> 2, wc = wid & 3, fr = lane & 15, fq = lane >> 4;
    const int K = g.K, nt = K / BK;
    unsigned voffA[2], voffB[2];
#pragma unroll
    for (int i = 0; i < 2; ++i) { int R, C; stage_rc(tid * 16 + i * 8192, R, C); const int Rb = Epi::PERM ? ((R & ~31) + perm32(R & 31)) : R;
        voffA[i] = (unsigned)(R * K + C) * 2u; voffB[i] = (unsigned)(Rb * K + C) * 2u; }
    const size_t kstep = (size_t)(BK * 2);
    const size_t hstep = (size_t)HALF * K * 2;
    const size_t tstep = 2 * hstep;
    const unsigned ldsw = (unsigned)wid * 1024u;
    const int aoff = lds_byte(wr * 64 + fr, fq * 8), boff = lds_byte(wc * 32 + fr, fq * 8);
#define PG8_SA(b, h) (((b) * 2 + (h)) * HTB)
#define PG8_SB(b, h) ((4 + (b) * 2 + (h)) * HTB)
#define PG8_STAGE(bufoff, gbase, voff) do { _Pragma("unroll") for (int _i = 0; _i < 2; ++_i) \
        __builtin_amdgcn_global_load_lds((const unsigned*)((const char*)(gbase) + (voff)[_i]), (PG8_LAS unsigned*)(lds + (bufoff) + ldsw + _i * 8192), 16, 0, 0); } while (0)
#define PG8_LDA(dst, b, h) do { _Pragma("unroll") for (int m = 0; m < 4; ++m) _Pragma("unroll") for (int k = 0; k < 2; ++k) dst[m][k] = *(const PG8_LAS bf16x8*)(lds + PG8_SA(b, h) + aoff + m * 2048 + k * 1024); } while (0)
#define PG8_LDB(dst, b, h) do { _Pragma("unroll") for (int n = 0; n < 2; ++n) _Pragma("unroll") for (int k = 0; k < 2; ++k) dst[n][k] = *(const PG8_LAS bf16x8*)(lds + PG8_SB(b, h) + boff + n * 2048 + k * 1024); } while (0)
#define PG8_MMA(ai, bj, At, Bt) do { __builtin_amdgcn_s_setprio(1); _Pragma("unroll") for (int m = 0; m < 4; ++m) _Pragma("unroll") for (int n = 0; n < 2; ++n) _Pragma("unroll") for (int k = 0; k < 2; ++k) \
        acc[ai][bj][m][n] = __builtin_amdgcn_mfma_f32_16x16x32_bf16(Bt[n][k], At[m][k], acc[ai][bj][m][n], 0, 0, 0); __builtin_amdgcn_s_setprio(0); } while (0)
#define PG8_WAIT_V(n) asm volatile("s_waitcnt vmcnt(" #n ")" ::: "memory")
#define PG8_WAIT_L(n) asm volatile("s_waitcnt lgkmcnt(" #n ")" ::: "memory")
#define PG8_BAR __builtin_amdgcn_s_barrier()
#define PG8_SCHED __builtin_amdgcn_sched_barrier(0)
    Unit cur, nxt; int ui = 0;
    if (!S.next(0, cur)) return;
    f32x4 acc[2][2][4][2];
#pragma unroll
    for (int a = 0; a < 2; ++a)
#pragma unroll
        for (int b = 0; b < 2; ++b)
#pragma unroll
            for (int m = 0; m < 4; ++m)
#pragma unroll
                for (int n = 0; n < 2; ++n) acc[a][b][m][n] = (f32x4){0.f, 0.f, 0.f, 0.f};
    bf16x8 At[4][2], B0[2][2], B1[2][2];
    const char* cA = (const char*)g.A + (size_t)cur.pm * tstep; const char* cB = (const char*)g.Bt + (size_t)cur.pn * tstep;
    S.a_ready(cur);
    if constexpr (SP2) {
        PG8_STAGE(PG8_SB(0, 0), cB, voffB); PG8_STAGE(PG8_SB(0, 1), cB + hstep, voffB); PG8_STAGE(PG8_SA(0, 0), cA, voffA); PG8_STAGE(PG8_SA(0, 1), cA + hstep, voffA);
        if (wr == 1) PG8_BAR;
        PG8_WAIT_V(2); PG8_BAR;
        PG8_STAGE(PG8_SB(1, 0), cB + kstep, voffB); PG8_STAGE(PG8_SA(1, 0), cA + kstep, voffA); PG8_STAGE(PG8_SB(1, 1), cB + hstep + kstep, voffB);
        PG8_WAIT_V(6); PG8_BAR;
    } else {
        PG8_STAGE(PG8_SB(0, 0), cB, voffB); PG8_STAGE(PG8_SA(0, 0), cA, voffA); PG8_STAGE(PG8_SB(0, 1), cB + hstep, voffB); PG8_STAGE(PG8_SA(0, 1), cA + hstep, voffA);
        if (wr == 1) PG8_BAR;
        PG8_WAIT_V(4); PG8_BAR;
        PG8_STAGE(PG8_SB(1, 0), cB + kstep, voffB); PG8_STAGE(PG8_SA(1, 0), cA + kstep, voffA); PG8_STAGE(PG8_SB(1, 1), cB + hstep + kstep, voffB);
        PG8_WAIT_V(6); PG8_BAR;
    }
    for (;;) {
        const bool has_next = S.next(ui + 1, nxt);
        const char* nA = has_next ? (const char*)g.A + (size_t)nxt.pm * tstep : cA; const char* nB = has_next ? (const char*)g.Bt + (size_t)nxt.pn * tstep : cB;
        for (int t = 0; t < nt; t += 2) {
            const bool last = (t == nt - 2);
            const char* a1 = cA + (size_t)(t + 1) * kstep;
            const char* a2 = last ? nA : cA + (size_t)(t + 2) * kstep; const char* b2 = last ? nB : cB + (size_t)(t + 2) * kstep;
            const char* a3 = a2 + kstep; const char* b3 = b2 + kstep;
            if (last && has_next) S.a_ready(nxt);
            if constexpr (SP2) {
            PG8_LDB(B0, 0, 0); PG8_LDB(B1, 0, 1); PG8_SCHED; PG8_LDA(At, 0, 0); PG8_STAGE(PG8_SA(1, 1), a1 + hstep, voffA);
            PG8_WAIT_V(8); PG8_WAIT_L(0); PG8_BAR; PG8_MMA(0, 0, At, B0); PG8_MMA(0, 1, At, B1); PG8_BAR; PG8_SCHED;
            PG8_LDA(At, 0, 1); PG8_STAGE(PG8_SB(0, 0), b2, voffB); PG8_STAGE(PG8_SB(0, 1), b2 + hstep, voffB); PG8_STAGE(PG8_SA(0, 0), a2, voffA);
            PG8_WAIT_V(8); PG8_WAIT_L(0); PG8_BAR; PG8_MMA(1, 0, At, B0); PG8_MMA(1, 1, At, B1); PG8_BAR; PG8_SCHED;
            PG8_LDB(B0, 1, 0); PG8_LDB(B1, 1, 1); PG8_SCHED; PG8_LDA(At, 1, 0); PG8_STAGE(PG8_SA(0, 1), a2 + hstep, voffA);
            PG8_WAIT_V(8); PG8_WAIT_L(0); PG8_BAR; PG8_MMA(0, 0, At, B0); PG8_MMA(0, 1, At, B1); PG8_BAR; PG8_SCHED;
            PG8_LDA(At, 1, 1); PG8_STAGE(PG8_SB(1, 0), b3, voffB); PG8_STAGE(PG8_SB(1, 1), b3 + hstep, voffB); PG8_STAGE(PG8_SA(1, 0), a3, voffA);
            PG8_WAIT_V(8); PG8_WAIT_L(0); PG8_BAR; PG8_MMA(1, 0, At, B0); PG8_MMA(1, 1, At, B1); PG8_BAR; PG8_SCHED;
            } else {
            PG8_LDB(B0, 0, 0); PG8_SCHED; PG8_LDA(At, 0, 0); PG8_STAGE(PG8_SA(1, 1), a1 + hstep, voffA);
            PG8_WAIT_L(8); PG8_BAR; PG8_WAIT_L(0); PG8_MMA(0, 0, At, B0); PG8_BAR; PG8_SCHED;
            PG8_LDB(B1, 0, 1); PG8_STAGE(PG8_SB(0, 0), b2, voffB);
            PG8_BAR; PG8_WAIT_L(0); PG8_MMA(0, 1, At, B1); PG8_BAR;
            PG8_LDA(At, 0, 1); PG8_STAGE(PG8_SA(0, 0), a2, voffA);
            PG8_BAR; PG8_WAIT_L(0); PG8_MMA(1, 0, At, B0); PG8_BAR; PG8_SCHED;
            PG8_STAGE(PG8_SB(0, 1), b2 + hstep, voffB);
            PG8_WAIT_V(6); PG8_BAR; PG8_MMA(1, 1, At, B1); PG8_BAR;
            PG8_LDB(B0, 1, 0); PG8_SCHED; PG8_LDA(At, 1, 0); PG8_STAGE(PG8_SA(0, 1), a2 + hstep, voffA);
            PG8_WAIT_L(8); PG8_BAR; PG8_WAIT_L(0); PG8_MMA(0, 0, At, B0); PG8_BAR; PG8_SCHED;
            PG8_LDB(B1, 1, 1); PG8_STAGE(PG8_SB(1, 0), b3, voffB);
            PG8_BAR; PG8_WAIT_L(0); PG8_MMA(0, 1, At, B1); PG8_BAR;
            PG8_LDA(At, 1, 1); PG8_STAGE(PG8_SA(1, 0), a3, voffA);
            PG8_BAR; PG8_WAIT_L(0); PG8_MMA(1, 0, At, B0); PG8_BAR; PG8_SCHED;
            PG8_STAGE(PG8_SB(1, 1), b3 + hstep, voffB);
            PG8_WAIT_V(6); PG8_BAR; PG8_MMA(1, 1, At, B1); PG8_BAR;
            }
        }
        if constexpr (ALIGN_EPI) { if (wr == 0) PG8_BAR; }
        if constexpr (!Epi::AFTER_DRAIN) { E(acc, cur, wr, wc, fr, fq); S.done(cur); }
        if (!has_next) break;
#pragma unroll
        for (int a = 0; a < 2; ++a)
#pragma unroll
            for (int b = 0; b < 2; ++b)
#pragma unroll
                for (int m = 0; m < 4; ++m)
#pragma unroll
                    for (int n = 0; n < 2; ++n) acc[a][b][m][n] = (f32x4){0.f, 0.f, 0.f, 0.f};
        cur = nxt; cA = nA; cB = nB; ++ui;
        if constexpr (ALIGN_EPI) { if (wr == 1) PG8_BAR; }
    }
    PG8_WAIT_V(0);
    if constexpr (!ALIGN_EPI) { if (wr == 0) PG8_BAR; }
    PG8_BAR;
    if constexpr (Epi::AFTER_DRAIN) { E.fused(acc, cur, wr, wc, fr, fq, lds, wid, lane); S.done(cur); }
#undef PG8_SA
#undef PG8_SB
#undef PG8_STAGE
#undef PG8_LDA
#undef PG8_LDB
#undef PG8_MMA
#undef PG8_WAIT_V
#undef PG8_WAIT_L
#undef PG8_BAR
#undef PG8_SCHED
}
}

constexpr int D_MODEL = 2048, BATCH = 4, SEQ = 2048, CTX = 256, GRID_W = 64, NHEAD = 8, HD = 128, WA = 1024;
constexpr int FFN = 5632, IN_COLS = 12288, NMOD = 6;
constexpr int ML = BATCH * SEQ;
constexpr int MC = BATCH * CTX;
constexpr int MT = ML + MC;
constexpr float EPS = 1e-6f;
constexpr int NTHREADS = 512;

typedef unsigned short bf16;
typedef float f32x4 __attribute__((ext_vector_type(4)));
typedef unsigned u32x2 __attribute__((ext_vector_type(2)));
typedef unsigned u32x4 __attribute__((ext_vector_type(4)));
#define LAS __attribute__((address_space(3)))

__device__ __forceinline__ unsigned f2bf(float f) { unsigned u = __builtin_bit_cast(unsigned, f); return (u + 0x7fffu + ((u >> 16) & 1u)) >> 16; }
__device__ __forceinline__ unsigned pk2(float lo, float hi) { return f2bf(lo) | (f2bf(hi) << 16); }
__device__ __forceinline__ float bf2f(unsigned short h) { return __builtin_bit_cast(float, (unsigned)h << 16); }
__device__ __forceinline__ float bflo(unsigned w) { return __builtin_bit_cast(float, w << 16); }
__device__ __forceinline__ float bfhi(unsigned w) { return __builtin_bit_cast(float, w & 0xffff0000u); }
__device__ __forceinline__ float sigmoidf_(float x) { return 1.0f / (1.0f + __expf(-x)); }
__device__ __forceinline__ float siluf_(float x) { return x / (1.0f + __expf(-x)); }
__device__ __forceinline__ float wave_sum(float v) {
#pragma unroll
    for (int o = 1; o < 64; o <<= 1) v += __shfl_xor(v, o);
    return v;
}
__device__ __forceinline__ float wave_max(float v) {
#pragma unroll
    for (int o = 1; o < 64; o <<= 1) v = fmaxf(v, __shfl_xor(v, o));
    return v;
}

constexpr size_t al256(size_t x) { return (x + 255) & ~(size_t)255; }
constexpr size_t WS_CTL   = 0;
constexpr size_t CTL_ZERO_BYTES = 1u << 20;
constexpr size_t WS_ROWSQ = 64 * 1024;
constexpr size_t WS_BIAS2 = WS_ROWSQ + (size_t)ML * 4;
static_assert(WS_BIAS2 + (size_t)4 * 2 * FFN * 4 <= CTL_ZERO_BYTES, "ctl");
constexpr size_t WS_MOD   = CTL_ZERO_BYTES;
constexpr size_t WS_LB    = al256(WS_MOD + (size_t)5 * IN_COLS * 4);
constexpr size_t WS_SMALL_END = al256(WS_LB + 2 * WA * 4);
constexpr size_t WS_W13T  = al256(WS_SMALL_END);
constexpr size_t WS_W2T   = WS_W13T + (size_t)2 * FFN * D_MODEL * 2;
constexpr size_t WS_WAT   = WS_W2T + (size_t)D_MODEL * FFN * 2;
constexpr size_t WS_WBT   = WS_WAT + (size_t)D_MODEL * WA * 2;
constexpr size_t WS_WOT   = WS_WBT + (size_t)D_MODEL * WA * 2;
constexpr size_t WS_A_END = WS_WOT + (size_t)D_MODEL * D_MODEL * 2;
constexpr size_t SEGB = (size_t)MT * WA * 2;
constexpr size_t WS_QA  = WS_A_END;
constexpr size_t WS_FW  = WS_QA + SEGB;
constexpr size_t WS_FB  = WS_FW + 2 * SEGB;
constexpr size_t WS_IA  = WS_FB + 2 * SEGB;
constexpr size_t WS_GA  = WS_IA + SEGB;
constexpr size_t WS_QN  = WS_GA + (size_t)ML * WA * 2;
constexpr size_t WS_KN  = WS_QN + (size_t)ML * WA * 2;
constexpr size_t WS_VN  = WS_KN + SEGB;
constexpr size_t WS_GTA = WS_VN + SEGB;
constexpr size_t WS_GTB = WS_GTA + (size_t)ML * D_MODEL * 2;
constexpr size_t WS_D_END = WS_GTB + (size_t)ML * D_MODEL * 2;
constexpr size_t WS_WINT = WS_D_END;
constexpr size_t WS_OF   = WS_WINT;
constexpr size_t WS_OB   = WS_OF + (size_t)ML * WA * 2;
constexpr size_t WS_B_END = WS_WINT + (size_t)IN_COLS * D_MODEL * 2;
static_assert(WS_OB + (size_t)ML * WA * 2 <= WS_B_END, "B");
constexpr size_t WS_H   = WS_B_END;
constexpr size_t WS_YA  = WS_H;
constexpr size_t WS_YB  = WS_YA + (size_t)ML * WA * 2;
constexpr size_t WS_C_END = WS_H + (size_t)MT * D_MODEL * 2;
constexpr size_t WS_ACT_END = WS_D_END + (size_t)ML * FFN * 2;
constexpr size_t WS_END = WS_C_END > WS_ACT_END ? WS_C_END : WS_ACT_END;
static_assert(WS_END <= 445000000, "ws budget");
constexpr size_t WS_Z   = WS_QA;
constexpr size_t WS_XMG = WS_GTB;
constexpr size_t WS_A13 = WS_QA;
static_assert(WS_A13 + (size_t)ML * 2 * FFN * 2 <= WS_XMG, "A13 overlay");
constexpr size_t WS_ACT = WS_WINT;
static_assert(WS_ACT + (size_t)ML * FFN * 2 <= WS_END, "ACT overlay");

struct Params {
    const float *x, *c, *ctx, *c_ctx, *ada_w, *ada_b, *norm1_g, *norm2_g, *w_in, *lb_logits, *hgrn_norm_g, *q_norm_g, *k_norm_g, *rel_bias,
                *w_a, *w_b, *w_o, *w1, *w3, *conv_w, *conv_b, *w2;
    float* out;
    unsigned char* ws;
};

__device__ __forceinline__ void transpose_item(const float* W, int K, int N, bf16* WT, int row_off, LAS float* scr, int item, int lane) {
    const int nblk = N / 32, kb = item / nblk, nb = item % nblk, k0 = 64 * kb, n0 = 32 * nb;
#pragma unroll 8
    for (int i = 0; i < 32; ++i) { const int kk = 2 * i + (lane >> 5); scr[kk * 33 + (lane & 31)] = W[(size_t)(k0 + kk) * N + n0 + (lane & 31)]; }
    asm volatile("s_waitcnt lgkmcnt(0)" ::: "memory");
    const int c = lane & 7;
#pragma unroll
    for (int j = 0; j < 4; ++j) { const int n = (lane >> 3) + 8 * j; const LAS float* s = scr + (8 * c) * 33 + n;
        u32x4 o; o.x = pk2(s[0 * 33], s[1 * 33]); o.y = pk2(s[2 * 33], s[3 * 33]); o.z = pk2(s[4 * 33], s[5 * 33]); o.w = pk2(s[6 * 33], s[7 * 33]);
        *(u32x4*)(WT + (size_t)(row_off + n0 + n) * K + k0 + 8 * c) = o; }
    asm volatile("s_waitcnt lgkmcnt(0)" ::: "memory");
}
__device__ __forceinline__ void phase_wconv(const Params& p, LAS unsigned char* lds, int vb, int nb) {
    const int tid = threadIdx.x, lane = tid & 63, wave = tid >> 6;
    LAS float* scr = (LAS float*)(lds + wave * 16384);
    const int gw = vb * 8 + wave, NGW = nb * 8;
    constexpr int I_IN = (D_MODEL / 64) * (IN_COLS / 32), I_A = (WA / 64) * (D_MODEL / 32), I_O = (D_MODEL / 64) * (D_MODEL / 32),
                  I_1 = (D_MODEL / 64) * (FFN / 32), I_2 = (FFN / 64) * (D_MODEL / 32);
    constexpr int NITEMS = I_IN + 2 * I_A + I_O + 2 * I_1 + I_2;
    unsigned char* ws = p.ws;
    for (int it = gw; it < NITEMS; it += NGW) {
        int r = it;
        if (r < I_IN) { transpose_item(p.w_in, D_MODEL, IN_COLS, (bf16*)(ws + WS_WINT), 0, scr, r, lane); continue; } r -= I_IN;
        if (r < I_A) { transpose_item(p.w_a, WA, D_MODEL, (bf16*)(ws + WS_WAT), 0, scr, r, lane); continue; } r -= I_A;
        if (r < I_A) { transpose_item(p.w_b, WA, D_MODEL, (bf16*)(ws + WS_WBT), 0, scr, r, lane); continue; } r -= I_A;
        if (r < I_O) { transpose_item(p.w_o, D_MODEL, D_MODEL, (bf16*)(ws + WS_WOT), 0, scr, r, lane); continue; } r -= I_O;
        if (r < I_1) { transpose_item(p.w1, D_MODEL, FFN, (bf16*)(ws + WS_W13T), 0, scr, r, lane); continue; } r -= I_1;
        if (r < I_1) { transpose_item(p.w3, D_MODEL, FFN, (bf16*)(ws + WS_W13T), FFN, scr, r, lane); continue; } r -= I_1;
        transpose_item(p.w2, FFN, D_MODEL, (bf16*)(ws + WS_W2T), 0, scr, r, lane);
    }
}

__device__ __forceinline__ void phase_mod(const Params& p, LAS unsigned char* lds, int vb, int nb) {
    const int tid = threadIdx.x;
    LAS float* sc = (LAS float*)lds;
    LAS float* red = (LAS float*)(lds + 5 * 2048 * 4);
    for (int i = tid; i < 5 * D_MODEL; i += NTHREADS) { const int r = i / D_MODEL, k = i % D_MODEL; const float v = (r < 4) ? p.c[r * D_MODEL + k] : p.c_ctx[k]; sc[i] = siluf_(v); }
    __syncthreads();
    float* mod = (float*)(p.ws + WS_MOD);
    const int c4 = tid & 15, kp = tid >> 4;
    for (int item = vb; item < IN_COLS / 64; item += nb) {
        const int n0 = item * 64 + c4 * 4;
        f32x4 acc[5];
#pragma unroll
        for (int r = 0; r < 5; ++r) acc[r] = (f32x4){0.f, 0.f, 0.f, 0.f};
#pragma unroll 4
        for (int k = kp; k < D_MODEL; k += 32) {
            const f32x4 w = *(const f32x4*)(p.ada_w + (size_t)k * IN_COLS + n0);
#pragma unroll
            for (int r = 0; r < 5; ++r) acc[r] += w * sc[r * D_MODEL + k];
        }
#pragma unroll
        for (int r = 0; r < 5; ++r) *(LAS f32x4*)(red + (kp * 5 + r) * 64 + c4 * 4) = acc[r];
        __syncthreads();
        if (tid < 320) { const int r = tid / 64, cidx = tid % 64; float s = 0.f;
            for (int q = 0; q < 32; ++q) s += red[(q * 5 + r) * 64 + cidx];
            mod[r * IN_COLS + item * 64 + cidx] = s + p.ada_b[item * 64 + cidx]; }
        __syncthreads();
    }
    if (vb == 0) { float* lb = (float*)(p.ws + WS_LB);
        for (int i = tid; i < 2 * WA; i += NTHREADS) { const int d = i / WA, cc = i % WA; const float l0 = p.lb_logits[d * 2 * WA + cc], l1 = p.lb_logits[d * 2 * WA + WA + cc]; lb[i] = 1.0f / (1.0f + expf(l1 - l0)); } }
}

__device__ __forceinline__ void phase_h(const Params& p, int vb, int nb) {
    const int tid = threadIdx.x, lane = tid & 63, wave = tid >> 6;
    const float* mod = (const float*)(p.ws + WS_MOD);
    bf16* H = (bf16*)(p.ws + WS_H);
    for (int m = vb * 8 + wave; m < MT; m += nb * 8) {
        const float* xr = (m < ML) ? p.x + (size_t)m * D_MODEL : p.ctx + (size_t)(m - ML) * D_MODEL;
        const int mr = (m < ML) ? (m / SEQ) : 4;
        const float* sh = mod + (size_t)mr * IN_COLS, *scl = sh + D_MODEL;
        f32x4 v[8]; float s = 0.f;
#pragma unroll
        for (int j = 0; j < 8; ++j) { v[j] = *(const f32x4*)(xr + 4 * lane + 256 * j); s += (v[j].x * v[j].x + v[j].y * v[j].y) + (v[j].z * v[j].z + v[j].w * v[j].w); }
        const float rstd = 1.0f / sqrtf(wave_sum(s) * (1.0f / D_MODEL) + EPS);
#pragma unroll
        for (int j = 0; j < 8; ++j) { const int k = 4 * lane + 256 * j;
            const f32x4 g = *(const f32x4*)(p.norm1_g + k), a = *(const f32x4*)(scl + k), b = *(const f32x4*)(sh + k);
            const f32x4 h = v[j] * rstd * g * (a + 1.0f) + b;
            u32x2 o; o.x = pk2(h.x, h.y); o.y = pk2(h.z, h.w);
            *(u32x2*)(H + (size_t)m * D_MODEL + k) = o; }
    }
}

#define EPI_LOOP_BEGIN \
    _Pragma("unroll") for (int ai = 0; ai < 2; ++ai) _Pragma("unroll") for (int m = 0; m < 4; ++m) { const int row = u.pm * 256 + ai * 128 + wr * 64 + m * 16 + fr; \
    _Pragma("unroll") for (int bj = 0; bj < 2; ++bj) _Pragma("unroll") for (int n = 0; n < 2; ++n) { const int col = u.pn * 256 + bj * 128 + wc * 32 + n * 16 + fq * 4; const f32x4 v = acc[ai][bj][m][n];
#define EPI_LOOP_END } }

struct EpiInProj {
    static constexpr bool PERM = false, AFTER_DRAIN = false;
    unsigned char* ws;
    __device__ __forceinline__ void operator()(const f32x4 (&acc)[2][2][4][2], const pg8::Unit& u, int wr, int wc, int fr, int fq) const {
        const int seg = u.pn >> 2;
        const bool ctxrow = u.pm >= ML / 256;
        const float* lb = (const float*)(ws + WS_LB);
        if (seg == 1 || seg == 2) {
            float* F = (float*)(ws + (seg == 1 ? WS_FW : WS_FB)); const float* lbd = lb + (seg - 1) * WA;
            EPI_LOOP_BEGIN
                const int c = col - seg * WA; const f32x4 l = *(const f32x4*)(lbd + c); f32x4 o;
                o.x = logf(l.x + (1.0f - l.x) * sigmoidf_(v.x)); o.y = logf(l.y + (1.0f - l.y) * sigmoidf_(v.y));
                o.z = logf(l.z + (1.0f - l.z) * sigmoidf_(v.z)); o.w = logf(l.w + (1.0f - l.w) * sigmoidf_(v.w));
                *(f32x4*)(F + (size_t)row * WA + c) = o;
            EPI_LOOP_END
        } else if (seg == 0 || seg == 3 || seg == 6 || seg == 7) {
            if (ctxrow && seg == 0) return;
            bf16* O = (bf16*)(ws + (seg == 0 ? WS_QA : seg == 3 ? WS_IA : seg == 6 ? WS_KN : WS_VN));
            EPI_LOOP_BEGIN
                const int c = col - seg * WA; u32x2 o; o.x = pk2(v.x, v.y); o.y = pk2(v.z, v.w);
                *(u32x2*)(O + (size_t)row * WA + c) = o;
            EPI_LOOP_END
        } else if (seg == 4) {
            if (ctxrow) return;
            bf16* O = (bf16*)(ws + WS_GA);
            EPI_LOOP_BEGIN
                const int c = col - seg * WA; u32x2 o; o.x = pk2(siluf_(v.x), siluf_(v.y)); o.y = pk2(siluf_(v.z), siluf_(v.w));
                *(u32x2*)(O + (size_t)row * WA + c) = o;
            EPI_LOOP_END
        } else if (seg == 5) {
            if (ctxrow) return;
            bf16* O = (bf16*)(ws + WS_QN);
            EPI_LOOP_BEGIN
                const int c = col - seg * WA; u32x2 o; o.x = pk2(v.x, v.y); o.y = pk2(v.z, v.w);
                *(u32x2*)(O + (size_t)row * WA + c) = o;
            EPI_LOOP_END
        } else {
            if (ctxrow) return;
            const bool isa = seg < 10;
            bf16* O = (bf16*)(ws + (isa ? WS_GTA : WS_GTB)); const int cbase = isa ? 8 * WA : 10 * WA;
            EPI_LOOP_BEGIN
                const int c = col - cbase; u32x2 o; o.x = pk2(sigmoidf_(v.x), sigmoidf_(v.y)); o.y = pk2(sigmoidf_(v.z), sigmoidf_(v.w));
                *(u32x2*)(O + (size_t)row * D_MODEL + c) = o;
            EPI_LOOP_END
        }
    }
};

struct EpiMergeA {
    static constexpr bool PERM = false, AFTER_DRAIN = false;
    unsigned char* ws; float* tmp;
    __device__ __forceinline__ void operator()(const f32x4 (&acc)[2][2][4][2], const pg8::Unit& u, int wr, int wc, int fr, int fq) const {
        const bf16* G = (const bf16*)(ws + WS_GTA);
        EPI_LOOP_BEGIN
            const u32x2 g = *(const u32x2*)(G + (size_t)row * D_MODEL + col);
            f32x4 o; o.x = bflo(g.x) * v.x; o.y = bfhi(g.x) * v.y; o.z = bflo(g.y) * v.z; o.w = bfhi(g.y) * v.w;
            *(f32x4*)(tmp + (size_t)row * D_MODEL + col) = o;
        EPI_LOOP_END
    }
};
struct EpiMergeB {
    static constexpr bool PERM = false, AFTER_DRAIN = false;
    unsigned char* ws; const float* tmp;
    __device__ __forceinline__ void operator()(const f32x4 (&acc)[2][2][4][2], const pg8::Unit& u, int wr, int wc, int fr, int fq) const {
        const bf16* G = (const bf16*)(ws + WS_GTB); bf16* Z = (bf16*)(ws + WS_Z);
        EPI_LOOP_BEGIN
            const u32x2 g = *(const u32x2*)(G + (size_t)row * D_MODEL + col);
            const f32x4 t = *(const f32x4*)(tmp + (size_t)row * D_MODEL + col);
            u32x2 o; o.x = pk2(t.x + bflo(g.x) * v.x, t.y + bfhi(g.x) * v.y); o.y = pk2(t.z + bflo(g.y) * v.z, t.w + bfhi(g.y) * v.w);
            *(u32x2*)(Z + (size_t)row * D_MODEL + col) = o;
        EPI_LOOP_END
    }
};
struct EpiOutProj {
    static constexpr bool PERM = false, AFTER_DRAIN = false;
    unsigned char* ws; const float* x; const float* norm2_g; float* out;
    __device__ __forceinline__ void operator()(const f32x4 (&acc)[2][2][4][2], const pg8::Unit& u, int wr, int wc, int fr, int fq) const {
        const float* mod = (const float*)(ws + WS_MOD); bf16* XMG = (bf16*)(ws + WS_XMG); float* rowsq = (float*)(ws + WS_ROWSQ);
        const int b = (u.pm * 256) / SEQ;
        const float* g1 = mod + (size_t)b * IN_COLS + 2 * D_MODEL, *sc2 = mod + (size_t)b * IN_COLS + 4 * D_MODEL;
#pragma unroll
        for (int ai = 0; ai < 2; ++ai)
#pragma unroll
            for (int m = 0; m < 4; ++m) { const int row = u.pm * 256 + ai * 128 + wr * 64 + m * 16 + fr; float ss = 0.f;
#pragma unroll
                for (int bj = 0; bj < 2; ++bj)
#pragma unroll
                    for (int n = 0; n < 2; ++n) { const int col = u.pn * 256 + bj * 128 + wc * 32 + n * 16 + fq * 4; const f32x4 v = acc[ai][bj][m][n];
                        const f32x4 xv = *(const f32x4*)(x + (size_t)row * D_MODEL + col), g = *(const f32x4*)(g1 + col);
                        const f32x4 xm = xv + g * v;
                        *(f32x4*)(out + (size_t)row * D_MODEL + col) = xm;
                        ss += (xm.x * xm.x + xm.y * xm.y) + (xm.z * xm.z + xm.w * xm.w);
                        const f32x4 ng = *(const f32x4*)(norm2_g + col), s2 = *(const f32x4*)(sc2 + col);
                        const f32x4 h = xm * ng * (s2 + 1.0f);
                        u32x2 o; o.x = pk2(h.x, h.y); o.y = pk2(h.z, h.w);
                        *(u32x2*)(XMG + (size_t)row * D_MODEL + col) = o; }
                ss += __shfl_xor(ss, 16); ss += __shfl_xor(ss, 32);
                if (fq == 0) atomicAdd(rowsq + row, ss); }
    }
};
struct EpiFfnUp {
    static constexpr bool PERM = false, AFTER_DRAIN = false;
    unsigned char* ws;
    __device__ __forceinline__ void operator()(const f32x4 (&acc)[2][2][4][2], const pg8::Unit& u, int wr, int wc, int fr, int fq) const {
        const float* rowsq = (const float*)(ws + WS_ROWSQ); bf16* A13 = (bf16*)(ws + WS_A13);
        const int b = (u.pm * 256) / SEQ; const float* bias2 = (const float*)(ws + WS_BIAS2) + (size_t)b * 2 * FFN;
#pragma unroll
        for (int ai = 0; ai < 2; ++ai)
#pragma unroll
            for (int m = 0; m < 4; ++m) { const int row = u.pm * 256 + ai * 128 + wr * 64 + m * 16 + fr;
                const float rstd = 1.0f / sqrtf(__builtin_nontemporal_load(rowsq + row) * (1.0f / D_MODEL) + EPS);
#pragma unroll
                for (int bj = 0; bj < 2; ++bj)
#pragma unroll
                    for (int n = 0; n < 2; ++n) { const int col = u.pn * 256 + bj * 128 + wc * 32 + n * 16 + fq * 4; const f32x4 v = acc[ai][bj][m][n];
                        const f32x4 bb = *(const f32x4*)(bias2 + col); const f32x4 r = v * rstd + bb;
                        u32x2 o; o.x = pk2(r.x, r.y); o.y = pk2(r.z, r.w);
                        *(u32x2*)(A13 + (size_t)row * (2 * FFN) + col) = o; } }
    }
};
struct EpiFfnDown {
    static constexpr bool PERM = false, AFTER_DRAIN = false;
    unsigned char* ws; float* out;
    __device__ __forceinline__ void operator()(const f32x4 (&acc)[2][2][4][2], const pg8::Unit& u, int wr, int wc, int fr, int fq) const {
        const float* mod = (const float*)(ws + WS_MOD); const int b = (u.pm * 256) / SEQ; const float* g2 = mod + (size_t)b * IN_COLS + 5 * D_MODEL;
        EPI_LOOP_BEGIN
            float* o = out + (size_t)row * D_MODEL + col; const f32x4 xm = *(const f32x4*)o, g = *(const f32x4*)(g2 + col);
            *(f32x4*)o = xm + g * v;
        EPI_LOOP_END
    }
};

__device__ __forceinline__ void phase_qkrope(const Params& p, int vb, int nb) {
    const int tid = threadIdx.x, lane = tid & 63, wave = tid >> 6;
    bf16* QN = (bf16*)(p.ws + WS_QN); bf16* KN = (bf16*)(p.ws + WS_KN);
    const int j = lane & 31;
    const float inv = exp2f(-(float)j * (13.287712379549449f / 32.0f));
    const int NI = (ML + MT) * NHEAD;
    for (int it = vb * 8 + wave; it < NI; it += nb * 8) {
        const bool isq = it < ML * NHEAD; const int r = isq ? it : it - ML * NHEAD; const int row = r / NHEAD, h = r % NHEAD;
        bf16* ptr = (isq ? QN : KN) + (size_t)row * WA + h * HD; const float* g = isq ? p.q_norm_g : p.k_norm_g;
        float a = bf2f(ptr[lane]), b = bf2f(ptr[64 + lane]);
        const float rstd = 1.0f / sqrtf(wave_sum(a * a + b * b) * (1.0f / HD) + EPS);
        a = a * rstd * g[lane]; b = b * rstd * g[64 + lane];
        if (row < ML) {
            const int pos = row % SEQ; const float prow = (float)(pos / GRID_W), pcol = (float)(pos % GRID_W);
            float sa, ca, sb, cb; sincosf(prow * inv, &sa, &ca); sincosf(pcol * inv, &sb, &cb);
            const float ao = __shfl_xor(a, 32), bo = __shfl_xor(b, 32);
            a = (lane < 32) ? (a * ca - ao * sa) : (ao * sa + a * ca);
            b = (lane < 32) ? (b * cb - bo * sb) : (bo * sb + b * cb);
        }
        ptr[lane] = (bf16)f2bf(a); ptr[64 + lane] = (bf16)f2bf(b);
    }
}

__device__ __forceinline__ void phase_attn_naive(const Params& p, LAS unsigned char* lds, int vb, int nb) {
    const int tid = threadIdx.x, lane = tid & 63, wave = tid >> 6;
    LAS float* qs = (LAS float*)(lds + wave * 4096);
    LAS float* ps = qs + 128;
    const bf16* QN = (const bf16*)(p.ws + WS_QN); const bf16* KN = (const bf16*)(p.ws + WS_KN); const bf16* VN = (const bf16*)(p.ws + WS_VN);
    bf16* YB = (bf16*)(p.ws + WS_YB);
    const float scale = 0.08838834764831845f;
    for (int it = vb * 8 + wave; it < ML * NHEAD; it += nb * 8) {
        const int h = it % NHEAD, row = it / NHEAD, b = row / SEQ, pos = row % SEQ, r = pos / GRID_W, cq = pos % GRID_W;
        const int rs = min(max(r - 4, 0), 24), cs = min(max(cq - 8, 0), 48);
        { const unsigned w = *(const unsigned*)(QN + (size_t)row * WA + h * HD + 2 * lane); qs[2 * lane] = bflo(w); qs[2 * lane + 1] = bfhi(w); }
        asm volatile("s_waitcnt lgkmcnt(0)" ::: "memory");
        float s[6]; float mx = -1e30f;
#pragma unroll
        for (int i = 0; i < 6; ++i) {
            const int ki = lane + 64 * i; size_t krow; float bias = 0.f;
            if (i < 2) { const int jr = ki >> 4, w = ki & 15; const int kr = rs + jr, kc = cs + w; krow = (size_t)b * SEQ + kr * GRID_W + kc;
                bias = p.rel_bias[(h * 15 + (kr - r + 7)) * 31 + (kc - cq + 15)]; }
            else krow = (size_t)ML + b * CTX + (ki - 128);
            const u32x4* kp = (const u32x4*)(KN + krow * WA + h * HD); float d = 0.f;
#pragma unroll
            for (int c = 0; c < 16; ++c) { const u32x4 kv = kp[c]; const LAS float* q = qs + 8 * c;
                d += bflo(kv.x) * q[0] + bfhi(kv.x) * q[1] + bflo(kv.y) * q[2] + bfhi(kv.y) * q[3] + bflo(kv.z) * q[4] + bfhi(kv.z) * q[5] + bflo(kv.w) * q[6] + bfhi(kv.w) * q[7]; }
            s[i] = d * scale + bias; mx = fmaxf(mx, s[i]);
        }
        mx = wave_max(mx); float sum = 0.f;
#pragma unroll
        for (int i = 0; i < 6; ++i) { s[i] = __expf(s[i] - mx); sum += s[i]; }
        sum = wave_sum(sum); const float rinv = 1.0f / sum;
#pragma unroll
        for (int i = 0; i < 6; ++i) ps[lane + 64 * i] = s[i] * rinv;
        asm volatile("s_waitcnt lgkmcnt(0)" ::: "memory");
        float o0 = 0.f, o1 = 0.f;
        for (int ki = 0; ki < 384; ++ki) {
            size_t krow;
            if (ki < 128) krow = (size_t)b * SEQ + (rs + (ki >> 4)) * GRID_W + cs + (ki & 15); else krow = (size_t)ML + b * CTX + (ki - 128);
            const unsigned w = *(const unsigned*)(VN + krow * WA + h * HD + 2 * lane); const float pv = ps[ki];
            o0 += pv * bflo(w); o1 += pv * bfhi(w);
        }
        *(unsigned*)(YB + (size_t)row * WA + h * HD + 2 * lane) = pk2(o0, o1);
        asm volatile("s_waitcnt lgkmcnt(0)" ::: "memory");
    }
}

__device__ __forceinline__ void phase_hgrn_naive(const Params& p, LAS unsigned char* lds, int vb, int nb) {
    const int tid = threadIdx.x; const int v = tid >> 2, kq = tid & 3;
    LAS float* F = (LAS float*)lds; LAS float* KK = F + 16 * 128; LAS float* Q = KK + 16 * 128; LAS float* V = Q + 16 * 128;
    const bf16* QA = (const bf16*)(p.ws + WS_QA); const bf16* IA = (const bf16*)(p.ws + WS_IA);
    for (int item = vb; item < 2 * BATCH * NHEAD; item += nb) {
        const int dir = item / (BATCH * NHEAD), b = (item / NHEAD) % BATCH, h = item % NHEAD;
        const float* LF = (const float*)(p.ws + (dir == 0 ? WS_FW : WS_FB)); bf16* O = (bf16*)(p.ws + (dir == 0 ? WS_OF : WS_OB));
        float S[32];
#pragma unroll
        for (int i = 0; i < 32; ++i) S[i] = 0.f;
        for (int t0 = 0; t0 < CTX + SEQ; t0 += 16) {
            __syncthreads();
            for (int e = tid; e < 16 * 128; e += NTHREADS) { const int tt = e >> 7, c = e & 127; const int t = t0 + tt;
                size_t row; if (t < CTX) row = (size_t)ML + b * CTX + (dir == 0 ? t : CTX - 1 - t); else row = (size_t)b * SEQ + (dir == 0 ? (t - CTX) : (SEQ - 1 - (t - CTX)));
                const float f = expf(LF[row * WA + h * HD + c]); F[e] = f; KK[e] = 1.0f - f;
                Q[e] = (t < CTX) ? 0.f : bf2f(QA[row * WA + h * HD + c]); V[e] = bf2f(IA[row * WA + h * HD + c]); }
            __syncthreads();
            for (int tt = 0; tt < 16; ++tt) {
                const float vv = V[tt * 128 + v]; float o = 0.f;
#pragma unroll
                for (int i = 0; i < 32; i += 4) {
                    const f32x4 f4 = *(const LAS f32x4*)(F + tt * 128 + kq * 32 + i), k4 = *(const LAS f32x4*)(KK + tt * 128 + kq * 32 + i), q4 = *(const LAS f32x4*)(Q + tt * 128 + kq * 32 + i);
                    S[i] = f4.x * S[i] + k4.x * vv; o += S[i] * q4.x;
                    S[i + 1] = f4.y * S[i + 1] + k4.y * vv; o += S[i + 1] * q4.y;
                    S[i + 2] = f4.z * S[i + 2] + k4.z * vv; o += S[i + 2] * q4.z;
                    S[i + 3] = f4.w * S[i + 3] + k4.w * vv; o += S[i + 3] * q4.w;
                }
                o += __shfl_xor(o, 1); o += __shfl_xor(o, 2);
                const int t = t0 + tt;
                if (t >= CTX && kq == 0) { const size_t row = (size_t)b * SEQ + (dir == 0 ? (t - CTX) : (SEQ - 1 - (t - CTX))); O[row * WA + h * HD + v] = (bf16)f2bf(o); }
            }
        }
    }
}

__device__ __forceinline__ void phase_readout(const Params& p, int vb, int nb) {
    const int tid = threadIdx.x, lane = tid & 63, wave = tid >> 6;
    const bf16* OF = (const bf16*)(p.ws + WS_OF); const bf16* OB = (const bf16*)(p.ws + WS_OB); const bf16* GA = (const bf16*)(p.ws + WS_GA);
    bf16* YA = (bf16*)(p.ws + WS_YA);
    for (int it = vb * 8 + wave; it < ML * NHEAD; it += nb * 8) {
        const int row = it / NHEAD, h = it % NHEAD; const size_t off = (size_t)row * WA + h * HD + 2 * lane;
        const unsigned a = *(const unsigned*)(OF + off), b = *(const unsigned*)(OB + off), g = *(const unsigned*)(GA + off);
        const float o0 = bflo(a) + bflo(b), o1 = bfhi(a) + bfhi(b);
        const float rstd = 1.0f / sqrtf(wave_sum(o0 * o0 + o1 * o1) * (1.0f / HD) + EPS);
        const float y0 = o0 * rstd * p.hgrn_norm_g[2 * lane] * bflo(g), y1 = o1 * rstd * p.hgrn_norm_g[2 * lane + 1] * bfhi(g);
        *(unsigned*)(YA + off) = pk2(y0, y1);
    }
}

__device__ __forceinline__ void phase_bias2(const Params& p, int vb, int nb) {
    const int tid = threadIdx.x; const float* mod = (const float*)(p.ws + WS_MOD); float* bias2 = (float*)(p.ws + WS_BIAS2);
    constexpr int NCC = 2 * FFN / 512, NKC = D_MODEL / 64;
    for (int item = vb; item < NCC * NKC; item += nb) {
        const int cc = item % NCC, kc = item / NCC; const int col = cc * 512 + tid;
        const float* W = (col < FFN) ? p.w1 + col : p.w3 + (col - FFN);
        float a0 = 0.f, a1 = 0.f, a2 = 0.f, a3 = 0.f;
#pragma unroll 8
        for (int k = kc * 64; k < kc * 64 + 64; ++k) { const float w = W[(size_t)k * FFN];
            a0 += w * mod[0 * IN_COLS + 3 * D_MODEL + k]; a1 += w * mod[1 * IN_COLS + 3 * D_MODEL + k]; a2 += w * mod[2 * IN_COLS + 3 * D_MODEL + k]; a3 += w * mod[3 * IN_COLS + 3 * D_MODEL + k]; }
        atomicAdd(bias2 + 0 * 2 * FFN + col, a0); atomicAdd(bias2 + 1 * 2 * FFN + col, a1); atomicAdd(bias2 + 2 * 2 * FFN + col, a2); atomicAdd(bias2 + 3 * 2 * FFN + col, a3);
    }
}

__device__ __forceinline__ void phase_conv(const Params& p, int vb, int nb) {
    const int tid = threadIdx.x; const bf16* A13 = (const bf16*)(p.ws + WS_A13); bf16* ACT = (bf16*)(p.ws + WS_ACT);
    constexpr int CPR = FFN / 8;
    const size_t total = (size_t)ML * CPR;
    for (size_t i = (size_t)vb * NTHREADS + tid; i < total; i += (size_t)nb * NTHREADS) {
        const int row = (int)(i / CPR), c = (int)(i % CPR) * 8; const int t = row % SEQ;
        const bf16* ap = A13 + (size_t)row * (2 * FFN) + c;
        const u32x4 a1 = *(const u32x4*)ap; const u32x4 g = *(const u32x4*)(ap + FFN);
        u32x4 a0 = (u32x4){0u, 0u, 0u, 0u}, a2 = (u32x4){0u, 0u, 0u, 0u};
        if (t > 0) a0 = *(const u32x4*)(ap - 2 * FFN);
        if (t < SEQ - 1) a2 = *(const u32x4*)(ap + 2 * FFN);
        float w0[8], w1[8], w2[8], cb[8];
#pragma unroll
        for (int e = 0; e < 8; ++e) { w0[e] = p.conv_w[c + e]; w1[e] = p.conv_w[FFN + c + e]; w2[e] = p.conv_w[2 * FFN + c + e]; cb[e] = p.conv_b[c + e]; }
        float r[8];
#pragma unroll
        for (int q = 0; q < 4; ++q) {
            const unsigned x0 = a0[q], x1 = a1[q], x2 = a2[q], gg = g[q];
            const float u0 = bflo(x0) * w0[2 * q] + bflo(x1) * w1[2 * q] + bflo(x2) * w2[2 * q] + cb[2 * q];
            const float u1 = bfhi(x0) * w0[2 * q + 1] + bfhi(x1) * w1[2 * q + 1] + bfhi(x2) * w2[2 * q + 1] + cb[2 * q + 1];
            r[2 * q] = siluf_(u0) * bflo(gg); r[2 * q + 1] = siluf_(u1) * bfhi(gg);
        }
        u32x4 o; o.x = pk2(r[0], r[1]); o.y = pk2(r[2], r[3]); o.z = pk2(r[4], r[5]); o.w = pk2(r[6], r[7]);
        *(u32x4*)(ACT + (size_t)row * FFN + c) = o;
    }
}

#define XB_TMO      128
#define XB_XCNT(j)  (256  + 64 * (j))
#define XB_XSUB(j)  (1280 + 64 * (j))
#define XB_XGEN(j)  (2304 + 64 * (j))
#define XB_TOP      3328
#define XB_TOPGEN   3392
#define XCD_BAR_WORDS 3456
#define XB_SPIN_CAP (1u << 18)

__device__ __forceinline__ unsigned xb_ld(unsigned* p)              { return __hip_atomic_load(p, __ATOMIC_RELAXED, __HIP_MEMORY_SCOPE_AGENT); }
__device__ __forceinline__ unsigned xb_add(unsigned* p, unsigned v) { return __hip_atomic_fetch_add(p, v, __ATOMIC_RELAXED, __HIP_MEMORY_SCOPE_AGENT); }
__device__ __forceinline__ unsigned xb_xcc_id() { return (unsigned)__builtin_amdgcn_s_getreg((3 << 11) | 20) & 0xFu; }
#define XB_SPIN(cond, bar) do { unsigned _sp = 0; while (cond) { __builtin_amdgcn_s_sleep(1); \
    if ((++_sp & 255u) == 0u) { if (xb_ld(&(bar)[XB_TMO])) break; if (_sp > XB_SPIN_CAP) { atomicAdd(&(bar)[XB_TMO], 1u); break; } } } } while (0)

struct XcdBarrier {
    unsigned* bar; unsigned x;
    volatile LAS unsigned* st;
};

__device__ __forceinline__ XcdBarrier xcd_barrier_post(unsigned* bar, volatile LAS unsigned* st) {
    XcdBarrier b; b.bar = bar; b.x = xb_xcc_id(); b.st = st;
    if (threadIdx.x == 0) (void)xb_add(&bar[XB_XCNT(b.x)], 1u);
    return b;
}
__device__ __forceinline__ void xcd_barrier_complete(unsigned* bar, unsigned x, unsigned& nloc, unsigned& nx) {
    const unsigned G = gridDim.x * gridDim.y * gridDim.z;
    unsigned sum, cnt, mine, sp = 0u;
    for (;;) {
        sum = 0u; cnt = 0u; mine = 0u;
#pragma unroll
        for (unsigned j = 0; j < 16; ++j) { const unsigned c = xb_ld(&bar[XB_XCNT(j)]); sum += c; cnt += (c > 0u) ? 1u : 0u; mine = (j == x) ? c : mine; }
        if (sum == G) break;
        __builtin_amdgcn_s_sleep(1);
        if ((++sp & 255u) == 0u) { if (xb_ld(&bar[XB_TMO])) break; if (sp > XB_SPIN_CAP) { atomicAdd(&bar[XB_TMO], 1u); break; } }
    }
    nloc = mine > 0u ? mine : 1u; nx = cnt > 0u ? cnt : 1u;
}

__device__ __forceinline__ void xcd_barrier(const XcdBarrier& b) {
    asm volatile("s_waitcnt vmcnt(0)" ::: "memory");
    __syncthreads();
    if (threadIdx.x == 0) {
        unsigned* bar = b.bar;
        __builtin_amdgcn_s_waitcnt(0);
        unsigned nloc = b.st[0], nx = b.st[1];
        if (nloc == 0u) { xcd_barrier_complete(bar, b.x, nloc, nx); b.st[0] = nloc; b.st[1] = nx; }
        const unsigned old = xb_add(&bar[XB_XSUB(b.x)], 1u);
        const unsigned gen = old / nloc;
        if (old + 1u == (gen + 1u) * nloc) {
            __builtin_amdgcn_fence(__ATOMIC_RELEASE, "agent");
            asm volatile("s_waitcnt vmcnt(0)" ::: "memory");
            const unsigned og = xb_add(&bar[XB_TOP], 1u);
            const unsigned tg = og / nx;
            if (og + 1u == (tg + 1u) * nx) xb_add(&bar[XB_TOPGEN], 1u);
            else XB_SPIN(xb_ld(&bar[XB_TOPGEN]) == tg, bar);
            __builtin_amdgcn_fence(__ATOMIC_ACQUIRE, "agent");
            xb_add(&bar[XB_XGEN(b.x)], 1u);
            asm volatile("s_waitcnt vmcnt(0)" ::: "memory");
        } else {
            XB_SPIN(xb_ld(&bar[XB_XGEN(b.x)]) == gen, bar);
            __builtin_amdgcn_fence(__ATOMIC_ACQUIRE, "agent");
            asm volatile("s_waitcnt vmcnt(0)" ::: "memory");
        }
    }
    __syncthreads();
}

constexpr int LDS_MISC_OFF = 131072;
constexpr int LDS_BYTES = 131072 + 1024;
constexpr size_t WS_BAR = 8192;
static_assert(WS_BAR + XCD_BAR_WORDS * 4 <= WS_ROWSQ, "barrier words inside ctl");

__global__ void __launch_bounds__(NTHREADS, 2) mega_fwd(Params p) {
    extern __shared__ __attribute__((aligned(16))) unsigned char lds_raw[];
    LAS unsigned char* lds = (LAS unsigned char*)lds_raw;
    const int nb = gridDim.x;
    const int vb = (nb % 8 == 0) ? ((int)(blockIdx.x % 8) * (nb / 8) + (int)(blockIdx.x / 8)) : (int)blockIdx.x;
    const int bx = blockIdx.x;
    unsigned char* ws = p.ws;
    volatile LAS unsigned* misc = (volatile LAS unsigned*)(lds + LDS_MISC_OFF);
    if (threadIdx.x < 64) misc[threadIdx.x] = 0u;
    __syncthreads();
    XcdBarrier bar = xcd_barrier_post((unsigned*)(ws + WS_BAR), misc + 8);
#define GRID_BAR() xcd_barrier(bar)

    phase_mod(p, lds, vb, nb);
    __syncthreads();
    phase_wconv(p, lds, vb, nb);
    GRID_BAR();
    phase_h(p, vb, nb);
    phase_bias2(p, vb, nb);
    GRID_BAR();
    { pg8::Gemm g{(const bf16*)(ws + WS_H), (const bf16*)(ws + WS_WINT), MT, IN_COLS, D_MODEL}; pg8::StaticOrder S; S.init(MT, IN_COLS, nb, bx);
      EpiInProj E{ws}; pg8::gemm_phase<EpiInProj, pg8::StaticOrder, true, true>(lds, g, S, E); }
    GRID_BAR();
    phase_qkrope(p, vb, nb);
    GRID_BAR();
    phase_hgrn_naive(p, lds, vb, nb);
    __syncthreads();
    phase_attn_naive(p, lds, vb, nb);
    GRID_BAR();
    phase_readout(p, vb, nb);
    GRID_BAR();
    { pg8::Gemm g{(const bf16*)(ws + WS_YA), (const bf16*)(ws + WS_WAT), ML, D_MODEL, WA}; pg8::StaticOrder S; S.init(ML, D_MODEL, nb, bx);
      EpiMergeA E{ws, p.out}; pg8::gemm_phase<EpiMergeA, pg8::StaticOrder, true, true>(lds, g, S, E); }
    GRID_BAR();
    { pg8::Gemm g{(const bf16*)(ws + WS_YB), (const bf16*)(ws + WS_WBT), ML, D_MODEL, WA}; pg8::StaticOrder S; S.init(ML, D_MODEL, nb, bx);
      EpiMergeB E{ws, p.out}; pg8::gemm_phase<EpiMergeB, pg8::StaticOrder, true, true>(lds, g, S, E); }
    GRID_BAR();
    { pg8::Gemm g{(const bf16*)(ws + WS_Z), (const bf16*)(ws + WS_WOT), ML, D_MODEL, D_MODEL}; pg8::StaticOrder S; S.init(ML, D_MODEL, nb, bx);
      EpiOutProj E{ws, p.x, p.norm2_g, p.out}; pg8::gemm_phase<EpiOutProj, pg8::StaticOrder, true, true>(lds, g, S, E); }
    GRID_BAR();
    { pg8::Gemm g{(const bf16*)(ws + WS_XMG), (const bf16*)(ws + WS_W13T), ML, 2 * FFN, D_MODEL}; pg8::StaticOrder S; S.init(ML, 2 * FFN, nb, bx);
      EpiFfnUp E{ws}; pg8::gemm_phase<EpiFfnUp, pg8::StaticOrder, true, true>(lds, g, S, E); }
    GRID_BAR();
    phase_conv(p, vb, nb);
    GRID_BAR();
    { pg8::Gemm g{(const bf16*)(ws + WS_ACT), (const bf16*)(ws + WS_W2T), ML, D_MODEL, FFN}; pg8::StaticOrder S; S.init(ML, D_MODEL, nb, bx);
      EpiFfnDown E{ws, p.out}; pg8::gemm_phase<EpiFfnDown, pg8::StaticOrder, true, true>(lds, g, S, E); }
#undef GRID_BAR
}

extern "C" void kernel_launch(void* const* d_in, const int* in_sizes, int n_in, void* d_out, int out_size, void* d_ws, size_t ws_size, hipStream_t stream) {
    static int grid = 0;
    if (grid == 0) {
        if (n_in != 22 || ws_size < WS_END || out_size != ML * D_MODEL) { fprintf(stderr, "kernel_launch: bad inputs (n_in %d, out %d, ws %zu, need %zu)\n", n_in, out_size, ws_size, (size_t)WS_END); grid = -1; return; }
        int dev = 0, cus = 0, per_cu = 0;
        if (hipGetDevice(&dev) != hipSuccess || hipDeviceGetAttribute(&cus, hipDeviceAttributeMultiprocessorCount, dev) != hipSuccess) { grid = -1; return; }
        if (hipFuncSetAttribute((const void*)mega_fwd, hipFuncAttributeMaxDynamicSharedMemorySize, LDS_BYTES) != hipSuccess) { fprintf(stderr, "kernel_launch: hipFuncSetAttribute failed\n"); grid = -1; return; }
        if (hipOccupancyMaxActiveBlocksPerMultiprocessor(&per_cu, (const void*)mega_fwd, NTHREADS, LDS_BYTES) != hipSuccess || per_cu < 1) { fprintf(stderr, "kernel_launch: occupancy query says %d blocks/CU\n", per_cu); (void)hipGetLastError(); grid = -1; return; }
        grid = cus;
        fprintf(stderr, "kernel_launch: grid %d (cus %d, occupancy %d/CU)\n", grid, cus, per_cu);
    }
    if (grid < 0) return;
    Params p{};
    const float** f = (const float**)&p;
    for (int i = 0; i < 22; ++i) f[i] = (const float*)d_in[i];
    p.out = (float*)d_out; p.ws = (unsigned char*)d_ws;
    (void)hipMemsetAsync((char*)d_ws + WS_CTL, 0, CTL_ZERO_BYTES, stream);
    hipLaunchKernelGGL(mega_fwd, dim3(grid), dim3(NTHREADS), LDS_BYTES, stream, p);
}
```

```cpp
#include <hip/hip_runtime.h>
#include <cstdio>
#include <cstdint>
#include <cmath>
namespace pg8 {
#define PG8_LAS __attribute__((address_space(3)))
typedef unsigned short bf16_t;
typedef short bf16x8 __attribute__((ext_vector_type(8)));
typedef float f32x4 __attribute__((ext_vector_type(4)));
typedef unsigned u32x4 __attribute__((ext_vector_type(4)));
constexpr int BM = 256, BK = 64, HALF = 128, HTB = HALF * BK * 2  , STAGE_BYTES = 8 * HTB, NXCD = 8, WGM = 8;

__host__ __device__ __forceinline__ int lds_byte(int r, int c) { const int st = (r >> 4) * 2 + (c >> 5), rr = r & 15, cc = c & 31, ob = rr * 64 + cc * 2; return st * 1024 + (ob ^ (((ob >> 9) & 1) << 5)); }
__host__ __device__ __forceinline__ void stage_rc(int b, int& R, int& C) { const int st = b / 1024, sb = b % 1024, swz = sb ^ (((sb >> 9) & 1) << 5); R = (st >> 1) * 16 + swz / 64; C = (st & 1) * 32 + (swz % 64) / 2; }
__host__ __device__ __forceinline__ int perm32(int rho) { const int n = rho >> 4, i = rho & 15; return 8 * (i >> 2) + 4 * n + (i & 3); }

struct Unit { int pm, pn; };
struct Gemm { const bf16_t* A; const bf16_t* Bt; int M, N, K; };

struct StaticOrder {
    int nM, nN, nwg, G, c;
    __host__ __device__ void init(int M, int N, int G_, int c_) { nM = M / BM; nN = N / BM; nwg = nM * nN; G = G_; c = c_; }
    __host__ __device__ bool next(int i, Unit& u) const {
        const long L = (long)i * G + c; if (L >= nwg) return false;
        int wgid = (int)L; { const int q = nwg / NXCD, r = nwg % NXCD, xcd = wgid % NXCD, off = wgid / NXCD; wgid = (xcd < r ? xcd * (q + 1) : r * (q + 1) + (xcd - r) * q) + off; }
        const int nig = WGM * nN, gid = wgid / nig, fm = gid * WGM, gsz = (nM - fm) < WGM ? (nM - fm) : WGM;
        u.pm = fm + ((wgid % nig) % gsz); u.pn = (wgid % nig) / gsz; return true;
    }
    __device__ __forceinline__ void a_ready(const Unit&) const {}
    __device__ __forceinline__ void done(const Unit&) const {}
};

template <class Epi, class Sched, bool ALIGN_EPI = false, bool SP2 = false>
__device__ __forceinline__ void gemm_phase(PG8_LAS unsigned char* lds, const Gemm g, const Sched& S, const Epi& E) {
    const int tid = threadIdx.x, wid = __builtin_amdgcn_readfirstlane(tid >> 6), lane = tid & 63, wr = wid >> 2, wc = wid & 3, fr = lane & 15, fq = lane >> 4;
    const int K = g.K, nt = K / BK;
    unsigned voffA[2], voffB[2];
#pragma unroll
    for (int i = 0; i < 2; ++i) { int R, C; stage_rc(tid * 16 + i * 8192, R, C); const int Rb = Epi::PERM ? ((R & ~31) + perm32(R & 31)) : R;
        voffA[i] = (unsigned)(R * K + C) * 2u; voffB[i] = (unsigned)(Rb * K + C) * 2u; }
    const size_t kstep = (size_t)(BK * 2);
    const size_t hstep = (size_t)HALF * K * 2;
    const size_t tstep = 2 * hstep;
    const unsigned ldsw = (unsigned)wid * 1024u;
    const int aoff = lds_byte(wr * 64 + fr, fq * 8), boff = lds_byte(wc * 32 + fr, fq * 8);
#define PG8_SA(b, h) (((b) * 2 + (h)) * HTB)
#define PG8_SB(b, h) ((4 + (b) * 2 + (h)) * HTB)
#define PG8_STAGE(bufoff, gbase, voff) do { _Pragma("unroll") for (int _i = 0; _i < 2; ++_i) \
        __builtin_amdgcn_global_load_lds((const unsigned*)((const char*)(gbase) + (voff)[_i]), (PG8_LAS unsigned*)(lds + (bufoff) + ldsw + _i * 8192), 16, 0, 0); } while (0)
#define PG8_LDA(dst, b, h) do { _Pragma("unroll") for (int m = 0; m < 4; ++m) _Pragma("unroll") for (int k = 0; k < 2; ++k) dst[m][k] = *(const PG8_LAS bf16x8*)(lds + PG8_SA(b, h) + aoff + m * 2048 + k * 1024); } while (0)
#define PG8_LDB(dst, b, h) do { _Pragma("unroll") for (int n = 0; n < 2; ++n) _Pragma("unroll") for (int k = 0; k < 2; ++k) dst[n][k] = *(const PG8_LAS bf16x8*)(lds + PG8_SB(b, h) + boff + n * 2048 + k * 1024); } while (0)
#define PG8_MMA(ai, bj, At, Bt) do { __builtin_amdgcn_s_setprio(1); _Pragma("unroll") for (int m = 0; m < 4; ++m) _Pragma("unroll") for (int n = 0; n < 2; ++n) _Pragma("unroll") for (int k = 0; k < 2; ++k) \
        acc[ai][bj][m][n] = __builtin_amdgcn_mfma_f32_16x16x32_bf16(Bt[n][k], At[m][k], acc[ai][bj][m][n], 0, 0, 0); __builtin_amdgcn_s_setprio(0); } while (0)
#define PG8_WAIT_V(n) asm volatile("s_waitcnt vmcnt(" #n ")" ::: "memory")
#define PG8_WAIT_L(n) asm volatile("s_waitcnt lgkmcnt(" #n ")" ::: "memory")
#define PG8_BAR __builtin_amdgcn_s_barrier()
#define PG8_SCHED __builtin_amdgcn_sched_barrier(0)
    Unit cur, nxt; int ui = 0;
    if (!S.next(0, cur)) return;
    f32x4 acc[2][2][4][2];
#pragma unroll
    for (int a = 0; a < 2; ++a)
#pragma unroll
        for (int b = 0; b < 2; ++b)
#pragma unroll
            for (int m = 0; m < 4; ++m)
#pragma unroll
                for (int n = 0; n < 2; ++n) acc[a][b][m][n] = (f32x4){0.f, 0.f, 0.f, 0.f};
    bf16x8 At[4][2], B0[2][2], B1[2][2];
    const char* cA = (const char*)g.A + (size_t)cur.pm * tstep; const char* cB = (const char*)g.Bt + (size_t)cur.pn * tstep;
    S.a_ready(cur);
    if constexpr (SP2) {
        PG8_STAGE(PG8_SB(0, 0), cB, voffB); PG8_STAGE(PG8_SB(0, 1), cB + hstep, voffB); PG8_STAGE(PG8_SA(0, 0), cA, voffA); PG8_STAGE(PG8_SA(0, 1), cA + hstep, voffA);
        if (wr == 1) PG8_BAR;
        PG8_WAIT_V(2); PG8_BAR;
        PG8_STAGE(PG8_SB(1, 0), cB + kstep, voffB); PG8_STAGE(PG8_SA(1, 0), cA + kstep, voffA); PG8_STAGE(PG8_SB(1, 1), cB + hstep + kstep, voffB);
        PG8_WAIT_V(6); PG8_BAR;
    } else {
        PG8_STAGE(PG8_SB(0, 0), cB, voffB); PG8_STAGE(PG8_SA(0, 0), cA, voffA); PG8_STAGE(PG8_SB(0, 1), cB + hstep, voffB); PG8_STAGE(PG8_SA(0, 1), cA + hstep, voffA);
        if (wr == 1) PG8_BAR;
        PG8_WAIT_V(4); PG8_BAR;
        PG8_STAGE(PG8_SB(1, 0), cB + kstep, voffB); PG8_STAGE(PG8_SA(1, 0), cA + kstep, voffA); PG8_STAGE(PG8_SB(1, 1), cB + hstep + kstep, voffB);
        PG8_WAIT_V(6); PG8_BAR;
    }
    for (;;) {
        const bool has_next = S.next(ui + 1, nxt);
        const char* nA = has_next ? (const char*)g.A + (size_t)nxt.pm * tstep : cA; const char* nB = has_next ? (const char*)g.Bt + (size_t)nxt.pn * tstep : cB;
        for (int t = 0; t < nt; t += 2) {
            const bool last = (t == nt - 2);
            const char* a1 = cA + (size_t)(t + 1) * kstep;
            const char* a2 = last ? nA : cA + (size_t)(t + 2) * kstep; const char* b2 = last ? nB : cB + (size_t)(t + 2) * kstep;
            const char* a3 = a2 + kstep; const char* b3 = b2 + kstep;
            if (last && has_next) S.a_ready(nxt);
            if constexpr (SP2) {
            PG8_LDB(B0, 0, 0); PG8_LDB(B1, 0, 1); PG8_SCHED; PG8_LDA(At, 0, 0); PG8_STAGE(PG8_SA(1, 1), a1 + hstep, voffA);
            PG8_WAIT_V(8); PG8_WAIT_L(0); PG8_BAR; PG8_MMA(0, 0, At, B0); PG8_MMA(0, 1, At, B1); PG8_BAR; PG8_SCHED;
            PG8_LDA(At, 0, 1); PG8_STAGE(PG8_SB(0, 0), b2, voffB); PG8_STAGE(PG8_SB(0, 1), b2 + hstep, voffB); PG8_STAGE(PG8_SA(0, 0), a2, voffA);
            PG8_WAIT_V(8); PG8_WAIT_L(0); PG8_BAR; PG8_MMA(1, 0, At, B0); PG8_MMA(1, 1, At, B1); PG8_BAR; PG8_SCHED;
            PG8_LDB(B0, 1, 0); PG8_LDB(B1, 1, 1); PG8_SCHED; PG8_LDA(At, 1, 0); PG8_STAGE(PG8_SA(0, 1), a2 + hstep, voffA);
            PG8_WAIT_V(8); PG8_WAIT_L(0); PG8_BAR; PG8_MMA(0, 0, At, B0); PG8_MMA(0, 1, At, B1); PG8_BAR; PG8_SCHED;
            PG8_LDA(At, 1, 1); PG8_STAGE(PG8_SB(1, 0), b3, voffB); PG8_STAGE(PG8_SB(1, 1), b3 + hstep, voffB); PG8_STAGE(PG8_SA(1, 0), a3, voffA);
            PG8_WAIT_V(8); PG8_WAIT_L(0); PG8_BAR; PG8_MMA(1, 0, At, B0); PG8_MMA(1, 1, At, B1); PG8_BAR; PG8_SCHED;
            } else {
            PG8_LDB(B0, 0, 0); PG8_SCHED; PG8_LDA(At, 0, 0); PG8_STAGE(PG8_SA(1, 1), a1 + hstep, voffA);
            PG8_WAIT_L(8); PG8_BAR; PG8_WAIT_L(0); PG8_MMA(0, 0, At, B0); PG8_BAR; PG8_SCHED;
            PG8_LDB(B1, 0, 1); PG8_STAGE(PG8_SB(0, 0), b2, voffB);
            PG8_BAR; PG8_WAIT_L(0); PG8_MMA(0, 1, At, B1); PG8_BAR;
            PG8_LDA(At, 0, 1); PG8_STAGE(PG8_SA(0, 0), a2, voffA);
            PG8_BAR; PG8_WAIT_L(0); PG8_MMA(1, 0, At, B0); PG8_BAR; PG8_SCHED;
            PG8_STAGE(PG8_SB(0, 1), b2 + hstep, voffB);
            PG8_WAIT_V(6); PG8_BAR; PG8_MMA(1, 1, At, B1); PG8_BAR;
            PG8_LDB(B0, 1, 0); PG8_SCHED; PG8_LDA(At, 1, 0); PG8_STAGE(PG8_SA(0, 1), a2 + hstep, voffA);
            PG8_WAIT_L(8); PG8_BAR; PG8_WAIT_L(0); PG8_MMA(0, 0, At, B0); PG8_BAR; PG8_SCHED;
            PG8_LDB(B1, 1, 1); PG8_STAGE(PG8_SB(1, 0), b3, voffB);
            PG8_BAR; PG8_WAIT_L(0); PG8_MMA(0, 1, At, B1); PG8_BAR;
            PG8_LDA(At, 1, 1); PG8_STAGE(PG8_SA(1, 0), a3, voffA);
            PG8_BAR; PG8_WAIT_L(0); PG8_MMA(1, 0, At, B0); PG8_BAR; PG8_SCHED;
            PG8_STAGE(PG8_SB(1, 1), b3 + hstep, voffB);
            PG8_WAIT_V(6); PG8_BAR; PG8_MMA(1, 1, At, B1); PG8_BAR;
            }
        }
        if constexpr (ALIGN_EPI) { if (wr == 0) PG8_BAR; }
        if constexpr (!Epi::AFTER_DRAIN) { E(acc, cur, wr, wc, fr, fq); S.done(cur); }
        if (!has_next) break;
#pragma unroll
        for (int a = 0; a < 2; ++a)
#pragma unroll
            for (int b = 0; b < 2; ++b)
#pragma unroll
                for (int m = 0; m < 4; ++m)
#pragma unroll
                    for (int n = 0; n < 2; ++n) acc[a][b][m][n] = (f32x4){0.f, 0.f, 0.f, 0.f};
        cur = nxt; cA = nA; cB = nB; ++ui;
        if constexpr (ALIGN_EPI) { if (wr == 1) PG8_BAR; }
    }
    PG8_WAIT_V(0);
    if constexpr (!ALIGN_EPI) { if (wr == 0) PG8_BAR; }
    PG8_BAR;
    if constexpr (Epi::AFTER_DRAIN) { E.fused(acc, cur, wr, wc, fr, fq, lds, wid, lane); S.done(cur); }
#undef PG8_SA
#undef PG8_SB
#undef PG8_STAGE
#undef PG8_LDA
#undef PG8_LDB
#undef PG8_MMA
#undef PG8_WAIT_V
#undef PG8_WAIT_L
#undef PG8_BAR
#undef PG8_SCHED
}
}

constexpr int D_MODEL = 2048, BATCH = 4, SEQ = 2048, CTX = 256, GRID_W = 64, NHEAD = 8, HD = 128, WA = 1024;
constexpr int FFN = 5632, IN_COLS = 12288, NMOD = 6;
constexpr int ML = BATCH * SEQ;
constexpr int MC = BATCH * CTX;
constexpr int MT = ML + MC;
constexpr float EPS = 1e-6f;
constexpr int NTHREADS = 512;
constexpr int VT_PITCH = SEQ + CTX;

typedef unsigned short bf16;
typedef float f32x4 __attribute__((ext_vector_type(4)));
typedef unsigned u32x2 __attribute__((ext_vector_type(2)));
typedef unsigned u32x4 __attribute__((ext_vector_type(4)));
#define LAS __attribute__((address_space(3)))

__device__ __forceinline__ unsigned f2bf(float f) { unsigned u = __builtin_bit_cast(unsigned, f); return (u + 0x7fffu + ((u >> 16) & 1u)) >> 16; }
__device__ __forceinline__ unsigned pk2(float lo, float hi) { return f2bf(lo) | (f2bf(hi) << 16); }
__device__ __forceinline__ float bf2f(unsigned short h) { return __builtin_bit_cast(float, (unsigned)h << 16); }
__device__ __forceinline__ float bflo(unsigned w) { return __builtin_bit_cast(float, w << 16); }
__device__ __forceinline__ float bfhi(unsigned w) { return __builtin_bit_cast(float, w & 0xffff0000u); }
__device__ __forceinline__ float sigmoidf_(float x) { return 1.0f / (1.0f + __expf(-x)); }
__device__ __forceinline__ float siluf_(float x) { return x / (1.0f + __expf(-x)); }
__device__ __forceinline__ float wave_sum(float v) {
#pragma unroll
    for (int o = 1; o < 64; o <<= 1) v += __shfl_xor(v, o);
    return v;
}
__device__ __forceinline__ float wave_max(float v) {
#pragma unroll
    for (int o = 1; o < 64; o <<= 1) v = fmaxf(v, __shfl_xor(v, o));
    return v;
}

constexpr size_t al256(size_t x) { return (x + 255) & ~(size_t)255; }
constexpr size_t WS_CTL   = 0;
constexpr size_t CTL_ZERO_BYTES = 1u << 20;
constexpr size_t WS_ROWSQ = 64 * 1024;
constexpr size_t WS_BIAS2 = WS_ROWSQ + (size_t)ML * 4;
static_assert(WS_BIAS2 + (size_t)4 * 2 * FFN * 4 <= CTL_ZERO_BYTES, "ctl");
constexpr size_t WS_MOD   = CTL_ZERO_BYTES;
constexpr size_t WS_LB    = al256(WS_MOD + (size_t)5 * IN_COLS * 4);
constexpr size_t WS_SMALL_END = al256(WS_LB + 2 * WA * 4);
constexpr size_t WS_W13T  = al256(WS_SMALL_END);
constexpr size_t WS_W2T   = WS_W13T + (size_t)2 * FFN * D_MODEL * 2;
constexpr size_t WS_WAT   = WS_W2T + (size_t)D_MODEL * FFN * 2;
constexpr size_t WS_WBT   = WS_WAT + (size_t)D_MODEL * WA * 2;
constexpr size_t WS_WOT   = WS_WBT + (size_t)D_MODEL * WA * 2;
constexpr size_t WS_A_END = WS_WOT + (size_t)D_MODEL * D_MODEL * 2;
constexpr size_t SEGB = (size_t)MT * WA * 2;
constexpr size_t WS_QA  = WS_A_END;
constexpr size_t WS_FW  = WS_QA + SEGB;
constexpr size_t WS_FB  = WS_FW + 2 * SEGB;
constexpr size_t WS_IA  = WS_FB + 2 * SEGB;
constexpr size_t WS_GA  = WS_IA + SEGB;
constexpr size_t WS_QN  = WS_GA + (size_t)ML * WA * 2;
constexpr size_t WS_KN  = WS_QN + (size_t)ML * WA * 2;
constexpr size_t WS_VN  = WS_KN + SEGB;
constexpr size_t WS_GTA = WS_VN + SEGB;
constexpr size_t WS_GTB = WS_GTA + (size_t)ML * D_MODEL * 2;
constexpr size_t WS_D_END = WS_GTB + (size_t)ML * D_MODEL * 2;
constexpr size_t WS_WINT = WS_D_END;
constexpr size_t WS_OF   = WS_WINT;
constexpr size_t WS_OB   = WS_OF + (size_t)ML * WA * 2;
constexpr size_t WS_B_END = WS_WINT + (size_t)IN_COLS * D_MODEL * 2;
static_assert(WS_OB + (size_t)ML * WA * 2 <= WS_B_END, "B");
constexpr size_t WS_H   = WS_B_END;
constexpr size_t WS_YA  = WS_H;
constexpr size_t WS_YB  = WS_YA + (size_t)ML * WA * 2;
constexpr size_t WS_C_END = WS_H + (size_t)MT * D_MODEL * 2;
constexpr size_t WS_ACT_END = WS_D_END + (size_t)ML * FFN * 2;
constexpr size_t WS_END = WS_C_END > WS_ACT_END ? WS_C_END : WS_ACT_END;
static_assert(WS_END <= 445000000, "ws budget");
constexpr size_t WS_Z   = WS_QA;
constexpr size_t WS_XMG = WS_GTB;
constexpr size_t WS_A13 = WS_QA;
static_assert(WS_A13 + (size_t)ML * 2 * FFN * 2 <= WS_XMG, "A13 overlay");
constexpr size_t WS_ACT = WS_WINT;
static_assert(WS_ACT + (size_t)ML * FFN * 2 <= WS_END, "ACT overlay");

struct Params {
    const float *x, *c, *ctx, *c_ctx, *ada_w, *ada_b, *norm1_g, *norm2_g, *w_in, *lb_logits, *hgrn_norm_g, *q_norm_g, *k_norm_g, *rel_bias,
                *w_a, *w_b, *w_o, *w1, *w3, *conv_w, *conv_b, *w2;
    float* out;
    unsigned char* ws;
};

__device__ __forceinline__ void transpose_item(const float* W, int K, int N, bf16* WT, int row_off, LAS float* scr, int item, int lane) {
    const int nblk = N / 32, kb = item / nblk, nb = item % nblk, k0 = 64 * kb, n0 = 32 * nb;
#pragma unroll 8
    for (int i = 0; i < 32; ++i) { const int kk = 2 * i + (lane >> 5); scr[kk * 33 + (lane & 31)] = W[(size_t)(k0 + kk) * N + n0 + (lane & 31)]; }
    asm volatile("s_waitcnt lgkmcnt(0)" ::: "memory");
    const int c = lane & 7;
#pragma unroll
    for (int j = 0; j < 4; ++j) { const int n = (lane >> 3) + 8 * j; const LAS float* s = scr + (8 * c) * 33 + n;
        u32x4 o; o.x = pk2(s[0 * 33], s[1 * 33]); o.y = pk2(s[2 * 33], s[3 * 33]); o.z = pk2(s[4 * 33], s[5 * 33]); o.w = pk2(s[6 * 33], s[7 * 33]);
        *(u32x4*)(WT + (size_t)(row_off + n0 + n) * K + k0 + 8 * c) = o; }
    asm volatile("s_waitcnt lgkmcnt(0)" ::: "memory");
}
__device__ __forceinline__ void phase_wconv(const Params& p, LAS unsigned char* lds, int vb, int nb) {
    const int tid = threadIdx.x, lane = tid & 63, wave = tid >> 6;
    LAS float* scr = (LAS float*)(lds + wave * 16384);
    const int gw = vb * 8 + wave, NGW = nb * 8;
    constexpr int I_IN = (D_MODEL / 64) * (IN_COLS / 32), I_A = (WA / 64) * (D_MODEL / 32), I_O = (D_MODEL / 64) * (D_MODEL / 32),
                  I_1 = (D_MODEL / 64) * (FFN / 32), I_2 = (FFN / 64) * (D_MODEL / 32);
    constexpr int NITEMS = I_IN + 2 * I_A + I_O + 2 * I_1 + I_2;
    unsigned char* ws = p.ws;
    for (int it = gw; it < NITEMS; it += NGW) {
        int r = it;
        if (r < I_IN) { transpose_item(p.w_in, D_MODEL, IN_COLS, (bf16*)(ws + WS_WINT), 0, scr, r, lane); continue; } r -= I_IN;
        if (r < I_A) { transpose_item(p.w_a, WA, D_MODEL, (bf16*)(ws + WS_WAT), 0, scr, r, lane); continue; } r -= I_A;
        if (r < I_A) { transpose_item(p.w_b, WA, D_MODEL, (bf16*)(ws + WS_WBT), 0, scr, r, lane); continue; } r -= I_A;
        if (r < I_O) { transpose_item(p.w_o, D_MODEL, D_MODEL, (bf16*)(ws + WS_WOT), 0, scr, r, lane); continue; } r -= I_O;
        if (r < I_1) { transpose_item(p.w1, D_MODEL, FFN, (bf16*)(ws + WS_W13T), 0, scr, r, lane); continue; } r -= I_1;
        if (r < I_1) { transpose_item(p.w3, D_MODEL, FFN, (bf16*)(ws + WS_W13T), FFN, scr, r, lane); continue; } r -= I_1;
        transpose_item(p.w2, FFN, D_MODEL, (bf16*)(ws + WS_W2T), 0, scr, r, lane);
    }
}

__device__ __forceinline__ void phase_mod(const Params& p, LAS unsigned char* lds, int vb, int nb) {
    const int tid = threadIdx.x;
    LAS float* sc = (LAS float*)lds;
    LAS float* red = (LAS float*)(lds + 5 * 2048 * 4);
    for (int i = tid; i < 5 * D_MODEL; i += NTHREADS) { const int r = i / D_MODEL, k = i % D_MODEL; const float v = (r < 4) ? p.c[r * D_MODEL + k] : p.c_ctx[k]; sc[i] = siluf_(v); }
    __syncthreads();
    float* mod = (float*)(p.ws + WS_MOD);
    const int c4 = tid & 15, kp = tid >> 4;
    for (int item = vb; item < IN_COLS / 64; item += nb) {
        const int n0 = item * 64 + c4 * 4;
        f32x4 acc[5];
#pragma unroll
        for (int r = 0; r < 5; ++r) acc[r] = (f32x4){0.f, 0.f, 0.f, 0.f};
#pragma unroll 4
        for (int k = kp; k < D_MODEL; k += 32) {
            const f32x4 w = *(const f32x4*)(p.ada_w + (size_t)k * IN_COLS + n0);
#pragma unroll
            for (int r = 0; r < 5; ++r) acc[r] += w * sc[r * D_MODEL + k];
        }
#pragma unroll
        for (int r = 0; r < 5; ++r) *(LAS f32x4*)(red + (kp * 5 + r) * 64 + c4 * 4) = acc[r];
        __syncthreads();
        if (tid < 320) { const int r = tid / 64, cidx = tid % 64; float s = 0.f;
            for (int q = 0; q < 32; ++q) s += red[(q * 5 + r) * 64 + cidx];
            mod[r * IN_COLS + item * 64 + cidx] = s + p.ada_b[item * 64 + cidx]; }
        __syncthreads();
    }
    if (vb == 0) { float* lb = (float*)(p.ws + WS_LB);
        for (int i = tid; i < 2 * WA; i += NTHREADS) { const int d = i / WA, cc = i % WA; const float l0 = p.lb_logits[d * 2 * WA + cc], l1 = p.lb_logits[d * 2 * WA + WA + cc]; lb[i] = 1.0f / (1.0f + expf(l1 - l0)); } }
}

__device__ __forceinline__ void phase_h(const Params& p, int vb, int nb) {
    const int tid = threadIdx.x, lane = tid & 63, wave = tid >> 6;
    const float* mod = (const float*)(p.ws + WS_MOD);
    bf16* H = (bf16*)(p.ws + WS_H);
    for (int m = vb * 8 + wave; m < MT; m += nb * 8) {
        const float* xr = (m < ML) ? p.x + (size_t)m * D_MODEL : p.ctx + (size_t)(m - ML) * D_MODEL;
        const int mr = (m < ML) ? (m / SEQ) : 4;
        const float* sh = mod + (size_t)mr * IN_COLS, *scl = sh + D_MODEL;
        f32x4 v[8]; float s = 0.f;
#pragma unroll
        for (int j = 0; j < 8; ++j) { v[j] = *(const f32x4*)(xr + 4 * lane + 256 * j); s += (v[j].x * v[j].x + v[j].y * v[j].y) + (v[j].z * v[j].z + v[j].w * v[j].w); }
        const float rstd = 1.0f / sqrtf(wave_sum(s) * (1.0f / D_MODEL) + EPS);
#pragma unroll
        for (int j = 0; j < 8; ++j) { const int k = 4 * lane + 256 * j;
            const f32x4 g = *(const f32x4*)(p.norm1_g + k), a = *(const f32x4*)(scl + k), b = *(const f32x4*)(sh + k);
            const f32x4 h = v[j] * rstd * g * (a + 1.0f) + b;
            u32x2 o; o.x = pk2(h.x, h.y); o.y = pk2(h.z, h.w);
            *(u32x2*)(H + (size_t)m * D_MODEL + k) = o; }
    }
}

#define EPI_LOOP_BEGIN \
    _Pragma("unroll") for (int ai = 0; ai < 2; ++ai) _Pragma("unroll") for (int m = 0; m < 4; ++m) { const int row = u.pm * 256 + ai * 128 + wr * 64 + m * 16 + fr; \
    _Pragma("unroll") for (int bj = 0; bj < 2; ++bj) _Pragma("unroll") for (int n = 0; n < 2; ++n) { const int col = u.pn * 256 + bj * 128 + wc * 32 + n * 16 + fq * 4; const f32x4 v = acc[ai][bj][m][n];
#define EPI_LOOP_END } }

struct EpiInProj {
    static constexpr bool PERM = false, AFTER_DRAIN = false;
    unsigned char* ws;
    __device__ __forceinline__ void operator()(const f32x4 (&acc)[2][2][4][2], const pg8::Unit& u, int wr, int wc, int fr, int fq) const {
        const int seg = u.pn >> 2;
        const bool ctxrow = u.pm >= ML / 256;
        const float* lb = (const float*)(ws + WS_LB);
        if (seg == 1 || seg == 2) {
            float* F = (float*)(ws + (seg == 1 ? WS_FW : WS_FB)); const float* lbd = lb + (seg - 1) * WA;
            EPI_LOOP_BEGIN
                const int c = col - seg * WA; const f32x4 l = *(const f32x4*)(lbd + c); f32x4 o;
                o.x = logf(l.x + (1.0f - l.x) * sigmoidf_(v.x)); o.y = logf(l.y + (1.0f - l.y) * sigmoidf_(v.y));
                o.z = logf(l.z + (1.0f - l.z) * sigmoidf_(v.z)); o.w = logf(l.w + (1.0f - l.w) * sigmoidf_(v.w));
                *(f32x4*)(F + (size_t)row * WA + c) = o;
            EPI_LOOP_END
        } else if (seg == 7) {
            bf16* VT = (bf16*)(ws + WS_VN);
            EPI_LOOP_BEGIN
                const int c = col - 7 * WA; const int hh = c >> 7, d = c & 127;
                int bb, tok; if (row < ML) { bb = row / SEQ; tok = row % SEQ; } else { bb = (row - ML) / CTX; tok = SEQ + (row - ML) % CTX; }
                bf16* o = VT + ((size_t)(bb * NHEAD + hh) * HD + d) * VT_PITCH + tok;
                o[0] = (bf16)f2bf(v.x); o[VT_PITCH] = (bf16)f2bf(v.y); o[2 * VT_PITCH] = (bf16)f2bf(v.z); o[3 * VT_PITCH] = (bf16)f2bf(v.w);
            EPI_LOOP_END
        } else if (seg == 0 || seg == 3 || seg == 6) {
            if (ctxrow && seg == 0) return;
            bf16* O = (bf16*)(ws + (seg == 0 ? WS_QA : seg == 3 ? WS_IA : WS_KN));
            EPI_LOOP_BEGIN
                const int c = col - seg * WA; u32x2 o; o.x = pk2(v.x, v.y); o.y = pk2(v.z, v.w);
                *(u32x2*)(O + (size_t)row * WA + c) = o;
            EPI_LOOP_END
        } else if (seg == 4) {
            if (ctxrow) return;
            bf16* O = (bf16*)(ws + WS_GA);
            EPI_LOOP_BEGIN
                const int c = col - seg * WA; u32x2 o; o.x = pk2(siluf_(v.x), siluf_(v.y)); o.y = pk2(siluf_(v.z), siluf_(v.w));
                *(u32x2*)(O + (size_t)row * WA + c) = o;
            EPI_LOOP_END
        } else if (seg == 5) {
            if (ctxrow) return;
            bf16* O = (bf16*)(ws + WS_QN);
            EPI_LOOP_BEGIN
                const int c = col - seg * WA; u32x2 o; o.x = pk2(v.x, v.y); o.y = pk2(v.z, v.w);
                *(u32x2*)(O + (size_t)row * WA + c) = o;
            EPI_LOOP_END
        } else {
            if (ctxrow) return;
            const bool isa = seg < 10;
            bf16* O = (bf16*)(ws + (isa ? WS_GTA : WS_GTB)); const int cbase = isa ? 8 * WA : 10 * WA;
            EPI_LOOP_BEGIN
                const int c = col - cbase; u32x2 o; o.x = pk2(sigmoidf_(v.x), sigmoidf_(v.y)); o.y = pk2(sigmoidf_(v.z), sigmoidf_(v.w));
                *(u32x2*)(O + (size_t)row * D_MODEL + c) = o;
            EPI_LOOP_END
        }
    }
};

struct EpiMergeA {
    static constexpr bool PERM = false, AFTER_DRAIN = false;
    unsigned char* ws; float* tmp;
    __device__ __forceinline__ void operator()(const f32x4 (&acc)[2][2][4][2], const pg8::Unit& u, int wr, int wc, int fr, int fq) const {
        const bf16* G = (const bf16*)(ws + WS_GTA);
        EPI_LOOP_BEGIN
            const u32x2 g = *(const u32x2*)(G + (size_t)row * D_MODEL + col);
            f32x4 o; o.x = bflo(g.x) * v.x; o.y = bfhi(g.x) * v.y; o.z = bflo(g.y) * v.z; o.w = bfhi(g.y) * v.w;
            *(f32x4*)(tmp + (size_t)row * D_MODEL + col) = o;
        EPI_LOOP_END
    }
};
struct EpiMergeB {
    static constexpr bool PERM = false, AFTER_DRAIN = false;
    unsigned char* ws; const float* tmp;
    __device__ __forceinline__ void operator()(const f32x4 (&acc)[2][2][4][2], const pg8::Unit& u, int wr, int wc, int fr, int fq) const {
        const bf16* G = (const bf16*)(ws + WS_GTB); bf16* Z = (bf16*)(ws + WS_Z);
        EPI_LOOP_BEGIN
            const u32x2 g = *(const u32x2*)(G + (size_t)row * D_MODEL + col);
            const f32x4 t = *(const f32x4*)(tmp + (size_t)row * D_MODEL + col);
            u32x2 o; o.x = pk2(t.x + bflo(g.x) * v.x, t.y + bfhi(g.x) * v.y); o.y = pk2(t.z + bflo(g.y) * v.z, t.w + bfhi(g.y) * v.w);
            *(u32x2*)(Z + (size_t)row * D_MODEL + col) = o;
        EPI_LOOP_END
    }
};
struct EpiOutProj {
    static constexpr bool PERM = false, AFTER_DRAIN = false;
    unsigned char* ws; const float* x; const float* norm2_g; float* out;
    __device__ __forceinline__ void operator()(const f32x4 (&acc)[2][2][4][2], const pg8::Unit& u, int wr, int wc, int fr, int fq) const {
        const float* mod = (const float*)(ws + WS_MOD); bf16* XMG = (bf16*)(ws + WS_XMG); float* rowsq = (float*)(ws + WS_ROWSQ);
        const int b = (u.pm * 256) / SEQ;
        const float* g1 = mod + (size_t)b * IN_COLS + 2 * D_MODEL, *sc2 = mod + (size_t)b * IN_COLS + 4 * D_MODEL;
#pragma unroll
        for (int ai = 0; ai < 2; ++ai)
#pragma unroll
            for (int m = 0; m < 4; ++m) { const int row = u.pm * 256 + ai * 128 + wr * 64 + m * 16 + fr; float ss = 0.f;
#pragma unroll
                for (int bj = 0; bj < 2; ++bj)
#pragma unroll
                    for (int n = 0; n < 2; ++n) { const int col = u.pn * 256 + bj * 128 + wc * 32 + n * 16 + fq * 4; const f32x4 v = acc[ai][bj][m][n];
                        const f32x4 xv = *(const f32x4*)(x + (size_t)row * D_MODEL + col), g = *(const f32x4*)(g1 + col);
                        const f32x4 xm = xv + g * v;
                        *(f32x4*)(out + (size_t)row * D_MODEL + col) = xm;
                        ss += (xm.x * xm.x + xm.y * xm.y) + (xm.z * xm.z + xm.w * xm.w);
                        const f32x4 ng = *(const f32x4*)(norm2_g + col), s2 = *(const f32x4*)(sc2 + col);
                        const f32x4 h = xm * ng * (s2 + 1.0f);
                        u32x2 o; o.x = pk2(h.x, h.y); o.y = pk2(h.z, h.w);
                        *(u32x2*)(XMG + (size_t)row * D_MODEL + col) = o; }
                ss += __shfl_xor(ss, 16); ss += __shfl_xor(ss, 32);
                if (fq == 0) atomicAdd(rowsq + row, ss); }
    }
};
struct EpiFfnUp {
    static constexpr bool PERM = false, AFTER_DRAIN = false;
    unsigned char* ws;
    __device__ __forceinline__ void operator()(const f32x4 (&acc)[2][2][4][2], const pg8::Unit& u, int wr, int wc, int fr, int fq) const {
        const float* rowsq = (const float*)(ws + WS_ROWSQ); bf16* A13 = (bf16*)(ws + WS_A13);
        const int b = (u.pm * 256) / SEQ; const float* bias2 = (const float*)(ws + WS_BIAS2) + (size_t)b * 2 * FFN;
#pragma unroll
        for (int ai = 0; ai < 2; ++ai)
#pragma unroll
            for (int m = 0; m < 4; ++m) { const int row = u.pm * 256 + ai * 128 + wr * 64 + m * 16 + fr;
                const float rstd = 1.0f / sqrtf(__builtin_nontemporal_load(rowsq + row) * (1.0f / D_MODEL) + EPS);
#pragma unroll
                for (int bj = 0; bj < 2; ++bj)
#pragma unroll
                    for (int n = 0; n < 2; ++n) { const int col = u.pn * 256 + bj * 128 + wc * 32 + n * 16 + fq * 4; const f32x4 v = acc[ai][bj][m][n];
                        const f32x4 bb = *(const f32x4*)(bias2 + col); const f32x4 r = v * rstd + bb;
                        u32x2 o; o.x = pk2(r.x, r.y); o.y = pk2(r.z, r.w);
                        *(u32x2*)(A13 + (size_t)row * (2 * FFN) + col) = o; } }
    }
};
struct EpiFfnDown {
    static constexpr bool PERM = false, AFTER_DRAIN = false;
    unsigned char* ws; float* out;
    __device__ __forceinline__ void operator()(const f32x4 (&acc)[2][2][4][2], const pg8::Unit& u, int wr, int wc, int fr, int fq) const {
        const float* mod = (const float*)(ws + WS_MOD); const int b = (u.pm * 256) / SEQ; const float* g2 = mod + (size_t)b * IN_COLS + 5 * D_MODEL;
        EPI_LOOP_BEGIN
            float* o = out + (size_t)row * D_MODEL + col; const f32x4 xm = *(const f32x4*)o, g = *(const f32x4*)(g2 + col);
            *(f32x4*)o = xm + g * v;
        EPI_LOOP_END
    }
};

__device__ __forceinline__ void phase_qkrope(const Params& p, int vb, int nb) {
    const int tid = threadIdx.x, lane = tid & 63, wave = tid >> 6;
    bf16* QN = (bf16*)(p.ws + WS_QN); bf16* KN = (bf16*)(p.ws + WS_KN);
    const int j = lane & 31;
    const float inv = exp2f(-(float)j * (13.287712379549449f / 32.0f));
    const int NI = (ML + MT) * NHEAD;
    for (int it = vb * 8 + wave; it < NI; it += nb * 8) {
        const bool isq = it < ML * NHEAD; const int r = isq ? it : it - ML * NHEAD; const int row = r / NHEAD, h = r % NHEAD;
        bf16* ptr = (isq ? QN : KN) + (size_t)row * WA + h * HD; const float* g = isq ? p.q_norm_g : p.k_norm_g;
        float a = bf2f(ptr[lane]), b = bf2f(ptr[64 + lane]);
        const float rstd = 1.0f / sqrtf(wave_sum(a * a + b * b) * (1.0f / HD) + EPS);
        a = a * rstd * g[lane]; b = b * rstd * g[64 + lane];
        if (row < ML) {
            const int pos = row % SEQ; const float prow = (float)(pos / GRID_W), pcol = (float)(pos % GRID_W);
            float sa, ca, sb, cb; sincosf(prow * inv, &sa, &ca); sincosf(pcol * inv, &sb, &cb);
            const float ao = __shfl_xor(a, 32), bo = __shfl_xor(b, 32);
            a = (lane < 32) ? (a * ca - ao * sa) : (ao * sa + a * ca);
            b = (lane < 32) ? (b * cb - bo * sb) : (bo * sb + b * cb);
        }
        ptr[lane] = (bf16)f2bf(a); ptr[64 + lane] = (bf16)f2bf(b);
    }
}

#define XB_TMO      128
#define XB_XCNT(j)  (256  + 64 * (j))
#define XB_XSUB(j)  (1280 + 64 * (j))
#define XB_XGEN(j)  (2304 + 64 * (j))
#define XB_TOP      3328
#define XB_TOPGEN   3392
#define XCD_BAR_WORDS 3456
#define XB_SPIN_CAP (1u << 18)

__device__ __forceinline__ unsigned xb_ld(unsigned* p)              { return __hip_atomic_load(p, __ATOMIC_RELAXED, __HIP_MEMORY_SCOPE_AGENT); }
__device__ __forceinline__ unsigned xb_add(unsigned* p, unsigned v) { return __hip_atomic_fetch_add(p, v, __ATOMIC_RELAXED, __HIP_MEMORY_SCOPE_AGENT); }
__device__ __forceinline__ unsigned xb_xcc_id() { return (unsigned)__builtin_amdgcn_s_getreg((3 << 11) | 20) & 0xFu; }
#define XB_SPIN(cond, bar) do { unsigned _sp = 0; while (cond) { __builtin_amdgcn_s_sleep(1); \
    if ((++_sp & 255u) == 0u) { if (xb_ld(&(bar)[XB_TMO])) break; if (_sp > XB_SPIN_CAP) { atomicAdd(&(bar)[XB_TMO], 1u); break; } } } } while (0)

struct XcdBarrier {
    unsigned* bar; unsigned x;
    volatile LAS unsigned* st;
};

__device__ __forceinline__ XcdBarrier xcd_barrier_post(unsigned* bar, volatile LAS unsigned* st) {
    XcdBarrier b; b.bar = bar; b.x = xb_xcc_id(); b.st = st;
    if (threadIdx.x == 0) (void)xb_add(&bar[XB_XCNT(b.x)], 1u);
    return b;
}
__device__ __forceinline__ void xcd_barrier_complete(unsigned* bar, unsigned x, unsigned& nloc, unsigned& nx) {
    const unsigned G = gridDim.x * gridDim.y * gridDim.z;
    unsigned sum, cnt, mine, sp = 0u;
    for (;;) {
        sum = 0u; cnt = 0u; mine = 0u;
#pragma unroll
        for (unsigned j = 0; j < 16; ++j) { const unsigned c = xb_ld(&bar[XB_XCNT(j)]); sum += c; cnt += (c > 0u) ? 1u : 0u; mine = (j == x) ? c : mine; }
        if (sum == G) break;
        __builtin_amdgcn_s_sleep(1);
        if ((++sp & 255u) == 0u) { if (xb_ld(&bar[XB_TMO])) break; if (sp > XB_SPIN_CAP) { atomicAdd(&bar[XB_TMO], 1u); break; } }
    }
    nloc = mine > 0u ? mine : 1u; nx = cnt > 0u ? cnt : 1u;
}

__device__ __forceinline__ void xcd_barrier(const XcdBarrier& b) {
    asm volatile("s_waitcnt vmcnt(0)" ::: "memory");
    __syncthreads();
    if (threadIdx.x == 0) {
        unsigned* bar = b.bar;
        __builtin_amdgcn_s_waitcnt(0);
        unsigned nloc = b.st[0], nx = b.st[1];
        if (nloc == 0u) { xcd_barrier_complete(bar, b.x, nloc, nx); b.st[0] = nloc; b.st[1] = nx; }
        const unsigned old = xb_add(&bar[XB_XSUB(b.x)], 1u);
        const unsigned gen = old / nloc;
        if (old + 1u == (gen + 1u) * nloc) {
            __builtin_amdgcn_fence(__ATOMIC_RELEASE, "agent");
            asm volatile("s_waitcnt vmcnt(0)" ::: "memory");
            const unsigned og = xb_add(&bar[XB_TOP], 1u);
            const unsigned tg = og / nx;
            if (og + 1u == (tg + 1u) * nx) xb_add(&bar[XB_TOPGEN], 1u);
            else XB_SPIN(xb_ld(&bar[XB_TOPGEN]) == tg, bar);
            __builtin_amdgcn_fence(__ATOMIC_ACQUIRE, "agent");
            xb_add(&bar[XB_XGEN(b.x)], 1u);
            asm volatile("s_waitcnt vmcnt(0)" ::: "memory");
        } else {
            XB_SPIN(xb_ld(&bar[XB_XGEN(b.x)]) == gen, bar);
            __builtin_amdgcn_fence(__ATOMIC_ACQUIRE, "agent");
            asm volatile("s_waitcnt vmcnt(0)" ::: "memory");
        }
    }
    __syncthreads();
}

constexpr size_t WS_BAR = 8192;

typedef short bf16x8 __attribute__((ext_vector_type(8)));
typedef short s16x4 __attribute__((ext_vector_type(4)));

__device__ __forceinline__ bf16x8 pack_p(const f32x4 a, const f32x4 b) {
    u32x4 w; w.x = pk2(a.x, a.y); w.y = pk2(a.z, a.w); w.z = pk2(b.x, b.y); w.w = pk2(b.z, b.w);
    return __builtin_bit_cast(bf16x8, w);
}

__device__ __forceinline__ void attn_item(const Params& p, LAS float* btab, int item, int lane) {
    const bf16* QN = (const bf16*)(p.ws + WS_QN); const bf16* KN = (const bf16*)(p.ws + WS_KN); const bf16* VT = (const bf16*)(p.ws + WS_VN);
    bf16* YB = (bf16*)(p.ws + WS_YB);
    const int qb = item & 3, r = (item >> 2) & 31, h = (item >> 7) & 7, b = item >> 10;
    const int q = lane & 15, g = lane >> 4;
    const float scale = 0.08838834764831845f;
    for (int i = lane; i < 15 * 31; i += 64) btab[i] = p.rel_bias[h * 465 + i];
    const int rs = min(max(r - 4, 0), 24), ks0 = min(max(16 * qb - 8, 0), 32);
    const int cq = 16 * qb + q, cs = min(max(cq - 8, 0), 48);
    const size_t qrow = (size_t)b * SEQ + r * GRID_W + cq;
    bf16x8 qf[4];
#pragma unroll
    for (int ks = 0; ks < 4; ++ks) qf[ks] = *(const bf16x8*)(QN + qrow * WA + h * HD + 32 * ks + 8 * g);
    asm volatile("s_waitcnt lgkmcnt(0)" ::: "memory");
    f32x4 st[16];
    f32x4 ot[8];
#pragma unroll
    for (int db = 0; db < 8; ++db) ot[db] = (f32x4){0.f, 0.f, 0.f, 0.f};
#pragma unroll
    for (int kb = 0; kb < 16; ++kb) {
        const int kr = rs + (kb >> 1); const size_t tok = (size_t)b * SEQ + kr * GRID_W + ks0 + 16 * (kb & 1) + q;
        const bf16* kp = KN + tok * WA + h * HD + 8 * g;
        f32x4 a = (f32x4){0.f, 0.f, 0.f, 0.f};
#pragma unroll
        for (int ks = 0; ks < 4; ++ks) a = __builtin_amdgcn_mfma_f32_16x16x32_bf16(*(const bf16x8*)(kp + 32 * ks), qf[ks], a, 0, 0, 0);
        st[kb] = a;
    }
    float m1 = -1e30f;
#pragma unroll
    for (int kb = 0; kb < 16; ++kb) {
        const int kr = rs + (kb >> 1); const int dr = kr - r + 7;
#pragma unroll
        for (int j = 0; j < 4; ++j) { const int kcol = ks0 + 16 * (kb & 1) + 4 * g + j; const bool valid = (kcol >= cs) && (kcol < cs + 16);
            const int bi = valid ? (dr * 31 + (kcol - cq + 15)) : 0;
            const float s = valid ? (st[kb][j] * scale + btab[bi]) : -1e30f; st[kb][j] = s; m1 = fmaxf(m1, s); }
    }
    m1 = fmaxf(m1, __shfl_xor(m1, 16)); m1 = fmaxf(m1, __shfl_xor(m1, 32));
    float l = 0.f;
#pragma unroll
    for (int kb = 0; kb < 16; ++kb)
#pragma unroll
        for (int j = 0; j < 4; ++j) { const float s = st[kb][j]; const float e = (s > -1e29f) ? __expf(s - m1) : 0.f; st[kb][j] = e; l += e; }
    const bf16* vbase = VT + ((size_t)(b * NHEAD + h) * HD + q) * VT_PITCH + 4 * g;
#pragma unroll
    for (int kp = 0; kp < 8; ++kp) {
        const bf16x8 pb = pack_p(st[2 * kp], st[2 * kp + 1]);
        const int tokbase = (rs + kp) * GRID_W + ks0;
#pragma unroll
        for (int db = 0; db < 8; ++db) { const bf16* vp = vbase + (size_t)(16 * db) * VT_PITCH + tokbase;
            const u32x2 lo = *(const u32x2*)vp, hi = *(const u32x2*)(vp + 16);
            const u32x4 w = (u32x4){lo.x, lo.y, hi.x, hi.y};
            ot[db] = __builtin_amdgcn_mfma_f32_16x16x32_bf16(__builtin_bit_cast(bf16x8, w), pb, ot[db], 0, 0, 0); }
    }
#pragma unroll
    for (int kb = 0; kb < 16; ++kb) {
        const size_t tok = (size_t)ML + b * CTX + 16 * kb + q;
        const bf16* kp = KN + tok * WA + h * HD + 8 * g;
        f32x4 a = (f32x4){0.f, 0.f, 0.f, 0.f};
#pragma unroll
        for (int ks = 0; ks < 4; ++ks) a = __builtin_amdgcn_mfma_f32_16x16x32_bf16(*(const bf16x8*)(kp + 32 * ks), qf[ks], a, 0, 0, 0);
        st[kb] = a * scale;
    }
    float m2 = m1;
#pragma unroll
    for (int kb = 0; kb < 16; ++kb) m2 = fmaxf(fmaxf(m2, fmaxf(st[kb][0], st[kb][1])), fmaxf(st[kb][2], st[kb][3]));
    m2 = fmaxf(m2, __shfl_xor(m2, 16)); m2 = fmaxf(m2, __shfl_xor(m2, 32));
    const float alpha = __expf(m1 - m2);
    l *= alpha;
#pragma unroll
    for (int db = 0; db < 8; ++db) ot[db] = ot[db] * alpha;
#pragma unroll
    for (int kb = 0; kb < 16; ++kb)
#pragma unroll
        for (int j = 0; j < 4; ++j) { const float e = __expf(st[kb][j] - m2); st[kb][j] = e; l += e; }
#pragma unroll
    for (int kp = 0; kp < 8; ++kp) {
        const bf16x8 pb = pack_p(st[2 * kp], st[2 * kp + 1]);
        const int tokbase = SEQ + 32 * kp;
#pragma unroll
        for (int db = 0; db < 8; ++db) { const bf16* vp = vbase + (size_t)(16 * db) * VT_PITCH + tokbase;
            const u32x2 lo = *(const u32x2*)vp, hi = *(const u32x2*)(vp + 16);
            const u32x4 w = (u32x4){lo.x, lo.y, hi.x, hi.y};
            ot[db] = __builtin_amdgcn_mfma_f32_16x16x32_bf16(__builtin_bit_cast(bf16x8, w), pb, ot[db], 0, 0, 0); }
    }
    l += __shfl_xor(l, 16); l += __shfl_xor(l, 32);
    const float inv = 1.0f / l;
#pragma unroll
    for (int db = 0; db < 8; ++db) { const f32x4 o = ot[db] * inv; u32x2 w; w.x = pk2(o.x, o.y); w.y = pk2(o.z, o.w);
        *(u32x2*)(YB + qrow * WA + h * HD + 16 * db + 4 * g) = w; }
    asm volatile("s_waitcnt lgkmcnt(0)" ::: "memory");
}

constexpr size_t WS_ATTCTR = 32768;
static_assert(WS_ATTCTR >= WS_BAR + XCD_BAR_WORDS * 4 && WS_ATTCTR + 4 <= WS_ROWSQ, "attn counter inside ctl");
__device__ __forceinline__ void phase_attn(const Params& p, LAS unsigned char* lds) {
    const int lane = threadIdx.x & 63, wave = threadIdx.x >> 6;
    LAS float* btab = (LAS float*)(lds + wave * 2048);
    unsigned* ctr = (unsigned*)(p.ws + WS_ATTCTR);
    for (;;) {
        unsigned it = 0;
        if (lane == 0) it = atomicAdd(ctr, 1u);
        it = (unsigned)__builtin_amdgcn_readfirstlane((int)it);
        if (it >= (unsigned)(BATCH * NHEAD * 32 * 4)) break;
        attn_item(p, btab, (int)it, lane);
    }
}

constexpr int HP = 160;
constexpr int H_QH = 0, H_KH = 20480, H_KE = 40960, H_QD = 61440, H_KD = 81920;
constexpr int HP2 = 48;
constexpr int H_Q2 = 102400, H_K2 = 108544;
constexpr int VP = 288;
constexpr int H_V = 114688;
constexpr int PP = 144;
constexpr int H_P = 133120;
constexpr int H_T = 142336;
constexpr int H_D = 144384;
constexpr int H_END = 144896;

__device__ __forceinline__ s16x4 lds_tr(LAS const unsigned char* p) {
    return __builtin_bit_cast(s16x4, __builtin_amdgcn_ds_read_tr16_b64_v4i16((LAS s16x4*)p));
}
__device__ __forceinline__ bf16x8 cat8(const s16x4 a, const s16x4 b) { return __builtin_shufflevector(a, b, 0, 1, 2, 3, 4, 5, 6, 7); }
__device__ __forceinline__ bf16x8 cat8u(const u32x2 a, const u32x2 b) { const u32x4 w = (u32x4){a.x, a.y, b.x, b.y}; return __builtin_bit_cast(bf16x8, w); }

__device__ __forceinline__ size_t hg_row(int dir, int b, int tau) {
    if (tau < CTX) return (size_t)ML + b * CTX + (dir == 0 ? tau : CTX - 1 - tau);
    const int t = tau - CTX; return (size_t)b * SEQ + (dir == 0 ? t : SEQ - 1 - t);
}

__device__ __forceinline__ void hgrn_item(const Params& p, LAS unsigned char* lds, int item) {
    const int tid = threadIdx.x, lane = tid & 63, wave = __builtin_amdgcn_readfirstlane(tid >> 6);
    const int k = tid & 127, J = __builtin_amdgcn_readfirstlane(tid >> 7);
    const int li = lane & 15, g = lane >> 4, qq = li >> 2, pp = li & 3;
    const int dir = item / (BATCH * NHEAD), b = (item / NHEAD) % BATCH, h = item % NHEAD;
    const float* LF = (const float*)(p.ws + (dir == 0 ? WS_FW : WS_FB)) + h * HD + k;
    const bf16* QA = (const bf16*)(p.ws + WS_QA) + h * HD + k;
    const bf16* IA = (const bf16*)(p.ws + WS_IA) + h * HD;
    bf16* O = (bf16*)(p.ws + (dir == 0 ? WS_OF : WS_OB)) + h * HD + 16 * wave + li;
    LAS float* Tl = (LAS float*)(lds + H_T); LAS float* Dl = (LAS float*)(lds + H_D);

    f32x4 S[8];
#pragma unroll
    for (int i = 0; i < 8; ++i) S[i] = (f32x4){0.f, 0.f, 0.f, 0.f};

    float lf[16]; unsigned qv[16]; u32x4 vreg[2];
#define HG_LOAD_CHUNK(c_) do { const int cc_ = (c_); \
        _Pragma("unroll") for (int i = 0; i < 16; ++i) { const size_t row = hg_row(dir, b, 64 * cc_ + 16 * J + i); lf[i] = LF[row * WA]; qv[i] = (cc_ >= 4) ? (unsigned)QA[row * WA] : 0u; } \
        _Pragma("unroll") for (int e = 0; e < 2; ++e) { const int idx = tid * 2 + e; const size_t row = hg_row(dir, b, 64 * cc_ + (idx >> 4)); vreg[e] = *(const u32x4*)(IA + row * WA + 8 * (idx & 15)); } } while (0)
    HG_LOAD_CHUNK(0);
    constexpr int NCH = (CTX + SEQ) / 64;
    for (int c = 0; c < NCH; ++c) {
        float cum[16]; float run = 0.f;
#pragma unroll
        for (int i = 0; i < 16; ++i) { run += lf[i]; cum[i] = run; }
        Tl[J * 128 + k] = run;
        __syncthreads();
        const float T0 = Tl[k], T1 = Tl[128 + k], T2 = Tl[256 + k], T3 = Tl[384 + k];
        const float bJ = (J > 0 ? T0 : 0.f) + (J > 1 ? T1 : 0.f) + (J > 2 ? T2 : 0.f);
        const float tail = (J < 1 ? T1 : 0.f) + (J < 2 ? T2 : 0.f) + (J < 3 ? T3 : 0.f);
        const float eb = __expf(bJ), et = __expf(tail), eT = __expf(run);
        const float x2 = (J == 3) ? __expf(T2) : __expf(T1);
        float qh[16], kh[16];
#pragma unroll
        for (int i = 0; i < 16; ++i) { const float e1 = __expf(cum[i]); const float r1 = 1.0f / e1; const float kk = 1.0f - __expf(lf[i]);
            qh[i] = __builtin_bit_cast(float, qv[i] << 16) * e1; kh[i] = kk * r1; }
        {
            LAS unsigned char* rowp = lds + k * HP + 32 * J;
            u32x4 w0, w1;
#define HG_WRITE(OFF, EXPR) do { \
            { float v0_, v1_; \
              { const int i = 0; v0_ = (EXPR); } { const int i = 1; v1_ = (EXPR); } w0.x = pk2(v0_, v1_); \
              { const int i = 2; v0_ = (EXPR); } { const int i = 3; v1_ = (EXPR); } w0.y = pk2(v0_, v1_); \
              { const int i = 4; v0_ = (EXPR); } { const int i = 5; v1_ = (EXPR); } w0.z = pk2(v0_, v1_); \
              { const int i = 6; v0_ = (EXPR); } { const int i = 7; v1_ = (EXPR); } w0.w = pk2(v0_, v1_); \
              { const int i = 8; v0_ = (EXPR); } { const int i = 9; v1_ = (EXPR); } w1.x = pk2(v0_, v1_); \
              { const int i = 10; v0_ = (EXPR); } { const int i = 11; v1_ = (EXPR); } w1.y = pk2(v0_, v1_); \
              { const int i = 12; v0_ = (EXPR); } { const int i = 13; v1_ = (EXPR); } w1.z = pk2(v0_, v1_); \
              { const int i = 14; v0_ = (EXPR); } { const int i = 15; v1_ = (EXPR); } w1.w = pk2(v0_, v1_); } \
            *(LAS u32x4*)(OFF) = w0; *(LAS u32x4*)((OFF) + 16) = w1; } while (0)
            HG_WRITE(rowp + H_QH, qh[i]);
            HG_WRITE(rowp + H_KH, kh[i]);
            HG_WRITE(rowp + H_KE, kh[i] * eT);
            HG_WRITE(rowp + H_QD, qh[i] * eb);
            HG_WRITE(rowp + H_KD, kh[i] * (eT * et));
            if (J == 3) { HG_WRITE(lds + H_Q2 + k * HP2, qh[i] * x2); }
            if (J == 0) { HG_WRITE(lds + H_K2 + k * HP2, kh[i] * (eT * x2)); }
#undef HG_WRITE
            if (J == 3) Dl[k] = __expf(bJ + run);
        }
#pragma unroll
        for (int e = 0; e < 2; ++e) { const int idx = tid * 2 + e; *(LAS u32x4*)(lds + H_V + (idx >> 4) * VP + 16 * (idx & 15)) = vreg[e]; }
        if (c + 1 < NCH) HG_LOAD_CHUNK(c + 1);
        __syncthreads();
        const bool lat = (c >= 4);
        if (lat) {
#pragma unroll
            for (int rep = 0; rep < 2; ++rep) {
                int I, Jb;
                if (rep == 0) { I = (wave < 4) ? wave : (wave == 4 ? 1 : (wave == 7 ? 3 : 2)); Jb = (wave < 4) ? wave : (wave == 4 ? 0 : (wave == 5 ? 0 : (wave == 6 ? 1 : 2))); }
                else { if (wave >= 2) break; I = 3; Jb = wave; }
                int aoff, apitch, acol, boff, bpitch, bcol;
                if (I == Jb) { aoff = H_KH; apitch = HP; acol = 16 * Jb; boff = H_QH; bpitch = HP; bcol = 16 * I; }
                else if (I == Jb + 1 && I != 2) { aoff = H_KE; apitch = HP; acol = 16 * Jb; boff = H_QH; bpitch = HP; bcol = 16 * I; }
                else if (I == 2) { if (Jb == 0) { aoff = H_K2; apitch = HP2; acol = 0; } else { aoff = H_KE; apitch = HP; acol = 16; } boff = H_QH; bpitch = HP; bcol = 32; }
                else { if (Jb == 0) { aoff = H_K2; apitch = HP2; acol = 0; } else { aoff = H_KE; apitch = HP; acol = 16; } boff = H_Q2; bpitch = HP2; bcol = 0; }
                f32x4 pt = (f32x4){0.f, 0.f, 0.f, 0.f};
#pragma unroll
                for (int ks = 0; ks < 4; ++ks) {
                    const int r0 = 32 * ks + 4 * g + qq;
                    const bf16x8 a = cat8(lds_tr(lds + aoff + r0 * apitch + (acol + 4 * pp) * 2), lds_tr(lds + aoff + (r0 + 16) * apitch + (acol + 4 * pp) * 2));
                    const bf16x8 bb = cat8(lds_tr(lds + boff + r0 * bpitch + (bcol + 4 * pp) * 2), lds_tr(lds + boff + (r0 + 16) * bpitch + (bcol + 4 * pp) * 2));
                    pt = __builtin_amdgcn_mfma_f32_16x16x32_bf16(a, bb, pt, 0, 0, 0);
                }
                if (I == Jb) {
#pragma unroll
                    for (int j = 0; j < 4; ++j) if (4 * g + j > li) pt[j] = 0.f;
                }
                u32x2 w; w.x = pk2(pt.x, pt.y); w.y = pk2(pt.z, pt.w);
                *(LAS u32x2*)(lds + H_P + (16 * I + li) * PP + (16 * Jb + 4 * g) * 2) = w;
            }
        }
        __syncthreads();
        bf16x8 vf[2];
#pragma unroll
        for (int sp = 0; sp < 2; ++sp) {
            const LAS unsigned char* vb0 = lds + H_V + (32 * sp + 4 * g + qq) * VP + (16 * wave + 4 * pp) * 2;
            vf[sp] = cat8(lds_tr(vb0), lds_tr(vb0 + 16 * VP));
        }
        if (lat) {
            bf16x8 sb[4];
#pragma unroll
            for (int ks = 0; ks < 4; ++ks) sb[ks] = pack_p(S[2 * ks], S[2 * ks + 1]);
#pragma unroll
            for (int I = 0; I < 4; ++I) {
                f32x4 o = (f32x4){0.f, 0.f, 0.f, 0.f};
#pragma unroll
                for (int ks = 0; ks < 4; ++ks) {
                    const LAS unsigned char* ap = lds + H_QD + (32 * ks + 4 * g + qq) * HP + (16 * I + 4 * pp) * 2;
                    o = __builtin_amdgcn_mfma_f32_16x16x32_bf16(cat8(lds_tr(ap), lds_tr(ap + 16 * HP)), sb[ks], o, 0, 0, 0);
                }
#pragma unroll
                for (int sp = 0; sp < 2; ++sp) {
                    if (2 * sp > I) break;
                    const LAS unsigned char* pr = lds + H_P + (16 * I + li) * PP + (32 * sp + 4 * g) * 2;
                    const u32x2 lo = *(const LAS u32x2*)pr; u32x2 hi = (u32x2){0u, 0u};
                    if (2 * sp + 1 <= I) hi = *(const LAS u32x2*)(pr + 32);
                    o = __builtin_amdgcn_mfma_f32_16x16x32_bf16(cat8u(lo, hi), vf[sp], o, 0, 0, 0);
                }
#pragma unroll
                for (int j = 0; j < 4; ++j) { const size_t row = hg_row(dir, b, 64 * c + 16 * I + 4 * g + j); O[row * WA] = (bf16)f2bf(o[j]); }
            }
        }
#pragma unroll
        for (int blk = 0; blk < 8; ++blk) {
            const f32x4 d4 = *(const LAS f32x4*)(Dl + 16 * blk + 4 * g);
            f32x4 s = S[blk] * d4;
#pragma unroll
            for (int sp = 0; sp < 2; ++sp) {
                const LAS unsigned char* kp = lds + H_KD + (16 * blk + li) * HP + (32 * sp + 4 * g) * 2;
                s = __builtin_amdgcn_mfma_f32_16x16x32_bf16(cat8u(*(const LAS u32x2*)kp, *(const LAS u32x2*)(kp + 32)), vf[sp], s, 0, 0, 0);
            }
            S[blk] = s;
        }
    }
    __syncthreads();
#undef HG_LOAD_CHUNK
}
__device__ __forceinline__ void phase_readout(const Params& p, int vb, int nb) {
    const int tid = threadIdx.x, lane = tid & 63, wave = tid >> 6;
    const bf16* OF = (const bf16*)(p.ws + WS_OF); const bf16* OB = (const bf16*)(p.ws + WS_OB); const bf16* GA = (const bf16*)(p.ws + WS_GA);
    bf16* YA = (bf16*)(p.ws + WS_YA);
    for (int it = vb * 8 + wave; it < ML * NHEAD; it += nb * 8) {
        const int row = it / NHEAD, h = it % NHEAD; const size_t off = (size_t)row * WA + h * HD + 2 * lane;
        const unsigned a = *(const unsigned*)(OF + off), b = *(const unsigned*)(OB + off), g = *(const unsigned*)(GA + off);
        const float o0 = bflo(a) + bflo(b), o1 = bfhi(a) + bfhi(b);
        const float rstd = 1.0f / sqrtf(wave_sum(o0 * o0 + o1 * o1) * (1.0f / HD) + EPS);
        const float y0 = o0 * rstd * p.hgrn_norm_g[2 * lane] * bflo(g), y1 = o1 * rstd * p.hgrn_norm_g[2 * lane + 1] * bfhi(g);
        *(unsigned*)(YA + off) = pk2(y0, y1);
    }
}

__device__ __forceinline__ void phase_bias2(const Params& p, int vb, int nb) {
    const int tid = threadIdx.x; const float* mod = (const float*)(p.ws + WS_MOD); float* bias2 = (float*)(p.ws + WS_BIAS2);
    constexpr int NCC = 2 * FFN / 512, NKC = D_MODEL / 64;
    for (int item = vb; item < NCC * NKC; item += nb) {
        const int cc = item % NCC, kc = item / NCC; const int col = cc * 512 + tid;
        const float* W = (col < FFN) ? p.w1 + col : p.w3 + (col - FFN);
        float a0 = 0.f, a1 = 0.f, a2 = 0.f, a3 = 0.f;
#pragma unroll 8
        for (int k = kc * 64; k < kc * 64 + 64; ++k) { const float w = W[(size_t)k * FFN];
            a0 += w * mod[0 * IN_COLS + 3 * D_MODEL + k]; a1 += w * mod[1 * IN_COLS + 3 * D_MODEL + k]; a2 += w * mod[2 * IN_COLS + 3 * D_MODEL + k]; a3 += w * mod[3 * IN_COLS + 3 * D_MODEL + k]; }
        atomicAdd(bias2 + 0 * 2 * FFN + col, a0); atomicAdd(bias2 + 1 * 2 * FFN + col, a1); atomicAdd(bias2 + 2 * 2 * FFN + col, a2); atomicAdd(bias2 + 3 * 2 * FFN + col, a3);
    }
}

__device__ __forceinline__ void phase_conv(const Params& p, int vb, int nb) {
    const int tid = threadIdx.x; const bf16* A13 = (const bf16*)(p.ws + WS_A13); bf16* ACT = (bf16*)(p.ws + WS_ACT);
    constexpr int CPR = FFN / 8;
    const size_t total = (size_t)ML * CPR;
    for (size_t i = (size_t)vb * NTHREADS + tid; i < total; i += (size_t)nb * NTHREADS) {
        const int row = (int)(i / CPR), c = (int)(i % CPR) * 8; const int t = row % SEQ;
        const bf16* ap = A13 + (size_t)row * (2 * FFN) + c;
        const u32x4 a1 = *(const u32x4*)ap; const u32x4 g = *(const u32x4*)(ap + FFN);
        u32x4 a0 = (u32x4){0u, 0u, 0u, 0u}, a2 = (u32x4){0u, 0u, 0u, 0u};
        if (t > 0) a0 = *(const u32x4*)(ap - 2 * FFN);
        if (t < SEQ - 1) a2 = *(const u32x4*)(ap + 2 * FFN);
        float w0[8], w1[8], w2[8], cb[8];
#pragma unroll
        for (int e = 0; e < 8; ++e) { w0[e] = p.conv_w[c + e]; w1[e] = p.conv_w[FFN + c + e]; w2[e] = p.conv_w[2 * FFN + c + e]; cb[e] = p.conv_b[c + e]; }
        float r[8];
#pragma unroll
        for (int q = 0; q < 4; ++q) {
            const unsigned x0 = a0[q], x1 = a1[q], x2 = a2[q], gg = g[q];
            const float u0 = bflo(x0) * w0[2 * q] + bflo(x1) * w1[2 * q] + bflo(x2) * w2[2 * q] + cb[2 * q];
            const float u1 = bfhi(x0) * w0[2 * q + 1] + bfhi(x1) * w1[2 * q + 1] + bfhi(x2) * w2[2 * q + 1] + cb[2 * q + 1];
            r[2 * q] = siluf_(u0) * bflo(gg); r[2 * q + 1] = siluf_(u1) * bfhi(gg);
        }
        u32x4 o; o.x = pk2(r[0], r[1]); o.y = pk2(r[2], r[3]); o.z = pk2(r[4], r[5]); o.w = pk2(r[6], r[7]);
        *(u32x4*)(ACT + (size_t)row * FFN + c) = o;
    }
}


constexpr int LDS_MISC_OFF = 145408;
constexpr int LDS_BYTES = 146432;
static_assert(WS_BAR + XCD_BAR_WORDS * 4 <= WS_ROWSQ, "barrier words inside ctl");

__global__ void __launch_bounds__(NTHREADS, 2) mega_fwd(Params p) {
    extern __shared__ __attribute__((aligned(16))) unsigned char lds_raw[];
    LAS unsigned char* lds = (LAS unsigned char*)lds_raw;
    const int nb = gridDim.x;
    const int vb = (nb % 8 == 0) ? ((int)(blockIdx.x % 8) * (nb / 8) + (int)(blockIdx.x / 8)) : (int)blockIdx.x;
    const int bx = blockIdx.x;
    unsigned char* ws = p.ws;
    volatile LAS unsigned* misc = (volatile LAS unsigned*)(lds + LDS_MISC_OFF);
    if (threadIdx.x < 64) misc[threadIdx.x] = 0u;
    __syncthreads();
    XcdBarrier bar = xcd_barrier_post((unsigned*)(ws + WS_BAR), misc + 8);
#define GRID_BAR() xcd_barrier(bar)

    phase_mod(p, lds, vb, nb);
    __syncthreads();
    phase_wconv(p, lds, vb, nb);
    GRID_BAR();
    phase_h(p, vb, nb);
    phase_bias2(p, vb, nb);
    GRID_BAR();
    { pg8::Gemm g{(const bf16*)(ws + WS_H), (const bf16*)(ws + WS_WINT), MT, IN_COLS, D_MODEL}; pg8::StaticOrder S; S.init(MT, IN_COLS, nb, bx);
      EpiInProj E{ws}; pg8::gemm_phase<EpiInProj, pg8::StaticOrder, true, true>(lds, g, S, E); }
    GRID_BAR();
    phase_qkrope(p, vb, nb);
    GRID_BAR();
    if (bx < 2 * BATCH * NHEAD) hgrn_item(p, lds, bx);
    __syncthreads();
    phase_attn(p, lds);
    GRID_BAR();
    phase_readout(p, vb, nb);
    GRID_BAR();
    { pg8::Gemm g{(const bf16*)(ws + WS_YA), (const bf16*)(ws + WS_WAT), ML, D_MODEL, WA}; pg8::StaticOrder S; S.init(ML, D_MODEL, nb, bx);
      EpiMergeA E{ws, p.out}; pg8::gemm_phase<EpiMergeA, pg8::StaticOrder, true, true>(lds, g, S, E); }
    GRID_BAR();
    { pg8::Gemm g{(const bf16*)(ws + WS_YB), (const bf16*)(ws + WS_WBT), ML, D_MODEL, WA}; pg8::StaticOrder S; S.init(ML, D_MODEL, nb, bx);
      EpiMergeB E{ws, p.out}; pg8::gemm_phase<EpiMergeB, pg8::StaticOrder, true, true>(lds, g, S, E); }
    GRID_BAR();
    { pg8::Gemm g{(const bf16*)(ws + WS_Z), (const bf16*)(ws + WS_WOT), ML, D_MODEL, D_MODEL}; pg8::StaticOrder S; S.init(ML, D_MODEL, nb, bx);
      EpiOutProj E{ws, p.x, p.norm2_g, p.out}; pg8::gemm_phase<EpiOutProj, pg8::StaticOrder, true, true>(lds, g, S, E); }
    GRID_BAR();
    { pg8::Gemm g{(const bf16*)(ws + WS_XMG), (const bf16*)(ws + WS_W13T), ML, 2 * FFN, D_MODEL}; pg8::StaticOrder S; S.init(ML, 2 * FFN, nb, bx);
      EpiFfnUp E{ws}; pg8::gemm_phase<EpiFfnUp, pg8::StaticOrder, true, true>(lds, g, S, E); }
    GRID_BAR();
    phase_conv(p, vb, nb);
    GRID_BAR();
    { pg8::Gemm g{(const bf16*)(ws + WS_ACT), (const bf16*)(ws + WS_W2T), ML, D_MODEL, FFN}; pg8::StaticOrder S; S.init(ML, D_MODEL, nb, bx);
      EpiFfnDown E{ws, p.out}; pg8::gemm_phase<EpiFfnDown, pg8::StaticOrder, true, true>(lds, g, S, E); }
#undef GRID_BAR
}

extern "C" void kernel_launch(void* const* d_in, const int* in_sizes, int n_in, void* d_out, int out_size, void* d_ws, size_t ws_size, hipStream_t stream) {
    static int grid = 0;
    if (grid == 0) {
        if (n_in != 22 || ws_size < WS_END || out_size != ML * D_MODEL) { fprintf(stderr, "kernel_launch: bad inputs (n_in %d, out %d, ws %zu, need %zu)\n", n_in, out_size, ws_size, (size_t)WS_END); grid = -1; return; }
        int dev = 0, cus = 0, per_cu = 0;
        if (hipGetDevice(&dev) != hipSuccess || hipDeviceGetAttribute(&cus, hipDeviceAttributeMultiprocessorCount, dev) != hipSuccess) { grid = -1; return; }
        if (hipFuncSetAttribute((const void*)mega_fwd, hipFuncAttributeMaxDynamicSharedMemorySize, LDS_BYTES) != hipSuccess) { fprintf(stderr, "kernel_launch: hipFuncSetAttribute failed\n"); grid = -1; return; }
        if (hipOccupancyMaxActiveBlocksPerMultiprocessor(&per_cu, (const void*)mega_fwd, NTHREADS, LDS_BYTES) != hipSuccess || per_cu < 1) { fprintf(stderr, "kernel_launch: occupancy query says %d blocks/CU\n", per_cu); (void)hipGetLastError(); grid = -1; return; }
        grid = cus;
        fprintf(stderr, "kernel_launch: grid %d (cus %d, occupancy %d/CU)\n", grid, cus, per_cu);
    }
    if (grid < 0) return;
    Params p{};
    const float** f = (const float**)&p;
    for (int i = 0; i < 22; ++i) f[i] = (const float*)d_in[i];
    p.out = (float*)d_out; p.ws = (unsigned char*)d_ws;
    (void)hipMemsetAsync((char*)d_ws + WS_CTL, 0, CTL_ZERO_BYTES, stream);
    hipLaunchKernelGGL(mega_fwd, dim3(grid), dim3(NTHREADS), LDS_BYTES, stream, p);
}
```

```cpp
#include <hip/hip_runtime.h>
#include <cstdio>
#include <cstdint>
#include <cmath>
namespace pg8 {
#define PG8_LAS __attribute__((address_space(3)))
typedef unsigned short bf16_t;
typedef short bf16x8 __attribute__((ext_vector_type(8)));
typedef float f32x4 __attribute__((ext_vector_type(4)));
typedef unsigned u32x4 __attribute__((ext_vector_type(4)));
constexpr int BM = 256, BK = 64, HALF = 128, HTB = HALF * BK * 2  , STAGE_BYTES = 8 * HTB, NXCD = 8, WGM = 8;

__host__ __device__ __forceinline__ int lds_byte(int r, int c) { const int st = (r >> 4) * 2 + (c >> 5), rr = r & 15, cc = c & 31, ob = rr * 64 + cc * 2; return st * 1024 + (ob ^ (((ob >> 9) & 1) << 5)); }
__host__ __device__ __forceinline__ void stage_rc(int b, int& R, int& C) { const int st = b / 1024, sb = b % 1024, swz = sb ^ (((sb >> 9) & 1) << 5); R = (st >> 1) * 16 + swz / 64; C = (st & 1) * 32 + (swz % 64) / 2; }
__host__ __device__ __forceinline__ int perm32(int rho) { const int n = rho >> 4, i = rho & 15; return 8 * (i >> 2) + 4 * n + (i & 3); }

struct Unit { int pm, pn; };
struct Gemm { const bf16_t* A; const bf16_t* Bt; int M, N, K; };

struct StaticOrder {
    int nM, nN, nwg, G, c;
    __host__ __device__ void init(int M, int N, int G_, int c_) { nM = M / BM; nN = N / BM; nwg = nM * nN; G = G_; c = c_; }
    __host__ __device__ bool next(int i, Unit& u) const {
        const long L = (long)i * G + c; if (L >= nwg) return false;
        int wgid = (int)L; { const int q = nwg / NXCD, r = nwg % NXCD, xcd = wgid % NXCD, off = wgid / NXCD; wgid = (xcd < r ? xcd * (q + 1) : r * (q + 1) + (xcd - r) * q) + off; }
        const int nig = WGM * nN, gid = wgid / nig, fm = gid * WGM, gsz = (nM - fm) < WGM ? (nM - fm) : WGM;
        u.pm = fm + ((wgid % nig) % gsz); u.pn = (wgid % nig) / gsz; return true;
    }
    __device__ __forceinline__ void a_ready(const Unit&) const {}
    __device__ __forceinline__ void done(const Unit&) const {}
};

template <class Epi, class Sched, bool ALIGN_EPI = false, bool SP2 = false>
__device__ __forceinline__ void gemm_phase(PG8_LAS unsigned char* lds, const Gemm g, const Sched& S, const Epi& E) {
    const int tid = threadIdx.x, wid = __builtin_amdgcn_readfirstlane(tid >> 6), lane = tid & 63, wr = wid >> 2, wc = wid & 3, fr = lane & 15, fq = lane >> 4;
    const int K = g.K, nt = K / BK;
    unsigned voffA[2], voffB[2];
#pragma unroll
    for (int i = 0; i < 2; ++i) { int R, C; stage_rc(tid * 16 + i * 8192, R, C); const int Rb = Epi::PERM ? ((R & ~31) + perm32(R & 31)) : R;
        voffA[i] = (unsigned)(R * K + C) * 2u; voffB[i] = (unsigned)(Rb * K + C) * 2u; }
    const size_t kstep = (size_t)(BK * 2);
    const size_t hstep = (size_t)HALF * K * 2;
    const size_t tstep = 2 * hstep;
    const unsigned ldsw = (unsigned)wid * 1024u;
    const int aoff = lds_byte(wr * 64 + fr, fq * 8), boff = lds_byte(wc * 32 + fr, fq * 8);
#define PG8_SA(b, h) (((b) * 2 + (h)) * HTB)
#define PG8_SB(b, h) ((4 + (b) * 2 + (h)) * HTB)
#define PG8_STAGE(bufoff, gbase, voff) do { _Pragma("unroll") for (int _i = 0; _i < 2; ++_i) \
        __builtin_amdgcn_global_load_lds((const unsigned*)((const char*)(gbase) + (voff)[_i]), (PG8_LAS unsigned*)(lds + (bufoff) + ldsw + _i * 8192), 16, 0, 0); } while (0)
#define PG8_LDA(dst, b, h) do { _Pragma("unroll") for (int m = 0; m < 4; ++m) _Pragma("unroll") for (int k = 0; k < 2; ++k) dst[m][k] = *(const PG8_LAS bf16x8*)(lds + PG8_SA(b, h) + aoff + m * 2048 + k * 1024); } while (0)
#define PG8_LDB(dst, b, h) do { _Pragma("unroll") for (int n = 0; n < 2; ++n) _Pragma("unroll") for (int k = 0; k < 2; ++k) dst[n][k] = *(const PG8_LAS bf16x8*)(lds + PG8_SB(b, h) + boff + n * 2048 + k * 1024); } while (0)
#define PG8_MMA(ai, bj, At, Bt) do { __builtin_amdgcn_s_setprio(1); _Pragma("unroll") for (int m = 0; m < 4; ++m) _Pragma("unroll") for (int n = 0; n < 2; ++n) _Pragma("unroll") for (int k = 0; k < 2; ++k) \
        acc[ai][bj][m][n] = __builtin_amdgcn_mfma_f32_16x16x32_bf16(Bt[n][k], At[m][k], acc[ai][bj][m][n], 0, 0, 0); __builtin_amdgcn_s_setprio(0); } while (0)
#define PG8_WAIT_V(n) asm volatile("s_waitcnt vmcnt(" #n ")" ::: "memory")
#define PG8_WAIT_L(n) asm volatile("s_waitcnt lgkmcnt(" #n ")" ::: "memory")
#define PG8_BAR __builtin_amdgcn_s_barrier()
#define PG8_SCHED __builtin_amdgcn_sched_barrier(0)
    Unit cur, nxt; int ui = 0;
    if (!S.next(0, cur)) return;
    f32x4 acc[2][2][4][2];
#pragma unroll
    for (int a = 0; a < 2; ++a)
#pragma unroll
        for (int b = 0; b < 2; ++b)
#pragma unroll
            for (int m = 0; m < 4; ++m)
#pragma unroll
                for (int n = 0; n < 2; ++n) acc[a][b][m][n] = (f32x4){0.f, 0.f, 0.f, 0.f};
    bf16x8 At[4][2], B0[2][2], B1[2][2];
    const char* cA = (const char*)g.A + (size_t)cur.pm * tstep; const char* cB = (const char*)g.Bt + (size_t)cur.pn * tstep;
    S.a_ready(cur);
    if constexpr (SP2) {
        PG8_STAGE(PG8_SB(0, 0), cB, voffB); PG8_STAGE(PG8_SB(0, 1), cB + hstep, voffB); PG8_STAGE(PG8_SA(0, 0), cA, voffA); PG8_STAGE(PG8_SA(0, 1), cA + hstep, voffA);
        if (wr == 1) PG8_BAR;
        PG8_WAIT_V(2); PG8_BAR;
        PG8_STAGE(PG8_SB(1, 0), cB + kstep, voffB); PG8_STAGE(PG8_SA(1, 0), cA + kstep, voffA); PG8_STAGE(PG8_SB(1, 1), cB + hstep + kstep, voffB);
        PG8_WAIT_V(6); PG8_BAR;
    } else {
        PG8_STAGE(PG8_SB(0, 0), cB, voffB); PG8_STAGE(PG8_SA(0, 0), cA, voffA); PG8_STAGE(PG8_SB(0, 1), cB + hstep, voffB); PG8_STAGE(PG8_SA(0, 1), cA + hstep, voffA);
        if (wr == 1) PG8_BAR;
        PG8_WAIT_V(4); PG8_BAR;
        PG8_STAGE(PG8_SB(1, 0), cB + kstep, voffB); PG8_STAGE(PG8_SA(1, 0), cA + kstep, voffA); PG8_STAGE(PG8_SB(1, 1), cB + hstep + kstep, voffB);
        PG8_WAIT_V(6); PG8_BAR;
    }
    for (;;) {
        const bool has_next = S.next(ui + 1, nxt);
        const char* nA = has_next ? (const char*)g.A + (size_t)nxt.pm * tstep : cA; const char* nB = has_next ? (const char*)g.Bt + (size_t)nxt.pn * tstep : cB;
        for (int t = 0; t < nt; t += 2) {
            const bool last = (t == nt - 2);
            const char* a1 = cA + (size_t)(t + 1) * kstep;
            const char* a2 = last ? nA : cA + (size_t)(t + 2) * kstep; const char* b2 = last ? nB : cB + (size_t)(t + 2) * kstep;
            const char* a3 = a2 + kstep; const char* b3 = b2 + kstep;
            if (last && has_next) S.a_ready(nxt);
            if constexpr (SP2) {
            PG8_LDB(B0, 0, 0); PG8_LDB(B1, 0, 1); PG8_SCHED; PG8_LDA(At, 0, 0); PG8_STAGE(PG8_SA(1, 1), a1 + hstep, voffA);
            PG8_WAIT_V(8); PG8_WAIT_L(0); PG8_BAR; PG8_MMA(0, 0, At, B0); PG8_MMA(0, 1, At, B1); PG8_BAR; PG8_SCHED;
            PG8_LDA(At, 0, 1); PG8_STAGE(PG8_SB(0, 0), b2, voffB); PG8_STAGE(PG8_SB(0, 1), b2 + hstep, voffB); PG8_STAGE(PG8_SA(0, 0), a2, voffA);
            PG8_WAIT_V(8); PG8_WAIT_L(0); PG8_BAR; PG8_MMA(1, 0, At, B0); PG8_MMA(1, 1, At, B1); PG8_BAR; PG8_SCHED;
            PG8_LDB(B0, 1, 0); PG8_LDB(B1, 1, 1); PG8_SCHED; PG8_LDA(At, 1, 0); PG8_STAGE(PG8_SA(0, 1), a2 + hstep, voffA);
            PG8_WAIT_V(8); PG8_WAIT_L(0); PG8_BAR; PG8_MMA(0, 0, At, B0); PG8_MMA(0, 1, At, B1); PG8_BAR; PG8_SCHED;
            PG8_LDA(At, 1, 1); PG8_STAGE(PG8_SB(1, 0), b3, voffB); PG8_STAGE(PG8_SB(1, 1), b3 + hstep, voffB); PG8_STAGE(PG8_SA(1, 0), a3, voffA);
            PG8_WAIT_V(8); PG8_WAIT_L(0); PG8_BAR; PG8_MMA(1, 0, At, B0); PG8_MMA(1, 1, At, B1); PG8_BAR; PG8_SCHED;
            } else {
            PG8_LDB(B0, 0, 0); PG8_SCHED; PG8_LDA(At, 0, 0); PG8_STAGE(PG8_SA(1, 1), a1 + hstep, voffA);
            PG8_WAIT_L(8); PG8_BAR; PG8_WAIT_L(0); PG8_MMA(0, 0, At, B0); PG8_BAR; PG8_SCHED;
            PG8_LDB(B1, 0, 1); PG8_STAGE(PG8_SB(0, 0), b2, voffB);
            PG8_BAR; PG8_WAIT_L(0); PG8_MMA(0, 1, At, B1); PG8_BAR;
            PG8_LDA(At, 0, 1); PG8_STAGE(PG8_SA(0, 0), a2, voffA);
            PG8_BAR; PG8_WAIT_L(0); PG8_MMA(1, 0, At, B0); PG8_BAR; PG8_SCHED;
            PG8_STAGE(PG8_SB(0, 1), b2 + hstep, voffB);
            PG8_WAIT_V(6); PG8_BAR; PG8_MMA(1, 1, At, B1); PG8_BAR;
            PG8_LDB(B0, 1, 0); PG8_SCHED; PG8_LDA(At, 1, 0); PG8_STAGE(PG8_SA(0, 1), a2 + hstep, voffA);
            PG8_WAIT_L(8); PG8_BAR; PG8_WAIT_L(0); PG8_MMA(0, 0, At, B0); PG8_BAR; PG8_SCHED;
            PG8_LDB(B1, 1, 1); PG8_STAGE(PG8_SB(1, 0), b3, voffB);
            PG8_BAR; PG8_WAIT_L(0); PG8_MMA(0, 1, At, B1); PG8_BAR;
            PG8_LDA(At, 1, 1); PG8_STAGE(PG8_SA(1, 0), a3, voffA);
            PG8_BAR; PG8_WAIT_L(0); PG8_MMA(1, 0, At, B0); PG8_BAR; PG8_SCHED;
            PG8_STAGE(PG8_SB(1, 1), b3 + hstep, voffB);
            PG8_WAIT_V(6); PG8_BAR; PG8_MMA(1, 1, At, B1); PG8_BAR;
            }
        }
        if constexpr (ALIGN_EPI) { if (wr == 0) PG8_BAR; }
        if constexpr (!Epi::AFTER_DRAIN) { E(acc, cur, wr, wc, fr, fq); S.done(cur); }
        if (!has_next) break;
#pragma unroll
        for (int a = 0; a < 2; ++a)
#pragma unroll
            for (int b = 0; b < 2; ++b)
#pragma unroll
                for (int m = 0; m < 4; ++m)
#pragma unroll
                    for (int n = 0; n < 2; ++n) acc[a][b][m][n] = (f32x4){0.f, 0.f, 0.f, 0.f};
        cur = nxt; cA = nA; cB = nB; ++ui;
        if constexpr (ALIGN_EPI) { if (wr == 1) PG8_BAR; }
    }
    PG8_WAIT_V(0);
    if constexpr (!ALIGN_EPI) { if (wr == 0) PG8_BAR; }
    PG8_BAR;
    if constexpr (Epi::AFTER_DRAIN) { E.fused(acc, cur, wr, wc, fr, fq, lds, wid, lane); S.done(cur); }
#undef PG8_SA
#undef PG8_SB
#undef PG8_STAGE
#undef PG8_LDA
#undef PG8_LDB
#undef PG8_MMA
#undef PG8_WAIT_V
#undef PG8_WAIT_L
#undef PG8_BAR
#undef PG8_SCHED
}
}

constexpr int D_MODEL = 2048, BATCH = 4, SEQ = 2048, CTX = 256, GRID_W = 64, NHEAD = 8, HD = 128, WA = 1024;
constexpr int FFN = 5632, IN_COLS = 12288, NMOD = 6;
constexpr int ML = BATCH * SEQ;
constexpr int MC = BATCH * CTX;
constexpr int MT = ML + MC;
constexpr float EPS = 1e-6f;
constexpr int NTHREADS = 512;
constexpr int VT_PITCH = SEQ + CTX;

typedef unsigned short bf16;
typedef float f32x4 __attribute__((ext_vector_type(4)));
typedef unsigned u32x2 __attribute__((ext_vector_type(2)));
typedef unsigned u32x4 __attribute__((ext_vector_type(4)));
#define LAS __attribute__((address_space(3)))

typedef float f32x2_t __attribute__((ext_vector_type(2)));
typedef __bf16 bf16x2_t __attribute__((ext_vector_type(2)));
__device__ __forceinline__ unsigned pk2(float lo, float hi) { const f32x2_t v = {lo, hi}; const bf16x2_t b = __builtin_convertvector(v, bf16x2_t); return __builtin_bit_cast(unsigned, b); }
__device__ __forceinline__ unsigned f2bf(float f) { return pk2(f, 0.f) & 0xffffu; }
__device__ __forceinline__ float bf2f(unsigned short h) { return __builtin_bit_cast(float, (unsigned)h << 16); }
__device__ __forceinline__ float bflo(unsigned w) { return __builtin_bit_cast(float, w << 16); }
__device__ __forceinline__ float bfhi(unsigned w) { return __builtin_bit_cast(float, w & 0xffff0000u); }
__device__ __forceinline__ float sigmoidf_(float x) { return 1.0f / (1.0f + __expf(-x)); }
__device__ __forceinline__ float siluf_(float x) { return x / (1.0f + __expf(-x)); }
__device__ __forceinline__ float wave_sum(float v) {
#pragma unroll
    for (int o = 1; o < 64; o <<= 1) v += __shfl_xor(v, o);
    return v;
}
__device__ __forceinline__ float wave_max(float v) {
#pragma unroll
    for (int o = 1; o < 64; o <<= 1) v = fmaxf(v, __shfl_xor(v, o));
    return v;
}

constexpr size_t al256(size_t x) { return (x + 255) & ~(size_t)255; }
constexpr size_t WS_CTL   = 0;
constexpr size_t CTL_ZERO_BYTES = 1u << 20;
constexpr size_t WS_ROWSQ = 64 * 1024;
constexpr size_t WS_BIAS2 = WS_ROWSQ + (size_t)ML * 4;
static_assert(WS_BIAS2 + (size_t)4 * 2 * FFN * 4 <= CTL_ZERO_BYTES, "ctl");
constexpr size_t WS_MOD   = CTL_ZERO_BYTES;
constexpr size_t WS_LB    = al256(WS_MOD + (size_t)5 * IN_COLS * 4);
constexpr size_t WS_ROPE  = al256(WS_LB + 2 * WA * 4);
constexpr size_t WS_SMALL_END = al256(WS_ROPE + 2 * 64 * 32 * 4);
constexpr size_t WS_W13T  = al256(WS_SMALL_END);
constexpr size_t WS_W2T   = WS_W13T + (size_t)2 * FFN * D_MODEL * 2;
constexpr size_t WS_WAT   = WS_W2T + (size_t)D_MODEL * FFN * 2;
constexpr size_t WS_WBT   = WS_WAT + (size_t)D_MODEL * WA * 2;
constexpr size_t WS_WOT   = WS_WBT + (size_t)D_MODEL * WA * 2;
constexpr size_t WS_A_END = WS_WOT + (size_t)D_MODEL * D_MODEL * 2;
constexpr size_t SEGB = (size_t)MT * WA * 2;
constexpr size_t WS_QA  = WS_A_END;
constexpr size_t WS_FW  = WS_QA + SEGB;
constexpr size_t WS_FB  = WS_FW + 2 * SEGB;
constexpr size_t WS_IA  = WS_FB + 2 * SEGB;
constexpr size_t WS_GA  = WS_IA + SEGB;
constexpr size_t WS_QN  = WS_GA + (size_t)ML * WA * 2;
constexpr size_t WS_KN  = WS_QN + (size_t)ML * WA * 2;
constexpr size_t WS_VN  = WS_KN + SEGB;
constexpr size_t WS_GTA = WS_VN + SEGB;
constexpr size_t WS_GTB = WS_GTA + (size_t)ML * D_MODEL * 2;
constexpr size_t WS_D_END = WS_GTB + (size_t)ML * D_MODEL * 2;
constexpr size_t WS_WINT = WS_D_END;
constexpr size_t WS_OF   = WS_WINT;
constexpr size_t WS_OB   = WS_OF + (size_t)ML * WA * 2;
constexpr size_t WS_B_END = WS_WINT + (size_t)IN_COLS * D_MODEL * 2;
static_assert(WS_OB + (size_t)ML * WA * 2 <= WS_B_END, "B");
constexpr size_t WS_H   = WS_B_END;
constexpr size_t WS_YA  = WS_H;
constexpr size_t WS_YB  = WS_YA + (size_t)ML * WA * 2;
constexpr size_t WS_C_END = WS_H + (size_t)MT * D_MODEL * 2;
constexpr size_t WS_ACT_END = WS_D_END + (size_t)ML * FFN * 2;
constexpr size_t WS_END = WS_C_END > WS_ACT_END ? WS_C_END : WS_ACT_END;
static_assert(WS_END <= 445000000, "ws budget");
constexpr size_t WS_Z   = WS_QA;
constexpr size_t WS_XMG = WS_GTB;
constexpr size_t WS_A13 = WS_QA;
static_assert(WS_A13 + (size_t)ML * 2 * FFN * 2 <= WS_XMG, "A13 overlay");
constexpr size_t WS_ACT = WS_WINT;
static_assert(WS_ACT + (size_t)ML * FFN * 2 <= WS_END, "ACT overlay");

struct Params {
    const float *x, *c, *ctx, *c_ctx, *ada_w, *ada_b, *norm1_g, *norm2_g, *w_in, *lb_logits, *hgrn_norm_g, *q_norm_g, *k_norm_g, *rel_bias,
                *w_a, *w_b, *w_o, *w1, *w3, *conv_w, *conv_b, *w2;
    float* out;
    unsigned char* ws;
};

template <bool QKPERM>
__device__ __forceinline__ void transpose_item(const float* W, int K, int N, bf16* WT, int row_off, LAS float* scr, int item, int lane) {
    const int nblk = N / 32, kb = item / nblk, nb = item % nblk, k0 = 64 * kb, n0 = 32 * nb;
#pragma unroll 8
    for (int i = 0; i < 32; ++i) { const int kk = 2 * i + (lane >> 5); scr[kk * 33 + (lane & 31)] = W[(size_t)(k0 + kk) * N + n0 + (lane & 31)]; }
    asm volatile("s_waitcnt lgkmcnt(0)" ::: "memory");
    const int c = lane & 7;
#pragma unroll
    for (int j = 0; j < 4; ++j) { const int n = (lane >> 3) + 8 * j; const LAS float* s = scr + (8 * c) * 33 + n;
        u32x4 o; o.x = pk2(s[0 * 33], s[1 * 33]); o.y = pk2(s[2 * 33], s[3 * 33]); o.z = pk2(s[4 * 33], s[5 * 33]); o.w = pk2(s[6 * 33], s[7 * 33]);
        int cdst = n0 + n;
        if (QKPERM && cdst >= 5 * WA && cdst < 7 * WA) cdst = (cdst & ~0x30) | ((cdst & 0x10) << 1) | ((cdst & 0x20) >> 1);
        *(u32x4*)(WT + (size_t)(row_off + cdst) * K + k0 + 8 * c) = o; }
    asm volatile("s_waitcnt lgkmcnt(0)" ::: "memory");
}
__device__ __forceinline__ void phase_wconv_in(const Params& p, LAS unsigned char* lds, int gw, int NGW) {
    const int lane = threadIdx.x & 63, wave = threadIdx.x >> 6;
    LAS float* scr = (LAS float*)(lds + wave * 16384);
    constexpr int I_IN = (D_MODEL / 64) * (IN_COLS / 32);
    for (int it = gw; it < I_IN; it += NGW) transpose_item<true>(p.w_in, D_MODEL, IN_COLS, (bf16*)(p.ws + WS_WINT), 0, scr, it, lane);
}
__device__ __forceinline__ void phase_wconv_rest(const Params& p, LAS unsigned char* lds, int gw, int NGW) {
    const int lane = threadIdx.x & 63, wave = threadIdx.x >> 6;
    LAS float* scr = (LAS float*)(lds + 16384 + wave * 16384);
    constexpr int I_A = (WA / 64) * (D_MODEL / 32), I_O = (D_MODEL / 64) * (D_MODEL / 32), I_1 = (D_MODEL / 64) * (FFN / 32), I_2 = (FFN / 64) * (D_MODEL / 32);
    constexpr int NITEMS = 2 * I_A + I_O + 2 * I_1 + I_2;
    unsigned char* ws = p.ws;
    for (int it = gw; it < NITEMS; it += NGW) {
        int r = it;
        if (r < I_A) { transpose_item<false>(p.w_a, WA, D_MODEL, (bf16*)(ws + WS_WAT), 0, scr, r, lane); continue; } r -= I_A;
        if (r < I_A) { transpose_item<false>(p.w_b, WA, D_MODEL, (bf16*)(ws + WS_WBT), 0, scr, r, lane); continue; } r -= I_A;
        if (r < I_O) { transpose_item<false>(p.w_o, D_MODEL, D_MODEL, (bf16*)(ws + WS_WOT), 0, scr, r, lane); continue; } r -= I_O;
        if (r < I_1) { transpose_item<false>(p.w1, D_MODEL, FFN, (bf16*)(ws + WS_W13T), 0, scr, r, lane); continue; } r -= I_1;
        if (r < I_1) { transpose_item<false>(p.w3, D_MODEL, FFN, (bf16*)(ws + WS_W13T), FFN, scr, r, lane); continue; } r -= I_1;
        transpose_item<false>(p.w2, FFN, D_MODEL, (bf16*)(ws + WS_W2T), 0, scr, r, lane);
    }
}

__device__ __forceinline__ void phase_mod(const Params& p, LAS unsigned char* lds, int vb, int nb) {
    const int tid = threadIdx.x;
    LAS float* sc = (LAS float*)lds;
    LAS float* red = (LAS float*)(lds + 5 * 2048 * 4);
    for (int i = tid; i < 5 * D_MODEL; i += NTHREADS) { const int r = i / D_MODEL, k = i % D_MODEL; const float v = (r < 4) ? p.c[r * D_MODEL + k] : p.c_ctx[k]; sc[i] = siluf_(v); }
    __syncthreads();
    float* mod = (float*)(p.ws + WS_MOD);
    const int c4 = tid & 15, kp = tid >> 4;
    for (int item = vb; item < IN_COLS / 64; item += nb) {
        const int n0 = item * 64 + c4 * 4;
        f32x4 acc[5];
#pragma unroll
        for (int r = 0; r < 5; ++r) acc[r] = (f32x4){0.f, 0.f, 0.f, 0.f};
#pragma unroll 4
        for (int k = kp; k < D_MODEL; k += 32) {
            const f32x4 w = *(const f32x4*)(p.ada_w + (size_t)k * IN_COLS + n0);
#pragma unroll
            for (int r = 0; r < 5; ++r) acc[r] += w * sc[r * D_MODEL + k];
        }
#pragma unroll
        for (int r = 0; r < 5; ++r) *(LAS f32x4*)(red + (kp * 5 + r) * 64 + c4 * 4) = acc[r];
        __syncthreads();
        if (tid < 320) { const int r = tid / 64, cidx = tid % 64; float s = 0.f;
            for (int q = 0; q < 32; ++q) s += red[(q * 5 + r) * 64 + cidx];
            mod[r * IN_COLS + item * 64 + cidx] = s + p.ada_b[item * 64 + cidx]; }
        __syncthreads();
    }
    if (vb == nb - 1) { float* rt = (float*)(p.ws + WS_ROPE);
        for (int i = tid; i < 64 * 32; i += NTHREADS) { const int pos = i >> 5, j = i & 31; const float inv = exp2f(-(float)j * (13.287712379549449f / 32.0f)); float sn, cs; sincosf((float)pos * inv, &sn, &cs); rt[i] = cs; rt[2048 + i] = sn; } }
    if (vb == 0) { float* lb = (float*)(p.ws + WS_LB);
        for (int i = tid; i < 2 * WA; i += NTHREADS) { const int d = i / WA, cc = i % WA; const float l0 = p.lb_logits[d * 2 * WA + cc], l1 = p.lb_logits[d * 2 * WA + WA + cc]; lb[i] = 1.0f / (1.0f + expf(l1 - l0)); } }
}

__device__ __forceinline__ void phase_h(const Params& p, int vb, int nb) {
    const int tid = threadIdx.x, lane = tid & 63, wave = tid >> 6;
    const float* mod = (const float*)(p.ws + WS_MOD);
    bf16* H = (bf16*)(p.ws + WS_H);
    for (int m = vb * 8 + wave; m < MT; m += nb * 8) {
        const float* xr = (m < ML) ? p.x + (size_t)m * D_MODEL : p.ctx + (size_t)(m - ML) * D_MODEL;
        const int mr = (m < ML) ? (m / SEQ) : 4;
        const float* sh = mod + (size_t)mr * IN_COLS, *scl = sh + D_MODEL;
        f32x4 v[8]; float s = 0.f;
#pragma unroll
        for (int j = 0; j < 8; ++j) { v[j] = *(const f32x4*)(xr + 4 * lane + 256 * j); s += (v[j].x * v[j].x + v[j].y * v[j].y) + (v[j].z * v[j].z + v[j].w * v[j].w); }
        const float rstd = 1.0f / sqrtf(wave_sum(s) * (1.0f / D_MODEL) + EPS);
#pragma unroll
        for (int j = 0; j < 8; ++j) { const int k = 4 * lane + 256 * j;
            const f32x4 g = *(const f32x4*)(p.norm1_g + k), a = *(const f32x4*)(scl + k), b = *(const f32x4*)(sh + k);
            const f32x4 h = v[j] * rstd * g * (a + 1.0f) + b;
            u32x2 o; o.x = pk2(h.x, h.y); o.y = pk2(h.z, h.w);
            *(u32x2*)(H + (size_t)m * D_MODEL + k) = o; }
    }
}

#define EPI_LOOP_BEGIN \
    _Pragma("unroll") for (int ai = 0; ai < 2; ++ai) _Pragma("unroll") for (int m = 0; m < 4; ++m) { const int row = u.pm * 256 + ai * 128 + wr * 64 + m * 16 + fr; \
    _Pragma("unroll") for (int bj = 0; bj < 2; ++bj) _Pragma("unroll") for (int n = 0; n < 2; ++n) { const int col = u.pn * 256 + bj * 128 + wc * 32 + n * 16 + fq * 4; const f32x4 v = acc[ai][bj][m][n];
#define EPI_LOOP_END } }

struct EpiInProj {
    static constexpr bool PERM = false, AFTER_DRAIN = false;
    unsigned char* ws; LAS unsigned char* lds; const float* qg; const float* kg;
    __device__ __forceinline__ void operator()(const f32x4 (&acc)[2][2][4][2], const pg8::Unit& u, int wr, int wc, int fr, int fq) const {
        const int seg = u.pn >> 2;
        const bool ctxrow = u.pm >= ML / 256;
        const float* lb = (const float*)(ws + WS_LB);
        if (seg == 1 || seg == 2) {
            float* F = (float*)(ws + (seg == 1 ? WS_FW : WS_FB)); const float* lbd = lb + (seg - 1) * WA;
            EPI_LOOP_BEGIN
                const int c = col - seg * WA; const f32x4 l = *(const f32x4*)(lbd + c); f32x4 o;
                o.x = logf(l.x + (1.0f - l.x) * sigmoidf_(v.x)); o.y = logf(l.y + (1.0f - l.y) * sigmoidf_(v.y));
                o.z = logf(l.z + (1.0f - l.z) * sigmoidf_(v.z)); o.w = logf(l.w + (1.0f - l.w) * sigmoidf_(v.w));
                *(f32x4*)(F + (size_t)row * WA + c) = o;
            EPI_LOOP_END
        } else if (seg == 7) {
            bf16* VT = (bf16*)(ws + WS_VN);
            EPI_LOOP_BEGIN
                const int c = col - 7 * WA; const int hh = c >> 7, d = c & 127;
                int bb, tok; if (row < ML) { bb = row / SEQ; tok = row % SEQ; } else { bb = (row - ML) / CTX; tok = SEQ + (row - ML) % CTX; }
                bf16* o = VT + ((size_t)(bb * NHEAD + hh) * HD + d) * VT_PITCH + tok;
                o[0] = (bf16)f2bf(v.x); o[VT_PITCH] = (bf16)f2bf(v.y); o[2 * VT_PITCH] = (bf16)f2bf(v.z); o[3 * VT_PITCH] = (bf16)f2bf(v.w);
            EPI_LOOP_END
        } else if (seg == 5 || seg == 6) {
            if (ctxrow && seg == 5) return;
            LAS float* ssq = (LAS float*)(lds + 131072);
            const float* gn = (seg == 5) ? qg : kg; const float* rt = (const float*)(ws + WS_ROPE);
            bf16* O = (bf16*)(ws + (seg == 5 ? WS_QN : WS_KN));
#pragma unroll
            for (int ai = 0; ai < 2; ++ai)
#pragma unroll
                for (int m = 0; m < 4; ++m)
#pragma unroll
                    for (int bj = 0; bj < 2; ++bj) { const f32x4 a = acc[ai][bj][m][0], b = acc[ai][bj][m][1];
                        float sq = (a.x * a.x + a.y * a.y) + (a.z * a.z + a.w * a.w) + (b.x * b.x + b.y * b.y) + (b.z * b.z + b.w * b.w);
                        sq += __shfl_xor(sq, 16); sq += __shfl_xor(sq, 32);
                        if (fq == 0) ssq[((ai * 128 + wr * 64 + m * 16 + fr) * 2 + bj) * 4 + wc] = sq; }
            asm volatile("s_waitcnt lgkmcnt(0)" ::: "memory"); __builtin_amdgcn_s_barrier(); asm volatile("" ::: "memory");
            const int H = wc >> 1, jj = 16 * (wc & 1) + 4 * fq;
            const f32x4 g0 = *(const f32x4*)(gn + 64 * H + jj), g1 = *(const f32x4*)(gn + 64 * H + 32 + jj);
#pragma unroll
            for (int ai = 0; ai < 2; ++ai)
#pragma unroll
                for (int m = 0; m < 4; ++m) { const int rl = ai * 128 + wr * 64 + m * 16 + fr; const int row = u.pm * 256 + rl;
                    f32x4 cs = (f32x4){1.f, 1.f, 1.f, 1.f}, sn = (f32x4){0.f, 0.f, 0.f, 0.f};
                    if (!ctxrow) { const int t = row & (SEQ - 1); const int pos = (H == 0) ? (t >> 6) : (t & 63); cs = *(const f32x4*)(rt + pos * 32 + jj); sn = *(const f32x4*)(rt + 2048 + pos * 32 + jj); }
#pragma unroll
                    for (int bj = 0; bj < 2; ++bj) { const f32x4 s4 = *(const LAS f32x4*)(ssq + (rl * 2 + bj) * 4);
                        const float rstd = 1.0f / sqrtf(((s4.x + s4.y) + (s4.z + s4.w)) * (1.0f / HD) + EPS);
                        const f32x4 u1 = acc[ai][bj][m][0] * rstd * g0, u2 = acc[ai][bj][m][1] * rstd * g1;
                        const f32x4 o1 = u1 * cs - u2 * sn, o2 = u1 * sn + u2 * cs;
                        bf16* op = O + (size_t)row * WA + (u.pn & 3) * 256 + bj * 128 + wc * 32 + fq * 4;
                        u32x2 w1; w1.x = pk2(o1.x, o1.y); w1.y = pk2(o1.z, o1.w); *(u32x2*)op = w1;
                        u32x2 w2; w2.x = pk2(o2.x, o2.y); w2.y = pk2(o2.z, o2.w); *(u32x2*)(op + 16) = w2; }
                    asm volatile("" ::: "memory"); }
            asm volatile("s_waitcnt lgkmcnt(0)" ::: "memory"); __builtin_amdgcn_s_barrier(); asm volatile("" ::: "memory");
        } else if (seg == 0 || seg == 3) {
            if (ctxrow && seg == 0) return;
            bf16* O = (bf16*)(ws + (seg == 0 ? WS_QA : WS_IA));
            EPI_LOOP_BEGIN
                const int c = col - seg * WA; u32x2 o; o.x = pk2(v.x, v.y); o.y = pk2(v.z, v.w);
                *(u32x2*)(O + (size_t)row * WA + c) = o;
            EPI_LOOP_END
        } else if (seg == 4) {
            if (ctxrow) return;
            bf16* O = (bf16*)(ws + WS_GA);
            EPI_LOOP_BEGIN
                const int c = col - seg * WA; u32x2 o; o.x = pk2(siluf_(v.x), siluf_(v.y)); o.y = pk2(siluf_(v.z), siluf_(v.w));
                *(u32x2*)(O + (size_t)row * WA + c) = o;
            EPI_LOOP_END
        } else {
            if (ctxrow) return;
            const bool isa = seg < 10;
            bf16* O = (bf16*)(ws + (isa ? WS_GTA : WS_GTB)); const int cbase = isa ? 8 * WA : 10 * WA;
            EPI_LOOP_BEGIN
                const int c = col - cbase; u32x2 o; o.x = pk2(sigmoidf_(v.x), sigmoidf_(v.y)); o.y = pk2(sigmoidf_(v.z), sigmoidf_(v.w));
                *(u32x2*)(O + (size_t)row * D_MODEL + c) = o;
            EPI_LOOP_END
        }
    }
};

struct EpiMergeA {
    static constexpr bool PERM = false, AFTER_DRAIN = false;
    unsigned char* ws; float* tmp;
    __device__ __forceinline__ void operator()(const f32x4 (&acc)[2][2][4][2], const pg8::Unit& u, int wr, int wc, int fr, int fq) const {
        const bf16* G = (const bf16*)(ws + WS_GTA);
        EPI_LOOP_BEGIN
            const u32x2 g = *(const u32x2*)(G + (size_t)row * D_MODEL + col);
            f32x4 o; o.x = bflo(g.x) * v.x; o.y = bfhi(g.x) * v.y; o.z = bflo(g.y) * v.z; o.w = bfhi(g.y) * v.w;
            *(f32x4*)(tmp + (size_t)row * D_MODEL + col) = o;
        EPI_LOOP_END
    }
};
struct EpiMergeB {
    static constexpr bool PERM = false, AFTER_DRAIN = false;
    unsigned char* ws; const float* tmp;
    __device__ __forceinline__ void operator()(const f32x4 (&acc)[2][2][4][2], const pg8::Unit& u, int wr, int wc, int fr, int fq) const {
        const bf16* G = (const bf16*)(ws + WS_GTB); bf16* Z = (bf16*)(ws + WS_Z);
        EPI_LOOP_BEGIN
            const u32x2 g = *(const u32x2*)(G + (size_t)row * D_MODEL + col);
            const f32x4 t = *(const f32x4*)(tmp + (size_t)row * D_MODEL + col);
            u32x2 o; o.x = pk2(t.x + bflo(g.x) * v.x, t.y + bfhi(g.x) * v.y); o.y = pk2(t.z + bflo(g.y) * v.z, t.w + bfhi(g.y) * v.w);
            *(u32x2*)(Z + (size_t)row * D_MODEL + col) = o;
        EPI_LOOP_END
    }
};
struct EpiOutProj {
    static constexpr bool PERM = false, AFTER_DRAIN = false;
    unsigned char* ws; const float* x; const float* norm2_g; float* out;
    __device__ __forceinline__ void operator()(const f32x4 (&acc)[2][2][4][2], const pg8::Unit& u, int wr, int wc, int fr, int fq) const {
        const float* mod = (const float*)(ws + WS_MOD); bf16* XMG = (bf16*)(ws + WS_XMG); float* rowsq = (float*)(ws + WS_ROWSQ);
        const int b = (u.pm * 256) / SEQ;
        const float* g1 = mod + (size_t)b * IN_COLS + 2 * D_MODEL, *sc2 = mod + (size_t)b * IN_COLS + 4 * D_MODEL;
#pragma unroll
        for (int ai = 0; ai < 2; ++ai)
#pragma unroll
            for (int m = 0; m < 4; ++m) { const int row = u.pm * 256 + ai * 128 + wr * 64 + m * 16 + fr; float ss = 0.f;
#pragma unroll
                for (int bj = 0; bj < 2; ++bj)
#pragma unroll
                    for (int n = 0; n < 2; ++n) { const int col = u.pn * 256 + bj * 128 + wc * 32 + n * 16 + fq * 4; const f32x4 v = acc[ai][bj][m][n];
                        const f32x4 xv = *(const f32x4*)(x + (size_t)row * D_MODEL + col), g = *(const f32x4*)(g1 + col);
                        const f32x4 xm = xv + g * v;
                        *(f32x4*)(out + (size_t)row * D_MODEL + col) = xm;
                        ss += (xm.x * xm.x + xm.y * xm.y) + (xm.z * xm.z + xm.w * xm.w);
                        const f32x4 ng = *(const f32x4*)(norm2_g + col), s2 = *(const f32x4*)(sc2 + col);
                        const f32x4 h = xm * ng * (s2 + 1.0f);
                        u32x2 o; o.x = pk2(h.x, h.y); o.y = pk2(h.z, h.w);
                        *(u32x2*)(XMG + (size_t)row * D_MODEL + col) = o; }
                ss += __shfl_xor(ss, 16); ss += __shfl_xor(ss, 32);
                if (fq == 0) atomicAdd(rowsq + row, ss); }
    }
};
struct EpiFfnUp {
    static constexpr bool PERM = false, AFTER_DRAIN = false;
    unsigned char* ws;
    __device__ __forceinline__ void operator()(const f32x4 (&acc)[2][2][4][2], const pg8::Unit& u, int wr, int wc, int fr, int fq) const {
        const float* rowsq = (const float*)(ws + WS_ROWSQ); bf16* A13 = (bf16*)(ws + WS_A13);
        const int b = (u.pm * 256) / SEQ; const float* bias2 = (const float*)(ws + WS_BIAS2) + (size_t)b * 2 * FFN;
#pragma unroll
        for (int ai = 0; ai < 2; ++ai)
#pragma unroll
            for (int m = 0; m < 4; ++m) { const int row = u.pm * 256 + ai * 128 + wr * 64 + m * 16 + fr;
                const float rstd = 1.0f / sqrtf(__builtin_nontemporal_load(rowsq + row) * (1.0f / D_MODEL) + EPS);
#pragma unroll
                for (int bj = 0; bj < 2; ++bj)
#pragma unroll
                    for (int n = 0; n < 2; ++n) { const int col = u.pn * 256 + bj * 128 + wc * 32 + n * 16 + fq * 4; const f32x4 v = acc[ai][bj][m][n];
                        const f32x4 bb = *(const f32x4*)(bias2 + col); const f32x4 r = v * rstd + bb;
                        u32x2 o; o.x = pk2(r.x, r.y); o.y = pk2(r.z, r.w);
                        *(u32x2*)(A13 + (size_t)row * (2 * FFN) + col) = o; } }
    }
};
struct EpiFfnDown {
    static constexpr bool PERM = false, AFTER_DRAIN = false;
    unsigned char* ws; float* out;
    __device__ __forceinline__ void operator()(const f32x4 (&acc)[2][2][4][2], const pg8::Unit& u, int wr, int wc, int fr, int fq) const {
        const float* mod = (const float*)(ws + WS_MOD); const int b = (u.pm * 256) / SEQ; const float* g2 = mod + (size_t)b * IN_COLS + 5 * D_MODEL;
        EPI_LOOP_BEGIN
            float* o = out + (size_t)row * D_MODEL + col; const f32x4 xm = *(const f32x4*)o, g = *(const f32x4*)(g2 + col);
            *(f32x4*)o = xm + g * v;
        EPI_LOOP_END
    }
};

#define XB_TMO      128
#define XB_XCNT(j)  (256  + 64 * (j))
#define XB_XSUB(j)  (1280 + 64 * (j))
#define XB_XGEN(j)  (2304 + 64 * (j))
#define XB_TOP      3328
#define XB_TOPGEN   3392
#define XCD_BAR_WORDS 3456
#define XB_SPIN_CAP (1u << 18)

__device__ __forceinline__ unsigned xb_ld(unsigned* p)              { return __hip_atomic_load(p, __ATOMIC_RELAXED, __HIP_MEMORY_SCOPE_AGENT); }
__device__ __forceinline__ unsigned xb_add(unsigned* p, unsigned v) { return __hip_atomic_fetch_add(p, v, __ATOMIC_RELAXED, __HIP_MEMORY_SCOPE_AGENT); }
__device__ __forceinline__ unsigned xb_xcc_id() { return (unsigned)__builtin_amdgcn_s_getreg((3 << 11) | 20) & 0xFu; }
#define XB_SPIN(cond, bar) do { unsigned _sp = 0; while (cond) { __builtin_amdgcn_s_sleep(1); \
    if ((++_sp & 255u) == 0u) { if (xb_ld(&(bar)[XB_TMO])) break; if (_sp > XB_SPIN_CAP) { atomicAdd(&(bar)[XB_TMO], 1u); break; } } } } while (0)

struct XcdBarrier {
    unsigned* bar; unsigned x;
    volatile LAS unsigned* st;
};

__device__ __forceinline__ XcdBarrier xcd_barrier_post(unsigned* bar, volatile LAS unsigned* st) {
    XcdBarrier b; b.bar = bar; b.x = xb_xcc_id(); b.st = st;
    if (threadIdx.x == 0) (void)xb_add(&bar[XB_XCNT(b.x)], 1u);
    return b;
}
__device__ __forceinline__ void xcd_barrier_complete(unsigned* bar, unsigned x, unsigned& nloc, unsigned& nx) {
    const unsigned G = gridDim.x * gridDim.y * gridDim.z;
    unsigned sum, cnt, mine, sp = 0u;
    for (;;) {
        sum = 0u; cnt = 0u; mine = 0u;
#pragma unroll
        for (unsigned j = 0; j < 16; ++j) { const unsigned c = xb_ld(&bar[XB_XCNT(j)]); sum += c; cnt += (c > 0u) ? 1u : 0u; mine = (j == x) ? c : mine; }
        if (sum == G) break;
        __builtin_amdgcn_s_sleep(1);
        if ((++sp & 255u) == 0u) { if (xb_ld(&bar[XB_TMO])) break; if (sp > XB_SPIN_CAP) { atomicAdd(&bar[XB_TMO], 1u); break; } }
    }
    nloc = mine > 0u ? mine : 1u; nx = cnt > 0u ? cnt : 1u;
}

__device__ __forceinline__ void xcd_barrier(const XcdBarrier& b) {
    asm volatile("s_waitcnt vmcnt(0)" ::: "memory");
    __syncthreads();
    if (threadIdx.x == 0) {
        unsigned* bar = b.bar;
        __builtin_amdgcn_s_waitcnt(0);
        unsigned nloc = b.st[0], nx = b.st[1];
        if (nloc == 0u) { xcd_barrier_complete(bar, b.x, nloc, nx); b.st[0] = nloc; b.st[1] = nx; }
        const unsigned old = xb_add(&bar[XB_XSUB(b.x)], 1u);
        const unsigned gen = old / nloc;
        if (old + 1u == (gen + 1u) * nloc) {
            __builtin_amdgcn_fence(__ATOMIC_RELEASE, "agent");
            asm volatile("s_waitcnt vmcnt(0)" ::: "memory");
            const unsigned og = xb_add(&bar[XB_TOP], 1u);
            const unsigned tg = og / nx;
            if (og + 1u == (tg + 1u) * nx) xb_add(&bar[XB_TOPGEN], 1u);
            else XB_SPIN(xb_ld(&bar[XB_TOPGEN]) == tg, bar);
            __builtin_amdgcn_fence(__ATOMIC_ACQUIRE, "agent");
            xb_add(&bar[XB_XGEN(b.x)], 1u);
            asm volatile("s_waitcnt vmcnt(0)" ::: "memory");
        } else {
            XB_SPIN(xb_ld(&bar[XB_XGEN(b.x)]) == gen, bar);
            __builtin_amdgcn_fence(__ATOMIC_ACQUIRE, "agent");
            asm volatile("s_waitcnt vmcnt(0)" ::: "memory");
        }
    }
    __syncthreads();
}

constexpr size_t WS_BAR = 8192;

typedef short bf16x8 __attribute__((ext_vector_type(8)));
typedef short s16x4 __attribute__((ext_vector_type(4)));

__device__ __forceinline__ bf16x8 pack_p(const f32x4 a, const f32x4 b) {
    u32x4 w; w.x = pk2(a.x, a.y); w.y = pk2(a.z, a.w); w.z = pk2(b.x, b.y); w.w = pk2(b.z, b.w);
    return __builtin_bit_cast(bf16x8, w);
}

__device__ __forceinline__ void attn_item(const Params& p, LAS float* btab, int item, int lane) {
    const bf16* QN = (const bf16*)(p.ws + WS_QN); const bf16* KN = (const bf16*)(p.ws + WS_KN); const bf16* VT = (const bf16*)(p.ws + WS_VN);
    bf16* YB = (bf16*)(p.ws + WS_YB);
    const int qb = item & 3, r = (item >> 2) & 31, h = (item >> 7) & 7, b = item >> 10;
    const int q = lane & 15, g = lane >> 4;
    const float scale = 0.08838834764831845f;
    for (int i = lane; i < 15 * 31; i += 64) btab[i] = p.rel_bias[h * 465 + i];
    const int rs = min(max(r - 4, 0), 24), ks0 = min(max(16 * qb - 8, 0), 32);
    const int cq = 16 * qb + q, cs = min(max(cq - 8, 0), 48);
    const size_t qrow = (size_t)b * SEQ + r * GRID_W + cq;
    bf16x8 qf[4];
#pragma unroll
    for (int ks = 0; ks < 4; ++ks) qf[ks] = *(const bf16x8*)(QN + qrow * WA + h * HD + 32 * ks + 8 * g);
    asm volatile("s_waitcnt lgkmcnt(0)" ::: "memory");
    f32x4 ot[8];
#pragma unroll
    for (int db = 0; db < 8; ++db) ot[db] = (f32x4){0.f, 0.f, 0.f, 0.f};
    float mrun = -1e30f, l = 0.f;
    const bf16* vbase = VT + ((size_t)(b * NHEAD + h) * HD + q) * VT_PITCH + 4 * g;
#pragma unroll 1
    for (int gi = 0; gi < 4; ++gi) {
        const bool band = gi < 2;
        f32x4 st[8];
#pragma unroll
        for (int kb = 0; kb < 8; ++kb) {
            const size_t tok = band ? ((size_t)b * SEQ + (rs + 4 * gi + (kb >> 1)) * GRID_W + ks0 + 16 * (kb & 1) + q) : ((size_t)ML + b * CTX + 128 * (gi - 2) + 16 * kb + q);
            const bf16* kp = KN + tok * WA + h * HD + 8 * g;
            f32x4 a = (f32x4){0.f, 0.f, 0.f, 0.f};
#pragma unroll
            for (int ks = 0; ks < 4; ++ks) a = __builtin_amdgcn_mfma_f32_16x16x32_bf16(*(const bf16x8*)(kp + 32 * ks), qf[ks], a, 0, 0, 0);
            st[kb] = a;
        }
        float gm = -1e30f;
        if (band) {
#pragma unroll
            for (int kb = 0; kb < 8; ++kb) { const int dr = rs + 4 * gi + (kb >> 1) - r + 7;
#pragma unroll
                for (int j = 0; j < 4; ++j) { const int kcol = ks0 + 16 * (kb & 1) + 4 * g + j; const bool valid = (kcol >= cs) && (kcol < cs + 16);
                    const int bi = valid ? (dr * 31 + (kcol - cq + 15)) : 0;
                    const float sv = valid ? (st[kb][j] * scale + btab[bi]) : -1e30f; st[kb][j] = sv; gm = fmaxf(gm, sv); } }
        } else {
#pragma unroll
            for (int kb = 0; kb < 8; ++kb) { st[kb] = st[kb] * scale; gm = fmaxf(fmaxf(gm, fmaxf(st[kb][0], st[kb][1])), fmaxf(st[kb][2], st[kb][3])); }
        }
        gm = fmaxf(gm, __shfl_xor(gm, 16)); gm = fmaxf(gm, __shfl_xor(gm, 32));
        const float mnew = fmaxf(mrun, gm); const float alpha = __expf(mrun - mnew); mrun = mnew;
        l *= alpha;
#pragma unroll
        for (int db = 0; db < 8; ++db) ot[db] = ot[db] * alpha;
#pragma unroll
        for (int kb = 0; kb < 8; ++kb)
#pragma unroll
            for (int j = 0; j < 4; ++j) { const float sv = st[kb][j]; const float e = (sv > -1e29f) ? __expf(sv - mnew) : 0.f; st[kb][j] = e; l += e; }
#pragma unroll
        for (int kp = 0; kp < 4; ++kp) {
            const bf16x8 pb = pack_p(st[2 * kp], st[2 * kp + 1]);
            const int tokbase = band ? ((rs + 4 * gi + kp) * GRID_W + ks0) : (SEQ + 128 * (gi - 2) + 32 * kp);
#pragma unroll
            for (int db = 0; db < 8; ++db) { const bf16* vp = vbase + (size_t)(16 * db) * VT_PITCH + tokbase;
                const u32x2 lo = *(const u32x2*)vp, hi = *(const u32x2*)(vp + 16);
                const u32x4 w = (u32x4){lo.x, lo.y, hi.x, hi.y};
                ot[db] = __builtin_amdgcn_mfma_f32_16x16x32_bf16(__builtin_bit_cast(bf16x8, w), pb, ot[db], 0, 0, 0); }
        }
    }
    l += __shfl_xor(l, 16); l += __shfl_xor(l, 32);
    const float inv = 1.0f / l;
#pragma unroll
    for (int db = 0; db < 8; ++db) { const f32x4 o = ot[db] * inv; u32x2 w; w.x = pk2(o.x, o.y); w.y = pk2(o.z, o.w);
        *(u32x2*)(YB + qrow * WA + h * HD + 16 * db + 4 * g) = w; }
    asm volatile("s_waitcnt lgkmcnt(0)" ::: "memory");
}

constexpr size_t WS_ATTCTR = 32768;
static_assert(WS_ATTCTR >= WS_BAR + XCD_BAR_WORDS * 4 && WS_ATTCTR + 4 <= WS_ROWSQ, "attn counter inside ctl");
__device__ __forceinline__ void phase_attn(const Params& p, LAS unsigned char* lds) {
    const int lane = threadIdx.x & 63, wave = threadIdx.x >> 6;
    LAS float* btab = (LAS float*)(lds + wave * 2048);
    unsigned* ctr = (unsigned*)(p.ws + WS_ATTCTR);
    for (;;) {
        unsigned it = 0;
        if (lane == 0) it = atomicAdd(ctr, 1u);
        it = (unsigned)__builtin_amdgcn_readfirstlane((int)it);
        if (it >= (unsigned)(BATCH * NHEAD * 32 * 4)) break;
        attn_item(p, btab, (int)it, lane);
    }
}

constexpr int HP = 160;
constexpr int H_QH = 0, H_KH = 20480, H_KE = 40960, H_QD = 61440, H_KD = 81920;
constexpr int HP2 = 48;
constexpr int H_Q2 = 102400, H_K2 = 108544;
constexpr int VP = 288;
constexpr int H_V = 114688;
constexpr int PP = 144;
constexpr int H_P = 133120;
constexpr int H_T = 142336;
constexpr int H_D = 144384;
constexpr int H_END = 144896;

__device__ __forceinline__ s16x4 lds_tr(LAS const unsigned char* p) {
    return __builtin_bit_cast(s16x4, __builtin_amdgcn_ds_read_tr16_b64_v4i16((LAS s16x4*)p));
}
__device__ __forceinline__ bf16x8 cat8(const s16x4 a, const s16x4 b) { return __builtin_shufflevector(a, b, 0, 1, 2, 3, 4, 5, 6, 7); }
__device__ __forceinline__ bf16x8 cat8u(const u32x2 a, const u32x2 b) { const u32x4 w = (u32x4){a.x, a.y, b.x, b.y}; return __builtin_bit_cast(bf16x8, w); }

__device__ __forceinline__ size_t hg_row(int dir, int b, int tau) {
    if (tau < CTX) return (size_t)ML + b * CTX + (dir == 0 ? tau : CTX - 1 - tau);
    const int t = tau - CTX; return (size_t)b * SEQ + (dir == 0 ? t : SEQ - 1 - t);
}

__device__ __forceinline__ void hgrn_item(const Params& p, LAS unsigned char* lds, int item) {
    const int tid = threadIdx.x, lane = tid & 63, wave = __builtin_amdgcn_readfirstlane(tid >> 6);
    const int k = tid & 127, J = __builtin_amdgcn_readfirstlane(tid >> 7);
    const int li = lane & 15, g = lane >> 4, qq = li >> 2, pp = li & 3;
    const int dir = item / (BATCH * NHEAD), b = (item / NHEAD) % BATCH, h = item % NHEAD;
    const float* LF = (const float*)(p.ws + (dir == 0 ? WS_FW : WS_FB)) + h * HD + k;
    const bf16* QA = (const bf16*)(p.ws + WS_QA) + h * HD + k;
    const bf16* IA = (const bf16*)(p.ws + WS_IA) + h * HD;
    bf16* O = (bf16*)(p.ws + (dir == 0 ? WS_OF : WS_OB)) + h * HD + 16 * wave + li;
    LAS float* Tl = (LAS float*)(lds + H_T); LAS float* Dl = (LAS float*)(lds + H_D);

    f32x4 S[8];
#pragma unroll
    for (int i = 0; i < 8; ++i) S[i] = (f32x4){0.f, 0.f, 0.f, 0.f};

    float lf[16]; unsigned qv[16]; u32x4 vreg[2];
#define HG_LOAD_CHUNK(c_) do { const int cc_ = (c_); \
        _Pragma("unroll") for (int i = 0; i < 16; ++i) { const size_t row = hg_row(dir, b, 64 * cc_ + 16 * J + i); lf[i] = LF[row * WA]; qv[i] = (cc_ >= 4) ? (unsigned)QA[row * WA] : 0u; } \
        _Pragma("unroll") for (int e = 0; e < 2; ++e) { const int idx = tid * 2 + e; const size_t row = hg_row(dir, b, 64 * cc_ + (idx >> 4)); vreg[e] = *(const u32x4*)(IA + row * WA + 8 * (idx & 15)); } } while (0)
    HG_LOAD_CHUNK(0);
    constexpr int NCH = (CTX + SEQ) / 64;
    for (int c = 0; c < NCH; ++c) {
        float cum[16]; float run = 0.f;
#pragma unroll
        for (int i = 0; i < 16; ++i) { run += lf[i]; cum[i] = run; }
        Tl[J * 128 + k] = run;
        __syncthreads();
        const float T0 = Tl[k], T1 = Tl[128 + k], T2 = Tl[256 + k], T3 = Tl[384 + k];
        const float bJ = (J > 0 ? T0 : 0.f) + (J > 1 ? T1 : 0.f) + (J > 2 ? T2 : 0.f);
        const float tail = (J < 1 ? T1 : 0.f) + (J < 2 ? T2 : 0.f) + (J < 3 ? T3 : 0.f);
        const float eb = __expf(bJ), et = __expf(tail), eT = __expf(run);
        const float x2 = (J == 3) ? __expf(T2) : __expf(T1);
        float qh[16], kh[16];
#pragma unroll
        for (int i = 0; i < 16; ++i) { const float e1 = __expf(cum[i]); const float r1 = 1.0f / e1; const float kk = 1.0f - __expf(lf[i]);
            qh[i] = __builtin_bit_cast(float, qv[i] << 16) * e1; kh[i] = kk * r1; }
        {
            LAS unsigned char* rowp = lds + k * HP + 32 * J;
            u32x4 w0, w1;
#define HG_WRITE(OFF, EXPR) do { \
            { float v0_, v1_; \
              { const int i = 0; v0_ = (EXPR); } { const int i = 1; v1_ = (EXPR); } w0.x = pk2(v0_, v1_); \
              { const int i = 2; v0_ = (EXPR); } { const int i = 3; v1_ = (EXPR); } w0.y = pk2(v0_, v1_); \
              { const int i = 4; v0_ = (EXPR); } { const int i = 5; v1_ = (EXPR); } w0.z = pk2(v0_, v1_); \
              { const int i = 6; v0_ = (EXPR); } { const int i = 7; v1_ = (EXPR); } w0.w = pk2(v0_, v1_); \
              { const int i = 8; v0_ = (EXPR); } { const int i = 9; v1_ = (EXPR); } w1.x = pk2(v0_, v1_); \
              { const int i = 10; v0_ = (EXPR); } { const int i = 11; v1_ = (EXPR); } w1.y = pk2(v0_, v1_); \
              { const int i = 12; v0_ = (EXPR); } { const int i = 13; v1_ = (EXPR); } w1.z = pk2(v0_, v1_); \
              { const int i = 14; v0_ = (EXPR); } { const int i = 15; v1_ = (EXPR); } w1.w = pk2(v0_, v1_); } \
            *(LAS u32x4*)(OFF) = w0; *(LAS u32x4*)((OFF) + 16) = w1; } while (0)
            HG_WRITE(rowp + H_QH, qh[i]);
            HG_WRITE(rowp + H_KH, kh[i]);
            HG_WRITE(rowp + H_KE, kh[i] * eT);
            HG_WRITE(rowp + H_QD, qh[i] * eb);
            HG_WRITE(rowp + H_KD, kh[i] * (eT * et));
            if (J == 3) { HG_WRITE(lds + H_Q2 + k * HP2, qh[i] * x2); }
            if (J == 0) { HG_WRITE(lds + H_K2 + k * HP2, kh[i] * (eT * x2)); }
#undef HG_WRITE
            if (J == 3) Dl[k] = __expf(bJ + run);
        }
#pragma unroll
        for (int e = 0; e < 2; ++e) { const int idx = tid * 2 + e; *(LAS u32x4*)(lds + H_V + (idx >> 4) * VP + 16 * (idx & 15)) = vreg[e]; }
        if (c + 1 < NCH) HG_LOAD_CHUNK(c + 1);
        __syncthreads();
        const bool lat = (c >= 4);
        if (lat) {
#pragma unroll
            for (int rep = 0; rep < 2; ++rep) {
                int I, Jb;
                if (rep == 0) { I = (wave < 4) ? wave : (wave == 4 ? 1 : (wave == 7 ? 3 : 2)); Jb = (wave < 4) ? wave : (wave == 4 ? 0 : (wave == 5 ? 0 : (wave == 6 ? 1 : 2))); }
                else { if (wave >= 2) break; I = 3; Jb = wave; }
                int aoff, apitch, acol, boff, bpitch, bcol;
                if (I == Jb) { aoff = H_KH; apitch = HP; acol = 16 * Jb; boff = H_QH; bpitch = HP; bcol = 16 * I; }
                else if (I == Jb + 1 && I != 2) { aoff = H_KE; apitch = HP; acol = 16 * Jb; boff = H_QH; bpitch = HP; bcol = 16 * I; }
                else if (I == 2) { if (Jb == 0) { aoff = H_K2; apitch = HP2; acol = 0; } else { aoff = H_KE; apitch = HP; acol = 16; } boff = H_QH; bpitch = HP; bcol = 32; }
                else { if (Jb == 0) { aoff = H_K2; apitch = HP2; acol = 0; } else { aoff = H_KE; apitch = HP; acol = 16; } boff = H_Q2; bpitch = HP2; bcol = 0; }
                f32x4 pt = (f32x4){0.f, 0.f, 0.f, 0.f};
#pragma unroll
                for (int ks = 0; ks < 4; ++ks) {
                    const int r0 = 32 * ks + 4 * g + qq;
                    const bf16x8 a = cat8(lds_tr(lds + aoff + r0 * apitch + (acol + 4 * pp) * 2), lds_tr(lds + aoff + (r0 + 16) * apitch + (acol + 4 * pp) * 2));
                    const bf16x8 bb = cat8(lds_tr(lds + boff + r0 * bpitch + (bcol + 4 * pp) * 2), lds_tr(lds + boff + (r0 + 16) * bpitch + (bcol + 4 * pp) * 2));
                    pt = __builtin_amdgcn_mfma_f32_16x16x32_bf16(a, bb, pt, 0, 0, 0);
                }
                if (I == Jb) {
#pragma unroll
                    for (int j = 0; j < 4; ++j) if (4 * g + j > li) pt[j] = 0.f;
                }
                u32x2 w; w.x = pk2(pt.x, pt.y); w.y = pk2(pt.z, pt.w);
                *(LAS u32x2*)(lds + H_P + (16 * I + li) * PP + (16 * Jb + 4 * g) * 2) = w;
            }
        }
        __syncthreads();
        bf16x8 vf[2];
#pragma unroll
        for (int sp = 0; sp < 2; ++sp) {
            const LAS unsigned char* vb0 = lds + H_V + (32 * sp + 4 * g + qq) * VP + (16 * wave + 4 * pp) * 2;
            vf[sp] = cat8(lds_tr(vb0), lds_tr(vb0 + 16 * VP));
        }
        if (lat) {
            bf16x8 sb[4];
#pragma unroll
            for (int ks = 0; ks < 4; ++ks) sb[ks] = pack_p(S[2 * ks], S[2 * ks + 1]);
#pragma unroll
            for (int I = 0; I < 4; ++I) {
                f32x4 o = (f32x4){0.f, 0.f, 0.f, 0.f};
#pragma unroll
                for (int ks = 0; ks < 4; ++ks) {
                    const LAS unsigned char* ap = lds + H_QD + (32 * ks + 4 * g + qq) * HP + (16 * I + 4 * pp) * 2;
                    o = __builtin_amdgcn_mfma_f32_16x16x32_bf16(cat8(lds_tr(ap), lds_tr(ap + 16 * HP)), sb[ks], o, 0, 0, 0);
                }
#pragma unroll
                for (int sp = 0; sp < 2; ++sp) {
                    if (2 * sp > I) break;
                    const LAS unsigned char* pr = lds + H_P + (16 * I + li) * PP + (32 * sp + 4 * g) * 2;
                    const u32x2 lo = *(const LAS u32x2*)pr; u32x2 hi = (u32x2){0u, 0u};
                    if (2 * sp + 1 <= I) hi = *(const LAS u32x2*)(pr + 32);
                    o = __builtin_amdgcn_mfma_f32_16x16x32_bf16(cat8u(lo, hi), vf[sp], o, 0, 0, 0);
                }
#pragma unroll
                for (int j = 0; j < 4; ++j) { const size_t row = hg_row(dir, b, 64 * c + 16 * I + 4 * g + j); O[row * WA] = (bf16)f2bf(o[j]); }
            }
        }
#pragma unroll
        for (int blk = 0; blk < 8; ++blk) {
            const f32x4 d4 = *(const LAS f32x4*)(Dl + 16 * blk + 4 * g);
            f32x4 s = S[blk] * d4;
#pragma unroll
            for (int sp = 0; sp < 2; ++sp) {
                const LAS unsigned char* kp = lds + H_KD + (16 * blk + li) * HP + (32 * sp + 4 * g) * 2;
                s = __builtin_amdgcn_mfma_f32_16x16x32_bf16(cat8u(*(const LAS u32x2*)kp, *(const LAS u32x2*)(kp + 32)), vf[sp], s, 0, 0, 0);
            }
            S[blk] = s;
        }
    }
    __syncthreads();
#undef HG_LOAD_CHUNK
}
__device__ __forceinline__ void phase_readout(const Params& p, int vb, int nb) {
    const int tid = threadIdx.x, lane = tid & 63, wave = tid >> 6;
    const bf16* OF = (const bf16*)(p.ws + WS_OF); const bf16* OB = (const bf16*)(p.ws + WS_OB); const bf16* GA = (const bf16*)(p.ws + WS_GA);
    bf16* YA = (bf16*)(p.ws + WS_YA);
    for (int it = vb * 8 + wave; it < ML * NHEAD; it += nb * 8) {
        const int row = it / NHEAD, h = it % NHEAD; const size_t off = (size_t)row * WA + h * HD + 2 * lane;
        const unsigned a = *(const unsigned*)(OF + off), b = *(const unsigned*)(OB + off), g = *(const unsigned*)(GA + off);
        const float o0 = bflo(a) + bflo(b), o1 = bfhi(a) + bfhi(b);
        const float rstd = 1.0f / sqrtf(wave_sum(o0 * o0 + o1 * o1) * (1.0f / HD) + EPS);
        const float y0 = o0 * rstd * p.hgrn_norm_g[2 * lane] * bflo(g), y1 = o1 * rstd * p.hgrn_norm_g[2 * lane + 1] * bfhi(g);
        *(unsigned*)(YA + off) = pk2(y0, y1);
    }
}

__device__ __forceinline__ void phase_bias2(const Params& p, int vb, int nb) {
    const int tid = threadIdx.x; const float* mod = (const float*)(p.ws + WS_MOD); float* bias2 = (float*)(p.ws + WS_BIAS2);
    constexpr int NCC = 2 * FFN / 512, NKC = D_MODEL / 64;
    for (int item = vb; item < NCC * NKC; item += nb) {
        const int cc = item % NCC, kc = item / NCC; const int col = cc * 512 + tid;
        const float* W = (col < FFN) ? p.w1 + col : p.w3 + (col - FFN);
        float a0 = 0.f, a1 = 0.f, a2 = 0.f, a3 = 0.f;
#pragma unroll 8
        for (int k = kc * 64; k < kc * 64 + 64; ++k) { const float w = W[(size_t)k * FFN];
            a0 += w * mod[0 * IN_COLS + 3 * D_MODEL + k]; a1 += w * mod[1 * IN_COLS + 3 * D_MODEL + k]; a2 += w * mod[2 * IN_COLS + 3 * D_MODEL + k]; a3 += w * mod[3 * IN_COLS + 3 * D_MODEL + k]; }
        atomicAdd(bias2 + 0 * 2 * FFN + col, a0); atomicAdd(bias2 + 1 * 2 * FFN + col, a1); atomicAdd(bias2 + 2 * 2 * FFN + col, a2); atomicAdd(bias2 + 3 * 2 * FFN + col, a3);
    }
}

__device__ __forceinline__ void phase_conv(const Params& p, int vb, int nb) {
    const int tid = threadIdx.x; const bf16* A13 = (const bf16*)(p.ws + WS_A13); bf16* ACT = (bf16*)(p.ws + WS_ACT);
    constexpr int CPR = FFN / 8;
    const size_t total = (size_t)ML * CPR;
    for (size_t i = (size_t)vb * NTHREADS + tid; i < total; i += (size_t)nb * NTHREADS) {
        const int row = (int)(i / CPR), c = (int)(i % CPR) * 8; const int t = row % SEQ;
        const bf16* ap = A13 + (size_t)row * (2 * FFN) + c;
        const u32x4 a1 = *(const u32x4*)ap; const u32x4 g = *(const u32x4*)(ap + FFN);
        u32x4 a0 = (u32x4){0u, 0u, 0u, 0u}, a2 = (u32x4){0u, 0u, 0u, 0u};
        if (t > 0) a0 = *(const u32x4*)(ap - 2 * FFN);
        if (t < SEQ - 1) a2 = *(const u32x4*)(ap + 2 * FFN);
        float w0[8], w1[8], w2[8], cb[8];
#pragma unroll
        for (int e = 0; e < 8; ++e) { w0[e] = p.conv_w[c + e]; w1[e] = p.conv_w[FFN + c + e]; w2[e] = p.conv_w[2 * FFN + c + e]; cb[e] = p.conv_b[c + e]; }
        float r[8];
#pragma unroll
        for (int q = 0; q < 4; ++q) {
            const unsigned x0 = a0[q], x1 = a1[q], x2 = a2[q], gg = g[q];
            const float u0 = bflo(x0) * w0[2 * q] + bflo(x1) * w1[2 * q] + bflo(x2) * w2[2 * q] + cb[2 * q];
            const float u1 = bfhi(x0) * w0[2 * q + 1] + bfhi(x1) * w1[2 * q + 1] + bfhi(x2) * w2[2 * q + 1] + cb[2 * q + 1];
            r[2 * q] = siluf_(u0) * bflo(gg); r[2 * q + 1] = siluf_(u1) * bfhi(gg);
        }
        u32x4 o; o.x = pk2(r[0], r[1]); o.y = pk2(r[2], r[3]); o.z = pk2(r[4], r[5]); o.w = pk2(r[6], r[7]);
        *(u32x4*)(ACT + (size_t)row * FFN + c) = o;
    }
}


constexpr int LDS_MISC_OFF = 145408;
constexpr int LDS_BYTES = 146432;
static_assert(WS_BAR + XCD_BAR_WORDS * 4 <= WS_ROWSQ, "barrier words inside ctl");

__global__ void __launch_bounds__(NTHREADS, 2) mega_fwd(Params p) {
    extern __shared__ __attribute__((aligned(16))) unsigned char lds_raw[];
    LAS unsigned char* lds = (LAS unsigned char*)lds_raw;
    const int nb = gridDim.x;
    const int vb = (nb % 8 == 0) ? ((int)(blockIdx.x % 8) * (nb / 8) + (int)(blockIdx.x / 8)) : (int)blockIdx.x;
    const int bx = blockIdx.x;
    unsigned char* ws = p.ws;
    volatile LAS unsigned* misc = (volatile LAS unsigned*)(lds + LDS_MISC_OFF);
    if (threadIdx.x < 64) misc[threadIdx.x] = 0u;
    __syncthreads();
    XcdBarrier bar = xcd_barrier_post((unsigned*)(ws + WS_BAR), misc + 8);
#define GRID_BAR() xcd_barrier(bar)

    phase_mod(p, lds, vb, nb);
    __syncthreads();
    phase_wconv_in(p, lds, vb * 8 + (int)(threadIdx.x >> 6), nb * 8);
    GRID_BAR();
    phase_h(p, vb, nb);
    phase_bias2(p, vb, nb);
    GRID_BAR();
    { pg8::Gemm g{(const bf16*)(ws + WS_H), (const bf16*)(ws + WS_WINT), MT, IN_COLS, D_MODEL}; pg8::StaticOrder S; S.init(MT, IN_COLS, nb, bx);
      EpiInProj E{ws, lds, p.q_norm_g, p.k_norm_g}; pg8::gemm_phase<EpiInProj, pg8::StaticOrder, true, true>(lds, g, S, E); }
    GRID_BAR();
    if (bx < 2 * BATCH * NHEAD) hgrn_item(p, lds, bx);
    __syncthreads();
    phase_attn(p, lds);
    if (bx >= 2 * BATCH * NHEAD) phase_wconv_rest(p, lds, (bx - 2 * BATCH * NHEAD) * 8 + (int)(threadIdx.x >> 6), (nb - 2 * BATCH * NHEAD) * 8);
    GRID_BAR();
    phase_readout(p, vb, nb);
    GRID_BAR();
    { pg8::Gemm g{(const bf16*)(ws + WS_YA), (const bf16*)(ws + WS_WAT), ML, D_MODEL, WA}; pg8::StaticOrder S; S.init(ML, D_MODEL, nb, bx);
      EpiMergeA E{ws, p.out}; pg8::gemm_phase<EpiMergeA, pg8::StaticOrder, true, true>(lds, g, S, E); }
    GRID_BAR();
    { pg8::Gemm g{(const bf16*)(ws + WS_YB), (const bf16*)(ws + WS_WBT), ML, D_MODEL, WA}; pg8::StaticOrder S; S.init(ML, D_MODEL, nb, bx);
      EpiMergeB E{ws, p.out}; pg8::gemm_phase<EpiMergeB, pg8::StaticOrder, true, true>(lds, g, S, E); }
    GRID_BAR();
    { pg8::Gemm g{(const bf16*)(ws + WS_Z), (const bf16*)(ws + WS_WOT), ML, D_MODEL, D_MODEL}; pg8::StaticOrder S; S.init(ML, D_MODEL, nb, bx);
      EpiOutProj E{ws, p.x, p.norm2_g, p.out}; pg8::gemm_phase<EpiOutProj, pg8::StaticOrder, true, true>(lds, g, S, E); }
    GRID_BAR();
    { pg8::Gemm g{(const bf16*)(ws + WS_XMG), (const bf16*)(ws + WS_W13T), ML, 2 * FFN, D_MODEL}; pg8::StaticOrder S; S.init(ML, 2 * FFN, nb, bx);
      EpiFfnUp E{ws}; pg8::gemm_phase<EpiFfnUp, pg8::StaticOrder, true, true>(lds, g, S, E); }
    GRID_BAR();
    phase_conv(p, vb, nb);
    GRID_BAR();
    { pg8::Gemm g{(const bf16*)(ws + WS_ACT), (const bf16*)(ws + WS_W2T), ML, D_MODEL, FFN}; pg8::StaticOrder S; S.init(ML, D_MODEL, nb, bx);
      EpiFfnDown E{ws, p.out}; pg8::gemm_phase<EpiFfnDown, pg8::StaticOrder, true, true>(lds, g, S, E); }
#undef GRID_BAR
}

extern "C" void kernel_launch(void* const* d_in, const int* in_sizes, int n_in, void* d_out, int out_size, void* d_ws, size_t ws_size, hipStream_t stream) {
    static int grid = 0;
    if (grid == 0) {
        if (n_in != 22 || ws_size < WS_END || out_size != ML * D_MODEL) { fprintf(stderr, "kernel_launch: bad inputs (n_in %d, out %d, ws %zu, need %zu)\n", n_in, out_size, ws_size, (size_t)WS_END); grid = -1; return; }
        int dev = 0, cus = 0, per_cu = 0;
        if (hipGetDevice(&dev) != hipSuccess || hipDeviceGetAttribute(&cus, hipDeviceAttributeMultiprocessorCount, dev) != hipSuccess) { grid = -1; return; }
        if (hipFuncSetAttribute((const void*)mega_fwd, hipFuncAttributeMaxDynamicSharedMemorySize, LDS_BYTES) != hipSuccess) { fprintf(stderr, "kernel_launch: hipFuncSetAttribute failed\n"); grid = -1; return; }
        if (hipOccupancyMaxActiveBlocksPerMultiprocessor(&per_cu, (const void*)mega_fwd, NTHREADS, LDS_BYTES) != hipSuccess || per_cu < 1) { fprintf(stderr, "kernel_launch: occupancy query says %d blocks/CU\n", per_cu); (void)hipGetLastError(); grid = -1; return; }
        grid = cus;
        fprintf(stderr, "kernel_launch: grid %d (cus %d, occupancy %d/CU)\n", grid, cus, per_cu);
    }
    if (grid < 0) return;
    Params p{};
    const float** f = (const float**)&p;
    for (int i = 0; i < 22; ++i) f[i] = (const float*)d_in[i];
    p.out = (float*)d_out; p.ws = (unsigned char*)d_ws;
    (void)hipMemsetAsync((char*)d_ws + WS_CTL, 0, CTL_ZERO_BYTES, stream);
    hipLaunchKernelGGL(mega_fwd, dim3(grid), dim3(NTHREADS), LDS_BYTES, stream, p);
}
```

```cpp
#include <hip/hip_runtime.h>
#include <cstdio>
#include <cstdint>
#include <cmath>
namespace pg8 {
#define PG8_LAS __attribute__((address_space(3)))
typedef unsigned short bf16_t;
typedef short bf16x8 __attribute__((ext_vector_type(8)));
typedef float f32x4 __attribute__((ext_vector_type(4)));
typedef unsigned u32x4 __attribute__((ext_vector_type(4)));
constexpr int BM = 256, BK = 64, HALF = 128, HTB = HALF * BK * 2  , STAGE_BYTES = 8 * HTB, NXCD = 8, WGM = 8;

__host__ __device__ __forceinline__ int lds_byte(int r, int c) { const int st = (r >> 4) * 2 + (c >> 5), rr = r & 15, cc = c & 31, ob = rr * 64 + cc * 2; return st * 1024 + (ob ^ (((ob >> 9) & 1) << 5)); }
__host__ __device__ __forceinline__ void stage_rc(int b, int& R, int& C) { const int st = b / 1024, sb = b % 1024, swz = sb ^ (((sb >> 9) & 1) << 5); R = (st >> 1) * 16 + swz / 64; C = (st & 1) * 32 + (swz % 64) / 2; }
__host__ __device__ __forceinline__ int perm32(int rho) { const int n = rho >> 4, i = rho & 15; return 8 * (i >> 2) + 4 * n + (i & 3); }

struct Unit { int pm, pn; };
struct Gemm { const bf16_t* A; const bf16_t* Bt; int M, N, K; };

struct StaticOrder {
    int nM, nN, nwg, G, c;
    __host__ __device__ void init(int M, int N, int G_, int c_) { nM = M / BM; nN = N / BM; nwg = nM * nN; G = G_; c = c_; }
    __host__ __device__ bool next(int i, Unit& u) const {
        const long L = (long)i * G + c; if (L >= nwg) return false;
        int wgid = (int)L; { const int q = nwg / NXCD, r = nwg % NXCD, xcd = wgid % NXCD, off = wgid / NXCD; wgid = (xcd < r ? xcd * (q + 1) : r * (q + 1) + (xcd - r) * q) + off; }
        const int nig = WGM * nN, gid = wgid / nig, fm = gid * WGM, gsz = (nM - fm) < WGM ? (nM - fm) : WGM;
        u.pm = fm + ((wgid % nig) % gsz); u.pn = (wgid % nig) / gsz; return true;
    }
    __device__ __forceinline__ void a_ready(const Unit&) const {}
    __device__ __forceinline__ void done(const Unit&) const {}
};

template <class Epi, class Sched, bool ALIGN_EPI = false, bool SP2 = false>
__device__ __forceinline__ void gemm_phase(PG8_LAS unsigned char* lds, const Gemm g, const Sched& S, const Epi& E) {
    const int tid = threadIdx.x, wid = __builtin_amdgcn_readfirstlane(tid >> 6), lane = tid & 63, wr = wid >> 2, wc = wid & 3, fr = lane & 15, fq = lane >> 4;
    const int K = g.K, nt = K / BK;
    unsigned voffA[2], voffB[2];
#pragma unroll
    for (int i = 0; i < 2; ++i) { int R, C; stage_rc(tid * 16 + i * 8192, R, C); const int Rb = Epi::PERM ? ((R & ~31) + perm32(R & 31)) : R;
        voffA[i] = (unsigned)(R * K + C) * 2u; voffB[i] = (unsigned)(Rb * K + C) * 2u; }
    const size_t kstep = (size_t)(BK * 2);
    const size_t hstep = (size_t)HALF * K * 2;
    const size_t tstep = 2 * hstep;
    const unsigned ldsw = (unsigned)wid * 1024u;
    const int aoff = lds_byte(wr * 64 + fr, fq * 8), boff = lds_byte(wc * 32 + fr, fq * 8);
#define PG8_SA(b, h) (((b) * 2 + (h)) * HTB)
#define PG8_SB(b, h) ((4 + (b) * 2 + (h)) * HTB)
#define PG8_STAGE(bufoff, gbase, voff) do { _Pragma("unroll") for (int _i = 0; _i < 2; ++_i) \
        __builtin_amdgcn_global_load_lds((const unsigned*)((const char*)(gbase) + (voff)[_i]), (PG8_LAS unsigned*)(lds + (bufoff) + ldsw + _i * 8192), 16, 0, 0); } while (0)
#define PG8_LDA(dst, b, h) do { _Pragma("unroll") for (int m = 0; m < 4; ++m) _Pragma("unroll") for (int k = 0; k < 2; ++k) dst[m][k] = *(const PG8_LAS bf16x8*)(lds + PG8_SA(b, h) + aoff + m * 2048 + k * 1024); } while (0)
#define PG8_LDB(dst, b, h) do { _Pragma("unroll") for (int n = 0; n < 2; ++n) _Pragma("unroll") for (int k = 0; k < 2; ++k) dst[n][k] = *(const PG8_LAS bf16x8*)(lds + PG8_SB(b, h) + boff + n * 2048 + k * 1024); } while (0)
#define PG8_MMA(ai, bj, At, Bt) do { __builtin_amdgcn_s_setprio(1); _Pragma("unroll") for (int m = 0; m < 4; ++m) _Pragma("unroll") for (int n = 0; n < 2; ++n) _Pragma("unroll") for (int k = 0; k < 2; ++k) \
        acc[ai][bj][m][n] = __builtin_amdgcn_mfma_f32_16x16x32_bf16(Bt[n][k], At[m][k], acc[ai][bj][m][n], 0, 0, 0); __builtin_amdgcn_s_setprio(0); } while (0)
#define PG8_WAIT_V(n) asm volatile("s_waitcnt vmcnt(" #n ")" ::: "memory")
#define PG8_WAIT_L(n) asm volatile("s_waitcnt lgkmcnt(" #n ")" ::: "memory")
#define PG8_BAR __builtin_amdgcn_s_barrier()
#define PG8_SCHED __builtin_amdgcn_sched_barrier(0)
    Unit cur, nxt; int ui = 0;
    if (!S.next(0, cur)) return;
    f32x4 acc[2][2][4][2];
#pragma unroll
    for (int a = 0; a < 2; ++a)
#pragma unroll
        for (int b = 0; b < 2; ++b)
#pragma unroll
            for (int m = 0; m < 4; ++m)
#pragma unroll
                for (int n = 0; n < 2; ++n) acc[a][b][m][n] = (f32x4){0.f, 0.f, 0.f, 0.f};
    bf16x8 At[4][2], B0[2][2], B1[2][2];
    const char* cA = (const char*)g.A + (size_t)cur.pm * tstep; const char* cB = (const char*)g.Bt + (size_t)cur.pn * tstep;
    S.a_ready(cur);
    if constexpr (SP2) {
        PG8_STAGE(PG8_SB(0, 0), cB, voffB); PG8_STAGE(PG8_SB(0, 1), cB + hstep, voffB); PG8_STAGE(PG8_SA(0, 0), cA, voffA); PG8_STAGE(PG8_SA(0, 1), cA + hstep, voffA);
        if (wr == 1) PG8_BAR;
        PG8_WAIT_V(2); PG8_BAR;
        PG8_STAGE(PG8_SB(1, 0), cB + kstep, voffB); PG8_STAGE(PG8_SA(1, 0), cA + kstep, voffA); PG8_STAGE(PG8_SB(1, 1), cB + hstep + kstep, voffB);
        PG8_WAIT_V(6); PG8_BAR;
    } else {
        PG8_STAGE(PG8_SB(0, 0), cB, voffB); PG8_STAGE(PG8_SA(0, 0), cA, voffA); PG8_STAGE(PG8_SB(0, 1), cB + hstep, voffB); PG8_STAGE(PG8_SA(0, 1), cA + hstep, voffA);
        if (wr == 1) PG8_BAR;
        PG8_WAIT_V(4); PG8_BAR;
        PG8_STAGE(PG8_SB(1, 0), cB + kstep, voffB); PG8_STAGE(PG8_SA(1, 0), cA + kstep, voffA); PG8_STAGE(PG8_SB(1, 1), cB + hstep + kstep, voffB);
        PG8_WAIT_V(6); PG8_BAR;
    }
    for (;;) {
        const bool has_next = S.next(ui + 1, nxt);
        const char* nA = has_next ? (const char*)g.A + (size_t)nxt.pm * tstep : cA; const char* nB = has_next ? (const char*)g.Bt + (size_t)nxt.pn * tstep : cB;
        for (int t = 0; t < nt; t += 2) {
            const bool last = (t == nt - 2);
            const char* a1 = cA + (size_t)(t + 1) * kstep;
            const char* a2 = last ? nA : cA + (size_t)(t + 2) * kstep; const char* b2 = last ? nB : cB + (size_t)(t + 2) * kstep;
            const char* a3 = a2 + kstep; const char* b3 = b2 + kstep;
            if (last && has_next) S.a_ready(nxt);
            if constexpr (SP2) {
            PG8_LDB(B0, 0, 0); PG8_LDB(B1, 0, 1); PG8_SCHED; PG8_LDA(At, 0, 0); PG8_STAGE(PG8_SA(1, 1), a1 + hstep, voffA);
            PG8_WAIT_V(8); PG8_WAIT_L(0); PG8_BAR; PG8_MMA(0, 0, At, B0); PG8_MMA(0, 1, At, B1); PG8_BAR; PG8_SCHED;
            PG8_LDA(At, 0, 1); PG8_STAGE(PG8_SB(0, 0), b2, voffB); PG8_STAGE(PG8_SB(0, 1), b2 + hstep, voffB); PG8_STAGE(PG8_SA(0, 0), a2, voffA);
            PG8_WAIT_V(8); PG8_WAIT_L(0); PG8_BAR; PG8_MMA(1, 0, At, B0); PG8_MMA(1, 1, At, B1); PG8_BAR; PG8_SCHED;
            PG8_LDB(B0, 1, 0); PG8_LDB(B1, 1, 1); PG8_SCHED; PG8_LDA(At, 1, 0); PG8_STAGE(PG8_SA(0, 1), a2 + hstep, voffA);
            PG8_WAIT_V(8); PG8_WAIT_L(0); PG8_BAR; PG8_MMA(0, 0, At, B0); PG8_MMA(0, 1, At, B1); PG8_BAR; PG8_SCHED;
            PG8_LDA(At, 1, 1); PG8_STAGE(PG8_SB(1, 0), b3, voffB); PG8_STAGE(PG8_SB(1, 1), b3 + hstep, voffB); PG8_STAGE(PG8_SA(1, 0), a3, voffA);
            PG8_WAIT_V(8); PG8_WAIT_L(0); PG8_BAR; PG8_MMA(1, 0, At, B0); PG8_MMA(1, 1, At, B1); PG8_BAR; PG8_SCHED;
            } else {
            PG8_LDB(B0, 0, 0); PG8_SCHED; PG8_LDA(At, 0, 0); PG8_STAGE(PG8_SA(1, 1), a1 + hstep, voffA);
            PG8_WAIT_L(8); PG8_BAR; PG8_WAIT_L(0); PG8_MMA(0, 0, At, B0); PG8_BAR; PG8_SCHED;
            PG8_LDB(B1, 0, 1); PG8_STAGE(PG8_SB(0, 0), b2, voffB);
            PG8_BAR; PG8_WAIT_L(0); PG8_MMA(0, 1, At, B1); PG8_BAR;
            PG8_LDA(At, 0, 1); PG8_STAGE(PG8_SA(0, 0), a2, voffA);
            PG8_BAR; PG8_WAIT_L(0); PG8_MMA(1, 0, At, B0); PG8_BAR; PG8_SCHED;
            PG8_STAGE(PG8_SB(0, 1), b2 + hstep, voffB);
            PG8_WAIT_V(6); PG8_BAR; PG8_MMA(1, 1, At, B1); PG8_BAR;
            PG8_LDB(B0, 1, 0); PG8_SCHED; PG8_LDA(At, 1, 0); PG8_STAGE(PG8_SA(0, 1), a2 + hstep, voffA);
            PG8_WAIT_L(8); PG8_BAR; PG8_WAIT_L(0); PG8_MMA(0, 0, At, B0); PG8_BAR; PG8_SCHED;
            PG8_LDB(B1, 1, 1); PG8_STAGE(PG8_SB(1, 0), b3, voffB);
            PG8_BAR; PG8_WAIT_L(0); PG8_MMA(0, 1, At, B1); PG8_BAR;
            PG8_LDA(At, 1, 1); PG8_STAGE(PG8_SA(1, 0), a3, voffA);
            PG8_BAR; PG8_WAIT_L(0); PG8_MMA(1, 0, At, B0); PG8_BAR; PG8_SCHED;
            PG8_STAGE(PG8_SB(1, 1), b3 + hstep, voffB);
            PG8_WAIT_V(6); PG8_BAR; PG8_MMA(1, 1, At, B1); PG8_BAR;
            }
        }
        if constexpr (ALIGN_EPI) { if (wr == 0) PG8_BAR; }
        if constexpr (!Epi::AFTER_DRAIN) { E(acc, cur, wr, wc, fr, fq); S.done(cur); }
        if (!has_next) break;
#pragma unroll
        for (int a = 0; a < 2; ++a)
#pragma unroll
            for (int b = 0; b < 2; ++b)
#pragma unroll
                for (int m = 0; m < 4; ++m)
#pragma unroll
                    for (int n = 0; n < 2; ++n) acc[a][b][m][n] = (f32x4){0.f, 0.f, 0.f, 0.f};
        cur = nxt; cA = nA; cB = nB; ++ui;
        if constexpr (ALIGN_EPI) { if (wr == 1) PG8_BAR; }
    }
    PG8_WAIT_V(0);
    if constexpr (!ALIGN_EPI) { if (wr == 0) PG8_BAR; }
    PG8_BAR;
    if constexpr (Epi::AFTER_DRAIN) { E.fused(acc, cur, wr, wc, fr, fq, lds, wid, lane); S.done(cur); }
#undef PG8_SA
#undef PG8_SB
#undef PG8_STAGE
#undef PG8_LDA
#undef PG8_LDB
#undef PG8_MMA
#undef PG8_WAIT_V
#undef PG8_WAIT_L
#undef PG8_BAR
#undef PG8_SCHED
}
}

constexpr int D_MODEL = 2048, BATCH = 4, SEQ = 2048, CTX = 256, GRID_W = 64, NHEAD = 8, HD = 128, WA = 1024;
constexpr int FFN = 5632, IN_COLS = 12288, NMOD = 6;
constexpr int ML = BATCH * SEQ;
constexpr int MC = BATCH * CTX;
constexpr int MT = ML + MC;
constexpr float EPS = 1e-6f;
constexpr int NTHREADS = 512;
constexpr int VT_PITCH = SEQ + CTX;

typedef unsigned short bf16;
typedef float f32x4 __attribute__((ext_vector_type(4)));
typedef unsigned u32x2 __attribute__((ext_vector_type(2)));
typedef unsigned u32x4 __attribute__((ext_vector_type(4)));
#define LAS __attribute__((address_space(3)))

typedef float f32x2_t __attribute__((ext_vector_type(2)));
typedef __bf16 bf16x2_t __attribute__((ext_vector_type(2)));
__device__ __forceinline__ unsigned pk2(float lo, float hi) { const f32x2_t v = {lo, hi}; const bf16x2_t b = __builtin_convertvector(v, bf16x2_t); return __builtin_bit_cast(unsigned, b); }
__device__ __forceinline__ unsigned f2bf(float f) { return pk2(f, 0.f) & 0xffffu; }
__device__ __forceinline__ float bf2f(unsigned short h) { return __builtin_bit_cast(float, (unsigned)h << 16); }
__device__ __forceinline__ float bflo(unsigned w) { return __builtin_bit_cast(float, w << 16); }
__device__ __forceinline__ float bfhi(unsigned w) { return __builtin_bit_cast(float, w & 0xffff0000u); }
__device__ __forceinline__ float sigmoidf_(float x) { return 1.0f / (1.0f + __expf(-x)); }
__device__ __forceinline__ float siluf_(float x) { return x / (1.0f + __expf(-x)); }
__device__ __forceinline__ float wave_sum(float v) {
#pragma unroll
    for (int o = 1; o < 64; o <<= 1) v += __shfl_xor(v, o);
    return v;
}
__device__ __forceinline__ float wave_max(float v) {
#pragma unroll
    for (int o = 1; o < 64; o <<= 1) v = fmaxf(v, __shfl_xor(v, o));
    return v;
}

constexpr size_t al256(size_t x) { return (x + 255) & ~(size_t)255; }
constexpr size_t WS_CTL   = 0;
constexpr size_t CTL_ZERO_BYTES = 1u << 20;
constexpr size_t WS_ROWSQ = 64 * 1024;
constexpr size_t WS_BIAS2 = WS_ROWSQ + (size_t)ML * 4;
static_assert(WS_BIAS2 + (size_t)4 * 2 * FFN * 4 <= CTL_ZERO_BYTES, "ctl");
constexpr size_t WS_MOD   = CTL_ZERO_BYTES;
constexpr size_t WS_LB    = al256(WS_MOD + (size_t)5 * IN_COLS * 4);
constexpr size_t WS_ROPE  = al256(WS_LB + 2 * WA * 4);
constexpr size_t WS_SMALL_END = al256(WS_ROPE + 2 * 64 * 32 * 4);
constexpr size_t WS_W13T  = al256(WS_SMALL_END);
constexpr size_t WS_W2T   = WS_W13T + (size_t)2 * FFN * D_MODEL * 2;
constexpr size_t WS_WAT   = WS_W2T + (size_t)D_MODEL * FFN * 2;
constexpr size_t WS_WBT   = WS_WAT + (size_t)D_MODEL * WA * 2;
constexpr size_t WS_WOT   = WS_WBT + (size_t)D_MODEL * WA * 2;
constexpr size_t WS_A_END = WS_WOT + (size_t)D_MODEL * D_MODEL * 2;
constexpr size_t SEGB = (size_t)MT * WA * 2;
constexpr size_t WS_QA  = WS_A_END;
constexpr size_t WS_FW  = WS_QA + SEGB;
constexpr size_t WS_FB  = WS_FW + 2 * SEGB;
constexpr size_t WS_IA  = WS_FB + 2 * SEGB;
constexpr size_t WS_GA  = WS_IA + SEGB;
constexpr size_t WS_QN  = WS_GA + (size_t)ML * WA * 2;
constexpr size_t WS_KN  = WS_QN + (size_t)ML * WA * 2;
constexpr size_t WS_VN  = WS_KN + SEGB;
constexpr size_t WS_GTA = WS_VN + SEGB;
constexpr size_t WS_GTB = WS_GTA + (size_t)ML * D_MODEL * 2;
constexpr size_t WS_D_END = WS_GTB + (size_t)ML * D_MODEL * 2;
constexpr size_t WS_WINT = WS_D_END;
constexpr size_t WS_OF   = WS_WINT;
constexpr size_t WS_OB   = WS_OF + (size_t)ML * WA * 2;
constexpr size_t WS_B_END = WS_WINT + (size_t)IN_COLS * D_MODEL * 2;
static_assert(WS_OB + (size_t)ML * WA * 2 <= WS_B_END, "B");
constexpr size_t WS_H   = WS_B_END;
constexpr size_t WS_YA  = WS_H;
constexpr size_t WS_YB  = WS_YA + (size_t)ML * WA * 2;
constexpr size_t WS_C_END = WS_H + (size_t)MT * D_MODEL * 2;
constexpr size_t WS_ACT_END = WS_D_END + (size_t)ML * FFN * 2;
constexpr size_t WS_END = WS_C_END > WS_ACT_END ? WS_C_END : WS_ACT_END;
static_assert(WS_END <= 445000000, "ws budget");
constexpr size_t WS_Z   = WS_QA;
constexpr size_t WS_XMG = WS_GTB;
constexpr size_t WS_A13 = WS_QA;
static_assert(WS_A13 + (size_t)ML * 2 * FFN * 2 <= WS_XMG, "A13 overlay");
constexpr size_t WS_ACT = WS_WINT;
static_assert(WS_ACT + (size_t)ML * FFN * 2 <= WS_END, "ACT overlay");

struct Params {
    const float *x, *c, *ctx, *c_ctx, *ada_w, *ada_b, *norm1_g, *norm2_g, *w_in, *lb_logits, *hgrn_norm_g, *q_norm_g, *k_norm_g, *rel_bias,
                *w_a, *w_b, *w_o, *w1, *w3, *conv_w, *conv_b, *w2;
    float* out;
    unsigned char* ws;
};

template <bool QKPERM>
__device__ __forceinline__ void transpose_item(const float* W, int K, int N, bf16* WT, int row_off, LAS float* scr, int item, int lane) {
    const int nblk = N / 32, kb = item / nblk, nb = item % nblk, k0 = 64 * kb, n0 = 32 * nb;
#pragma unroll 8
    for (int i = 0; i < 32; ++i) { const int kk = 2 * i + (lane >> 5); scr[kk * 33 + (lane & 31)] = W[(size_t)(k0 + kk) * N + n0 + (lane & 31)]; }
    asm volatile("s_waitcnt lgkmcnt(0)" ::: "memory");
    const int c = lane & 7;
#pragma unroll
    for (int j = 0; j < 4; ++j) { const int n = (lane >> 3) + 8 * j; const LAS float* s = scr + (8 * c) * 33 + n;
        u32x4 o; o.x = pk2(s[0 * 33], s[1 * 33]); o.y = pk2(s[2 * 33], s[3 * 33]); o.z = pk2(s[4 * 33], s[5 * 33]); o.w = pk2(s[6 * 33], s[7 * 33]);
        int cdst = n0 + n;
        if (QKPERM && cdst >= 5 * WA && cdst < 7 * WA) cdst = (cdst & ~0x30) | ((cdst & 0x10) << 1) | ((cdst & 0x20) >> 1);
        *(u32x4*)(WT + (size_t)(row_off + cdst) * K + k0 + 8 * c) = o; }
    asm volatile("s_waitcnt lgkmcnt(0)" ::: "memory");
}
__device__ __forceinline__ void phase_wconv_in(const Params& p, LAS unsigned char* lds, int gw, int NGW) {
    const int lane = threadIdx.x & 63, wave = threadIdx.x >> 6;
    LAS float* scr = (LAS float*)(lds + wave * 16384);
    constexpr int I_IN = (D_MODEL / 64) * (IN_COLS / 32);
    for (int it = gw; it < I_IN; it += NGW) transpose_item<true>(p.w_in, D_MODEL, IN_COLS, (bf16*)(p.ws + WS_WINT), 0, scr, it, lane);
}
__device__ __forceinline__ void phase_wconv_rest(const Params& p, LAS unsigned char* lds, int gw, int NGW) {
    const int lane = threadIdx.x & 63, wave = threadIdx.x >> 6;
    LAS float* scr = (LAS float*)(lds + 16384 + wave * 16384);
    constexpr int I_A = (WA / 64) * (D_MODEL / 32), I_O = (D_MODEL / 64) * (D_MODEL / 32), I_1 = (D_MODEL / 64) * (FFN / 32), I_2 = (FFN / 64) * (D_MODEL / 32);
    constexpr int NITEMS = 2 * I_A + I_O + 2 * I_1 + I_2;
    unsigned char* ws = p.ws;
    for (int it = gw; it < NITEMS; it += NGW) {
        int r = it;
        if (r < I_A) { transpose_item<false>(p.w_a, WA, D_MODEL, (bf16*)(ws + WS_WAT), 0, scr, r, lane); continue; } r -= I_A;
        if (r < I_A) { transpose_item<false>(p.w_b, WA, D_MODEL, (bf16*)(ws + WS_WBT), 0, scr, r, lane); continue; } r -= I_A;
        if (r < I_O) { transpose_item<false>(p.w_o, D_MODEL, D_MODEL, (bf16*)(ws + WS_WOT), 0, scr, r, lane); continue; } r -= I_O;
        if (r < I_1) { transpose_item<false>(p.w1, D_MODEL, FFN, (bf16*)(ws + WS_W13T), 0, scr, r, lane); continue; } r -= I_1;
        if (r < I_1) { transpose_item<false>(p.w3, D_MODEL, FFN, (bf16*)(ws + WS_W13T), FFN, scr, r, lane); continue; } r -= I_1;
        transpose_item<false>(p.w2, FFN, D_MODEL, (bf16*)(ws + WS_W2T), 0, scr, r, lane);
    }
}

__device__ __forceinline__ void phase_mod(const Params& p, LAS unsigned char* lds, int vb, int nb) {
    const int tid = threadIdx.x;
    LAS float* sc = (LAS float*)lds;
    LAS float* red = (LAS float*)(lds + 5 * 2048 * 4);
    for (int i = tid; i < 5 * D_MODEL; i += NTHREADS) { const int r = i / D_MODEL, k = i % D_MODEL; const float v = (r < 4) ? p.c[r * D_MODEL + k] : p.c_ctx[k]; sc[i] = siluf_(v); }
    __syncthreads();
    float* mod = (float*)(p.ws + WS_MOD);
    const int c4 = tid & 15, kp = tid >> 4;
    for (int item = vb; item < IN_COLS / 64; item += nb) {
        const int n0 = item * 64 + c4 * 4;
        f32x4 acc[5];
#pragma unroll
        for (int r = 0; r < 5; ++r) acc[r] = (f32x4){0.f, 0.f, 0.f, 0.f};
#pragma unroll 4
        for (int k = kp; k < D_MODEL; k += 32) {
            const f32x4 w = *(const f32x4*)(p.ada_w + (size_t)k * IN_COLS + n0);
#pragma unroll
            for (int r = 0; r < 5; ++r) acc[r] += w * sc[r * D_MODEL + k];
        }
#pragma unroll
        for (int r = 0; r < 5; ++r) *(LAS f32x4*)(red + (kp * 5 + r) * 64 + c4 * 4) = acc[r];
        __syncthreads();
        if (tid < 320) { const int r = tid / 64, cidx = tid % 64; float s = 0.f;
            for (int q = 0; q < 32; ++q) s += red[(q * 5 + r) * 64 + cidx];
            mod[r * IN_COLS + item * 64 + cidx] = s + p.ada_b[item * 64 + cidx]; }
        __syncthreads();
    }
    if (vb == nb - 1) { float* rt = (float*)(p.ws + WS_ROPE);
        for (int i = tid; i < 64 * 32; i += NTHREADS) { const int pos = i >> 5, j = i & 31; const float inv = exp2f(-(float)j * (13.287712379549449f / 32.0f)); float sn, cs; sincosf((float)pos * inv, &sn, &cs); rt[i] = cs; rt[2048 + i] = sn; } }
    if (vb == 0) { float* lb = (float*)(p.ws + WS_LB);
        for (int i = tid; i < 2 * WA; i += NTHREADS) { const int d = i / WA, cc = i % WA; const float l0 = p.lb_logits[d * 2 * WA + cc], l1 = p.lb_logits[d * 2 * WA + WA + cc]; lb[i] = 1.0f / (1.0f + expf(l1 - l0)); } }
}

__device__ __forceinline__ void phase_h(const Params& p, int vb, int nb) {
    const int tid = threadIdx.x, lane = tid & 63, wave = tid >> 6;
    const float* mod = (const float*)(p.ws + WS_MOD);
    bf16* H = (bf16*)(p.ws + WS_H);
    for (int m = vb * 8 + wave; m < MT; m += nb * 8) {
        const float* xr = (m < ML) ? p.x + (size_t)m * D_MODEL : p.ctx + (size_t)(m - ML) * D_MODEL;
        const int mr = (m < ML) ? (m / SEQ) : 4;
        const float* sh = mod + (size_t)mr * IN_COLS, *scl = sh + D_MODEL;
        f32x4 v[8]; float s = 0.f;
#pragma unroll
        for (int j = 0; j < 8; ++j) { v[j] = *(const f32x4*)(xr + 4 * lane + 256 * j); s += (v[j].x * v[j].x + v[j].y * v[j].y) + (v[j].z * v[j].z + v[j].w * v[j].w); }
        const float rstd = 1.0f / sqrtf(wave_sum(s) * (1.0f / D_MODEL) + EPS);
#pragma unroll
        for (int j = 0; j < 8; ++j) { const int k = 4 * lane + 256 * j;
            const f32x4 g = *(const f32x4*)(p.norm1_g + k), a = *(const f32x4*)(scl + k), b = *(const f32x4*)(sh + k);
            const f32x4 h = v[j] * rstd * g * (a + 1.0f) + b;
            u32x2 o; o.x = pk2(h.x, h.y); o.y = pk2(h.z, h.w);
            *(u32x2*)(H + (size_t)m * D_MODEL + k) = o; }
    }
}

#define EPI_LOOP_BEGIN \
    _Pragma("unroll") for (int ai = 0; ai < 2; ++ai) _Pragma("unroll") for (int m = 0; m < 4; ++m) { const int row = u.pm * 256 + ai * 128 + wr * 64 + m * 16 + fr; \
    _Pragma("unroll") for (int bj = 0; bj < 2; ++bj) _Pragma("unroll") for (int n = 0; n < 2; ++n) { const int col = u.pn * 256 + bj * 128 + wc * 32 + n * 16 + fq * 4; const f32x4 v = acc[ai][bj][m][n];
#define EPI_LOOP_END } }

struct EpiInProj {
    static constexpr bool PERM = false, AFTER_DRAIN = false;
    unsigned char* ws; LAS unsigned char* lds; const float* qg; const float* kg;
    __device__ __forceinline__ void operator()(const f32x4 (&acc)[2][2][4][2], const pg8::Unit& u, int wr, int wc, int fr, int fq) const {
        const int seg = u.pn >> 2;
        const bool ctxrow = u.pm >= ML / 256;
        const float* lb = (const float*)(ws + WS_LB);
        if (seg == 1 || seg == 2) {
            float* F = (float*)(ws + (seg == 1 ? WS_FW : WS_FB)); const float* lbd = lb + (seg - 1) * WA;
            EPI_LOOP_BEGIN
                const int c = col - seg * WA; const f32x4 l = *(const f32x4*)(lbd + c); f32x4 o;
                o.x = logf(l.x + (1.0f - l.x) * sigmoidf_(v.x)); o.y = logf(l.y + (1.0f - l.y) * sigmoidf_(v.y));
                o.z = logf(l.z + (1.0f - l.z) * sigmoidf_(v.z)); o.w = logf(l.w + (1.0f - l.w) * sigmoidf_(v.w));
                *(f32x4*)(F + (size_t)row * WA + c) = o;
            EPI_LOOP_END
        } else if (seg == 7) {
            bf16* VT = (bf16*)(ws + WS_VN);
            EPI_LOOP_BEGIN
                const int c = col - 7 * WA; const int hh = c >> 7, d = c & 127;
                int bb, tok; if (row < ML) { bb = row / SEQ; tok = row % SEQ; } else { bb = (row - ML) / CTX; tok = SEQ + (row - ML) % CTX; }
                bf16* o = VT + ((size_t)(bb * NHEAD + hh) * HD + d) * VT_PITCH + tok;
                o[0] = (bf16)f2bf(v.x); o[VT_PITCH] = (bf16)f2bf(v.y); o[2 * VT_PITCH] = (bf16)f2bf(v.z); o[3 * VT_PITCH] = (bf16)f2bf(v.w);
            EPI_LOOP_END
        } else if (seg == 5 || seg == 6) {
            if (ctxrow && seg == 5) return;
            LAS float* ssq = (LAS float*)(lds + 131072);
            const float* gn = (seg == 5) ? qg : kg; const float* rt = (const float*)(ws + WS_ROPE);
            bf16* O = (bf16*)(ws + (seg == 5 ? WS_QN : WS_KN));
#pragma unroll
            for (int ai = 0; ai < 2; ++ai)
#pragma unroll
                for (int m = 0; m < 4; ++m)
#pragma unroll
                    for (int bj = 0; bj < 2; ++bj) { const f32x4 a = acc[ai][bj][m][0], b = acc[ai][bj][m][1];
                        float sq = (a.x * a.x + a.y * a.y) + (a.z * a.z + a.w * a.w) + (b.x * b.x + b.y * b.y) + (b.z * b.z + b.w * b.w);
                        sq += __shfl_xor(sq, 16); sq += __shfl_xor(sq, 32);
                        if (fq == 0) ssq[((ai * 128 + wr * 64 + m * 16 + fr) * 2 + bj) * 4 + wc] = sq; }
            asm volatile("s_waitcnt lgkmcnt(0)" ::: "memory"); __builtin_amdgcn_s_barrier(); asm volatile("" ::: "memory");
            const int H = wc >> 1, jj = 16 * (wc & 1) + 4 * fq;
            const f32x4 g0 = *(const f32x4*)(gn + 64 * H + jj), g1 = *(const f32x4*)(gn + 64 * H + 32 + jj);
#pragma unroll
            for (int ai = 0; ai < 2; ++ai)
#pragma unroll
                for (int m = 0; m < 4; ++m) { const int rl = ai * 128 + wr * 64 + m * 16 + fr; const int row = u.pm * 256 + rl;
                    f32x4 cs = (f32x4){1.f, 1.f, 1.f, 1.f}, sn = (f32x4){0.f, 0.f, 0.f, 0.f};
                    if (!ctxrow) { const int t = row & (SEQ - 1); const int pos = (H == 0) ? (t >> 6) : (t & 63); cs = *(const f32x4*)(rt + pos * 32 + jj); sn = *(const f32x4*)(rt + 2048 + pos * 32 + jj); }
#pragma unroll
                    for (int bj = 0; bj < 2; ++bj) { const f32x4 s4 = *(const LAS f32x4*)(ssq + (rl * 2 + bj) * 4);
                        const float rstd = 1.0f / sqrtf(((s4.x + s4.y) + (s4.z + s4.w)) * (1.0f / HD) + EPS);
                        const f32x4 u1 = acc[ai][bj][m][0] * rstd * g0, u2 = acc[ai][bj][m][1] * rstd * g1;
                        const f32x4 o1 = u1 * cs - u2 * sn, o2 = u1 * sn + u2 * cs;
                        bf16* op = O + (size_t)row * WA + (u.pn & 3) * 256 + bj * 128 + wc * 32 + fq * 4;
                        u32x2 w1; w1.x = pk2(o1.x, o1.y); w1.y = pk2(o1.z, o1.w); *(u32x2*)op = w1;
                        u32x2 w2; w2.x = pk2(o2.x, o2.y); w2.y = pk2(o2.z, o2.w); *(u32x2*)(op + 16) = w2; }
                    asm volatile("" ::: "memory"); }
            asm volatile("s_waitcnt lgkmcnt(0)" ::: "memory"); __builtin_amdgcn_s_barrier(); asm volatile("" ::: "memory");
        } else if (seg == 0 || seg == 3) {
            if (ctxrow && seg == 0) return;
            bf16* O = (bf16*)(ws + (seg == 0 ? WS_QA : WS_IA));
            EPI_LOOP_BEGIN
                const int c = col - seg * WA; u32x2 o; o.x = pk2(v.x, v.y); o.y = pk2(v.z, v.w);
                *(u32x2*)(O + (size_t)row * WA + c) = o;
            EPI_LOOP_END
        } else if (seg == 4) {
            if (ctxrow) return;
            bf16* O = (bf16*)(ws + WS_GA);
            EPI_LOOP_BEGIN
                const int c = col - seg * WA; u32x2 o; o.x = pk2(siluf_(v.x), siluf_(v.y)); o.y = pk2(siluf_(v.z), siluf_(v.w));
                *(u32x2*)(O + (size_t)row * WA + c) = o;
            EPI_LOOP_END
        } else {
            if (ctxrow) return;
            const bool isa = seg < 10;
            bf16* O = (bf16*)(ws + (isa ? WS_GTA : WS_GTB)); const int cbase = isa ? 8 * WA : 10 * WA;
            EPI_LOOP_BEGIN
                const int c = col - cbase; u32x2 o; o.x = pk2(sigmoidf_(v.x), sigmoidf_(v.y)); o.y = pk2(sigmoidf_(v.z), sigmoidf_(v.w));
                *(u32x2*)(O + (size_t)row * D_MODEL + c) = o;
            EPI_LOOP_END
        }
    }
};

struct EpiMergeA {
    static constexpr bool PERM = false, AFTER_DRAIN = false;
    unsigned char* ws; float* tmp;
    __device__ __forceinline__ void operator()(const f32x4 (&acc)[2][2][4][2], const pg8::Unit& u, int wr, int wc, int fr, int fq) const {
        const bf16* G = (const bf16*)(ws + WS_GTA);
        EPI_LOOP_BEGIN
            const u32x2 g = *(const u32x2*)(G + (size_t)row * D_MODEL + col);
            f32x4 o; o.x = bflo(g.x) * v.x; o.y = bfhi(g.x) * v.y; o.z = bflo(g.y) * v.z; o.w = bfhi(g.y) * v.w;
            *(f32x4*)(tmp + (size_t)row * D_MODEL + col) = o;
        EPI_LOOP_END
    }
};
struct EpiMergeB {
    static constexpr bool PERM = false, AFTER_DRAIN = false;
    unsigned char* ws; const float* tmp;
    __device__ __forceinline__ void operator()(const f32x4 (&acc)[2][2][4][2], const pg8::Unit& u, int wr, int wc, int fr, int fq) const {
        const bf16* G = (const bf16*)(ws + WS_GTB); bf16* Z = (bf16*)(ws + WS_Z);
        EPI_LOOP_BEGIN
            const u32x2 g = *(const u32x2*)(G + (size_t)row * D_MODEL + col);
            const f32x4 t = *(const f32x4*)(tmp + (size_t)row * D_MODEL + col);
            u32x2 o; o.x = pk2(t.x + bflo(g.x) * v.x, t.y + bfhi(g.x) * v.y); o.y = pk2(t.z + bflo(g.y) * v.z, t.w + bfhi(g.y) * v.w);
            *(u32x2*)(Z + (size_t)row * D_MODEL + col) = o;
        EPI_LOOP_END
    }
};
struct EpiOutProj {
    static constexpr bool PERM = false, AFTER_DRAIN = false;
    unsigned char* ws; const float* x; const float* norm2_g; float* out;
    __device__ __forceinline__ void operator()(const f32x4 (&acc)[2][2][4][2], const pg8::Unit& u, int wr, int wc, int fr, int fq) const {
        const float* mod = (const float*)(ws + WS_MOD); bf16* XMG = (bf16*)(ws + WS_XMG); float* rowsq = (float*)(ws + WS_ROWSQ);
        const int b = (u.pm * 256) / SEQ;
        const float* g1 = mod + (size_t)b * IN_COLS + 2 * D_MODEL, *sc2 = mod + (size_t)b * IN_COLS + 4 * D_MODEL;
#pragma unroll
        for (int ai = 0; ai < 2; ++ai)
#pragma unroll
            for (int m = 0; m < 4; ++m) { const int row = u.pm * 256 + ai * 128 + wr * 64 + m * 16 + fr; float ss = 0.f;
#pragma unroll
                for (int bj = 0; bj < 2; ++bj)
#pragma unroll
                    for (int n = 0; n < 2; ++n) { const int col = u.pn * 256 + bj * 128 + wc * 32 + n * 16 + fq * 4; const f32x4 v = acc[ai][bj][m][n];
                        const f32x4 xv = *(const f32x4*)(x + (size_t)row * D_MODEL + col), g = *(const f32x4*)(g1 + col);
                        const f32x4 xm = xv + g * v;
                        *(f32x4*)(out + (size_t)row * D_MODEL + col) = xm;
                        ss += (xm.x * xm.x + xm.y * xm.y) + (xm.z * xm.z + xm.w * xm.w);
                        const f32x4 ng = *(const f32x4*)(norm2_g + col), s2 = *(const f32x4*)(sc2 + col);
                        const f32x4 h = xm * ng * (s2 + 1.0f);
                        u32x2 o; o.x = pk2(h.x, h.y); o.y = pk2(h.z, h.w);
                        *(u32x2*)(XMG + (size_t)row * D_MODEL + col) = o; }
                ss += __shfl_xor(ss, 16); ss += __shfl_xor(ss, 32);
                if (fq == 0) atomicAdd(rowsq + row, ss); }
    }
};
struct EpiFfnUp {
    static constexpr bool PERM = false, AFTER_DRAIN = false;
    unsigned char* ws;
    __device__ __forceinline__ void operator()(const f32x4 (&acc)[2][2][4][2], const pg8::Unit& u, int wr, int wc, int fr, int fq) const {
        const float* rowsq = (const float*)(ws + WS_ROWSQ); bf16* A13 = (bf16*)(ws + WS_A13);
        const int b = (u.pm * 256) / SEQ; const float* bias2 = (const float*)(ws + WS_BIAS2) + (size_t)b * 2 * FFN;
#pragma unroll
        for (int ai = 0; ai < 2; ++ai)
#pragma unroll
            for (int m = 0; m < 4; ++m) { const int row = u.pm * 256 + ai * 128 + wr * 64 + m * 16 + fr;
                const float rstd = 1.0f / sqrtf(__builtin_nontemporal_load(rowsq + row) * (1.0f / D_MODEL) + EPS);
#pragma unroll
                for (int bj = 0; bj < 2; ++bj)
#pragma unroll
                    for (int n = 0; n < 2; ++n) { const int col = u.pn * 256 + bj * 128 + wc * 32 + n * 16 + fq * 4; const f32x4 v = acc[ai][bj][m][n];
                        const f32x4 bb = *(const f32x4*)(bias2 + col); const f32x4 r = v * rstd + bb;
                        u32x2 o; o.x = pk2(r.x, r.y); o.y = pk2(r.z, r.w);
                        *(u32x2*)(A13 + (size_t)row * (2 * FFN) + col) = o; } }
    }
};
struct EpiFfnDown {
    static constexpr bool PERM = false, AFTER_DRAIN = false;
    unsigned char* ws; float* out;
    __device__ __forceinline__ void operator()(const f32x4 (&acc)[2][2][4][2], const pg8::Unit& u, int wr, int wc, int fr, int fq) const {
        const float* mod = (const float*)(ws + WS_MOD); const int b = (u.pm * 256) / SEQ; const float* g2 = mod + (size_t)b * IN_COLS + 5 * D_MODEL;
        EPI_LOOP_BEGIN
            float* o = out + (size_t)row * D_MODEL + col; const f32x4 xm = *(const f32x4*)o, g = *(const f32x4*)(g2 + col);
            *(f32x4*)o = xm + g * v;
        EPI_LOOP_END
    }
};

#define XB_TMO      128
#define XB_XCNT(j)  (256  + 64 * (j))
#define XB_XSUB(j)  (1280 + 64 * (j))
#define XB_XGEN(j)  (2304 + 64 * (j))
#define XB_TOP      3328
#define XB_TOPGEN   3392
#define XCD_BAR_WORDS 3456
#define XB_SPIN_CAP (1u << 18)

__device__ __forceinline__ unsigned xb_ld(unsigned* p)              { return __hip_atomic_load(p, __ATOMIC_RELAXED, __HIP_MEMORY_SCOPE_AGENT); }
__device__ __forceinline__ unsigned xb_add(unsigned* p, unsigned v) { return __hip_atomic_fetch_add(p, v, __ATOMIC_RELAXED, __HIP_MEMORY_SCOPE_AGENT); }
__device__ __forceinline__ unsigned xb_xcc_id() { return (unsigned)__builtin_amdgcn_s_getreg((3 << 11) | 20) & 0xFu; }
#define XB_SPIN(cond, bar) do { unsigned _sp = 0; while (cond) { __builtin_amdgcn_s_sleep(1); \
    if ((++_sp & 255u) == 0u) { if (xb_ld(&(bar)[XB_TMO])) break; if (_sp > XB_SPIN_CAP) { atomicAdd(&(bar)[XB_TMO], 1u); break; } } } } while (0)

struct XcdBarrier {
    unsigned* bar; unsigned x;
    volatile LAS unsigned* st;
};

__device__ __forceinline__ XcdBarrier xcd_barrier_post(unsigned* bar, volatile LAS unsigned* st) {
    XcdBarrier b; b.bar = bar; b.x = xb_xcc_id(); b.st = st;
    if (threadIdx.x == 0) (void)xb_add(&bar[XB_XCNT(b.x)], 1u);
    return b;
}
__device__ __forceinline__ void xcd_barrier_complete(unsigned* bar, unsigned x, unsigned& nloc, unsigned& nx) {
    const unsigned G = gridDim.x * gridDim.y * gridDim.z;
    unsigned sum, cnt, mine, sp = 0u;
    for (;;) {
        sum = 0u; cnt = 0u; mine = 0u;
#pragma unroll
        for (unsigned j = 0; j < 16; ++j) { const unsigned c = xb_ld(&bar[XB_XCNT(j)]); sum += c; cnt += (c > 0u) ? 1u : 0u; mine = (j == x) ? c : mine; }
        if (sum == G) break;
        __builtin_amdgcn_s_sleep(1);
        if ((++sp & 255u) == 0u) { if (xb_ld(&bar[XB_TMO])) break; if (sp > XB_SPIN_CAP) { atomicAdd(&bar[XB_TMO], 1u); break; } }
    }
    nloc = mine > 0u ? mine : 1u; nx = cnt > 0u ? cnt : 1u;
}

__device__ __forceinline__ void xcd_barrier(const XcdBarrier& b) {
    asm volatile("s_waitcnt vmcnt(0)" ::: "memory");
    __syncthreads();
    if (threadIdx.x == 0) {
        unsigned* bar = b.bar;
        __builtin_amdgcn_s_waitcnt(0);
        unsigned nloc = b.st[0], nx = b.st[1];
        if (nloc == 0u) { xcd_barrier_complete(bar, b.x, nloc, nx); b.st[0] = nloc; b.st[1] = nx; }
        const unsigned old = xb_add(&bar[XB_XSUB(b.x)], 1u);
        const unsigned gen = old / nloc;
        if (old + 1u == (gen + 1u) * nloc) {
            __builtin_amdgcn_fence(__ATOMIC_RELEASE, "agent");
            asm volatile("s_waitcnt vmcnt(0)" ::: "memory");
            const unsigned og = xb_add(&bar[XB_TOP], 1u);
            const unsigned tg = og / nx;
            if (og + 1u == (tg + 1u) * nx) xb_add(&bar[XB_TOPGEN], 1u);
            else XB_SPIN(xb_ld(&bar[XB_TOPGEN]) == tg, bar);
            __builtin_amdgcn_fence(__ATOMIC_ACQUIRE, "agent");
            xb_add(&bar[XB_XGEN(b.x)], 1u);
            asm volatile("s_waitcnt vmcnt(0)" ::: "memory");
        } else {
            XB_SPIN(xb_ld(&bar[XB_XGEN(b.x)]) == gen, bar);
            __builtin_amdgcn_fence(__ATOMIC_ACQUIRE, "agent");
            asm volatile("s_waitcnt vmcnt(0)" ::: "memory");
        }
    }
    __syncthreads();
}

constexpr size_t WS_BAR = 8192;

typedef short bf16x8 __attribute__((ext_vector_type(8)));
typedef short s16x4 __attribute__((ext_vector_type(4)));

__device__ __forceinline__ bf16x8 cat8u(const u32x2 a, const u32x2 b) { const u32x4 w = (u32x4){a.x, a.y, b.x, b.y}; return __builtin_bit_cast(bf16x8, w); }
__device__ __forceinline__ bf16x8 pack_p(const f32x4 a, const f32x4 b) {
    u32x4 w; w.x = pk2(a.x, a.y); w.y = pk2(a.z, a.w); w.z = pk2(b.x, b.y); w.w = pk2(b.z, b.w);
    return __builtin_bit_cast(bf16x8, w);
}

constexpr int AK_PITCH = 272, AV_PITCH = 144;
constexpr int A_KBUF = 0, A_KSZ = 64 * AK_PITCH;
constexpr int A_VBUF = 2 * A_KSZ, A_VSZ = 128 * AV_PITCH;
constexpr int A_BIAS = A_VBUF + 2 * A_VSZ;
constexpr int A_ITEM = A_BIAS + 2048;
constexpr size_t WS_ATTCTR = 32768;
static_assert(WS_ATTCTR >= WS_BAR + XCD_BAR_WORDS * 4 && WS_ATTCTR + 4 <= WS_ROWSQ, "attn counter inside ctl");
#define ATT_BAR() do { asm volatile("s_waitcnt lgkmcnt(0)" ::: "memory"); __builtin_amdgcn_s_barrier(); asm volatile("" ::: "memory"); } while (0)

__device__ __forceinline__ void phase_attn(const Params& p, LAS unsigned char* lds) {
    const int tid = threadIdx.x, lane = tid & 63, wave = __builtin_amdgcn_readfirstlane(tid >> 6);
    const int qb = wave & 3, dh = wave >> 2, li = lane & 15, g = lane >> 4;
    const bf16* QN = (const bf16*)(p.ws + WS_QN); const bf16* KN = (const bf16*)(p.ws + WS_KN); const bf16* VT = (const bf16*)(p.ws + WS_VN);
    bf16* YB = (bf16*)(p.ws + WS_YB);
    unsigned* ctr = (unsigned*)(p.ws + WS_ATTCTR);
    LAS float* btab = (LAS float*)(lds + A_BIAS);
    const float scale = 0.08838834764831845f;
    for (;;) {
        if (tid == 0) *(LAS unsigned*)(lds + A_ITEM) = atomicAdd(ctr, 1u);
        __syncthreads();
        const int it = (int)*(LAS unsigned*)(lds + A_ITEM);
        if (it >= BATCH * NHEAD * 32) break;
        const int r = it & 31, h = (it >> 5) & 7, b = it >> 8;
        const int rs = min(max(r - 4, 0), 24), ks0 = min(max(16 * qb - 8, 0), 32);
        const int cq = 16 * qb + li, cs = min(max(cq - 8, 0), 48);
        const size_t qrow = (size_t)b * SEQ + r * GRID_W + cq;
        if (tid < 15 * 31) btab[tid] = p.rel_bias[h * 465 + tid];
        const bf16* kgl = KN + (size_t)h * HD + (size_t)(tid >> 4) * WA + 8 * (tid & 15);
        const bf16* vgl = VT + ((size_t)(b * NHEAD + h) * HD + (tid >> 3)) * VT_PITCH + 8 * (tid & 7);
        const int klds = (tid >> 4) * AK_PITCH + 16 * (tid & 15), vlds = (tid >> 3) * AV_PITCH + 16 * (tid & 7);
        u32x4 kreg[2], vreg[2];
#define ATT_LOAD(ti_) do { const int t_ = (ti_); const size_t krow0 = (t_ < 8) ? ((size_t)b * SEQ + (rs + t_) * GRID_W) : ((size_t)ML + b * CTX + 64 * (t_ - 8)); \
            const int tok0 = (t_ < 8) ? ((rs + t_) * GRID_W) : (SEQ + 64 * (t_ - 8)); \
            kreg[0] = *(const u32x4*)(kgl + krow0 * WA); kreg[1] = *(const u32x4*)(kgl + (krow0 + 32) * WA); \
            vreg[0] = *(const u32x4*)(vgl + tok0); vreg[1] = *(const u32x4*)(vgl + (size_t)64 * VT_PITCH + tok0); } while (0)
#define ATT_STORE(buf_) do { const int bb_ = (buf_); \
            *(LAS u32x4*)(lds + A_KBUF + bb_ * A_KSZ + klds) = kreg[0]; *(LAS u32x4*)(lds + A_KBUF + bb_ * A_KSZ + klds + 32 * AK_PITCH) = kreg[1]; \
            *(LAS u32x4*)(lds + A_VBUF + bb_ * A_VSZ + vlds) = vreg[0]; *(LAS u32x4*)(lds + A_VBUF + bb_ * A_VSZ + vlds + 64 * AV_PITCH) = vreg[1]; } while (0)
        ATT_LOAD(0);
        bf16x8 qf[4];
#pragma unroll
        for (int ks = 0; ks < 4; ++ks) qf[ks] = *(const bf16x8*)(QN + qrow * WA + h * HD + 32 * ks + 8 * g);
        ATT_STORE(0);
        ATT_LOAD(1);
        f32x4 ot[4];
#pragma unroll
        for (int db = 0; db < 4; ++db) ot[db] = (f32x4){0.f, 0.f, 0.f, 0.f};
        float mrun = -1e30f, l = 0.f;
        ATT_BAR();
#pragma unroll 1
        for (int ti = 0; ti < 12; ++ti) {
            const LAS unsigned char* kb_ = lds + A_KBUF + (ti & 1) * A_KSZ; const LAS unsigned char* vb_ = lds + A_VBUF + (ti & 1) * A_VSZ + (64 * dh + li) * AV_PITCH + 8 * g;
            if (ti < 8) {
                f32x4 st[2];
#pragma unroll
                for (int kb = 0; kb < 2; ++kb) { const LAS unsigned char* kp = kb_ + (ks0 + 16 * kb + li) * AK_PITCH + 16 * g; f32x4 a = (f32x4){0.f, 0.f, 0.f, 0.f};
#pragma unroll
                    for (int ks = 0; ks < 4; ++ks) a = __builtin_amdgcn_mfma_f32_16x16x32_bf16(*(const LAS bf16x8*)(kp + 64 * ks), qf[ks], a, 0, 0, 0);
                    st[kb] = a; }
                const int dr = rs + ti - r + 7; float gm = -1e30f;
#pragma unroll
                for (int kb = 0; kb < 2; ++kb)
#pragma unroll
                    for (int j = 0; j < 4; ++j) { const int kcol = ks0 + 16 * kb + 4 * g + j; const bool valid = (kcol >= cs) && (kcol < cs + 16);
                        const int bi = valid ? (dr * 31 + (kcol - cq + 15)) : 0;
                        const float sv = valid ? (st[kb][j] * scale + btab[bi]) : -1e30f; st[kb][j] = sv; gm = fmaxf(gm, sv); }
                gm = fmaxf(gm, __shfl_xor(gm, 16)); gm = fmaxf(gm, __shfl_xor(gm, 32));
                const float mnew = fmaxf(mrun, gm); const float alpha = __expf(mrun - mnew); mrun = mnew; l *= alpha;
#pragma unroll
                for (int db = 0; db < 4; ++db) ot[db] = ot[db] * alpha;
#pragma unroll
                for (int kb = 0; kb < 2; ++kb)
#pragma unroll
                    for (int j = 0; j < 4; ++j) { const float sv = st[kb][j]; const float e = (sv > -1e29f) ? __expf(sv - mnew) : 0.f; st[kb][j] = e; l += e; }
                const bf16x8 pb = pack_p(st[0], st[1]);
#pragma unroll
                for (int db = 0; db < 4; ++db) { const LAS unsigned char* vp = vb_ + 16 * db * AV_PITCH + 2 * ks0;
                    ot[db] = __builtin_amdgcn_mfma_f32_16x16x32_bf16(cat8u(*(const LAS u32x2*)vp, *(const LAS u32x2*)(vp + 32)), pb, ot[db], 0, 0, 0); }
            } else {
                f32x4 st[4];
#pragma unroll
                for (int kb = 0; kb < 4; ++kb) { const LAS unsigned char* kp = kb_ + (16 * kb + li) * AK_PITCH + 16 * g; f32x4 a = (f32x4){0.f, 0.f, 0.f, 0.f};
#pragma unroll
                    for (int ks = 0; ks < 4; ++ks) a = __builtin_amdgcn_mfma_f32_16x16x32_bf16(*(const LAS bf16x8*)(kp + 64 * ks), qf[ks], a, 0, 0, 0);
                    st[kb] = a * scale; }
                float gm = -1e30f;
#pragma unroll
                for (int kb = 0; kb < 4; ++kb) gm = fmaxf(fmaxf(gm, fmaxf(st[kb][0], st[kb][1])), fmaxf(st[kb][2], st[kb][3]));
                gm = fmaxf(gm, __shfl_xor(gm, 16)); gm = fmaxf(gm, __shfl_xor(gm, 32));
                const float mnew = fmaxf(mrun, gm); const float alpha = __expf(mrun - mnew); mrun = mnew; l *= alpha;
#pragma unroll
                for (int db = 0; db < 4; ++db) ot[db] = ot[db] * alpha;
#pragma unroll
                for (int kb = 0; kb < 4; ++kb)
#pragma unroll
                    for (int j = 0; j < 4; ++j) { const float e = __expf(st[kb][j] - mnew); st[kb][j] = e; l += e; }
#pragma unroll
                for (int kp2 = 0; kp2 < 2; ++kp2) { const bf16x8 pb = pack_p(st[2 * kp2], st[2 * kp2 + 1]);
#pragma unroll
                    for (int db = 0; db < 4; ++db) { const LAS unsigned char* vp = vb_ + 16 * db * AV_PITCH + 64 * kp2;
                        ot[db] = __builtin_amdgcn_mfma_f32_16x16x32_bf16(cat8u(*(const LAS u32x2*)vp, *(const LAS u32x2*)(vp + 32)), pb, ot[db], 0, 0, 0); } }
            }
            if (ti + 1 < 12) ATT_STORE((ti + 1) & 1);
            if (ti + 2 < 12) ATT_LOAD(ti + 2);
            ATT_BAR();
        }
        l += __shfl_xor(l, 16); l += __shfl_xor(l, 32);
        const float inv = 1.0f / l;
#pragma unroll
        for (int db = 0; db < 4; ++db) { const f32x4 o = ot[db] * inv; u32x2 w; w.x = pk2(o.x, o.y); w.y = pk2(o.z, o.w);
            *(u32x2*)(YB + qrow * WA + h * HD + 64 * dh + 16 * db + 4 * g) = w; }
#undef ATT_LOAD
#undef ATT_STORE
    }
}

constexpr int HP = 160;
constexpr int H_QH = 0, H_KH = 20480, H_KE = 40960, H_QD = 61440, H_KD = 81920;
constexpr int HP2 = 48;
constexpr int H_Q2 = 102400, H_K2 = 108544;
constexpr int VP = 288;
constexpr int H_V = 114688;
constexpr int PP = 144;
constexpr int H_P = 133120;
constexpr int H_T = 142336;
constexpr int H_D = 144384;
constexpr int H_END = 144896;

__device__ __forceinline__ s16x4 lds_tr(LAS const unsigned char* p) {
    return __builtin_bit_cast(s16x4, __builtin_amdgcn_ds_read_tr16_b64_v4i16((LAS s16x4*)p));
}
__device__ __forceinline__ bf16x8 cat8(const s16x4 a, const s16x4 b) { return __builtin_shufflevector(a, b, 0, 1, 2, 3, 4, 5, 6, 7); }

__device__ __forceinline__ size_t hg_row(int dir, int b, int tau) {
    if (tau < CTX) return (size_t)ML + b * CTX + (dir == 0 ? tau : CTX - 1 - tau);
    const int t = tau - CTX; return (size_t)b * SEQ + (dir == 0 ? t : SEQ - 1 - t);
}

__device__ __forceinline__ void hgrn_item(const Params& p, LAS unsigned char* lds, int item) {
    const int tid = threadIdx.x, lane = tid & 63, wave = __builtin_amdgcn_readfirstlane(tid >> 6);
    const int k = tid & 127, J = __builtin_amdgcn_readfirstlane(tid >> 7);
    const int li = lane & 15, g = lane >> 4, qq = li >> 2, pp = li & 3;
    const int dir = item / (BATCH * NHEAD), b = (item / NHEAD) % BATCH, h = item % NHEAD;
    const float* LF = (const float*)(p.ws + (dir == 0 ? WS_FW : WS_FB)) + h * HD + k;
    const bf16* QA = (const bf16*)(p.ws + WS_QA) + h * HD + k;
    const bf16* IA = (const bf16*)(p.ws + WS_IA) + h * HD;
    bf16* O = (bf16*)(p.ws + (dir == 0 ? WS_OF : WS_OB)) + h * HD + 16 * wave + li;
    LAS float* Tl = (LAS float*)(lds + H_T); LAS float* Dl = (LAS float*)(lds + H_D);

    f32x4 S[8];
#pragma unroll
    for (int i = 0; i < 8; ++i) S[i] = (f32x4){0.f, 0.f, 0.f, 0.f};

    float lf[16]; unsigned qv[16]; u32x4 vreg[2];
#define HG_LOAD_CHUNK(c_) do { const int cc_ = (c_); \
        _Pragma("unroll") for (int i = 0; i < 16; ++i) { const size_t row = hg_row(dir, b, 64 * cc_ + 16 * J + i); lf[i] = LF[row * WA]; qv[i] = (cc_ >= 4) ? (unsigned)QA[row * WA] : 0u; } \
        _Pragma("unroll") for (int e = 0; e < 2; ++e) { const int idx = tid * 2 + e; const size_t row = hg_row(dir, b, 64 * cc_ + (idx >> 4)); vreg[e] = *(const u32x4*)(IA + row * WA + 8 * (idx & 15)); } } while (0)
    HG_LOAD_CHUNK(0);
    constexpr int NCH = (CTX + SEQ) / 64;
    for (int c = 0; c < NCH; ++c) {
        float cum[16]; float run = 0.f;
#pragma unroll
        for (int i = 0; i < 16; ++i) { run += lf[i]; cum[i] = run; }
        Tl[J * 128 + k] = run;
        ATT_BAR();
        const float T0 = Tl[k], T1 = Tl[128 + k], T2 = Tl[256 + k], T3 = Tl[384 + k];
        const float bJ = (J > 0 ? T0 : 0.f) + (J > 1 ? T1 : 0.f) + (J > 2 ? T2 : 0.f);
        const float tail = (J < 1 ? T1 : 0.f) + (J < 2 ? T2 : 0.f) + (J < 3 ? T3 : 0.f);
        const float eb = __expf(bJ), et = __expf(tail), eT = __expf(run);
        const float x2 = (J == 3) ? __expf(T2) : __expf(T1);
        float qh[16], kh[16];
#pragma unroll
        for (int i = 0; i < 16; ++i) { const float e1 = __expf(cum[i]); const float r1 = 1.0f / e1; const float kk = 1.0f - __expf(lf[i]);
            qh[i] = __builtin_bit_cast(float, qv[i] << 16) * e1; kh[i] = kk * r1; }
        {
            LAS unsigned char* rowp = lds + k * HP + 32 * J;
            u32x4 w0, w1;
#define HG_WRITE(OFF, EXPR) do { \
            { float v0_, v1_; \
              { const int i = 0; v0_ = (EXPR); } { const int i = 1; v1_ = (EXPR); } w0.x = pk2(v0_, v1_); \
              { const int i = 2; v0_ = (EXPR); } { const int i = 3; v1_ = (EXPR); } w0.y = pk2(v0_, v1_); \
              { const int i = 4; v0_ = (EXPR); } { const int i = 5; v1_ = (EXPR); } w0.z = pk2(v0_, v1_); \
              { const int i = 6; v0_ = (EXPR); } { const int i = 7; v1_ = (EXPR); } w0.w = pk2(v0_, v1_); \
              { const int i = 8; v0_ = (EXPR); } { const int i = 9; v1_ = (EXPR); } w1.x = pk2(v0_, v1_); \
              { const int i = 10; v0_ = (EXPR); } { const int i = 11; v1_ = (EXPR); } w1.y = pk2(v0_, v1_); \
              { const int i = 12; v0_ = (EXPR); } { const int i = 13; v1_ = (EXPR); } w1.z = pk2(v0_, v1_); \
              { const int i = 14; v0_ = (EXPR); } { const int i = 15; v1_ = (EXPR); } w1.w = pk2(v0_, v1_); } \
            *(LAS u32x4*)(OFF) = w0; *(LAS u32x4*)((OFF) + 16) = w1; } while (0)
            HG_WRITE(rowp + H_QH, qh[i]);
            HG_WRITE(rowp + H_KH, kh[i]);
            HG_WRITE(rowp + H_KE, kh[i] * eT);
            HG_WRITE(rowp + H_QD, qh[i] * eb);
            HG_WRITE(rowp + H_KD, kh[i] * (eT * et));
            if (J == 3) { HG_WRITE(lds + H_Q2 + k * HP2, qh[i] * x2); }
            if (J == 0) { HG_WRITE(lds + H_K2 + k * HP2, kh[i] * (eT * x2)); }
#undef HG_WRITE
            if (J == 3) Dl[k] = __expf(bJ + run);
        }
#pragma unroll
        for (int e = 0; e < 2; ++e) { const int idx = tid * 2 + e; *(LAS u32x4*)(lds + H_V + (idx >> 4) * VP + 16 * (idx & 15)) = vreg[e]; }
        if (c + 1 < NCH) HG_LOAD_CHUNK(c + 1);
        ATT_BAR();
        const bool lat = (c >= 4);
        if (lat) {
#pragma unroll
            for (int rep = 0; rep < 2; ++rep) {
                int I, Jb;
                if (rep == 0) { I = (wave < 4) ? wave : (wave == 4 ? 1 : (wave == 7 ? 3 : 2)); Jb = (wave < 4) ? wave : (wave == 4 ? 0 : (wave == 5 ? 0 : (wave == 6 ? 1 : 2))); }
                else { if (wave >= 2) break; I = 3; Jb = wave; }
                int aoff, apitch, acol, boff, bpitch, bcol;
                if (I == Jb) { aoff = H_KH; apitch = HP; acol = 16 * Jb; boff = H_QH; bpitch = HP; bcol = 16 * I; }
                else if (I == Jb + 1 && I != 2) { aoff = H_KE; apitch = HP; acol = 16 * Jb; boff = H_QH; bpitch = HP; bcol = 16 * I; }
                else if (I == 2) { if (Jb == 0) { aoff = H_K2; apitch = HP2; acol = 0; } else { aoff = H_KE; apitch = HP; acol = 16; } boff = H_QH; bpitch = HP; bcol = 32; }
                else { if (Jb == 0) { aoff = H_K2; apitch = HP2; acol = 0; } else { aoff = H_KE; apitch = HP; acol = 16; } boff = H_Q2; bpitch = HP2; bcol = 0; }
                f32x4 pt = (f32x4){0.f, 0.f, 0.f, 0.f};
#pragma unroll
                for (int ks = 0; ks < 4; ++ks) {
                    const int r0 = 32 * ks + 4 * g + qq;
                    const bf16x8 a = cat8(lds_tr(lds + aoff + r0 * apitch + (acol + 4 * pp) * 2), lds_tr(lds + aoff + (r0 + 16) * apitch + (acol + 4 * pp) * 2));
                    const bf16x8 bb = cat8(lds_tr(lds + boff + r0 * bpitch + (bcol + 4 * pp) * 2), lds_tr(lds + boff + (r0 + 16) * bpitch + (bcol + 4 * pp) * 2));
                    pt = __builtin_amdgcn_mfma_f32_16x16x32_bf16(a, bb, pt, 0, 0, 0);
                }
                if (I == Jb) {
#pragma unroll
                    for (int j = 0; j < 4; ++j) if (4 * g + j > li) pt[j] = 0.f;
                }
                u32x2 w; w.x = pk2(pt.x, pt.y); w.y = pk2(pt.z, pt.w);
                *(LAS u32x2*)(lds + H_P + (16 * I + li) * PP + (16 * Jb + 4 * g) * 2) = w;
            }
        }
        ATT_BAR();
        bf16x8 vf[2];
#pragma unroll
        for (int sp = 0; sp < 2; ++sp) {
            const LAS unsigned char* vb0 = lds + H_V + (32 * sp + 4 * g + qq) * VP + (16 * wave + 4 * pp) * 2;
            vf[sp] = cat8(lds_tr(vb0), lds_tr(vb0 + 16 * VP));
        }
        if (lat) {
            bf16x8 sb[4];
#pragma unroll
            for (int ks = 0; ks < 4; ++ks) sb[ks] = pack_p(S[2 * ks], S[2 * ks + 1]);
#pragma unroll
            for (int I = 0; I < 4; ++I) {
                f32x4 o = (f32x4){0.f, 0.f, 0.f, 0.f};
#pragma unroll
                for (int ks = 0; ks < 4; ++ks) {
                    const LAS unsigned char* ap = lds + H_QD + (32 * ks + 4 * g + qq) * HP + (16 * I + 4 * pp) * 2;
                    o = __builtin_amdgcn_mfma_f32_16x16x32_bf16(cat8(lds_tr(ap), lds_tr(ap + 16 * HP)), sb[ks], o, 0, 0, 0);
                }
#pragma unroll
                for (int sp = 0; sp < 2; ++sp) {
                    if (2 * sp > I) break;
                    const LAS unsigned char* pr = lds + H_P + (16 * I + li) * PP + (32 * sp + 4 * g) * 2;
                    const u32x2 lo = *(const LAS u32x2*)pr; u32x2 hi = (u32x2){0u, 0u};
                    if (2 * sp + 1 <= I) hi = *(const LAS u32x2*)(pr + 32);
                    o = __builtin_amdgcn_mfma_f32_16x16x32_bf16(cat8u(lo, hi), vf[sp], o, 0, 0, 0);
                }
#pragma unroll
                for (int j = 0; j < 4; ++j) { const size_t row = hg_row(dir, b, 64 * c + 16 * I + 4 * g + j); O[row * WA] = (bf16)f2bf(o[j]); }
            }
        }
#pragma unroll
        for (int blk = 0; blk < 8; ++blk) {
            const f32x4 d4 = *(const LAS f32x4*)(Dl + 16 * blk + 4 * g);
            f32x4 s = S[blk] * d4;
#pragma unroll
            for (int sp = 0; sp < 2; ++sp) {
                const LAS unsigned char* kp = lds + H_KD + (16 * blk + li) * HP + (32 * sp + 4 * g) * 2;
                s = __builtin_amdgcn_mfma_f32_16x16x32_bf16(cat8u(*(const LAS u32x2*)kp, *(const LAS u32x2*)(kp + 32)), vf[sp], s, 0, 0, 0);
            }
            S[blk] = s;
        }
    }
    __syncthreads();
#undef HG_LOAD_CHUNK
}
__device__ __forceinline__ void phase_readout(const Params& p, int vb, int nb) {
    const int tid = threadIdx.x, lane = tid & 63, wave = tid >> 6;
    const bf16* OF = (const bf16*)(p.ws + WS_OF); const bf16* OB = (const bf16*)(p.ws + WS_OB); const bf16* GA = (const bf16*)(p.ws + WS_GA);
    bf16* YA = (bf16*)(p.ws + WS_YA);
    for (int it = vb * 8 + wave; it < ML * NHEAD; it += nb * 8) {
        const int row = it / NHEAD, h = it % NHEAD; const size_t off = (size_t)row * WA + h * HD + 2 * lane;
        const unsigned a = *(const unsigned*)(OF + off), b = *(const unsigned*)(OB + off), g = *(const unsigned*)(GA + off);
        const float o0 = bflo(a) + bflo(b), o1 = bfhi(a) + bfhi(b);
        const float rstd = 1.0f / sqrtf(wave_sum(o0 * o0 + o1 * o1) * (1.0f / HD) + EPS);
        const float y0 = o0 * rstd * p.hgrn_norm_g[2 * lane] * bflo(g), y1 = o1 * rstd * p.hgrn_norm_g[2 * lane + 1] * bfhi(g);
        *(unsigned*)(YA + off) = pk2(y0, y1);
    }
}

__device__ __forceinline__ void phase_bias2(const Params& p, int vb, int nb) {
    const int tid = threadIdx.x; const float* mod = (const float*)(p.ws + WS_MOD); float* bias2 = (float*)(p.ws + WS_BIAS2);
    constexpr int NCC = 2 * FFN / 512, NKC = D_MODEL / 64;
    for (int item = vb; item < NCC * NKC; item += nb) {
        const int cc = item % NCC, kc = item / NCC; const int col = cc * 512 + tid;
        const float* W = (col < FFN) ? p.w1 + col : p.w3 + (col - FFN);
        float a0 = 0.f, a1 = 0.f, a2 = 0.f, a3 = 0.f;
#pragma unroll 8
        for (int k = kc * 64; k < kc * 64 + 64; ++k) { const float w = W[(size_t)k * FFN];
            a0 += w * mod[0 * IN_COLS + 3 * D_MODEL + k]; a1 += w * mod[1 * IN_COLS + 3 * D_MODEL + k]; a2 += w * mod[2 * IN_COLS + 3 * D_MODEL + k]; a3 += w * mod[3 * IN_COLS + 3 * D_MODEL + k]; }
        atomicAdd(bias2 + 0 * 2 * FFN + col, a0); atomicAdd(bias2 + 1 * 2 * FFN + col, a1); atomicAdd(bias2 + 2 * 2 * FFN + col, a2); atomicAdd(bias2 + 3 * 2 * FFN + col, a3);
    }
}

__device__ __forceinline__ void phase_conv(const Params& p, int vb, int nb) {
    const int tid = threadIdx.x; const bf16* A13 = (const bf16*)(p.ws + WS_A13); bf16* ACT = (bf16*)(p.ws + WS_ACT);
    constexpr int CPR = FFN / 8;
    const size_t total = (size_t)ML * CPR;
    for (size_t i = (size_t)vb * NTHREADS + tid; i < total; i += (size_t)nb * NTHREADS) {
        const int row = (int)(i / CPR), c = (int)(i % CPR) * 8; const int t = row % SEQ;
        const bf16* ap = A13 + (size_t)row * (2 * FFN) + c;
        const u32x4 a1 = *(const u32x4*)ap; const u32x4 g = *(const u32x4*)(ap + FFN);
        u32x4 a0 = (u32x4){0u, 0u, 0u, 0u}, a2 = (u32x4){0u, 0u, 0u, 0u};
        if (t > 0) a0 = *(const u32x4*)(ap - 2 * FFN);
        if (t < SEQ - 1) a2 = *(const u32x4*)(ap + 2 * FFN);
        float w0[8], w1[8], w2[8], cb[8];
#pragma unroll
        for (int e = 0; e < 8; ++e) { w0[e] = p.conv_w[c + e]; w1[e] = p.conv_w[FFN + c + e]; w2[e] = p.conv_w[2 * FFN + c + e]; cb[e] = p.conv_b[c + e]; }
        float r[8];
#pragma unroll
        for (int q = 0; q < 4; ++q) {
            const unsigned x0 = a0[q], x1 = a1[q], x2 = a2[q], gg = g[q];
            const float u0 = bflo(x0) * w0[2 * q] + bflo(x1) * w1[2 * q] + bflo(x2) * w2[2 * q] + cb[2 * q];
            const float u1 = bfhi(x0) * w0[2 * q + 1] + bfhi(x1) * w1[2 * q + 1] + bfhi(x2) * w2[2 * q + 1] + cb[2 * q + 1];
            r[2 * q] = siluf_(u0) * bflo(gg); r[2 * q + 1] = siluf_(u1) * bfhi(gg);
        }
        u32x4 o; o.x = pk2(r[0], r[1]); o.y = pk2(r[2], r[3]); o.z = pk2(r[4], r[5]); o.w = pk2(r[6], r[7]);
        *(u32x4*)(ACT + (size_t)row * FFN + c) = o;
    }
}


constexpr int LDS_MISC_OFF = 145408;
constexpr int LDS_BYTES = 146432;
static_assert(WS_BAR + XCD_BAR_WORDS * 4 <= WS_ROWSQ, "barrier words inside ctl");

__global__ void __launch_bounds__(NTHREADS, 2) mega_fwd(Params p) {
    extern __shared__ __attribute__((aligned(16))) unsigned char lds_raw[];
    LAS unsigned char* lds = (LAS unsigned char*)lds_raw;
    const int nb = gridDim.x;
    const int vb = (nb % 8 == 0) ? ((int)(blockIdx.x % 8) * (nb / 8) + (int)(blockIdx.x / 8)) : (int)blockIdx.x;
    const int bx = blockIdx.x;
    unsigned char* ws = p.ws;
    volatile LAS unsigned* misc = (volatile LAS unsigned*)(lds + LDS_MISC_OFF);
    if (threadIdx.x < 64) misc[threadIdx.x] = 0u;
    __syncthreads();
    XcdBarrier bar = xcd_barrier_post((unsigned*)(ws + WS_BAR), misc + 8);
#define GRID_BAR() xcd_barrier(bar)

    phase_mod(p, lds, vb, nb);
    __syncthreads();
    phase_wconv_in(p, lds, vb * 8 + (int)(threadIdx.x >> 6), nb * 8);
    GRID_BAR();
    phase_h(p, vb, nb);
    phase_bias2(p, vb, nb);
    GRID_BAR();
    { pg8::Gemm g{(const bf16*)(ws + WS_H), (const bf16*)(ws + WS_WINT), MT, IN_COLS, D_MODEL}; pg8::StaticOrder S; S.init(MT, IN_COLS, nb, bx);
      EpiInProj E{ws, lds, p.q_norm_g, p.k_norm_g}; pg8::gemm_phase<EpiInProj, pg8::StaticOrder, true, true>(lds, g, S, E); }
    GRID_BAR();
    if (bx < 2 * BATCH * NHEAD) hgrn_item(p, lds, bx);
    __syncthreads();
    phase_attn(p, lds);
    if (bx >= 2 * BATCH * NHEAD) phase_wconv_rest(p, lds, (bx - 2 * BATCH * NHEAD) * 8 + (int)(threadIdx.x >> 6), (nb - 2 * BATCH * NHEAD) * 8);
    GRID_BAR();
    phase_readout(p, vb, nb);
    GRID_BAR();
    { pg8::Gemm g{(const bf16*)(ws + WS_YA), (const bf16*)(ws + WS_WAT), ML, D_MODEL, WA}; pg8::StaticOrder S; S.init(ML, D_MODEL, nb, bx);
      EpiMergeA E{ws, p.out}; pg8::gemm_phase<EpiMergeA, pg8::StaticOrder, true, true>(lds, g, S, E); }
    GRID_BAR();
    { pg8::Gemm g{(const bf16*)(ws + WS_YB), (const bf16*)(ws + WS_WBT), ML, D_MODEL, WA}; pg8::StaticOrder S; S.init(ML, D_MODEL, nb, bx);
      EpiMergeB E{ws, p.out}; pg8::gemm_phase<EpiMergeB, pg8::StaticOrder, true, true>(lds, g, S, E); }
    GRID_BAR();
    { pg8::Gemm g{(const bf16*)(ws + WS_Z), (const bf16*)(ws + WS_WOT), ML, D_MODEL, D_MODEL}; pg8::StaticOrder S; S.init(ML, D_MODEL, nb, bx);
      EpiOutProj E{ws, p.x, p.norm2_g, p.out}; pg8::gemm_phase<EpiOutProj, pg8::StaticOrder, true, true>(lds, g, S, E); }
    GRID_BAR();
    { pg8::Gemm g{(const bf16*)(ws + WS_XMG), (const bf16*)(ws + WS_W13T), ML, 2 * FFN, D_MODEL}; pg8::StaticOrder S; S.init(ML, 2 * FFN, nb, bx);
      EpiFfnUp E{ws}; pg8::gemm_phase<EpiFfnUp, pg8::StaticOrder, true, true>(lds, g, S, E); }
    GRID_BAR();
    phase_conv(p, vb, nb);
    GRID_BAR();
    { pg8::Gemm g{(const bf16*)(ws + WS_ACT), (const bf16*)(ws + WS_W2T), ML, D_MODEL, FFN}; pg8::StaticOrder S; S.init(ML, D_MODEL, nb, bx);
      EpiFfnDown E{ws, p.out}; pg8::gemm_phase<EpiFfnDown, pg8::StaticOrder, true, true>(lds, g, S, E); }
#undef GRID_BAR
}

extern "C" void kernel_launch(void* const* d_in, const int* in_sizes, int n_in, void* d_out, int out_size, void* d_ws, size_t ws_size, hipStream_t stream) {
    static int grid = 0;
    if (grid == 0) {
        if (n_in != 22 || ws_size < WS_END || out_size != ML * D_MODEL) { fprintf(stderr, "kernel_launch: bad inputs (n_in %d, out %d, ws %zu, need %zu)\n", n_in, out_size, ws_size, (size_t)WS_END); grid = -1; return; }
        int dev = 0, cus = 0, per_cu = 0;
        if (hipGetDevice(&dev) != hipSuccess || hipDeviceGetAttribute(&cus, hipDeviceAttributeMultiprocessorCount, dev) != hipSuccess) { grid = -1; return; }
        if (hipFuncSetAttribute((const void*)mega_fwd, hipFuncAttributeMaxDynamicSharedMemorySize, LDS_BYTES) != hipSuccess) { fprintf(stderr, "kernel_launch: hipFuncSetAttribute failed\n"); grid = -1; return; }
        if (hipOccupancyMaxActiveBlocksPerMultiprocessor(&per_cu, (const void*)mega_fwd, NTHREADS, LDS_BYTES) != hipSuccess || per_cu < 1) { fprintf(stderr, "kernel_launch: occupancy query says %d blocks/CU\n", per_cu); (void)hipGetLastError(); grid = -1; return; }
        grid = cus;
        fprintf(stderr, "kernel_launch: grid %d (cus %d, occupancy %d/CU)\n", grid, cus, per_cu);
    }
    if (grid < 0) return;
    Params p{};
    const float** f = (const float**)&p;
    for (int i = 0; i < 22; ++i) f[i] = (const float*)d_in[i];
    p.out = (float*)d_out; p.ws = (unsigned char*)d_ws;
    (void)hipMemsetAsync((char*)d_ws + WS_CTL, 0, CTL_ZERO_BYTES, stream);
    hipLaunchKernelGGL(mega_fwd, dim3(grid), dim3(NTHREADS), LDS_BYTES, stream, p);
}
```

```cpp
#include <hip/hip_runtime.h>
#include <cstdio>
#include <cstdint>
#include <cmath>

__device__ __forceinline__ int lane_id() { int l; asm volatile("v_mbcnt_lo_u32_b32 %0, -1, 0\n\tv_mbcnt_hi_u32_b32 %0, -1, %0" : "=v"(l)); return l; }
__device__ __forceinline__ int tid_of(int wave_id) { int t = wave_id * 64 + lane_id(); asm volatile("" : "+v"(t)); return t; }
namespace pg8 {
#define PG8_LAS __attribute__((address_space(3)))
typedef unsigned short bf16_t;
typedef short bf16x8 __attribute__((ext_vector_type(8)));
typedef float f32x4 __attribute__((ext_vector_type(4)));
typedef unsigned u32x4 __attribute__((ext_vector_type(4)));
constexpr int BM = 256, BK = 64, HALF = 128, HTB = HALF * BK * 2  , STAGE_BYTES = 8 * HTB, NXCD = 8, WGM = 8;

__host__ __device__ __forceinline__ int lds_byte(int r, int c) { const int st = (r >> 4) * 2 + (c >> 5), rr = r & 15, cc = c & 31, ob = rr * 64 + cc * 2; return st * 1024 + (ob ^ (((ob >> 9) & 1) << 5)); }
__host__ __device__ __forceinline__ void stage_rc(int b, int& R, int& C) { const int st = b / 1024, sb = b % 1024, swz = sb ^ (((sb >> 9) & 1) << 5); R = (st >> 1) * 16 + swz / 64; C = (st & 1) * 32 + (swz % 64) / 2; }
__host__ __device__ __forceinline__ int perm32(int rho) { const int n = rho >> 4, i = rho & 15; return 8 * (i >> 2) + 4 * n + (i & 3); }

struct Unit { int pm, pn; };
struct Gemm { const bf16_t* A; const bf16_t* Bt; int M, N, K; };

struct StaticOrder {
    int nM, nN, nwg, G, c;
    __host__ __device__ void init(int M, int N, int G_, int c_) { nM = M / BM; nN = N / BM; nwg = nM * nN; G = G_; c = c_; }
    __host__ __device__ bool next(int i, Unit& u) const {
        const long L = (long)i * G + c; if (L >= nwg) return false;
        int wgid = (int)L; { const int q = nwg / NXCD, r = nwg % NXCD, xcd = wgid % NXCD, off = wgid / NXCD; wgid = (xcd < r ? xcd * (q + 1) : r * (q + 1) + (xcd - r) * q) + off; }
        const int nig = WGM * nN, gid = wgid / nig, fm = gid * WGM, gsz = (nM - fm) < WGM ? (nM - fm) : WGM;
        u.pm = fm + ((wgid % nig) % gsz); u.pn = (wgid % nig) / gsz; return true;
    }
    __device__ __forceinline__ void a_ready(const Unit&) const {}
    __device__ __forceinline__ void done(const Unit&) const {}
};

template <class Epi, class Sched, bool ALIGN_EPI = false, bool SP2 = false>
__device__ __forceinline__ void gemm_phase(PG8_LAS unsigned char* lds, const Gemm g, const Sched& S, const Epi& E, const int wave_id_in) {
    int tid_o = tid_of(wave_id_in);
    const int tid = tid_o, wid = __builtin_amdgcn_readfirstlane(tid >> 6), lane = tid & 63, wr = wid >> 2, wc = wid & 3, fr = lane & 15, fq = lane >> 4;
    const int K = g.K, nt = K / BK;
    unsigned voffA[2], voffB[2];
#pragma unroll
    for (int i = 0; i < 2; ++i) { int R, C; stage_rc(tid * 16 + i * 8192, R, C); const int Rb = Epi::PERM ? ((R & ~31) + perm32(R & 31)) : R;
        voffA[i] = (unsigned)(R * K + C) * 2u; voffB[i] = (unsigned)(Rb * K + C) * 2u; }
    const size_t kstep = (size_t)(BK * 2);
    const size_t hstep = (size_t)HALF * K * 2;
    const size_t tstep = 2 * hstep;
    const unsigned ldsw = (unsigned)wid * 1024u;
    const int aoff = lds_byte(wr * 64 + fr, fq * 8), boff = lds_byte(wc * 32 + fr, fq * 8);
#define PG8_SA(b, h) (((b) * 2 + (h)) * HTB)
#define PG8_SB(b, h) ((4 + (b) * 2 + (h)) * HTB)
#define PG8_STAGE(bufoff, gbase, voff) do { _Pragma("unroll") for (int _i = 0; _i < 2; ++_i) \
        __builtin_amdgcn_global_load_lds((const unsigned*)((const char*)(gbase) + (voff)[_i]), (PG8_LAS unsigned*)(lds + (bufoff) + ldsw + _i * 8192), 16, 0, 0); } while (0)
#define PG8_LDA(dst, b, h) do { _Pragma("unroll") for (int m = 0; m < 4; ++m) _Pragma("unroll") for (int k = 0; k < 2; ++k) dst[m][k] = *(const PG8_LAS bf16x8*)(lds + PG8_SA(b, h) + aoff + m * 2048 + k * 1024); } while (0)
#define PG8_LDB(dst, b, h) do { _Pragma("unroll") for (int n = 0; n < 2; ++n) _Pragma("unroll") for (int k = 0; k < 2; ++k) dst[n][k] = *(const PG8_LAS bf16x8*)(lds + PG8_SB(b, h) + boff + n * 2048 + k * 1024); } while (0)
#define PG8_MMA(ai, bj, At, Bt) do { __builtin_amdgcn_s_setprio(1); _Pragma("unroll") for (int m = 0; m < 4; ++m) _Pragma("unroll") for (int n = 0; n < 2; ++n) _Pragma("unroll") for (int k = 0; k < 2; ++k) \
        acc[ai][bj][m][n] = __builtin_amdgcn_mfma_f32_16x16x32_bf16(Bt[n][k], At[m][k], acc[ai][bj][m][n], 0, 0, 0); __builtin_amdgcn_s_setprio(0); } while (0)
#define PG8_WAIT_V(n) asm volatile("s_waitcnt vmcnt(" #n ")" ::: "memory")
#define PG8_WAIT_L(n) asm volatile("s_waitcnt lgkmcnt(" #n ")" ::: "memory")
#define PG8_BAR __builtin_amdgcn_s_barrier()
#define PG8_SCHED __builtin_amdgcn_sched_barrier(0)
    Unit cur, nxt; int ui = 0;
    if (!S.next(0, cur)) return;
    f32x4 acc[2][2][4][2];
#pragma unroll
    for (int a = 0; a < 2; ++a)
#pragma unroll
        for (int b = 0; b < 2; ++b)
#pragma unroll
            for (int m = 0; m < 4; ++m)
#pragma unroll
                for (int n = 0; n < 2; ++n) acc[a][b][m][n] = (f32x4){0.f, 0.f, 0.f, 0.f};
    bf16x8 At[4][2], B0[2][2], B1[2][2];
    const char* cA = (const char*)g.A + (size_t)cur.pm * tstep; const char* cB = (const char*)g.Bt + (size_t)cur.pn * tstep;
    S.a_ready(cur);
    if constexpr (SP2) {
        PG8_STAGE(PG8_SB(0, 0), cB, voffB); PG8_STAGE(PG8_SB(0, 1), cB + hstep, voffB); PG8_STAGE(PG8_SA(0, 0), cA, voffA); PG8_STAGE(PG8_SA(0, 1), cA + hstep, voffA);
        if (wr == 1) PG8_BAR;
        PG8_WAIT_V(2); PG8_BAR;
        PG8_STAGE(PG8_SB(1, 0), cB + kstep, voffB); PG8_STAGE(PG8_SA(1, 0), cA + kstep, voffA); PG8_STAGE(PG8_SB(1, 1), cB + hstep + kstep, voffB);
        PG8_WAIT_V(6); PG8_BAR;
    } else {
        PG8_STAGE(PG8_SB(0, 0), cB, voffB); PG8_STAGE(PG8_SA(0, 0), cA, voffA); PG8_STAGE(PG8_SB(0, 1), cB + hstep, voffB); PG8_STAGE(PG8_SA(0, 1), cA + hstep, voffA);
        if (wr == 1) PG8_BAR;
        PG8_WAIT_V(4); PG8_BAR;
        PG8_STAGE(PG8_SB(1, 0), cB + kstep, voffB); PG8_STAGE(PG8_SA(1, 0), cA + kstep, voffA); PG8_STAGE(PG8_SB(1, 1), cB + hstep + kstep, voffB);
        PG8_WAIT_V(6); PG8_BAR;
    }
    for (;;) {
        const bool has_next = S.next(ui + 1, nxt);
        const char* nA = has_next ? (const char*)g.A + (size_t)nxt.pm * tstep : cA; const char* nB = has_next ? (const char*)g.Bt + (size_t)nxt.pn * tstep : cB;
        for (int t = 0; t < nt; t += 2) {
            const bool last = (t == nt - 2);
            const char* a1 = cA + (size_t)(t + 1) * kstep;
            const char* a2 = last ? nA : cA + (size_t)(t + 2) * kstep; const char* b2 = last ? nB : cB + (size_t)(t + 2) * kstep;
            const char* a3 = a2 + kstep; const char* b3 = b2 + kstep;
            if (last && has_next) S.a_ready(nxt);
            if constexpr (SP2) {
            PG8_LDB(B0, 0, 0); PG8_LDB(B1, 0, 1); PG8_SCHED; PG8_LDA(At, 0, 0); PG8_STAGE(PG8_SA(1, 1), a1 + hstep, voffA);
            PG8_WAIT_V(8); PG8_WAIT_L(0); PG8_BAR; PG8_MMA(0, 0, At, B0); PG8_MMA(0, 1, At, B1); PG8_BAR; PG8_SCHED;
            PG8_LDA(At, 0, 1); PG8_STAGE(PG8_SB(0, 0), b2, voffB); PG8_STAGE(PG8_SB(0, 1), b2 + hstep, voffB); PG8_STAGE(PG8_SA(0, 0), a2, voffA);
            PG8_WAIT_V(8); PG8_WAIT_L(0); PG8_BAR; PG8_MMA(1, 0, At, B0); PG8_MMA(1, 1, At, B1); PG8_BAR; PG8_SCHED;
            PG8_LDB(B0, 1, 0); PG8_LDB(B1, 1, 1); PG8_SCHED; PG8_LDA(At, 1, 0); PG8_STAGE(PG8_SA(0, 1), a2 + hstep, voffA);
            PG8_WAIT_V(8); PG8_WAIT_L(0); PG8_BAR; PG8_MMA(0, 0, At, B0); PG8_MMA(0, 1, At, B1); PG8_BAR; PG8_SCHED;
            PG8_LDA(At, 1, 1); PG8_STAGE(PG8_SB(1, 0), b3, voffB); PG8_STAGE(PG8_SB(1, 1), b3 + hstep, voffB); PG8_STAGE(PG8_SA(1, 0), a3, voffA);
            PG8_WAIT_V(8); PG8_WAIT_L(0); PG8_BAR; PG8_MMA(1, 0, At, B0); PG8_MMA(1, 1, At, B1); PG8_BAR; PG8_SCHED;
            } else {
            PG8_LDB(B0, 0, 0); PG8_SCHED; PG8_LDA(At, 0, 0); PG8_STAGE(PG8_SA(1, 1), a1 + hstep, voffA);
            PG8_WAIT_L(8); PG8_BAR; PG8_WAIT_L(0); PG8_MMA(0, 0, At, B0); PG8_BAR; PG8_SCHED;
            PG8_LDB(B1, 0, 1); PG8_STAGE(PG8_SB(0, 0), b2, voffB);
            PG8_BAR; PG8_WAIT_L(0); PG8_MMA(0, 1, At, B1); PG8_BAR;
            PG8_LDA(At, 0, 1); PG8_STAGE(PG8_SA(0, 0), a2, voffA);
            PG8_BAR; PG8_WAIT_L(0); PG8_MMA(1, 0, At, B0); PG8_BAR; PG8_SCHED;
            PG8_STAGE(PG8_SB(0, 1), b2 + hstep, voffB);
            PG8_WAIT_V(6); PG8_BAR; PG8_MMA(1, 1, At, B1); PG8_BAR;
            PG8_LDB(B0, 1, 0); PG8_SCHED; PG8_LDA(At, 1, 0); PG8_STAGE(PG8_SA(0, 1), a2 + hstep, voffA);
            PG8_WAIT_L(8); PG8_BAR; PG8_WAIT_L(0); PG8_MMA(0, 0, At, B0); PG8_BAR; PG8_SCHED;
            PG8_LDB(B1, 1, 1); PG8_STAGE(PG8_SB(1, 0), b3, voffB);
            PG8_BAR; PG8_WAIT_L(0); PG8_MMA(0, 1, At, B1); PG8_BAR;
            PG8_LDA(At, 1, 1); PG8_STAGE(PG8_SA(1, 0), a3, voffA);
            PG8_BAR; PG8_WAIT_L(0); PG8_MMA(1, 0, At, B0); PG8_BAR; PG8_SCHED;
            PG8_STAGE(PG8_SB(1, 1), b3 + hstep, voffB);
            PG8_WAIT_V(6); PG8_BAR; PG8_MMA(1, 1, At, B1); PG8_BAR;
            }
        }
        if constexpr (ALIGN_EPI) { if (wr == 0) PG8_BAR; }
        if constexpr (!Epi::AFTER_DRAIN) { E(acc, cur, wr, wc, fr, fq); S.done(cur); }
        if (!has_next) break;
#pragma unroll
        for (int a = 0; a < 2; ++a)
#pragma unroll
            for (int b = 0; b < 2; ++b)
#pragma unroll
                for (int m = 0; m < 4; ++m)
#pragma unroll
                    for (int n = 0; n < 2; ++n) acc[a][b][m][n] = (f32x4){0.f, 0.f, 0.f, 0.f};
        cur = nxt; cA = nA; cB = nB; ++ui;
        if constexpr (ALIGN_EPI) { if (wr == 1) PG8_BAR; }
    }
    PG8_WAIT_V(0);
    if constexpr (!ALIGN_EPI) { if (wr == 0) PG8_BAR; }
    PG8_BAR;
    if constexpr (Epi::AFTER_DRAIN) { E.fused(acc, cur, wr, wc, fr, fq, lds, wid, lane); S.done(cur); }
#undef PG8_SA
#undef PG8_SB
#undef PG8_STAGE
#undef PG8_LDA
#undef PG8_LDB
#undef PG8_MMA
#undef PG8_WAIT_V
#undef PG8_WAIT_L
#undef PG8_BAR
#undef PG8_SCHED
}
}

constexpr int D_MODEL = 2048, BATCH = 4, SEQ = 2048, CTX = 256, GRID_W = 64, NHEAD = 8, HD = 128, WA = 1024;
constexpr int FFN = 5632, IN_COLS = 12288, NMOD = 6;
constexpr int ML = BATCH * SEQ;
constexpr int MC = BATCH * CTX;
constexpr int MT = ML + MC;
constexpr float EPS = 1e-6f;
constexpr int NTHREADS = 512;
constexpr int VT_PITCH = SEQ + CTX;

typedef unsigned short bf16;
typedef float f32x4 __attribute__((ext_vector_type(4)));
typedef unsigned u32x2 __attribute__((ext_vector_type(2)));
typedef unsigned u32x4 __attribute__((ext_vector_type(4)));
#define LAS __attribute__((address_space(3)))

typedef float f32x2_t __attribute__((ext_vector_type(2)));
typedef __bf16 bf16x2_t __attribute__((ext_vector_type(2)));
__device__ __forceinline__ unsigned pk2(float lo, float hi) { const f32x2_t v = {lo, hi}; const bf16x2_t b = __builtin_convertvector(v, bf16x2_t); return __builtin_bit_cast(unsigned, b); }
__device__ __forceinline__ unsigned f2bf(float f) { return pk2(f, 0.f) & 0xffffu; }
__device__ __forceinline__ float bf2f(unsigned short h) { return __builtin_bit_cast(float, (unsigned)h << 16); }
__device__ __forceinline__ float bflo(unsigned w) { return __builtin_bit_cast(float, w << 16); }
__device__ __forceinline__ float bfhi(unsigned w) { return __builtin_bit_cast(float, w & 0xffff0000u); }
__device__ __forceinline__ float sigmoidf_(float x) { return 1.0f / (1.0f + __expf(-x)); }
__device__ __forceinline__ float siluf_(float x) { return x / (1.0f + __expf(-x)); }
__device__ __forceinline__ float wave_sum(float v) {
#pragma unroll
    for (int o = 1; o < 64; o <<= 1) v += __shfl_xor(v, o);
    return v;
}
__device__ __forceinline__ float wave_max(float v) {
#pragma unroll
    for (int o = 1; o < 64; o <<= 1) v = fmaxf(v, __shfl_xor(v, o));
    return v;
}

constexpr size_t al256(size_t x) { return (x + 255) & ~(size_t)255; }
constexpr size_t WS_CTL   = 0;
constexpr size_t CTL_ZERO_BYTES = 1u << 20;
constexpr size_t WS_ROWSQ = 64 * 1024;
constexpr size_t WS_BIAS2 = WS_ROWSQ + (size_t)ML * 4;
static_assert(WS_BIAS2 + (size_t)4 * 2 * FFN * 4 <= CTL_ZERO_BYTES, "ctl");
constexpr size_t WS_MOD   = CTL_ZERO_BYTES;
constexpr size_t WS_LB    = al256(WS_MOD + (size_t)5 * IN_COLS * 4);
constexpr size_t WS_ROPE  = al256(WS_LB + 2 * WA * 4);
constexpr size_t WS_SMALL_END = al256(WS_ROPE + 2 * 64 * 32 * 4);
constexpr size_t WS_W13T  = al256(WS_SMALL_END);
constexpr size_t WS_W2T   = WS_W13T + (size_t)2 * FFN * D_MODEL * 2;
constexpr size_t WS_WAT   = WS_W2T + (size_t)D_MODEL * FFN * 2;
constexpr size_t WS_WBT   = WS_WAT + (size_t)D_MODEL * WA * 2;
constexpr size_t WS_WOT   = WS_WBT + (size_t)D_MODEL * WA * 2;
constexpr size_t WS_A_END = WS_WOT + (size_t)D_MODEL * D_MODEL * 2;
constexpr size_t SEGB = (size_t)MT * WA * 2;
constexpr size_t WS_QA  = WS_A_END;
constexpr size_t WS_FW  = WS_QA + SEGB;
constexpr size_t WS_FB  = WS_FW + 2 * SEGB;
constexpr size_t WS_IA  = WS_FB + 2 * SEGB;
constexpr size_t WS_GA  = WS_IA + SEGB;
constexpr size_t WS_QN  = WS_GA + (size_t)ML * WA * 2;
constexpr size_t WS_KN  = WS_QN + (size_t)ML * WA * 2;
constexpr size_t WS_VN  = WS_KN + SEGB;
constexpr size_t WS_GTA = WS_VN + SEGB;
constexpr size_t WS_GTB = WS_GTA + (size_t)ML * D_MODEL * 2;
constexpr size_t WS_D_END = WS_GTB + (size_t)ML * D_MODEL * 2;
constexpr size_t WS_WINT = WS_D_END;
constexpr size_t WS_OF   = WS_WINT;
constexpr size_t WS_OB   = WS_OF + (size_t)ML * WA * 2;
constexpr size_t WS_B_END = WS_WINT + (size_t)IN_COLS * D_MODEL * 2;
static_assert(WS_OB + (size_t)ML * WA * 2 <= WS_B_END, "B");
constexpr size_t WS_H   = WS_B_END;
constexpr size_t WS_YA  = WS_H;
constexpr size_t WS_YB  = WS_YA + (size_t)ML * WA * 2;
constexpr size_t WS_C_END = WS_H + (size_t)MT * D_MODEL * 2;
constexpr size_t WS_ACT_END = WS_D_END + (size_t)ML * FFN * 2;
constexpr size_t WS_HIMG = WS_WINT;
constexpr size_t WS_HIMG_END = WS_HIMG + (size_t)64 * 36 * 41472;
constexpr size_t WS_T1 = WS_WINT;
constexpr size_t WS_END0 = WS_C_END > WS_ACT_END ? WS_C_END : WS_ACT_END;
constexpr size_t WS_END = WS_END0 > WS_HIMG_END ? WS_END0 : WS_HIMG_END;
static_assert(WS_END <= 445000000, "ws budget");
constexpr size_t WS_Z   = WS_QA;
constexpr size_t WS_XMG = WS_GTB;
constexpr size_t WS_A13 = WS_QA;
static_assert(WS_A13 + (size_t)ML * 2 * FFN * 2 <= WS_XMG, "A13 overlay");
constexpr size_t WS_ACT = WS_WINT;
static_assert(WS_ACT + (size_t)ML * FFN * 2 <= WS_END, "ACT overlay");

struct Params {
    const float *x, *c, *ctx, *c_ctx, *ada_w, *ada_b, *norm1_g, *norm2_g, *w_in, *lb_logits, *hgrn_norm_g, *q_norm_g, *k_norm_g, *rel_bias,
                *w_a, *w_b, *w_o, *w1, *w3, *conv_w, *conv_b, *w2;
    float* out;
    unsigned char* ws;
    int wave_id, pad;
};

template <bool QKPERM, bool BIAS>
__device__ __forceinline__ void transpose_item(const float* W, int K, int N, bf16* WT, int row_off, LAS float* scr, int item, int lane, const float* sh2 = nullptr, float* bias2 = nullptr) {
    const int nblk = N / 32, kb = item / nblk, nb = item % nblk, k0 = 64 * kb, n0 = 32 * nb;
    float wv[32];
#pragma unroll
    for (int i = 0; i < 32; ++i) wv[i] = W[(size_t)(k0 + 2 * i + (lane >> 5)) * N + n0 + (lane & 31)];
#pragma unroll
    for (int i = 0; i < 32; ++i) scr[(2 * i + (lane >> 5)) * 33 + (lane & 31)] = wv[i];
    if (BIAS) {
        float a0 = 0.f, a1 = 0.f, a2 = 0.f, a3 = 0.f;
#pragma unroll
        for (int i = 0; i < 32; ++i) { const int k = k0 + 2 * i + (lane >> 5); const float w = wv[i];
            a0 += w * sh2[0 * IN_COLS + k]; a1 += w * sh2[1 * IN_COLS + k]; a2 += w * sh2[2 * IN_COLS + k]; a3 += w * sh2[3 * IN_COLS + k]; }
        a0 += __shfl_xor(a0, 32); a1 += __shfl_xor(a1, 32); a2 += __shfl_xor(a2, 32); a3 += __shfl_xor(a3, 32);
        if (lane < 32) { float* bp = bias2 + row_off + n0 + lane; atomicAdd(bp, a0); atomicAdd(bp + 2 * FFN, a1); atomicAdd(bp + 4 * FFN, a2); atomicAdd(bp + 6 * FFN, a3); }
    }
    asm volatile("s_waitcnt lgkmcnt(0)" ::: "memory");
    const int c = lane & 7;
#pragma unroll
    for (int j = 0; j < 4; ++j) { const int n = (lane >> 3) + 8 * j; const LAS float* s = scr + (8 * c) * 33 + n;
        u32x4 o; o.x = pk2(s[0 * 33], s[1 * 33]); o.y = pk2(s[2 * 33], s[3 * 33]); o.z = pk2(s[4 * 33], s[5 * 33]); o.w = pk2(s[6 * 33], s[7 * 33]);
        int cdst = n0 + n;
        if (QKPERM && cdst >= 5 * WA && cdst < 7 * WA) cdst = (cdst & ~0x30) | ((cdst & 0x10) << 1) | ((cdst & 0x20) >> 1);
        *(u32x4*)(WT + (size_t)(row_off + cdst) * K + k0 + 8 * c) = o; }
    asm volatile("s_waitcnt lgkmcnt(0)" ::: "memory");
}
__device__ __forceinline__ void phase_wconv_in(const Params& p, LAS unsigned char* lds, int gw, int NGW) {
    const int lane = lane_id(), wave = p.wave_id;
    LAS float* scr = (LAS float*)(lds + wave * 16384);
    constexpr int I_IN = (D_MODEL / 64) * (IN_COLS / 32);
    for (int it = gw; it < I_IN; it += NGW) transpose_item<true, false>(p.w_in, D_MODEL, IN_COLS, (bf16*)(p.ws + WS_WINT), 0, scr, it, lane);
}
__device__ __forceinline__ void phase_wconv_rest(const Params& p, LAS unsigned char* lds, int gw, int NGW) {
    const int lane = lane_id(), wave = p.wave_id;
    LAS float* scr = (LAS float*)(lds + 16384 + wave * 16384);
    constexpr int I_A = (WA / 64) * (D_MODEL / 32), I_O = (D_MODEL / 64) * (D_MODEL / 32), I_1 = (D_MODEL / 64) * (FFN / 32), I_2 = (FFN / 64) * (D_MODEL / 32);
    constexpr int NITEMS = 2 * I_A + I_O + 2 * I_1 + I_2;
    unsigned char* ws = p.ws;
    const float* sh2 = (const float*)(ws + WS_MOD) + 3 * D_MODEL; float* b2 = (float*)(ws + WS_BIAS2);
    for (int it = gw; it < NITEMS; it += NGW) {
        int r = it;
        if (r < I_A) { transpose_item<false, false>(p.w_a, WA, D_MODEL, (bf16*)(ws + WS_WAT), 0, scr, r, lane); continue; } r -= I_A;
        if (r < I_A) { transpose_item<false, false>(p.w_b, WA, D_MODEL, (bf16*)(ws + WS_WBT), 0, scr, r, lane); continue; } r -= I_A;
        if (r < I_O) { transpose_item<false, false>(p.w_o, D_MODEL, D_MODEL, (bf16*)(ws + WS_WOT), 0, scr, r, lane); continue; } r -= I_O;
        if (r < I_1) { transpose_item<false, true>(p.w1, D_MODEL, FFN, (bf16*)(ws + WS_W13T), 0, scr, r, lane, sh2, b2); continue; } r -= I_1;
        if (r < I_1) { transpose_item<false, true>(p.w3, D_MODEL, FFN, (bf16*)(ws + WS_W13T), FFN, scr, r, lane, sh2, b2); continue; } r -= I_1;
        transpose_item<false, false>(p.w2, FFN, D_MODEL, (bf16*)(ws + WS_W2T), 0, scr, r, lane);
    }
}

__device__ __forceinline__ void phase_mod(const Params& p, LAS unsigned char* lds, int vb, int nb) {
    const int tid = tid_of(p.wave_id);
    LAS float* sc = (LAS float*)lds;
    LAS float* red = (LAS float*)(lds + 5 * 2048 * 4);
    for (int i = tid; i < 5 * D_MODEL; i += NTHREADS) { const int r = i / D_MODEL, k = i % D_MODEL; const float v = (r < 4) ? p.c[r * D_MODEL + k] : p.c_ctx[k]; sc[i] = siluf_(v); }
    __syncthreads();
    float* mod = (float*)(p.ws + WS_MOD);
    const int c4 = tid & 15, kp = tid >> 4;
    for (int item = vb; item < IN_COLS / 64; item += nb) {
        const int n0 = item * 64 + c4 * 4;
        f32x4 acc[5];
#pragma unroll
        for (int r = 0; r < 5; ++r) acc[r] = (f32x4){0.f, 0.f, 0.f, 0.f};
#pragma unroll 8
        for (int k = kp; k < D_MODEL; k += 32) {
            const f32x4 w = *(const f32x4*)(p.ada_w + (size_t)k * IN_COLS + n0);
#pragma unroll
            for (int r = 0; r < 5; ++r) acc[r] += w * sc[r * D_MODEL + k];
        }
#pragma unroll
        for (int r = 0; r < 5; ++r) *(LAS f32x4*)(red + (kp * 5 + r) * 64 + c4 * 4) = acc[r];
        __syncthreads();
        if (tid < 320) { const int r = tid / 64, cidx = tid % 64; float s = 0.f;
            for (int q = 0; q < 32; ++q) s += red[(q * 5 + r) * 64 + cidx];
            mod[r * IN_COLS + item * 64 + cidx] = s + p.ada_b[item * 64 + cidx]; }
        __syncthreads();
    }
    if (vb == nb - 1) { float* rt = (float*)(p.ws + WS_ROPE);
        for (int i = tid; i < 64 * 32; i += NTHREADS) { const int pos = i >> 5, j = i & 31; const float inv = exp2f(-(float)j * (13.287712379549449f / 32.0f)); float sn, cs; sincosf((float)pos * inv, &sn, &cs); rt[i] = cs; rt[2048 + i] = sn; } }
    if (vb == 0) { float* lb = (float*)(p.ws + WS_LB);
        for (int i = tid; i < 2 * WA; i += NTHREADS) { const int d = i / WA, cc = i % WA; const float l0 = p.lb_logits[d * 2 * WA + cc], l1 = p.lb_logits[d * 2 * WA + WA + cc]; lb[i] = 1.0f / (1.0f + expf(l1 - l0)); } }
}

__device__ __forceinline__ void phase_h(const Params& p, int vb, int nb) {
    const int tid = tid_of(p.wave_id), lane = tid & 63, wave = p.wave_id;
    const float* mod = (const float*)(p.ws + WS_MOD);
    bf16* H = (bf16*)(p.ws + WS_H);
    for (int m = vb * 8 + wave; m < MT; m += nb * 8) {
        const float* xr = (m < ML) ? p.x + (size_t)m * D_MODEL : p.ctx + (size_t)(m - ML) * D_MODEL;
        const int mr = (m < ML) ? (m / SEQ) : 4;
        const float* sh = mod + (size_t)mr * IN_COLS, *scl = sh + D_MODEL;
        f32x4 v[8]; float s = 0.f;
#pragma unroll
        for (int j = 0; j < 8; ++j) { v[j] = *(const f32x4*)(xr + 4 * lane + 256 * j); s += (v[j].x * v[j].x + v[j].y * v[j].y) + (v[j].z * v[j].z + v[j].w * v[j].w); }
        const float rstd = 1.0f / sqrtf(wave_sum(s) * (1.0f / D_MODEL) + EPS);
#pragma unroll
        for (int j = 0; j < 8; ++j) { const int k = 4 * lane + 256 * j;
            const f32x4 g = *(const f32x4*)(p.norm1_g + k), a = *(const f32x4*)(scl + k), b = *(const f32x4*)(sh + k);
            const f32x4 h = v[j] * rstd * g * (a + 1.0f) + b;
            u32x2 o; o.x = pk2(h.x, h.y); o.y = pk2(h.z, h.w);
            *(u32x2*)(H + (size_t)m * D_MODEL + k) = o; }
    }
}

#define EPI_LOOP_BEGIN \
    _Pragma("unroll") for (int ai = 0; ai < 2; ++ai) _Pragma("unroll") for (int m = 0; m < 4; ++m) { const int row = u.pm * 256 + ai * 128 + wr * 64 + m * 16 + fr; \
    _Pragma("unroll") for (int bj = 0; bj < 2; ++bj) _Pragma("unroll") for (int n = 0; n < 2; ++n) { const int col = u.pn * 256 + bj * 128 + wc * 32 + n * 16 + fq * 4; const f32x4 v = acc[ai][bj][m][n];
#define EPI_LOOP_END } }

struct EpiInProj {
    static constexpr bool PERM = false, AFTER_DRAIN = false;
    unsigned char* ws; LAS unsigned char* lds; const float* qg; const float* kg;
    __device__ __forceinline__ void operator()(const f32x4 (&acc)[2][2][4][2], const pg8::Unit& u, int wr, int wc, int fr, int fq) const {
        const int seg = u.pn >> 2;
        const bool ctxrow = u.pm >= ML / 256;
        const float* lb = (const float*)(ws + WS_LB);
        if (seg == 1 || seg == 2) {
            float* F = (float*)(ws + (seg == 1 ? WS_FW : WS_FB)); const float* lbd = lb + (seg - 1) * WA;
            EPI_LOOP_BEGIN
                const int c = col - seg * WA; const f32x4 l = *(const f32x4*)(lbd + c); f32x4 o;
                o.x = logf(l.x + (1.0f - l.x) * sigmoidf_(v.x)); o.y = logf(l.y + (1.0f - l.y) * sigmoidf_(v.y));
                o.z = logf(l.z + (1.0f - l.z) * sigmoidf_(v.z)); o.w = logf(l.w + (1.0f - l.w) * sigmoidf_(v.w));
                *(f32x4*)(F + (size_t)row * WA + c) = o;
            EPI_LOOP_END
        } else if (seg == 7) {
            bf16* VT = (bf16*)(ws + WS_VN);
            EPI_LOOP_BEGIN
                const int c = col - 7 * WA; const int hh = c >> 7, d = c & 127;
                int bb, tok; if (row < ML) { bb = row / SEQ; tok = row % SEQ; } else { bb = (row - ML) / CTX; tok = SEQ + (row - ML) % CTX; }
                bf16* o = VT + ((size_t)(bb * NHEAD + hh) * HD + d) * VT_PITCH + tok;
                o[0] = (bf16)f2bf(v.x); o[VT_PITCH] = (bf16)f2bf(v.y); o[2 * VT_PITCH] = (bf16)f2bf(v.z); o[3 * VT_PITCH] = (bf16)f2bf(v.w);
            EPI_LOOP_END
        } else if (seg == 5 || seg == 6) {
            if (ctxrow && seg == 5) return;
            LAS float* ssq = (LAS float*)(lds + 131072);
            const float* gn = (seg == 5) ? qg : kg; const float* rt = (const float*)(ws + WS_ROPE);
            bf16* O = (bf16*)(ws + (seg == 5 ? WS_QN : WS_KN));
#pragma unroll
            for (int ai = 0; ai < 2; ++ai)
#pragma unroll
                for (int m = 0; m < 4; ++m)
#pragma unroll
                    for (int bj = 0; bj < 2; ++bj) { const f32x4 a = acc[ai][bj][m][0], b = acc[ai][bj][m][1];
                        float sq = (a.x * a.x + a.y * a.y) + (a.z * a.z + a.w * a.w) + (b.x * b.x + b.y * b.y) + (b.z * b.z + b.w * b.w);
                        sq += __shfl_xor(sq, 16); sq += __shfl_xor(sq, 32);
                        if (fq == 0) ssq[((ai * 128 + wr * 64 + m * 16 + fr) * 2 + bj) * 4 + wc] = sq; }
            asm volatile("s_waitcnt lgkmcnt(0)" ::: "memory"); __builtin_amdgcn_s_barrier(); asm volatile("" ::: "memory");
            const int H = wc >> 1, jj = 16 * (wc & 1) + 4 * fq;
            const f32x4 g0 = *(const f32x4*)(gn + 64 * H + jj), g1 = *(const f32x4*)(gn + 64 * H + 32 + jj);
#pragma unroll
            for (int ai = 0; ai < 2; ++ai)
#pragma unroll
                for (int m = 0; m < 4; ++m) { const int rl = ai * 128 + wr * 64 + m * 16 + fr; const int row = u.pm * 256 + rl;
                    f32x4 cs = (f32x4){1.f, 1.f, 1.f, 1.f}, sn = (f32x4){0.f, 0.f, 0.f, 0.f};
                    if (!ctxrow) { const int t = row & (SEQ - 1); const int pos = (H == 0) ? (t >> 6) : (t & 63); cs = *(const f32x4*)(rt + pos * 32 + jj); sn = *(const f32x4*)(rt + 2048 + pos * 32 + jj); }
#pragma unroll
                    for (int bj = 0; bj < 2; ++bj) { const f32x4 s4 = *(const LAS f32x4*)(ssq + (rl * 2 + bj) * 4);
                        const float rstd = 1.0f / sqrtf(((s4.x + s4.y) + (s4.z + s4.w)) * (1.0f / HD) + EPS);
                        const f32x4 u1 = acc[ai][bj][m][0] * rstd * g0, u2 = acc[ai][bj][m][1] * rstd * g1;
                        const f32x4 o1 = u1 * cs - u2 * sn, o2 = u1 * sn + u2 * cs;
                        bf16* op = O + (size_t)row * WA + (u.pn & 3) * 256 + bj * 128 + wc * 32 + fq * 4;
                        u32x2 w1; w1.x = pk2(o1.x, o1.y); w1.y = pk2(o1.z, o1.w); *(u32x2*)op = w1;
                        u32x2 w2; w2.x = pk2(o2.x, o2.y); w2.y = pk2(o2.z, o2.w); *(u32x2*)(op + 16) = w2; }
                    asm volatile("" ::: "memory"); }
            asm volatile("s_waitcnt lgkmcnt(0)" ::: "memory"); __builtin_amdgcn_s_barrier(); asm volatile("" ::: "memory");
        } else if (seg == 0 || seg == 3) {
            if (ctxrow && seg == 0) return;
            bf16* O = (bf16*)(ws + (seg == 0 ? WS_QA : WS_IA));
            EPI_LOOP_BEGIN
                const int c = col - seg * WA; u32x2 o; o.x = pk2(v.x, v.y); o.y = pk2(v.z, v.w);
                *(u32x2*)(O + (size_t)row * WA + c) = o;
            EPI_LOOP_END
        } else if (seg == 4) {
            if (ctxrow) return;
            bf16* O = (bf16*)(ws + WS_GA);
            EPI_LOOP_BEGIN
                const int c = col - seg * WA; u32x2 o; o.x = pk2(siluf_(v.x), siluf_(v.y)); o.y = pk2(siluf_(v.z), siluf_(v.w));
                *(u32x2*)(O + (size_t)row * WA + c) = o;
            EPI_LOOP_END
        } else {
            if (ctxrow) return;
            const bool isa = seg < 10;
            bf16* O = (bf16*)(ws + (isa ? WS_GTA : WS_GTB)); const int cbase = isa ? 8 * WA : 10 * WA;
            EPI_LOOP_BEGIN
                const int c = col - cbase; u32x2 o; o.x = pk2(sigmoidf_(v.x), sigmoidf_(v.y)); o.y = pk2(sigmoidf_(v.z), sigmoidf_(v.w));
                *(u32x2*)(O + (size_t)row * D_MODEL + c) = o;
            EPI_LOOP_END
        }
    }
};

struct EpiMergeA {
    static constexpr bool PERM = false, AFTER_DRAIN = false;
    unsigned char* ws; float* tmp;
    __device__ __forceinline__ void operator()(const f32x4 (&acc)[2][2][4][2], const pg8::Unit& u, int wr, int wc, int fr, int fq) const {
        const bf16* G = (const bf16*)(ws + WS_GTA);
        EPI_LOOP_BEGIN
            const u32x2 g = *(const u32x2*)(G + (size_t)row * D_MODEL + col);
            f32x4 o; o.x = bflo(g.x) * v.x; o.y = bfhi(g.x) * v.y; o.z = bflo(g.y) * v.z; o.w = bfhi(g.y) * v.w;
            *(f32x4*)(tmp + (size_t)row * D_MODEL + col) = o;
        EPI_LOOP_END
    }
};
struct EpiMergeB {
    static constexpr bool PERM = false, AFTER_DRAIN = false;
    unsigned char* ws; const float* tmp;
    __device__ __forceinline__ void operator()(const f32x4 (&acc)[2][2][4][2], const pg8::Unit& u, int wr, int wc, int fr, int fq) const {
        const bf16* G = (const bf16*)(ws + WS_GTB); bf16* Z = (bf16*)(ws + WS_Z);
        EPI_LOOP_BEGIN
            const u32x2 g = *(const u32x2*)(G + (size_t)row * D_MODEL + col);
            const f32x4 t = *(const f32x4*)(tmp + (size_t)row * D_MODEL + col);
            u32x2 o; o.x = pk2(t.x + bflo(g.x) * v.x, t.y + bfhi(g.x) * v.y); o.y = pk2(t.z + bflo(g.y) * v.z, t.w + bfhi(g.y) * v.w);
            *(u32x2*)(Z + (size_t)row * D_MODEL + col) = o;
        EPI_LOOP_END
    }
};
struct EpiOutProj {
    static constexpr bool PERM = false, AFTER_DRAIN = false;
    unsigned char* ws; const float* x; const float* norm2_g; float* out;
    __device__ __forceinline__ void operator()(const f32x4 (&acc)[2][2][4][2], const pg8::Unit& u, int wr, int wc, int fr, int fq) const {
        const float* mod = (const float*)(ws + WS_MOD); bf16* XMG = (bf16*)(ws + WS_XMG); float* rowsq = (float*)(ws + WS_ROWSQ);
        const int b = (u.pm * 256) / SEQ;
        const float* g1 = mod + (size_t)b * IN_COLS + 2 * D_MODEL, *sc2 = mod + (size_t)b * IN_COLS + 4 * D_MODEL;
#pragma unroll
        for (int ai = 0; ai < 2; ++ai)
#pragma unroll
            for (int m = 0; m < 4; ++m) { const int row = u.pm * 256 + ai * 128 + wr * 64 + m * 16 + fr; float ss = 0.f;
#pragma unroll
                for (int bj = 0; bj < 2; ++bj)
#pragma unroll
                    for (int n = 0; n < 2; ++n) { const int col = u.pn * 256 + bj * 128 + wc * 32 + n * 16 + fq * 4; const f32x4 v = acc[ai][bj][m][n];
                        const f32x4 xv = *(const f32x4*)(x + (size_t)row * D_MODEL + col), g = *(const f32x4*)(g1 + col);
                        const f32x4 xm = xv + g * v;
                        *(f32x4*)(out + (size_t)row * D_MODEL + col) = xm;
                        ss += (xm.x * xm.x + xm.y * xm.y) + (xm.z * xm.z + xm.w * xm.w);
                        const f32x4 ng = *(const f32x4*)(norm2_g + col), s2 = *(const f32x4*)(sc2 + col);
                        const f32x4 h = xm * ng * (s2 + 1.0f);
                        u32x2 o; o.x = pk2(h.x, h.y); o.y = pk2(h.z, h.w);
                        *(u32x2*)(XMG + (size_t)row * D_MODEL + col) = o; }
                ss += __shfl_xor(ss, 16); ss += __shfl_xor(ss, 32);
                if (fq == 0) atomicAdd(rowsq + row, ss); }
    }
};
struct EpiFfnUp {
    static constexpr bool PERM = false, AFTER_DRAIN = false;
    unsigned char* ws;
    __device__ __forceinline__ void operator()(const f32x4 (&acc)[2][2][4][2], const pg8::Unit& u, int wr, int wc, int fr, int fq) const {
        const float* rowsq = (const float*)(ws + WS_ROWSQ); bf16* A13 = (bf16*)(ws + WS_A13);
        const int b = (u.pm * 256) / SEQ; const float* bias2 = (const float*)(ws + WS_BIAS2) + (size_t)b * 2 * FFN;
#pragma unroll
        for (int ai = 0; ai < 2; ++ai)
#pragma unroll
            for (int m = 0; m < 4; ++m) { const int row = u.pm * 256 + ai * 128 + wr * 64 + m * 16 + fr;
                const float rstd = 1.0f / sqrtf(__builtin_nontemporal_load(rowsq + row) * (1.0f / D_MODEL) + EPS);
#pragma unroll
                for (int bj = 0; bj < 2; ++bj)
#pragma unroll
                    for (int n = 0; n < 2; ++n) { const int col = u.pn * 256 + bj * 128 + wc * 32 + n * 16 + fq * 4; const f32x4 v = acc[ai][bj][m][n];
                        const f32x4 bb = *(const f32x4*)(bias2 + col); const f32x4 r = v * rstd + bb;
                        u32x2 o; o.x = pk2(r.x, r.y); o.y = pk2(r.z, r.w);
                        *(u32x2*)(A13 + (size_t)row * (2 * FFN) + col) = o; } }
    }
};
struct EpiFfnDown {
    static constexpr bool PERM = false, AFTER_DRAIN = false;
    unsigned char* ws; float* out;
    __device__ __forceinline__ void operator()(const f32x4 (&acc)[2][2][4][2], const pg8::Unit& u, int wr, int wc, int fr, int fq) const {
        const float* mod = (const float*)(ws + WS_MOD); const int b = (u.pm * 256) / SEQ; const float* g2 = mod + (size_t)b * IN_COLS + 5 * D_MODEL;
        EPI_LOOP_BEGIN
            float* o = out + (size_t)row * D_MODEL + col; const f32x4 xm = *(const f32x4*)o, g = *(const f32x4*)(g2 + col);
            *(f32x4*)o = xm + g * v;
        EPI_LOOP_END
    }
};

#define XB_TMO      128
#define XB_XCNT(j)  (256  + 64 * (j))
#define XB_XSUB(j)  (1280 + 64 * (j))
#define XB_XGEN(j)  (2304 + 64 * (j))
#define XB_TOP      3328
#define XB_TOPGEN   3392
#define XCD_BAR_WORDS 3456
#define XB_SPIN_CAP (1u << 18)

__device__ __forceinline__ unsigned xb_ld(unsigned* p)              { return __hip_atomic_load(p, __ATOMIC_RELAXED, __HIP_MEMORY_SCOPE_AGENT); }
__device__ __forceinline__ unsigned xb_add(unsigned* p, unsigned v) { return __hip_atomic_fetch_add(p, v, __ATOMIC_RELAXED, __HIP_MEMORY_SCOPE_AGENT); }
__device__ __forceinline__ unsigned xb_xcc_id() { return (unsigned)__builtin_amdgcn_s_getreg((3 << 11) | 20) & 0xFu; }
#define XB_SPIN(cond, bar) do { unsigned _sp = 0; while (cond) { __builtin_amdgcn_s_sleep(1); \
    if ((++_sp & 255u) == 0u) { if (xb_ld(&(bar)[XB_TMO])) break; if (_sp > XB_SPIN_CAP) { atomicAdd(&(bar)[XB_TMO], 1u); break; } } } } while (0)

struct XcdBarrier {
    unsigned* bar; unsigned x; int wave;
    volatile LAS unsigned* st;
};

__device__ __forceinline__ XcdBarrier xcd_barrier_post(unsigned* bar, volatile LAS unsigned* st, int wave_id) {
    XcdBarrier b; b.bar = bar; b.x = xb_xcc_id(); b.st = st; b.wave = wave_id;
    if (wave_id == 0 && lane_id() == 0) (void)xb_add(&bar[XB_XCNT(b.x)], 1u);
    return b;
}
__device__ __forceinline__ void xcd_barrier_complete(unsigned* bar, unsigned x, unsigned& nloc, unsigned& nx) {
    const unsigned G = gridDim.x * gridDim.y * gridDim.z;
    unsigned sum, cnt, mine, sp = 0u;
    for (;;) {
        sum = 0u; cnt = 0u; mine = 0u;
#pragma unroll
        for (unsigned j = 0; j < 16; ++j) { const unsigned c = xb_ld(&bar[XB_XCNT(j)]); sum += c; cnt += (c > 0u) ? 1u : 0u; mine = (j == x) ? c : mine; }
        if (sum == G) break;
        __builtin_amdgcn_s_sleep(1);
        if ((++sp & 255u) == 0u) { if (xb_ld(&bar[XB_TMO])) break; if (sp > XB_SPIN_CAP) { atomicAdd(&bar[XB_TMO], 1u); break; } }
    }
    nloc = mine > 0u ? mine : 1u; nx = cnt > 0u ? cnt : 1u;
}

__device__ __forceinline__ void xcd_barrier(const XcdBarrier& b) {
    asm volatile("s_waitcnt vmcnt(0)" ::: "memory");
    __syncthreads();
    if (b.wave == 0 && lane_id() == 0) {
        unsigned* bar = b.bar;
        __builtin_amdgcn_s_waitcnt(0);
        unsigned nloc = b.st[0], nx = b.st[1];
        if (nloc == 0u) { xcd_barrier_complete(bar, b.x, nloc, nx); b.st[0] = nloc; b.st[1] = nx; }
        const unsigned old = xb_add(&bar[XB_XSUB(b.x)], 1u);
        const unsigned gen = old / nloc;
        if (old + 1u == (gen + 1u) * nloc) {
            __builtin_amdgcn_fence(__ATOMIC_RELEASE, "agent");
            asm volatile("s_waitcnt vmcnt(0)" ::: "memory");
            const unsigned og = xb_add(&bar[XB_TOP], 1u);
            const unsigned tg = og / nx;
            if (og + 1u == (tg + 1u) * nx) xb_add(&bar[XB_TOPGEN], 1u);
            else XB_SPIN(xb_ld(&bar[XB_TOPGEN]) == tg, bar);
            __builtin_amdgcn_fence(__ATOMIC_ACQUIRE, "agent");
            xb_add(&bar[XB_XGEN(b.x)], 1u);
            asm volatile("s_waitcnt vmcnt(0)" ::: "memory");
        } else {
            XB_SPIN(xb_ld(&bar[XB_XGEN(b.x)]) == gen, bar);
            __builtin_amdgcn_fence(__ATOMIC_ACQUIRE, "agent");
            asm volatile("s_waitcnt vmcnt(0)" ::: "memory");
        }
    }
    __syncthreads();
}

constexpr size_t WS_BAR = 8192;

typedef short bf16x8 __attribute__((ext_vector_type(8)));
typedef short s16x4 __attribute__((ext_vector_type(4)));

__device__ __forceinline__ bf16x8 cat8u(const u32x2 a, const u32x2 b) { const u32x4 w = (u32x4){a.x, a.y, b.x, b.y}; return __builtin_bit_cast(bf16x8, w); }
__device__ __forceinline__ bf16x8 pack_p(const f32x4 a, const f32x4 b) {
    u32x4 w; w.x = pk2(a.x, a.y); w.y = pk2(a.z, a.w); w.z = pk2(b.x, b.y); w.w = pk2(b.z, b.w);
    return __builtin_bit_cast(bf16x8, w);
}

constexpr int A_TILE = 32768, A_KOFF = 0, A_VOFF = 16384;
constexpr int A_BIAS = 4 * A_TILE;
constexpr int A_ITEM = A_BIAS + 2048;
static_assert(A_ITEM + 64 <= 145408, "attention LDS");
constexpr size_t WS_ATTCTR = 32768;
static_assert(WS_ATTCTR >= WS_BAR + XCD_BAR_WORDS * 4 && WS_ATTCTR + 8 * 256 <= WS_ROWSQ, "attn counters (8 x 256 B apart) inside ctl");
#define ATT_BAR() do { asm volatile("s_waitcnt lgkmcnt(0)" ::: "memory"); __builtin_amdgcn_s_barrier(); asm volatile("" ::: "memory"); } while (0)

__device__ __forceinline__ void phase_attn(const Params& p, LAS unsigned char* lds) {
    int tid_o = tid_of(p.wave_id);
    const int tid = tid_o, lane = tid & 63, wave = __builtin_amdgcn_readfirstlane(tid >> 6);
    const int qb = wave & 3, dh = wave >> 2, li = lane & 15, g = lane >> 4;
    const bf16* QN = (const bf16*)(p.ws + WS_QN); const bf16* KN = (const bf16*)(p.ws + WS_KN); const bf16* VT = (const bf16*)(p.ws + WS_VN);
    bf16* YB = (bf16*)p.out + (size_t)3 * ML * WA;
    unsigned* ctr = (unsigned*)(p.ws + WS_ATTCTR);
    LAS float* btab = (LAS float*)(lds + A_BIAS);
    const float scale = 0.08838834764831845f;
    int krow_l[2], kch_l[2], vrow_l[2], vch_l[2];
#pragma unroll
    for (int e = 0; e < 2; ++e) { const int pk = 2 * wave + e; krow_l[e] = 4 * pk + (lane >> 4); kch_l[e] = (lane & 15) ^ (krow_l[e] & 15);
        vrow_l[e] = 8 * pk + (lane >> 3); vch_l[e] = (lane & 7) ^ ((vrow_l[e] >> 1) & 7); }
    const int myx = (int)(xb_xcc_id() & 7u);
    int qoff = 0;
    for (;;) {
        if (tid == 0) { unsigned v = 0xffffffffu;
            while (qoff < 8) { const int qx = (myx + qoff) & 7; const unsigned n = atomicAdd(ctr + 64 * qx, 1u); if (n < 128u) { v = (unsigned)((qx + 8 * (n >> 5)) * 32 + (n & 31)); break; } ++qoff; }
            *(LAS unsigned*)(lds + A_ITEM) = v; }
        __syncthreads();
        const unsigned itu = *(LAS unsigned*)(lds + A_ITEM);
        if (itu == 0xffffffffu) break;
        const int it = (int)itu;
        const int r = it & 31, h = (it >> 5) & 7, b = it >> 8;
        const int rs = min(max(r - 4, 0), 24), ks0 = min(max(16 * qb - 8, 0), 32);
        const int cq = 16 * qb + li, cs = min(max(cq - 8, 0), 48);
        const size_t qrow = (size_t)b * SEQ + r * GRID_W + cq;
        if (tid < 15 * 31) btab[tid] = p.rel_bias[h * 465 + tid];
        bf16x8 qf[4];
#pragma unroll
        for (int ks = 0; ks < 4; ++ks) qf[ks] = *(const bf16x8*)(QN + qrow * WA + h * HD + 32 * ks + 8 * g);
        asm volatile("s_waitcnt vmcnt(0)" ::: "memory");
        const bf16* kg0 = KN + (size_t)h * HD + (size_t)krow_l[0] * WA + 8 * kch_l[0]; const bf16* kg1 = KN + (size_t)h * HD + (size_t)krow_l[1] * WA + 8 * kch_l[1];
        const bf16* vg0 = VT + ((size_t)(b * NHEAD + h) * HD + vrow_l[0]) * VT_PITCH + 8 * vch_l[0]; const bf16* vg1 = VT + ((size_t)(b * NHEAD + h) * HD + vrow_l[1]) * VT_PITCH + 8 * vch_l[1];
#define ATT_DMA(ti_) do { const int t_ = (ti_) < 12 ? (ti_) : 11; LAS unsigned char* bb_ = lds + ((ti_) & 3) * A_TILE + wave * 2048; \
            const size_t krow0 = (t_ < 8) ? ((size_t)b * SEQ + (rs + t_) * GRID_W) : ((size_t)ML + b * CTX + 64 * (t_ - 8)); \
            const int tok0 = (t_ < 8) ? ((rs + t_) * GRID_W) : (SEQ + 64 * (t_ - 8)); \
            __builtin_amdgcn_global_load_lds((const unsigned*)(kg0 + krow0 * WA), (LAS unsigned*)(bb_ + A_KOFF), 16, 0, 0); \
            __builtin_amdgcn_global_load_lds((const unsigned*)(kg1 + krow0 * WA), (LAS unsigned*)(bb_ + A_KOFF + 1024), 16, 0, 0); \
            __builtin_amdgcn_global_load_lds((const unsigned*)(vg0 + tok0), (LAS unsigned*)(bb_ + A_VOFF), 16, 0, 0); \
            __builtin_amdgcn_global_load_lds((const unsigned*)(vg1 + tok0), (LAS unsigned*)(bb_ + A_VOFF + 1024), 16, 0, 0); } while (0)
        ATT_DMA(0); ATT_DMA(1); ATT_DMA(2);
        f32x4 ot[4];
#pragma unroll
        for (int db = 0; db < 4; ++db) ot[db] = (f32x4){0.f, 0.f, 0.f, 0.f};
        float mrun = -1e30f, l = 0.f;
        const int kx = (ks0 + li) & 15, vy = (li >> 1) & 7;
        int koff[4];
#pragma unroll
        for (int ks = 0; ks < 4; ++ks) koff[ks] = A_KOFF + (ks0 + li) * 256 + (((4 * ks + g) ^ kx) << 4);
        const int vrow_off = A_VOFF + (64 * dh + li) * 128 + 8 * (g & 1);
        const int gq = g >> 1;
#pragma unroll 1
        for (int ti = 0; ti < 12; ++ti) {
            asm volatile("s_waitcnt vmcnt(8)" ::: "memory");
            ATT_BAR();
            ATT_DMA(ti + 3);
            const LAS unsigned char* tb = lds + (ti & 3) * A_TILE;
            if (ti < 8) {
                f32x4 st[2];
#pragma unroll
                for (int kb = 0; kb < 2; ++kb) { f32x4 a = (f32x4){0.f, 0.f, 0.f, 0.f};
#pragma unroll
                    for (int ks = 0; ks < 4; ++ks) a = __builtin_amdgcn_mfma_f32_16x16x32_bf16(*(const LAS bf16x8*)(tb + koff[ks] + kb * 4096), qf[ks], a, 0, 0, 0);
                    st[kb] = a; }
                const int dr = rs + ti - r + 7; float gm = -1e30f;
#pragma unroll
                for (int kb = 0; kb < 2; ++kb)
#pragma unroll
                    for (int j = 0; j < 4; ++j) { const int kcol = ks0 + 16 * kb + 4 * g + j; const bool valid = (kcol >= cs) && (kcol < cs + 16);
                        const int bi = valid ? (dr * 31 + (kcol - cq + 15)) : 0;
                        const float sv = valid ? (st[kb][j] * scale + btab[bi]) : -1e30f; st[kb][j] = sv; gm = fmaxf(gm, sv); }
                gm = fmaxf(gm, __shfl_xor(gm, 16)); gm = fmaxf(gm, __shfl_xor(gm, 32));
                const float mnew = fmaxf(mrun, gm); const float alpha = __expf(mrun - mnew); mrun = mnew; l *= alpha;
#pragma unroll
                for (int db = 0; db < 4; ++db) ot[db] = ot[db] * alpha;
#pragma unroll
                for (int kb = 0; kb < 2; ++kb)
#pragma unroll
                    for (int j = 0; j < 4; ++j) { const float sv = st[kb][j]; const float e = (sv > -1e29f) ? __expf(sv - mnew) : 0.f; st[kb][j] = e; l += e; }
                const bf16x8 pb = pack_p(st[0], st[1]);
                const int c0 = (ks0 >> 3) + gq;
#pragma unroll
                for (int db = 0; db < 4; ++db) { const LAS unsigned char* vp = tb + vrow_off + db * 2048;
                    ot[db] = __builtin_amdgcn_mfma_f32_16x16x32_bf16(cat8u(*(const LAS u32x2*)(vp + ((c0 ^ vy) << 4)), *(const LAS u32x2*)(vp + (((c0 + 2) ^ vy) << 4))), pb, ot[db], 0, 0, 0); }
            } else {
                f32x4 st[4];
#pragma unroll
                for (int kb = 0; kb < 4; ++kb) { f32x4 a = (f32x4){0.f, 0.f, 0.f, 0.f};
#pragma unroll
                    for (int ks = 0; ks < 4; ++ks) a = __builtin_amdgcn_mfma_f32_16x16x32_bf16(*(const LAS bf16x8*)(tb + A_KOFF + (16 * kb + li) * 256 + (((4 * ks + g) ^ li) << 4)), qf[ks], a, 0, 0, 0);
                    st[kb] = a * scale; }
                float gm = -1e30f;
#pragma unroll
                for (int kb = 0; kb < 4; ++kb) gm = fmaxf(fmaxf(gm, fmaxf(st[kb][0], st[kb][1])), fmaxf(st[kb][2], st[kb][3]));
                gm = fmaxf(gm, __shfl_xor(gm, 16)); gm = fmaxf(gm, __shfl_xor(gm, 32));
                const float mnew = fmaxf(mrun, gm); const float alpha = __expf(mrun - mnew); mrun = mnew; l *= alpha;
#pragma unroll
                for (int db = 0; db < 4; ++db) ot[db] = ot[db] * alpha;
#pragma unroll
                for (int kb = 0; kb < 4; ++kb)
#pragma unroll
                    for (int j = 0; j < 4; ++j) { const float e = __expf(st[kb][j] - mnew); st[kb][j] = e; l += e; }
#pragma unroll
                for (int kp2 = 0; kp2 < 2; ++kp2) { const bf16x8 pb = pack_p(st[2 * kp2], st[2 * kp2 + 1]);
                    const int c0 = 4 * kp2 + gq;
#pragma unroll
                    for (int db = 0; db < 4; ++db) { const LAS unsigned char* vp = tb + vrow_off + db * 2048;
                        ot[db] = __builtin_amdgcn_mfma_f32_16x16x32_bf16(cat8u(*(const LAS u32x2*)(vp + ((c0 ^ vy) << 4)), *(const LAS u32x2*)(vp + (((c0 + 2) ^ vy) << 4))), pb, ot[db], 0, 0, 0); } }
            }
        }
        asm volatile("s_waitcnt vmcnt(0)" ::: "memory");
        l += __shfl_xor(l, 16); l += __shfl_xor(l, 32);
        const float inv = 1.0f / l;
#pragma unroll
        for (int db = 0; db < 4; ++db) { const f32x4 o = ot[db] * inv; u32x2 w; w.x = pk2(o.x, o.y); w.y = pk2(o.z, o.w);
            *(u32x2*)(YB + qrow * WA + h * HD + 64 * dh + 16 * db + 4 * g) = w; }
#undef ATT_DMA
    }
}

constexpr int HP = 160;
constexpr int H_QH = 0, H_KH = 20480, H_KE = 40960, H_QD = 61440, H_KD = 81920;
constexpr int HP2 = 48;
constexpr int H_Q2 = 102400, H_K2 = 108544;
constexpr int PP = 144;
constexpr int H_P = 114688;
constexpr int H_T = 123904;
constexpr int H_D = 125952;
constexpr int HIMG_QD = 0, HIMG_KD = 16384, HIMG_P = 32768, HIMG_D = 40960, HIMG_BYTES = 41472;
constexpr int NCH = (CTX + SEQ) / 64;
constexpr int VP = 288;
constexpr int SB_QD = 0, SB_KD = 20480, SB_P = 40960, SB_D = 50176, SB_V = 50688, SB_BYTES = 69120;
static_assert(2 * SB_BYTES <= 145408, "scan buffers");

__device__ __forceinline__ s16x4 lds_tr(LAS const unsigned char* p) {
    return __builtin_bit_cast(s16x4, __builtin_amdgcn_ds_read_tr16_b64_v4i16((LAS s16x4*)p));
}
__device__ __forceinline__ bf16x8 cat8(const s16x4 a, const s16x4 b) { return __builtin_shufflevector(a, b, 0, 1, 2, 3, 4, 5, 6, 7); }

__device__ __forceinline__ size_t hg_row(int dir, int b, int tau) {
    if (tau < CTX) return (size_t)ML + b * CTX + (dir == 0 ? tau : CTX - 1 - tau);
    const int t = tau - CTX; return (size_t)b * SEQ + (dir == 0 ? t : SEQ - 1 - t);
}

__device__ __forceinline__ void hgrn_prep(const Params& p, LAS unsigned char* lds, int vb, int nb) {
    int tid_o = tid_of(p.wave_id);
    const int tid = tid_o, lane = tid & 63, wave = __builtin_amdgcn_readfirstlane(tid >> 6);
    const int k = tid & 127, J = __builtin_amdgcn_readfirstlane(tid >> 7);
    const int li = lane & 15, g = lane >> 4, qq = li >> 2, pp = li & 3;
    LAS float* Tl = (LAS float*)(lds + H_T); LAS float* Dl = (LAS float*)(lds + H_D);
    float lf[16]; unsigned qv[16];
#define HG_LOADP(idx_) do { const int id_ = (idx_); const int ch_ = id_ / NCH, cc_ = id_ % NCH; const int dir_ = ch_ / (BATCH * NHEAD), b_ = (ch_ / NHEAD) % BATCH, h_ = ch_ % NHEAD; \
        const size_t row0_ = hg_row(dir_, b_, 64 * cc_ + 16 * J); const long st_ = dir_ ? -(long)WA : (long)WA; \
        const float* lfp_ = (const float*)(p.ws + (dir_ == 0 ? WS_FW : WS_FB)) + row0_ * WA + h_ * HD + k; const bf16* qp_ = (const bf16*)(p.ws + WS_QA) + row0_ * WA + h_ * HD + k; \
        _Pragma("unroll") for (int i = 0; i < 16; ++i) { lf[i] = lfp_[(long)i * st_]; qv[i] = (cc_ >= 4) ? (unsigned)qp_[(long)i * st_] : 0u; } } while (0)
    if (vb < 64 * NCH) HG_LOADP(vb);
    for (int idx = vb; idx < 64 * NCH; idx += nb) {
        const int c = idx % NCH;
        float cum[16]; float run = 0.f;
#pragma unroll
        for (int i = 0; i < 16; ++i) { run += lf[i]; cum[i] = run; }
        Tl[J * 128 + k] = run;
        ATT_BAR();
        const float T0 = Tl[k], T1 = Tl[128 + k], T2 = Tl[256 + k], T3 = Tl[384 + k];
        const float bJ = (J > 0 ? T0 : 0.f) + (J > 1 ? T1 : 0.f) + (J > 2 ? T2 : 0.f);
        const float tail = (J < 1 ? T1 : 0.f) + (J < 2 ? T2 : 0.f) + (J < 3 ? T3 : 0.f);
        const float eb = __expf(bJ), et = __expf(tail), eT = __expf(run);
        const float x2 = (J == 3) ? __expf(T2) : __expf(T1);
        float qh[16], kh[16];
#pragma unroll
        for (int i = 0; i < 16; ++i) { const float e1 = __expf(cum[i]); const float r1 = __builtin_amdgcn_rcpf(e1); const float kk = 1.0f - __expf(lf[i]);
            qh[i] = __builtin_bit_cast(float, qv[i] << 16) * e1; kh[i] = kk * r1; }
        {
            LAS unsigned char* rowp = lds + k * HP + 32 * J;
            u32x4 w0, w1;
#define HG_WRITE(OFF, EXPR) do { \
            { float v0_, v1_; \
              { const int i = 0; v0_ = (EXPR); } { const int i = 1; v1_ = (EXPR); } w0.x = pk2(v0_, v1_); \
              { const int i = 2; v0_ = (EXPR); } { const int i = 3; v1_ = (EXPR); } w0.y = pk2(v0_, v1_); \
              { const int i = 4; v0_ = (EXPR); } { const int i = 5; v1_ = (EXPR); } w0.z = pk2(v0_, v1_); \
              { const int i = 6; v0_ = (EXPR); } { const int i = 7; v1_ = (EXPR); } w0.w = pk2(v0_, v1_); \
              { const int i = 8; v0_ = (EXPR); } { const int i = 9; v1_ = (EXPR); } w1.x = pk2(v0_, v1_); \
              { const int i = 10; v0_ = (EXPR); } { const int i = 11; v1_ = (EXPR); } w1.y = pk2(v0_, v1_); \
              { const int i = 12; v0_ = (EXPR); } { const int i = 13; v1_ = (EXPR); } w1.z = pk2(v0_, v1_); \
              { const int i = 14; v0_ = (EXPR); } { const int i = 15; v1_ = (EXPR); } w1.w = pk2(v0_, v1_); } \
            *(LAS u32x4*)(OFF) = w0; *(LAS u32x4*)((OFF) + 16) = w1; } while (0)
            HG_WRITE(rowp + H_QH, qh[i]);
            HG_WRITE(rowp + H_KH, kh[i]);
            HG_WRITE(rowp + H_KE, kh[i] * eT);
            HG_WRITE(rowp + H_QD, qh[i] * eb);
            HG_WRITE(rowp + H_KD, kh[i] * (eT * et));
            if (J == 3) { HG_WRITE(lds + H_Q2 + k * HP2, qh[i] * x2); }
            if (J == 0) { HG_WRITE(lds + H_K2 + k * HP2, kh[i] * (eT * x2)); }
#undef HG_WRITE
            if (J == 3) Dl[k] = __expf(bJ + run);
        }
        if (idx + nb < 64 * NCH) HG_LOADP(idx + nb);
        ATT_BAR();
        const bool lat = (c >= 4);
        if (lat) {
#pragma unroll
            for (int rep = 0; rep < 2; ++rep) {
                int I, Jb;
                if (rep == 0) { I = (wave < 4) ? wave : (wave == 4 ? 1 : (wave == 7 ? 3 : 2)); Jb = (wave < 4) ? wave : (wave == 4 ? 0 : (wave == 5 ? 0 : (wave == 6 ? 1 : 2))); }
                else { if (wave >= 2) break; I = 3; Jb = wave; }
                int aoff, apitch, acol, boff, bpitch, bcol;
                if (I == Jb) { aoff = H_KH; apitch = HP; acol = 16 * Jb; boff = H_QH; bpitch = HP; bcol = 16 * I; }
                else if (I == Jb + 1 && I != 2) { aoff = H_KE; apitch = HP; acol = 16 * Jb; boff = H_QH; bpitch = HP; bcol = 16 * I; }
                else if (I == 2) { if (Jb == 0) { aoff = H_K2; apitch = HP2; acol = 0; } else { aoff = H_KE; apitch = HP; acol = 16; } boff = H_QH; bpitch = HP; bcol = 32; }
                else { if (Jb == 0) { aoff = H_K2; apitch = HP2; acol = 0; } else { aoff = H_KE; apitch = HP; acol = 16; } boff = H_Q2; bpitch = HP2; bcol = 0; }
                f32x4 pt = (f32x4){0.f, 0.f, 0.f, 0.f};
#pragma unroll
                for (int ks = 0; ks < 4; ++ks) {
                    const int r0 = 32 * ks + 4 * g + qq;
                    const bf16x8 a = cat8(lds_tr(lds + aoff + r0 * apitch + (acol + 4 * pp) * 2), lds_tr(lds + aoff + (r0 + 16) * apitch + (acol + 4 * pp) * 2));
                    const bf16x8 bb = cat8(lds_tr(lds + boff + r0 * bpitch + (bcol + 4 * pp) * 2), lds_tr(lds + boff + (r0 + 16) * bpitch + (bcol + 4 * pp) * 2));
                    pt = __builtin_amdgcn_mfma_f32_16x16x32_bf16(a, bb, pt, 0, 0, 0);
                }
                if (I == Jb) {
#pragma unroll
                    for (int j = 0; j < 4; ++j) if (4 * g + j > li) pt[j] = 0.f;
                }
                u32x2 w; w.x = pk2(pt.x, pt.y); w.y = pk2(pt.z, pt.w);
                *(LAS u32x2*)(lds + H_P + (16 * I + li) * PP + (16 * Jb + 4 * g) * 2) = w;
            }
        }
        ATT_BAR();
        unsigned char* img = p.ws + WS_HIMG + (size_t)idx * HIMG_BYTES;
#pragma unroll
        for (int e = 0; e < 2; ++e) { const int id = tid + 512 * e; const int kr = id >> 3, part = id & 7;
            if (lat) *(u32x4*)(img + HIMG_QD + id * 16) = *(const LAS u32x4*)(lds + H_QD + kr * HP + 16 * part);
            *(u32x4*)(img + HIMG_KD + id * 16) = *(const LAS u32x4*)(lds + H_KD + kr * HP + 16 * part); }
        if (lat) *(u32x4*)(img + HIMG_P + tid * 16) = *(const LAS u32x4*)(lds + H_P + (tid >> 3) * PP + 16 * (tid & 7));
        if (tid < 32) *(u32x4*)(img + HIMG_D + tid * 16) = *(const LAS u32x4*)(lds + H_D + 16 * tid);
    }
#undef HG_LOADP
    __syncthreads();
}

__device__ __forceinline__ void hgrn_scan(const Params& p, LAS unsigned char* lds, int chain) {
    int tid_o = tid_of(p.wave_id);
    const int tid = tid_o, lane = tid & 63, wave = __builtin_amdgcn_readfirstlane(tid >> 6);
    const int li = lane & 15, g = lane >> 4, qq = li >> 2, pp = li & 3;
    const int dir = chain / (BATCH * NHEAD), b = (chain / NHEAD) % BATCH, h = chain % NHEAD;
    const bf16* IA = (const bf16*)(p.ws + WS_IA) + h * HD;
    bf16* O = ((bf16*)p.out + (dir == 0 ? 0 : (size_t)ML * WA)) + h * HD + 16 * wave + li;
    const long ost = dir ? -(long)WA : (long)WA;
    const unsigned char* img0 = p.ws + WS_HIMG + (size_t)chain * NCH * HIMG_BYTES;
    f32x4 S[8];
#pragma unroll
    for (int i = 0; i < 8; ++i) S[i] = (f32x4){0.f, 0.f, 0.f, 0.f};
    u32x4 rq[2][2], rk[2][2], rp[2], rd[2], rv[2][2];
#define HS_LOAD(c_, set_) do { const int cc_ = (c_); const unsigned char* im_ = img0 + (size_t)cc_ * HIMG_BYTES; \
        if (cc_ >= 4) { rq[set_][0] = *(const u32x4*)(im_ + HIMG_QD + tid * 16); rq[set_][1] = *(const u32x4*)(im_ + HIMG_QD + (tid + 512) * 16); rp[set_] = *(const u32x4*)(im_ + HIMG_P + tid * 16); } \
        rk[set_][0] = *(const u32x4*)(im_ + HIMG_KD + tid * 16); rk[set_][1] = *(const u32x4*)(im_ + HIMG_KD + (tid + 512) * 16); \
        if (tid < 32) rd[set_] = *(const u32x4*)(im_ + HIMG_D + tid * 16); \
        _Pragma("unroll") for (int e = 0; e < 2; ++e) { const int idx_ = tid * 2 + e; const size_t row_ = hg_row(dir, b, 64 * cc_ + (idx_ >> 4)); rv[set_][e] = *(const u32x4*)(IA + row_ * WA + 8 * (idx_ & 15)); } } while (0)
#define HS_STORE(c_, set_) do { const int cc_ = (c_); LAS unsigned char* bb_ = lds + (cc_ & 1) * SB_BYTES; \
        if (cc_ >= 4) { *(LAS u32x4*)(bb_ + SB_QD + (tid >> 3) * HP + 16 * (tid & 7)) = rq[set_][0]; *(LAS u32x4*)(bb_ + SB_QD + ((tid >> 3) + 64) * HP + 16 * (tid & 7)) = rq[set_][1]; \
                        *(LAS u32x4*)(bb_ + SB_P + (tid >> 3) * PP + 16 * (tid & 7)) = rp[set_]; } \
        *(LAS u32x4*)(bb_ + SB_KD + (tid >> 3) * HP + 16 * (tid & 7)) = rk[set_][0]; *(LAS u32x4*)(bb_ + SB_KD + ((tid >> 3) + 64) * HP + 16 * (tid & 7)) = rk[set_][1]; \
        if (tid < 32) *(LAS u32x4*)(bb_ + SB_D + 16 * tid) = rd[set_]; \
        _Pragma("unroll") for (int e = 0; e < 2; ++e) { const int idx_ = tid * 2 + e; *(LAS u32x4*)(bb_ + SB_V + (idx_ >> 4) * VP + 16 * (idx_ & 15)) = rv[set_][e]; } } while (0)
    HS_LOAD(0, 0); HS_LOAD(1, 1);
    HS_STORE(0, 0);
    HS_LOAD(2, 0);
    ATT_BAR();
#pragma unroll 1
    for (int c2 = 0; c2 < NCH; c2 += 2) {
#pragma unroll
    for (int uu = 0; uu < 2; ++uu) { const int c = c2 + uu;
        const LAS unsigned char* bb = lds + (c & 1) * SB_BYTES;
        const bool lat = (c >= 4);
        bf16x8 vf[2];
#pragma unroll
        for (int sp = 0; sp < 2; ++sp) {
            const LAS unsigned char* vb0 = bb + SB_V + (32 * sp + 4 * g + qq) * VP + (16 * wave + 4 * pp) * 2;
            vf[sp] = cat8(lds_tr(vb0), lds_tr(vb0 + 16 * VP));
        }
        if (lat) {
            bf16x8 sb[4];
#pragma unroll
            for (int ks = 0; ks < 4; ++ks) sb[ks] = pack_p(S[2 * ks], S[2 * ks + 1]);
            bf16* orow = O + (long)hg_row(dir, b, 64 * c) * WA;
#pragma unroll
            for (int I = 0; I < 4; ++I) {
                f32x4 o = (f32x4){0.f, 0.f, 0.f, 0.f};
#pragma unroll
                for (int ks = 0; ks < 4; ++ks) {
                    const LAS unsigned char* ap = bb + SB_QD + (32 * ks + 4 * g + qq) * HP + (16 * I + 4 * pp) * 2;
                    o = __builtin_amdgcn_mfma_f32_16x16x32_bf16(cat8(lds_tr(ap), lds_tr(ap + 16 * HP)), sb[ks], o, 0, 0, 0);
                }
#pragma unroll
                for (int sp = 0; sp < 2; ++sp) {
                    if (2 * sp > I) break;
                    const LAS unsigned char* pr = bb + SB_P + (16 * I + li) * PP + (32 * sp + 4 * g) * 2;
                    const u32x2 lo = *(const LAS u32x2*)pr; u32x2 hi = (u32x2){0u, 0u};
                    if (2 * sp + 1 <= I) hi = *(const LAS u32x2*)(pr + 32);
                    o = __builtin_amdgcn_mfma_f32_16x16x32_bf16(cat8u(lo, hi), vf[sp], o, 0, 0, 0);
                }
#pragma unroll
                for (int j = 0; j < 4; ++j) orow[(long)(16 * I + 4 * g + j) * ost] = (bf16)f2bf(o[j]);
            }
        }
#pragma unroll
        for (int blk = 0; blk < 8; ++blk) {
            const f32x4 d4 = *(const LAS f32x4*)(bb + SB_D + (16 * blk + 4 * g) * 4);
            f32x4 s = S[blk] * d4;
#pragma unroll
            for (int sp = 0; sp < 2; ++sp) {
                const LAS unsigned char* kp = bb + SB_KD + (16 * blk + li) * HP + (32 * sp + 4 * g) * 2;
                s = __builtin_amdgcn_mfma_f32_16x16x32_bf16(cat8u(*(const LAS u32x2*)kp, *(const LAS u32x2*)(kp + 32)), vf[sp], s, 0, 0, 0);
            }
            S[blk] = s;
        }
        if (c + 1 < NCH) HS_STORE(c + 1, (uu + 1) & 1);
        if (c + 3 < NCH) HS_LOAD(c + 3, (uu + 1) & 1);
        ATT_BAR();
    } }
#undef HS_LOAD
#undef HS_STORE
    __syncthreads();
}

__device__ __forceinline__ void phase_readout(const Params& p, int vb, int nb) {
    const int tid = tid_of(p.wave_id), lane = tid & 63, wave = p.wave_id;
    const bf16* OF = (const bf16*)p.out; const bf16* OB = OF + (size_t)ML * WA; const bf16* GA = (const bf16*)(p.ws + WS_GA);
    bf16* YA = (bf16*)p.out + (size_t)2 * ML * WA;
    for (int it = vb * 8 + wave; it < ML * NHEAD; it += nb * 8) {
        const int row = it / NHEAD, h = it % NHEAD; const size_t off = (size_t)row * WA + h * HD + 2 * lane;
        const unsigned a = *(const unsigned*)(OF + off), b = *(const unsigned*)(OB + off), g = *(const unsigned*)(GA + off);
        const float o0 = bflo(a) + bflo(b), o1 = bfhi(a) + bfhi(b);
        const float rstd = 1.0f / sqrtf(wave_sum(o0 * o0 + o1 * o1) * (1.0f / HD) + EPS);
        const float y0 = o0 * rstd * p.hgrn_norm_g[2 * lane] * bflo(g), y1 = o1 * rstd * p.hgrn_norm_g[2 * lane + 1] * bfhi(g);
        *(unsigned*)(YA + off) = pk2(y0, y1);
    }
}

__device__ __forceinline__ void phase_bias2(const Params& p, int vb, int nb) {
    const int tid = tid_of(p.wave_id); const float* mod = (const float*)(p.ws + WS_MOD); float* bias2 = (float*)(p.ws + WS_BIAS2);
    constexpr int NCC = 2 * FFN / 512, NKC = D_MODEL / 64;
    for (int item = vb; item < NCC * NKC; item += nb) {
        const int cc = item % NCC, kc = item / NCC; const int col = cc * 512 + tid;
        const float* W = (col < FFN) ? p.w1 + col : p.w3 + (col - FFN);
        float a0 = 0.f, a1 = 0.f, a2 = 0.f, a3 = 0.f;
#pragma unroll 8
        for (int k = kc * 64; k < kc * 64 + 64; ++k) { const float w = W[(size_t)k * FFN];
            a0 += w * mod[0 * IN_COLS + 3 * D_MODEL + k]; a1 += w * mod[1 * IN_COLS + 3 * D_MODEL + k]; a2 += w * mod[2 * IN_COLS + 3 * D_MODEL + k]; a3 += w * mod[3 * IN_COLS + 3 * D_MODEL + k]; }
        atomicAdd(bias2 + 0 * 2 * FFN + col, a0); atomicAdd(bias2 + 1 * 2 * FFN + col, a1); atomicAdd(bias2 + 2 * 2 * FFN + col, a2); atomicAdd(bias2 + 3 * 2 * FFN + col, a3);
    }
}

__device__ __forceinline__ void phase_conv(const Params& p, int vb, int nb) {
    const int tid = tid_of(p.wave_id); const bf16* A13 = (const bf16*)(p.ws + WS_A13); bf16* ACT = (bf16*)(p.ws + WS_ACT);
    constexpr int CPR = FFN / 8;
    const size_t total = (size_t)ML * CPR;
    for (size_t i = (size_t)vb * NTHREADS + tid; i < total; i += (size_t)nb * NTHREADS) {
        const int row = (int)(i / CPR), c = (int)(i % CPR) * 8; const int t = row % SEQ;
        const bf16* ap = A13 + (size_t)row * (2 * FFN) + c;
        const u32x4 a1 = *(const u32x4*)ap; const u32x4 g = *(const u32x4*)(ap + FFN);
        u32x4 a0 = (u32x4){0u, 0u, 0u, 0u}, a2 = (u32x4){0u, 0u, 0u, 0u};
        if (t > 0) a0 = *(const u32x4*)(ap - 2 * FFN);
        if (t < SEQ - 1) a2 = *(const u32x4*)(ap + 2 * FFN);
        float w0[8], w1[8], w2[8], cb[8];
#pragma unroll
        for (int e = 0; e < 8; ++e) { w0[e] = p.conv_w[c + e]; w1[e] = p.conv_w[FFN + c + e]; w2[e] = p.conv_w[2 * FFN + c + e]; cb[e] = p.conv_b[c + e]; }
        float r[8];
#pragma unroll
        for (int q = 0; q < 4; ++q) {
            const unsigned x0 = a0[q], x1 = a1[q], x2 = a2[q], gg = g[q];
            const float u0 = bflo(x0) * w0[2 * q] + bflo(x1) * w1[2 * q] + bflo(x2) * w2[2 * q] + cb[2 * q];
            const float u1 = bfhi(x0) * w0[2 * q + 1] + bfhi(x1) * w1[2 * q + 1] + bfhi(x2) * w2[2 * q + 1] + cb[2 * q + 1];
            r[2 * q] = siluf_(u0) * bflo(gg); r[2 * q + 1] = siluf_(u1) * bfhi(gg);
        }
        u32x4 o; o.x = pk2(r[0], r[1]); o.y = pk2(r[2], r[3]); o.z = pk2(r[4], r[5]); o.w = pk2(r[6], r[7]);
        *(u32x4*)(ACT + (size_t)row * FFN + c) = o;
    }
}


constexpr int LDS_MISC_OFF = 145408;
constexpr int LDS_BYTES = 146432;
static_assert(WS_BAR + XCD_BAR_WORDS * 4 <= WS_ROWSQ, "barrier words inside ctl");

#if defined(__HIP_DEVICE_COMPILE__)
#define LOAD_P() Params p; { const __attribute__((address_space(4))) Params* q_ = (const __attribute__((address_space(4))) Params*)__builtin_amdgcn_kernarg_segment_ptr(); asm volatile("" : "+s"(q_)); \
    p = *q_; p.wave_id = wave_id; } unsigned char* ws = p.ws; (void)ws
#else
#define LOAD_P() Params p = p_in; p.wave_id = wave_id; unsigned char* ws = p.ws; (void)ws
#endif
__global__ void __launch_bounds__(NTHREADS, 2) mega_fwd(Params p_in) {
    const int wave_id = __builtin_amdgcn_readfirstlane((int)(threadIdx.x >> 6));
    extern __shared__ __attribute__((aligned(16))) unsigned char lds_raw[];
    LAS unsigned char* lds = (LAS unsigned char*)lds_raw;
    const int nb = gridDim.x;
    const int vb = (nb % 8 == 0) ? ((int)(blockIdx.x % 8) * (nb / 8) + (int)(blockIdx.x / 8)) : (int)blockIdx.x;
    const int bx = blockIdx.x;
    volatile LAS unsigned* misc = (volatile LAS unsigned*)(lds + LDS_MISC_OFF);
    if (wave_id == 0) misc[lane_id()] = 0u;
    __syncthreads();
    XcdBarrier bar = xcd_barrier_post((unsigned*)(p_in.ws + WS_BAR), misc + 8, wave_id);
#define GRID_BAR() xcd_barrier(bar)

    { LOAD_P(); phase_mod(p, lds, vb, nb); __syncthreads(); phase_wconv_in(p, lds, vb * 8 + wave_id, nb * 8); }
    GRID_BAR();
    { LOAD_P(); phase_h(p, vb, nb); }
    GRID_BAR();
    { LOAD_P(); pg8::Gemm g{(const bf16*)(ws + WS_H), (const bf16*)(ws + WS_WINT), MT, IN_COLS, D_MODEL}; pg8::StaticOrder S; S.init(MT, IN_COLS, nb, bx);
      EpiInProj E{ws, lds, p.q_norm_g, p.k_norm_g}; pg8::gemm_phase<EpiInProj, pg8::StaticOrder, true, true>(lds, g, S, E, wave_id); }
    GRID_BAR();
    { LOAD_P(); hgrn_prep(p, lds, vb, nb); }
    GRID_BAR();
    { LOAD_P();
      if (bx < 2 * BATCH * NHEAD) hgrn_scan(p, lds, bx);
      __syncthreads();
      phase_attn(p, lds);
      if (bx >= 2 * BATCH * NHEAD) phase_wconv_rest(p, lds, (bx - 2 * BATCH * NHEAD) * 8 + wave_id, (nb - 2 * BATCH * NHEAD) * 8); }
    GRID_BAR();
    { LOAD_P(); phase_readout(p, vb, nb); }
    GRID_BAR();
    { LOAD_P(); pg8::Gemm g{(const bf16*)p.out + (size_t)2 * ML * WA, (const bf16*)(ws + WS_WAT), ML, D_MODEL, WA}; pg8::StaticOrder S; S.init(ML, D_MODEL, nb, bx);
      EpiMergeA E{ws, (float*)(ws + WS_T1)}; pg8::gemm_phase<EpiMergeA, pg8::StaticOrder, true, true>(lds, g, S, E, wave_id); }
    GRID_BAR();
    { LOAD_P(); pg8::Gemm g{(const bf16*)p.out + (size_t)3 * ML * WA, (const bf16*)(ws + WS_WBT), ML, D_MODEL, WA}; pg8::StaticOrder S; S.init(ML, D_MODEL, nb, bx);
      EpiMergeB E{ws, (const float*)(ws + WS_T1)}; pg8::gemm_phase<EpiMergeB, pg8::StaticOrder, true, true>(lds, g, S, E, wave_id); }
    GRID_BAR();
    { LOAD_P(); pg8::Gemm g{(const bf16*)(ws + WS_Z), (const bf16*)(ws + WS_WOT), ML, D_MODEL, D_MODEL}; pg8::StaticOrder S; S.init(ML, D_MODEL, nb, bx);
      EpiOutProj E{ws, p.x, p.norm2_g, p.out}; pg8::gemm_phase<EpiOutProj, pg8::StaticOrder, true, true>(lds, g, S, E, wave_id); }
    GRID_BAR();
    { LOAD_P(); pg8::Gemm g{(const bf16*)(ws + WS_XMG), (const bf16*)(ws + WS_W13T), ML, 2 * FFN, D_MODEL}; pg8::StaticOrder S; S.init(ML, 2 * FFN, nb, bx);
      EpiFfnUp E{ws}; pg8::gemm_phase<EpiFfnUp, pg8::StaticOrder, true, true>(lds, g, S, E, wave_id); }
    GRID_BAR();
    { LOAD_P(); phase_conv(p, vb, nb); }
    GRID_BAR();
    { LOAD_P(); pg8::Gemm g{(const bf16*)(ws + WS_ACT), (const bf16*)(ws + WS_W2T), ML, D_MODEL, FFN}; pg8::StaticOrder S; S.init(ML, D_MODEL, nb, bx);
      EpiFfnDown E{ws, p.out}; pg8::gemm_phase<EpiFfnDown, pg8::StaticOrder, true, true>(lds, g, S, E, wave_id); }
#undef GRID_BAR
}

extern "C" void kernel_launch(void* const* d_in, const int* in_sizes, int n_in, void* d_out, int out_size, void* d_ws, size_t ws_size, hipStream_t stream) {
    static int grid = 0;
    if (grid == 0) {
        if (n_in != 22 || ws_size < WS_END || out_size != ML * D_MODEL) { fprintf(stderr, "kernel_launch: bad inputs (n_in %d, out %d, ws %zu, need %zu)\n", n_in, out_size, ws_size, (size_t)WS_END); grid = -1; return; }
        int dev = 0, cus = 0, per_cu = 0;
        if (hipGetDevice(&dev) != hipSuccess || hipDeviceGetAttribute(&cus, hipDeviceAttributeMultiprocessorCount, dev) != hipSuccess) { grid = -1; return; }
        if (hipFuncSetAttribute((const void*)mega_fwd, hipFuncAttributeMaxDynamicSharedMemorySize, LDS_BYTES) != hipSuccess) { fprintf(stderr, "kernel_launch: hipFuncSetAttribute failed\n"); grid = -1; return; }
        if (hipOccupancyMaxActiveBlocksPerMultiprocessor(&per_cu, (const void*)mega_fwd, NTHREADS, LDS_BYTES) != hipSuccess || per_cu < 1) { fprintf(stderr, "kernel_launch: occupancy query says %d blocks/CU\n", per_cu); (void)hipGetLastError(); grid = -1; return; }
        grid = cus;
        fprintf(stderr, "kernel_launch: grid %d (cus %d, occupancy %d/CU)\n", grid, cus, per_cu);
    }
    if (grid < 0) return;
    Params p{};
    const float** f = (const float**)&p;
    for (int i = 0; i < 22; ++i) f[i] = (const float*)d_in[i];
    p.out = (float*)d_out; p.ws = (unsigned char*)d_ws;
    (void)hipMemsetAsync((char*)d_ws + WS_CTL, 0, CTL_ZERO_BYTES, stream);
    hipLaunchKernelGGL(mega_fwd, dim3(grid), dim3(NTHREADS), LDS_BYTES, stream, p);
}
```

```cpp
#include <hip/hip_runtime.h>
#include <cstdio>
#include <cstdint>
#include <cmath>

__device__ __forceinline__ int lane_id() { int l; asm volatile("v_mbcnt_lo_u32_b32 %0, -1, 0\n\tv_mbcnt_hi_u32_b32 %0, -1, %0" : "=v"(l)); return l; }
__device__ __forceinline__ int tid_of(int wave_id) { int t = wave_id * 64 + lane_id(); asm volatile("" : "+v"(t)); return t; }
namespace pg8 {
#define PG8_LAS __attribute__((address_space(3)))
typedef unsigned short bf16_t;
typedef short bf16x8 __attribute__((ext_vector_type(8)));
typedef float f32x4 __attribute__((ext_vector_type(4)));
typedef unsigned u32x4 __attribute__((ext_vector_type(4)));
constexpr int BM = 256, BK = 64, HALF = 128, HTB = HALF * BK * 2  , STAGE_BYTES = 8 * HTB, NXCD = 8, WGM = 8;

__host__ __device__ __forceinline__ int lds_byte(int r, int c) { const int st = (r >> 4) * 2 + (c >> 5), rr = r & 15, cc = c & 31, ob = rr * 64 + cc * 2; return st * 1024 + (ob ^ (((ob >> 9) & 1) << 5)); }
__host__ __device__ __forceinline__ void stage_rc(int b, int& R, int& C) { const int st = b / 1024, sb = b % 1024, swz = sb ^ (((sb >> 9) & 1) << 5); R = (st >> 1) * 16 + swz / 64; C = (st & 1) * 32 + (swz % 64) / 2; }
__host__ __device__ __forceinline__ int perm32(int rho) { const int n = rho >> 4, i = rho & 15; return 8 * (i >> 2) + 4 * n + (i & 3); }

struct Unit { int pm, pn; };
struct Gemm { const bf16_t* A; const bf16_t* Bt; int M, N, K; };

struct StaticOrder {
    int nM, nN, nwg, G, c;
    __host__ __device__ void init(int M, int N, int G_, int c_) { nM = M / BM; nN = N / BM; nwg = nM * nN; G = G_; c = c_; }
    __host__ __device__ bool next(int i, Unit& u) const {
        const long L = (long)i * G + c; if (L >= nwg) return false;
        int wgid = (int)L; { const int q = nwg / NXCD, r = nwg % NXCD, xcd = wgid % NXCD, off = wgid / NXCD; wgid = (xcd < r ? xcd * (q + 1) : r * (q + 1) + (xcd - r) * q) + off; }
        const int nig = WGM * nN, gid = wgid / nig, fm = gid * WGM, gsz = (nM - fm) < WGM ? (nM - fm) : WGM;
        u.pm = fm + ((wgid % nig) % gsz); u.pn = (wgid % nig) / gsz; return true;
    }
    __device__ __forceinline__ void a_ready(const Unit&) const {}
    __device__ __forceinline__ void done(const Unit&) const {}
};

template <class Epi, class Sched, bool ALIGN_EPI = false, bool SP2 = false>
__device__ __forceinline__ void gemm_phase(PG8_LAS unsigned char* lds, const Gemm g, const Sched& S, const Epi& E, const int wave_id_in) {
    int tid_o = tid_of(wave_id_in);
    const int tid = tid_o, wid = __builtin_amdgcn_readfirstlane(tid >> 6), lane = tid & 63, wr = wid >> 2, wc = wid & 3, fr = lane & 15, fq = lane >> 4;
    const int K = g.K, nt = K / BK;
    unsigned voffA[2], voffB[2];
#pragma unroll
    for (int i = 0; i < 2; ++i) { int R, C; stage_rc(tid * 16 + i * 8192, R, C); const int Rb = Epi::PERM ? ((R & ~31) + perm32(R & 31)) : R;
        voffA[i] = (unsigned)(R * K + C) * 2u; voffB[i] = (unsigned)(Rb * K + C) * 2u; }
    const size_t kstep = (size_t)(BK * 2);
    const size_t hstep = (size_t)HALF * K * 2;
    const size_t tstep = 2 * hstep;
    const unsigned ldsw = (unsigned)wid * 1024u;
    const int aoff = lds_byte(wr * 64 + fr, fq * 8), boff = lds_byte(wc * 32 + fr, fq * 8);
#define PG8_SA(b, h) (((b) * 2 + (h)) * HTB)
#define PG8_SB(b, h) ((4 + (b) * 2 + (h)) * HTB)
#define PG8_STAGE(bufoff, gbase, voff) do { _Pragma("unroll") for (int _i = 0; _i < 2; ++_i) \
        __builtin_amdgcn_global_load_lds((const unsigned*)((const char*)(gbase) + (voff)[_i]), (PG8_LAS unsigned*)(lds + (bufoff) + ldsw + _i * 8192), 16, 0, 0); } while (0)
#define PG8_LDA(dst, b, h) do { _Pragma("unroll") for (int m = 0; m < 4; ++m) _Pragma("unroll") for (int k = 0; k < 2; ++k) dst[m][k] = *(const PG8_LAS bf16x8*)(lds + PG8_SA(b, h) + aoff + m * 2048 + k * 1024); } while (0)
#define PG8_LDB(dst, b, h) do { _Pragma("unroll") for (int n = 0; n < 2; ++n) _Pragma("unroll") for (int k = 0; k < 2; ++k) dst[n][k] = *(const PG8_LAS bf16x8*)(lds + PG8_SB(b, h) + boff + n * 2048 + k * 1024); } while (0)
#define PG8_MMA(ai, bj, At, Bt) do { __builtin_amdgcn_s_setprio(1); _Pragma("unroll") for (int m = 0; m < 4; ++m) _Pragma("unroll") for (int n = 0; n < 2; ++n) _Pragma("unroll") for (int k = 0; k < 2; ++k) \
        acc[ai][bj][m][n] = __builtin_amdgcn_mfma_f32_16x16x32_bf16(Bt[n][k], At[m][k], acc[ai][bj][m][n], 0, 0, 0); __builtin_amdgcn_s_setprio(0); } while (0)
#define PG8_WAIT_V(n) asm volatile("s_waitcnt vmcnt(" #n ")" ::: "memory")
#define PG8_WAIT_L(n) asm volatile("s_waitcnt lgkmcnt(" #n ")" ::: "memory")
#define PG8_BAR __builtin_amdgcn_s_barrier()
#define PG8_SCHED __builtin_amdgcn_sched_barrier(0)
    Unit cur, nxt; int ui = 0;
    if (!S.next(0, cur)) return;
    f32x4 acc[2][2][4][2];
#pragma unroll
    for (int a = 0; a < 2; ++a)
#pragma unroll
        for (int b = 0; b < 2; ++b)
#pragma unroll
            for (int m = 0; m < 4; ++m)
#pragma unroll
                for (int n = 0; n < 2; ++n) acc[a][b][m][n] = (f32x4){0.f, 0.f, 0.f, 0.f};
    bf16x8 At[4][2], B0[2][2], B1[2][2];
    const char* cA = (const char*)g.A + (size_t)cur.pm * tstep; const char* cB = (const char*)g.Bt + (size_t)cur.pn * tstep;
    S.a_ready(cur);
    if constexpr (SP2) {
        PG8_STAGE(PG8_SB(0, 0), cB, voffB); PG8_STAGE(PG8_SB(0, 1), cB + hstep, voffB); PG8_STAGE(PG8_SA(0, 0), cA, voffA); PG8_STAGE(PG8_SA(0, 1), cA + hstep, voffA);
        if (wr == 1) PG8_BAR;
        PG8_WAIT_V(2); PG8_BAR;
        PG8_STAGE(PG8_SB(1, 0), cB + kstep, voffB); PG8_STAGE(PG8_SA(1, 0), cA + kstep, voffA); PG8_STAGE(PG8_SB(1, 1), cB + hstep + kstep, voffB);
        PG8_WAIT_V(6); PG8_BAR;
    } else {
        PG8_STAGE(PG8_SB(0, 0), cB, voffB); PG8_STAGE(PG8_SA(0, 0), cA, voffA); PG8_STAGE(PG8_SB(0, 1), cB + hstep, voffB); PG8_STAGE(PG8_SA(0, 1), cA + hstep, voffA);
        if (wr == 1) PG8_BAR;
        PG8_WAIT_V(4); PG8_BAR;
        PG8_STAGE(PG8_SB(1, 0), cB + kstep, voffB); PG8_STAGE(PG8_SA(1, 0), cA + kstep, voffA); PG8_STAGE(PG8_SB(1, 1), cB + hstep + kstep, voffB);
        PG8_WAIT_V(6); PG8_BAR;
    }
    for (;;) {
        const bool has_next = S.next(ui + 1, nxt);
        const char* nA = has_next ? (const char*)g.A + (size_t)nxt.pm * tstep : cA; const char* nB = has_next ? (const char*)g.Bt + (size_t)nxt.pn * tstep : cB;
        for (int t = 0; t < nt; t += 2) {
            const bool last = (t == nt - 2);
            const char* a1 = cA + (size_t)(t + 1) * kstep;
            const char* a2 = last ? nA : cA + (size_t)(t + 2) * kstep; const char* b2 = last ? nB : cB + (size_t)(t + 2) * kstep;
            const char* a3 = a2 + kstep; const char* b3 = b2 + kstep;
            if (last && has_next) S.a_ready(nxt);
            if constexpr (SP2) {
            PG8_LDB(B0, 0, 0); PG8_LDB(B1, 0, 1); PG8_SCHED; PG8_LDA(At, 0, 0); PG8_STAGE(PG8_SA(1, 1), a1 + hstep, voffA);
            PG8_WAIT_V(8); PG8_WAIT_L(0); PG8_BAR; PG8_MMA(0, 0, At, B0); PG8_MMA(0, 1, At, B1); PG8_BAR; PG8_SCHED;
            PG8_LDA(At, 0, 1); PG8_STAGE(PG8_SB(0, 0), b2, voffB); PG8_STAGE(PG8_SB(0, 1), b2 + hstep, voffB); PG8_STAGE(PG8_SA(0, 0), a2, voffA);
            PG8_WAIT_V(8); PG8_WAIT_L(0); PG8_BAR; PG8_MMA(1, 0, At, B0); PG8_MMA(1, 1, At, B1); PG8_BAR; PG8_SCHED;
            PG8_LDB(B0, 1, 0); PG8_LDB(B1, 1, 1); PG8_SCHED; PG8_LDA(At, 1, 0); PG8_STAGE(PG8_SA(0, 1), a2 + hstep, voffA);
            PG8_WAIT_V(8); PG8_WAIT_L(0); PG8_BAR; PG8_MMA(0, 0, At, B0); PG8_MMA(0, 1, At, B1); PG8_BAR; PG8_SCHED;
            PG8_LDA(At, 1, 1); PG8_STAGE(PG8_SB(1, 0), b3, voffB); PG8_STAGE(PG8_SB(1, 1), b3 + hstep, voffB); PG8_STAGE(PG8_SA(1, 0), a3, voffA);
            PG8_WAIT_V(8); PG8_WAIT_L(0); PG8_BAR; PG8_MMA(1, 0, At, B0); PG8_MMA(1, 1, At, B1); PG8_BAR; PG8_SCHED;
            } else {
            PG8_LDB(B0, 0, 0); PG8_SCHED; PG8_LDA(At, 0, 0); PG8_STAGE(PG8_SA(1, 1), a1 + hstep, voffA);
            PG8_WAIT_L(8); PG8_BAR; PG8_WAIT_L(0); PG8_MMA(0, 0, At, B0); PG8_BAR; PG8_SCHED;
            PG8_LDB(B1, 0, 1); PG8_STAGE(PG8_SB(0, 0), b2, voffB);
            PG8_BAR; PG8_WAIT_L(0); PG8_MMA(0, 1, At, B1); PG8_BAR;
            PG8_LDA(At, 0, 1); PG8_STAGE(PG8_SA(0, 0), a2, voffA);
            PG8_BAR; PG8_WAIT_L(0); PG8_MMA(1, 0, At, B0); PG8_BAR; PG8_SCHED;
            PG8_STAGE(PG8_SB(0, 1), b2 + hstep, voffB);
            PG8_WAIT_V(6); PG8_BAR; PG8_MMA(1, 1, At, B1); PG8_BAR;
            PG8_LDB(B0, 1, 0); PG8_SCHED; PG8_LDA(At, 1, 0); PG8_STAGE(PG8_SA(0, 1), a2 + hstep, voffA);
            PG8_WAIT_L(8); PG8_BAR; PG8_WAIT_L(0); PG8_MMA(0, 0, At, B0); PG8_BAR; PG8_SCHED;
            PG8_LDB(B1, 1, 1); PG8_STAGE(PG8_SB(1, 0), b3, voffB);
            PG8_BAR; PG8_WAIT_L(0); PG8_MMA(0, 1, At, B1); PG8_BAR;
            PG8_LDA(At, 1, 1); PG8_STAGE(PG8_SA(1, 0), a3, voffA);
            PG8_BAR; PG8_WAIT_L(0); PG8_MMA(1, 0, At, B0); PG8_BAR; PG8_SCHED;
            PG8_STAGE(PG8_SB(1, 1), b3 + hstep, voffB);
            PG8_WAIT_V(6); PG8_BAR; PG8_MMA(1, 1, At, B1); PG8_BAR;
            }
        }
        if constexpr (ALIGN_EPI) { if (wr == 0) PG8_BAR; }
        if constexpr (!Epi::AFTER_DRAIN) { E(acc, cur, wr, wc, fr, fq); S.done(cur); }
        if (!has_next) break;
#pragma unroll
        for (int a = 0; a < 2; ++a)
#pragma unroll
            for (int b = 0; b < 2; ++b)
#pragma unroll
                for (int m = 0; m < 4; ++m)
#pragma unroll
                    for (int n = 0; n < 2; ++n) acc[a][b][m][n] = (f32x4){0.f, 0.f, 0.f, 0.f};
        cur = nxt; cA = nA; cB = nB; ++ui;
        if constexpr (ALIGN_EPI) { if (wr == 1) PG8_BAR; }
    }
    PG8_WAIT_V(0);
    if constexpr (!ALIGN_EPI) { if (wr == 0) PG8_BAR; }
    PG8_BAR;
    if constexpr (Epi::AFTER_DRAIN) { E.fused(acc, cur, wr, wc, fr, fq, lds, wid, lane); S.done(cur); }
#undef PG8_SA
#undef PG8_SB
#undef PG8_STAGE
#undef PG8_LDA
#undef PG8_LDB
#undef PG8_MMA
#undef PG8_WAIT_V
#undef PG8_WAIT_L
#undef PG8_BAR
#undef PG8_SCHED
}
}

constexpr int D_MODEL = 2048, BATCH = 4, SEQ = 2048, CTX = 256, GRID_W = 64, NHEAD = 8, HD = 128, WA = 1024;
constexpr int FFN = 5632, IN_COLS = 12288, NMOD = 6;
constexpr int ML = BATCH * SEQ;
constexpr int MC = BATCH * CTX;
constexpr int MT = ML + MC;
constexpr float EPS = 1e-6f;
constexpr int NTHREADS = 512;
constexpr int VT_PITCH = SEQ + CTX;

typedef unsigned short bf16;
typedef float f32x4 __attribute__((ext_vector_type(4)));
typedef unsigned u32x2 __attribute__((ext_vector_type(2)));
typedef unsigned u32x4 __attribute__((ext_vector_type(4)));
#define LAS __attribute__((address_space(3)))

typedef float f32x2_t __attribute__((ext_vector_type(2)));
typedef __bf16 bf16x2_t __attribute__((ext_vector_type(2)));
__device__ __forceinline__ unsigned pk2(float lo, float hi) { const f32x2_t v = {lo, hi}; const bf16x2_t b = __builtin_convertvector(v, bf16x2_t); return __builtin_bit_cast(unsigned, b); }
__device__ __forceinline__ unsigned f2bf(float f) { return pk2(f, 0.f) & 0xffffu; }
__device__ __forceinline__ float bf2f(unsigned short h) { return __builtin_bit_cast(float, (unsigned)h << 16); }
__device__ __forceinline__ float bflo(unsigned w) { return __builtin_bit_cast(float, w << 16); }
__device__ __forceinline__ float bfhi(unsigned w) { return __builtin_bit_cast(float, w & 0xffff0000u); }
__device__ __forceinline__ float sigmoidf_(float x) { return 1.0f / (1.0f + __expf(-x)); }
__device__ __forceinline__ float siluf_(float x) { return x / (1.0f + __expf(-x)); }
__device__ __forceinline__ float wave_sum(float v) {
#pragma unroll
    for (int o = 1; o < 64; o <<= 1) v += __shfl_xor(v, o);
    return v;
}
__device__ __forceinline__ float wave_max(float v) {
#pragma unroll
    for (int o = 1; o < 64; o <<= 1) v = fmaxf(v, __shfl_xor(v, o));
    return v;
}

constexpr size_t al256(size_t x) { return (x + 255) & ~(size_t)255; }
constexpr size_t WS_CTL   = 0;
constexpr size_t CTL_ZERO_BYTES = 1u << 20;
constexpr size_t WS_ROWSQ = 64 * 1024;
constexpr size_t WS_BIAS2 = WS_ROWSQ + (size_t)ML * 4;
static_assert(WS_BIAS2 + (size_t)4 * 2 * FFN * 4 <= CTL_ZERO_BYTES, "ctl");
constexpr size_t WS_MOD   = CTL_ZERO_BYTES;
constexpr size_t WS_LB    = al256(WS_MOD + (size_t)5 * IN_COLS * 4);
constexpr size_t WS_ROPE  = al256(WS_LB + 2 * WA * 4);
constexpr size_t WS_SMALL_END = al256(WS_ROPE + 2 * 64 * 32 * 4);
constexpr size_t WS_W13T  = al256(WS_SMALL_END);
constexpr size_t WS_W2T   = WS_W13T + (size_t)2 * FFN * D_MODEL * 2;
constexpr size_t WS_WAT   = WS_W2T + (size_t)D_MODEL * FFN * 2;
constexpr size_t WS_WBT   = WS_WAT + (size_t)D_MODEL * WA * 2;
constexpr size_t WS_WOT   = WS_WBT + (size_t)D_MODEL * WA * 2;
constexpr size_t WS_A_END = WS_WOT + (size_t)D_MODEL * D_MODEL * 2;
constexpr size_t SEGB = (size_t)MT * WA * 2;
constexpr size_t WS_QA  = WS_A_END;
constexpr size_t WS_FW  = WS_QA + SEGB;
constexpr size_t WS_FB  = WS_FW + 2 * SEGB;
constexpr size_t WS_IA  = WS_FB + 2 * SEGB;
constexpr size_t WS_GA  = WS_IA + SEGB;
constexpr size_t WS_QN  = WS_GA + (size_t)ML * WA * 2;
constexpr size_t WS_KN  = WS_QN + (size_t)ML * WA * 2;
constexpr size_t WS_VN  = WS_KN + SEGB;
constexpr size_t WS_GTA = WS_VN + SEGB;
constexpr size_t WS_GTB = WS_GTA + (size_t)ML * D_MODEL * 2;
constexpr size_t WS_D_END = WS_GTB + (size_t)ML * D_MODEL * 2;
constexpr size_t WS_WINT = WS_D_END;
constexpr size_t WS_OF   = WS_WINT;
constexpr size_t WS_OB   = WS_OF + (size_t)ML * WA * 2;
constexpr size_t WS_B_END = WS_WINT + (size_t)IN_COLS * D_MODEL * 2;
static_assert(WS_OB + (size_t)ML * WA * 2 <= WS_B_END, "B");
constexpr size_t WS_H   = WS_B_END;
constexpr size_t WS_YA  = WS_H;
constexpr size_t WS_YB  = WS_YA + (size_t)ML * WA * 2;
constexpr size_t WS_C_END = WS_H + (size_t)MT * D_MODEL * 2;
constexpr size_t WS_ACT_END = WS_D_END + (size_t)ML * FFN * 2;
constexpr size_t WS_HIMG = WS_WINT;
constexpr size_t WS_HIMG_END = WS_HIMG + (size_t)64 * 36 * 41472;
constexpr size_t WS_T1 = WS_WINT;
constexpr size_t WS_END0 = WS_C_END > WS_ACT_END ? WS_C_END : WS_ACT_END;
constexpr size_t WS_END = WS_END0 > WS_HIMG_END ? WS_END0 : WS_HIMG_END;
static_assert(WS_END <= 445000000, "ws budget");
constexpr size_t WS_Z   = WS_QA;
constexpr size_t WS_XMG = WS_GTB;
constexpr size_t WS_HALO = WS_QA;
static_assert(WS_HALO + (size_t)32 * 6 * FFN * 4 <= WS_XMG, "HALO overlay");
constexpr size_t WS_ACT = WS_WINT;
static_assert(WS_ACT + (size_t)ML * FFN * 2 <= WS_END, "ACT overlay");

struct Params {
    const float *x, *c, *ctx, *c_ctx, *ada_w, *ada_b, *norm1_g, *norm2_g, *w_in, *lb_logits, *hgrn_norm_g, *q_norm_g, *k_norm_g, *rel_bias,
                *w_a, *w_b, *w_o, *w1, *w3, *conv_w, *conv_b, *w2;
    float* out;
    unsigned char* ws;
    int wave_id, pad;
};

template <bool QKPERM, bool BIAS>
__device__ __forceinline__ void transpose_item(const float* W, int K, int N, bf16* WT, int row_off, LAS float* scr, int item, int lane, const float* sh2 = nullptr, float* bias2 = nullptr) {
    const int nblk = N / 32, kb = item / nblk, nb = item % nblk, k0 = 64 * kb, n0 = 32 * nb;
    if (BIAS) row_off += (n0 >> 7) * 128;
    float wv[32];
#pragma unroll
    for (int i = 0; i < 32; ++i) wv[i] = W[(size_t)(k0 + 2 * i + (lane >> 5)) * N + n0 + (lane & 31)];
#pragma unroll
    for (int i = 0; i < 32; ++i) scr[(2 * i + (lane >> 5)) * 33 + (lane & 31)] = wv[i];
    if (BIAS) {
        float a0 = 0.f, a1 = 0.f, a2 = 0.f, a3 = 0.f;
#pragma unroll
        for (int i = 0; i < 32; ++i) { const int k = k0 + 2 * i + (lane >> 5); const float w = wv[i];
            a0 += w * sh2[0 * IN_COLS + k]; a1 += w * sh2[1 * IN_COLS + k]; a2 += w * sh2[2 * IN_COLS + k]; a3 += w * sh2[3 * IN_COLS + k]; }
        a0 += __shfl_xor(a0, 32); a1 += __shfl_xor(a1, 32); a2 += __shfl_xor(a2, 32); a3 += __shfl_xor(a3, 32);
        if (lane < 32) { float* bp = bias2 + row_off + n0 + lane; atomicAdd(bp, a0); atomicAdd(bp + 2 * FFN, a1); atomicAdd(bp + 4 * FFN, a2); atomicAdd(bp + 6 * FFN, a3); }
    }
    asm volatile("s_waitcnt lgkmcnt(0)" ::: "memory");
    const int c = lane & 7;
#pragma unroll
    for (int j = 0; j < 4; ++j) { const int n = (lane >> 3) + 8 * j; const LAS float* s = scr + (8 * c) * 33 + n;
        u32x4 o; o.x = pk2(s[0 * 33], s[1 * 33]); o.y = pk2(s[2 * 33], s[3 * 33]); o.z = pk2(s[4 * 33], s[5 * 33]); o.w = pk2(s[6 * 33], s[7 * 33]);
        int cdst = n0 + n;
        if (QKPERM && cdst >= 5 * WA && cdst < 7 * WA) cdst = (cdst & ~0x30) | ((cdst & 0x10) << 1) | ((cdst & 0x20) >> 1);
        *(u32x4*)(WT + (size_t)(row_off + cdst) * K + k0 + 8 * c) = o; }
    asm volatile("s_waitcnt lgkmcnt(0)" ::: "memory");
}
__device__ __forceinline__ void phase_wconv_in(const Params& p, LAS unsigned char* lds, int gw, int NGW) {
    const int lane = lane_id(), wave = p.wave_id;
    LAS float* scr = (LAS float*)(lds + wave * 16384);
    constexpr int I_IN = (D_MODEL / 64) * (IN_COLS / 32);
    for (int it = gw; it < I_IN; it += NGW) transpose_item<true, false>(p.w_in, D_MODEL, IN_COLS, (bf16*)(p.ws + WS_WINT), 0, scr, it, lane);
}
__device__ __forceinline__ void phase_wconv_rest(const Params& p, LAS unsigned char* lds, int gw, int NGW) {
    const int lane = lane_id(), wave = p.wave_id;
    LAS float* scr = (LAS float*)(lds + 16384 + wave * 16384);
    constexpr int I_A = (WA / 64) * (D_MODEL / 32), I_O = (D_MODEL / 64) * (D_MODEL / 32), I_1 = (D_MODEL / 64) * (FFN / 32), I_2 = (FFN / 64) * (D_MODEL / 32);
    constexpr int NITEMS = 2 * I_A + I_O + 2 * I_1 + I_2;
    unsigned char* ws = p.ws;
    const float* sh2 = (const float*)(ws + WS_MOD) + 3 * D_MODEL; float* b2 = (float*)(ws + WS_BIAS2);
    for (int it = gw; it < NITEMS; it += NGW) {
        int r = it;
        if (r < I_A) { transpose_item<false, false>(p.w_a, WA, D_MODEL, (bf16*)(ws + WS_WAT), 0, scr, r, lane); continue; } r -= I_A;
        if (r < I_A) { transpose_item<false, false>(p.w_b, WA, D_MODEL, (bf16*)(ws + WS_WBT), 0, scr, r, lane); continue; } r -= I_A;
        if (r < I_O) { transpose_item<false, false>(p.w_o, D_MODEL, D_MODEL, (bf16*)(ws + WS_WOT), 0, scr, r, lane); continue; } r -= I_O;
        if (r < I_1) { transpose_item<false, true>(p.w1, D_MODEL, FFN, (bf16*)(ws + WS_W13T), 0, scr, r, lane, sh2, b2); continue; } r -= I_1;
        if (r < I_1) { transpose_item<false, true>(p.w3, D_MODEL, FFN, (bf16*)(ws + WS_W13T), 128, scr, r, lane, sh2, b2); continue; } r -= I_1;
        transpose_item<false, false>(p.w2, FFN, D_MODEL, (bf16*)(ws + WS_W2T), 0, scr, r, lane);
    }
}

__device__ __forceinline__ void phase_mod(const Params& p, LAS unsigned char* lds, int vb, int nb) {
    const int tid = tid_of(p.wave_id);
    LAS float* sc = (LAS float*)lds;
    LAS float* red = (LAS float*)(lds + 5 * 2048 * 4);
    for (int i = tid; i < 5 * D_MODEL; i += NTHREADS) { const int r = i / D_MODEL, k = i % D_MODEL; const float v = (r < 4) ? p.c[r * D_MODEL + k] : p.c_ctx[k]; sc[i] = siluf_(v); }
    __syncthreads();
    float* mod = (float*)(p.ws + WS_MOD);
    const int c4 = tid & 15, kp = tid >> 4;
    for (int item = vb; item < IN_COLS / 64; item += nb) {
        const int n0 = item * 64 + c4 * 4;
        f32x4 acc[5];
#pragma unroll
        for (int r = 0; r < 5; ++r) acc[r] = (f32x4){0.f, 0.f, 0.f, 0.f};
#pragma unroll 8
        for (int k = kp; k < D_MODEL; k += 32) {
            const f32x4 w = *(const f32x4*)(p.ada_w + (size_t)k * IN_COLS + n0);
#pragma unroll
            for (int r = 0; r < 5; ++r) acc[r] += w * sc[r * D_MODEL + k];
        }
#pragma unroll
        for (int r = 0; r < 5; ++r) *(LAS f32x4*)(red + (kp * 5 + r) * 64 + c4 * 4) = acc[r];
        __syncthreads();
        if (tid < 320) { const int r = tid / 64, cidx = tid % 64; float s = 0.f;
            for (int q = 0; q < 32; ++q) s += red[(q * 5 + r) * 64 + cidx];
            mod[r * IN_COLS + item * 64 + cidx] = s + p.ada_b[item * 64 + cidx]; }
        __syncthreads();
    }
    if (vb == nb - 1) { float* rt = (float*)(p.ws + WS_ROPE);
        for (int i = tid; i < 64 * 32; i += NTHREADS) { const int pos = i >> 5, j = i & 31; const float inv = exp2f(-(float)j * (13.287712379549449f / 32.0f)); float sn, cs; sincosf((float)pos * inv, &sn, &cs); rt[i] = cs; rt[2048 + i] = sn; } }
    if (vb == 0) { float* lb = (float*)(p.ws + WS_LB);
        for (int i = tid; i < 2 * WA; i += NTHREADS) { const int d = i / WA, cc = i % WA; const float l0 = p.lb_logits[d * 2 * WA + cc], l1 = p.lb_logits[d * 2 * WA + WA + cc]; lb[i] = 1.0f / (1.0f + expf(l1 - l0)); } }
}

__device__ __forceinline__ void phase_h(const Params& p, int vb, int nb) {
    const int tid = tid_of(p.wave_id), lane = tid & 63, wave = p.wave_id;
    const float* mod = (const float*)(p.ws + WS_MOD);
    bf16* H = (bf16*)(p.ws + WS_H);
    for (int m = vb * 8 + wave; m < MT; m += nb * 8) {
        const float* xr = (m < ML) ? p.x + (size_t)m * D_MODEL : p.ctx + (size_t)(m - ML) * D_MODEL;
        const int mr = (m < ML) ? (m / SEQ) : 4;
        const float* sh = mod + (size_t)mr * IN_COLS, *scl = sh + D_MODEL;
        f32x4 v[8]; float s = 0.f;
#pragma unroll
        for (int j = 0; j < 8; ++j) { v[j] = *(const f32x4*)(xr + 4 * lane + 256 * j); s += (v[j].x * v[j].x + v[j].y * v[j].y) + (v[j].z * v[j].z + v[j].w * v[j].w); }
        const float rstd = 1.0f / sqrtf(wave_sum(s) * (1.0f / D_MODEL) + EPS);
#pragma unroll
        for (int j = 0; j < 8; ++j) { const int k = 4 * lane + 256 * j;
            const f32x4 g = *(const f32x4*)(p.norm1_g + k), a = *(const f32x4*)(scl + k), b = *(const f32x4*)(sh + k);
            const f32x4 h = v[j] * rstd * g * (a + 1.0f) + b;
            u32x2 o; o.x = pk2(h.x, h.y); o.y = pk2(h.z, h.w);
            *(u32x2*)(H + (size_t)m * D_MODEL + k) = o; }
    }
}

#define EPI_LOOP_BEGIN \
    _Pragma("unroll") for (int ai = 0; ai < 2; ++ai) _Pragma("unroll") for (int m = 0; m < 4; ++m) { const int row = u.pm * 256 + ai * 128 + wr * 64 + m * 16 + fr; \
    _Pragma("unroll") for (int bj = 0; bj < 2; ++bj) _Pragma("unroll") for (int n = 0; n < 2; ++n) { const int col = u.pn * 256 + bj * 128 + wc * 32 + n * 16 + fq * 4; const f32x4 v = acc[ai][bj][m][n];
#define EPI_LOOP_END } }

struct EpiInProj {
    static constexpr bool PERM = false, AFTER_DRAIN = false;
    unsigned char* ws; LAS unsigned char* lds; const float* qg; const float* kg;
    __device__ __forceinline__ void operator()(const f32x4 (&acc)[2][2][4][2], const pg8::Unit& u, int wr, int wc, int fr, int fq) const {
        const int seg = u.pn >> 2;
        const bool ctxrow = u.pm >= ML / 256;
        const float* lb = (const float*)(ws + WS_LB);
        if (seg == 1 || seg == 2) {
            float* F = (float*)(ws + (seg == 1 ? WS_FW : WS_FB)); const float* lbd = lb + (seg - 1) * WA;
            EPI_LOOP_BEGIN
                const int c = col - seg * WA; const f32x4 l = *(const f32x4*)(lbd + c); f32x4 o;
                o.x = logf(l.x + (1.0f - l.x) * sigmoidf_(v.x)); o.y = logf(l.y + (1.0f - l.y) * sigmoidf_(v.y));
                o.z = logf(l.z + (1.0f - l.z) * sigmoidf_(v.z)); o.w = logf(l.w + (1.0f - l.w) * sigmoidf_(v.w));
                *(f32x4*)(F + (size_t)row * WA + c) = o;
            EPI_LOOP_END
        } else if (seg == 7) {
            bf16* VT = (bf16*)(ws + WS_VN);
            EPI_LOOP_BEGIN
                const int c = col - 7 * WA; const int hh = c >> 7, d = c & 127;
                int bb, tok; if (row < ML) { bb = row / SEQ; tok = row % SEQ; } else { bb = (row - ML) / CTX; tok = SEQ + (row - ML) % CTX; }
                bf16* o = VT + ((size_t)(bb * NHEAD + hh) * HD + d) * VT_PITCH + tok;
                o[0] = (bf16)f2bf(v.x); o[VT_PITCH] = (bf16)f2bf(v.y); o[2 * VT_PITCH] = (bf16)f2bf(v.z); o[3 * VT_PITCH] = (bf16)f2bf(v.w);
            EPI_LOOP_END
        } else if (seg == 5 || seg == 6) {
            if (ctxrow && seg == 5) return;
            LAS float* ssq = (LAS float*)(lds + 131072);
            const float* gn = (seg == 5) ? qg : kg; const float* rt = (const float*)(ws + WS_ROPE);
            bf16* O = (bf16*)(ws + (seg == 5 ? WS_QN : WS_KN));
#pragma unroll
            for (int ai = 0; ai < 2; ++ai)
#pragma unroll
                for (int m = 0; m < 4; ++m)
#pragma unroll
                    for (int bj = 0; bj < 2; ++bj) { const f32x4 a = acc[ai][bj][m][0], b = acc[ai][bj][m][1];
                        float sq = (a.x * a.x + a.y * a.y) + (a.z * a.z + a.w * a.w) + (b.x * b.x + b.y * b.y) + (b.z * b.z + b.w * b.w);
                        sq += __shfl_xor(sq, 16); sq += __shfl_xor(sq, 32);
                        if (fq == 0) ssq[((ai * 128 + wr * 64 + m * 16 + fr) * 2 + bj) * 4 + wc] = sq; }
            asm volatile("s_waitcnt lgkmcnt(0)" ::: "memory"); __builtin_amdgcn_s_barrier(); asm volatile("" ::: "memory");
            const int H = wc >> 1, jj = 16 * (wc & 1) + 4 * fq;
            const f32x4 g0 = *(const f32x4*)(gn + 64 * H + jj), g1 = *(const f32x4*)(gn + 64 * H + 32 + jj);
#pragma unroll
            for (int ai = 0; ai < 2; ++ai)
#pragma unroll
                for (int m = 0; m < 4; ++m) { const int rl = ai * 128 + wr * 64 + m * 16 + fr; const int row = u.pm * 256 + rl;
                    f32x4 cs = (f32x4){1.f, 1.f, 1.f, 1.f}, sn = (f32x4){0.f, 0.f, 0.f, 0.f};
                    if (!ctxrow) { const int t = row & (SEQ - 1); const int pos = (H == 0) ? (t >> 6) : (t & 63); cs = *(const f32x4*)(rt + pos * 32 + jj); sn = *(const f32x4*)(rt + 2048 + pos * 32 + jj); }
#pragma unroll
                    for (int bj = 0; bj < 2; ++bj) { const f32x4 s4 = *(const LAS f32x4*)(ssq + (rl * 2 + bj) * 4);
                        const float rstd = 1.0f / sqrtf(((s4.x + s4.y) + (s4.z + s4.w)) * (1.0f / HD) + EPS);
                        const f32x4 u1 = acc[ai][bj][m][0] * rstd * g0, u2 = acc[ai][bj][m][1] * rstd * g1;
                        const f32x4 o1 = u1 * cs - u2 * sn, o2 = u1 * sn + u2 * cs;
                        bf16* op = O + (size_t)row * WA + (u.pn & 3) * 256 + bj * 128 + wc * 32 + fq * 4;
                        u32x2 w1; w1.x = pk2(o1.x, o1.y); w1.y = pk2(o1.z, o1.w); *(u32x2*)op = w1;
                        u32x2 w2; w2.x = pk2(o2.x, o2.y); w2.y = pk2(o2.z, o2.w); *(u32x2*)(op + 16) = w2; }
                    asm volatile("" ::: "memory"); }
            asm volatile("s_waitcnt lgkmcnt(0)" ::: "memory"); __builtin_amdgcn_s_barrier(); asm volatile("" ::: "memory");
        } else if (seg == 0 || seg == 3) {
            if (ctxrow && seg == 0) return;
            bf16* O = (bf16*)(ws + (seg == 0 ? WS_QA : WS_IA));
            EPI_LOOP_BEGIN
                const int c = col - seg * WA; u32x2 o; o.x = pk2(v.x, v.y); o.y = pk2(v.z, v.w);
                *(u32x2*)(O + (size_t)row * WA + c) = o;
            EPI_LOOP_END
        } else if (seg == 4) {
            if (ctxrow) return;
            bf16* O = (bf16*)(ws + WS_GA);
            EPI_LOOP_BEGIN
                const int c = col - seg * WA; u32x2 o; o.x = pk2(siluf_(v.x), siluf_(v.y)); o.y = pk2(siluf_(v.z), siluf_(v.w));
                *(u32x2*)(O + (size_t)row * WA + c) = o;
            EPI_LOOP_END
        } else {
            if (ctxrow) return;
            const bool isa = seg < 10;
            bf16* O = (bf16*)(ws + (isa ? WS_GTA : WS_GTB)); const int cbase = isa ? 8 * WA : 10 * WA;
            EPI_LOOP_BEGIN
                const int c = col - cbase; u32x2 o; o.x = pk2(sigmoidf_(v.x), sigmoidf_(v.y)); o.y = pk2(sigmoidf_(v.z), sigmoidf_(v.w));
                *(u32x2*)(O + (size_t)row * D_MODEL + c) = o;
            EPI_LOOP_END
        }
    }
};

struct EpiMergeA {
    static constexpr bool PERM = false, AFTER_DRAIN = false;
    unsigned char* ws; float* tmp;
    __device__ __forceinline__ void operator()(const f32x4 (&acc)[2][2][4][2], const pg8::Unit& u, int wr, int wc, int fr, int fq) const {
        const bf16* G = (const bf16*)(ws + WS_GTA);
        EPI_LOOP_BEGIN
            const u32x2 g = *(const u32x2*)(G + (size_t)row * D_MODEL + col);
            f32x4 o; o.x = bflo(g.x) * v.x; o.y = bfhi(g.x) * v.y; o.z = bflo(g.y) * v.z; o.w = bfhi(g.y) * v.w;
            *(f32x4*)(tmp + (size_t)row * D_MODEL + col) = o;
        EPI_LOOP_END
    }
};
struct EpiMergeB {
    static constexpr bool PERM = false, AFTER_DRAIN = false;
    unsigned char* ws; const float* tmp;
    __device__ __forceinline__ void operator()(const f32x4 (&acc)[2][2][4][2], const pg8::Unit& u, int wr, int wc, int fr, int fq) const {
        const bf16* G = (const bf16*)(ws + WS_GTB); bf16* Z = (bf16*)(ws + WS_Z);
        EPI_LOOP_BEGIN
            const u32x2 g = *(const u32x2*)(G + (size_t)row * D_MODEL + col);
            const f32x4 t = *(const f32x4*)(tmp + (size_t)row * D_MODEL + col);
            u32x2 o; o.x = pk2(t.x + bflo(g.x) * v.x, t.y + bfhi(g.x) * v.y); o.y = pk2(t.z + bflo(g.y) * v.z, t.w + bfhi(g.y) * v.w);
            *(u32x2*)(Z + (size_t)row * D_MODEL + col) = o;
        EPI_LOOP_END
    }
};
struct EpiOutProj {
    static constexpr bool PERM = false, AFTER_DRAIN = false;
    unsigned char* ws; const float* x; const float* norm2_g; float* out;
    __device__ __forceinline__ void operator()(const f32x4 (&acc)[2][2][4][2], const pg8::Unit& u, int wr, int wc, int fr, int fq) const {
        const float* mod = (const float*)(ws + WS_MOD); bf16* XMG = (bf16*)(ws + WS_XMG); float* rowsq = (float*)(ws + WS_ROWSQ);
        const int b = (u.pm * 256) / SEQ;
        const float* g1 = mod + (size_t)b * IN_COLS + 2 * D_MODEL, *sc2 = mod + (size_t)b * IN_COLS + 4 * D_MODEL;
#pragma unroll
        for (int ai = 0; ai < 2; ++ai)
#pragma unroll
            for (int m = 0; m < 4; ++m) { const int row = u.pm * 256 + ai * 128 + wr * 64 + m * 16 + fr; float ss = 0.f;
#pragma unroll
                for (int bj = 0; bj < 2; ++bj)
#pragma unroll
                    for (int n = 0; n < 2; ++n) { const int col = u.pn * 256 + bj * 128 + wc * 32 + n * 16 + fq * 4; const f32x4 v = acc[ai][bj][m][n];
                        const f32x4 xv = *(const f32x4*)(x + (size_t)row * D_MODEL + col), g = *(const f32x4*)(g1 + col);
                        const f32x4 xm = xv + g * v;
                        *(f32x4*)(out + (size_t)row * D_MODEL + col) = xm;
                        ss += (xm.x * xm.x + xm.y * xm.y) + (xm.z * xm.z + xm.w * xm.w);
                        const f32x4 ng = *(const f32x4*)(norm2_g + col), s2 = *(const f32x4*)(sc2 + col);
                        const f32x4 h = xm * ng * (s2 + 1.0f);
                        u32x2 o; o.x = pk2(h.x, h.y); o.y = pk2(h.z, h.w);
                        *(u32x2*)(XMG + (size_t)row * D_MODEL + col) = o; }
                ss += __shfl_xor(ss, 16); ss += __shfl_xor(ss, 32);
                if (fq == 0) atomicAdd(rowsq + row, ss); }
    }
};
__device__ __forceinline__ float dpp_ror1(float v) { return __builtin_bit_cast(float, __builtin_amdgcn_update_dpp(0, __builtin_bit_cast(int, v), 0x121, 0xf, 0xf, false)); }
__device__ __forceinline__ float dpp_rol1(float v) { return __builtin_bit_cast(float, __builtin_amdgcn_update_dpp(0, __builtin_bit_cast(int, v), 0x12f, 0xf, 0xf, false)); }
__device__ __forceinline__ f32x4 ror1_4(const f32x4 v) { return (f32x4){dpp_ror1(v.x), dpp_ror1(v.y), dpp_ror1(v.z), dpp_ror1(v.w)}; }
__device__ __forceinline__ f32x4 rol1_4(const f32x4 v) { return (f32x4){dpp_rol1(v.x), dpp_rol1(v.y), dpp_rol1(v.z), dpp_rol1(v.w)}; }
struct EpiFfnUp {
    static constexpr bool PERM = false, AFTER_DRAIN = false;
    unsigned char* ws; LAS unsigned char* lds; const float* cw; const float* cb;
    __device__ __forceinline__ void operator()(const f32x4 (&acc_c)[2][2][4][2], const pg8::Unit& u, int wr, int wc, int fr, int fq) const {
        f32x4 (&acc)[2][2][4][2] = const_cast<f32x4 (&)[2][2][4][2]>(acc_c);
        const float* rowsq = (const float*)(ws + WS_ROWSQ); bf16* ACT = (bf16*)(ws + WS_ACT); float* HALO = (float*)(ws + WS_HALO) + (size_t)u.pm * 6 * FFN;
        const int b = (u.pm * 256) / SEQ; const float* bias2 = (const float*)(ws + WS_BIAS2) + (size_t)b * 2 * FFN + u.pn * 256;
        const int cl = wc * 32 + fq * 4, ch0 = u.pn * 128 + cl;
        LAS float* X = (LAS float*)(lds + 131072);
#pragma unroll
        for (int ai = 0; ai < 2; ++ai)
#pragma unroll
            for (int m = 0; m < 4; ++m) { const int row = u.pm * 256 + ai * 128 + wr * 64 + m * 16 + fr;
                const float rstd = 1.0f / sqrtf(rowsq[row] * (1.0f / D_MODEL) + EPS);
#pragma unroll
                for (int bj = 0; bj < 2; ++bj)
#pragma unroll
                    for (int n = 0; n < 2; ++n) acc[ai][bj][m][n] = acc[ai][bj][m][n] * rstd + *(const f32x4*)(bias2 + bj * 128 + cl + 16 * n); }
#pragma unroll
        for (int ai = 0; ai < 2; ++ai) { const int bi = 2 * ai + wr;
            if (fr == 0) {
#pragma unroll
                for (int n = 0; n < 2; ++n) *(LAS f32x4*)(X + (bi * 2 + 0) * 128 + cl + 16 * n) = acc[ai][0][0][n]; }
            if (fr == 15) {
#pragma unroll
                for (int n = 0; n < 2; ++n) *(LAS f32x4*)(X + (bi * 2 + 1) * 128 + cl + 16 * n) = acc[ai][0][3][n]; } }
        asm volatile("s_waitcnt lgkmcnt(0)" ::: "memory"); __builtin_amdgcn_s_barrier(); asm volatile("" ::: "memory");
        if (wr == 0 && fr < 2) {
#pragma unroll
            for (int n = 0; n < 2; ++n) { *(f32x4*)(HALO + (size_t)fr * FFN + ch0 + 16 * n) = acc[0][0][0][n]; if (fr == 0) *(f32x4*)(HALO + (size_t)4 * FFN + ch0 + 16 * n) = acc[0][1][0][n]; } }
        if (wr == 1 && fr >= 14) {
#pragma unroll
            for (int n = 0; n < 2; ++n) { *(f32x4*)(HALO + (size_t)(fr - 12) * FFN + ch0 + 16 * n) = acc[1][0][3][n]; if (fr == 15) *(f32x4*)(HALO + (size_t)5 * FFN + ch0 + 16 * n) = acc[1][1][3][n]; } }
#pragma unroll
        for (int n = 0; n < 2; ++n) {
            const f32x4 w0 = *(const f32x4*)(cw + ch0 + 16 * n), w1 = *(const f32x4*)(cw + FFN + ch0 + 16 * n), w2 = *(const f32x4*)(cw + 2 * FFN + ch0 + 16 * n), cbv = *(const f32x4*)(cb + ch0 + 16 * n);
#pragma unroll
            for (int ai = 0; ai < 2; ++ai) { const int bi = 2 * ai + wr;
                const f32x4 xprev = (bi > 0) ? *(const LAS f32x4*)(X + ((bi - 1) * 2 + 1) * 128 + cl + 16 * n) : (f32x4){0.f, 0.f, 0.f, 0.f};
                const f32x4 xnext = (bi < 3) ? *(const LAS f32x4*)(X + ((bi + 1) * 2 + 0) * 128 + cl + 16 * n) : (f32x4){0.f, 0.f, 0.f, 0.f};
#pragma unroll
                for (int m = 0; m < 4; ++m) { const f32x4 cur = acc[ai][0][m][n];
                    const f32x4 pu = (m > 0) ? ror1_4(acc[ai][0][m > 0 ? m - 1 : 0][n]) : xprev; const f32x4 ps = ror1_4(cur);
                    const f32x4 nd = (m < 3) ? rol1_4(acc[ai][0][m < 3 ? m + 1 : 3][n]) : xnext; const f32x4 ns = rol1_4(cur);
                    const f32x4 prev = (fr > 0) ? ps : pu, next = (fr < 15) ? ns : nd;
                    const f32x4 uu = w0 * prev + w1 * cur + w2 * next + cbv; const f32x4 gt = acc[ai][1][m][n];
                    f32x4 r; r.x = siluf_(uu.x) * gt.x; r.y = siluf_(uu.y) * gt.y; r.z = siluf_(uu.z) * gt.z; r.w = siluf_(uu.w) * gt.w;
                    const int rl = ai * 128 + wr * 64 + m * 16 + fr;
                    if (rl != 0 && rl != 255) { u32x2 o; o.x = pk2(r.x, r.y); o.y = pk2(r.z, r.w); *(u32x2*)(ACT + (size_t)(u.pm * 256 + rl) * FFN + ch0 + 16 * n) = o; } } } }
    }
};
__device__ __forceinline__ void halo_fix(const Params& p, int pm, int tid) {
    const float* HB = (const float*)(p.ws + WS_HALO); const float* H = HB + (size_t)pm * 6 * FFN; bf16* ACT = (bf16*)(p.ws + WS_ACT);
    for (int ch = tid; ch < FFN; ch += NTHREADS) {
        const float w0 = p.conv_w[ch], w1 = p.conv_w[FFN + ch], w2 = p.conv_w[2 * FFN + ch], cbv = p.conv_b[ch];
        const float pv = (pm & 7) ? HB[((size_t)(pm - 1) * 6 + 3) * FFN + ch] : 0.f; const float nx = ((pm & 7) != 7) ? HB[((size_t)(pm + 1) * 6 + 0) * FFN + ch] : 0.f;
        const float ut = w0 * pv + w1 * H[ch] + w2 * H[FFN + ch] + cbv; const float ub = w0 * H[2 * FFN + ch] + w1 * H[3 * FFN + ch] + w2 * nx + cbv;
        ACT[(size_t)(pm * 256) * FFN + ch] = (bf16)f2bf(siluf_(ut) * H[4 * FFN + ch]); ACT[(size_t)(pm * 256 + 255) * FFN + ch] = (bf16)f2bf(siluf_(ub) * H[5 * FFN + ch]);
    }
}
struct EpiFfnDown {
    static constexpr bool PERM = false, AFTER_DRAIN = false;
    unsigned char* ws; float* out;
    __device__ __forceinline__ void operator()(const f32x4 (&acc)[2][2][4][2], const pg8::Unit& u, int wr, int wc, int fr, int fq) const {
        const float* mod = (const float*)(ws + WS_MOD); const int b = (u.pm * 256) / SEQ; const float* g2 = mod + (size_t)b * IN_COLS + 5 * D_MODEL;
        EPI_LOOP_BEGIN
            float* o = out + (size_t)row * D_MODEL + col; const f32x4 xm = *(const f32x4*)o, g = *(const f32x4*)(g2 + col);
            *(f32x4*)o = xm + g * v;
        EPI_LOOP_END
    }
};

#define XB_TMO      128
#define XB_XCNT(j)  (256  + 64 * (j))
#define XB_XSUB(j)  (1280 + 64 * (j))
#define XB_XGEN(j)  (2304 + 64 * (j))
#define XB_TOP      3328
#define XB_TOPGEN   3392
#define XCD_BAR_WORDS 3456
#define XB_SPIN_CAP (1u << 18)

__device__ __forceinline__ unsigned xb_ld(unsigned* p)              { return __hip_atomic_load(p, __ATOMIC_RELAXED, __HIP_MEMORY_SCOPE_AGENT); }
__device__ __forceinline__ unsigned xb_add(unsigned* p, unsigned v) { return __hip_atomic_fetch_add(p, v, __ATOMIC_RELAXED, __HIP_MEMORY_SCOPE_AGENT); }
__device__ __forceinline__ unsigned xb_xcc_id() { return (unsigned)__builtin_amdgcn_s_getreg((3 << 11) | 20) & 0xFu; }
#define XB_SPIN(cond, bar) do { unsigned _sp = 0; while (cond) { __builtin_amdgcn_s_sleep(1); \
    if ((++_sp & 255u) == 0u) { if (xb_ld(&(bar)[XB_TMO])) break; if (_sp > XB_SPIN_CAP) { atomicAdd(&(bar)[XB_TMO], 1u); break; } } } } while (0)

struct XcdBarrier {
    unsigned* bar; unsigned x; int wave;
    volatile LAS unsigned* st;
};

__device__ __forceinline__ XcdBarrier xcd_barrier_post(unsigned* bar, volatile LAS unsigned* st, int wave_id) {
    XcdBarrier b; b.bar = bar; b.x = xb_xcc_id(); b.st = st; b.wave = wave_id;
    if (wave_id == 0 && lane_id() == 0) (void)xb_add(&bar[XB_XCNT(b.x)], 1u);
    return b;
}
__device__ __forceinline__ void xcd_barrier_complete(unsigned* bar, unsigned x, unsigned& nloc, unsigned& nx) {
    const unsigned G = gridDim.x * gridDim.y * gridDim.z;
    unsigned sum, cnt, mine, sp = 0u;
    for (;;) {
        sum = 0u; cnt = 0u; mine = 0u;
#pragma unroll
        for (unsigned j = 0; j < 16; ++j) { const unsigned c = xb_ld(&bar[XB_XCNT(j)]); sum += c; cnt += (c > 0u) ? 1u : 0u; mine = (j == x) ? c : mine; }
        if (sum == G) break;
        __builtin_amdgcn_s_sleep(1);
        if ((++sp & 255u) == 0u) { if (xb_ld(&bar[XB_TMO])) break; if (sp > XB_SPIN_CAP) { atomicAdd(&bar[XB_TMO], 1u); break; } }
    }
    nloc = mine > 0u ? mine : 1u; nx = cnt > 0u ? cnt : 1u;
}

__device__ __forceinline__ void xcd_barrier(const XcdBarrier& b) {
    asm volatile("s_waitcnt vmcnt(0)" ::: "memory");
    __syncthreads();
    if (b.wave == 0 && lane_id() == 0) {
        unsigned* bar = b.bar;
        __builtin_amdgcn_s_waitcnt(0);
        unsigned nloc = b.st[0], nx = b.st[1];
        if (nloc == 0u) { xcd_barrier_complete(bar, b.x, nloc, nx); b.st[0] = nloc; b.st[1] = nx; }
        const unsigned old = xb_add(&bar[XB_XSUB(b.x)], 1u);
        const unsigned gen = old / nloc;
        if (old + 1u == (gen + 1u) * nloc) {
            __builtin_amdgcn_fence(__ATOMIC_RELEASE, "agent");
            asm volatile("s_waitcnt vmcnt(0)" ::: "memory");
            const unsigned og = xb_add(&bar[XB_TOP], 1u);
            const unsigned tg = og / nx;
            if (og + 1u == (tg + 1u) * nx) xb_add(&bar[XB_TOPGEN], 1u);
            else XB_SPIN(xb_ld(&bar[XB_TOPGEN]) == tg, bar);
            __builtin_amdgcn_fence(__ATOMIC_ACQUIRE, "agent");
            xb_add(&bar[XB_XGEN(b.x)], 1u);
            asm volatile("s_waitcnt vmcnt(0)" ::: "memory");
        } else {
            XB_SPIN(xb_ld(&bar[XB_XGEN(b.x)]) == gen, bar);
            __builtin_amdgcn_fence(__ATOMIC_ACQUIRE, "agent");
            asm volatile("s_waitcnt vmcnt(0)" ::: "memory");
        }
    }
    __syncthreads();
}

constexpr size_t WS_BAR = 8192;

typedef short bf16x8 __attribute__((ext_vector_type(8)));
typedef short s16x4 __attribute__((ext_vector_type(4)));

__device__ __forceinline__ bf16x8 cat8u(const u32x2 a, const u32x2 b) { const u32x4 w = (u32x4){a.x, a.y, b.x, b.y}; return __builtin_bit_cast(bf16x8, w); }
__device__ __forceinline__ bf16x8 pack_p(const f32x4 a, const f32x4 b) {
    u32x4 w; w.x = pk2(a.x, a.y); w.y = pk2(a.z, a.w); w.z = pk2(b.x, b.y); w.w = pk2(b.z, b.w);
    return __builtin_bit_cast(bf16x8, w);
}

constexpr int A_TILE = 32768, A_KOFF = 0, A_VOFF = 16384;
constexpr int A_BIAS = 4 * A_TILE;
constexpr int A_ITEM = A_BIAS + 2048;
static_assert(A_ITEM + 64 <= 145408, "attention LDS");
constexpr size_t WS_ATTCTR = 32768;
static_assert(WS_ATTCTR >= WS_BAR + XCD_BAR_WORDS * 4 && WS_ATTCTR + 8 * 256 <= WS_ROWSQ, "attn counters (8 x 256 B apart) inside ctl");
#define ATT_BAR() do { asm volatile("s_waitcnt lgkmcnt(0)" ::: "memory"); __builtin_amdgcn_s_barrier(); asm volatile("" ::: "memory"); } while (0)

__device__ __forceinline__ void phase_attn(const Params& p, LAS unsigned char* lds) {
    int tid_o = tid_of(p.wave_id);
    const int tid = tid_o, lane = tid & 63, wave = __builtin_amdgcn_readfirstlane(tid >> 6);
    const int qb = wave & 3, dh = wave >> 2, li = lane & 15, g = lane >> 4;
    const bf16* QN = (const bf16*)(p.ws + WS_QN); const bf16* KN = (const bf16*)(p.ws + WS_KN); const bf16* VT = (const bf16*)(p.ws + WS_VN);
    bf16* YB = (bf16*)p.out + (size_t)3 * ML * WA;
    unsigned* ctr = (unsigned*)(p.ws + WS_ATTCTR);
    LAS float* btab = (LAS float*)(lds + A_BIAS);
    const float scale = 0.08838834764831845f;
    int krow_l[2], kch_l[2], vrow_l[2], vch_l[2];
#pragma unroll
    for (int e = 0; e < 2; ++e) { const int pk = 2 * wave + e; krow_l[e] = 4 * pk + (lane >> 4); kch_l[e] = (lane & 15) ^ (krow_l[e] & 15);
        vrow_l[e] = 8 * pk + (lane >> 3); vch_l[e] = (lane & 7) ^ ((vrow_l[e] >> 1) & 7); }
    const int myx = (int)(xb_xcc_id() & 7u);
    int qoff = 0;
    for (;;) {
        if (tid == 0) { unsigned v = 0xffffffffu;
            while (qoff < 8) { const int qx = (myx + qoff) & 7; const unsigned n = atomicAdd(ctr + 64 * qx, 1u); if (n < 128u) { v = (unsigned)((qx + 8 * (n >> 5)) * 32 + (n & 31)); break; } ++qoff; }
            *(LAS unsigned*)(lds + A_ITEM) = v; }
        __syncthreads();
        const unsigned itu = *(LAS unsigned*)(lds + A_ITEM);
        if (itu == 0xffffffffu) break;
        const int it = (int)itu;
        const int r = it & 31, h = (it >> 5) & 7, b = it >> 8;
        const int rs = min(max(r - 4, 0), 24), ks0 = min(max(16 * qb - 8, 0), 32);
        const int cq = 16 * qb + li, cs = min(max(cq - 8, 0), 48);
        const size_t qrow = (size_t)b * SEQ + r * GRID_W + cq;
        if (tid < 15 * 31) btab[tid] = p.rel_bias[h * 465 + tid];
        bf16x8 qf[4];
#pragma unroll
        for (int ks = 0; ks < 4; ++ks) qf[ks] = *(const bf16x8*)(QN + qrow * WA + h * HD + 32 * ks + 8 * g);
        asm volatile("s_waitcnt vmcnt(0)" ::: "memory");
        const bf16* kg0 = KN + (size_t)h * HD + (size_t)krow_l[0] * WA + 8 * kch_l[0]; const bf16* kg1 = KN + (size_t)h * HD + (size_t)krow_l[1] * WA + 8 * kch_l[1];
        const bf16* vg0 = VT + ((size_t)(b * NHEAD + h) * HD + vrow_l[0]) * VT_PITCH + 8 * vch_l[0]; const bf16* vg1 = VT + ((size_t)(b * NHEAD + h) * HD + vrow_l[1]) * VT_PITCH + 8 * vch_l[1];
#define ATT_DMA(ti_) do { const int t_ = (ti_) < 12 ? (ti_) : 11; LAS unsigned char* bb_ = lds + ((ti_) & 3) * A_TILE + wave * 2048; \
            const size_t krow0 = (t_ < 8) ? ((size_t)b * SEQ + (rs + t_) * GRID_W) : ((size_t)ML + b * CTX + 64 * (t_ - 8)); \
            const int tok0 = (t_ < 8) ? ((rs + t_) * GRID_W) : (SEQ + 64 * (t_ - 8)); \
            __builtin_amdgcn_global_load_lds((const unsigned*)(kg0 + krow0 * WA), (LAS unsigned*)(bb_ + A_KOFF), 16, 0, 0); \
            __builtin_amdgcn_global_load_lds((const unsigned*)(kg1 + krow0 * WA), (LAS unsigned*)(bb_ + A_KOFF + 1024), 16, 0, 0); \
            __builtin_amdgcn_global_load_lds((const unsigned*)(vg0 + tok0), (LAS unsigned*)(bb_ + A_VOFF), 16, 0, 0); \
            __builtin_amdgcn_global_load_lds((const unsigned*)(vg1 + tok0), (LAS unsigned*)(bb_ + A_VOFF + 1024), 16, 0, 0); } while (0)
        ATT_DMA(0); ATT_DMA(1); ATT_DMA(2);
        f32x4 ot[4];
#pragma unroll
        for (int db = 0; db < 4; ++db) ot[db] = (f32x4){0.f, 0.f, 0.f, 0.f};
        float mrun = -1e30f, l = 0.f;
        const int kx = (ks0 + li) & 15, vy = (li >> 1) & 7;
        int koff[4];
#pragma unroll
        for (int ks = 0; ks < 4; ++ks) koff[ks] = A_KOFF + (ks0 + li) * 256 + (((4 * ks + g) ^ kx) << 4);
        const int vrow_off = A_VOFF + (64 * dh + li) * 128 + 8 * (g & 1);
        const int gq = g >> 1;
#pragma unroll 1
        for (int ti = 0; ti < 12; ++ti) {
            asm volatile("s_waitcnt vmcnt(8)" ::: "memory");
            ATT_BAR();
            ATT_DMA(ti + 3);
            const LAS unsigned char* tb = lds + (ti & 3) * A_TILE;
            if (ti < 8) {
                f32x4 st[2];
#pragma unroll
                for (int kb = 0; kb < 2; ++kb) { f32x4 a = (f32x4){0.f, 0.f, 0.f, 0.f};
#pragma unroll
                    for (int ks = 0; ks < 4; ++ks) a = __builtin_amdgcn_mfma_f32_16x16x32_bf16(*(const LAS bf16x8*)(tb + koff[ks] + kb * 4096), qf[ks], a, 0, 0, 0);
                    st[kb] = a; }
                const int dr = rs + ti - r + 7; float gm = -1e30f;
#pragma unroll
                for (int kb = 0; kb < 2; ++kb)
#pragma unroll
                    for (int j = 0; j < 4; ++j) { const int kcol = ks0 + 16 * kb + 4 * g + j; const bool valid = (kcol >= cs) && (kcol < cs + 16);
                        const int bi = valid ? (dr * 31 + (kcol - cq + 15)) : 0;
                        const float sv = valid ? (st[kb][j] * scale + btab[bi]) : -1e30f; st[kb][j] = sv; gm = fmaxf(gm, sv); }
                gm = fmaxf(gm, __shfl_xor(gm, 16)); gm = fmaxf(gm, __shfl_xor(gm, 32));
                const float mnew = fmaxf(mrun, gm); const float alpha = __expf(mrun - mnew); mrun = mnew; l *= alpha;
#pragma unroll
                for (int db = 0; db < 4; ++db) ot[db] = ot[db] * alpha;
#pragma unroll
                for (int kb = 0; kb < 2; ++kb)
#pragma unroll
                    for (int j = 0; j < 4; ++j) { const float sv = st[kb][j]; const float e = (sv > -1e29f) ? __expf(sv - mnew) : 0.f; st[kb][j] = e; l += e; }
                const bf16x8 pb = pack_p(st[0], st[1]);
                const int c0 = (ks0 >> 3) + gq;
#pragma unroll
                for (int db = 0; db < 4; ++db) { const LAS unsigned char* vp = tb + vrow_off + db * 2048;
                    ot[db] = __builtin_amdgcn_mfma_f32_16x16x32_bf16(cat8u(*(const LAS u32x2*)(vp + ((c0 ^ vy) << 4)), *(const LAS u32x2*)(vp + (((c0 + 2) ^ vy) << 4))), pb, ot[db], 0, 0, 0); }
            } else {
                f32x4 st[4];
#pragma unroll
                for (int kb = 0; kb < 4; ++kb) { f32x4 a = (f32x4){0.f, 0.f, 0.f, 0.f};
#pragma unroll
                    for (int ks = 0; ks < 4; ++ks) a = __builtin_amdgcn_mfma_f32_16x16x32_bf16(*(const LAS bf16x8*)(tb + A_KOFF + (16 * kb + li) * 256 + (((4 * ks + g) ^ li) << 4)), qf[ks], a, 0, 0, 0);
                    st[kb] = a * scale; }
                float gm = -1e30f;
#pragma unroll
                for (int kb = 0; kb < 4; ++kb) gm = fmaxf(fmaxf(gm, fmaxf(st[kb][0], st[kb][1])), fmaxf(st[kb][2], st[kb][3]));
                gm = fmaxf(gm, __shfl_xor(gm, 16)); gm = fmaxf(gm, __shfl_xor(gm, 32));
                const float mnew = fmaxf(mrun, gm); const float alpha = __expf(mrun - mnew); mrun = mnew; l *= alpha;
#pragma unroll
                for (int db = 0; db < 4; ++db) ot[db] = ot[db] * alpha;
#pragma unroll
                for (int kb = 0; kb < 4; ++kb)
#pragma unroll
                    for (int j = 0; j < 4; ++j) { const float e = __expf(st[kb][j] - mnew); st[kb][j] = e; l += e; }
#pragma unroll
                for (int kp2 = 0; kp2 < 2; ++kp2) { const bf16x8 pb = pack_p(st[2 * kp2], st[2 * kp2 + 1]);
                    const int c0 = 4 * kp2 + gq;
#pragma unroll
                    for (int db = 0; db < 4; ++db) { const LAS unsigned char* vp = tb + vrow_off + db * 2048;
                        ot[db] = __builtin_amdgcn_mfma_f32_16x16x32_bf16(cat8u(*(const LAS u32x2*)(vp + ((c0 ^ vy) << 4)), *(const LAS u32x2*)(vp + (((c0 + 2) ^ vy) << 4))), pb, ot[db], 0, 0, 0); } }
            }
        }
        asm volatile("s_waitcnt vmcnt(0)" ::: "memory");
        l += __shfl_xor(l, 16); l += __shfl_xor(l, 32);
        const float inv = 1.0f / l;
#pragma unroll
        for (int db = 0; db < 4; ++db) { const f32x4 o = ot[db] * inv; u32x2 w; w.x = pk2(o.x, o.y); w.y = pk2(o.z, o.w);
            *(u32x2*)(YB + qrow * WA + h * HD + 64 * dh + 16 * db + 4 * g) = w; }
#undef ATT_DMA
    }
}

constexpr int HP = 160;
constexpr int H_QH = 0, H_KH = 20480, H_KE = 40960, H_QD = 61440, H_KD = 81920;
constexpr int HP2 = 48;
constexpr int H_Q2 = 102400, H_K2 = 108544;
constexpr int PP = 144;
constexpr int H_P = 114688;
constexpr int H_T = 123904;
constexpr int H_D = 125952;
constexpr int HIMG_QD = 0, HIMG_KD = 16384, HIMG_P = 32768, HIMG_D = 40960, HIMG_BYTES = 41472;
constexpr int NCH = (CTX + SEQ) / 64;
constexpr int VP = 288;
constexpr int SB_QD = 0, SB_KD = 20480, SB_P = 40960, SB_D = 50176, SB_V = 50688, SB_BYTES = 69120;
static_assert(2 * SB_BYTES <= 145408, "scan buffers");

__device__ __forceinline__ s16x4 lds_tr(LAS const unsigned char* p) {
    return __builtin_bit_cast(s16x4, __builtin_amdgcn_ds_read_tr16_b64_v4i16((LAS s16x4*)p));
}
__device__ __forceinline__ bf16x8 cat8(const s16x4 a, const s16x4 b) { return __builtin_shufflevector(a, b, 0, 1, 2, 3, 4, 5, 6, 7); }

__device__ __forceinline__ size_t hg_row(int dir, int b, int tau) {
    if (tau < CTX) return (size_t)ML + b * CTX + (dir == 0 ? tau : CTX - 1 - tau);
    const int t = tau - CTX; return (size_t)b * SEQ + (dir == 0 ? t : SEQ - 1 - t);
}

__device__ __forceinline__ void hgrn_prep(const Params& p, LAS unsigned char* lds, int vb, int nb) {
    int tid_o = tid_of(p.wave_id);
    const int tid = tid_o, lane = tid & 63, wave = __builtin_amdgcn_readfirstlane(tid >> 6);
    const int k = tid & 127, J = __builtin_amdgcn_readfirstlane(tid >> 7);
    const int li = lane & 15, g = lane >> 4, qq = li >> 2, pp = li & 3;
    LAS float* Tl = (LAS float*)(lds + H_T); LAS float* Dl = (LAS float*)(lds + H_D);
    float lf[16]; unsigned qv[16];
#define HG_LOADP(idx_) do { const int id_ = (idx_); const int ch_ = id_ / NCH, cc_ = id_ % NCH; const int dir_ = ch_ / (BATCH * NHEAD), b_ = (ch_ / NHEAD) % BATCH, h_ = ch_ % NHEAD; \
        const size_t row0_ = hg_row(dir_, b_, 64 * cc_ + 16 * J); const long st_ = dir_ ? -(long)WA : (long)WA; \
        const float* lfp_ = (const float*)(p.ws + (dir_ == 0 ? WS_FW : WS_FB)) + row0_ * WA + h_ * HD + k; const bf16* qp_ = (const bf16*)(p.ws + WS_QA) + row0_ * WA + h_ * HD + k; \
        _Pragma("unroll") for (int i = 0; i < 16; ++i) { lf[i] = lfp_[(long)i * st_]; qv[i] = (cc_ >= 4) ? (unsigned)qp_[(long)i * st_] : 0u; } } while (0)
    if (vb < 64 * NCH) HG_LOADP(vb);
    for (int idx = vb; idx < 64 * NCH; idx += nb) {
        const int c = idx % NCH;
        float cum[16]; float run = 0.f;
#pragma unroll
        for (int i = 0; i < 16; ++i) { run += lf[i]; cum[i] = run; }
        Tl[J * 128 + k] = run;
        ATT_BAR();
        const float T0 = Tl[k], T1 = Tl[128 + k], T2 = Tl[256 + k], T3 = Tl[384 + k];
        const float bJ = (J > 0 ? T0 : 0.f) + (J > 1 ? T1 : 0.f) + (J > 2 ? T2 : 0.f);
        const float tail = (J < 1 ? T1 : 0.f) + (J < 2 ? T2 : 0.f) + (J < 3 ? T3 : 0.f);
        const float eb = __expf(bJ), et = __expf(tail), eT = __expf(run);
        const float x2 = (J == 3) ? __expf(T2) : __expf(T1);
        float qh[16], kh[16];
#pragma unroll
        for (int i = 0; i < 16; ++i) { const float e1 = __expf(cum[i]); const float r1 = __builtin_amdgcn_rcpf(e1); const float kk = 1.0f - __expf(lf[i]);
            qh[i] = __builtin_bit_cast(float, qv[i] << 16) * e1; kh[i] = kk * r1; }
        {
            LAS unsigned char* rowp = lds + k * HP + 32 * J;
            u32x4 w0, w1;
#define HG_WRITE(OFF, EXPR) do { \
            { float v0_, v1_; \
              { const int i = 0; v0_ = (EXPR); } { const int i = 1; v1_ = (EXPR); } w0.x = pk2(v0_, v1_); \
              { const int i = 2; v0_ = (EXPR); } { const int i = 3; v1_ = (EXPR); } w0.y = pk2(v0_, v1_); \
              { const int i = 4; v0_ = (EXPR); } { const int i = 5; v1_ = (EXPR); } w0.z = pk2(v0_, v1_); \
              { const int i = 6; v0_ = (EXPR); } { const int i = 7; v1_ = (EXPR); } w0.w = pk2(v0_, v1_); \
              { const int i = 8; v0_ = (EXPR); } { const int i = 9; v1_ = (EXPR); } w1.x = pk2(v0_, v1_); \
              { const int i = 10; v0_ = (EXPR); } { const int i = 11; v1_ = (EXPR); } w1.y = pk2(v0_, v1_); \
              { const int i = 12; v0_ = (EXPR); } { const int i = 13; v1_ = (EXPR); } w1.z = pk2(v0_, v1_); \
              { const int i = 14; v0_ = (EXPR); } { const int i = 15; v1_ = (EXPR); } w1.w = pk2(v0_, v1_); } \
            *(LAS u32x4*)(OFF) = w0; *(LAS u32x4*)((OFF) + 16) = w1; } while (0)
            HG_WRITE(rowp + H_QH, qh[i]);
            HG_WRITE(rowp + H_KH, kh[i]);
            HG_WRITE(rowp + H_KE, kh[i] * eT);
            HG_WRITE(rowp + H_QD, qh[i] * eb);
            HG_WRITE(rowp + H_KD, kh[i] * (eT * et));
            if (J == 3) { HG_WRITE(lds + H_Q2 + k * HP2, qh[i] * x2); }
            if (J == 0) { HG_WRITE(lds + H_K2 + k * HP2, kh[i] * (eT * x2)); }
#undef HG_WRITE
            if (J == 3) Dl[k] = __expf(bJ + run);
        }
        if (idx + nb < 64 * NCH) HG_LOADP(idx + nb);
        ATT_BAR();
        const bool lat = (c >= 4);
        if (lat) {
#pragma unroll
            for (int rep = 0; rep < 2; ++rep) {
                int I, Jb;
                if (rep == 0) { I = (wave < 4) ? wave : (wave == 4 ? 1 : (wave == 7 ? 3 : 2)); Jb = (wave < 4) ? wave : (wave == 4 ? 0 : (wave == 5 ? 0 : (wave == 6 ? 1 : 2))); }
                else { if (wave >= 2) break; I = 3; Jb = wave; }
                int aoff, apitch, acol, boff, bpitch, bcol;
                if (I == Jb) { aoff = H_KH; apitch = HP; acol = 16 * Jb; boff = H_QH; bpitch = HP; bcol = 16 * I; }
                else if (I == Jb + 1 && I != 2) { aoff = H_KE; apitch = HP; acol = 16 * Jb; boff = H_QH; bpitch = HP; bcol = 16 * I; }
                else if (I == 2) { if (Jb == 0) { aoff = H_K2; apitch = HP2; acol = 0; } else { aoff = H_KE; apitch = HP; acol = 16; } boff = H_QH; bpitch = HP; bcol = 32; }
                else { if (Jb == 0) { aoff = H_K2; apitch = HP2; acol = 0; } else { aoff = H_KE; apitch = HP; acol = 16; } boff = H_Q2; bpitch = HP2; bcol = 0; }
                f32x4 pt = (f32x4){0.f, 0.f, 0.f, 0.f};
#pragma unroll
                for (int ks = 0; ks < 4; ++ks) {
                    const int r0 = 32 * ks + 4 * g + qq;
                    const bf16x8 a = cat8(lds_tr(lds + aoff + r0 * apitch + (acol + 4 * pp) * 2), lds_tr(lds + aoff + (r0 + 16) * apitch + (acol + 4 * pp) * 2));
                    const bf16x8 bb = cat8(lds_tr(lds + boff + r0 * bpitch + (bcol + 4 * pp) * 2), lds_tr(lds + boff + (r0 + 16) * bpitch + (bcol + 4 * pp) * 2));
                    pt = __builtin_amdgcn_mfma_f32_16x16x32_bf16(a, bb, pt, 0, 0, 0);
                }
                if (I == Jb) {
#pragma unroll
                    for (int j = 0; j < 4; ++j) if (4 * g + j > li) pt[j] = 0.f;
                }
                u32x2 w; w.x = pk2(pt.x, pt.y); w.y = pk2(pt.z, pt.w);
                *(LAS u32x2*)(lds + H_P + (16 * I + li) * PP + (16 * Jb + 4 * g) * 2) = w;
            }
        }
        ATT_BAR();
        unsigned char* img = p.ws + WS_HIMG + (size_t)idx * HIMG_BYTES;
#pragma unroll
        for (int e = 0; e < 2; ++e) { const int id = tid + 512 * e; const int kr = id >> 3, part = id & 7;
            if (lat) *(u32x4*)(img + HIMG_QD + id * 16) = *(const LAS u32x4*)(lds + H_QD + kr * HP + 16 * part);
            *(u32x4*)(img + HIMG_KD + id * 16) = *(const LAS u32x4*)(lds + H_KD + kr * HP + 16 * part); }
        if (lat) *(u32x4*)(img + HIMG_P + tid * 16) = *(const LAS u32x4*)(lds + H_P + (tid >> 3) * PP + 16 * (tid & 7));
        if (tid < 32) *(u32x4*)(img + HIMG_D + tid * 16) = *(const LAS u32x4*)(lds + H_D + 16 * tid);
    }
#undef HG_LOADP
    __syncthreads();
}

__device__ __forceinline__ void hgrn_scan(const Params& p, LAS unsigned char* lds, int chain) {
    int tid_o = tid_of(p.wave_id);
    const int tid = tid_o, lane = tid & 63, wave = __builtin_amdgcn_readfirstlane(tid >> 6);
    const int li = lane & 15, g = lane >> 4, qq = li >> 2, pp = li & 3;
    const int dir = chain / (BATCH * NHEAD), b = (chain / NHEAD) % BATCH, h = chain % NHEAD;
    const bf16* IA = (const bf16*)(p.ws + WS_IA) + h * HD;
    bf16* O = ((bf16*)p.out + (dir == 0 ? 0 : (size_t)ML * WA)) + h * HD + 16 * wave + li;
    const long ost = dir ? -(long)WA : (long)WA;
    const unsigned char* img0 = p.ws + WS_HIMG + (size_t)chain * NCH * HIMG_BYTES;
    f32x4 S[8];
#pragma unroll
    for (int i = 0; i < 8; ++i) S[i] = (f32x4){0.f, 0.f, 0.f, 0.f};
    u32x4 rq[2][2], rk[2][2], rp[2], rd[2], rv[2][2];
#define HS_LOAD(c_, set_) do { const int cc_ = (c_); const unsigned char* im_ = img0 + (size_t)cc_ * HIMG_BYTES; \
        if (cc_ >= 4) { rq[set_][0] = *(const u32x4*)(im_ + HIMG_QD + tid * 16); rq[set_][1] = *(const u32x4*)(im_ + HIMG_QD + (tid + 512) * 16); rp[set_] = *(const u32x4*)(im_ + HIMG_P + tid * 16); } \
        rk[set_][0] = *(const u32x4*)(im_ + HIMG_KD + tid * 16); rk[set_][1] = *(const u32x4*)(im_ + HIMG_KD + (tid + 512) * 16); \
        if (tid < 32) rd[set_] = *(const u32x4*)(im_ + HIMG_D + tid * 16); \
        _Pragma("unroll") for (int e = 0; e < 2; ++e) { const int idx_ = tid * 2 + e; const size_t row_ = hg_row(dir, b, 64 * cc_ + (idx_ >> 4)); rv[set_][e] = *(const u32x4*)(IA + row_ * WA + 8 * (idx_ & 15)); } } while (0)
#define HS_STORE(c_, set_) do { const int cc_ = (c_); LAS unsigned char* bb_ = lds + (cc_ & 1) * SB_BYTES; \
        if (cc_ >= 4) { *(LAS u32x4*)(bb_ + SB_QD + (tid >> 3) * HP + 16 * (tid & 7)) = rq[set_][0]; *(LAS u32x4*)(bb_ + SB_QD + ((tid >> 3) + 64) * HP + 16 * (tid & 7)) = rq[set_][1]; \
                        *(LAS u32x4*)(bb_ + SB_P + (tid >> 3) * PP + 16 * (tid & 7)) = rp[set_]; } \
        *(LAS u32x4*)(bb_ + SB_KD + (tid >> 3) * HP + 16 * (tid & 7)) = rk[set_][0]; *(LAS u32x4*)(bb_ + SB_KD + ((tid >> 3) + 64) * HP + 16 * (tid & 7)) = rk[set_][1]; \
        if (tid < 32) *(LAS u32x4*)(bb_ + SB_D + 16 * tid) = rd[set_]; \
        _Pragma("unroll") for (int e = 0; e < 2; ++e) { const int idx_ = tid * 2 + e; *(LAS u32x4*)(bb_ + SB_V + (idx_ >> 4) * VP + 16 * (idx_ & 15)) = rv[set_][e]; } } while (0)
    HS_LOAD(0, 0); HS_LOAD(1, 1);
    HS_STORE(0, 0);
    HS_LOAD(2, 0);
    ATT_BAR();
#pragma unroll 1
    for (int c2 = 0; c2 < NCH; c2 += 2) {
#pragma unroll
    for (int uu = 0; uu < 2; ++uu) { const int c = c2 + uu;
        const LAS unsigned char* bb = lds + (c & 1) * SB_BYTES;
        const bool lat = (c >= 4);
        bf16x8 vf[2];
#pragma unroll
        for (int sp = 0; sp < 2; ++sp) {
            const LAS unsigned char* vb0 = bb + SB_V + (32 * sp + 4 * g + qq) * VP + (16 * wave + 4 * pp) * 2;
            vf[sp] = cat8(lds_tr(vb0), lds_tr(vb0 + 16 * VP));
        }
        if (lat) {
            bf16x8 sb[4];
#pragma unroll
            for (int ks = 0; ks < 4; ++ks) sb[ks] = pack_p(S[2 * ks], S[2 * ks + 1]);
            bf16* orow = O + (long)hg_row(dir, b, 64 * c) * WA;
#pragma unroll
            for (int I = 0; I < 4; ++I) {
                f32x4 o = (f32x4){0.f, 0.f, 0.f, 0.f};
#pragma unroll
                for (int ks = 0; ks < 4; ++ks) {
                    const LAS unsigned char* ap = bb + SB_QD + (32 * ks + 4 * g + qq) * HP + (16 * I + 4 * pp) * 2;
                    o = __builtin_amdgcn_mfma_f32_16x16x32_bf16(cat8(lds_tr(ap), lds_tr(ap + 16 * HP)), sb[ks], o, 0, 0, 0);
                }
#pragma unroll
                for (int sp = 0; sp < 2; ++sp) {
                    if (2 * sp > I) break;
                    const LAS unsigned char* pr = bb + SB_P + (16 * I + li) * PP + (32 * sp + 4 * g) * 2;
                    const u32x2 lo = *(const LAS u32x2*)pr; u32x2 hi = (u32x2){0u, 0u};
                    if (2 * sp + 1 <= I) hi = *(const LAS u32x2*)(pr + 32);
                    o = __builtin_amdgcn_mfma_f32_16x16x32_bf16(cat8u(lo, hi), vf[sp], o, 0, 0, 0);
                }
#pragma unroll
                for (int j = 0; j < 4; ++j) orow[(long)(16 * I + 4 * g + j) * ost] = (bf16)f2bf(o[j]);
            }
        }
#pragma unroll
        for (int blk = 0; blk < 8; ++blk) {
            const f32x4 d4 = *(const LAS f32x4*)(bb + SB_D + (16 * blk + 4 * g) * 4);
            f32x4 s = S[blk] * d4;
#pragma unroll
            for (int sp = 0; sp < 2; ++sp) {
                const LAS unsigned char* kp = bb + SB_KD + (16 * blk + li) * HP + (32 * sp + 4 * g) * 2;
                s = __builtin_amdgcn_mfma_f32_16x16x32_bf16(cat8u(*(const LAS u32x2*)kp, *(const LAS u32x2*)(kp + 32)), vf[sp], s, 0, 0, 0);
            }
            S[blk] = s;
        }
        if (c + 1 < NCH) HS_STORE(c + 1, (uu + 1) & 1);
        if (c + 3 < NCH) HS_LOAD(c + 3, (uu + 1) & 1);
        ATT_BAR();
    } }
#undef HS_LOAD
#undef HS_STORE
    __syncthreads();
}

__device__ __forceinline__ void phase_readout(const Params& p, int vb, int nb) {
    const int tid = tid_of(p.wave_id), lane = tid & 63, wave = p.wave_id;
    const bf16* OF = (const bf16*)p.out; const bf16* OB = OF + (size_t)ML * WA; const bf16* GA = (const bf16*)(p.ws + WS_GA);
    bf16* YA = (bf16*)p.out + (size_t)2 * ML * WA;
    for (int it = vb * 8 + wave; it < ML * NHEAD; it += nb * 8) {
        const int row = it / NHEAD, h = it % NHEAD; const size_t off = (size_t)row * WA + h * HD + 2 * lane;
        const unsigned a = *(const unsigned*)(OF + off), b = *(const unsigned*)(OB + off), g = *(const unsigned*)(GA + off);
        const float o0 = bflo(a) + bflo(b), o1 = bfhi(a) + bfhi(b);
        const float rstd = 1.0f / sqrtf(wave_sum(o0 * o0 + o1 * o1) * (1.0f / HD) + EPS);
        const float y0 = o0 * rstd * p.hgrn_norm_g[2 * lane] * bflo(g), y1 = o1 * rstd * p.hgrn_norm_g[2 * lane + 1] * bfhi(g);
        *(unsigned*)(YA + off) = pk2(y0, y1);
    }
}

__device__ __forceinline__ void phase_bias2(const Params& p, int vb, int nb) {
    const int tid = tid_of(p.wave_id); const float* mod = (const float*)(p.ws + WS_MOD); float* bias2 = (float*)(p.ws + WS_BIAS2);
    constexpr int NCC = 2 * FFN / 512, NKC = D_MODEL / 64;
    for (int item = vb; item < NCC * NKC; item += nb) {
        const int cc = item % NCC, kc = item / NCC; const int col = cc * 512 + tid;
        const float* W = (col < FFN) ? p.w1 + col : p.w3 + (col - FFN);
        float a0 = 0.f, a1 = 0.f, a2 = 0.f, a3 = 0.f;
#pragma unroll 8
        for (int k = kc * 64; k < kc * 64 + 64; ++k) { const float w = W[(size_t)k * FFN];
            a0 += w * mod[0 * IN_COLS + 3 * D_MODEL + k]; a1 += w * mod[1 * IN_COLS + 3 * D_MODEL + k]; a2 += w * mod[2 * IN_COLS + 3 * D_MODEL + k]; a3 += w * mod[3 * IN_COLS + 3 * D_MODEL + k]; }
        atomicAdd(bias2 + 0 * 2 * FFN + col, a0); atomicAdd(bias2 + 1 * 2 * FFN + col, a1); atomicAdd(bias2 + 2 * 2 * FFN + col, a2); atomicAdd(bias2 + 3 * 2 * FFN + col, a3);
    }
}

constexpr int LDS_MISC_OFF = 145408;
constexpr int LDS_BYTES = 146432;
static_assert(WS_BAR + XCD_BAR_WORDS * 4 <= WS_ROWSQ, "barrier words inside ctl");

#if defined(__HIP_DEVICE_COMPILE__)
#define LOAD_P() Params p; { const __attribute__((address_space(4))) Params* q_ = (const __attribute__((address_space(4))) Params*)__builtin_amdgcn_kernarg_segment_ptr(); asm volatile("" : "+s"(q_)); \
    p = *q_; p.wave_id = wave_id; } unsigned char* ws = p.ws; (void)ws
#else
#define LOAD_P() Params p = p_in; p.wave_id = wave_id; unsigned char* ws = p.ws; (void)ws
#endif
__global__ void __launch_bounds__(NTHREADS, 2) mega_fwd(Params p_in) {
    const int wave_id = __builtin_amdgcn_readfirstlane((int)(threadIdx.x >> 6));
    extern __shared__ __attribute__((aligned(16))) unsigned char lds_raw[];
    LAS unsigned char* lds = (LAS unsigned char*)lds_raw;
    const int nb = gridDim.x;
    const int vb = (nb % 8 == 0) ? ((int)(blockIdx.x % 8) * (nb / 8) + (int)(blockIdx.x / 8)) : (int)blockIdx.x;
    const int bx = blockIdx.x;
    volatile LAS unsigned* misc = (volatile LAS unsigned*)(lds + LDS_MISC_OFF);
    if (wave_id == 0) misc[lane_id()] = 0u;
    __syncthreads();
    XcdBarrier bar = xcd_barrier_post((unsigned*)(p_in.ws + WS_BAR), misc + 8, wave_id);
#define GRID_BAR() xcd_barrier(bar)

    { LOAD_P(); phase_mod(p, lds, vb, nb); __syncthreads(); phase_wconv_in(p, lds, vb * 8 + wave_id, nb * 8); }
    GRID_BAR();
    { LOAD_P(); phase_h(p, vb, nb); }
    GRID_BAR();
    { LOAD_P(); pg8::Gemm g{(const bf16*)(ws + WS_H), (const bf16*)(ws + WS_WINT), MT, IN_COLS, D_MODEL}; pg8::StaticOrder S; S.init(MT, IN_COLS, nb, bx);
      EpiInProj E{ws, lds, p.q_norm_g, p.k_norm_g}; pg8::gemm_phase<EpiInProj, pg8::StaticOrder, true, true>(lds, g, S, E, wave_id); }
    GRID_BAR();
    { LOAD_P(); hgrn_prep(p, lds, vb, nb); }
    GRID_BAR();
    { LOAD_P();
      if (bx < 2 * BATCH * NHEAD) hgrn_scan(p, lds, bx);
      __syncthreads();
      phase_attn(p, lds);
      if (bx >= 2 * BATCH * NHEAD) phase_wconv_rest(p, lds, (bx - 2 * BATCH * NHEAD) * 8 + wave_id, (nb - 2 * BATCH * NHEAD) * 8); }
    GRID_BAR();
    { LOAD_P(); phase_readout(p, vb, nb); }
    GRID_BAR();
    { LOAD_P(); pg8::Gemm g{(const bf16*)p.out + (size_t)2 * ML * WA, (const bf16*)(ws + WS_WAT), ML, D_MODEL, WA}; pg8::StaticOrder S; S.init(ML, D_MODEL, nb, bx);
      EpiMergeA E{ws, (float*)(ws + WS_T1)}; pg8::gemm_phase<EpiMergeA, pg8::StaticOrder, true, true>(lds, g, S, E, wave_id); }
    GRID_BAR();
    { LOAD_P(); pg8::Gemm g{(const bf16*)p.out + (size_t)3 * ML * WA, (const bf16*)(ws + WS_WBT), ML, D_MODEL, WA}; pg8::StaticOrder S; S.init(ML, D_MODEL, nb, bx);
      EpiMergeB E{ws, (const float*)(ws + WS_T1)}; pg8::gemm_phase<EpiMergeB, pg8::StaticOrder, true, true>(lds, g, S, E, wave_id); }
    GRID_BAR();
    { LOAD_P(); pg8::Gemm g{(const bf16*)(ws + WS_Z), (const bf16*)(ws + WS_WOT), ML, D_MODEL, D_MODEL}; pg8::StaticOrder S; S.init(ML, D_MODEL, nb, bx);
      EpiOutProj E{ws, p.x, p.norm2_g, p.out}; pg8::gemm_phase<EpiOutProj, pg8::StaticOrder, true, true>(lds, g, S, E, wave_id); }
    GRID_BAR();
    { LOAD_P(); pg8::Gemm g{(const bf16*)(ws + WS_XMG), (const bf16*)(ws + WS_W13T), ML, 2 * FFN, D_MODEL}; pg8::StaticOrder S; S.init(ML, 2 * FFN, nb, bx);
      EpiFfnUp E{ws, lds, p.conv_w, p.conv_b}; pg8::gemm_phase<EpiFfnUp, pg8::StaticOrder, true, true>(lds, g, S, E, wave_id); }
    GRID_BAR();
    { LOAD_P(); { pg8::StaticOrder S0; S0.init(ML, D_MODEL, nb, bx); pg8::Unit u0; const int tid = tid_of(wave_id); for (int i = 0; S0.next(i, u0); ++i) halo_fix(p, u0.pm, tid); }
      asm volatile("s_waitcnt vmcnt(0)" ::: "memory"); __syncthreads();
      pg8::Gemm g{(const bf16*)(ws + WS_ACT), (const bf16*)(ws + WS_W2T), ML, D_MODEL, FFN}; pg8::StaticOrder S; S.init(ML, D_MODEL, nb, bx);
      EpiFfnDown E{ws, p.out}; pg8::gemm_phase<EpiFfnDown, pg8::StaticOrder, true, true>(lds, g, S, E, wave_id); }
#undef GRID_BAR
}

extern "C" void kernel_launch(void* const* d_in, const int* in_sizes, int n_in, void* d_out, int out_size, void* d_ws, size_t ws_size, hipStream_t stream) {
    static int grid = 0;
    if (grid == 0) {
        if (n_in != 22 || ws_size < WS_END || out_size != ML * D_MODEL) { fprintf(stderr, "kernel_launch: bad inputs (n_in %d, out %d, ws %zu, need %zu)\n", n_in, out_size, ws_size, (size_t)WS_END); grid = -1; return; }
        int dev = 0, cus = 0, per_cu = 0;
        if (hipGetDevice(&dev) != hipSuccess || hipDeviceGetAttribute(&cus, hipDeviceAttributeMultiprocessorCount, dev) != hipSuccess) { grid = -1; return; }
        if (hipFuncSetAttribute((const void*)mega_fwd, hipFuncAttributeMaxDynamicSharedMemorySize, LDS_BYTES) != hipSuccess) { fprintf(stderr, "kernel_launch: hipFuncSetAttribute failed\n"); grid = -1; return; }
        if (hipOccupancyMaxActiveBlocksPerMultiprocessor(&per_cu, (const void*)mega_fwd, NTHREADS, LDS_BYTES) != hipSuccess || per_cu < 1) { fprintf(stderr, "kernel_launch: occupancy query says %d blocks/CU\n", per_cu); (void)hipGetLastError(); grid = -1; return; }
        grid = cus;
        fprintf(stderr, "kernel_launch: grid %d (cus %d, occupancy %d/CU)\n", grid, cus, per_cu);
    }
    if (grid < 0) return;
    Params p{};
    const float** f = (const float**)&p;
    for (int i = 0; i < 22; ++i) f[i] = (const float*)d_in[i];
    p.out = (float*)d_out; p.ws = (unsigned char*)d_ws;
    (void)hipMemsetAsync((char*)d_ws + WS_CTL, 0, CTL_ZERO_BYTES, stream);
    hipLaunchKernelGGL(mega_fwd, dim3(grid), dim3(NTHREADS), LDS_BYTES, stream, p);
}
```

```cpp
#include <hip/hip_runtime.h>
#include <cstdio>
#include <cstdint>
#include <cmath>

__device__ __forceinline__ int lane_id() { int l; asm volatile("v_mbcnt_lo_u32_b32 %0, -1, 0\n\tv_mbcnt_hi_u32_b32 %0, -1, %0" : "=v"(l)); return l; }
__device__ __forceinline__ int tid_of(int wave_id) { int t = wave_id * 64 + lane_id(); asm volatile("" : "+v"(t)); return t; }
namespace pg8 {
#define PG8_LAS __attribute__((address_space(3)))
typedef unsigned short bf16_t;
typedef short bf16x8 __attribute__((ext_vector_type(8)));
typedef float f32x4 __attribute__((ext_vector_type(4)));
typedef unsigned u32x4 __attribute__((ext_vector_type(4)));
constexpr int BM = 256, BK = 64, HALF = 128, HTB = HALF * BK * 2  , STAGE_BYTES = 8 * HTB, NXCD = 8, WGM = 8;

__host__ __device__ __forceinline__ int lds_byte(int r, int c) { const int st = (r >> 4) * 2 + (c >> 5), rr = r & 15, cc = c & 31, ob = rr * 64 + cc * 2; return st * 1024 + (ob ^ (((ob >> 9) & 1) << 5)); }
__host__ __device__ __forceinline__ void stage_rc(int b, int& R, int& C) { const int st = b / 1024, sb = b % 1024, swz = sb ^ (((sb >> 9) & 1) << 5); R = (st >> 1) * 16 + swz / 64; C = (st & 1) * 32 + (swz % 64) / 2; }
__host__ __device__ __forceinline__ int perm32(int rho) { const int n = rho >> 4, i = rho & 15; return 8 * (i >> 2) + 4 * n + (i & 3); }

struct Unit { int pm, pn, br; };
struct Gemm { const bf16_t* A; const bf16_t* Bt; int M, N, K; };

struct StaticOrder {
    int nM, nN, nwg, G, c;
    __host__ __device__ void init(int M, int N, int G_, int c_) { nM = M / BM; nN = N / BM; nwg = nM * nN; G = G_; c = c_; }
    __host__ __device__ bool next(int i, Unit& u) const {
        const long L = (long)i * G + c; if (L >= nwg) return false;
        int wgid = (int)L; { const int q = nwg / NXCD, r = nwg % NXCD, xcd = wgid % NXCD, off = wgid / NXCD; wgid = (xcd < r ? xcd * (q + 1) : r * (q + 1) + (xcd - r) * q) + off; }
        const int nig = WGM * nN, gid = wgid / nig, fm = gid * WGM, gsz = (nM - fm) < WGM ? (nM - fm) : WGM;
        u.pm = fm + ((wgid % nig) % gsz); u.pn = (wgid % nig) / gsz; u.br = 0; return true;
    }
    __device__ __forceinline__ const char* a_base(const Gemm& g, const Unit& u, size_t tstep) const { return (const char*)g.A + (size_t)u.pm * tstep; }
    __device__ __forceinline__ const char* b_base(const Gemm& g, const Unit& u, size_t tstep) const { return (const char*)g.Bt + (size_t)u.pn * tstep; }
    __device__ __forceinline__ void a_ready(const Unit&) const {}
    __device__ __forceinline__ void done(const Unit&) const {}
};

template <class Epi, class Sched, bool ALIGN_EPI = false, bool SP2 = false>
__device__ __forceinline__ void gemm_phase(PG8_LAS unsigned char* lds, const Gemm g, const Sched& S, const Epi& E, const int wave_id_in) {
    int tid_o = tid_of(wave_id_in);
    const int tid = tid_o, wid = __builtin_amdgcn_readfirstlane(tid >> 6), lane = tid & 63, wr = wid >> 2, wc = wid & 3, fr = lane & 15, fq = lane >> 4;
    const int K = g.K, nt = K / BK;
    unsigned voffA[2], voffB[2];
#pragma unroll
    for (int i = 0; i < 2; ++i) { int R, C; stage_rc(tid * 16 + i * 8192, R, C); const int Rb = Epi::PERM ? ((R & ~31) + perm32(R & 31)) : R;
        voffA[i] = (unsigned)(R * K + C) * 2u; voffB[i] = (unsigned)(Rb * K + C) * 2u; }
    const size_t kstep = (size_t)(BK * 2);
    const size_t hstep = (size_t)HALF * K * 2;
    const size_t tstep = 2 * hstep;
    const unsigned ldsw = (unsigned)wid * 1024u;
    const int aoff = lds_byte(wr * 64 + fr, fq * 8), boff = lds_byte(wc * 32 + fr, fq * 8);
#define PG8_SA(b, h) (((b) * 2 + (h)) * HTB)
#define PG8_SB(b, h) ((4 + (b) * 2 + (h)) * HTB)
#define PG8_STAGE(bufoff, gbase, voff) do { _Pragma("unroll") for (int _i = 0; _i < 2; ++_i) \
        __builtin_amdgcn_global_load_lds((const unsigned*)((const char*)(gbase) + (voff)[_i]), (PG8_LAS unsigned*)(lds + (bufoff) + ldsw + _i * 8192), 16, 0, 0); } while (0)
#define PG8_LDA(dst, b, h) do { _Pragma("unroll") for (int m = 0; m < 4; ++m) _Pragma("unroll") for (int k = 0; k < 2; ++k) dst[m][k] = *(const PG8_LAS bf16x8*)(lds + PG8_SA(b, h) + aoff + m * 2048 + k * 1024); } while (0)
#define PG8_LDB(dst, b, h) do { _Pragma("unroll") for (int n = 0; n < 2; ++n) _Pragma("unroll") for (int k = 0; k < 2; ++k) dst[n][k] = *(const PG8_LAS bf16x8*)(lds + PG8_SB(b, h) + boff + n * 2048 + k * 1024); } while (0)
#define PG8_MMA(ai, bj, At, Bt) do { __builtin_amdgcn_s_setprio(1); _Pragma("unroll") for (int m = 0; m < 4; ++m) _Pragma("unroll") for (int n = 0; n < 2; ++n) _Pragma("unroll") for (int k = 0; k < 2; ++k) \
        acc[ai][bj][m][n] = __builtin_amdgcn_mfma_f32_16x16x32_bf16(Bt[n][k], At[m][k], acc[ai][bj][m][n], 0, 0, 0); __builtin_amdgcn_s_setprio(0); } while (0)
#define PG8_WAIT_V(n) asm volatile("s_waitcnt vmcnt(" #n ")" ::: "memory")
#define PG8_WAIT_L(n) asm volatile("s_waitcnt lgkmcnt(" #n ")" ::: "memory")
#define PG8_BAR __builtin_amdgcn_s_barrier()
#define PG8_SCHED __builtin_amdgcn_sched_barrier(0)
    Unit cur, nxt; int ui = 0;
    if (!S.next(0, cur)) return;
    f32x4 acc[2][2][4][2];
#pragma unroll
    for (int a = 0; a < 2; ++a)
#pragma unroll
        for (int b = 0; b < 2; ++b)
#pragma unroll
            for (int m = 0; m < 4; ++m)
#pragma unroll
                for (int n = 0; n < 2; ++n) acc[a][b][m][n] = (f32x4){0.f, 0.f, 0.f, 0.f};
    bf16x8 At[4][2], B0[2][2], B1[2][2];
    const char* cA = S.a_base(g, cur, tstep); const char* cB = S.b_base(g, cur, tstep);
    S.a_ready(cur);
    if constexpr (SP2) {
        PG8_STAGE(PG8_SB(0, 0), cB, voffB); PG8_STAGE(PG8_SB(0, 1), cB + hstep, voffB); PG8_STAGE(PG8_SA(0, 0), cA, voffA); PG8_STAGE(PG8_SA(0, 1), cA + hstep, voffA);
        if (wr == 1) PG8_BAR;
        PG8_WAIT_V(2); PG8_BAR;
        PG8_STAGE(PG8_SB(1, 0), cB + kstep, voffB); PG8_STAGE(PG8_SA(1, 0), cA + kstep, voffA); PG8_STAGE(PG8_SB(1, 1), cB + hstep + kstep, voffB);
        PG8_WAIT_V(6); PG8_BAR;
    } else {
        PG8_STAGE(PG8_SB(0, 0), cB, voffB); PG8_STAGE(PG8_SA(0, 0), cA, voffA); PG8_STAGE(PG8_SB(0, 1), cB + hstep, voffB); PG8_STAGE(PG8_SA(0, 1), cA + hstep, voffA);
        if (wr == 1) PG8_BAR;
        PG8_WAIT_V(4); PG8_BAR;
        PG8_STAGE(PG8_SB(1, 0), cB + kstep, voffB); PG8_STAGE(PG8_SA(1, 0), cA + kstep, voffA); PG8_STAGE(PG8_SB(1, 1), cB + hstep + kstep, voffB);
        PG8_WAIT_V(6); PG8_BAR;
    }
    for (;;) {
        const bool has_next = S.next(ui + 1, nxt);
        const char* nA = has_next ? S.a_base(g, nxt, tstep) : cA; const char* nB = has_next ? S.b_base(g, nxt, tstep) : cB;
        for (int t = 0; t < nt; t += 2) {
            const bool last = (t == nt - 2);
            const char* a1 = cA + (size_t)(t + 1) * kstep;
            const char* a2 = last ? nA : cA + (size_t)(t + 2) * kstep; const char* b2 = last ? nB : cB + (size_t)(t + 2) * kstep;
            const char* a3 = a2 + kstep; const char* b3 = b2 + kstep;
            if (last && has_next) S.a_ready(nxt);
            if constexpr (SP2) {
            PG8_LDB(B0, 0, 0); PG8_LDB(B1, 0, 1); PG8_SCHED; PG8_LDA(At, 0, 0); PG8_STAGE(PG8_SA(1, 1), a1 + hstep, voffA);
            PG8_WAIT_V(8); PG8_WAIT_L(0); PG8_BAR; PG8_MMA(0, 0, At, B0); PG8_MMA(0, 1, At, B1); PG8_BAR; PG8_SCHED;
            PG8_LDA(At, 0, 1); PG8_STAGE(PG8_SB(0, 0), b2, voffB); PG8_STAGE(PG8_SB(0, 1), b2 + hstep, voffB); PG8_STAGE(PG8_SA(0, 0), a2, voffA);
            PG8_WAIT_V(8); PG8_WAIT_L(0); PG8_BAR; PG8_MMA(1, 0, At, B0); PG8_MMA(1, 1, At, B1); PG8_BAR; PG8_SCHED;
            PG8_LDB(B0, 1, 0); PG8_LDB(B1, 1, 1); PG8_SCHED; PG8_LDA(At, 1, 0); PG8_STAGE(PG8_SA(0, 1), a2 + hstep, voffA);
            PG8_WAIT_V(8); PG8_WAIT_L(0); PG8_BAR; PG8_MMA(0, 0, At, B0); PG8_MMA(0, 1, At, B1); PG8_BAR; PG8_SCHED;
            PG8_LDA(At, 1, 1); PG8_STAGE(PG8_SB(1, 0), b3, voffB); PG8_STAGE(PG8_SB(1, 1), b3 + hstep, voffB); PG8_STAGE(PG8_SA(1, 0), a3, voffA);
            PG8_WAIT_V(8); PG8_WAIT_L(0); PG8_BAR; PG8_MMA(1, 0, At, B0); PG8_MMA(1, 1, At, B1); PG8_BAR; PG8_SCHED;
            } else {
            PG8_LDB(B0, 0, 0); PG8_SCHED; PG8_LDA(At, 0, 0); PG8_STAGE(PG8_SA(1, 1), a1 + hstep, voffA);
            PG8_WAIT_L(8); PG8_BAR; PG8_WAIT_L(0); PG8_MMA(0, 0, At, B0); PG8_BAR; PG8_SCHED;
            PG8_LDB(B1, 0, 1); PG8_STAGE(PG8_SB(0, 0), b2, voffB);
            PG8_BAR; PG8_WAIT_L(0); PG8_MMA(0, 1, At, B1); PG8_BAR;
            PG8_LDA(At, 0, 1); PG8_STAGE(PG8_SA(0, 0), a2, voffA);
            PG8_BAR; PG8_WAIT_L(0); PG8_MMA(1, 0, At, B0); PG8_BAR; PG8_SCHED;
            PG8_STAGE(PG8_SB(0, 1), b2 + hstep, voffB);
            PG8_WAIT_V(6); PG8_BAR; PG8_MMA(1, 1, At, B1); PG8_BAR;
            PG8_LDB(B0, 1, 0); PG8_SCHED; PG8_LDA(At, 1, 0); PG8_STAGE(PG8_SA(0, 1), a2 + hstep, voffA);
            PG8_WAIT_L(8); PG8_BAR; PG8_WAIT_L(0); PG8_MMA(0, 0, At, B0); PG8_BAR; PG8_SCHED;
            PG8_LDB(B1, 1, 1); PG8_STAGE(PG8_SB(1, 0), b3, voffB);
            PG8_BAR; PG8_WAIT_L(0); PG8_MMA(0, 1, At, B1); PG8_BAR;
            PG8_LDA(At, 1, 1); PG8_STAGE(PG8_SA(1, 0), a3, voffA);
            PG8_BAR; PG8_WAIT_L(0); PG8_MMA(1, 0, At, B0); PG8_BAR; PG8_SCHED;
            PG8_STAGE(PG8_SB(1, 1), b3 + hstep, voffB);
            PG8_WAIT_V(6); PG8_BAR; PG8_MMA(1, 1, At, B1); PG8_BAR;
            }
        }
        if constexpr (ALIGN_EPI) { if (wr == 0) PG8_BAR; }
        if constexpr (!Epi::AFTER_DRAIN) { E(acc, cur, wr, wc, fr, fq); S.done(cur); }
        if (!has_next) break;
#pragma unroll
        for (int a = 0; a < 2; ++a)
#pragma unroll
            for (int b = 0; b < 2; ++b)
#pragma unroll
                for (int m = 0; m < 4; ++m)
#pragma unroll
                    for (int n = 0; n < 2; ++n) acc[a][b][m][n] = (f32x4){0.f, 0.f, 0.f, 0.f};
        cur = nxt; cA = nA; cB = nB; ++ui;
        if constexpr (ALIGN_EPI) { if (wr == 1) PG8_BAR; }
    }
    PG8_WAIT_V(0);
    if constexpr (!ALIGN_EPI) { if (wr == 0) PG8_BAR; }
    PG8_BAR;
    if constexpr (Epi::AFTER_DRAIN) { E.fused(acc, cur, wr, wc, fr, fq, lds, wid, lane); S.done(cur); }
#undef PG8_SA
#undef PG8_SB
#undef PG8_STAGE
#undef PG8_LDA
#undef PG8_LDB
#undef PG8_MMA
#undef PG8_WAIT_V
#undef PG8_WAIT_L
#undef PG8_BAR
#undef PG8_SCHED
}
}

constexpr int D_MODEL = 2048, BATCH = 4, SEQ = 2048, CTX = 256, GRID_W = 64, NHEAD = 8, HD = 128, WA = 1024;
constexpr int FFN = 5632, IN_COLS = 12288, NMOD = 6;
constexpr int ML = BATCH * SEQ;
constexpr int MC = BATCH * CTX;
constexpr int MT = ML + MC;
constexpr float EPS = 1e-6f;
constexpr int NTHREADS = 512;
constexpr int VT_PITCH = SEQ + CTX;

typedef unsigned short bf16;
typedef float f32x4 __attribute__((ext_vector_type(4)));
typedef unsigned u32x2 __attribute__((ext_vector_type(2)));
typedef unsigned u32x4 __attribute__((ext_vector_type(4)));
#define LAS __attribute__((address_space(3)))

typedef float f32x2_t __attribute__((ext_vector_type(2)));
typedef __bf16 bf16x2_t __attribute__((ext_vector_type(2)));
__device__ __forceinline__ unsigned pk2(float lo, float hi) { const f32x2_t v = {lo, hi}; const bf16x2_t b = __builtin_convertvector(v, bf16x2_t); return __builtin_bit_cast(unsigned, b); }
__device__ __forceinline__ unsigned f2bf(float f) { return pk2(f, 0.f) & 0xffffu; }
__device__ __forceinline__ float bf2f(unsigned short h) { return __builtin_bit_cast(float, (unsigned)h << 16); }
__device__ __forceinline__ float bflo(unsigned w) { return __builtin_bit_cast(float, w << 16); }
__device__ __forceinline__ float bfhi(unsigned w) { return __builtin_bit_cast(float, w & 0xffff0000u); }
__device__ __forceinline__ float sigmoidf_(float x) { return 1.0f / (1.0f + __expf(-x)); }
__device__ __forceinline__ float siluf_(float x) { return x / (1.0f + __expf(-x)); }
__device__ __forceinline__ float wave_sum(float v) {
#pragma unroll
    for (int o = 1; o < 64; o <<= 1) v += __shfl_xor(v, o);
    return v;
}
__device__ __forceinline__ float wave_max(float v) {
#pragma unroll
    for (int o = 1; o < 64; o <<= 1) v = fmaxf(v, __shfl_xor(v, o));
    return v;
}

constexpr size_t al256(size_t x) { return (x + 255) & ~(size_t)255; }
constexpr size_t WS_CTL   = 0;
constexpr size_t CTL_ZERO_BYTES = 1u << 20;
constexpr size_t WS_ROWSQ = 64 * 1024;
constexpr size_t WS_BIAS2 = WS_ROWSQ + (size_t)ML * 4;
static_assert(WS_BIAS2 + (size_t)4 * 2 * FFN * 4 <= CTL_ZERO_BYTES, "ctl");
constexpr size_t WS_MOD   = CTL_ZERO_BYTES;
constexpr size_t WS_LB    = al256(WS_MOD + (size_t)5 * IN_COLS * 4);
constexpr size_t WS_ROPE  = al256(WS_LB + 2 * WA * 4);
constexpr size_t WS_SMALL_END = al256(WS_ROPE + 2 * 64 * 32 * 4);
constexpr size_t WS_W13T  = al256(WS_SMALL_END);
constexpr size_t WS_W2T   = WS_W13T + (size_t)2 * FFN * D_MODEL * 2;
constexpr size_t WS_WAT   = WS_W2T + (size_t)D_MODEL * FFN * 2;
constexpr size_t WS_WBT   = WS_WAT + (size_t)D_MODEL * WA * 2;
constexpr size_t WS_WOT   = WS_WBT + (size_t)D_MODEL * WA * 2;
constexpr size_t WS_A_END = WS_WOT + (size_t)D_MODEL * D_MODEL * 2;
constexpr size_t SEGB = (size_t)MT * WA * 2;
constexpr size_t WS_QA  = WS_A_END;
constexpr size_t WS_FW  = WS_QA + SEGB;
constexpr size_t WS_FB  = WS_FW + 2 * SEGB;
constexpr size_t WS_IA  = WS_FB + 2 * SEGB;
constexpr size_t WS_GA  = WS_IA + SEGB;
constexpr size_t WS_QN  = WS_GA + (size_t)ML * WA * 2;
constexpr size_t WS_KN  = WS_QN + (size_t)ML * WA * 2;
constexpr size_t WS_VN  = WS_KN + SEGB;
constexpr size_t WS_GTA = WS_VN + SEGB;
constexpr size_t WS_GTB = WS_GTA + (size_t)ML * D_MODEL * 2;
constexpr size_t WS_D_END = WS_GTB + (size_t)ML * D_MODEL * 2;
constexpr size_t WS_WINT = WS_D_END;
constexpr size_t WS_OF   = WS_WINT;
constexpr size_t WS_OB   = WS_OF + (size_t)ML * WA * 2;
constexpr size_t WS_B_END = WS_WINT + (size_t)IN_COLS * D_MODEL * 2;
static_assert(WS_OB + (size_t)ML * WA * 2 <= WS_B_END, "B");
constexpr size_t WS_H   = WS_B_END;
constexpr size_t WS_YA  = WS_H;
constexpr size_t WS_YB  = WS_YA + (size_t)ML * WA * 2;
constexpr size_t WS_C_END = WS_H + (size_t)MT * D_MODEL * 2;
constexpr size_t WS_ACT_END = WS_D_END + (size_t)ML * FFN * 2;
constexpr size_t WS_HIMG = WS_WINT;
constexpr size_t WS_HIMG_END = WS_HIMG + (size_t)64 * 36 * 41472;
constexpr size_t WS_T1 = WS_WINT;
constexpr size_t WS_END0 = WS_C_END > WS_ACT_END ? WS_C_END : WS_ACT_END;
constexpr size_t WS_END = WS_END0 > WS_HIMG_END ? WS_END0 : WS_HIMG_END;
static_assert(WS_END <= 445000000, "ws budget");
constexpr size_t WS_Z   = WS_QA;
constexpr size_t WS_XMG = WS_GTB;
constexpr size_t WS_HALO = WS_QA;
static_assert(WS_HALO + (size_t)32 * 6 * FFN * 4 <= WS_XMG, "HALO overlay");
constexpr size_t WS_ACT = WS_WINT;
static_assert(WS_ACT + (size_t)ML * FFN * 2 <= WS_END, "ACT overlay");

struct Params {
    const float *x, *c, *ctx, *c_ctx, *ada_w, *ada_b, *norm1_g, *norm2_g, *w_in, *lb_logits, *hgrn_norm_g, *q_norm_g, *k_norm_g, *rel_bias,
                *w_a, *w_b, *w_o, *w1, *w3, *conv_w, *conv_b, *w2;
    float* out;
    unsigned char* ws;
    int wave_id, pad;
};

template <bool QKPERM, bool BIAS>
__device__ __forceinline__ void transpose_item(const float* W, int K, int N, bf16* WT, int row_off, LAS float* scr, int item, int lane, const float* sh2 = nullptr, float* bias2 = nullptr) {
    const int nblk = N / 32, kb = item / nblk, nb = item % nblk, k0 = 64 * kb, n0 = 32 * nb;
    if (BIAS) row_off += (n0 >> 7) * 128;
    float wv[32];
#pragma unroll
    for (int i = 0; i < 32; ++i) wv[i] = W[(size_t)(k0 + 2 * i + (lane >> 5)) * N + n0 + (lane & 31)];
#pragma unroll
    for (int i = 0; i < 32; ++i) scr[(2 * i + (lane >> 5)) * 33 + (lane & 31)] = wv[i];
    if (BIAS) {
        float a0 = 0.f, a1 = 0.f, a2 = 0.f, a3 = 0.f;
#pragma unroll
        for (int i = 0; i < 32; ++i) { const int k = k0 + 2 * i + (lane >> 5); const float w = wv[i];
            a0 += w * sh2[0 * IN_COLS + k]; a1 += w * sh2[1 * IN_COLS + k]; a2 += w * sh2[2 * IN_COLS + k]; a3 += w * sh2[3 * IN_COLS + k]; }
        a0 += __shfl_xor(a0, 32); a1 += __shfl_xor(a1, 32); a2 += __shfl_xor(a2, 32); a3 += __shfl_xor(a3, 32);
        if (lane < 32) { float* bp = bias2 + row_off + n0 + lane; atomicAdd(bp, a0); atomicAdd(bp + 2 * FFN, a1); atomicAdd(bp + 4 * FFN, a2); atomicAdd(bp + 6 * FFN, a3); }
    }
    asm volatile("s_waitcnt lgkmcnt(0)" ::: "memory");
    const int c = lane & 7;
#pragma unroll
    for (int j = 0; j < 4; ++j) { const int n = (lane >> 3) + 8 * j; const LAS float* s = scr + (8 * c) * 33 + n;
        u32x4 o; o.x = pk2(s[0 * 33], s[1 * 33]); o.y = pk2(s[2 * 33], s[3 * 33]); o.z = pk2(s[4 * 33], s[5 * 33]); o.w = pk2(s[6 * 33], s[7 * 33]);
        int cdst = n0 + n;
        if (QKPERM && cdst >= 5 * WA && cdst < 7 * WA) cdst = (cdst & ~0x30) | ((cdst & 0x10) << 1) | ((cdst & 0x20) >> 1);
        *(u32x4*)(WT + (size_t)(row_off + cdst) * K + k0 + 8 * c) = o; }
    asm volatile("s_waitcnt lgkmcnt(0)" ::: "memory");
}
__device__ __forceinline__ void phase_wconv_in(const Params& p, LAS unsigned char* lds, int gw, int NGW) {
    const int lane = lane_id(), wave = p.wave_id;
    LAS float* scr = (LAS float*)(lds + wave * 16384);
    constexpr int I_IN = (D_MODEL / 64) * (IN_COLS / 32);
    for (int it = gw; it < I_IN; it += NGW) transpose_item<true, false>(p.w_in, D_MODEL, IN_COLS, (bf16*)(p.ws + WS_WINT), 0, scr, it, lane);
}
__device__ __forceinline__ void phase_wconv_rest(const Params& p, LAS unsigned char* lds, int gw, int NGW) {
    const int lane = lane_id(), wave = p.wave_id;
    LAS float* scr = (LAS float*)(lds + 16384 + wave * 16384);
    constexpr int I_A = (WA / 64) * (D_MODEL / 32), I_O = (D_MODEL / 64) * (D_MODEL / 32), I_1 = (D_MODEL / 64) * (FFN / 32), I_2 = (FFN / 64) * (D_MODEL / 32);
    constexpr int NITEMS = 2 * I_A + I_O + 2 * I_1 + I_2;
    unsigned char* ws = p.ws;
    const float* sh2 = (const float*)(ws + WS_MOD) + 3 * D_MODEL; float* b2 = (float*)(ws + WS_BIAS2);
    for (int it = gw; it < NITEMS; it += NGW) {
        int r = it;
        if (r < I_A) { transpose_item<false, false>(p.w_a, WA, D_MODEL, (bf16*)(ws + WS_WAT), 0, scr, r, lane); continue; } r -= I_A;
        if (r < I_A) { transpose_item<false, false>(p.w_b, WA, D_MODEL, (bf16*)(ws + WS_WBT), 0, scr, r, lane); continue; } r -= I_A;
        if (r < I_O) { transpose_item<false, false>(p.w_o, D_MODEL, D_MODEL, (bf16*)(ws + WS_WOT), 0, scr, r, lane); continue; } r -= I_O;
        if (r < I_1) { transpose_item<false, true>(p.w1, D_MODEL, FFN, (bf16*)(ws + WS_W13T), 0, scr, r, lane, sh2, b2); continue; } r -= I_1;
        if (r < I_1) { transpose_item<false, true>(p.w3, D_MODEL, FFN, (bf16*)(ws + WS_W13T), 128, scr, r, lane, sh2, b2); continue; } r -= I_1;
        transpose_item<false, false>(p.w2, FFN, D_MODEL, (bf16*)(ws + WS_W2T), 0, scr, r, lane);
    }
}

__device__ __forceinline__ void phase_mod(const Params& p, LAS unsigned char* lds, int vb, int nb) {
    const int tid = tid_of(p.wave_id);
    LAS float* sc = (LAS float*)lds;
    LAS float* red = (LAS float*)(lds + 5 * 2048 * 4);
    for (int i = tid; i < 5 * D_MODEL; i += NTHREADS) { const int r = i / D_MODEL, k = i % D_MODEL; const float v = (r < 4) ? p.c[r * D_MODEL + k] : p.c_ctx[k]; sc[i] = siluf_(v); }
    __syncthreads();
    float* mod = (float*)(p.ws + WS_MOD);
    const int c4 = tid & 15, kp = tid >> 4;
    for (int item = vb; item < IN_COLS / 64; item += nb) {
        const int n0 = item * 64 + c4 * 4;
        f32x4 acc[5];
#pragma unroll
        for (int r = 0; r < 5; ++r) acc[r] = (f32x4){0.f, 0.f, 0.f, 0.f};
#pragma unroll 8
        for (int k = kp; k < D_MODEL; k += 32) {
            const f32x4 w = *(const f32x4*)(p.ada_w + (size_t)k * IN_COLS + n0);
#pragma unroll
            for (int r = 0; r < 5; ++r) acc[r] += w * sc[r * D_MODEL + k];
        }
#pragma unroll
        for (int r = 0; r < 5; ++r) *(LAS f32x4*)(red + (kp * 5 + r) * 64 + c4 * 4) = acc[r];
        __syncthreads();
        if (tid < 320) { const int r = tid / 64, cidx = tid % 64; float s = 0.f;
            for (int q = 0; q < 32; ++q) s += red[(q * 5 + r) * 64 + cidx];
            mod[r * IN_COLS + item * 64 + cidx] = s + p.ada_b[item * 64 + cidx]; }
        __syncthreads();
    }
    if (vb == nb - 1) { float* rt = (float*)(p.ws + WS_ROPE);
        for (int i = tid; i < 64 * 32; i += NTHREADS) { const int pos = i >> 5, j = i & 31; const float inv = exp2f(-(float)j * (13.287712379549449f / 32.0f)); float sn, cs; sincosf((float)pos * inv, &sn, &cs); rt[i] = cs; rt[2048 + i] = sn; } }
    if (vb == 0) { float* lb = (float*)(p.ws + WS_LB);
        for (int i = tid; i < 2 * WA; i += NTHREADS) { const int d = i / WA, cc = i % WA; const float l0 = p.lb_logits[d * 2 * WA + cc], l1 = p.lb_logits[d * 2 * WA + WA + cc]; lb[i] = 1.0f / (1.0f + expf(l1 - l0)); } }
}

__device__ __forceinline__ void phase_h(const Params& p, int vb, int nb) {
    const int tid = tid_of(p.wave_id), lane = tid & 63, wave = p.wave_id;
    const float* mod = (const float*)(p.ws + WS_MOD);
    bf16* H = (bf16*)(p.ws + WS_H);
    for (int m = vb * 8 + wave; m < MT; m += nb * 8) {
        const float* xr = (m < ML) ? p.x + (size_t)m * D_MODEL : p.ctx + (size_t)(m - ML) * D_MODEL;
        const int mr = (m < ML) ? (m / SEQ) : 4;
        const float* sh = mod + (size_t)mr * IN_COLS, *scl = sh + D_MODEL;
        f32x4 v[8]; float s = 0.f;
#pragma unroll
        for (int j = 0; j < 8; ++j) { v[j] = *(const f32x4*)(xr + 4 * lane + 256 * j); s += (v[j].x * v[j].x + v[j].y * v[j].y) + (v[j].z * v[j].z + v[j].w * v[j].w); }
        const float rstd = 1.0f / sqrtf(wave_sum(s) * (1.0f / D_MODEL) + EPS);
#pragma unroll
        for (int j = 0; j < 8; ++j) { const int k = 4 * lane + 256 * j;
            const f32x4 g = *(const f32x4*)(p.norm1_g + k), a = *(const f32x4*)(scl + k), b = *(const f32x4*)(sh + k);
            const f32x4 h = v[j] * rstd * g * (a + 1.0f) + b;
            u32x2 o; o.x = pk2(h.x, h.y); o.y = pk2(h.z, h.w);
            *(u32x2*)(H + (size_t)m * D_MODEL + k) = o; }
    }
}

#define EPI_LOOP_BEGIN \
    _Pragma("unroll") for (int ai = 0; ai < 2; ++ai) _Pragma("unroll") for (int m = 0; m < 4; ++m) { const int row = u.pm * 256 + ai * 128 + wr * 64 + m * 16 + fr; \
    _Pragma("unroll") for (int bj = 0; bj < 2; ++bj) _Pragma("unroll") for (int n = 0; n < 2; ++n) { const int col = u.pn * 256 + bj * 128 + wc * 32 + n * 16 + fq * 4; const f32x4 v = acc[ai][bj][m][n];
#define EPI_LOOP_END } }

struct EpiInProj {
    static constexpr bool PERM = false, AFTER_DRAIN = false;
    unsigned char* ws; LAS unsigned char* lds; const float* qg; const float* kg;
    __device__ __forceinline__ void operator()(const f32x4 (&acc)[2][2][4][2], const pg8::Unit& u, int wr, int wc, int fr, int fq) const {
        const int seg = u.pn >> 2;
        const bool ctxrow = u.pm >= ML / 256;
        const float* lb = (const float*)(ws + WS_LB);
        if (seg == 1 || seg == 2) {
            float* F = (float*)(ws + (seg == 1 ? WS_FW : WS_FB)); const float* lbd = lb + (seg - 1) * WA;
            EPI_LOOP_BEGIN
                const int c = col - seg * WA; const f32x4 l = *(const f32x4*)(lbd + c); f32x4 o;
                o.x = logf(l.x + (1.0f - l.x) * sigmoidf_(v.x)); o.y = logf(l.y + (1.0f - l.y) * sigmoidf_(v.y));
                o.z = logf(l.z + (1.0f - l.z) * sigmoidf_(v.z)); o.w = logf(l.w + (1.0f - l.w) * sigmoidf_(v.w));
                *(f32x4*)(F + (size_t)row * WA + c) = o;
            EPI_LOOP_END
        } else if (seg == 7) {
            bf16* VT = (bf16*)(ws + WS_VN);
            EPI_LOOP_BEGIN
                const int c = col - 7 * WA; const int hh = c >> 7, d = c & 127;
                int bb, tok; if (row < ML) { bb = row / SEQ; tok = row % SEQ; } else { bb = (row - ML) / CTX; tok = SEQ + (row - ML) % CTX; }
                bf16* o = VT + ((size_t)(bb * NHEAD + hh) * HD + d) * VT_PITCH + tok;
                o[0] = (bf16)f2bf(v.x); o[VT_PITCH] = (bf16)f2bf(v.y); o[2 * VT_PITCH] = (bf16)f2bf(v.z); o[3 * VT_PITCH] = (bf16)f2bf(v.w);
            EPI_LOOP_END
        } else if (seg == 5 || seg == 6) {
            if (ctxrow && seg == 5) return;
            LAS float* ssq = (LAS float*)(lds + 131072);
            const float* gn = (seg == 5) ? qg : kg; const float* rt = (const float*)(ws + WS_ROPE);
            bf16* O = (bf16*)(ws + (seg == 5 ? WS_QN : WS_KN));
#pragma unroll
            for (int ai = 0; ai < 2; ++ai)
#pragma unroll
                for (int m = 0; m < 4; ++m)
#pragma unroll
                    for (int bj = 0; bj < 2; ++bj) { const f32x4 a = acc[ai][bj][m][0], b = acc[ai][bj][m][1];
                        float sq = (a.x * a.x + a.y * a.y) + (a.z * a.z + a.w * a.w) + (b.x * b.x + b.y * b.y) + (b.z * b.z + b.w * b.w);
                        sq += __shfl_xor(sq, 16); sq += __shfl_xor(sq, 32);
                        if (fq == 0) ssq[((ai * 128 + wr * 64 + m * 16 + fr) * 2 + bj) * 4 + wc] = sq; }
            asm volatile("s_waitcnt lgkmcnt(0)" ::: "memory"); __builtin_amdgcn_s_barrier(); asm volatile("" ::: "memory");
            const int H = wc >> 1, jj = 16 * (wc & 1) + 4 * fq;
            const f32x4 g0 = *(const f32x4*)(gn + 64 * H + jj), g1 = *(const f32x4*)(gn + 64 * H + 32 + jj);
#pragma unroll
            for (int ai = 0; ai < 2; ++ai)
#pragma unroll
                for (int m = 0; m < 4; ++m) { const int rl = ai * 128 + wr * 64 + m * 16 + fr; const int row = u.pm * 256 + rl;
                    f32x4 cs = (f32x4){1.f, 1.f, 1.f, 1.f}, sn = (f32x4){0.f, 0.f, 0.f, 0.f};
                    if (!ctxrow) { const int t = row & (SEQ - 1); const int pos = (H == 0) ? (t >> 6) : (t & 63); cs = *(const f32x4*)(rt + pos * 32 + jj); sn = *(const f32x4*)(rt + 2048 + pos * 32 + jj); }
#pragma unroll
                    for (int bj = 0; bj < 2; ++bj) { const f32x4 s4 = *(const LAS f32x4*)(ssq + (rl * 2 + bj) * 4);
                        const float rstd = 1.0f / sqrtf(((s4.x + s4.y) + (s4.z + s4.w)) * (1.0f / HD) + EPS);
                        const f32x4 u1 = acc[ai][bj][m][0] * rstd * g0, u2 = acc[ai][bj][m][1] * rstd * g1;
                        const f32x4 o1 = u1 * cs - u2 * sn, o2 = u1 * sn + u2 * cs;
                        bf16* op = O + (size_t)row * WA + (u.pn & 3) * 256 + bj * 128 + wc * 32 + fq * 4;
                        u32x2 w1; w1.x = pk2(o1.x, o1.y); w1.y = pk2(o1.z, o1.w); *(u32x2*)op = w1;
                        u32x2 w2; w2.x = pk2(o2.x, o2.y); w2.y = pk2(o2.z, o2.w); *(u32x2*)(op + 16) = w2; }
                    asm volatile("" ::: "memory"); }
            asm volatile("s_waitcnt lgkmcnt(0)" ::: "memory"); __builtin_amdgcn_s_barrier(); asm volatile("" ::: "memory");
        } else if (seg == 0 || seg == 3) {
            if (ctxrow && seg == 0) return;
            bf16* O = (bf16*)(ws + (seg == 0 ? WS_QA : WS_IA));
            EPI_LOOP_BEGIN
                const int c = col - seg * WA; u32x2 o; o.x = pk2(v.x, v.y); o.y = pk2(v.z, v.w);
                *(u32x2*)(O + (size_t)row * WA + c) = o;
            EPI_LOOP_END
        } else if (seg == 4) {
            if (ctxrow) return;
            bf16* O = (bf16*)(ws + WS_GA);
            EPI_LOOP_BEGIN
                const int c = col - seg * WA; u32x2 o; o.x = pk2(siluf_(v.x), siluf_(v.y)); o.y = pk2(siluf_(v.z), siluf_(v.w));
                *(u32x2*)(O + (size_t)row * WA + c) = o;
            EPI_LOOP_END
        } else {
            if (ctxrow) return;
            const bool isa = seg < 10;
            bf16* O = (bf16*)(ws + (isa ? WS_GTA : WS_GTB)); const int cbase = isa ? 8 * WA : 10 * WA;
            EPI_LOOP_BEGIN
                const int c = col - cbase; u32x2 o; o.x = pk2(sigmoidf_(v.x), sigmoidf_(v.y)); o.y = pk2(sigmoidf_(v.z), sigmoidf_(v.w));
                *(u32x2*)(O + (size_t)row * D_MODEL + c) = o;
            EPI_LOOP_END
        }
    }
};

constexpr int CTX_UNITS = (MC / 256) * 20;
struct InProjOrder : pg8::StaticOrder {
    __device__ bool next(int i, pg8::Unit& u) const {
        if (pg8::StaticOrder::next(i, u)) return true;
        const long L = (long)i * G + c - nwg; if (L < 0 || L >= CTX_UNITS) return false;
        const int t = (int)L, j = t % 20; u.pm = ML / 256 + t / 20; u.pn = (j < 12) ? 4 + j : 12 + j; u.br = 0; return true; }
};
struct MergeOrder : pg8::StaticOrder {
    const bf16* A1; const bf16* B1;
    __device__ bool next(int i, pg8::Unit& u) const { if (!pg8::StaticOrder::next(i >> 1, u)) return false; u.br = i & 1; return true; }
    __device__ __forceinline__ const char* a_base(const pg8::Gemm& g, const pg8::Unit& u, size_t tstep) const { return (const char*)(u.br ? A1 : g.A) + (size_t)u.pm * tstep; }
    __device__ __forceinline__ const char* b_base(const pg8::Gemm& g, const pg8::Unit& u, size_t tstep) const { return (const char*)(u.br ? B1 : g.Bt) + (size_t)u.pn * tstep; }
};
struct EpiMerge {
    static constexpr bool PERM = false, AFTER_DRAIN = false;
    unsigned char* ws; float* tmp;
    __device__ __forceinline__ void operator()(const f32x4 (&acc)[2][2][4][2], const pg8::Unit& u, int wr, int wc, int fr, int fq) const {
        if (u.br == 0) {
            const bf16* G = (const bf16*)(ws + WS_GTA);
            EPI_LOOP_BEGIN
                const u32x2 g = *(const u32x2*)(G + (size_t)row * D_MODEL + col);
                f32x4 o; o.x = bflo(g.x) * v.x; o.y = bfhi(g.x) * v.y; o.z = bflo(g.y) * v.z; o.w = bfhi(g.y) * v.w;
                *(f32x4*)(tmp + (size_t)row * D_MODEL + col) = o;
            EPI_LOOP_END
        } else {
            const bf16* G = (const bf16*)(ws + WS_GTB); bf16* Z = (bf16*)(ws + WS_Z);
            EPI_LOOP_BEGIN
                const u32x2 g = *(const u32x2*)(G + (size_t)row * D_MODEL + col);
                const f32x4 t = *(const f32x4*)(tmp + (size_t)row * D_MODEL + col);
                u32x2 o; o.x = pk2(t.x + bflo(g.x) * v.x, t.y + bfhi(g.x) * v.y); o.y = pk2(t.z + bflo(g.y) * v.z, t.w + bfhi(g.y) * v.w);
                *(u32x2*)(Z + (size_t)row * D_MODEL + col) = o;
            EPI_LOOP_END
        }
    }
};
struct EpiOutProj {
    static constexpr bool PERM = false, AFTER_DRAIN = false;
    unsigned char* ws; const float* x; const float* norm2_g; float* out;
    __device__ __forceinline__ void operator()(const f32x4 (&acc)[2][2][4][2], const pg8::Unit& u, int wr, int wc, int fr, int fq) const {
        const float* mod = (const float*)(ws + WS_MOD); bf16* XMG = (bf16*)(ws + WS_XMG); float* rowsq = (float*)(ws + WS_ROWSQ);
        const int b = (u.pm * 256) / SEQ;
        const float* g1 = mod + (size_t)b * IN_COLS + 2 * D_MODEL, *sc2 = mod + (size_t)b * IN_COLS + 4 * D_MODEL;
#pragma unroll
        for (int ai = 0; ai < 2; ++ai)
#pragma unroll
            for (int m = 0; m < 4; ++m) { const int row = u.pm * 256 + ai * 128 + wr * 64 + m * 16 + fr; float ss = 0.f;
#pragma unroll
                for (int bj = 0; bj < 2; ++bj)
#pragma unroll
                    for (int n = 0; n < 2; ++n) { const int col = u.pn * 256 + bj * 128 + wc * 32 + n * 16 + fq * 4; const f32x4 v = acc[ai][bj][m][n];
                        const f32x4 xv = *(const f32x4*)(x + (size_t)row * D_MODEL + col), g = *(const f32x4*)(g1 + col);
                        const f32x4 xm = xv + g * v;
                        *(f32x4*)(out + (size_t)row * D_MODEL + col) = xm;
                        ss += (xm.x * xm.x + xm.y * xm.y) + (xm.z * xm.z + xm.w * xm.w);
                        const f32x4 ng = *(const f32x4*)(norm2_g + col), s2 = *(const f32x4*)(sc2 + col);
                        const f32x4 h = xm * ng * (s2 + 1.0f);
                        u32x2 o; o.x = pk2(h.x, h.y); o.y = pk2(h.z, h.w);
                        *(u32x2*)(XMG + (size_t)row * D_MODEL + col) = o; }
                ss += __shfl_xor(ss, 16); ss += __shfl_xor(ss, 32);
                if (fq == 0) atomicAdd(rowsq + row, ss); }
    }
};
__device__ __forceinline__ float dpp_ror1(float v) { return __builtin_bit_cast(float, __builtin_amdgcn_update_dpp(0, __builtin_bit_cast(int, v), 0x121, 0xf, 0xf, false)); }
__device__ __forceinline__ float dpp_rol1(float v) { return __builtin_bit_cast(float, __builtin_amdgcn_update_dpp(0, __builtin_bit_cast(int, v), 0x12f, 0xf, 0xf, false)); }
__device__ __forceinline__ f32x4 ror1_4(const f32x4 v) { return (f32x4){dpp_ror1(v.x), dpp_ror1(v.y), dpp_ror1(v.z), dpp_ror1(v.w)}; }
__device__ __forceinline__ f32x4 rol1_4(const f32x4 v) { return (f32x4){dpp_rol1(v.x), dpp_rol1(v.y), dpp_rol1(v.z), dpp_rol1(v.w)}; }
struct EpiFfnUp {
    static constexpr bool PERM = false, AFTER_DRAIN = false;
    unsigned char* ws; LAS unsigned char* lds; const float* cw; const float* cb;
    __device__ __forceinline__ void operator()(const f32x4 (&acc_c)[2][2][4][2], const pg8::Unit& u, int wr, int wc, int fr, int fq) const {
        f32x4 (&acc)[2][2][4][2] = const_cast<f32x4 (&)[2][2][4][2]>(acc_c);
        const float* rowsq = (const float*)(ws + WS_ROWSQ); bf16* ACT = (bf16*)(ws + WS_ACT); float* HALO = (float*)(ws + WS_HALO) + (size_t)u.pm * 6 * FFN;
        const int b = (u.pm * 256) / SEQ; const float* bias2 = (const float*)(ws + WS_BIAS2) + (size_t)b * 2 * FFN + u.pn * 256;
        const int cl = wc * 32 + fq * 4, ch0 = u.pn * 128 + cl;
        LAS float* X = (LAS float*)(lds + 131072);
#pragma unroll
        for (int ai = 0; ai < 2; ++ai)
#pragma unroll
            for (int m = 0; m < 4; ++m) { const int row = u.pm * 256 + ai * 128 + wr * 64 + m * 16 + fr;
                const float rstd = 1.0f / sqrtf(rowsq[row] * (1.0f / D_MODEL) + EPS);
#pragma unroll
                for (int bj = 0; bj < 2; ++bj)
#pragma unroll
                    for (int n = 0; n < 2; ++n) acc[ai][bj][m][n] = acc[ai][bj][m][n] * rstd + *(const f32x4*)(bias2 + bj * 128 + cl + 16 * n); }
#pragma unroll
        for (int ai = 0; ai < 2; ++ai) { const int bi = 2 * ai + wr;
            if (fr == 0) {
#pragma unroll
                for (int n = 0; n < 2; ++n) *(LAS f32x4*)(X + (bi * 2 + 0) * 128 + cl + 16 * n) = acc[ai][0][0][n]; }
            if (fr == 15) {
#pragma unroll
                for (int n = 0; n < 2; ++n) *(LAS f32x4*)(X + (bi * 2 + 1) * 128 + cl + 16 * n) = acc[ai][0][3][n]; } }
        asm volatile("s_waitcnt lgkmcnt(0)" ::: "memory"); __builtin_amdgcn_s_barrier(); asm volatile("" ::: "memory");
        if (wr == 0 && fr < 2) {
#pragma unroll
            for (int n = 0; n < 2; ++n) { *(f32x4*)(HALO + (size_t)fr * FFN + ch0 + 16 * n) = acc[0][0][0][n]; if (fr == 0) *(f32x4*)(HALO + (size_t)4 * FFN + ch0 + 16 * n) = acc[0][1][0][n]; } }
        if (wr == 1 && fr >= 14) {
#pragma unroll
            for (int n = 0; n < 2; ++n) { *(f32x4*)(HALO + (size_t)(fr - 12) * FFN + ch0 + 16 * n) = acc[1][0][3][n]; if (fr == 15) *(f32x4*)(HALO + (size_t)5 * FFN + ch0 + 16 * n) = acc[1][1][3][n]; } }
#pragma unroll
        for (int n = 0; n < 2; ++n) {
            const f32x4 w0 = *(const f32x4*)(cw + ch0 + 16 * n), w1 = *(const f32x4*)(cw + FFN + ch0 + 16 * n), w2 = *(const f32x4*)(cw + 2 * FFN + ch0 + 16 * n), cbv = *(const f32x4*)(cb + ch0 + 16 * n);
#pragma unroll
            for (int ai = 0; ai < 2; ++ai) { const int bi = 2 * ai + wr;
                const f32x4 xprev = (bi > 0) ? *(const LAS f32x4*)(X + ((bi - 1) * 2 + 1) * 128 + cl + 16 * n) : (f32x4){0.f, 0.f, 0.f, 0.f};
                const f32x4 xnext = (bi < 3) ? *(const LAS f32x4*)(X + ((bi + 1) * 2 + 0) * 128 + cl + 16 * n) : (f32x4){0.f, 0.f, 0.f, 0.f};
#pragma unroll
                for (int m = 0; m < 4; ++m) { const f32x4 cur = acc[ai][0][m][n];
                    const f32x4 pu = (m > 0) ? ror1_4(acc[ai][0][m > 0 ? m - 1 : 0][n]) : xprev; const f32x4 ps = ror1_4(cur);
                    const f32x4 nd = (m < 3) ? rol1_4(acc[ai][0][m < 3 ? m + 1 : 3][n]) : xnext; const f32x4 ns = rol1_4(cur);
                    const f32x4 prev = (fr > 0) ? ps : pu, next = (fr < 15) ? ns : nd;
                    const f32x4 uu = w0 * prev + w1 * cur + w2 * next + cbv; const f32x4 gt = acc[ai][1][m][n];
                    f32x4 r; r.x = siluf_(uu.x) * gt.x; r.y = siluf_(uu.y) * gt.y; r.z = siluf_(uu.z) * gt.z; r.w = siluf_(uu.w) * gt.w;
                    const int rl = ai * 128 + wr * 64 + m * 16 + fr;
                    if (rl != 0 && rl != 255) { u32x2 o; o.x = pk2(r.x, r.y); o.y = pk2(r.z, r.w); *(u32x2*)(ACT + (size_t)(u.pm * 256 + rl) * FFN + ch0 + 16 * n) = o; } } } }
    }
};
__device__ __forceinline__ void halo_fix(const Params& p, int pm, int tid) {
    const float* HB = (const float*)(p.ws + WS_HALO); const float* H = HB + (size_t)pm * 6 * FFN; bf16* ACT = (bf16*)(p.ws + WS_ACT);
    for (int ch = tid; ch < FFN; ch += NTHREADS) {
        const float w0 = p.conv_w[ch], w1 = p.conv_w[FFN + ch], w2 = p.conv_w[2 * FFN + ch], cbv = p.conv_b[ch];
        const float pv = (pm & 7) ? HB[((size_t)(pm - 1) * 6 + 3) * FFN + ch] : 0.f; const float nx = ((pm & 7) != 7) ? HB[((size_t)(pm + 1) * 6 + 0) * FFN + ch] : 0.f;
        const float ut = w0 * pv + w1 * H[ch] + w2 * H[FFN + ch] + cbv; const float ub = w0 * H[2 * FFN + ch] + w1 * H[3 * FFN + ch] + w2 * nx + cbv;
        ACT[(size_t)(pm * 256) * FFN + ch] = (bf16)f2bf(siluf_(ut) * H[4 * FFN + ch]); ACT[(size_t)(pm * 256 + 255) * FFN + ch] = (bf16)f2bf(siluf_(ub) * H[5 * FFN + ch]);
    }
}
struct EpiFfnDown {
    static constexpr bool PERM = false, AFTER_DRAIN = false;
    unsigned char* ws; float* out;
    __device__ __forceinline__ void operator()(const f32x4 (&acc)[2][2][4][2], const pg8::Unit& u, int wr, int wc, int fr, int fq) const {
        const float* mod = (const float*)(ws + WS_MOD); const int b = (u.pm * 256) / SEQ; const float* g2 = mod + (size_t)b * IN_COLS + 5 * D_MODEL;
        EPI_LOOP_BEGIN
            float* o = out + (size_t)row * D_MODEL + col; const f32x4 xm = *(const f32x4*)o, g = *(const f32x4*)(g2 + col);
            *(f32x4*)o = xm + g * v;
        EPI_LOOP_END
    }
};

#define XB_TMO      128
#define XB_XCNT(j)  (256  + 64 * (j))
#define XB_XSUB(j)  (1280 + 64 * (j))
#define XB_XGEN(j)  (2304 + 64 * (j))
#define XB_TOP      3328
#define XB_TOPGEN   3392
#define XCD_BAR_WORDS 3456
#define XB_SPIN_CAP (1u << 18)

__device__ __forceinline__ unsigned xb_ld(unsigned* p)              { return __hip_atomic_load(p, __ATOMIC_RELAXED, __HIP_MEMORY_SCOPE_AGENT); }
__device__ __forceinline__ unsigned xb_add(unsigned* p, unsigned v) { return __hip_atomic_fetch_add(p, v, __ATOMIC_RELAXED, __HIP_MEMORY_SCOPE_AGENT); }
__device__ __forceinline__ unsigned xb_xcc_id() { return (unsigned)__builtin_amdgcn_s_getreg((3 << 11) | 20) & 0xFu; }
#define XB_SPIN(cond, bar) do { unsigned _sp = 0; while (cond) { __builtin_amdgcn_s_sleep(1); \
    if ((++_sp & 255u) == 0u) { if (xb_ld(&(bar)[XB_TMO])) break; if (_sp > XB_SPIN_CAP) { atomicAdd(&(bar)[XB_TMO], 1u); break; } } } } while (0)

struct XcdBarrier {
    unsigned* bar; unsigned x; int wave;
    volatile LAS unsigned* st;
};

__device__ __forceinline__ XcdBarrier xcd_barrier_post(unsigned* bar, volatile LAS unsigned* st, int wave_id) {
    XcdBarrier b; b.bar = bar; b.x = xb_xcc_id(); b.st = st; b.wave = wave_id;
    if (wave_id == 0 && lane_id() == 0) (void)xb_add(&bar[XB_XCNT(b.x)], 1u);
    return b;
}
__device__ __forceinline__ void xcd_barrier_complete(unsigned* bar, unsigned x, unsigned& nloc, unsigned& nx) {
    const unsigned G = gridDim.x * gridDim.y * gridDim.z;
    unsigned sum, cnt, mine, sp = 0u;
    for (;;) {
        sum = 0u; cnt = 0u; mine = 0u;
#pragma unroll
        for (unsigned j = 0; j < 16; ++j) { const unsigned c = xb_ld(&bar[XB_XCNT(j)]); sum += c; cnt += (c > 0u) ? 1u : 0u; mine = (j == x) ? c : mine; }
        if (sum == G) break;
        __builtin_amdgcn_s_sleep(1);
        if ((++sp & 255u) == 0u) { if (xb_ld(&bar[XB_TMO])) break; if (sp > XB_SPIN_CAP) { atomicAdd(&bar[XB_TMO], 1u); break; } }
    }
    nloc = mine > 0u ? mine : 1u; nx = cnt > 0u ? cnt : 1u;
}

__device__ __forceinline__ void xcd_barrier(const XcdBarrier& b) {
    asm volatile("s_waitcnt vmcnt(0)" ::: "memory");
    __syncthreads();
    if (b.wave == 0 && lane_id() == 0) {
        unsigned* bar = b.bar;
        __builtin_amdgcn_s_waitcnt(0);
        unsigned nloc = b.st[0], nx = b.st[1];
        if (nloc == 0u) { xcd_barrier_complete(bar, b.x, nloc, nx); b.st[0] = nloc; b.st[1] = nx; }
        const unsigned old = xb_add(&bar[XB_XSUB(b.x)], 1u);
        const unsigned gen = old / nloc;
        if (old + 1u == (gen + 1u) * nloc) {
            __builtin_amdgcn_fence(__ATOMIC_RELEASE, "agent");
            asm volatile("s_waitcnt vmcnt(0)" ::: "memory");
            const unsigned og = xb_add(&bar[XB_TOP], 1u);
            const unsigned tg = og / nx;
            if (og + 1u == (tg + 1u) * nx) xb_add(&bar[XB_TOPGEN], 1u);
            else XB_SPIN(xb_ld(&bar[XB_TOPGEN]) == tg, bar);
            __builtin_amdgcn_fence(__ATOMIC_ACQUIRE, "agent");
            xb_add(&bar[XB_XGEN(b.x)], 1u);
            asm volatile("s_waitcnt vmcnt(0)" ::: "memory");
        } else {
            XB_SPIN(xb_ld(&bar[XB_XGEN(b.x)]) == gen, bar);
            __builtin_amdgcn_fence(__ATOMIC_ACQUIRE, "agent");
            asm volatile("s_waitcnt vmcnt(0)" ::: "memory");
        }
    }
    __syncthreads();
}

constexpr size_t WS_BAR = 8192;

typedef short bf16x8 __attribute__((ext_vector_type(8)));
typedef short s16x4 __attribute__((ext_vector_type(4)));

__device__ __forceinline__ bf16x8 cat8u(const u32x2 a, const u32x2 b) { const u32x4 w = (u32x4){a.x, a.y, b.x, b.y}; return __builtin_bit_cast(bf16x8, w); }
__device__ __forceinline__ bf16x8 pack_p(const f32x4 a, const f32x4 b) {
    u32x4 w; w.x = pk2(a.x, a.y); w.y = pk2(a.z, a.w); w.z = pk2(b.x, b.y); w.w = pk2(b.z, b.w);
    return __builtin_bit_cast(bf16x8, w);
}

constexpr int A_TILE = 32768, A_KOFF = 0, A_VOFF = 16384;
constexpr int A_BIAS = 4 * A_TILE;
constexpr int A_ITEM = A_BIAS + 2048;
static_assert(A_ITEM + 64 <= 145408, "attention LDS");
constexpr size_t WS_ATTCTR = 32768;
static_assert(WS_ATTCTR >= WS_BAR + XCD_BAR_WORDS * 4 && WS_ATTCTR + 8 * 256 <= WS_ROWSQ, "attn counters (8 x 256 B apart) inside ctl");
#define ATT_BAR() do { asm volatile("s_waitcnt lgkmcnt(0)" ::: "memory"); __builtin_amdgcn_s_barrier(); asm volatile("" ::: "memory"); } while (0)

__device__ __forceinline__ void phase_attn(const Params& p, LAS unsigned char* lds) {
    int tid_o = tid_of(p.wave_id);
    const int tid = tid_o, lane = tid & 63, wave = __builtin_amdgcn_readfirstlane(tid >> 6);
    const int qb = wave & 3, dh = wave >> 2, li = lane & 15, g = lane >> 4;
    const bf16* QN = (const bf16*)(p.ws + WS_QN); const bf16* KN = (const bf16*)(p.ws + WS_KN); const bf16* VT = (const bf16*)(p.ws + WS_VN);
    bf16* YB = (bf16*)p.out + (size_t)3 * ML * WA;
    unsigned* ctr = (unsigned*)(p.ws + WS_ATTCTR);
    LAS float* btab = (LAS float*)(lds + A_BIAS);
    const float scale = 0.08838834764831845f;
    int krow_l[2], kch_l[2], vrow_l[2], vch_l[2];
#pragma unroll
    for (int e = 0; e < 2; ++e) { const int pk = 2 * wave + e; krow_l[e] = 4 * pk + (lane >> 4); kch_l[e] = (lane & 15) ^ (krow_l[e] & 15);
        vrow_l[e] = 8 * pk + (lane >> 3); vch_l[e] = (lane & 7) ^ ((vrow_l[e] >> 1) & 7); }
    const int myx = (int)(xb_xcc_id() & 7u);
    int qoff = 0;
    for (;;) {
        if (tid == 0) { unsigned v = 0xffffffffu;
            while (qoff < 8) { const int qx = (myx + qoff) & 7; const unsigned n = atomicAdd(ctr + 64 * qx, 1u); if (n < 128u) { v = (unsigned)((qx + 8 * (n >> 5)) * 32 + (n & 31)); break; } ++qoff; }
            *(LAS unsigned*)(lds + A_ITEM) = v; }
        __syncthreads();
        const unsigned itu = *(LAS unsigned*)(lds + A_ITEM);
        if (itu == 0xffffffffu) break;
        const int it = (int)itu;
        const int r = it & 31, h = (it >> 5) & 7, b = it >> 8;
        const int rs = min(max(r - 4, 0), 24), ks0 = min(max(16 * qb - 8, 0), 32);
        const int cq = 16 * qb + li, cs = min(max(cq - 8, 0), 48);
        const size_t qrow = (size_t)b * SEQ + r * GRID_W + cq;
        if (tid < 15 * 31) btab[tid] = p.rel_bias[h * 465 + tid];
        bf16x8 qf[4];
#pragma unroll
        for (int ks = 0; ks < 4; ++ks) qf[ks] = *(const bf16x8*)(QN + qrow * WA + h * HD + 32 * ks + 8 * g);
        asm volatile("s_waitcnt vmcnt(0)" ::: "memory");
        const bf16* kg0 = KN + (size_t)h * HD + (size_t)krow_l[0] * WA + 8 * kch_l[0]; const bf16* kg1 = KN + (size_t)h * HD + (size_t)krow_l[1] * WA + 8 * kch_l[1];
        const bf16* vg0 = VT + ((size_t)(b * NHEAD + h) * HD + vrow_l[0]) * VT_PITCH + 8 * vch_l[0]; const bf16* vg1 = VT + ((size_t)(b * NHEAD + h) * HD + vrow_l[1]) * VT_PITCH + 8 * vch_l[1];
#define ATT_DMA(ti_) do { const int t_ = (ti_) < 12 ? (ti_) : 11; LAS unsigned char* bb_ = lds + ((ti_) & 3) * A_TILE + wave * 2048; \
            const size_t krow0 = (t_ < 8) ? ((size_t)b * SEQ + (rs + t_) * GRID_W) : ((size_t)ML + b * CTX + 64 * (t_ - 8)); \
            const int tok0 = (t_ < 8) ? ((rs + t_) * GRID_W) : (SEQ + 64 * (t_ - 8)); \
            __builtin_amdgcn_global_load_lds((const unsigned*)(kg0 + krow0 * WA), (LAS unsigned*)(bb_ + A_KOFF), 16, 0, 0); \
            __builtin_amdgcn_global_load_lds((const unsigned*)(kg1 + krow0 * WA), (LAS unsigned*)(bb_ + A_KOFF + 1024), 16, 0, 0); \
            __builtin_amdgcn_global_load_lds((const unsigned*)(vg0 + tok0), (LAS unsigned*)(bb_ + A_VOFF), 16, 0, 0); \
            __builtin_amdgcn_global_load_lds((const unsigned*)(vg1 + tok0), (LAS unsigned*)(bb_ + A_VOFF + 1024), 16, 0, 0); } while (0)
        ATT_DMA(0); ATT_DMA(1); ATT_DMA(2);
        f32x4 ot[4];
#pragma unroll
        for (int db = 0; db < 4; ++db) ot[db] = (f32x4){0.f, 0.f, 0.f, 0.f};
        float mrun = -1e30f, l = 0.f;
        const int kx = (ks0 + li) & 15, vy = (li >> 1) & 7;
        int koff[4];
#pragma unroll
        for (int ks = 0; ks < 4; ++ks) koff[ks] = A_KOFF + (ks0 + li) * 256 + (((4 * ks + g) ^ kx) << 4);
        const int vrow_off = A_VOFF + (64 * dh + li) * 128 + 8 * (g & 1);
        const int gq = g >> 1;
#pragma unroll 1
        for (int ti = 0; ti < 12; ++ti) {
            asm volatile("s_waitcnt vmcnt(8)" ::: "memory");
            ATT_BAR();
            ATT_DMA(ti + 3);
            const LAS unsigned char* tb = lds + (ti & 3) * A_TILE;
            if (ti < 8) {
                f32x4 st[2];
#pragma unroll
                for (int kb = 0; kb < 2; ++kb) { f32x4 a = (f32x4){0.f, 0.f, 0.f, 0.f};
#pragma unroll
                    for (int ks = 0; ks < 4; ++ks) a = __builtin_amdgcn_mfma_f32_16x16x32_bf16(*(const LAS bf16x8*)(tb + koff[ks] + kb * 4096), qf[ks], a, 0, 0, 0);
                    st[kb] = a; }
                const int dr = rs + ti - r + 7; float gm = -1e30f;
#pragma unroll
                for (int kb = 0; kb < 2; ++kb)
#pragma unroll
                    for (int j = 0; j < 4; ++j) { const int kcol = ks0 + 16 * kb + 4 * g + j; const bool valid = (kcol >= cs) && (kcol < cs + 16);
                        const int bi = valid ? (dr * 31 + (kcol - cq + 15)) : 0;
                        const float sv = valid ? (st[kb][j] * scale + btab[bi]) : -1e30f; st[kb][j] = sv; gm = fmaxf(gm, sv); }
                gm = fmaxf(gm, __shfl_xor(gm, 16)); gm = fmaxf(gm, __shfl_xor(gm, 32));
                const float mnew = fmaxf(mrun, gm); const float alpha = __expf(mrun - mnew); mrun = mnew; l *= alpha;
#pragma unroll
                for (int db = 0; db < 4; ++db) ot[db] = ot[db] * alpha;
#pragma unroll
                for (int kb = 0; kb < 2; ++kb)
#pragma unroll
                    for (int j = 0; j < 4; ++j) { const float sv = st[kb][j]; const float e = (sv > -1e29f) ? __expf(sv - mnew) : 0.f; st[kb][j] = e; l += e; }
                const bf16x8 pb = pack_p(st[0], st[1]);
                const int c0 = (ks0 >> 3) + gq;
#pragma unroll
                for (int db = 0; db < 4; ++db) { const LAS unsigned char* vp = tb + vrow_off + db * 2048;
                    ot[db] = __builtin_amdgcn_mfma_f32_16x16x32_bf16(cat8u(*(const LAS u32x2*)(vp + ((c0 ^ vy) << 4)), *(const LAS u32x2*)(vp + (((c0 + 2) ^ vy) << 4))), pb, ot[db], 0, 0, 0); }
            } else {
                f32x4 st[4];
#pragma unroll
                for (int kb = 0; kb < 4; ++kb) { f32x4 a = (f32x4){0.f, 0.f, 0.f, 0.f};
#pragma unroll
                    for (int ks = 0; ks < 4; ++ks) a = __builtin_amdgcn_mfma_f32_16x16x32_bf16(*(const LAS bf16x8*)(tb + A_KOFF + (16 * kb + li) * 256 + (((4 * ks + g) ^ li) << 4)), qf[ks], a, 0, 0, 0);
                    st[kb] = a * scale; }
                float gm = -1e30f;
#pragma unroll
                for (int kb = 0; kb < 4; ++kb) gm = fmaxf(fmaxf(gm, fmaxf(st[kb][0], st[kb][1])), fmaxf(st[kb][2], st[kb][3]));
                gm = fmaxf(gm, __shfl_xor(gm, 16)); gm = fmaxf(gm, __shfl_xor(gm, 32));
                const float mnew = fmaxf(mrun, gm); const float alpha = __expf(mrun - mnew); mrun = mnew; l *= alpha;
#pragma unroll
                for (int db = 0; db < 4; ++db) ot[db] = ot[db] * alpha;
#pragma unroll
                for (int kb = 0; kb < 4; ++kb)
#pragma unroll
                    for (int j = 0; j < 4; ++j) { const float e = __expf(st[kb][j] - mnew); st[kb][j] = e; l += e; }
#pragma unroll
                for (int kp2 = 0; kp2 < 2; ++kp2) { const bf16x8 pb = pack_p(st[2 * kp2], st[2 * kp2 + 1]);
                    const int c0 = 4 * kp2 + gq;
#pragma unroll
                    for (int db = 0; db < 4; ++db) { const LAS unsigned char* vp = tb + vrow_off + db * 2048;
                        ot[db] = __builtin_amdgcn_mfma_f32_16x16x32_bf16(cat8u(*(const LAS u32x2*)(vp + ((c0 ^ vy) << 4)), *(const LAS u32x2*)(vp + (((c0 + 2) ^ vy) << 4))), pb, ot[db], 0, 0, 0); } }
            }
        }
        asm volatile("s_waitcnt vmcnt(0)" ::: "memory");
        l += __shfl_xor(l, 16); l += __shfl_xor(l, 32);
        const float inv = 1.0f / l;
#pragma unroll
        for (int db = 0; db < 4; ++db) { const f32x4 o = ot[db] * inv; u32x2 w; w.x = pk2(o.x, o.y); w.y = pk2(o.z, o.w);
            *(u32x2*)(YB + qrow * WA + h * HD + 64 * dh + 16 * db + 4 * g) = w; }
#undef ATT_DMA
    }
}

constexpr int HP = 160;
constexpr int H_QH = 0, H_KH = 20480, H_KE = 40960, H_QD = 61440, H_KD = 81920;
constexpr int HP2 = 48;
constexpr int H_Q2 = 102400, H_K2 = 108544;
constexpr int PP = 144;
constexpr int H_P = 114688;
constexpr int H_T = 123904;
constexpr int H_D = 125952;
constexpr int HIMG_QD = 0, HIMG_KD = 16384, HIMG_P = 32768, HIMG_D = 40960, HIMG_BYTES = 41472;
constexpr int NCH = (CTX + SEQ) / 64;
constexpr int VP = 288;
constexpr int SB_QD = 0, SB_KD = 20480, SB_P = 40960, SB_D = 50176, SB_V = 50688, SB_BYTES = 69120;
static_assert(2 * SB_BYTES <= 145408, "scan buffers");

__device__ __forceinline__ s16x4 lds_tr(LAS const unsigned char* p) {
    return __builtin_bit_cast(s16x4, __builtin_amdgcn_ds_read_tr16_b64_v4i16((LAS s16x4*)p));
}
__device__ __forceinline__ bf16x8 cat8(const s16x4 a, const s16x4 b) { return __builtin_shufflevector(a, b, 0, 1, 2, 3, 4, 5, 6, 7); }

__device__ __forceinline__ size_t hg_row(int dir, int b, int tau) {
    if (tau < CTX) return (size_t)ML + b * CTX + (dir == 0 ? tau : CTX - 1 - tau);
    const int t = tau - CTX; return (size_t)b * SEQ + (dir == 0 ? t : SEQ - 1 - t);
}

__device__ __forceinline__ void hgrn_prep(const Params& p, LAS unsigned char* lds, int vb, int nb) {
    int tid_o = tid_of(p.wave_id);
    const int tid = tid_o, lane = tid & 63, wave = __builtin_amdgcn_readfirstlane(tid >> 6);
    const int k = tid & 127, J = __builtin_amdgcn_readfirstlane(tid >> 7);
    const int li = lane & 15, g = lane >> 4, qq = li >> 2, pp = li & 3;
    LAS float* Tl = (LAS float*)(lds + H_T); LAS float* Dl = (LAS float*)(lds + H_D);
    float lf[16]; unsigned qv[16];
#define HG_LOADP(idx_) do { const int id_ = (idx_); const int ch_ = id_ / NCH, cc_ = id_ % NCH; const int dir_ = ch_ / (BATCH * NHEAD), b_ = (ch_ / NHEAD) % BATCH, h_ = ch_ % NHEAD; \
        const size_t row0_ = hg_row(dir_, b_, 64 * cc_ + 16 * J); const long st_ = dir_ ? -(long)WA : (long)WA; \
        const float* lfp_ = (const float*)(p.ws + (dir_ == 0 ? WS_FW : WS_FB)) + row0_ * WA + h_ * HD + k; const bf16* qp_ = (const bf16*)(p.ws + WS_QA) + row0_ * WA + h_ * HD + k; \
        _Pragma("unroll") for (int i = 0; i < 16; ++i) { lf[i] = lfp_[(long)i * st_]; qv[i] = (cc_ >= 4) ? (unsigned)qp_[(long)i * st_] : 0u; } } while (0)
    if (vb < 64 * NCH) HG_LOADP(vb);
    for (int idx = vb; idx < 64 * NCH; idx += nb) {
        const int c = idx % NCH;
        float cum[16]; float run = 0.f;
#pragma unroll
        for (int i = 0; i < 16; ++i) { run += lf[i]; cum[i] = run; }
        Tl[J * 128 + k] = run;
        ATT_BAR();
        const float T0 = Tl[k], T1 = Tl[128 + k], T2 = Tl[256 + k], T3 = Tl[384 + k];
        const float bJ = (J > 0 ? T0 : 0.f) + (J > 1 ? T1 : 0.f) + (J > 2 ? T2 : 0.f);
        const float tail = (J < 1 ? T1 : 0.f) + (J < 2 ? T2 : 0.f) + (J < 3 ? T3 : 0.f);
        const float eb = __expf(bJ), et = __expf(tail), eT = __expf(run);
        const float x2 = (J == 3) ? __expf(T2) : __expf(T1);
        float qh[16], kh[16];
#pragma unroll
        for (int i = 0; i < 16; ++i) { const float e1 = __expf(cum[i]); const float r1 = __builtin_amdgcn_rcpf(e1); const float kk = 1.0f - __expf(lf[i]);
            qh[i] = __builtin_bit_cast(float, qv[i] << 16) * e1; kh[i] = kk * r1; }
        {
            LAS unsigned char* rowp = lds + k * HP + 32 * J;
            u32x4 w0, w1;
#define HG_WRITE(OFF, EXPR) do { \
            { float v0_, v1_; \
              { const int i = 0; v0_ = (EXPR); } { const int i = 1; v1_ = (EXPR); } w0.x = pk2(v0_, v1_); \
              { const int i = 2; v0_ = (EXPR); } { const int i = 3; v1_ = (EXPR); } w0.y = pk2(v0_, v1_); \
              { const int i = 4; v0_ = (EXPR); } { const int i = 5; v1_ = (EXPR); } w0.z = pk2(v0_, v1_); \
              { const int i = 6; v0_ = (EXPR); } { const int i = 7; v1_ = (EXPR); } w0.w = pk2(v0_, v1_); \
              { const int i = 8; v0_ = (EXPR); } { const int i = 9; v1_ = (EXPR); } w1.x = pk2(v0_, v1_); \
              { const int i = 10; v0_ = (EXPR); } { const int i = 11; v1_ = (EXPR); } w1.y = pk2(v0_, v1_); \
              { const int i = 12; v0_ = (EXPR); } { const int i = 13; v1_ = (EXPR); } w1.z = pk2(v0_, v1_); \
              { const int i = 14; v0_ = (EXPR); } { const int i = 15; v1_ = (EXPR); } w1.w = pk2(v0_, v1_); } \
            *(LAS u32x4*)(OFF) = w0; *(LAS u32x4*)((OFF) + 16) = w1; } while (0)
            HG_WRITE(rowp + H_QH, qh[i]);
            HG_WRITE(rowp + H_KH, kh[i]);
            HG_WRITE(rowp + H_KE, kh[i] * eT);
            HG_WRITE(rowp + H_QD, qh[i] * eb);
            HG_WRITE(rowp + H_KD, kh[i] * (eT * et));
            if (J == 3) { HG_WRITE(lds + H_Q2 + k * HP2, qh[i] * x2); }
            if (J == 0) { HG_WRITE(lds + H_K2 + k * HP2, kh[i] * (eT * x2)); }
#undef HG_WRITE
            if (J == 3) Dl[k] = __expf(bJ + run);
        }
        if (idx + nb < 64 * NCH) HG_LOADP(idx + nb);
        ATT_BAR();
        const bool lat = (c >= 4);
        if (lat) {
#pragma unroll
            for (int rep = 0; rep < 2; ++rep) {
                int I, Jb;
                if (rep == 0) { I = (wave < 4) ? wave : (wave == 4 ? 1 : (wave == 7 ? 3 : 2)); Jb = (wave < 4) ? wave : (wave == 4 ? 0 : (wave == 5 ? 0 : (wave == 6 ? 1 : 2))); }
                else { if (wave >= 2) break; I = 3; Jb = wave; }
                int aoff, apitch, acol, boff, bpitch, bcol;
                if (I == Jb) { aoff = H_KH; apitch = HP; acol = 16 * Jb; boff = H_QH; bpitch = HP; bcol = 16 * I; }
                else if (I == Jb + 1 && I != 2) { aoff = H_KE; apitch = HP; acol = 16 * Jb; boff = H_QH; bpitch = HP; bcol = 16 * I; }
                else if (I == 2) { if (Jb == 0) { aoff = H_K2; apitch = HP2; acol = 0; } else { aoff = H_KE; apitch = HP; acol = 16; } boff = H_QH; bpitch = HP; bcol = 32; }
                else { if (Jb == 0) { aoff = H_K2; apitch = HP2; acol = 0; } else { aoff = H_KE; apitch = HP; acol = 16; } boff = H_Q2; bpitch = HP2; bcol = 0; }
                f32x4 pt = (f32x4){0.f, 0.f, 0.f, 0.f};
#pragma unroll
                for (int ks = 0; ks < 4; ++ks) {
                    const int r0 = 32 * ks + 4 * g + qq;
                    const bf16x8 a = cat8(lds_tr(lds + aoff + r0 * apitch + (acol + 4 * pp) * 2), lds_tr(lds + aoff + (r0 + 16) * apitch + (acol + 4 * pp) * 2));
                    const bf16x8 bb = cat8(lds_tr(lds + boff + r0 * bpitch + (bcol + 4 * pp) * 2), lds_tr(lds + boff + (r0 + 16) * bpitch + (bcol + 4 * pp) * 2));
                    pt = __builtin_amdgcn_mfma_f32_16x16x32_bf16(a, bb, pt, 0, 0, 0);
                }
                if (I == Jb) {
#pragma unroll
                    for (int j = 0; j < 4; ++j) if (4 * g + j > li) pt[j] = 0.f;
                }
                u32x2 w; w.x = pk2(pt.x, pt.y); w.y = pk2(pt.z, pt.w);
                *(LAS u32x2*)(lds + H_P + (16 * I + li) * PP + (16 * Jb + 4 * g) * 2) = w;
            }
        }
        ATT_BAR();
        unsigned char* img = p.ws + WS_HIMG + (size_t)idx * HIMG_BYTES;
#pragma unroll
        for (int e = 0; e < 2; ++e) { const int id = tid + 512 * e; const int kr = id >> 3, part = id & 7;
            if (lat) *(u32x4*)(img + HIMG_QD + id * 16) = *(const LAS u32x4*)(lds + H_QD + kr * HP + 16 * part);
            *(u32x4*)(img + HIMG_KD + id * 16) = *(const LAS u32x4*)(lds + H_KD + kr * HP + 16 * part); }
        if (lat) *(u32x4*)(img + HIMG_P + tid * 16) = *(const LAS u32x4*)(lds + H_P + (tid >> 3) * PP + 16 * (tid & 7));
        if (tid < 32) *(u32x4*)(img + HIMG_D + tid * 16) = *(const LAS u32x4*)(lds + H_D + 16 * tid);
    }
#undef HG_LOADP
    __syncthreads();
}

__device__ __forceinline__ void hgrn_scan(const Params& p, LAS unsigned char* lds, int chain) {
    int tid_o = tid_of(p.wave_id);
    const int tid = tid_o, lane = tid & 63, wave = __builtin_amdgcn_readfirstlane(tid >> 6);
    const int li = lane & 15, g = lane >> 4, qq = li >> 2, pp = li & 3;
    const int dir = chain / (BATCH * NHEAD), b = (chain / NHEAD) % BATCH, h = chain % NHEAD;
    const bf16* IA = (const bf16*)(p.ws + WS_IA) + h * HD;
    bf16* O = ((bf16*)p.out + (dir == 0 ? 0 : (size_t)ML * WA)) + h * HD + 16 * wave + li;
    const long ost = dir ? -(long)WA : (long)WA;
    const unsigned char* img0 = p.ws + WS_HIMG + (size_t)chain * NCH * HIMG_BYTES;
    f32x4 S[8];
#pragma unroll
    for (int i = 0; i < 8; ++i) S[i] = (f32x4){0.f, 0.f, 0.f, 0.f};
    u32x4 rq[2][2], rk[2][2], rp[2], rd[2], rv[2][2];
#define HS_LOAD(c_, set_) do { const int cc_ = (c_); const unsigned char* im_ = img0 + (size_t)cc_ * HIMG_BYTES; \
        if (cc_ >= 4) { rq[set_][0] = *(const u32x4*)(im_ + HIMG_QD + tid * 16); rq[set_][1] = *(const u32x4*)(im_ + HIMG_QD + (tid + 512) * 16); rp[set_] = *(const u32x4*)(im_ + HIMG_P + tid * 16); } \
        rk[set_][0] = *(const u32x4*)(im_ + HIMG_KD + tid * 16); rk[set_][1] = *(const u32x4*)(im_ + HIMG_KD + (tid + 512) * 16); \
        if (tid < 32) rd[set_] = *(const u32x4*)(im_ + HIMG_D + tid * 16); \
        _Pragma("unroll") for (int e = 0; e < 2; ++e) { const int idx_ = tid * 2 + e; const size_t row_ = hg_row(dir, b, 64 * cc_ + (idx_ >> 4)); rv[set_][e] = *(const u32x4*)(IA + row_ * WA + 8 * (idx_ & 15)); } } while (0)
#define HS_STORE(c_, set_) do { const int cc_ = (c_); LAS unsigned char* bb_ = lds + (cc_ & 1) * SB_BYTES; \
        if (cc_ >= 4) { *(LAS u32x4*)(bb_ + SB_QD + (tid >> 3) * HP + 16 * (tid & 7)) = rq[set_][0]; *(LAS u32x4*)(bb_ + SB_QD + ((tid >> 3) + 64) * HP + 16 * (tid & 7)) = rq[set_][1]; \
                        *(LAS u32x4*)(bb_ + SB_P + (tid >> 3) * PP + 16 * (tid & 7)) = rp[set_]; } \
        *(LAS u32x4*)(bb_ + SB_KD + (tid >> 3) * HP + 16 * (tid & 7)) = rk[set_][0]; *(LAS u32x4*)(bb_ + SB_KD + ((tid >> 3) + 64) * HP + 16 * (tid & 7)) = rk[set_][1]; \
        if (tid < 32) *(LAS u32x4*)(bb_ + SB_D + 16 * tid) = rd[set_]; \
        _Pragma("unroll") for (int e = 0; e < 2; ++e) { const int idx_ = tid * 2 + e; *(LAS u32x4*)(bb_ + SB_V + (idx_ >> 4) * VP + 16 * (idx_ & 15)) = rv[set_][e]; } } while (0)
    HS_LOAD(0, 0); HS_LOAD(1, 1);
    HS_STORE(0, 0);
    HS_LOAD(2, 0);
    ATT_BAR();
#pragma unroll 1
    for (int c2 = 0; c2 < NCH; c2 += 2) {
#pragma unroll
    for (int uu = 0; uu < 2; ++uu) { const int c = c2 + uu;
        const LAS unsigned char* bb = lds + (c & 1) * SB_BYTES;
        const bool lat = (c >= 4);
        bf16x8 vf[2];
#pragma unroll
        for (int sp = 0; sp < 2; ++sp) {
            const LAS unsigned char* vb0 = bb + SB_V + (32 * sp + 4 * g + qq) * VP + (16 * wave + 4 * pp) * 2;
            vf[sp] = cat8(lds_tr(vb0), lds_tr(vb0 + 16 * VP));
        }
        if (lat) {
            bf16x8 sb[4];
#pragma unroll
            for (int ks = 0; ks < 4; ++ks) sb[ks] = pack_p(S[2 * ks], S[2 * ks + 1]);
            bf16* orow = O + (long)hg_row(dir, b, 64 * c) * WA;
#pragma unroll
            for (int I = 0; I < 4; ++I) {
                f32x4 o = (f32x4){0.f, 0.f, 0.f, 0.f};
#pragma unroll
                for (int ks = 0; ks < 4; ++ks) {
                    const LAS unsigned char* ap = bb + SB_QD + (32 * ks + 4 * g + qq) * HP + (16 * I + 4 * pp) * 2;
                    o = __builtin_amdgcn_mfma_f32_16x16x32_bf16(cat8(lds_tr(ap), lds_tr(ap + 16 * HP)), sb[ks], o, 0, 0, 0);
                }
#pragma unroll
                for (int sp = 0; sp < 2; ++sp) {
                    if (2 * sp > I) break;
                    const LAS unsigned char* pr = bb + SB_P + (16 * I + li) * PP + (32 * sp + 4 * g) * 2;
                    const u32x2 lo = *(const LAS u32x2*)pr; u32x2 hi = (u32x2){0u, 0u};
                    if (2 * sp + 1 <= I) hi = *(const LAS u32x2*)(pr + 32);
                    o = __builtin_amdgcn_mfma_f32_16x16x32_bf16(cat8u(lo, hi), vf[sp], o, 0, 0, 0);
                }
#pragma unroll
                for (int j = 0; j < 4; ++j) orow[(long)(16 * I + 4 * g + j) * ost] = (bf16)f2bf(o[j]);
            }
        }
#pragma unroll
        for (int blk = 0; blk < 8; ++blk) {
            const f32x4 d4 = *(const LAS f32x4*)(bb + SB_D + (16 * blk + 4 * g) * 4);
            f32x4 s = S[blk] * d4;
#pragma unroll
            for (int sp = 0; sp < 2; ++sp) {
                const LAS unsigned char* kp = bb + SB_KD + (16 * blk + li) * HP + (32 * sp + 4 * g) * 2;
                s = __builtin_amdgcn_mfma_f32_16x16x32_bf16(cat8u(*(const LAS u32x2*)kp, *(const LAS u32x2*)(kp + 32)), vf[sp], s, 0, 0, 0);
            }
            S[blk] = s;
        }
        if (c + 1 < NCH) HS_STORE(c + 1, (uu + 1) & 1);
        if (c + 3 < NCH) HS_LOAD(c + 3, (uu + 1) & 1);
        ATT_BAR();
    } }
#undef HS_LOAD
#undef HS_STORE
    __syncthreads();
}

__device__ __forceinline__ void phase_readout(const Params& p, int vb, int nb) {
    const int tid = tid_of(p.wave_id), lane = tid & 63, wave = p.wave_id;
    const bf16* OF = (const bf16*)p.out; const bf16* OB = OF + (size_t)ML * WA; const bf16* GA = (const bf16*)(p.ws + WS_GA);
    bf16* YA = (bf16*)p.out + (size_t)2 * ML * WA;
    for (int it = vb * 8 + wave; it < ML * NHEAD; it += nb * 8) {
        const int row = it / NHEAD, h = it % NHEAD; const size_t off = (size_t)row * WA + h * HD + 2 * lane;
        const unsigned a = *(const unsigned*)(OF + off), b = *(const unsigned*)(OB + off), g = *(const unsigned*)(GA + off);
        const float o0 = bflo(a) + bflo(b), o1 = bfhi(a) + bfhi(b);
        const float rstd = 1.0f / sqrtf(wave_sum(o0 * o0 + o1 * o1) * (1.0f / HD) + EPS);
        const float y0 = o0 * rstd * p.hgrn_norm_g[2 * lane] * bflo(g), y1 = o1 * rstd * p.hgrn_norm_g[2 * lane + 1] * bfhi(g);
        *(unsigned*)(YA + off) = pk2(y0, y1);
    }
}

__device__ __forceinline__ void phase_bias2(const Params& p, int vb, int nb) {
    const int tid = tid_of(p.wave_id); const float* mod = (const float*)(p.ws + WS_MOD); float* bias2 = (float*)(p.ws + WS_BIAS2);
    constexpr int NCC = 2 * FFN / 512, NKC = D_MODEL / 64;
    for (int item = vb; item < NCC * NKC; item += nb) {
        const int cc = item % NCC, kc = item / NCC; const int col = cc * 512 + tid;
        const float* W = (col < FFN) ? p.w1 + col : p.w3 + (col - FFN);
        float a0 = 0.f, a1 = 0.f, a2 = 0.f, a3 = 0.f;
#pragma unroll 8
        for (int k = kc * 64; k < kc * 64 + 64; ++k) { const float w = W[(size_t)k * FFN];
            a0 += w * mod[0 * IN_COLS + 3 * D_MODEL + k]; a1 += w * mod[1 * IN_COLS + 3 * D_MODEL + k]; a2 += w * mod[2 * IN_COLS + 3 * D_MODEL + k]; a3 += w * mod[3 * IN_COLS + 3 * D_MODEL + k]; }
        atomicAdd(bias2 + 0 * 2 * FFN + col, a0); atomicAdd(bias2 + 1 * 2 * FFN + col, a1); atomicAdd(bias2 + 2 * 2 * FFN + col, a2); atomicAdd(bias2 + 3 * 2 * FFN + col, a3);
    }
}

constexpr int LDS_MISC_OFF = 145408;
constexpr int LDS_BYTES = 146432;
static_assert(WS_BAR + XCD_BAR_WORDS * 4 <= WS_ROWSQ, "barrier words inside ctl");

#if defined(__HIP_DEVICE_COMPILE__)
#define LOAD_P() Params p; { const __attribute__((address_space(4))) Params* q_ = (const __attribute__((address_space(4))) Params*)__builtin_amdgcn_kernarg_segment_ptr(); asm volatile("" : "+s"(q_)); \
    p = *q_; p.wave_id = wave_id; } unsigned char* ws = p.ws; (void)ws
#else
#define LOAD_P() Params p = p_in; p.wave_id = wave_id; unsigned char* ws = p.ws; (void)ws
#endif
__global__ void __launch_bounds__(NTHREADS, 2) mega_fwd(Params p_in) {
    const int wave_id = __builtin_amdgcn_readfirstlane((int)(threadIdx.x >> 6));
    extern __shared__ __attribute__((aligned(16))) unsigned char lds_raw[];
    LAS unsigned char* lds = (LAS unsigned char*)lds_raw;
    const int nb = gridDim.x;
    const int vb = (nb % 8 == 0) ? ((int)(blockIdx.x % 8) * (nb / 8) + (int)(blockIdx.x / 8)) : (int)blockIdx.x;
    const int bx = blockIdx.x;
    volatile LAS unsigned* misc = (volatile LAS unsigned*)(lds + LDS_MISC_OFF);
    if (wave_id == 0) misc[lane_id()] = 0u;
    __syncthreads();
    XcdBarrier bar = xcd_barrier_post((unsigned*)(p_in.ws + WS_BAR), misc + 8, wave_id);
#define GRID_BAR() xcd_barrier(bar)

    { LOAD_P(); phase_mod(p, lds, vb, nb); __syncthreads(); phase_wconv_in(p, lds, vb * 8 + wave_id, nb * 8); }
    GRID_BAR();
    { LOAD_P(); phase_h(p, vb, nb); }
    GRID_BAR();
    { LOAD_P(); pg8::Gemm g{(const bf16*)(ws + WS_H), (const bf16*)(ws + WS_WINT), MT, IN_COLS, D_MODEL}; InProjOrder S; S.init(ML, IN_COLS, nb, bx);
      EpiInProj E{ws, lds, p.q_norm_g, p.k_norm_g}; pg8::gemm_phase<EpiInProj, InProjOrder, true, true>(lds, g, S, E, wave_id);
      const int nfree = nb - CTX_UNITS;
      if (nfree >= 64) { if (bx >= CTX_UNITS) phase_wconv_rest(p, lds, (bx - CTX_UNITS) * 8 + wave_id, nfree * 8); }
      else phase_wconv_rest(p, lds, bx * 8 + wave_id, nb * 8); }
    GRID_BAR();
    { LOAD_P(); hgrn_prep(p, lds, vb, nb); }
    GRID_BAR();
    { LOAD_P();
      if (bx < 2 * BATCH * NHEAD) hgrn_scan(p, lds, bx);
      __syncthreads();
      phase_attn(p, lds); }
    GRID_BAR();
    { LOAD_P(); phase_readout(p, vb, nb); }
    GRID_BAR();
    { LOAD_P(); pg8::Gemm g{(const bf16*)p.out + (size_t)2 * ML * WA, (const bf16*)(ws + WS_WAT), ML, D_MODEL, WA};
      MergeOrder S; S.init(ML, D_MODEL, nb, bx); S.A1 = (const bf16*)p.out + (size_t)3 * ML * WA; S.B1 = (const bf16*)(ws + WS_WBT);
      EpiMerge E{ws, (float*)(ws + WS_T1)}; pg8::gemm_phase<EpiMerge, MergeOrder, true, true>(lds, g, S, E, wave_id); }
    GRID_BAR();
    { LOAD_P(); pg8::Gemm g{(const bf16*)(ws + WS_Z), (const bf16*)(ws + WS_WOT), ML, D_MODEL, D_MODEL}; pg8::StaticOrder S; S.init(ML, D_MODEL, nb, bx);
      EpiOutProj E{ws, p.x, p.norm2_g, p.out}; pg8::gemm_phase<EpiOutProj, pg8::StaticOrder, true, true>(lds, g, S, E, wave_id); }
    GRID_BAR();
    { LOAD_P(); pg8::Gemm g{(const bf16*)(ws + WS_XMG), (const bf16*)(ws + WS_W13T), ML, 2 * FFN, D_MODEL}; pg8::StaticOrder S; S.init(ML, 2 * FFN, nb, bx);
      EpiFfnUp E{ws, lds, p.conv_w, p.conv_b}; pg8::gemm_phase<EpiFfnUp, pg8::StaticOrder, true, true>(lds, g, S, E, wave_id); }
    GRID_BAR();
    { LOAD_P(); { pg8::StaticOrder S0; S0.init(ML, D_MODEL, nb, bx); pg8::Unit u0; const int tid = tid_of(wave_id); for (int i = 0; S0.next(i, u0); ++i) halo_fix(p, u0.pm, tid); }
      asm volatile("s_waitcnt vmcnt(0)" ::: "memory"); __syncthreads();
      pg8::Gemm g{(const bf16*)(ws + WS_ACT), (const bf16*)(ws + WS_W2T), ML, D_MODEL, FFN}; pg8::StaticOrder S; S.init(ML, D_MODEL, nb, bx);
      EpiFfnDown E{ws, p.out}; pg8::gemm_phase<EpiFfnDown, pg8::StaticOrder, true, true>(lds, g, S, E, wave_id); }
#undef GRID_BAR
}

extern "C" void kernel_launch(void* const* d_in, const int* in_sizes, int n_in, void* d_out, int out_size, void* d_ws, size_t ws_size, hipStream_t stream) {
    static int grid = 0;
    if (grid == 0) {
        if (n_in != 22 || ws_size < WS_END || out_size != ML * D_MODEL) { fprintf(stderr, "kernel_launch: bad inputs (n_in %d, out %d, ws %zu, need %zu)\n", n_in, out_size, ws_size, (size_t)WS_END); grid = -1; return; }
        int dev = 0, cus = 0, per_cu = 0;
        if (hipGetDevice(&dev) != hipSuccess || hipDeviceGetAttribute(&cus, hipDeviceAttributeMultiprocessorCount, dev) != hipSuccess) { grid = -1; return; }
        if (hipFuncSetAttribute((const void*)mega_fwd, hipFuncAttributeMaxDynamicSharedMemorySize, LDS_BYTES) != hipSuccess) { fprintf(stderr, "kernel_launch: hipFuncSetAttribute failed\n"); grid = -1; return; }
        if (hipOccupancyMaxActiveBlocksPerMultiprocessor(&per_cu, (const void*)mega_fwd, NTHREADS, LDS_BYTES) != hipSuccess || per_cu < 1) { fprintf(stderr, "kernel_launch: occupancy query says %d blocks/CU\n", per_cu); (void)hipGetLastError(); grid = -1; return; }
        grid = cus;
        fprintf(stderr, "kernel_launch: grid %d (cus %d, occupancy %d/CU)\n", grid, cus, per_cu);
    }
    if (grid < 0) return;
    Params p{};
    const float** f = (const float**)&p;
    for (int i = 0; i < 22; ++i) f[i] = (const float*)d_in[i];
    p.out = (float*)d_out; p.ws = (unsigned char*)d_ws;
    (void)hipMemsetAsync((char*)d_ws + WS_CTL, 0, CTL_ZERO_BYTES, stream);
    hipLaunchKernelGGL(mega_fwd, dim3(grid), dim3(NTHREADS), LDS_BYTES, stream, p);
}
```

```cpp
#include <hip/hip_runtime.h>
#include <cstdio>
#include <cstdint>
#include <cmath>

__device__ __forceinline__ int lane_id() { int l; asm volatile("v_mbcnt_lo_u32_b32 %0, -1, 0\n\tv_mbcnt_hi_u32_b32 %0, -1, %0" : "=v"(l)); return l; }
__device__ __forceinline__ int tid_of(int wave_id) { int t = wave_id * 64 + lane_id(); asm volatile("" : "+v"(t)); return t; }
namespace pg8 {
#define PG8_LAS __attribute__((address_space(3)))
typedef unsigned short bf16_t;
typedef short bf16x8 __attribute__((ext_vector_type(8)));
typedef float f32x4 __attribute__((ext_vector_type(4)));
typedef unsigned u32x4 __attribute__((ext_vector_type(4)));
constexpr int BM = 256, BK = 64, HALF = 128, HTB = HALF * BK * 2  , STAGE_BYTES = 8 * HTB, NXCD = 8, WGM = 8;

__host__ __device__ __forceinline__ int lds_byte(int r, int c) { const int st = (r >> 4) * 2 + (c >> 5), rr = r & 15, cc = c & 31, ob = rr * 64 + cc * 2; return st * 1024 + (ob ^ (((ob >> 9) & 1) << 5)); }
__host__ __device__ __forceinline__ void stage_rc(int b, int& R, int& C) { const int st = b / 1024, sb = b % 1024, swz = sb ^ (((sb >> 9) & 1) << 5); R = (st >> 1) * 16 + swz / 64; C = (st & 1) * 32 + (swz % 64) / 2; }
__host__ __device__ __forceinline__ int perm32(int rho) { const int n = rho >> 4, i = rho & 15; return 8 * (i >> 2) + 4 * n + (i & 3); }

struct Unit { int pm, pn, br; };
struct Gemm { const bf16_t* A; const bf16_t* Bt; int M, N, K; };

struct StaticOrder {
    int nM, nN, nwg, G, c;
    __host__ __device__ void init(int M, int N, int G_, int c_) { nM = M / BM; nN = N / BM; nwg = nM * nN; G = G_; c = c_; }
    __host__ __device__ bool next(int i, Unit& u) const {
        const long L = (long)i * G + c; if (L >= nwg) return false;
        int wgid = (int)L; { const int q = nwg / NXCD, r = nwg % NXCD, xcd = wgid % NXCD, off = wgid / NXCD; wgid = (xcd < r ? xcd * (q + 1) : r * (q + 1) + (xcd - r) * q) + off; }
        const int nig = WGM * nN, gid = wgid / nig, fm = gid * WGM, gsz = (nM - fm) < WGM ? (nM - fm) : WGM;
        u.pm = fm + ((wgid % nig) % gsz); u.pn = (wgid % nig) / gsz; u.br = 0; return true;
    }
    __device__ __forceinline__ const char* a_base(const Gemm& g, const Unit& u, size_t tstep) const { return (const char*)g.A + (size_t)u.pm * tstep; }
    __device__ __forceinline__ const char* b_base(const Gemm& g, const Unit& u, size_t tstep) const { return (const char*)g.Bt + (size_t)u.pn * tstep; }
    __device__ __forceinline__ void a_ready(const Unit&) const {}
    __device__ __forceinline__ void done(const Unit&) const {}
};

template <class Epi, class Sched, bool ALIGN_EPI = false, bool SP2 = false>
__device__ __forceinline__ void gemm_phase(PG8_LAS unsigned char* lds, const Gemm g, const Sched& S, const Epi& E, const int wave_id_in) {
    int tid_o = tid_of(wave_id_in);
    const int tid = tid_o, wid = __builtin_amdgcn_readfirstlane(tid >> 6), lane = tid & 63, wr = wid >> 2, wc = wid & 3, fr = lane & 15, fq = lane >> 4;
    const int K = g.K, nt = K / BK;
    unsigned voffA[2], voffB[2];
#pragma unroll
    for (int i = 0; i < 2; ++i) { int R, C; stage_rc(tid * 16 + i * 8192, R, C); const int Rb = Epi::PERM ? ((R & ~31) + perm32(R & 31)) : R;
        voffA[i] = (unsigned)(R * K + C) * 2u; voffB[i] = (unsigned)(Rb * K + C) * 2u; }
    const size_t kstep = (size_t)(BK * 2);
    const size_t hstep = (size_t)HALF * K * 2;
    const size_t tstep = 2 * hstep;
    const unsigned ldsw = (unsigned)wid * 1024u;
    const int aoff = lds_byte(wr * 64 + fr, fq * 8), boff = lds_byte(wc * 32 + fr, fq * 8);
#define PG8_SA(b, h) (((b) * 2 + (h)) * HTB)
#define PG8_SB(b, h) ((4 + (b) * 2 + (h)) * HTB)
#define PG8_STAGE(bufoff, gbase, voff) do { _Pragma("unroll") for (int _i = 0; _i < 2; ++_i) \
        __builtin_amdgcn_global_load_lds((const unsigned*)((const char*)(gbase) + (voff)[_i]), (PG8_LAS unsigned*)(lds + (bufoff) + ldsw + _i * 8192), 16, 0, 0); } while (0)
#define PG8_LDA(dst, b, h) do { _Pragma("unroll") for (int m = 0; m < 4; ++m) _Pragma("unroll") for (int k = 0; k < 2; ++k) dst[m][k] = *(const PG8_LAS bf16x8*)(lds + PG8_SA(b, h) + aoff + m * 2048 + k * 1024); } while (0)
#define PG8_LDB(dst, b, h) do { _Pragma("unroll") for (int n = 0; n < 2; ++n) _Pragma("unroll") for (int k = 0; k < 2; ++k) dst[n][k] = *(const PG8_LAS bf16x8*)(lds + PG8_SB(b, h) + boff + n * 2048 + k * 1024); } while (0)
#define PG8_MMA(ai, bj, At, Bt) do { __builtin_amdgcn_s_setprio(1); _Pragma("unroll") for (int m = 0; m < 4; ++m) _Pragma("unroll") for (int n = 0; n < 2; ++n) _Pragma("unroll") for (int k = 0; k < 2; ++k) \
        acc[ai][bj][m][n] = __builtin_amdgcn_mfma_f32_16x16x32_bf16(Bt[n][k], At[m][k], acc[ai][bj][m][n], 0, 0, 0); __builtin_amdgcn_s_setprio(0); } while (0)
#define PG8_WAIT_V(n) asm volatile("s_waitcnt vmcnt(" #n ")" ::: "memory")
#define PG8_WAIT_L(n) asm volatile("s_waitcnt lgkmcnt(" #n ")" ::: "memory")
#define PG8_BAR __builtin_amdgcn_s_barrier()
#define PG8_SCHED __builtin_amdgcn_sched_barrier(0)
    Unit cur, nxt; int ui = 0;
    if (!S.next(0, cur)) return;
    f32x4 acc[2][2][4][2];
#pragma unroll
    for (int a = 0; a < 2; ++a)
#pragma unroll
        for (int b = 0; b < 2; ++b)
#pragma unroll
            for (int m = 0; m < 4; ++m)
#pragma unroll
                for (int n = 0; n < 2; ++n) acc[a][b][m][n] = (f32x4){0.f, 0.f, 0.f, 0.f};
    bf16x8 At[4][2], B0[2][2], B1[2][2];
    const char* cA = S.a_base(g, cur, tstep); const char* cB = S.b_base(g, cur, tstep);
    S.a_ready(cur);
    if constexpr (SP2) {
        PG8_STAGE(PG8_SB(0, 0), cB, voffB); PG8_STAGE(PG8_SB(0, 1), cB + hstep, voffB); PG8_STAGE(PG8_SA(0, 0), cA, voffA); PG8_STAGE(PG8_SA(0, 1), cA + hstep, voffA);
        if (wr == 1) PG8_BAR;
        PG8_WAIT_V(2); PG8_BAR;
        PG8_STAGE(PG8_SB(1, 0), cB + kstep, voffB); PG8_STAGE(PG8_SA(1, 0), cA + kstep, voffA); PG8_STAGE(PG8_SB(1, 1), cB + hstep + kstep, voffB);
        PG8_WAIT_V(6); PG8_BAR;
    } else {
        PG8_STAGE(PG8_SB(0, 0), cB, voffB); PG8_STAGE(PG8_SA(0, 0), cA, voffA); PG8_STAGE(PG8_SB(0, 1), cB + hstep, voffB); PG8_STAGE(PG8_SA(0, 1), cA + hstep, voffA);
        if (wr == 1) PG8_BAR;
        PG8_WAIT_V(4); PG8_BAR;
        PG8_STAGE(PG8_SB(1, 0), cB + kstep, voffB); PG8_STAGE(PG8_SA(1, 0), cA + kstep, voffA); PG8_STAGE(PG8_SB(1, 1), cB + hstep + kstep, voffB);
        PG8_WAIT_V(6); PG8_BAR;
    }
    for (;;) {
        const bool has_next = S.next(ui + 1, nxt);
        const char* nA = has_next ? S.a_base(g, nxt, tstep) : cA; const char* nB = has_next ? S.b_base(g, nxt, tstep) : cB;
        for (int t = 0; t < nt; t += 2) {
            const bool last = (t == nt - 2);
            const char* a1 = cA + (size_t)(t + 1) * kstep;
            const char* a2 = last ? nA : cA + (size_t)(t + 2) * kstep; const char* b2 = last ? nB : cB + (size_t)(t + 2) * kstep;
            const char* a3 = a2 + kstep; const char* b3 = b2 + kstep;
            if (last && has_next) S.a_ready(nxt);
            if constexpr (SP2) {
            PG8_LDB(B0, 0, 0); PG8_LDB(B1, 0, 1); PG8_SCHED; PG8_LDA(At, 0, 0); PG8_STAGE(PG8_SA(1, 1), a1 + hstep, voffA);
            PG8_WAIT_V(8); PG8_WAIT_L(0); PG8_BAR; PG8_MMA(0, 0, At, B0); PG8_MMA(0, 1, At, B1); PG8_BAR; PG8_SCHED;
            PG8_LDA(At, 0, 1); PG8_STAGE(PG8_SB(0, 0), b2, voffB); PG8_STAGE(PG8_SB(0, 1), b2 + hstep, voffB); PG8_STAGE(PG8_SA(0, 0), a2, voffA);
            PG8_WAIT_V(8); PG8_WAIT_L(0); PG8_BAR; PG8_MMA(1, 0, At, B0); PG8_MMA(1, 1, At, B1); PG8_BAR; PG8_SCHED;
            PG8_LDB(B0, 1, 0); PG8_LDB(B1, 1, 1); PG8_SCHED; PG8_LDA(At, 1, 0); PG8_STAGE(PG8_SA(0, 1), a2 + hstep, voffA);
            PG8_WAIT_V(8); PG8_WAIT_L(0); PG8_BAR; PG8_MMA(0, 0, At, B0); PG8_MMA(0, 1, At, B1); PG8_BAR; PG8_SCHED;
            PG8_LDA(At, 1, 1); PG8_STAGE(PG8_SB(1, 0), b3, voffB); PG8_STAGE(PG8_SB(1, 1), b3 + hstep, voffB); PG8_STAGE(PG8_SA(1, 0), a3, voffA);
            PG8_WAIT_V(8); PG8_WAIT_L(0); PG8_BAR; PG8_MMA(1, 0, At, B0); PG8_MMA(1, 1, At, B1); PG8_BAR; PG8_SCHED;
            } else {
            PG8_LDB(B0, 0, 0); PG8_SCHED; PG8_LDA(At, 0, 0); PG8_STAGE(PG8_SA(1, 1), a1 + hstep, voffA);
            PG8_WAIT_L(8); PG8_BAR; PG8_WAIT_L(0); PG8_MMA(0, 0, At, B0); PG8_BAR; PG8_SCHED;
            PG8_LDB(B1, 0, 1); PG8_STAGE(PG8_SB(0, 0), b2, voffB);
            PG8_BAR; PG8_WAIT_L(0); PG8_MMA(0, 1, At, B1); PG8_BAR;
            PG8_LDA(At, 0, 1); PG8_STAGE(PG8_SA(0, 0), a2, voffA);
            PG8_BAR; PG8_WAIT_L(0); PG8_MMA(1, 0, At, B0); PG8_BAR; PG8_SCHED;
            PG8_STAGE(PG8_SB(0, 1), b2 + hstep, voffB);
            PG8_WAIT_V(6); PG8_BAR; PG8_MMA(1, 1, At, B1); PG8_BAR;
            PG8_LDB(B0, 1, 0); PG8_SCHED; PG8_LDA(At, 1, 0); PG8_STAGE(PG8_SA(0, 1), a2 + hstep, voffA);
            PG8_WAIT_L(8); PG8_BAR; PG8_WAIT_L(0); PG8_MMA(0, 0, At, B0); PG8_BAR; PG8_SCHED;
            PG8_LDB(B1, 1, 1); PG8_STAGE(PG8_SB(1, 0), b3, voffB);
            PG8_BAR; PG8_WAIT_L(0); PG8_MMA(0, 1, At, B1); PG8_BAR;
            PG8_LDA(At, 1, 1); PG8_STAGE(PG8_SA(1, 0), a3, voffA);
            PG8_BAR; PG8_WAIT_L(0); PG8_MMA(1, 0, At, B0); PG8_BAR; PG8_SCHED;
            PG8_STAGE(PG8_SB(1, 1), b3 + hstep, voffB);
            PG8_WAIT_V(6); PG8_BAR; PG8_MMA(1, 1, At, B1); PG8_BAR;
            }
        }
        if constexpr (ALIGN_EPI) { if (wr == 0) PG8_BAR; }
        if constexpr (!Epi::AFTER_DRAIN) { E(acc, cur, wr, wc, fr, fq); S.done(cur); }
        if (!has_next) break;
#pragma unroll
        for (int a = 0; a < 2; ++a)
#pragma unroll
            for (int b = 0; b < 2; ++b)
#pragma unroll
                for (int m = 0; m < 4; ++m)
#pragma unroll
                    for (int n = 0; n < 2; ++n) acc[a][b][m][n] = (f32x4){0.f, 0.f, 0.f, 0.f};
        cur = nxt; cA = nA; cB = nB; ++ui;
        if constexpr (ALIGN_EPI) { if (wr == 1) PG8_BAR; }
    }
    PG8_WAIT_V(0);
    if constexpr (!ALIGN_EPI) { if (wr == 0) PG8_BAR; }
    PG8_BAR;
    if constexpr (Epi::AFTER_DRAIN) { E.fused(acc, cur, wr, wc, fr, fq, lds, wid, lane); S.done(cur); }
#undef PG8_SA
#undef PG8_SB
#undef PG8_STAGE
#undef PG8_LDA
#undef PG8_LDB
#undef PG8_MMA
#undef PG8_WAIT_V
#undef PG8_WAIT_L
#undef PG8_BAR
#undef PG8_SCHED
}
}

constexpr int D_MODEL = 2048, BATCH = 4, SEQ = 2048, CTX = 256, GRID_W = 64, NHEAD = 8, HD = 128, WA = 1024;
constexpr int FFN = 5632, IN_COLS = 12288, NMOD = 6;
constexpr int ML = BATCH * SEQ;
constexpr int MC = BATCH * CTX;
constexpr int MT = ML + MC;
constexpr float EPS = 1e-6f;
constexpr int NTHREADS = 512;
constexpr int VT_PITCH = SEQ + CTX;

typedef unsigned short bf16;
typedef float f32x4 __attribute__((ext_vector_type(4)));
typedef unsigned u32x2 __attribute__((ext_vector_type(2)));
typedef unsigned u32x4 __attribute__((ext_vector_type(4)));
#define LAS __attribute__((address_space(3)))

typedef float f32x2_t __attribute__((ext_vector_type(2)));
typedef __bf16 bf16x2_t __attribute__((ext_vector_type(2)));
__device__ __forceinline__ unsigned pk2(float lo, float hi) { const f32x2_t v = {lo, hi}; const bf16x2_t b = __builtin_convertvector(v, bf16x2_t); return __builtin_bit_cast(unsigned, b); }
__device__ __forceinline__ unsigned f2bf(float f) { return pk2(f, 0.f) & 0xffffu; }
__device__ __forceinline__ float bf2f(unsigned short h) { return __builtin_bit_cast(float, (unsigned)h << 16); }
__device__ __forceinline__ float bflo(unsigned w) { return __builtin_bit_cast(float, w << 16); }
__device__ __forceinline__ float bfhi(unsigned w) { return __builtin_bit_cast(float, w & 0xffff0000u); }
__device__ __forceinline__ float sigmoidf_(float x) { return __builtin_amdgcn_rcpf(1.0f + __expf(-x)); }
__device__ __forceinline__ float siluf_(float x) { return x * __builtin_amdgcn_rcpf(1.0f + __expf(-x)); }
__device__ __forceinline__ float wave_sum(float v) {
#pragma unroll
    for (int o = 1; o < 64; o <<= 1) v += __shfl_xor(v, o);
    return v;
}
__device__ __forceinline__ float wave_max(float v) {
#pragma unroll
    for (int o = 1; o < 64; o <<= 1) v = fmaxf(v, __shfl_xor(v, o));
    return v;
}

constexpr size_t al256(size_t x) { return (x + 255) & ~(size_t)255; }
constexpr size_t WS_CTL   = 0;
constexpr size_t CTL_ZERO_BYTES = 1u << 20;
constexpr size_t WS_ROWSQ = 64 * 1024;
constexpr size_t WS_BIAS2 = WS_ROWSQ + (size_t)ML * 4;
static_assert(WS_BIAS2 + (size_t)4 * 2 * FFN * 4 <= CTL_ZERO_BYTES, "ctl");
constexpr size_t WS_MOD   = CTL_ZERO_BYTES;
constexpr size_t WS_LB    = al256(WS_MOD + (size_t)5 * IN_COLS * 4);
constexpr size_t WS_ROPE  = al256(WS_LB + 2 * WA * 4);
constexpr size_t WS_SMALL_END = al256(WS_ROPE + 2 * 64 * 32 * 4);
constexpr size_t WS_W13T  = al256(WS_SMALL_END);
constexpr size_t WS_W2T   = WS_W13T + (size_t)2 * FFN * D_MODEL * 2;
constexpr size_t WS_WAT   = WS_W2T + (size_t)D_MODEL * FFN * 2;
constexpr size_t WS_WBT   = WS_WAT + (size_t)D_MODEL * WA * 2;
constexpr size_t WS_WOT   = WS_WBT + (size_t)D_MODEL * WA * 2;
constexpr size_t WS_A_END = WS_WOT + (size_t)D_MODEL * D_MODEL * 2;
constexpr size_t SEGB = (size_t)MT * WA * 2;
constexpr size_t WS_QA  = WS_A_END;
constexpr size_t WS_FW  = WS_QA + SEGB;
constexpr size_t WS_FB  = WS_FW + 2 * SEGB;
constexpr size_t WS_IA  = WS_FB + 2 * SEGB;
constexpr size_t WS_GA  = WS_IA + SEGB;
constexpr size_t WS_QN  = WS_GA + (size_t)ML * WA * 2;
constexpr size_t WS_KN  = WS_QN + (size_t)ML * WA * 2;
constexpr size_t WS_VN  = WS_KN + SEGB;
constexpr size_t WS_GTA = WS_VN + SEGB;
constexpr size_t WS_GTB = WS_GTA + (size_t)ML * D_MODEL * 2;
constexpr size_t WS_D_END = WS_GTB + (size_t)ML * D_MODEL * 2;
constexpr size_t WS_WINT = WS_D_END;
constexpr size_t WS_OF   = WS_WINT;
constexpr size_t WS_OB   = WS_OF + (size_t)ML * WA * 2;
constexpr size_t WS_B_END = WS_WINT + (size_t)IN_COLS * D_MODEL * 2;
static_assert(WS_OB + (size_t)ML * WA * 2 <= WS_B_END, "B");
constexpr size_t WS_H   = WS_B_END;
constexpr size_t WS_YA  = WS_H;
constexpr size_t WS_YB  = WS_YA + (size_t)ML * WA * 2;
constexpr size_t WS_C_END = WS_H + (size_t)MT * D_MODEL * 2;
constexpr size_t WS_ACT_END = WS_D_END + (size_t)ML * FFN * 2;
constexpr size_t WS_HIMG = WS_WINT;
constexpr size_t WS_HIMG_END = WS_HIMG + (size_t)64 * 36 * 41472;
constexpr size_t WS_T1 = WS_WINT;
constexpr size_t WS_END0 = WS_C_END > WS_ACT_END ? WS_C_END : WS_ACT_END;
constexpr size_t WS_END = WS_END0 > WS_HIMG_END ? WS_END0 : WS_HIMG_END;
static_assert(WS_END <= 445000000, "ws budget");
constexpr size_t WS_Z   = WS_QA;
constexpr size_t WS_XMG = WS_GTB;
constexpr size_t WS_HALO = WS_QA;
static_assert(WS_HALO + (size_t)32 * 6 * FFN * 4 <= WS_XMG, "HALO overlay");
constexpr size_t WS_ACT = WS_WINT;
static_assert(WS_ACT + (size_t)ML * FFN * 2 <= WS_END, "ACT overlay");

struct Params {
    const float *x, *c, *ctx, *c_ctx, *ada_w, *ada_b, *norm1_g, *norm2_g, *w_in, *lb_logits, *hgrn_norm_g, *q_norm_g, *k_norm_g, *rel_bias,
                *w_a, *w_b, *w_o, *w1, *w3, *conv_w, *conv_b, *w2;
    float* out;
    unsigned char* ws;
    int wave_id, pad;
};

template <bool QKPERM, bool BIAS>
__device__ __forceinline__ void transpose_item(const float* W, int K, int N, bf16* WT, int row_off, LAS float* scr, int item, int lane, const float* sh2 = nullptr, float* bias2 = nullptr) {
    const int nblk = N / 32, kb = item / nblk, nb = item % nblk, k0 = 64 * kb, n0 = 32 * nb;
    if (BIAS) row_off += (n0 >> 7) * 128;
    float wv[32];
#pragma unroll
    for (int i = 0; i < 32; ++i) wv[i] = W[(size_t)(k0 + 2 * i + (lane >> 5)) * N + n0 + (lane & 31)];
#pragma unroll
    for (int i = 0; i < 32; ++i) scr[(2 * i + (lane >> 5)) * 33 + (lane & 31)] = wv[i];
    if (BIAS) {
        float a0 = 0.f, a1 = 0.f, a2 = 0.f, a3 = 0.f;
#pragma unroll
        for (int i = 0; i < 32; ++i) { const int k = k0 + 2 * i + (lane >> 5); const float w = wv[i];
            a0 += w * sh2[0 * IN_COLS + k]; a1 += w * sh2[1 * IN_COLS + k]; a2 += w * sh2[2 * IN_COLS + k]; a3 += w * sh2[3 * IN_COLS + k]; }
        a0 += __shfl_xor(a0, 32); a1 += __shfl_xor(a1, 32); a2 += __shfl_xor(a2, 32); a3 += __shfl_xor(a3, 32);
        if (lane < 32) { float* bp = bias2 + row_off + n0 + lane; atomicAdd(bp, a0); atomicAdd(bp + 2 * FFN, a1); atomicAdd(bp + 4 * FFN, a2); atomicAdd(bp + 6 * FFN, a3); }
    }
    asm volatile("s_waitcnt lgkmcnt(0)" ::: "memory");
    const int c = lane & 7;
#pragma unroll
    for (int j = 0; j < 4; ++j) { const int n = (lane >> 3) + 8 * j; const LAS float* s = scr + (8 * c) * 33 + n;
        u32x4 o; o.x = pk2(s[0 * 33], s[1 * 33]); o.y = pk2(s[2 * 33], s[3 * 33]); o.z = pk2(s[4 * 33], s[5 * 33]); o.w = pk2(s[6 * 33], s[7 * 33]);
        int cdst = n0 + n;
        if (QKPERM && cdst >= 5 * WA && cdst < 7 * WA) cdst = (cdst & ~0x30) | ((cdst & 0x10) << 1) | ((cdst & 0x20) >> 1);
        *(u32x4*)(WT + (size_t)(row_off + cdst) * K + k0 + 8 * c) = o; }
    asm volatile("s_waitcnt lgkmcnt(0)" ::: "memory");
}
__device__ __forceinline__ void phase_wconv_in(const Params& p, LAS unsigned char* lds, int gw, int NGW) {
    const int lane = lane_id(), wave = p.wave_id;
    LAS float* scr = (LAS float*)(lds + wave * 16384);
    constexpr int I_IN = (D_MODEL / 64) * (IN_COLS / 32);
    for (int it = gw; it < I_IN; it += NGW) transpose_item<true, false>(p.w_in, D_MODEL, IN_COLS, (bf16*)(p.ws + WS_WINT), 0, scr, it, lane);
}
__device__ __forceinline__ void phase_wconv_rest(const Params& p, LAS unsigned char* lds, int gw, int NGW) {
    const int lane = lane_id(), wave = p.wave_id;
    LAS float* scr = (LAS float*)(lds + 16384 + wave * 16384);
    constexpr int I_A = (WA / 64) * (D_MODEL / 32), I_O = (D_MODEL / 64) * (D_MODEL / 32), I_1 = (D_MODEL / 64) * (FFN / 32), I_2 = (FFN / 64) * (D_MODEL / 32);
    constexpr int NITEMS = 2 * I_A + I_O + 2 * I_1 + I_2;
    unsigned char* ws = p.ws;
    const float* sh2 = (const float*)(ws + WS_MOD) + 3 * D_MODEL; float* b2 = (float*)(ws + WS_BIAS2);
    for (int it = gw; it < NITEMS; it += NGW) {
        int r = it;
        if (r < I_A) { transpose_item<false, false>(p.w_a, WA, D_MODEL, (bf16*)(ws + WS_WAT), 0, scr, r, lane); continue; } r -= I_A;
        if (r < I_A) { transpose_item<false, false>(p.w_b, WA, D_MODEL, (bf16*)(ws + WS_WBT), 0, scr, r, lane); continue; } r -= I_A;
        if (r < I_O) { transpose_item<false, false>(p.w_o, D_MODEL, D_MODEL, (bf16*)(ws + WS_WOT), 0, scr, r, lane); continue; } r -= I_O;
        if (r < I_1) { transpose_item<false, true>(p.w1, D_MODEL, FFN, (bf16*)(ws + WS_W13T), 0, scr, r, lane, sh2, b2); continue; } r -= I_1;
        if (r < I_1) { transpose_item<false, true>(p.w3, D_MODEL, FFN, (bf16*)(ws + WS_W13T), 128, scr, r, lane, sh2, b2); continue; } r -= I_1;
        transpose_item<false, false>(p.w2, FFN, D_MODEL, (bf16*)(ws + WS_W2T), 0, scr, r, lane);
    }
}

__device__ __forceinline__ void phase_mod(const Params& p, LAS unsigned char* lds, int vb, int nb) {
    const int tid = tid_of(p.wave_id);
    LAS float* sc = (LAS float*)lds;
    LAS float* red = (LAS float*)(lds + 5 * 2048 * 4);
    for (int i = tid; i < 5 * D_MODEL; i += NTHREADS) { const int r = i / D_MODEL, k = i % D_MODEL; const float v = (r < 4) ? p.c[r * D_MODEL + k] : p.c_ctx[k]; sc[i] = siluf_(v); }
    __syncthreads();
    float* mod = (float*)(p.ws + WS_MOD);
    const int c4 = tid & 15, kp = tid >> 4;
    for (int item = vb; item < IN_COLS / 64; item += nb) {
        const int n0 = item * 64 + c4 * 4;
        f32x4 acc[5];
#pragma unroll
        for (int r = 0; r < 5; ++r) acc[r] = (f32x4){0.f, 0.f, 0.f, 0.f};
#pragma unroll 8
        for (int k = kp; k < D_MODEL; k += 32) {
            const f32x4 w = *(const f32x4*)(p.ada_w + (size_t)k * IN_COLS + n0);
#pragma unroll
            for (int r = 0; r < 5; ++r) acc[r] += w * sc[r * D_MODEL + k];
        }
#pragma unroll
        for (int r = 0; r < 5; ++r) *(LAS f32x4*)(red + (kp * 5 + r) * 64 + c4 * 4) = acc[r];
        __syncthreads();
        if (tid < 320) { const int r = tid / 64, cidx = tid % 64; float s = 0.f;
            for (int q = 0; q < 32; ++q) s += red[(q * 5 + r) * 64 + cidx];
            mod[r * IN_COLS + item * 64 + cidx] = s + p.ada_b[item * 64 + cidx]; }
        __syncthreads();
    }
    if (vb == nb - 1) { float* rt = (float*)(p.ws + WS_ROPE);
        for (int i = tid; i < 64 * 32; i += NTHREADS) { const int pos = i >> 5, j = i & 31; const float inv = exp2f(-(float)j * (13.287712379549449f / 32.0f)); float sn, cs; sincosf((float)pos * inv, &sn, &cs); rt[i] = cs; rt[2048 + i] = sn; } }
    if (vb == 0) { float* lb = (float*)(p.ws + WS_LB);
        for (int i = tid; i < 2 * WA; i += NTHREADS) { const int d = i / WA, cc = i % WA; const float l0 = p.lb_logits[d * 2 * WA + cc], l1 = p.lb_logits[d * 2 * WA + WA + cc]; lb[i] = 1.0f / (1.0f + expf(l1 - l0)); } }
}

__device__ __forceinline__ void phase_h(const Params& p, int vb, int nb) {
    const int tid = tid_of(p.wave_id), lane = tid & 63, wave = p.wave_id;
    const float* mod = (const float*)(p.ws + WS_MOD);
    bf16* H = (bf16*)(p.ws + WS_H);
    for (int m = vb * 8 + wave; m < MT; m += nb * 8) {
        const float* xr = (m < ML) ? p.x + (size_t)m * D_MODEL : p.ctx + (size_t)(m - ML) * D_MODEL;
        const int mr = (m < ML) ? (m / SEQ) : 4;
        const float* sh = mod + (size_t)mr * IN_COLS, *scl = sh + D_MODEL;
        f32x4 v[8]; float s = 0.f;
#pragma unroll
        for (int j = 0; j < 8; ++j) { v[j] = *(const f32x4*)(xr + 4 * lane + 256 * j); s += (v[j].x * v[j].x + v[j].y * v[j].y) + (v[j].z * v[j].z + v[j].w * v[j].w); }
        const float rstd = __builtin_amdgcn_rsqf(wave_sum(s) * (1.0f / D_MODEL) + EPS);
#pragma unroll
        for (int j = 0; j < 8; ++j) { const int k = 4 * lane + 256 * j;
            const f32x4 g = *(const f32x4*)(p.norm1_g + k), a = *(const f32x4*)(scl + k), b = *(const f32x4*)(sh + k);
            const f32x4 h = v[j] * rstd * g * (a + 1.0f) + b;
            u32x2 o; o.x = pk2(h.x, h.y); o.y = pk2(h.z, h.w);
            *(u32x2*)(H + (size_t)m * D_MODEL + k) = o; }
    }
}

#define EPI_LOOP_BEGIN \
    _Pragma("unroll") for (int ai = 0; ai < 2; ++ai) _Pragma("unroll") for (int m = 0; m < 4; ++m) { const int row = u.pm * 256 + ai * 128 + wr * 64 + m * 16 + fr; \
    _Pragma("unroll") for (int bj = 0; bj < 2; ++bj) _Pragma("unroll") for (int n = 0; n < 2; ++n) { const int col = u.pn * 256 + bj * 128 + wc * 32 + n * 16 + fq * 4; const f32x4 v = acc[ai][bj][m][n];
#define EPI_LOOP_END } }

struct EpiInProj {
    static constexpr bool PERM = false, AFTER_DRAIN = false;
    unsigned char* ws; LAS unsigned char* lds; const float* qg; const float* kg;
    __device__ __forceinline__ void operator()(const f32x4 (&acc)[2][2][4][2], const pg8::Unit& u, int wr, int wc, int fr, int fq) const {
        const int seg = u.pn >> 2;
        const bool ctxrow = u.pm >= ML / 256;
        const float* lb = (const float*)(ws + WS_LB);
        if (seg == 1 || seg == 2) {
            float* F = (float*)(ws + (seg == 1 ? WS_FW : WS_FB)); const float* lbd = lb + (seg - 1) * WA;
            EPI_LOOP_BEGIN
                const int c = col - seg * WA; const f32x4 l = *(const f32x4*)(lbd + c); f32x4 o;
                o.x = __logf(l.x + (1.0f - l.x) * sigmoidf_(v.x)); o.y = __logf(l.y + (1.0f - l.y) * sigmoidf_(v.y));
                o.z = __logf(l.z + (1.0f - l.z) * sigmoidf_(v.z)); o.w = __logf(l.w + (1.0f - l.w) * sigmoidf_(v.w));
                *(f32x4*)(F + (size_t)row * WA + c) = o;
            EPI_LOOP_END
        } else if (seg == 7) {
            bf16* VT = (bf16*)(ws + WS_VN);
            EPI_LOOP_BEGIN
                const int c = col - 7 * WA; const int hh = c >> 7, d = c & 127;
                int bb, tok; if (row < ML) { bb = row / SEQ; tok = row % SEQ; } else { bb = (row - ML) / CTX; tok = SEQ + (row - ML) % CTX; }
                bf16* o = VT + ((size_t)(bb * NHEAD + hh) * HD + d) * VT_PITCH + tok;
                o[0] = (bf16)f2bf(v.x); o[VT_PITCH] = (bf16)f2bf(v.y); o[2 * VT_PITCH] = (bf16)f2bf(v.z); o[3 * VT_PITCH] = (bf16)f2bf(v.w);
            EPI_LOOP_END
        } else if (seg == 5 || seg == 6) {
            if (ctxrow && seg == 5) return;
            LAS float* ssq = (LAS float*)(lds + 131072);
            const float* gn = (seg == 5) ? qg : kg; const float* rt = (const float*)(ws + WS_ROPE);
            bf16* O = (bf16*)(ws + (seg == 5 ? WS_QN : WS_KN));
#pragma unroll
            for (int ai = 0; ai < 2; ++ai)
#pragma unroll
                for (int m = 0; m < 4; ++m)
#pragma unroll
                    for (int bj = 0; bj < 2; ++bj) { const f32x4 a = acc[ai][bj][m][0], b = acc[ai][bj][m][1];
                        float sq = (a.x * a.x + a.y * a.y) + (a.z * a.z + a.w * a.w) + (b.x * b.x + b.y * b.y) + (b.z * b.z + b.w * b.w);
                        sq += __shfl_xor(sq, 16); sq += __shfl_xor(sq, 32);
                        if (fq == 0) ssq[((ai * 128 + wr * 64 + m * 16 + fr) * 2 + bj) * 4 + wc] = sq; }
            asm volatile("s_waitcnt lgkmcnt(0)" ::: "memory"); __builtin_amdgcn_s_barrier(); asm volatile("" ::: "memory");
            const int H = wc >> 1, jj = 16 * (wc & 1) + 4 * fq;
            const f32x4 g0 = *(const f32x4*)(gn + 64 * H + jj), g1 = *(const f32x4*)(gn + 64 * H + 32 + jj);
#pragma unroll
            for (int ai = 0; ai < 2; ++ai)
#pragma unroll
                for (int m = 0; m < 4; ++m) { const int rl = ai * 128 + wr * 64 + m * 16 + fr; const int row = u.pm * 256 + rl;
                    f32x4 cs = (f32x4){1.f, 1.f, 1.f, 1.f}, sn = (f32x4){0.f, 0.f, 0.f, 0.f};
                    if (!ctxrow) { const int t = row & (SEQ - 1); const int pos = (H == 0) ? (t >> 6) : (t & 63); cs = *(const f32x4*)(rt + pos * 32 + jj); sn = *(const f32x4*)(rt + 2048 + pos * 32 + jj); }
#pragma unroll
                    for (int bj = 0; bj < 2; ++bj) { const f32x4 s4 = *(const LAS f32x4*)(ssq + (rl * 2 + bj) * 4);
                        const float rstd = __builtin_amdgcn_rsqf(((s4.x + s4.y) + (s4.z + s4.w)) * (1.0f / HD) + EPS);
                        const f32x4 u1 = acc[ai][bj][m][0] * rstd * g0, u2 = acc[ai][bj][m][1] * rstd * g1;
                        const f32x4 o1 = u1 * cs - u2 * sn, o2 = u1 * sn + u2 * cs;
                        bf16* op = O + (size_t)row * WA + (u.pn & 3) * 256 + bj * 128 + wc * 32 + fq * 4;
                        u32x2 w1; w1.x = pk2(o1.x, o1.y); w1.y = pk2(o1.z, o1.w); *(u32x2*)op = w1;
                        u32x2 w2; w2.x = pk2(o2.x, o2.y); w2.y = pk2(o2.z, o2.w); *(u32x2*)(op + 16) = w2; }
                    asm volatile("" ::: "memory"); }
            asm volatile("s_waitcnt lgkmcnt(0)" ::: "memory"); __builtin_amdgcn_s_barrier(); asm volatile("" ::: "memory");
        } else if (seg == 0 || seg == 3) {
            if (ctxrow && seg == 0) return;
            bf16* O = (bf16*)(ws + (seg == 0 ? WS_QA : WS_IA));
            EPI_LOOP_BEGIN
                const int c = col - seg * WA; u32x2 o; o.x = pk2(v.x, v.y); o.y = pk2(v.z, v.w);
                *(u32x2*)(O + (size_t)row * WA + c) = o;
            EPI_LOOP_END
        } else if (seg == 4) {
            if (ctxrow) return;
            bf16* O = (bf16*)(ws + WS_GA);
            EPI_LOOP_BEGIN
                const int c = col - seg * WA; u32x2 o; o.x = pk2(siluf_(v.x), siluf_(v.y)); o.y = pk2(siluf_(v.z), siluf_(v.w));
                *(u32x2*)(O + (size_t)row * WA + c) = o;
            EPI_LOOP_END
        } else {
            if (ctxrow) return;
            const bool isa = seg < 10;
            bf16* O = (bf16*)(ws + (isa ? WS_GTA : WS_GTB)); const int cbase = isa ? 8 * WA : 10 * WA;
            EPI_LOOP_BEGIN
                const int c = col - cbase; u32x2 o; o.x = pk2(sigmoidf_(v.x), sigmoidf_(v.y)); o.y = pk2(sigmoidf_(v.z), sigmoidf_(v.w));
                *(u32x2*)(O + (size_t)row * D_MODEL + c) = o;
            EPI_LOOP_END
        }
    }
};

constexpr int CTX_UNITS = (MC / 256) * 20;
struct InProjOrder : pg8::StaticOrder {
    __device__ bool next(int i, pg8::Unit& u) const {
        if (pg8::StaticOrder::next(i, u)) return true;
        const long L = (long)i * G + c - nwg; if (L < 0 || L >= CTX_UNITS) return false;
        const int t = (int)L, j = t % 20; u.pm = ML / 256 + t / 20; u.pn = (j < 12) ? 4 + j : 12 + j; u.br = 0; return true; }
};
struct MergeOrder : pg8::StaticOrder {
    const bf16* A1; const bf16* B1;
    __device__ bool next(int i, pg8::Unit& u) const { if (!pg8::StaticOrder::next(i >> 1, u)) return false; u.br = i & 1; return true; }
    __device__ __forceinline__ const char* a_base(const pg8::Gemm& g, const pg8::Unit& u, size_t tstep) const { return (const char*)(u.br ? A1 : g.A) + (size_t)u.pm * tstep; }
    __device__ __forceinline__ const char* b_base(const pg8::Gemm& g, const pg8::Unit& u, size_t tstep) const { return (const char*)(u.br ? B1 : g.Bt) + (size_t)u.pn * tstep; }
};
struct EpiMerge {
    static constexpr bool PERM = false, AFTER_DRAIN = false;
    unsigned char* ws; float* tmp;
    __device__ __forceinline__ void operator()(const f32x4 (&acc)[2][2][4][2], const pg8::Unit& u, int wr, int wc, int fr, int fq) const {
        if (u.br == 0) {
            const bf16* G = (const bf16*)(ws + WS_GTA);
            EPI_LOOP_BEGIN
                const u32x2 g = *(const u32x2*)(G + (size_t)row * D_MODEL + col);
                f32x4 o; o.x = bflo(g.x) * v.x; o.y = bfhi(g.x) * v.y; o.z = bflo(g.y) * v.z; o.w = bfhi(g.y) * v.w;
                *(f32x4*)(tmp + (size_t)row * D_MODEL + col) = o;
            EPI_LOOP_END
        } else {
            const bf16* G = (const bf16*)(ws + WS_GTB); bf16* Z = (bf16*)(ws + WS_Z);
            EPI_LOOP_BEGIN
                const u32x2 g = *(const u32x2*)(G + (size_t)row * D_MODEL + col);
                const f32x4 t = *(const f32x4*)(tmp + (size_t)row * D_MODEL + col);
                u32x2 o; o.x = pk2(t.x + bflo(g.x) * v.x, t.y + bfhi(g.x) * v.y); o.y = pk2(t.z + bflo(g.y) * v.z, t.w + bfhi(g.y) * v.w);
                *(u32x2*)(Z + (size_t)row * D_MODEL + col) = o;
            EPI_LOOP_END
        }
    }
};
struct EpiOutProj {
    static constexpr bool PERM = false, AFTER_DRAIN = false;
    unsigned char* ws; const float* x; const float* norm2_g; float* out;
    __device__ __forceinline__ void operator()(const f32x4 (&acc)[2][2][4][2], const pg8::Unit& u, int wr, int wc, int fr, int fq) const {
        const float* mod = (const float*)(ws + WS_MOD); bf16* XMG = (bf16*)(ws + WS_XMG); float* rowsq = (float*)(ws + WS_ROWSQ);
        const int b = (u.pm * 256) / SEQ;
        const float* g1 = mod + (size_t)b * IN_COLS + 2 * D_MODEL, *sc2 = mod + (size_t)b * IN_COLS + 4 * D_MODEL;
#pragma unroll
        for (int ai = 0; ai < 2; ++ai)
#pragma unroll
            for (int m = 0; m < 4; ++m) { const int row = u.pm * 256 + ai * 128 + wr * 64 + m * 16 + fr; float ss = 0.f;
#pragma unroll
                for (int bj = 0; bj < 2; ++bj)
#pragma unroll
                    for (int n = 0; n < 2; ++n) { const int col = u.pn * 256 + bj * 128 + wc * 32 + n * 16 + fq * 4; const f32x4 v = acc[ai][bj][m][n];
                        const f32x4 xv = *(const f32x4*)(x + (size_t)row * D_MODEL + col), g = *(const f32x4*)(g1 + col);
                        const f32x4 xm = xv + g * v;
                        *(f32x4*)(out + (size_t)row * D_MODEL + col) = xm;
                        ss += (xm.x * xm.x + xm.y * xm.y) + (xm.z * xm.z + xm.w * xm.w);
                        const f32x4 ng = *(const f32x4*)(norm2_g + col), s2 = *(const f32x4*)(sc2 + col);
                        const f32x4 h = xm * ng * (s2 + 1.0f);
                        u32x2 o; o.x = pk2(h.x, h.y); o.y = pk2(h.z, h.w);
                        *(u32x2*)(XMG + (size_t)row * D_MODEL + col) = o; }
                ss += __shfl_xor(ss, 16); ss += __shfl_xor(ss, 32);
                if (fq == 0) atomicAdd(rowsq + row, ss); }
    }
};
__device__ __forceinline__ float dpp_ror1(float v) { return __builtin_bit_cast(float, __builtin_amdgcn_update_dpp(0, __builtin_bit_cast(int, v), 0x121, 0xf, 0xf, false)); }
__device__ __forceinline__ float dpp_rol1(float v) { return __builtin_bit_cast(float, __builtin_amdgcn_update_dpp(0, __builtin_bit_cast(int, v), 0x12f, 0xf, 0xf, false)); }
__device__ __forceinline__ f32x4 ror1_4(const f32x4 v) { return (f32x4){dpp_ror1(v.x), dpp_ror1(v.y), dpp_ror1(v.z), dpp_ror1(v.w)}; }
__device__ __forceinline__ f32x4 rol1_4(const f32x4 v) { return (f32x4){dpp_rol1(v.x), dpp_rol1(v.y), dpp_rol1(v.z), dpp_rol1(v.w)}; }
struct EpiFfnUp {
    static constexpr bool PERM = false, AFTER_DRAIN = false;
    unsigned char* ws; LAS unsigned char* lds; const float* cw; const float* cb;
    __device__ __forceinline__ void operator()(const f32x4 (&acc_c)[2][2][4][2], const pg8::Unit& u, int wr, int wc, int fr, int fq) const {
        f32x4 (&acc)[2][2][4][2] = const_cast<f32x4 (&)[2][2][4][2]>(acc_c);
        const float* rowsq = (const float*)(ws + WS_ROWSQ); bf16* ACT = (bf16*)(ws + WS_ACT); float* HALO = (float*)(ws + WS_HALO) + (size_t)u.pm * 6 * FFN;
        const int b = (u.pm * 256) / SEQ; const float* bias2 = (const float*)(ws + WS_BIAS2) + (size_t)b * 2 * FFN + u.pn * 256;
        const int cl = wc * 32 + fq * 4, ch0 = u.pn * 128 + cl;
        LAS float* X = (LAS float*)(lds + 131072);
#pragma unroll
        for (int ai = 0; ai < 2; ++ai)
#pragma unroll
            for (int m = 0; m < 4; ++m) { const int row = u.pm * 256 + ai * 128 + wr * 64 + m * 16 + fr;
                const float rstd = __builtin_amdgcn_rsqf(rowsq[row] * (1.0f / D_MODEL) + EPS);
#pragma unroll
                for (int bj = 0; bj < 2; ++bj)
#pragma unroll
                    for (int n = 0; n < 2; ++n) acc[ai][bj][m][n] = acc[ai][bj][m][n] * rstd + *(const f32x4*)(bias2 + bj * 128 + cl + 16 * n); }
#pragma unroll
        for (int ai = 0; ai < 2; ++ai) { const int bi = 2 * ai + wr;
            if (fr == 0) {
#pragma unroll
                for (int n = 0; n < 2; ++n) *(LAS f32x4*)(X + (bi * 2 + 0) * 128 + cl + 16 * n) = acc[ai][0][0][n]; }
            if (fr == 15) {
#pragma unroll
                for (int n = 0; n < 2; ++n) *(LAS f32x4*)(X + (bi * 2 + 1) * 128 + cl + 16 * n) = acc[ai][0][3][n]; } }
        asm volatile("s_waitcnt lgkmcnt(0)" ::: "memory"); __builtin_amdgcn_s_barrier(); asm volatile("" ::: "memory");
        if (wr == 0 && fr < 2) {
#pragma unroll
            for (int n = 0; n < 2; ++n) { *(f32x4*)(HALO + (size_t)fr * FFN + ch0 + 16 * n) = acc[0][0][0][n]; if (fr == 0) *(f32x4*)(HALO + (size_t)4 * FFN + ch0 + 16 * n) = acc[0][1][0][n]; } }
        if (wr == 1 && fr >= 14) {
#pragma unroll
            for (int n = 0; n < 2; ++n) { *(f32x4*)(HALO + (size_t)(fr - 12) * FFN + ch0 + 16 * n) = acc[1][0][3][n]; if (fr == 15) *(f32x4*)(HALO + (size_t)5 * FFN + ch0 + 16 * n) = acc[1][1][3][n]; } }
#pragma unroll
        for (int n = 0; n < 2; ++n) {
            const f32x4 w0 = *(const f32x4*)(cw + ch0 + 16 * n), w1 = *(const f32x4*)(cw + FFN + ch0 + 16 * n), w2 = *(const f32x4*)(cw + 2 * FFN + ch0 + 16 * n), cbv = *(const f32x4*)(cb + ch0 + 16 * n);
#pragma unroll
            for (int ai = 0; ai < 2; ++ai) { const int bi = 2 * ai + wr;
                const f32x4 xprev = (bi > 0) ? *(const LAS f32x4*)(X + ((bi - 1) * 2 + 1) * 128 + cl + 16 * n) : (f32x4){0.f, 0.f, 0.f, 0.f};
                const f32x4 xnext = (bi < 3) ? *(const LAS f32x4*)(X + ((bi + 1) * 2 + 0) * 128 + cl + 16 * n) : (f32x4){0.f, 0.f, 0.f, 0.f};
#pragma unroll
                for (int m = 0; m < 4; ++m) { const f32x4 cur = acc[ai][0][m][n];
                    const f32x4 pu = (m > 0) ? ror1_4(acc[ai][0][m > 0 ? m - 1 : 0][n]) : xprev; const f32x4 ps = ror1_4(cur);
                    const f32x4 nd = (m < 3) ? rol1_4(acc[ai][0][m < 3 ? m + 1 : 3][n]) : xnext; const f32x4 ns = rol1_4(cur);
                    const f32x4 prev = (fr > 0) ? ps : pu, next = (fr < 15) ? ns : nd;
                    const f32x4 uu = w0 * prev + w1 * cur + w2 * next + cbv; const f32x4 gt = acc[ai][1][m][n];
                    f32x4 r; r.x = siluf_(uu.x) * gt.x; r.y = siluf_(uu.y) * gt.y; r.z = siluf_(uu.z) * gt.z; r.w = siluf_(uu.w) * gt.w;
                    const int rl = ai * 128 + wr * 64 + m * 16 + fr;
                    if (rl != 0 && rl != 255) { u32x2 o; o.x = pk2(r.x, r.y); o.y = pk2(r.z, r.w); *(u32x2*)(ACT + (size_t)(u.pm * 256 + rl) * FFN + ch0 + 16 * n) = o; } } } }
    }
};
__device__ __forceinline__ void halo_fix(const Params& p, int pm, int tid) {
    const float* HB = (const float*)(p.ws + WS_HALO); const float* H = HB + (size_t)pm * 6 * FFN; bf16* ACT = (bf16*)(p.ws + WS_ACT);
    for (int ch = tid; ch < FFN; ch += NTHREADS) {
        const float w0 = p.conv_w[ch], w1 = p.conv_w[FFN + ch], w2 = p.conv_w[2 * FFN + ch], cbv = p.conv_b[ch];
        const float pv = (pm & 7) ? HB[((size_t)(pm - 1) * 6 + 3) * FFN + ch] : 0.f; const float nx = ((pm & 7) != 7) ? HB[((size_t)(pm + 1) * 6 + 0) * FFN + ch] : 0.f;
        const float ut = w0 * pv + w1 * H[ch] + w2 * H[FFN + ch] + cbv; const float ub = w0 * H[2 * FFN + ch] + w1 * H[3 * FFN + ch] + w2 * nx + cbv;
        ACT[(size_t)(pm * 256) * FFN + ch] = (bf16)f2bf(siluf_(ut) * H[4 * FFN + ch]); ACT[(size_t)(pm * 256 + 255) * FFN + ch] = (bf16)f2bf(siluf_(ub) * H[5 * FFN + ch]);
    }
}
struct EpiFfnDown {
    static constexpr bool PERM = false, AFTER_DRAIN = false;
    unsigned char* ws; float* out;
    __device__ __forceinline__ void operator()(const f32x4 (&acc)[2][2][4][2], const pg8::Unit& u, int wr, int wc, int fr, int fq) const {
        const float* mod = (const float*)(ws + WS_MOD); const int b = (u.pm * 256) / SEQ; const float* g2 = mod + (size_t)b * IN_COLS + 5 * D_MODEL;
        EPI_LOOP_BEGIN
            float* o = out + (size_t)row * D_MODEL + col; const f32x4 xm = *(const f32x4*)o, g = *(const f32x4*)(g2 + col);
            *(f32x4*)o = xm + g * v;
        EPI_LOOP_END
    }
};

#define XB_TMO      128
#define XB_XCNT(j)  (256  + 64 * (j))
#define XB_XSUB(j)  (1280 + 64 * (j))
#define XB_XGEN(j)  (2304 + 64 * (j))
#define XB_TOP      3328
#define XB_TOPGEN   3392
#define XCD_BAR_WORDS 3456
#define XB_SPIN_CAP (1u << 18)

__device__ __forceinline__ unsigned xb_ld(unsigned* p)              { return __hip_atomic_load(p, __ATOMIC_RELAXED, __HIP_MEMORY_SCOPE_AGENT); }
__device__ __forceinline__ unsigned xb_add(unsigned* p, unsigned v) { return __hip_atomic_fetch_add(p, v, __ATOMIC_RELAXED, __HIP_MEMORY_SCOPE_AGENT); }
__device__ __forceinline__ unsigned xb_xcc_id() { return (unsigned)__builtin_amdgcn_s_getreg((3 << 11) | 20) & 0xFu; }
#define XB_SPIN(cond, bar) do { unsigned _sp = 0; while (cond) { __builtin_amdgcn_s_sleep(1); \
    if ((++_sp & 255u) == 0u) { if (xb_ld(&(bar)[XB_TMO])) break; if (_sp > XB_SPIN_CAP) { atomicAdd(&(bar)[XB_TMO], 1u); break; } } } } while (0)

struct XcdBarrier {
    unsigned* bar; unsigned x; int wave;
    volatile LAS unsigned* st;
};

__device__ __forceinline__ XcdBarrier xcd_barrier_post(unsigned* bar, volatile LAS unsigned* st, int wave_id) {
    XcdBarrier b; b.bar = bar; b.x = xb_xcc_id(); b.st = st; b.wave = wave_id;
    if (wave_id == 0 && lane_id() == 0) (void)xb_add(&bar[XB_XCNT(b.x)], 1u);
    return b;
}
__device__ __forceinline__ void xcd_barrier_complete(unsigned* bar, unsigned x, unsigned& nloc, unsigned& nx) {
    const unsigned G = gridDim.x * gridDim.y * gridDim.z;
    unsigned sum, cnt, mine, sp = 0u;
    for (;;) {
        sum = 0u; cnt = 0u; mine = 0u;
#pragma unroll
        for (unsigned j = 0; j < 16; ++j) { const unsigned c = xb_ld(&bar[XB_XCNT(j)]); sum += c; cnt += (c > 0u) ? 1u : 0u; mine = (j == x) ? c : mine; }
        if (sum == G) break;
        __builtin_amdgcn_s_sleep(1);
        if ((++sp & 255u) == 0u) { if (xb_ld(&bar[XB_TMO])) break; if (sp > XB_SPIN_CAP) { atomicAdd(&bar[XB_TMO], 1u); break; } }
    }
    nloc = mine > 0u ? mine : 1u; nx = cnt > 0u ? cnt : 1u;
}

__device__ __forceinline__ void xcd_barrier(const XcdBarrier& b) {
    asm volatile("s_waitcnt vmcnt(0)" ::: "memory");
    __syncthreads();
    if (b.wave == 0 && lane_id() == 0) {
        unsigned* bar = b.bar;
        __builtin_amdgcn_s_waitcnt(0);
        unsigned nloc = b.st[0], nx = b.st[1];
        if (nloc == 0u) { xcd_barrier_complete(bar, b.x, nloc, nx); b.st[0] = nloc; b.st[1] = nx; }
        const unsigned old = xb_add(&bar[XB_XSUB(b.x)], 1u);
        const unsigned gen = old / nloc;
        if (old + 1u == (gen + 1u) * nloc) {
            __builtin_amdgcn_fence(__ATOMIC_RELEASE, "agent");
            asm volatile("s_waitcnt vmcnt(0)" ::: "memory");
            const unsigned og = xb_add(&bar[XB_TOP], 1u);
            const unsigned tg = og / nx;
            if (og + 1u == (tg + 1u) * nx) xb_add(&bar[XB_TOPGEN], 1u);
            else XB_SPIN(xb_ld(&bar[XB_TOPGEN]) == tg, bar);
            __builtin_amdgcn_fence(__ATOMIC_ACQUIRE, "agent");
            xb_add(&bar[XB_XGEN(b.x)], 1u);
            asm volatile("s_waitcnt vmcnt(0)" ::: "memory");
        } else {
            XB_SPIN(xb_ld(&bar[XB_XGEN(b.x)]) == gen, bar);
            __builtin_amdgcn_fence(__ATOMIC_ACQUIRE, "agent");
            asm volatile("s_waitcnt vmcnt(0)" ::: "memory");
        }
    }
    __syncthreads();
}

constexpr size_t WS_BAR = 8192;

typedef short bf16x8 __attribute__((ext_vector_type(8)));
typedef short s16x4 __attribute__((ext_vector_type(4)));

__device__ __forceinline__ bf16x8 cat8u(const u32x2 a, const u32x2 b) { const u32x4 w = (u32x4){a.x, a.y, b.x, b.y}; return __builtin_bit_cast(bf16x8, w); }
__device__ __forceinline__ bf16x8 pack_p(const f32x4 a, const f32x4 b) {
    u32x4 w; w.x = pk2(a.x, a.y); w.y = pk2(a.z, a.w); w.z = pk2(b.x, b.y); w.w = pk2(b.z, b.w);
    return __builtin_bit_cast(bf16x8, w);
}

constexpr int A_TILE = 32768, A_KOFF = 0, A_VOFF = 16384;
constexpr int A_BIAS = 4 * A_TILE;
constexpr int A_ITEM = A_BIAS + 2048;
static_assert(A_ITEM + 64 <= 145408, "attention LDS");
constexpr size_t WS_ATTCTR = 32768;
static_assert(WS_ATTCTR >= WS_BAR + XCD_BAR_WORDS * 4 && WS_ATTCTR + 8 * 256 <= WS_ROWSQ, "attn counters (8 x 256 B apart) inside ctl");
#define ATT_BAR() do { asm volatile("s_waitcnt lgkmcnt(0)" ::: "memory"); __builtin_amdgcn_s_barrier(); asm volatile("" ::: "memory"); } while (0)

__device__ __forceinline__ void phase_attn(const Params& p, LAS unsigned char* lds) {
    int tid_o = tid_of(p.wave_id);
    const int tid = tid_o, lane = tid & 63, wave = __builtin_amdgcn_readfirstlane(tid >> 6);
    const int qb = wave & 3, dh = wave >> 2, li = lane & 15, g = lane >> 4;
    const bf16* QN = (const bf16*)(p.ws + WS_QN); const bf16* KN = (const bf16*)(p.ws + WS_KN); const bf16* VT = (const bf16*)(p.ws + WS_VN);
    bf16* YB = (bf16*)p.out + (size_t)3 * ML * WA;
    unsigned* ctr = (unsigned*)(p.ws + WS_ATTCTR);
    LAS float* btab = (LAS float*)(lds + A_BIAS);
    const float scale = 0.08838834764831845f;
    int krow_l[2], kch_l[2], vrow_l[2], vch_l[2];
#pragma unroll
    for (int e = 0; e < 2; ++e) { const int pk = 2 * wave + e; krow_l[e] = 4 * pk + (lane >> 4); kch_l[e] = (lane & 15) ^ (krow_l[e] & 15);
        vrow_l[e] = 8 * pk + (lane >> 3); vch_l[e] = (lane & 7) ^ ((vrow_l[e] >> 1) & 7); }
    const int myx = (int)(xb_xcc_id() & 7u);
    int qoff = 0;
    for (;;) {
        if (tid == 0) { unsigned v = 0xffffffffu;
            while (qoff < 8) { const int qx = (myx + qoff) & 7; const unsigned n = atomicAdd(ctr + 64 * qx, 1u); if (n < 128u) { v = (unsigned)((qx + 8 * (n >> 5)) * 32 + (n & 31)); break; } ++qoff; }
            *(LAS unsigned*)(lds + A_ITEM) = v; }
        __syncthreads();
        const unsigned itu = *(LAS unsigned*)(lds + A_ITEM);
        if (itu == 0xffffffffu) break;
        const int it = (int)itu;
        const int r = it & 31, h = (it >> 5) & 7, b = it >> 8;
        const int rs = min(max(r - 4, 0), 24), ks0 = min(max(16 * qb - 8, 0), 32);
        const int cq = 16 * qb + li, cs = min(max(cq - 8, 0), 48);
        const size_t qrow = (size_t)b * SEQ + r * GRID_W + cq;
        if (tid < 15 * 31) btab[tid] = p.rel_bias[h * 465 + tid];
        bf16x8 qf[4];
#pragma unroll
        for (int ks = 0; ks < 4; ++ks) qf[ks] = *(const bf16x8*)(QN + qrow * WA + h * HD + 32 * ks + 8 * g);
        asm volatile("s_waitcnt vmcnt(0)" ::: "memory");
        const bf16* kg0 = KN + (size_t)h * HD + (size_t)krow_l[0] * WA + 8 * kch_l[0]; const bf16* kg1 = KN + (size_t)h * HD + (size_t)krow_l[1] * WA + 8 * kch_l[1];
        const bf16* vg0 = VT + ((size_t)(b * NHEAD + h) * HD + vrow_l[0]) * VT_PITCH + 8 * vch_l[0]; const bf16* vg1 = VT + ((size_t)(b * NHEAD + h) * HD + vrow_l[1]) * VT_PITCH + 8 * vch_l[1];
#define ATT_DMA(ti_) do { const int t_ = (ti_) < 12 ? (ti_) : 11; LAS unsigned char* bb_ = lds + ((ti_) & 3) * A_TILE + wave * 2048; \
            const size_t krow0 = (t_ < 8) ? ((size_t)b * SEQ + (rs + t_) * GRID_W) : ((size_t)ML + b * CTX + 64 * (t_ - 8)); \
            const int tok0 = (t_ < 8) ? ((rs + t_) * GRID_W) : (SEQ + 64 * (t_ - 8)); \
            __builtin_amdgcn_global_load_lds((const unsigned*)(kg0 + krow0 * WA), (LAS unsigned*)(bb_ + A_KOFF), 16, 0, 0); \
            __builtin_amdgcn_global_load_lds((const unsigned*)(kg1 + krow0 * WA), (LAS unsigned*)(bb_ + A_KOFF + 1024), 16, 0, 0); \
            __builtin_amdgcn_global_load_lds((const unsigned*)(vg0 + tok0), (LAS unsigned*)(bb_ + A_VOFF), 16, 0, 0); \
            __builtin_amdgcn_global_load_lds((const unsigned*)(vg1 + tok0), (LAS unsigned*)(bb_ + A_VOFF + 1024), 16, 0, 0); } while (0)
        ATT_DMA(0); ATT_DMA(1); ATT_DMA(2);
        f32x4 ot[4];
#pragma unroll
        for (int db = 0; db < 4; ++db) ot[db] = (f32x4){0.f, 0.f, 0.f, 0.f};
        float mrun = -1e30f, l = 0.f;
        const int kx = (ks0 + li) & 15, vy = (li >> 1) & 7;
        int koff[4];
#pragma unroll
        for (int ks = 0; ks < 4; ++ks) koff[ks] = A_KOFF + (ks0 + li) * 256 + (((4 * ks + g) ^ kx) << 4);
        const int vrow_off = A_VOFF + (64 * dh + li) * 128 + 8 * (g & 1);
        const int gq = g >> 1;
#pragma unroll 1
        for (int ti = 0; ti < 12; ++ti) {
            asm volatile("s_waitcnt vmcnt(8)" ::: "memory");
            ATT_BAR();
            ATT_DMA(ti + 3);
            const LAS unsigned char* tb = lds + (ti & 3) * A_TILE;
            if (ti < 8) {
                f32x4 st[2];
#pragma unroll
                for (int kb = 0; kb < 2; ++kb) { f32x4 a = (f32x4){0.f, 0.f, 0.f, 0.f};
#pragma unroll
                    for (int ks = 0; ks < 4; ++ks) a = __builtin_amdgcn_mfma_f32_16x16x32_bf16(*(const LAS bf16x8*)(tb + koff[ks] + kb * 4096), qf[ks], a, 0, 0, 0);
                    st[kb] = a; }
                const int dr = rs + ti - r + 7; float gm = -1e30f;
#pragma unroll
                for (int kb = 0; kb < 2; ++kb)
#pragma unroll
                    for (int j = 0; j < 4; ++j) { const int kcol = ks0 + 16 * kb + 4 * g + j; const bool valid = (kcol >= cs) && (kcol < cs + 16);
                        const int bi = valid ? (dr * 31 + (kcol - cq + 15)) : 0;
                        const float sv = valid ? (st[kb][j] * scale + btab[bi]) : -1e30f; st[kb][j] = sv; gm = fmaxf(gm, sv); }
                gm = fmaxf(gm, __shfl_xor(gm, 16)); gm = fmaxf(gm, __shfl_xor(gm, 32));
                const float mnew = fmaxf(mrun, gm); const float alpha = __expf(mrun - mnew); mrun = mnew; l *= alpha;
#pragma unroll
                for (int db = 0; db < 4; ++db) ot[db] = ot[db] * alpha;
#pragma unroll
                for (int kb = 0; kb < 2; ++kb)
#pragma unroll
                    for (int j = 0; j < 4; ++j) { const float sv = st[kb][j]; const float e = (sv > -1e29f) ? __expf(sv - mnew) : 0.f; st[kb][j] = e; l += e; }
                const bf16x8 pb = pack_p(st[0], st[1]);
                const int c0 = (ks0 >> 3) + gq;
#pragma unroll
                for (int db = 0; db < 4; ++db) { const LAS unsigned char* vp = tb + vrow_off + db * 2048;
                    ot[db] = __builtin_amdgcn_mfma_f32_16x16x32_bf16(cat8u(*(const LAS u32x2*)(vp + ((c0 ^ vy) << 4)), *(const LAS u32x2*)(vp + (((c0 + 2) ^ vy) << 4))), pb, ot[db], 0, 0, 0); }
            } else {
                f32x4 st[4];
#pragma unroll
                for (int kb = 0; kb < 4; ++kb) { f32x4 a = (f32x4){0.f, 0.f, 0.f, 0.f};
#pragma unroll
                    for (int ks = 0; ks < 4; ++ks) a = __builtin_amdgcn_mfma_f32_16x16x32_bf16(*(const LAS bf16x8*)(tb + A_KOFF + (16 * kb + li) * 256 + (((4 * ks + g) ^ li) << 4)), qf[ks], a, 0, 0, 0);
                    st[kb] = a * scale; }
                float gm = -1e30f;
#pragma unroll
                for (int kb = 0; kb < 4; ++kb) gm = fmaxf(fmaxf(gm, fmaxf(st[kb][0], st[kb][1])), fmaxf(st[kb][2], st[kb][3]));
                gm = fmaxf(gm, __shfl_xor(gm, 16)); gm = fmaxf(gm, __shfl_xor(gm, 32));
                const float mnew = fmaxf(mrun, gm); const float alpha = __expf(mrun - mnew); mrun = mnew; l *= alpha;
#pragma unroll
                for (int db = 0; db < 4; ++db) ot[db] = ot[db] * alpha;
#pragma unroll
                for (int kb = 0; kb < 4; ++kb)
#pragma unroll
                    for (int j = 0; j < 4; ++j) { const float e = __expf(st[kb][j] - mnew); st[kb][j] = e; l += e; }
#pragma unroll
                for (int kp2 = 0; kp2 < 2; ++kp2) { const bf16x8 pb = pack_p(st[2 * kp2], st[2 * kp2 + 1]);
                    const int c0 = 4 * kp2 + gq;
#pragma unroll
                    for (int db = 0; db < 4; ++db) { const LAS unsigned char* vp = tb + vrow_off + db * 2048;
                        ot[db] = __builtin_amdgcn_mfma_f32_16x16x32_bf16(cat8u(*(const LAS u32x2*)(vp + ((c0 ^ vy) << 4)), *(const LAS u32x2*)(vp + (((c0 + 2) ^ vy) << 4))), pb, ot[db], 0, 0, 0); } }
            }
        }
        asm volatile("s_waitcnt vmcnt(0)" ::: "memory");
        l += __shfl_xor(l, 16); l += __shfl_xor(l, 32);
        const float inv = 1.0f / l;
#pragma unroll
        for (int db = 0; db < 4; ++db) { const f32x4 o = ot[db] * inv; u32x2 w; w.x = pk2(o.x, o.y); w.y = pk2(o.z, o.w);
            *(u32x2*)(YB + qrow * WA + h * HD + 64 * dh + 16 * db + 4 * g) = w; }
#undef ATT_DMA
    }
}

constexpr int HP = 160;
constexpr int H_QH = 0, H_KH = 20480, H_KE = 40960, H_QD = 61440, H_KD = 81920;
constexpr int HP2 = 48;
constexpr int H_Q2 = 102400, H_K2 = 108544;
constexpr int PP = 144;
constexpr int H_P = 114688;
constexpr int H_T = 123904;
constexpr int H_D = 125952;
constexpr int HIMG_QD = 0, HIMG_KD = 16384, HIMG_P = 32768, HIMG_D = 40960, HIMG_BYTES = 41472;
constexpr int NCH = (CTX + SEQ) / 64;
constexpr int VP = 288;
constexpr int HPK = 136;
constexpr int SB_QD = 0, SB_KD = 20480, SB_P = 40960, SB_D = 50176, SB_V = 50688, SB_BYTES = 69120;
static_assert(2 * SB_BYTES <= 145408, "scan buffers");

__device__ __forceinline__ s16x4 lds_tr(LAS const unsigned char* p) {
    return __builtin_bit_cast(s16x4, __builtin_amdgcn_ds_read_tr16_b64_v4i16((LAS s16x4*)p));
}
__device__ __forceinline__ bf16x8 cat8(const s16x4 a, const s16x4 b) { return __builtin_shufflevector(a, b, 0, 1, 2, 3, 4, 5, 6, 7); }

__device__ __forceinline__ size_t hg_row(int dir, int b, int tau) {
    if (tau < CTX) return (size_t)ML + b * CTX + (dir == 0 ? tau : CTX - 1 - tau);
    const int t = tau - CTX; return (size_t)b * SEQ + (dir == 0 ? t : SEQ - 1 - t);
}

__device__ __forceinline__ void hgrn_prep(const Params& p, LAS unsigned char* lds, int vb, int nb) {
    int tid_o = tid_of(p.wave_id);
    const int tid = tid_o, lane = tid & 63, wave = __builtin_amdgcn_readfirstlane(tid >> 6);
    const int k = tid & 127, J = __builtin_amdgcn_readfirstlane(tid >> 7);
    const int li = lane & 15, g = lane >> 4, qq = li >> 2, pp = li & 3;
    LAS float* Tl = (LAS float*)(lds + H_T); LAS float* Dl = (LAS float*)(lds + H_D);
    float lf[16]; unsigned qv[16];
#define HG_LOADP(idx_) do { const int id_ = (idx_); const int ch_ = id_ / NCH, cc_ = id_ % NCH; const int dir_ = ch_ / (BATCH * NHEAD), b_ = (ch_ / NHEAD) % BATCH, h_ = ch_ % NHEAD; \
        const size_t row0_ = hg_row(dir_, b_, 64 * cc_ + 16 * J); const long st_ = dir_ ? -(long)WA : (long)WA; \
        const float* lfp_ = (const float*)(p.ws + (dir_ == 0 ? WS_FW : WS_FB)) + row0_ * WA + h_ * HD + k; const bf16* qp_ = (const bf16*)(p.ws + WS_QA) + row0_ * WA + h_ * HD + k; \
        _Pragma("unroll") for (int i = 0; i < 16; ++i) { lf[i] = lfp_[(long)i * st_]; qv[i] = (cc_ >= 4) ? (unsigned)qp_[(long)i * st_] : 0u; } } while (0)
    if (vb < 64 * NCH) HG_LOADP(vb);
    for (int idx = vb; idx < 64 * NCH; idx += nb) {
        const int c = idx % NCH;
        float cum[16]; float run = 0.f;
#pragma unroll
        for (int i = 0; i < 16; ++i) { run += lf[i]; cum[i] = run; }
        Tl[J * 128 + k] = run;
        ATT_BAR();
        const float T0 = Tl[k], T1 = Tl[128 + k], T2 = Tl[256 + k], T3 = Tl[384 + k];
        const float bJ = (J > 0 ? T0 : 0.f) + (J > 1 ? T1 : 0.f) + (J > 2 ? T2 : 0.f);
        const float tail = (J < 1 ? T1 : 0.f) + (J < 2 ? T2 : 0.f) + (J < 3 ? T3 : 0.f);
        const float eb = __expf(bJ), et = __expf(tail), eT = __expf(run);
        const float x2 = (J == 3) ? __expf(T2) : __expf(T1);
        float qh[16], kh[16];
#pragma unroll
        for (int i = 0; i < 16; ++i) { const float e1 = __expf(cum[i]); const float r1 = __builtin_amdgcn_rcpf(e1); const float kk = 1.0f - __expf(lf[i]);
            qh[i] = __builtin_bit_cast(float, qv[i] << 16) * e1; kh[i] = kk * r1; }
        {
            LAS unsigned char* rowp = lds + k * HP + 32 * J;
            u32x4 w0, w1;
#define HG_WRITE(OFF, EXPR) do { \
            { float v0_, v1_; \
              { const int i = 0; v0_ = (EXPR); } { const int i = 1; v1_ = (EXPR); } w0.x = pk2(v0_, v1_); \
              { const int i = 2; v0_ = (EXPR); } { const int i = 3; v1_ = (EXPR); } w0.y = pk2(v0_, v1_); \
              { const int i = 4; v0_ = (EXPR); } { const int i = 5; v1_ = (EXPR); } w0.z = pk2(v0_, v1_); \
              { const int i = 6; v0_ = (EXPR); } { const int i = 7; v1_ = (EXPR); } w0.w = pk2(v0_, v1_); \
              { const int i = 8; v0_ = (EXPR); } { const int i = 9; v1_ = (EXPR); } w1.x = pk2(v0_, v1_); \
              { const int i = 10; v0_ = (EXPR); } { const int i = 11; v1_ = (EXPR); } w1.y = pk2(v0_, v1_); \
              { const int i = 12; v0_ = (EXPR); } { const int i = 13; v1_ = (EXPR); } w1.z = pk2(v0_, v1_); \
              { const int i = 14; v0_ = (EXPR); } { const int i = 15; v1_ = (EXPR); } w1.w = pk2(v0_, v1_); } \
            *(LAS u32x4*)(OFF) = w0; *(LAS u32x4*)((OFF) + 16) = w1; } while (0)
            HG_WRITE(rowp + H_QH, qh[i]);
            HG_WRITE(rowp + H_KH, kh[i]);
            HG_WRITE(rowp + H_KE, kh[i] * eT);
            HG_WRITE(rowp + H_QD, qh[i] * eb);
            HG_WRITE(rowp + H_KD, kh[i] * (eT * et));
            if (J == 3) { HG_WRITE(lds + H_Q2 + k * HP2, qh[i] * x2); }
            if (J == 0) { HG_WRITE(lds + H_K2 + k * HP2, kh[i] * (eT * x2)); }
#undef HG_WRITE
            if (J == 3) Dl[k] = __expf(bJ + run);
        }
        if (idx + nb < 64 * NCH) HG_LOADP(idx + nb);
        ATT_BAR();
        const bool lat = (c >= 4);
        if (lat) {
#pragma unroll
            for (int rep = 0; rep < 2; ++rep) {
                int I, Jb;
                if (rep == 0) { I = (wave < 4) ? wave : (wave == 4 ? 1 : (wave == 7 ? 3 : 2)); Jb = (wave < 4) ? wave : (wave == 4 ? 0 : (wave == 5 ? 0 : (wave == 6 ? 1 : 2))); }
                else { if (wave >= 2) break; I = 3; Jb = wave; }
                int aoff, apitch, acol, boff, bpitch, bcol;
                if (I == Jb) { aoff = H_KH; apitch = HP; acol = 16 * Jb; boff = H_QH; bpitch = HP; bcol = 16 * I; }
                else if (I == Jb + 1 && I != 2) { aoff = H_KE; apitch = HP; acol = 16 * Jb; boff = H_QH; bpitch = HP; bcol = 16 * I; }
                else if (I == 2) { if (Jb == 0) { aoff = H_K2; apitch = HP2; acol = 0; } else { aoff = H_KE; apitch = HP; acol = 16; } boff = H_QH; bpitch = HP; bcol = 32; }
                else { if (Jb == 0) { aoff = H_K2; apitch = HP2; acol = 0; } else { aoff = H_KE; apitch = HP; acol = 16; } boff = H_Q2; bpitch = HP2; bcol = 0; }
                f32x4 pt = (f32x4){0.f, 0.f, 0.f, 0.f};
#pragma unroll
                for (int ks = 0; ks < 4; ++ks) {
                    const int r0 = 32 * ks + 4 * g + qq;
                    const bf16x8 a = cat8(lds_tr(lds + aoff + r0 * apitch + (acol + 4 * pp) * 2), lds_tr(lds + aoff + (r0 + 16) * apitch + (acol + 4 * pp) * 2));
                    const bf16x8 bb = cat8(lds_tr(lds + boff + r0 * bpitch + (bcol + 4 * pp) * 2), lds_tr(lds + boff + (r0 + 16) * bpitch + (bcol + 4 * pp) * 2));
                    pt = __builtin_amdgcn_mfma_f32_16x16x32_bf16(a, bb, pt, 0, 0, 0);
                }
                if (I == Jb) {
#pragma unroll
                    for (int j = 0; j < 4; ++j) if (4 * g + j > li) pt[j] = 0.f;
                }
                u32x2 w; w.x = pk2(pt.x, pt.y); w.y = pk2(pt.z, pt.w);
                *(LAS u32x2*)(lds + H_P + (16 * I + li) * PP + (16 * Jb + 4 * g) * 2) = w;
            }
        }
        ATT_BAR();
        unsigned char* img = p.ws + WS_HIMG + (size_t)idx * HIMG_BYTES;
#pragma unroll
        for (int e = 0; e < 2; ++e) { const int id = tid + 512 * e; const int kr = id >> 3, part = id & 7;
            if (lat) *(u32x4*)(img + HIMG_QD + id * 16) = *(const LAS u32x4*)(lds + H_QD + kr * HP + 16 * part);
            *(u32x4*)(img + HIMG_KD + id * 16) = *(const LAS u32x4*)(lds + H_KD + kr * HP + 16 * part); }
        if (lat) *(u32x4*)(img + HIMG_P + tid * 16) = *(const LAS u32x4*)(lds + H_P + (tid >> 3) * PP + 16 * (tid & 7));
        if (tid < 32) *(u32x4*)(img + HIMG_D + tid * 16) = *(const LAS u32x4*)(lds + H_D + 16 * tid);
    }
#undef HG_LOADP
    __syncthreads();
}

__device__ __forceinline__ void hgrn_scan(const Params& p, LAS unsigned char* lds, int chain) {
    int tid_o = tid_of(p.wave_id);
    const int tid = tid_o, lane = tid & 63, wave = __builtin_amdgcn_readfirstlane(tid >> 6);
    const int li = lane & 15, g = lane >> 4, qq = li >> 2, pp = li & 3;
    const int dir = chain / (BATCH * NHEAD), b = (chain / NHEAD) % BATCH, h = chain % NHEAD;
    const bf16* IA = (const bf16*)(p.ws + WS_IA) + h * HD;
    bf16* O = ((bf16*)p.out + (dir == 0 ? 0 : (size_t)ML * WA)) + h * HD + 16 * wave + li;
    const long ost = dir ? -(long)WA : (long)WA;
    const unsigned char* img0 = p.ws + WS_HIMG + (size_t)chain * NCH * HIMG_BYTES;
    f32x4 S[8];
#pragma unroll
    for (int i = 0; i < 8; ++i) S[i] = (f32x4){0.f, 0.f, 0.f, 0.f};
    u32x4 rq[2][2], rk[2][2], rp[2], rd[2], rv[2][2];
#define HS_LOAD(c_, set_) do { const int cc_ = (c_); const unsigned char* im_ = img0 + (size_t)cc_ * HIMG_BYTES; \
        if (cc_ >= 4) { rq[set_][0] = *(const u32x4*)(im_ + HIMG_QD + tid * 16); rq[set_][1] = *(const u32x4*)(im_ + HIMG_QD + (tid + 512) * 16); rp[set_] = *(const u32x4*)(im_ + HIMG_P + tid * 16); } \
        rk[set_][0] = *(const u32x4*)(im_ + HIMG_KD + tid * 16); rk[set_][1] = *(const u32x4*)(im_ + HIMG_KD + (tid + 512) * 16); \
        if (tid < 32) rd[set_] = *(const u32x4*)(im_ + HIMG_D + tid * 16); \
        _Pragma("unroll") for (int e = 0; e < 2; ++e) { const int idx_ = tid * 2 + e; const size_t row_ = hg_row(dir, b, 64 * cc_ + (idx_ >> 4)); rv[set_][e] = *(const u32x4*)(IA + row_ * WA + 8 * (idx_ & 15)); } } while (0)
#define HS_STORE(c_, set_) do { const int cc_ = (c_); LAS unsigned char* bb_ = lds + (cc_ & 1) * SB_BYTES; \
        if (cc_ >= 4) { *(LAS u32x4*)(bb_ + SB_QD + (tid >> 3) * HP + 16 * (tid & 7)) = rq[set_][0]; *(LAS u32x4*)(bb_ + SB_QD + ((tid >> 3) + 64) * HP + 16 * (tid & 7)) = rq[set_][1]; \
                        *(LAS u32x4*)(bb_ + SB_P + (tid >> 3) * PP + 16 * (tid & 7)) = rp[set_]; } \
        { LAS unsigned char* k0_ = bb_ + SB_KD + (tid >> 3) * HPK + 16 * (tid & 7); LAS unsigned char* k1_ = k0_ + 64 * HPK; \
          *(LAS u32x2*)k0_ = (u32x2){rk[set_][0].x, rk[set_][0].y}; *(LAS u32x2*)(k0_ + 8) = (u32x2){rk[set_][0].z, rk[set_][0].w}; *(LAS u32x2*)k1_ = (u32x2){rk[set_][1].x, rk[set_][1].y}; *(LAS u32x2*)(k1_ + 8) = (u32x2){rk[set_][1].z, rk[set_][1].w}; } \
        if (tid < 32) *(LAS u32x4*)(bb_ + SB_D + 16 * tid) = rd[set_]; \
        _Pragma("unroll") for (int e = 0; e < 2; ++e) { const int idx_ = tid * 2 + e; *(LAS u32x4*)(bb_ + SB_V + (idx_ >> 4) * VP + 16 * (idx_ & 15)) = rv[set_][e]; } } while (0)
    HS_LOAD(0, 0); HS_LOAD(1, 1);
    HS_STORE(0, 0);
    HS_LOAD(2, 0);
    ATT_BAR();
#pragma unroll 1
    for (int c2 = 0; c2 < NCH; c2 += 2) {
#pragma unroll
    for (int uu = 0; uu < 2; ++uu) { const int c = c2 + uu;
        const LAS unsigned char* bb = lds + (c & 1) * SB_BYTES;
        const bool lat = (c >= 4);
        bf16x8 vf[2];
#pragma unroll
        for (int sp = 0; sp < 2; ++sp) {
            const LAS unsigned char* vb0 = bb + SB_V + (32 * sp + 4 * g + qq) * VP + (16 * wave + 4 * pp) * 2;
            vf[sp] = cat8(lds_tr(vb0), lds_tr(vb0 + 16 * VP));
        }
        if (lat) {
            bf16x8 sb[4];
#pragma unroll
            for (int ks = 0; ks < 4; ++ks) sb[ks] = pack_p(S[2 * ks], S[2 * ks + 1]);
            bf16* orow = O + (long)hg_row(dir, b, 64 * c) * WA;
#pragma unroll
            for (int I = 0; I < 4; ++I) {
                f32x4 o = (f32x4){0.f, 0.f, 0.f, 0.f};
#pragma unroll
                for (int ks = 0; ks < 4; ++ks) {
                    const LAS unsigned char* ap = bb + SB_QD + (32 * ks + 4 * g + qq) * HP + (16 * I + 4 * pp) * 2;
                    o = __builtin_amdgcn_mfma_f32_16x16x32_bf16(cat8(lds_tr(ap), lds_tr(ap + 16 * HP)), sb[ks], o, 0, 0, 0);
                }
#pragma unroll
                for (int sp = 0; sp < 2; ++sp) {
                    if (2 * sp > I) break;
                    const LAS unsigned char* pr = bb + SB_P + (16 * I + li) * PP + (32 * sp + 4 * g) * 2;
                    const u32x2 lo = *(const LAS u32x2*)pr; u32x2 hi = (u32x2){0u, 0u};
                    if (2 * sp + 1 <= I) hi = *(const LAS u32x2*)(pr + 32);
                    o = __builtin_amdgcn_mfma_f32_16x16x32_bf16(cat8u(lo, hi), vf[sp], o, 0, 0, 0);
                }
#pragma unroll
                for (int j = 0; j < 4; ++j) orow[(long)(16 * I + 4 * g + j) * ost] = (bf16)f2bf(o[j]);
            }
        }
#pragma unroll
        for (int blk = 0; blk < 8; ++blk) {
            const f32x4 d4 = *(const LAS f32x4*)(bb + SB_D + (16 * blk + 4 * g) * 4);
            f32x4 s = S[blk] * d4;
#pragma unroll
            for (int sp = 0; sp < 2; ++sp) {
                const LAS unsigned char* kp = bb + SB_KD + (16 * blk + li) * HPK + (32 * sp + 4 * g) * 2;
                s = __builtin_amdgcn_mfma_f32_16x16x32_bf16(cat8u(*(const LAS u32x2*)kp, *(const LAS u32x2*)(kp + 32)), vf[sp], s, 0, 0, 0);
            }
            S[blk] = s;
        }
        if (c + 1 < NCH) HS_STORE(c + 1, (uu + 1) & 1);
        if (c + 3 < NCH) HS_LOAD(c + 3, (uu + 1) & 1);
        ATT_BAR();
    } }
#undef HS_LOAD
#undef HS_STORE
    __syncthreads();
}

__device__ __forceinline__ void phase_readout(const Params& p, int vb, int nb) {
    const int tid = tid_of(p.wave_id), lane = tid & 63, wave = p.wave_id;
    const bf16* OF = (const bf16*)p.out; const bf16* OB = OF + (size_t)ML * WA; const bf16* GA = (const bf16*)(p.ws + WS_GA);
    bf16* YA = (bf16*)p.out + (size_t)2 * ML * WA;
    for (int it = vb * 8 + wave; it < ML * NHEAD; it += nb * 8) {
        const int row = it / NHEAD, h = it % NHEAD; const size_t off = (size_t)row * WA + h * HD + 2 * lane;
        const unsigned a = *(const unsigned*)(OF + off), b = *(const unsigned*)(OB + off), g = *(const unsigned*)(GA + off);
        const float o0 = bflo(a) + bflo(b), o1 = bfhi(a) + bfhi(b);
        const float rstd = __builtin_amdgcn_rsqf(wave_sum(o0 * o0 + o1 * o1) * (1.0f / HD) + EPS);
        const float y0 = o0 * rstd * p.hgrn_norm_g[2 * lane] * bflo(g), y1 = o1 * rstd * p.hgrn_norm_g[2 * lane + 1] * bfhi(g);
        *(unsigned*)(YA + off) = pk2(y0, y1);
    }
}

__device__ __forceinline__ void phase_bias2(const Params& p, int vb, int nb) {
    const int tid = tid_of(p.wave_id); const float* mod = (const float*)(p.ws + WS_MOD); float* bias2 = (float*)(p.ws + WS_BIAS2);
    constexpr int NCC = 2 * FFN / 512, NKC = D_MODEL / 64;
    for (int item = vb; item < NCC * NKC; item += nb) {
        const int cc = item % NCC, kc = item / NCC; const int col = cc * 512 + tid;
        const float* W = (col < FFN) ? p.w1 + col : p.w3 + (col - FFN);
        float a0 = 0.f, a1 = 0.f, a2 = 0.f, a3 = 0.f;
#pragma unroll 8
        for (int k = kc * 64; k < kc * 64 + 64; ++k) { const float w = W[(size_t)k * FFN];
            a0 += w * mod[0 * IN_COLS + 3 * D_MODEL + k]; a1 += w * mod[1 * IN_COLS + 3 * D_MODEL + k]; a2 += w * mod[2 * IN_COLS + 3 * D_MODEL + k]; a3 += w * mod[3 * IN_COLS + 3 * D_MODEL + k]; }
        atomicAdd(bias2 + 0 * 2 * FFN + col, a0); atomicAdd(bias2 + 1 * 2 * FFN + col, a1); atomicAdd(bias2 + 2 * 2 * FFN + col, a2); atomicAdd(bias2 + 3 * 2 * FFN + col, a3);
    }
}

constexpr int LDS_MISC_OFF = 145408;
constexpr int LDS_BYTES = 146432;
static_assert(WS_BAR + XCD_BAR_WORDS * 4 <= WS_ROWSQ, "barrier words inside ctl");

#if defined(__HIP_DEVICE_COMPILE__)
#define LOAD_P() Params p; { const __attribute__((address_space(4))) Params* q_ = (const __attribute__((address_space(4))) Params*)__builtin_amdgcn_kernarg_segment_ptr(); asm volatile("" : "+s"(q_)); \
    p = *q_; p.wave_id = wave_id; } unsigned char* ws = p.ws; (void)ws
#else
#define LOAD_P() Params p = p_in; p.wave_id = wave_id; unsigned char* ws = p.ws; (void)ws
#endif
__global__ void __launch_bounds__(NTHREADS, 2) mega_fwd(Params p_in) {
    const int wave_id = __builtin_amdgcn_readfirstlane((int)(threadIdx.x >> 6));
    extern __shared__ __attribute__((aligned(16))) unsigned char lds_raw[];
    LAS unsigned char* lds = (LAS unsigned char*)lds_raw;
    const int nb = gridDim.x;
    const int vb = (nb % 8 == 0) ? ((int)(blockIdx.x % 8) * (nb / 8) + (int)(blockIdx.x / 8)) : (int)blockIdx.x;
    const int bx = blockIdx.x;
    volatile LAS unsigned* misc = (volatile LAS unsigned*)(lds + LDS_MISC_OFF);
    if (wave_id == 0) misc[lane_id()] = 0u;
    __syncthreads();
    XcdBarrier bar = xcd_barrier_post((unsigned*)(p_in.ws + WS_BAR), misc + 8, wave_id);
#define GRID_BAR() xcd_barrier(bar)

    { LOAD_P(); phase_mod(p, lds, vb, nb); __syncthreads(); phase_wconv_in(p, lds, vb * 8 + wave_id, nb * 8); }
    GRID_BAR();
    { LOAD_P(); phase_h(p, vb, nb); }
    GRID_BAR();
    { LOAD_P(); pg8::Gemm g{(const bf16*)(ws + WS_H), (const bf16*)(ws + WS_WINT), MT, IN_COLS, D_MODEL}; InProjOrder S; S.init(ML, IN_COLS, nb, bx);
      EpiInProj E{ws, lds, p.q_norm_g, p.k_norm_g}; pg8::gemm_phase<EpiInProj, InProjOrder, true, true>(lds, g, S, E, wave_id);
      const int nfree = nb - CTX_UNITS;
      if (nfree >= 64) { if (bx >= CTX_UNITS) phase_wconv_rest(p, lds, (bx - CTX_UNITS) * 8 + wave_id, nfree * 8); }
      else phase_wconv_rest(p, lds, bx * 8 + wave_id, nb * 8); }
    GRID_BAR();
    { LOAD_P(); hgrn_prep(p, lds, vb, nb); }
    GRID_BAR();
    { LOAD_P();
      if (bx < 2 * BATCH * NHEAD) hgrn_scan(p, lds, bx);
      __syncthreads();
      phase_attn(p, lds); }
    GRID_BAR();
    { LOAD_P(); phase_readout(p, vb, nb); }
    GRID_BAR();
    { LOAD_P(); pg8::Gemm g{(const bf16*)p.out + (size_t)2 * ML * WA, (const bf16*)(ws + WS_WAT), ML, D_MODEL, WA};
      MergeOrder S; S.init(ML, D_MODEL, nb, bx); S.A1 = (const bf16*)p.out + (size_t)3 * ML * WA; S.B1 = (const bf16*)(ws + WS_WBT);
      EpiMerge E{ws, (float*)(ws + WS_T1)}; pg8::gemm_phase<EpiMerge, MergeOrder, true, true>(lds, g, S, E, wave_id); }
    GRID_BAR();
    { LOAD_P(); pg8::Gemm g{(const bf16*)(ws + WS_Z), (const bf16*)(ws + WS_WOT), ML, D_MODEL, D_MODEL}; pg8::StaticOrder S; S.init(ML, D_MODEL, nb, bx);
      EpiOutProj E{ws, p.x, p.norm2_g, p.out}; pg8::gemm_phase<EpiOutProj, pg8::StaticOrder, true, true>(lds, g, S, E, wave_id); }
    GRID_BAR();
    { LOAD_P(); pg8::Gemm g{(const bf16*)(ws + WS_XMG), (const bf16*)(ws + WS_W13T), ML, 2 * FFN, D_MODEL}; pg8::StaticOrder S; S.init(ML, 2 * FFN, nb, bx);
      EpiFfnUp E{ws, lds, p.conv_w, p.conv_b}; pg8::gemm_phase<EpiFfnUp, pg8::StaticOrder, true, true>(lds, g, S, E, wave_id); }
    GRID_BAR();
    { LOAD_P(); { pg8::StaticOrder S0; S0.init(ML, D_MODEL, nb, bx); pg8::Unit u0; const int tid = tid_of(wave_id); for (int i = 0; S0.next(i, u0); ++i) halo_fix(p, u0.pm, tid); }
      asm volatile("s_waitcnt vmcnt(0)" ::: "memory"); __syncthreads();
      pg8::Gemm g{(const bf16*)(ws + WS_ACT), (const bf16*)(ws + WS_W2T), ML, D_MODEL, FFN}; pg8::StaticOrder S; S.init(ML, D_MODEL, nb, bx);
      EpiFfnDown E{ws, p.out}; pg8::gemm_phase<EpiFfnDown, pg8::StaticOrder, true, true>(lds, g, S, E, wave_id); }
#undef GRID_BAR
}

extern "C" void kernel_launch(void* const* d_in, const int* in_sizes, int n_in, void* d_out, int out_size, void* d_ws, size_t ws_size, hipStream_t stream) {
    static int grid = 0;
    if (grid == 0) {
        if (n_in != 22 || ws_size < WS_END || out_size != ML * D_MODEL) { fprintf(stderr, "kernel_launch: bad inputs (n_in %d, out %d, ws %zu, need %zu)\n", n_in, out_size, ws_size, (size_t)WS_END); grid = -1; return; }
        int dev = 0, cus = 0, per_cu = 0;
        if (hipGetDevice(&dev) != hipSuccess || hipDeviceGetAttribute(&cus, hipDeviceAttributeMultiprocessorCount, dev) != hipSuccess) { grid = -1; return; }
        if (hipFuncSetAttribute((const void*)mega_fwd, hipFuncAttributeMaxDynamicSharedMemorySize, LDS_BYTES) != hipSuccess) { fprintf(stderr, "kernel_launch: hipFuncSetAttribute failed\n"); grid = -1; return; }
        if (hipOccupancyMaxActiveBlocksPerMultiprocessor(&per_cu, (const void*)mega_fwd, NTHREADS, LDS_BYTES) != hipSuccess || per_cu < 1) { fprintf(stderr, "kernel_launch: occupancy query says %d blocks/CU\n", per_cu); (void)hipGetLastError(); grid = -1; return; }
        grid = cus;
        fprintf(stderr, "kernel_launch: grid %d (cus %d, occupancy %d/CU)\n", grid, cus, per_cu);
    }
    if (grid < 0) return;
    Params p{};
    const float** f = (const float**)&p;
    for (int i = 0; i < 22; ++i) f[i] = (const float*)d_in[i];
    p.out = (float*)d_out; p.ws = (unsigned char*)d_ws;
    (void)hipMemsetAsync((char*)d_ws + WS_CTL, 0, CTL_ZERO_BYTES, stream);
    hipLaunchKernelGGL(mega_fwd, dim3(grid), dim3(NTHREADS), LDS_BYTES, stream, p);
}
```

```cpp
#include <hip/hip_runtime.h>
#include <cstdio>
#include <cstdint>
#include <cmath>

__device__ __forceinline__ int lane_id() { int l; asm volatile("v_mbcnt_lo_u32_b32 %0, -1, 0\n\tv_mbcnt_hi_u32_b32 %0, -1, %0" : "=v"(l)); return l; }
__device__ __forceinline__ int tid_of(int wave_id) { int t = wave_id * 64 + lane_id(); asm volatile("" : "+v"(t)); return t; }
namespace pg8 {
#define PG8_LAS __attribute__((address_space(3)))
typedef unsigned short bf16_t;
typedef short bf16x8 __attribute__((ext_vector_type(8)));
typedef float f32x4 __attribute__((ext_vector_type(4)));
typedef unsigned u32x4 __attribute__((ext_vector_type(4)));
constexpr int BM = 256, BK = 64, HALF = 128, HTB = HALF * BK * 2  , STAGE_BYTES = 8 * HTB, NXCD = 8, WGM = 8;

__host__ __device__ __forceinline__ int lds_byte(int r, int c) { const int st = (r >> 4) * 2 + (c >> 5), rr = r & 15, cc = c & 31, ob = rr * 64 + cc * 2; return st * 1024 + (ob ^ (((ob >> 9) & 1) << 5)); }
__host__ __device__ __forceinline__ void stage_rc(int b, int& R, int& C) { const int st = b / 1024, sb = b % 1024, swz = sb ^ (((sb >> 9) & 1) << 5); R = (st >> 1) * 16 + swz / 64; C = (st & 1) * 32 + (swz % 64) / 2; }
__host__ __device__ __forceinline__ int perm32(int rho) { const int n = rho >> 4, i = rho & 15; return 8 * (i >> 2) + 4 * n + (i & 3); }

struct Unit { int pm, pn, br; };
struct Gemm { const bf16_t* A; const bf16_t* Bt; int M, N, K; };

struct StaticOrder {
    int nM, nN, nwg, G, c;
    __host__ __device__ void init(int M, int N, int G_, int c_) { nM = M / BM; nN = N / BM; nwg = nM * nN; G = G_; c = c_; }
    __host__ __device__ bool next(int i, Unit& u) const {
        const long L = (long)i * G + c; if (L >= nwg) return false;
        int wgid = (int)L; { const int q = nwg / NXCD, r = nwg % NXCD, xcd = wgid % NXCD, off = wgid / NXCD; wgid = (xcd < r ? xcd * (q + 1) : r * (q + 1) + (xcd - r) * q) + off; }
        const int nig = WGM * nN, gid = wgid / nig, fm = gid * WGM, gsz = (nM - fm) < WGM ? (nM - fm) : WGM;
        u.pm = fm + ((wgid % nig) % gsz); u.pn = (wgid % nig) / gsz; u.br = 0; return true;
    }
    __device__ __forceinline__ const char* a_base(const Gemm& g, const Unit& u, size_t tstep) const { return (const char*)g.A + (size_t)u.pm * tstep; }
    __device__ __forceinline__ const char* b_base(const Gemm& g, const Unit& u, size_t tstep) const { return (const char*)g.Bt + (size_t)u.pn * tstep; }
    __device__ __forceinline__ void a_ready(const Unit&) const {}
    __device__ __forceinline__ void done(const Unit&) const {}
};

template <class Epi, class Sched, bool ALIGN_EPI = false, bool SP2 = false>
__device__ __forceinline__ void gemm_phase(PG8_LAS unsigned char* lds, const Gemm g, const Sched& S, const Epi& E, const int wave_id_in) {
    int tid_o = tid_of(wave_id_in);
    const int tid = tid_o, wid = __builtin_amdgcn_readfirstlane(tid >> 6), lane = tid & 63, wr = wid >> 2, wc = wid & 3, fr = lane & 15, fq = lane >> 4;
    const int K = g.K, nt = K / BK;
    unsigned voffA[2], voffB[2];
#pragma unroll
    for (int i = 0; i < 2; ++i) { int R, C; stage_rc(tid * 16 + i * 8192, R, C); const int Rb = Epi::PERM ? ((R & ~31) + perm32(R & 31)) : R;
        voffA[i] = (unsigned)(R * K + C) * 2u; voffB[i] = (unsigned)(Rb * K + C) * 2u; }
    const size_t kstep = (size_t)(BK * 2);
    const size_t hstep = (size_t)HALF * K * 2;
    const size_t tstep = 2 * hstep;
    const unsigned ldsw = (unsigned)wid * 1024u;
    const int aoff = lds_byte(wr * 64 + fr, fq * 8), boff = lds_byte(wc * 32 + fr, fq * 8);
#define PG8_SA(b, h) (((b) * 2 + (h)) * HTB)
#define PG8_SB(b, h) ((4 + (b) * 2 + (h)) * HTB)
#define PG8_STAGE(bufoff, gbase, voff) do { _Pragma("unroll") for (int _i = 0; _i < 2; ++_i) \
        __builtin_amdgcn_global_load_lds((const unsigned*)((const char*)(gbase) + (voff)[_i]), (PG8_LAS unsigned*)(lds + (bufoff) + ldsw + _i * 8192), 16, 0, 0); } while (0)
#define PG8_LDA(dst, b, h) do { _Pragma("unroll") for (int m = 0; m < 4; ++m) _Pragma("unroll") for (int k = 0; k < 2; ++k) dst[m][k] = *(const PG8_LAS bf16x8*)(lds + PG8_SA(b, h) + aoff + m * 2048 + k * 1024); } while (0)
#define PG8_LDB(dst, b, h) do { _Pragma("unroll") for (int n = 0; n < 2; ++n) _Pragma("unroll") for (int k = 0; k < 2; ++k) dst[n][k] = *(const PG8_LAS bf16x8*)(lds + PG8_SB(b, h) + boff + n * 2048 + k * 1024); } while (0)
#define PG8_MMA(ai, bj, At, Bt) do { __builtin_amdgcn_s_setprio(1); _Pragma("unroll") for (int m = 0; m < 4; ++m) _Pragma("unroll") for (int n = 0; n < 2; ++n) _Pragma("unroll") for (int k = 0; k < 2; ++k) \
        acc[ai][bj][m][n] = __builtin_amdgcn_mfma_f32_16x16x32_bf16(Bt[n][k], At[m][k], acc[ai][bj][m][n], 0, 0, 0); __builtin_amdgcn_s_setprio(0); } while (0)
#define PG8_WAIT_V(n) asm volatile("s_waitcnt vmcnt(" #n ")" ::: "memory")
#define PG8_WAIT_L(n) asm volatile("s_waitcnt lgkmcnt(" #n ")" ::: "memory")
#define PG8_BAR __builtin_amdgcn_s_barrier()
#define PG8_SCHED __builtin_amdgcn_sched_barrier(0)
    Unit cur, nxt; int ui = 0;
    if (!S.next(0, cur)) return;
    f32x4 acc[2][2][4][2];
#pragma unroll
    for (int a = 0; a < 2; ++a)
#pragma unroll
        for (int b = 0; b < 2; ++b)
#pragma unroll
            for (int m = 0; m < 4; ++m)
#pragma unroll
                for (int n = 0; n < 2; ++n) acc[a][b][m][n] = (f32x4){0.f, 0.f, 0.f, 0.f};
    bf16x8 At[4][2], B0[2][2], B1[2][2];
    const char* cA = S.a_base(g, cur, tstep); const char* cB = S.b_base(g, cur, tstep);
    S.a_ready(cur);
    if constexpr (SP2) {
        PG8_STAGE(PG8_SB(0, 0), cB, voffB); PG8_STAGE(PG8_SB(0, 1), cB + hstep, voffB); PG8_STAGE(PG8_SA(0, 0), cA, voffA); PG8_STAGE(PG8_SA(0, 1), cA + hstep, voffA);
        if (wr == 1) PG8_BAR;
        PG8_WAIT_V(2); PG8_BAR;
        PG8_STAGE(PG8_SB(1, 0), cB + kstep, voffB); PG8_STAGE(PG8_SA(1, 0), cA + kstep, voffA); PG8_STAGE(PG8_SB(1, 1), cB + hstep + kstep, voffB);
        PG8_WAIT_V(6); PG8_BAR;
    } else {
        PG8_STAGE(PG8_SB(0, 0), cB, voffB); PG8_STAGE(PG8_SA(0, 0), cA, voffA); PG8_STAGE(PG8_SB(0, 1), cB + hstep, voffB); PG8_STAGE(PG8_SA(0, 1), cA + hstep, voffA);
        if (wr == 1) PG8_BAR;
        PG8_WAIT_V(4); PG8_BAR;
        PG8_STAGE(PG8_SB(1, 0), cB + kstep, voffB); PG8_STAGE(PG8_SA(1, 0), cA + kstep, voffA); PG8_STAGE(PG8_SB(1, 1), cB + hstep + kstep, voffB);
        PG8_WAIT_V(6); PG8_BAR;
    }
    for (;;) {
        const bool has_next = S.next(ui + 1, nxt);
        const char* nA = has_next ? S.a_base(g, nxt, tstep) : cA; const char* nB = has_next ? S.b_base(g, nxt, tstep) : cB;
        for (int t = 0; t < nt; t += 2) {
            const bool last = (t == nt - 2);
            const char* a1 = cA + (size_t)(t + 1) * kstep;
            const char* a2 = last ? nA : cA + (size_t)(t + 2) * kstep; const char* b2 = last ? nB : cB + (size_t)(t + 2) * kstep;
            const char* a3 = a2 + kstep; const char* b3 = b2 + kstep;
            if (last && has_next) S.a_ready(nxt);
            if constexpr (SP2) {
            PG8_LDB(B0, 0, 0); PG8_LDB(B1, 0, 1); PG8_SCHED; PG8_LDA(At, 0, 0); PG8_STAGE(PG8_SA(1, 1), a1 + hstep, voffA);
            PG8_WAIT_V(8); PG8_WAIT_L(0); PG8_BAR; PG8_MMA(0, 0, At, B0); PG8_MMA(0, 1, At, B1); PG8_BAR; PG8_SCHED;
            PG8_LDA(At, 0, 1); PG8_STAGE(PG8_SB(0, 0), b2, voffB); PG8_STAGE(PG8_SB(0, 1), b2 + hstep, voffB); PG8_STAGE(PG8_SA(0, 0), a2, voffA);
            PG8_WAIT_V(8); PG8_WAIT_L(0); PG8_BAR; PG8_MMA(1, 0, At, B0); PG8_MMA(1, 1, At, B1); PG8_BAR; PG8_SCHED;
            PG8_LDB(B0, 1, 0); PG8_LDB(B1, 1, 1); PG8_SCHED; PG8_LDA(At, 1, 0); PG8_STAGE(PG8_SA(0, 1), a2 + hstep, voffA);
            PG8_WAIT_V(8); PG8_WAIT_L(0); PG8_BAR; PG8_MMA(0, 0, At, B0); PG8_MMA(0, 1, At, B1); PG8_BAR; PG8_SCHED;
            PG8_LDA(At, 1, 1); PG8_STAGE(PG8_SB(1, 0), b3, voffB); PG8_STAGE(PG8_SB(1, 1), b3 + hstep, voffB); PG8_STAGE(PG8_SA(1, 0), a3, voffA);
            PG8_WAIT_V(8); PG8_WAIT_L(0); PG8_BAR; PG8_MMA(1, 0, At, B0); PG8_MMA(1, 1, At, B1); PG8_BAR; PG8_SCHED;
            } else {
            PG8_LDB(B0, 0, 0); PG8_SCHED; PG8_LDA(At, 0, 0); PG8_STAGE(PG8_SA(1, 1), a1 + hstep, voffA);
            PG8_WAIT_L(8); PG8_BAR; PG8_WAIT_L(0); PG8_MMA(0, 0, At, B0); PG8_BAR; PG8_SCHED;
            PG8_LDB(B1, 0, 1); PG8_STAGE(PG8_SB(0, 0), b2, voffB);
            PG8_BAR; PG8_WAIT_L(0); PG8_MMA(0, 1, At, B1); PG8_BAR;
            PG8_LDA(At, 0, 1); PG8_STAGE(PG8_SA(0, 0), a2, voffA);
            PG8_BAR; PG8_WAIT_L(0); PG8_MMA(1, 0, At, B0); PG8_BAR; PG8_SCHED;
            PG8_STAGE(PG8_SB(0, 1), b2 + hstep, voffB);
            PG8_WAIT_V(6); PG8_BAR; PG8_MMA(1, 1, At, B1); PG8_BAR;
            PG8_LDB(B0, 1, 0); PG8_SCHED; PG8_LDA(At, 1, 0); PG8_STAGE(PG8_SA(0, 1), a2 + hstep, voffA);
            PG8_WAIT_L(8); PG8_BAR; PG8_WAIT_L(0); PG8_MMA(0, 0, At, B0); PG8_BAR; PG8_SCHED;
            PG8_LDB(B1, 1, 1); PG8_STAGE(PG8_SB(1, 0), b3, voffB);
            PG8_BAR; PG8_WAIT_L(0); PG8_MMA(0, 1, At, B1); PG8_BAR;
            PG8_LDA(At, 1, 1); PG8_STAGE(PG8_SA(1, 0), a3, voffA);
            PG8_BAR; PG8_WAIT_L(0); PG8_MMA(1, 0, At, B0); PG8_BAR; PG8_SCHED;
            PG8_STAGE(PG8_SB(1, 1), b3 + hstep, voffB);
            PG8_WAIT_V(6); PG8_BAR; PG8_MMA(1, 1, At, B1); PG8_BAR;
            }
        }
        if constexpr (ALIGN_EPI) { if (wr == 0) PG8_BAR; }
        if constexpr (!Epi::AFTER_DRAIN) { E(acc, cur, wr, wc, fr, fq); S.done(cur); }
        if (!has_next) break;
#pragma unroll
        for (int a = 0; a < 2; ++a)
#pragma unroll
            for (int b = 0; b < 2; ++b)
#pragma unroll
                for (int m = 0; m < 4; ++m)
#pragma unroll
                    for (int n = 0; n < 2; ++n) acc[a][b][m][n] = (f32x4){0.f, 0.f, 0.f, 0.f};
        cur = nxt; cA = nA; cB = nB; ++ui;
        if constexpr (ALIGN_EPI) { if (wr == 1) PG8_BAR; }
    }
    PG8_WAIT_V(0);
    if constexpr (!ALIGN_EPI) { if (wr == 0) PG8_BAR; }
    PG8_BAR;
    if constexpr (Epi::AFTER_DRAIN) { E.fused(acc, cur, wr, wc, fr, fq, lds, wid, lane); S.done(cur); }
#undef PG8_SA
#undef PG8_SB
#undef PG8_STAGE
#undef PG8_LDA
#undef PG8_LDB
#undef PG8_MMA
#undef PG8_WAIT_V
#undef PG8_WAIT_L
#undef PG8_BAR
#undef PG8_SCHED
}
}

constexpr int D_MODEL = 2048, BATCH = 4, SEQ = 2048, CTX = 256, GRID_W = 64, NHEAD = 8, HD = 128, WA = 1024;
constexpr int FFN = 5632, IN_COLS = 12288, NMOD = 6;
constexpr int ML = BATCH * SEQ;
constexpr int MC = BATCH * CTX;
constexpr int MT = ML + MC;
constexpr float EPS = 1e-6f;
constexpr int NTHREADS = 512;
constexpr int VT_PITCH = SEQ + CTX;

typedef unsigned short bf16;
typedef float f32x4 __attribute__((ext_vector_type(4)));
typedef unsigned u32x2 __attribute__((ext_vector_type(2)));
typedef unsigned u32x4 __attribute__((ext_vector_type(4)));
#define LAS __attribute__((address_space(3)))

typedef float f32x2_t __attribute__((ext_vector_type(2)));
typedef __bf16 bf16x2_t __attribute__((ext_vector_type(2)));
__device__ __forceinline__ unsigned pk2(float lo, float hi) { const f32x2_t v = {lo, hi}; const bf16x2_t b = __builtin_convertvector(v, bf16x2_t); return __builtin_bit_cast(unsigned, b); }
__device__ __forceinline__ unsigned f2bf(float f) { return pk2(f, 0.f) & 0xffffu; }
__device__ __forceinline__ float bf2f(unsigned short h) { return __builtin_bit_cast(float, (unsigned)h << 16); }
__device__ __forceinline__ float bflo(unsigned w) { return __builtin_bit_cast(float, w << 16); }
__device__ __forceinline__ float bfhi(unsigned w) { return __builtin_bit_cast(float, w & 0xffff0000u); }
__device__ __forceinline__ float sigmoidf_(float x) { return __builtin_amdgcn_rcpf(1.0f + __expf(-x)); }
__device__ __forceinline__ float siluf_(float x) { return x * __builtin_amdgcn_rcpf(1.0f + __expf(-x)); }
__device__ __forceinline__ float wave_sum(float v) {
#pragma unroll
    for (int o = 1; o < 64; o <<= 1) v += __shfl_xor(v, o);
    return v;
}
__device__ __forceinline__ float wave_max(float v) {
#pragma unroll
    for (int o = 1; o < 64; o <<= 1) v = fmaxf(v, __shfl_xor(v, o));
    return v;
}

constexpr size_t al256(size_t x) { return (x + 255) & ~(size_t)255; }
constexpr size_t WS_CTL   = 0;
constexpr size_t CTL_ZERO_BYTES = 1u << 20;
constexpr size_t WS_ROWSQ = 64 * 1024;
constexpr size_t WS_BIAS2 = WS_ROWSQ + (size_t)ML * 4;
static_assert(WS_BIAS2 + (size_t)4 * 2 * FFN * 4 <= CTL_ZERO_BYTES, "ctl");
constexpr size_t WS_MOD   = CTL_ZERO_BYTES;
constexpr size_t WS_LB    = al256(WS_MOD + (size_t)5 * IN_COLS * 4);
constexpr size_t WS_ROPE  = al256(WS_LB + 2 * WA * 4);
constexpr size_t WS_SMALL_END = al256(WS_ROPE + 2 * 64 * 32 * 4);
constexpr size_t WS_W13T  = al256(WS_SMALL_END);
constexpr size_t WS_W2T   = WS_W13T + (size_t)2 * FFN * D_MODEL * 2;
constexpr size_t WS_WAT   = WS_W2T + (size_t)D_MODEL * FFN * 2;
constexpr size_t WS_WBT   = WS_WAT + (size_t)D_MODEL * WA * 2;
constexpr size_t WS_WOT   = WS_WBT + (size_t)D_MODEL * WA * 2;
constexpr size_t WS_A_END = WS_WOT + (size_t)D_MODEL * D_MODEL * 2;
constexpr size_t SEGB = (size_t)MT * WA * 2;
constexpr size_t WS_QA  = WS_A_END;
constexpr size_t WS_FW  = WS_QA + SEGB;
constexpr size_t WS_FB  = WS_FW + 2 * SEGB;
constexpr size_t WS_IA  = WS_FB + 2 * SEGB;
constexpr size_t WS_GA  = WS_IA + SEGB;
constexpr size_t WS_QN  = WS_GA + (size_t)ML * WA * 2;
constexpr size_t WS_KN  = WS_QN + (size_t)ML * WA * 2;
constexpr size_t WS_VN  = WS_KN + SEGB;
constexpr size_t WS_GTA = WS_VN + SEGB;
constexpr size_t WS_GTB = WS_GTA + (size_t)ML * D_MODEL * 2;
constexpr size_t WS_D_END = WS_GTB + (size_t)ML * D_MODEL * 2;
constexpr size_t WS_WINT = WS_D_END;
constexpr size_t WS_OF   = WS_WINT;
constexpr size_t WS_OB   = WS_OF + (size_t)ML * WA * 2;
constexpr size_t WS_B_END = WS_WINT + (size_t)IN_COLS * D_MODEL * 2;
static_assert(WS_OB + (size_t)ML * WA * 2 <= WS_B_END, "B");
constexpr size_t WS_H   = WS_B_END;
constexpr size_t WS_YA  = WS_H;
constexpr size_t WS_YB  = WS_YA + (size_t)ML * WA * 2;
constexpr size_t WS_C_END = WS_H + (size_t)MT * D_MODEL * 2;
constexpr size_t WS_ACT_END = WS_D_END + (size_t)ML * FFN * 2;
constexpr size_t WS_HIMG = WS_WINT;
constexpr size_t WS_HIMG_END = WS_HIMG + (size_t)64 * 36 * 41472;
constexpr size_t WS_T1 = WS_WINT;
constexpr size_t WS_END0 = WS_C_END > WS_ACT_END ? WS_C_END : WS_ACT_END;
constexpr size_t WS_END = WS_END0 > WS_HIMG_END ? WS_END0 : WS_HIMG_END;
static_assert(WS_END <= 445000000, "ws budget");
constexpr size_t WS_Z   = WS_QA;
constexpr size_t WS_XMG = WS_GTB;
constexpr size_t WS_HALO = WS_QA;
static_assert(WS_HALO + (size_t)32 * 6 * FFN * 4 <= WS_XMG, "HALO overlay");
constexpr size_t WS_ACT = WS_WINT;
static_assert(WS_ACT + (size_t)ML * FFN * 2 <= WS_END, "ACT overlay");

struct Params {
    const float *x, *c, *ctx, *c_ctx, *ada_w, *ada_b, *norm1_g, *norm2_g, *w_in, *lb_logits, *hgrn_norm_g, *q_norm_g, *k_norm_g, *rel_bias,
                *w_a, *w_b, *w_o, *w1, *w3, *conv_w, *conv_b, *w2;
    float* out;
    unsigned char* ws;
    int wave_id, pad;
};

template <bool QKPERM, bool BIAS>
__device__ __forceinline__ void transpose_item(const float* W, int K, int N, bf16* WT, int row_off, LAS float* scr, int item, int lane, const float* sh2 = nullptr, float* bias2 = nullptr) {
    const int nblk = N / 32, kb = item / nblk, nb = item % nblk, k0 = 64 * kb, n0 = 32 * nb;
    if (BIAS) row_off += (n0 >> 7) * 128;
    float wv[32];
#pragma unroll
    for (int i = 0; i < 32; ++i) wv[i] = W[(size_t)(k0 + 2 * i + (lane >> 5)) * N + n0 + (lane & 31)];
#pragma unroll
    for (int i = 0; i < 32; ++i) scr[(2 * i + (lane >> 5)) * 33 + (lane & 31)] = wv[i];
    if (BIAS) {
        float a0 = 0.f, a1 = 0.f, a2 = 0.f, a3 = 0.f;
#pragma unroll
        for (int i = 0; i < 32; ++i) { const int k = k0 + 2 * i + (lane >> 5); const float w = wv[i];
            a0 += w * sh2[0 * IN_COLS + k]; a1 += w * sh2[1 * IN_COLS + k]; a2 += w * sh2[2 * IN_COLS + k]; a3 += w * sh2[3 * IN_COLS + k]; }
        a0 += __shfl_xor(a0, 32); a1 += __shfl_xor(a1, 32); a2 += __shfl_xor(a2, 32); a3 += __shfl_xor(a3, 32);
        if (lane < 32) { float* bp = bias2 + row_off + n0 + lane; atomicAdd(bp, a0); atomicAdd(bp + 2 * FFN, a1); atomicAdd(bp + 4 * FFN, a2); atomicAdd(bp + 6 * FFN, a3); }
    }
    asm volatile("s_waitcnt lgkmcnt(0)" ::: "memory");
    const int c = lane & 7;
#pragma unroll
    for (int j = 0; j < 4; ++j) { const int n = (lane >> 3) + 8 * j; const LAS float* s = scr + (8 * c) * 33 + n;
        u32x4 o; o.x = pk2(s[0 * 33], s[1 * 33]); o.y = pk2(s[2 * 33], s[3 * 33]); o.z = pk2(s[4 * 33], s[5 * 33]); o.w = pk2(s[6 * 33], s[7 * 33]);
        int cdst = n0 + n;
        if (QKPERM && cdst >= 5 * WA && cdst < 7 * WA) cdst = (cdst & ~0x30) | ((cdst & 0x10) << 1) | ((cdst & 0x20) >> 1);
        *(u32x4*)(WT + (size_t)(row_off + cdst) * K + k0 + 8 * c) = o; }
    asm volatile("s_waitcnt lgkmcnt(0)" ::: "memory");
}
__device__ __forceinline__ void phase_wconv_in(const Params& p, LAS unsigned char* lds, int gw, int NGW) {
    const int lane = lane_id(), wave = p.wave_id;
    LAS float* scr = (LAS float*)(lds + wave * 16384);
    constexpr int I_IN = (D_MODEL / 64) * (IN_COLS / 32);
    for (int it = gw; it < I_IN; it += NGW) transpose_item<true, false>(p.w_in, D_MODEL, IN_COLS, (bf16*)(p.ws + WS_WINT), 0, scr, it, lane);
}
__device__ __forceinline__ void phase_wconv_rest(const Params& p, LAS unsigned char* lds, int gw, int NGW) {
    const int lane = lane_id(), wave = p.wave_id;
    LAS float* scr = (LAS float*)(lds + 16384 + wave * 16384);
    constexpr int I_A = (WA / 64) * (D_MODEL / 32), I_O = (D_MODEL / 64) * (D_MODEL / 32), I_1 = (D_MODEL / 64) * (FFN / 32), I_2 = (FFN / 64) * (D_MODEL / 32);
    constexpr int NITEMS = 2 * I_A + I_O + 2 * I_1 + I_2;
    unsigned char* ws = p.ws;
    const float* sh2 = (const float*)(ws + WS_MOD) + 3 * D_MODEL; float* b2 = (float*)(ws + WS_BIAS2);
    for (int it = gw; it < NITEMS; it += NGW) {
        int r = it;
        if (r < I_A) { transpose_item<false, false>(p.w_a, WA, D_MODEL, (bf16*)(ws + WS_WAT), 0, scr, r, lane); continue; } r -= I_A;
        if (r < I_A) { transpose_item<false, false>(p.w_b, WA, D_MODEL, (bf16*)(ws + WS_WBT), 0, scr, r, lane); continue; } r -= I_A;
        if (r < I_O) { transpose_item<false, false>(p.w_o, D_MODEL, D_MODEL, (bf16*)(ws + WS_WOT), 0, scr, r, lane); continue; } r -= I_O;
        if (r < I_1) { transpose_item<false, true>(p.w1, D_MODEL, FFN, (bf16*)(ws + WS_W13T), 0, scr, r, lane, sh2, b2); continue; } r -= I_1;
        if (r < I_1) { transpose_item<false, true>(p.w3, D_MODEL, FFN, (bf16*)(ws + WS_W13T), 128, scr, r, lane, sh2, b2); continue; } r -= I_1;
        transpose_item<false, false>(p.w2, FFN, D_MODEL, (bf16*)(ws + WS_W2T), 0, scr, r, lane);
    }
}

__device__ __forceinline__ void phase_mod(const Params& p, LAS unsigned char* lds, int vb, int nb) {
    const int tid = tid_of(p.wave_id);
    LAS float* sc = (LAS float*)lds;
    LAS float* red = (LAS float*)(lds + 5 * 2048 * 4);
    for (int i = tid; i < 5 * D_MODEL; i += NTHREADS) { const int r = i / D_MODEL, k = i % D_MODEL; const float v = (r < 4) ? p.c[r * D_MODEL + k] : p.c_ctx[k]; sc[i] = siluf_(v); }
    __syncthreads();
    float* mod = (float*)(p.ws + WS_MOD);
    const int c4 = tid & 15, kp = tid >> 4;
    for (int item = vb; item < IN_COLS / 64; item += nb) {
        const int n0 = item * 64 + c4 * 4;
        f32x4 acc[5];
#pragma unroll
        for (int r = 0; r < 5; ++r) acc[r] = (f32x4){0.f, 0.f, 0.f, 0.f};
#pragma unroll 8
        for (int k = kp; k < D_MODEL; k += 32) {
            const f32x4 w = *(const f32x4*)(p.ada_w + (size_t)k * IN_COLS + n0);
#pragma unroll
            for (int r = 0; r < 5; ++r) acc[r] += w * sc[r * D_MODEL + k];
        }
#pragma unroll
        for (int r = 0; r < 5; ++r) *(LAS f32x4*)(red + (kp * 5 + r) * 64 + c4 * 4) = acc[r];
        __syncthreads();
        if (tid < 320) { const int r = tid / 64, cidx = tid % 64; float s = 0.f;
            for (int q = 0; q < 32; ++q) s += red[(q * 5 + r) * 64 + cidx];
            mod[r * IN_COLS + item * 64 + cidx] = s + p.ada_b[item * 64 + cidx]; }
        __syncthreads();
    }
    if (vb == nb - 1) { float* rt = (float*)(p.ws + WS_ROPE);
        for (int i = tid; i < 64 * 32; i += NTHREADS) { const int pos = i >> 5, j = i & 31; const float inv = exp2f(-(float)j * (13.287712379549449f / 32.0f)); float sn, cs; sincosf((float)pos * inv, &sn, &cs); rt[i] = cs; rt[2048 + i] = sn; } }
    if (vb == 0) { float* lb = (float*)(p.ws + WS_LB);
        for (int i = tid; i < 2 * WA; i += NTHREADS) { const int d = i / WA, cc = i % WA; const float l0 = p.lb_logits[d * 2 * WA + cc], l1 = p.lb_logits[d * 2 * WA + WA + cc]; lb[i] = 1.0f / (1.0f + expf(l1 - l0)); } }
}

__device__ __forceinline__ void phase_h(const Params& p, int vb, int nb) {
    const int tid = tid_of(p.wave_id), lane = tid & 63, wave = p.wave_id;
    const float* mod = (const float*)(p.ws + WS_MOD);
    bf16* H = (bf16*)(p.ws + WS_H);
    for (int m = vb * 8 + wave; m < MT; m += nb * 8) {
        const float* xr = (m < ML) ? p.x + (size_t)m * D_MODEL : p.ctx + (size_t)(m - ML) * D_MODEL;
        const int mr = (m < ML) ? (m / SEQ) : 4;
        const float* sh = mod + (size_t)mr * IN_COLS, *scl = sh + D_MODEL;
        f32x4 v[8]; float s = 0.f;
#pragma unroll
        for (int j = 0; j < 8; ++j) { v[j] = *(const f32x4*)(xr + 4 * lane + 256 * j); s += (v[j].x * v[j].x + v[j].y * v[j].y) + (v[j].z * v[j].z + v[j].w * v[j].w); }
        const float rstd = __builtin_amdgcn_rsqf(wave_sum(s) * (1.0f / D_MODEL) + EPS);
#pragma unroll
        for (int j = 0; j < 8; ++j) { const int k = 4 * lane + 256 * j;
            const f32x4 g = *(const f32x4*)(p.norm1_g + k), a = *(const f32x4*)(scl + k), b = *(const f32x4*)(sh + k);
            const f32x4 h = v[j] * rstd * g * (a + 1.0f) + b;
            u32x2 o; o.x = pk2(h.x, h.y); o.y = pk2(h.z, h.w);
            *(u32x2*)(H + (size_t)m * D_MODEL + k) = o; }
    }
}

#define EPI_LOOP_BEGIN \
    _Pragma("unroll") for (int ai = 0; ai < 2; ++ai) _Pragma("unroll") for (int m = 0; m < 4; ++m) { const int row = u.pm * 256 + ai * 128 + wr * 64 + m * 16 + fr; \
    _Pragma("unroll") for (int bj = 0; bj < 2; ++bj) _Pragma("unroll") for (int n = 0; n < 2; ++n) { const int col = u.pn * 256 + bj * 128 + wc * 32 + n * 16 + fq * 4; const f32x4 v = acc[ai][bj][m][n];
#define EPI_LOOP_END } }

struct EpiInProj {
    static constexpr bool PERM = false, AFTER_DRAIN = false;
    unsigned char* ws; LAS unsigned char* lds; const float* qg; const float* kg;
    __device__ __forceinline__ void operator()(const f32x4 (&acc)[2][2][4][2], const pg8::Unit& u, int wr, int wc, int fr, int fq) const {
        const int seg = u.pn >> 2;
        const bool ctxrow = u.pm >= ML / 256;
        const float* lb = (const float*)(ws + WS_LB);
        if (seg == 1 || seg == 2) {
            float* F = (float*)(ws + (seg == 1 ? WS_FW : WS_FB)); const float* lbd = lb + (seg - 1) * WA;
            EPI_LOOP_BEGIN
                const int c = col - seg * WA; const f32x4 l = *(const f32x4*)(lbd + c); f32x4 o;
                o.x = __logf(l.x + (1.0f - l.x) * sigmoidf_(v.x)); o.y = __logf(l.y + (1.0f - l.y) * sigmoidf_(v.y));
                o.z = __logf(l.z + (1.0f - l.z) * sigmoidf_(v.z)); o.w = __logf(l.w + (1.0f - l.w) * sigmoidf_(v.w));
                *(f32x4*)(F + (size_t)row * WA + c) = o;
            EPI_LOOP_END
        } else if (seg == 7) {
            bf16* VT = (bf16*)(ws + WS_VN);
            EPI_LOOP_BEGIN
                const int c = col - 7 * WA; const int hh = c >> 7, d = c & 127;
                int bb, tok; if (row < ML) { bb = row / SEQ; tok = row % SEQ; } else { bb = (row - ML) / CTX; tok = SEQ + (row - ML) % CTX; }
                bf16* o = VT + ((size_t)(bb * NHEAD + hh) * HD + d) * VT_PITCH + tok;
                o[0] = (bf16)f2bf(v.x); o[VT_PITCH] = (bf16)f2bf(v.y); o[2 * VT_PITCH] = (bf16)f2bf(v.z); o[3 * VT_PITCH] = (bf16)f2bf(v.w);
            EPI_LOOP_END
        } else if (seg == 5 || seg == 6) {
            if (ctxrow && seg == 5) return;
            LAS float* ssq = (LAS float*)(lds + 131072);
            const float* gn = (seg == 5) ? qg : kg; const float* rt = (const float*)(ws + WS_ROPE);
            bf16* O = (bf16*)(ws + (seg == 5 ? WS_QN : WS_KN));
#pragma unroll
            for (int ai = 0; ai < 2; ++ai)
#pragma unroll
                for (int m = 0; m < 4; ++m)
#pragma unroll
                    for (int bj = 0; bj < 2; ++bj) { const f32x4 a = acc[ai][bj][m][0], b = acc[ai][bj][m][1];
                        float sq = (a.x * a.x + a.y * a.y) + (a.z * a.z + a.w * a.w) + (b.x * b.x + b.y * b.y) + (b.z * b.z + b.w * b.w);
                        sq += __shfl_xor(sq, 16); sq += __shfl_xor(sq, 32);
                        if (fq == 0) ssq[((ai * 128 + wr * 64 + m * 16 + fr) * 2 + bj) * 4 + wc] = sq; }
            asm volatile("s_waitcnt lgkmcnt(0)" ::: "memory"); __builtin_amdgcn_s_barrier(); asm volatile("" ::: "memory");
            const int H = wc >> 1, jj = 16 * (wc & 1) + 4 * fq;
            const f32x4 g0 = *(const f32x4*)(gn + 64 * H + jj), g1 = *(const f32x4*)(gn + 64 * H + 32 + jj);
#pragma unroll
            for (int ai = 0; ai < 2; ++ai)
#pragma unroll
                for (int m = 0; m < 4; ++m) { const int rl = ai * 128 + wr * 64 + m * 16 + fr; const int row = u.pm * 256 + rl;
                    f32x4 cs = (f32x4){1.f, 1.f, 1.f, 1.f}, sn = (f32x4){0.f, 0.f, 0.f, 0.f};
                    if (!ctxrow) { const int t = row & (SEQ - 1); const int pos = (H == 0) ? (t >> 6) : (t & 63); cs = *(const f32x4*)(rt + pos * 32 + jj); sn = *(const f32x4*)(rt + 2048 + pos * 32 + jj); }
#pragma unroll
                    for (int bj = 0; bj < 2; ++bj) { const f32x4 s4 = *(const LAS f32x4*)(ssq + (rl * 2 + bj) * 4);
                        const float rstd = __builtin_amdgcn_rsqf(((s4.x + s4.y) + (s4.z + s4.w)) * (1.0f / HD) + EPS);
                        const f32x4 u1 = acc[ai][bj][m][0] * rstd * g0, u2 = acc[ai][bj][m][1] * rstd * g1;
                        const f32x4 o1 = u1 * cs - u2 * sn, o2 = u1 * sn + u2 * cs;
                        bf16* op = O + (size_t)row * WA + (u.pn & 3) * 256 + bj * 128 + wc * 32 + fq * 4;
                        u32x2 w1; w1.x = pk2(o1.x, o1.y); w1.y = pk2(o1.z, o1.w); *(u32x2*)op = w1;
                        u32x2 w2; w2.x = pk2(o2.x, o2.y); w2.y = pk2(o2.z, o2.w); *(u32x2*)(op + 16) = w2; }
                    asm volatile("" ::: "memory"); }
            asm volatile("s_waitcnt lgkmcnt(0)" ::: "memory"); __builtin_amdgcn_s_barrier(); asm volatile("" ::: "memory");
        } else if (seg == 0 || seg == 3) {
            if (ctxrow && seg == 0) return;
            bf16* O = (bf16*)(ws + (seg == 0 ? WS_QA : WS_IA));
            EPI_LOOP_BEGIN
                const int c = col - seg * WA; u32x2 o; o.x = pk2(v.x, v.y); o.y = pk2(v.z, v.w);
                *(u32x2*)(O + (size_t)row * WA + c) = o;
            EPI_LOOP_END
        } else if (seg == 4) {
            if (ctxrow) return;
            bf16* O = (bf16*)(ws + WS_GA);
            EPI_LOOP_BEGIN
                const int c = col - seg * WA; u32x2 o; o.x = pk2(siluf_(v.x), siluf_(v.y)); o.y = pk2(siluf_(v.z), siluf_(v.w));
                *(u32x2*)(O + (size_t)row * WA + c) = o;
            EPI_LOOP_END
        } else {
            if (ctxrow) return;
            const bool isa = seg < 10;
            bf16* O = (bf16*)(ws + (isa ? WS_GTA : WS_GTB)); const int cbase = isa ? 8 * WA : 10 * WA;
            EPI_LOOP_BEGIN
                const int c = col - cbase; u32x2 o; o.x = pk2(sigmoidf_(v.x), sigmoidf_(v.y)); o.y = pk2(sigmoidf_(v.z), sigmoidf_(v.w));
                *(u32x2*)(O + (size_t)row * D_MODEL + c) = o;
            EPI_LOOP_END
        }
    }
};

constexpr int CTX_UNITS = (MC / 256) * 20;
struct InProjOrder : pg8::StaticOrder {
    __device__ bool next(int i, pg8::Unit& u) const {
        if (pg8::StaticOrder::next(i, u)) return true;
        const long L = (long)i * G + c - nwg; if (L < 0 || L >= CTX_UNITS) return false;
        const int t = (int)L, j = t % 20; u.pm = ML / 256 + t / 20; u.pn = (j < 12) ? 4 + j : 12 + j; u.br = 0; return true; }
};
struct MergeOrder : pg8::StaticOrder {
    const bf16* A1; const bf16* B1;
    __device__ bool next(int i, pg8::Unit& u) const { if (!pg8::StaticOrder::next(i >> 1, u)) return false; u.br = i & 1; return true; }
    __device__ __forceinline__ const char* a_base(const pg8::Gemm& g, const pg8::Unit& u, size_t tstep) const { return (const char*)(u.br ? A1 : g.A) + (size_t)u.pm * tstep; }
    __device__ __forceinline__ const char* b_base(const pg8::Gemm& g, const pg8::Unit& u, size_t tstep) const { return (const char*)(u.br ? B1 : g.Bt) + (size_t)u.pn * tstep; }
};
struct EpiMerge {
    static constexpr bool PERM = false, AFTER_DRAIN = false;
    unsigned char* ws; float* tmp;
    __device__ __forceinline__ void operator()(const f32x4 (&acc)[2][2][4][2], const pg8::Unit& u, int wr, int wc, int fr, int fq) const {
        if (u.br == 0) {
            const bf16* G = (const bf16*)(ws + WS_GTA);
            EPI_LOOP_BEGIN
                const u32x2 g = *(const u32x2*)(G + (size_t)row * D_MODEL + col);
                f32x4 o; o.x = bflo(g.x) * v.x; o.y = bfhi(g.x) * v.y; o.z = bflo(g.y) * v.z; o.w = bfhi(g.y) * v.w;
                *(f32x4*)(tmp + (size_t)row * D_MODEL + col) = o;
            EPI_LOOP_END
        } else {
            const bf16* G = (const bf16*)(ws + WS_GTB); bf16* Z = (bf16*)(ws + WS_Z);
            EPI_LOOP_BEGIN
                const u32x2 g = *(const u32x2*)(G + (size_t)row * D_MODEL + col);
                const f32x4 t = *(const f32x4*)(tmp + (size_t)row * D_MODEL + col);
                u32x2 o; o.x = pk2(t.x + bflo(g.x) * v.x, t.y + bfhi(g.x) * v.y); o.y = pk2(t.z + bflo(g.y) * v.z, t.w + bfhi(g.y) * v.w);
                *(u32x2*)(Z + (size_t)row * D_MODEL + col) = o;
            EPI_LOOP_END
        }
    }
};
struct EpiOutProj {
    static constexpr bool PERM = false, AFTER_DRAIN = false;
    unsigned char* ws; const float* x; const float* norm2_g; float* out;
    __device__ __forceinline__ void operator()(const f32x4 (&acc)[2][2][4][2], const pg8::Unit& u, int wr, int wc, int fr, int fq) const {
        const float* mod = (const float*)(ws + WS_MOD); bf16* XMG = (bf16*)(ws + WS_XMG); float* rowsq = (float*)(ws + WS_ROWSQ);
        const int b = (u.pm * 256) / SEQ;
        const float* g1 = mod + (size_t)b * IN_COLS + 2 * D_MODEL, *sc2 = mod + (size_t)b * IN_COLS + 4 * D_MODEL;
#pragma unroll
        for (int ai = 0; ai < 2; ++ai)
#pragma unroll
            for (int m = 0; m < 4; ++m) { const int row = u.pm * 256 + ai * 128 + wr * 64 + m * 16 + fr; float ss = 0.f;
#pragma unroll
                for (int bj = 0; bj < 2; ++bj)
#pragma unroll
                    for (int n = 0; n < 2; ++n) { const int col = u.pn * 256 + bj * 128 + wc * 32 + n * 16 + fq * 4; const f32x4 v = acc[ai][bj][m][n];
                        const f32x4 xv = *(const f32x4*)(x + (size_t)row * D_MODEL + col), g = *(const f32x4*)(g1 + col);
                        const f32x4 xm = xv + g * v;
                        *(f32x4*)(out + (size_t)row * D_MODEL + col) = xm;
                        ss += (xm.x * xm.x + xm.y * xm.y) + (xm.z * xm.z + xm.w * xm.w);
                        const f32x4 ng = *(const f32x4*)(norm2_g + col), s2 = *(const f32x4*)(sc2 + col);
                        const f32x4 h = xm * ng * (s2 + 1.0f);
                        u32x2 o; o.x = pk2(h.x, h.y); o.y = pk2(h.z, h.w);
                        *(u32x2*)(XMG + (size_t)row * D_MODEL + col) = o; }
                ss += __shfl_xor(ss, 16); ss += __shfl_xor(ss, 32);
                if (fq == 0) atomicAdd(rowsq + row, ss); }
    }
};
__device__ __forceinline__ float dpp_ror1(float v) { return __builtin_bit_cast(float, __builtin_amdgcn_update_dpp(0, __builtin_bit_cast(int, v), 0x121, 0xf, 0xf, false)); }
__device__ __forceinline__ float dpp_rol1(float v) { return __builtin_bit_cast(float, __builtin_amdgcn_update_dpp(0, __builtin_bit_cast(int, v), 0x12f, 0xf, 0xf, false)); }
__device__ __forceinline__ f32x4 ror1_4(const f32x4 v) { return (f32x4){dpp_ror1(v.x), dpp_ror1(v.y), dpp_ror1(v.z), dpp_ror1(v.w)}; }
__device__ __forceinline__ f32x4 rol1_4(const f32x4 v) { return (f32x4){dpp_rol1(v.x), dpp_rol1(v.y), dpp_rol1(v.z), dpp_rol1(v.w)}; }
struct EpiFfnUp {
    static constexpr bool PERM = false, AFTER_DRAIN = false;
    unsigned char* ws; LAS unsigned char* lds; const float* cw; const float* cb;
    __device__ __forceinline__ void operator()(const f32x4 (&acc_c)[2][2][4][2], const pg8::Unit& u, int wr, int wc, int fr, int fq) const {
        f32x4 (&acc)[2][2][4][2] = const_cast<f32x4 (&)[2][2][4][2]>(acc_c);
        const float* rowsq = (const float*)(ws + WS_ROWSQ); bf16* ACT = (bf16*)(ws + WS_ACT); float* HALO = (float*)(ws + WS_HALO) + (size_t)u.pm * 6 * FFN;
        const int b = (u.pm * 256) / SEQ; const float* bias2 = (const float*)(ws + WS_BIAS2) + (size_t)b * 2 * FFN + u.pn * 256;
        const int cl = wc * 32 + fq * 4, ch0 = u.pn * 128 + cl;
        LAS float* X = (LAS float*)(lds + 131072);
#pragma unroll
        for (int ai = 0; ai < 2; ++ai)
#pragma unroll
            for (int m = 0; m < 4; ++m) { const int row = u.pm * 256 + ai * 128 + wr * 64 + m * 16 + fr;
                const float rstd = __builtin_amdgcn_rsqf(rowsq[row] * (1.0f / D_MODEL) + EPS);
#pragma unroll
                for (int bj = 0; bj < 2; ++bj)
#pragma unroll
                    for (int n = 0; n < 2; ++n) acc[ai][bj][m][n] = acc[ai][bj][m][n] * rstd + *(const f32x4*)(bias2 + bj * 128 + cl + 16 * n); }
#pragma unroll
        for (int ai = 0; ai < 2; ++ai) { const int bi = 2 * ai + wr;
            if (fr == 0) {
#pragma unroll
                for (int n = 0; n < 2; ++n) *(LAS f32x4*)(X + (bi * 2 + 0) * 128 + cl + 16 * n) = acc[ai][0][0][n]; }
            if (fr == 15) {
#pragma unroll
                for (int n = 0; n < 2; ++n) *(LAS f32x4*)(X + (bi * 2 + 1) * 128 + cl + 16 * n) = acc[ai][0][3][n]; } }
        asm volatile("s_waitcnt lgkmcnt(0)" ::: "memory"); __builtin_amdgcn_s_barrier(); asm volatile("" ::: "memory");
        if (wr == 0 && fr < 2) {
#pragma unroll
            for (int n = 0; n < 2; ++n) { *(f32x4*)(HALO + (size_t)fr * FFN + ch0 + 16 * n) = acc[0][0][0][n]; if (fr == 0) *(f32x4*)(HALO + (size_t)4 * FFN + ch0 + 16 * n) = acc[0][1][0][n]; } }
        if (wr == 1 && fr >= 14) {
#pragma unroll
            for (int n = 0; n < 2; ++n) { *(f32x4*)(HALO + (size_t)(fr - 12) * FFN + ch0 + 16 * n) = acc[1][0][3][n]; if (fr == 15) *(f32x4*)(HALO + (size_t)5 * FFN + ch0 + 16 * n) = acc[1][1][3][n]; } }
#pragma unroll
        for (int n = 0; n < 2; ++n) {
            const f32x4 w0 = *(const f32x4*)(cw + ch0 + 16 * n), w1 = *(const f32x4*)(cw + FFN + ch0 + 16 * n), w2 = *(const f32x4*)(cw + 2 * FFN + ch0 + 16 * n), cbv = *(const f32x4*)(cb + ch0 + 16 * n);
#pragma unroll
            for (int ai = 0; ai < 2; ++ai) { const int bi = 2 * ai + wr;
                const f32x4 xprev = (bi > 0) ? *(const LAS f32x4*)(X + ((bi - 1) * 2 + 1) * 128 + cl + 16 * n) : (f32x4){0.f, 0.f, 0.f, 0.f};
                const f32x4 xnext = (bi < 3) ? *(const LAS f32x4*)(X + ((bi + 1) * 2 + 0) * 128 + cl + 16 * n) : (f32x4){0.f, 0.f, 0.f, 0.f};
#pragma unroll
                for (int m = 0; m < 4; ++m) { const f32x4 cur = acc[ai][0][m][n];
                    const f32x4 pu = (m > 0) ? ror1_4(acc[ai][0][m > 0 ? m - 1 : 0][n]) : xprev; const f32x4 ps = ror1_4(cur);
                    const f32x4 nd = (m < 3) ? rol1_4(acc[ai][0][m < 3 ? m + 1 : 3][n]) : xnext; const f32x4 ns = rol1_4(cur);
                    const f32x4 prev = (fr > 0) ? ps : pu, next = (fr < 15) ? ns : nd;
                    const f32x4 uu = w0 * prev + w1 * cur + w2 * next + cbv; const f32x4 gt = acc[ai][1][m][n];
                    f32x4 r; r.x = siluf_(uu.x) * gt.x; r.y = siluf_(uu.y) * gt.y; r.z = siluf_(uu.z) * gt.z; r.w = siluf_(uu.w) * gt.w;
                    const int rl = ai * 128 + wr * 64 + m * 16 + fr;
                    if (rl != 0 && rl != 255) { u32x2 o; o.x = pk2(r.x, r.y); o.y = pk2(r.z, r.w); *(u32x2*)(ACT + (size_t)(u.pm * 256 + rl) * FFN + ch0 + 16 * n) = o; } } } }
    }
};
__device__ __forceinline__ void halo_fix(const Params& p, int pm, int tid) {
    const float* HB = (const float*)(p.ws + WS_HALO); const float* H = HB + (size_t)pm * 6 * FFN; bf16* ACT = (bf16*)(p.ws + WS_ACT);
    for (int ch = tid; ch < FFN; ch += NTHREADS) {
        const float w0 = p.conv_w[ch], w1 = p.conv_w[FFN + ch], w2 = p.conv_w[2 * FFN + ch], cbv = p.conv_b[ch];
        const float pv = (pm & 7) ? HB[((size_t)(pm - 1) * 6 + 3) * FFN + ch] : 0.f; const float nx = ((pm & 7) != 7) ? HB[((size_t)(pm + 1) * 6 + 0) * FFN + ch] : 0.f;
        const float ut = w0 * pv + w1 * H[ch] + w2 * H[FFN + ch] + cbv; const float ub = w0 * H[2 * FFN + ch] + w1 * H[3 * FFN + ch] + w2 * nx + cbv;
        ACT[(size_t)(pm * 256) * FFN + ch] = (bf16)f2bf(siluf_(ut) * H[4 * FFN + ch]); ACT[(size_t)(pm * 256 + 255) * FFN + ch] = (bf16)f2bf(siluf_(ub) * H[5 * FFN + ch]);
    }
}
struct EpiFfnDown {
    static constexpr bool PERM = false, AFTER_DRAIN = false;
    unsigned char* ws; float* out;
    __device__ __forceinline__ void operator()(const f32x4 (&acc)[2][2][4][2], const pg8::Unit& u, int wr, int wc, int fr, int fq) const {
        const float* mod = (const float*)(ws + WS_MOD); const int b = (u.pm * 256) / SEQ; const float* g2 = mod + (size_t)b * IN_COLS + 5 * D_MODEL;
        EPI_LOOP_BEGIN
            float* o = out + (size_t)row * D_MODEL + col; const f32x4 xm = *(const f32x4*)o, g = *(const f32x4*)(g2 + col);
            *(f32x4*)o = xm + g * v;
        EPI_LOOP_END
    }
};

#define XB_TMO      128
#define XB_XCNT(j)  (256  + 64 * (j))
#define XB_XSUB(j)  (1280 + 64 * (j))
#define XB_XGEN(j)  (2304 + 64 * (j))
#define XB_TOP      3328
#define XB_TOPGEN   3392
#define XCD_BAR_WORDS 3456
#define XB_SPIN_CAP (1u << 18)

__device__ __forceinline__ unsigned xb_ld(unsigned* p)              { return __hip_atomic_load(p, __ATOMIC_RELAXED, __HIP_MEMORY_SCOPE_AGENT); }
__device__ __forceinline__ unsigned xb_add(unsigned* p, unsigned v) { return __hip_atomic_fetch_add(p, v, __ATOMIC_RELAXED, __HIP_MEMORY_SCOPE_AGENT); }
__device__ __forceinline__ unsigned xb_xcc_id() { return (unsigned)__builtin_amdgcn_s_getreg((3 << 11) | 20) & 0xFu; }
#define XB_SPIN(cond, bar) do { unsigned _sp = 0; while (cond) { __builtin_amdgcn_s_sleep(1); \
    if ((++_sp & 255u) == 0u) { if (xb_ld(&(bar)[XB_TMO])) break; if (_sp > XB_SPIN_CAP) { atomicAdd(&(bar)[XB_TMO], 1u); break; } } } } while (0)

struct XcdBarrier {
    unsigned* bar; unsigned x; int wave;
    volatile LAS unsigned* st;
};

__device__ __forceinline__ XcdBarrier xcd_barrier_post(unsigned* bar, volatile LAS unsigned* st, int wave_id) {
    XcdBarrier b; b.bar = bar; b.x = xb_xcc_id(); b.st = st; b.wave = wave_id;
    if (wave_id == 0 && lane_id() == 0) (void)xb_add(&bar[XB_XCNT(b.x)], 1u);
    return b;
}
__device__ __forceinline__ void xcd_barrier_complete(unsigned* bar, unsigned x, unsigned& nloc, unsigned& nx) {
    const unsigned G = gridDim.x * gridDim.y * gridDim.z;
    unsigned sum, cnt, mine, sp = 0u;
    for (;;) {
        sum = 0u; cnt = 0u; mine = 0u;
#pragma unroll
        for (unsigned j = 0; j < 16; ++j) { const unsigned c = xb_ld(&bar[XB_XCNT(j)]); sum += c; cnt += (c > 0u) ? 1u : 0u; mine = (j == x) ? c : mine; }
        if (sum == G) break;
        __builtin_amdgcn_s_sleep(1);
        if ((++sp & 255u) == 0u) { if (xb_ld(&bar[XB_TMO])) break; if (sp > XB_SPIN_CAP) { atomicAdd(&bar[XB_TMO], 1u); break; } }
    }
    nloc = mine > 0u ? mine : 1u; nx = cnt > 0u ? cnt : 1u;
}

__device__ __forceinline__ void xcd_barrier(const XcdBarrier& b) {
    asm volatile("s_waitcnt vmcnt(0)" ::: "memory");
    __syncthreads();
    if (b.wave == 0 && lane_id() == 0) {
        unsigned* bar = b.bar;
        __builtin_amdgcn_s_waitcnt(0);
        unsigned nloc = b.st[0], nx = b.st[1];
        if (nloc == 0u) { xcd_barrier_complete(bar, b.x, nloc, nx); b.st[0] = nloc; b.st[1] = nx; }
        const unsigned old = xb_add(&bar[XB_XSUB(b.x)], 1u);
        const unsigned gen = old / nloc;
        if (old + 1u == (gen + 1u) * nloc) {
            __builtin_amdgcn_fence(__ATOMIC_RELEASE, "agent");
            asm volatile("s_waitcnt vmcnt(0)" ::: "memory");
            const unsigned og = xb_add(&bar[XB_TOP], 1u);
            const unsigned tg = og / nx;
            if (og + 1u == (tg + 1u) * nx) xb_add(&bar[XB_TOPGEN], 1u);
            else XB_SPIN(xb_ld(&bar[XB_TOPGEN]) == tg, bar);
            __builtin_amdgcn_fence(__ATOMIC_ACQUIRE, "agent");
            xb_add(&bar[XB_XGEN(b.x)], 1u);
            asm volatile("s_waitcnt vmcnt(0)" ::: "memory");
        } else {
            XB_SPIN(xb_ld(&bar[XB_XGEN(b.x)]) == gen, bar);
            __builtin_amdgcn_fence(__ATOMIC_ACQUIRE, "agent");
            asm volatile("s_waitcnt vmcnt(0)" ::: "memory");
        }
    }
    __syncthreads();
}

constexpr size_t WS_BAR = 8192;

typedef short bf16x8 __attribute__((ext_vector_type(8)));
typedef short s16x4 __attribute__((ext_vector_type(4)));

__device__ __forceinline__ bf16x8 cat8u(const u32x2 a, const u32x2 b) { const u32x4 w = (u32x4){a.x, a.y, b.x, b.y}; return __builtin_bit_cast(bf16x8, w); }
__device__ __forceinline__ bf16x8 pack_p(const f32x4 a, const f32x4 b) {
    u32x4 w; w.x = pk2(a.x, a.y); w.y = pk2(a.z, a.w); w.z = pk2(b.x, b.y); w.w = pk2(b.z, b.w);
    return __builtin_bit_cast(bf16x8, w);
}

constexpr int A_TILE = 32768, A_KOFF = 0, A_VOFF = 16384;
constexpr int A_BIAS = 4 * A_TILE;
constexpr int A_ITEM = A_BIAS + 2048;
static_assert(A_ITEM + 64 <= 145408, "attention LDS");
constexpr size_t WS_ATTCTR = 32768;
static_assert(WS_ATTCTR >= WS_BAR + XCD_BAR_WORDS * 4 && WS_ATTCTR + 8 * 256 <= WS_ROWSQ, "attn counters (8 x 256 B apart) inside ctl");
#define ATT_BAR() do { asm volatile("s_waitcnt lgkmcnt(0)" ::: "memory"); __builtin_amdgcn_s_barrier(); asm volatile("" ::: "memory"); } while (0)
__device__ __forceinline__ void glds16(const void* gsrc, unsigned lds_dst) { unsigned keep;
    asm volatile("s_mov_b32 %0, m0\n\ts_mov_b32 m0, %2\n\ts_nop 0\n\tglobal_load_lds_dwordx4 %1, off\n\ts_mov_b32 m0, %0" : "=&s"(keep) : "v"(gsrc), "s"(lds_dst) : "memory"); }
__device__ __forceinline__ unsigned lds_addr(LAS const void* p) { return (unsigned)__builtin_amdgcn_readfirstlane((int)(unsigned)(unsigned long long)p); }

__device__ __forceinline__ void phase_attn(const Params& p, LAS unsigned char* lds) {
    int tid_o = tid_of(p.wave_id);
    const int tid = tid_o, lane = tid & 63, wave = __builtin_amdgcn_readfirstlane(tid >> 6);
    const int qb = wave & 3, rw = wave >> 2, li = lane & 15, g = lane >> 4;
    const bf16* QN = (const bf16*)(p.ws + WS_QN); const bf16* KN = (const bf16*)(p.ws + WS_KN); const bf16* VT = (const bf16*)(p.ws + WS_VN);
    bf16* YB = (bf16*)p.out + (size_t)3 * ML * WA;
    unsigned* ctr = (unsigned*)(p.ws + WS_ATTCTR);
    LAS float* btab = (LAS float*)(lds + A_BIAS);
    const float scale = 0.08838834764831845f;
    int krow_l[2], kch_l[2], vrow_l[2], vch_l[2];
#pragma unroll
    for (int e = 0; e < 2; ++e) { const int pk = 2 * wave + e; krow_l[e] = 4 * pk + (lane >> 4); kch_l[e] = (lane & 15) ^ (krow_l[e] & 15);
        vrow_l[e] = 8 * pk + (lane >> 3); vch_l[e] = (lane & 7) ^ ((vrow_l[e] >> 1) & 7); }
    const int myx = (int)(xb_xcc_id() & 7u);
    int qoff = 0;
    for (;;) {
        if (tid == 0) { unsigned v = 0xffffffffu;
            while (qoff < 8) { const int qx = (myx + qoff) & 7; const unsigned n = atomicAdd(ctr + 64 * qx, 1u); if (n < 64u) { v = (unsigned)((qx + 8 * (n >> 4)) * 16 + (n & 15)); break; } ++qoff; }
            *(LAS unsigned*)(lds + A_ITEM) = v; }
        __syncthreads();
        const unsigned itu = *(LAS unsigned*)(lds + A_ITEM);
        if (itu == 0xffffffffu) break;
        const int it = (int)itu;
        const int rp = it & 15, h = (it >> 4) & 7, b = it >> 7;
        const int r = 2 * rp + rw;
        const int rs = min(max(r - 4, 0), 24), ks0 = min(max(16 * qb - 8, 0), 32);
        const int kr0 = min(max(2 * rp - 4, 0), 24), nband = min(max(2 * rp + 1 - 4, 0), 24) + 8 - kr0, NT = nband + 4;
        const int cq = 16 * qb + li, cs = min(max(cq - 8, 0), 48);
        const size_t qrow = (size_t)b * SEQ + r * GRID_W + cq;
        if (tid < 15 * 31) btab[tid] = p.rel_bias[h * 465 + tid];
        bf16x8 qf[4];
#pragma unroll
        for (int ks = 0; ks < 4; ++ks) qf[ks] = *(const bf16x8*)(QN + qrow * WA + h * HD + 32 * ks + 8 * g);
        asm volatile("s_waitcnt vmcnt(0)" ::: "memory");
        const bf16* kg0 = KN + (size_t)h * HD + (size_t)krow_l[0] * WA + 8 * kch_l[0]; const bf16* kg1 = KN + (size_t)h * HD + (size_t)krow_l[1] * WA + 8 * kch_l[1];
        const bf16* vg0 = VT + ((size_t)(b * NHEAD + h) * HD + vrow_l[0]) * VT_PITCH + 8 * vch_l[0]; const bf16* vg1 = VT + ((size_t)(b * NHEAD + h) * HD + vrow_l[1]) * VT_PITCH + 8 * vch_l[1];
#define ATT_DMA(ti_) do { const int t_ = (ti_) < NT ? (ti_) : NT - 1; const unsigned la_ = lds_addr(lds + ((ti_) & 3) * A_TILE + wave * 2048); \
            const size_t krow0 = (t_ < nband) ? ((size_t)b * SEQ + (kr0 + t_) * GRID_W) : ((size_t)ML + b * CTX + 64 * (t_ - nband)); \
            const int tok0 = (t_ < nband) ? ((kr0 + t_) * GRID_W) : (SEQ + 64 * (t_ - nband)); \
            glds16(kg0 + krow0 * WA, la_ + A_KOFF); glds16(kg1 + krow0 * WA, la_ + A_KOFF + 1024); glds16(vg0 + tok0, la_ + A_VOFF); glds16(vg1 + tok0, la_ + A_VOFF + 1024); } while (0)
        ATT_DMA(0); ATT_DMA(1); ATT_DMA(2);
        f32x4 ot[8];
#pragma unroll
        for (int db = 0; db < 8; ++db) ot[db] = (f32x4){0.f, 0.f, 0.f, 0.f};
        float mrun = -1e30f, l = 0.f;
        const int kx = (ks0 + li) & 15, vy = (li >> 1) & 7;
        int koff[4];
#pragma unroll
        for (int ks = 0; ks < 4; ++ks) koff[ks] = A_KOFF + (ks0 + li) * 256 + (((4 * ks + g) ^ kx) << 4);
        const int vrow_off = A_VOFF + li * 128 + 8 * (g & 1);
        const int gq = g >> 1;
#pragma unroll 1
        for (int ti = 0; ti < NT; ++ti) {
            asm volatile("s_waitcnt vmcnt(8)" ::: "memory");
            ATT_BAR();
            ATT_DMA(ti + 3);
            const LAS unsigned char* tb = lds + (ti & 3) * A_TILE;
            if (ti < nband) {
                const int kr = kr0 + ti;
                if (kr >= rs && kr < rs + 8) {
                    f32x4 st[2];
#pragma unroll
                    for (int kb = 0; kb < 2; ++kb) { f32x4 a = (f32x4){0.f, 0.f, 0.f, 0.f};
#pragma unroll
                        for (int ks = 0; ks < 4; ++ks) a = __builtin_amdgcn_mfma_f32_16x16x32_bf16(*(const LAS bf16x8*)(tb + koff[ks] + kb * 4096), qf[ks], a, 0, 0, 0);
                        st[kb] = a; }
                    const int dr = kr - r + 7; float gm = -1e30f;
#pragma unroll
                    for (int kb = 0; kb < 2; ++kb)
#pragma unroll
                        for (int j = 0; j < 4; ++j) { const int kcol = ks0 + 16 * kb + 4 * g + j; const bool valid = (kcol >= cs) && (kcol < cs + 16);
                            const int bi = valid ? (dr * 31 + (kcol - cq + 15)) : 0;
                            const float sv = valid ? (st[kb][j] * scale + btab[bi]) : -1e30f; st[kb][j] = sv; gm = fmaxf(gm, sv); }
                    gm = fmaxf(gm, __shfl_xor(gm, 16)); gm = fmaxf(gm, __shfl_xor(gm, 32));
                    const float mnew = fmaxf(mrun, gm); const float alpha = __expf(mrun - mnew); mrun = mnew; l *= alpha;
#pragma unroll
                    for (int db = 0; db < 8; ++db) ot[db] = ot[db] * alpha;
#pragma unroll
                    for (int kb = 0; kb < 2; ++kb)
#pragma unroll
                        for (int j = 0; j < 4; ++j) { const float sv = st[kb][j]; const float e = (sv > -1e29f) ? __expf(sv - mnew) : 0.f; st[kb][j] = e; l += e; }
                    const bf16x8 pb = pack_p(st[0], st[1]);
                    const int c0 = (ks0 >> 3) + gq;
#pragma unroll
                    for (int db = 0; db < 8; ++db) { const LAS unsigned char* vp = tb + vrow_off + db * 2048;
                        ot[db] = __builtin_amdgcn_mfma_f32_16x16x32_bf16(cat8u(*(const LAS u32x2*)(vp + ((c0 ^ vy) << 4)), *(const LAS u32x2*)(vp + (((c0 + 2) ^ vy) << 4))), pb, ot[db], 0, 0, 0); }
                }
            } else {
                f32x4 st[4];
#pragma unroll
                for (int kb = 0; kb < 4; ++kb) { f32x4 a = (f32x4){0.f, 0.f, 0.f, 0.f};
#pragma unroll
                    for (int ks = 0; ks < 4; ++ks) a = __builtin_amdgcn_mfma_f32_16x16x32_bf16(*(const LAS bf16x8*)(tb + A_KOFF + (16 * kb + li) * 256 + (((4 * ks + g) ^ li) << 4)), qf[ks], a, 0, 0, 0);
                    st[kb] = a * scale; }
                float gm = -1e30f;
#pragma unroll
                for (int kb = 0; kb < 4; ++kb) gm = fmaxf(fmaxf(gm, fmaxf(st[kb][0], st[kb][1])), fmaxf(st[kb][2], st[kb][3]));
                gm = fmaxf(gm, __shfl_xor(gm, 16)); gm = fmaxf(gm, __shfl_xor(gm, 32));
                const float mnew = fmaxf(mrun, gm); const float alpha = __expf(mrun - mnew); mrun = mnew; l *= alpha;
#pragma unroll
                for (int db = 0; db < 8; ++db) ot[db] = ot[db] * alpha;
#pragma unroll
                for (int kb = 0; kb < 4; ++kb)
#pragma unroll
                    for (int j = 0; j < 4; ++j) { const float e = __expf(st[kb][j] - mnew); st[kb][j] = e; l += e; }
#pragma unroll
                for (int kp2 = 0; kp2 < 2; ++kp2) { const bf16x8 pb = pack_p(st[2 * kp2], st[2 * kp2 + 1]);
                    const int c0 = 4 * kp2 + gq;
#pragma unroll
                    for (int db = 0; db < 8; ++db) { const LAS unsigned char* vp = tb + vrow_off + db * 2048;
                        ot[db] = __builtin_amdgcn_mfma_f32_16x16x32_bf16(cat8u(*(const LAS u32x2*)(vp + ((c0 ^ vy) << 4)), *(const LAS u32x2*)(vp + (((c0 + 2) ^ vy) << 4))), pb, ot[db], 0, 0, 0); } }
            }
        }
        asm volatile("s_waitcnt vmcnt(0)" ::: "memory");
        l += __shfl_xor(l, 16); l += __shfl_xor(l, 32);
        const float inv = 1.0f / l;
#pragma unroll
        for (int db = 0; db < 8; ++db) { const f32x4 o = ot[db] * inv; u32x2 w; w.x = pk2(o.x, o.y); w.y = pk2(o.z, o.w);
            *(u32x2*)(YB + qrow * WA + h * HD + 16 * db + 4 * g) = w; }
#undef ATT_DMA
    }
}

constexpr int HP = 160;
constexpr int H_QH = 0, H_KH = 20480, H_KE = 40960, H_QD = 61440, H_KD = 81920;
constexpr int HP2 = 48;
constexpr int H_Q2 = 102400, H_K2 = 108544;
constexpr int PP = 144;
constexpr int H_P = 114688;
constexpr int H_T = 123904;
constexpr int H_D = 125952;
constexpr int HIMG_QD = 0, HIMG_KD = 16384, HIMG_P = 32768, HIMG_D = 40960, HIMG_BYTES = 41472;
constexpr int NCH = (CTX + SEQ) / 64;
constexpr int VP = 288;
constexpr int HPK = 136;
constexpr int SB_QD = 0, SB_KD = 20480, SB_P = 40960, SB_D = 50176, SB_V = 50688, SB_BYTES = 69120;
static_assert(2 * SB_BYTES <= 145408, "scan buffers");

__device__ __forceinline__ s16x4 lds_tr(LAS const unsigned char* p) {
    return __builtin_bit_cast(s16x4, __builtin_amdgcn_ds_read_tr16_b64_v4i16((LAS s16x4*)p));
}
__device__ __forceinline__ bf16x8 cat8(const s16x4 a, const s16x4 b) { return __builtin_shufflevector(a, b, 0, 1, 2, 3, 4, 5, 6, 7); }

__device__ __forceinline__ size_t hg_row(int dir, int b, int tau) {
    if (tau < CTX) return (size_t)ML + b * CTX + (dir == 0 ? tau : CTX - 1 - tau);
    const int t = tau - CTX; return (size_t)b * SEQ + (dir == 0 ? t : SEQ - 1 - t);
}

__device__ __forceinline__ void hgrn_prep(const Params& p, LAS unsigned char* lds, int vb, int nb) {
    int tid_o = tid_of(p.wave_id);
    const int tid = tid_o, lane = tid & 63, wave = __builtin_amdgcn_readfirstlane(tid >> 6);
    const int k = tid & 127, J = __builtin_amdgcn_readfirstlane(tid >> 7);
    const int li = lane & 15, g = lane >> 4, qq = li >> 2, pp = li & 3;
    LAS float* Tl = (LAS float*)(lds + H_T); LAS float* Dl = (LAS float*)(lds + H_D);
    float lf[16]; unsigned qv[16];
#define HG_LOADP(idx_) do { const int id_ = (idx_); const int ch_ = id_ / NCH, cc_ = id_ % NCH; const int dir_ = ch_ / (BATCH * NHEAD), b_ = (ch_ / NHEAD) % BATCH, h_ = ch_ % NHEAD; \
        const size_t row0_ = hg_row(dir_, b_, 64 * cc_ + 16 * J); const long st_ = dir_ ? -(long)WA : (long)WA; \
        const float* lfp_ = (const float*)(p.ws + (dir_ == 0 ? WS_FW : WS_FB)) + row0_ * WA + h_ * HD + k; const bf16* qp_ = (const bf16*)(p.ws + WS_QA) + row0_ * WA + h_ * HD + k; \
        _Pragma("unroll") for (int i = 0; i < 16; ++i) { lf[i] = lfp_[(long)i * st_]; qv[i] = (cc_ >= 4) ? (unsigned)qp_[(long)i * st_] : 0u; } } while (0)
    if (vb < 64 * NCH) HG_LOADP(vb);
    for (int idx = vb; idx < 64 * NCH; idx += nb) {
        const int c = idx % NCH;
        float cum[16]; float run = 0.f;
#pragma unroll
        for (int i = 0; i < 16; ++i) { run += lf[i]; cum[i] = run; }
        Tl[J * 128 + k] = run;
        ATT_BAR();
        const float T0 = Tl[k], T1 = Tl[128 + k], T2 = Tl[256 + k], T3 = Tl[384 + k];
        const float bJ = (J > 0 ? T0 : 0.f) + (J > 1 ? T1 : 0.f) + (J > 2 ? T2 : 0.f);
        const float tail = (J < 1 ? T1 : 0.f) + (J < 2 ? T2 : 0.f) + (J < 3 ? T3 : 0.f);
        const float eb = __expf(bJ), et = __expf(tail), eT = __expf(run);
        const float x2 = (J == 3) ? __expf(T2) : __expf(T1);
        float qh[16], kh[16];
#pragma unroll
        for (int i = 0; i < 16; ++i) { const float e1 = __expf(cum[i]); const float r1 = __builtin_amdgcn_rcpf(e1); const float kk = 1.0f - __expf(lf[i]);
            qh[i] = __builtin_bit_cast(float, qv[i] << 16) * e1; kh[i] = kk * r1; }
        {
            LAS unsigned char* rowp = lds + k * HP + 32 * J;
            u32x4 w0, w1;
#define HG_WRITE(OFF, EXPR) do { \
            { float v0_, v1_; \
              { const int i = 0; v0_ = (EXPR); } { const int i = 1; v1_ = (EXPR); } w0.x = pk2(v0_, v1_); \
              { const int i = 2; v0_ = (EXPR); } { const int i = 3; v1_ = (EXPR); } w0.y = pk2(v0_, v1_); \
              { const int i = 4; v0_ = (EXPR); } { const int i = 5; v1_ = (EXPR); } w0.z = pk2(v0_, v1_); \
              { const int i = 6; v0_ = (EXPR); } { const int i = 7; v1_ = (EXPR); } w0.w = pk2(v0_, v1_); \
              { const int i = 8; v0_ = (EXPR); } { const int i = 9; v1_ = (EXPR); } w1.x = pk2(v0_, v1_); \
              { const int i = 10; v0_ = (EXPR); } { const int i = 11; v1_ = (EXPR); } w1.y = pk2(v0_, v1_); \
              { const int i = 12; v0_ = (EXPR); } { const int i = 13; v1_ = (EXPR); } w1.z = pk2(v0_, v1_); \
              { const int i = 14; v0_ = (EXPR); } { const int i = 15; v1_ = (EXPR); } w1.w = pk2(v0_, v1_); } \
            *(LAS u32x4*)(OFF) = w0; *(LAS u32x4*)((OFF) + 16) = w1; } while (0)
            HG_WRITE(rowp + H_QH, qh[i]);
            HG_WRITE(rowp + H_KH, kh[i]);
            HG_WRITE(rowp + H_KE, kh[i] * eT);
            HG_WRITE(rowp + H_QD, qh[i] * eb);
            HG_WRITE(rowp + H_KD, kh[i] * (eT * et));
            if (J == 3) { HG_WRITE(lds + H_Q2 + k * HP2, qh[i] * x2); }
            if (J == 0) { HG_WRITE(lds + H_K2 + k * HP2, kh[i] * (eT * x2)); }
#undef HG_WRITE
            if (J == 3) Dl[k] = __expf(bJ + run);
        }
        if (idx + nb < 64 * NCH) HG_LOADP(idx + nb);
        ATT_BAR();
        const bool lat = (c >= 4);
        if (lat) {
#pragma unroll
            for (int rep = 0; rep < 2; ++rep) {
                int I, Jb;
                if (rep == 0) { I = (wave < 4) ? wave : (wave == 4 ? 1 : (wave == 7 ? 3 : 2)); Jb = (wave < 4) ? wave : (wave == 4 ? 0 : (wave == 5 ? 0 : (wave == 6 ? 1 : 2))); }
                else { if (wave >= 2) break; I = 3; Jb = wave; }
                int aoff, apitch, acol, boff, bpitch, bcol;
                if (I == Jb) { aoff = H_KH; apitch = HP; acol = 16 * Jb; boff = H_QH; bpitch = HP; bcol = 16 * I; }
                else if (I == Jb + 1 && I != 2) { aoff = H_KE; apitch = HP; acol = 16 * Jb; boff = H_QH; bpitch = HP; bcol = 16 * I; }
                else if (I == 2) { if (Jb == 0) { aoff = H_K2; apitch = HP2; acol = 0; } else { aoff = H_KE; apitch = HP; acol = 16; } boff = H_QH; bpitch = HP; bcol = 32; }
                else { if (Jb == 0) { aoff = H_K2; apitch = HP2; acol = 0; } else { aoff = H_KE; apitch = HP; acol = 16; } boff = H_Q2; bpitch = HP2; bcol = 0; }
                f32x4 pt = (f32x4){0.f, 0.f, 0.f, 0.f};
#pragma unroll
                for (int ks = 0; ks < 4; ++ks) {
                    const int r0 = 32 * ks + 4 * g + qq;
                    const bf16x8 a = cat8(lds_tr(lds + aoff + r0 * apitch + (acol + 4 * pp) * 2), lds_tr(lds + aoff + (r0 + 16) * apitch + (acol + 4 * pp) * 2));
                    const bf16x8 bb = cat8(lds_tr(lds + boff + r0 * bpitch + (bcol + 4 * pp) * 2), lds_tr(lds + boff + (r0 + 16) * bpitch + (bcol + 4 * pp) * 2));
                    pt = __builtin_amdgcn_mfma_f32_16x16x32_bf16(a, bb, pt, 0, 0, 0);
                }
                if (I == Jb) {
#pragma unroll
                    for (int j = 0; j < 4; ++j) if (4 * g + j > li) pt[j] = 0.f;
                }
                u32x2 w; w.x = pk2(pt.x, pt.y); w.y = pk2(pt.z, pt.w);
                *(LAS u32x2*)(lds + H_P + (16 * I + li) * PP + (16 * Jb + 4 * g) * 2) = w;
            }
        }
        ATT_BAR();
        unsigned char* img = p.ws + WS_HIMG + (size_t)idx * HIMG_BYTES;
#pragma unroll
        for (int e = 0; e < 2; ++e) { const int id = tid + 512 * e; const int kr = id >> 3, part = id & 7;
            if (lat) *(u32x4*)(img + HIMG_QD + id * 16) = *(const LAS u32x4*)(lds + H_QD + kr * HP + 16 * part);
            *(u32x4*)(img + HIMG_KD + id * 16) = *(const LAS u32x4*)(lds + H_KD + kr * HP + 16 * part); }
        if (lat) *(u32x4*)(img + HIMG_P + tid * 16) = *(const LAS u32x4*)(lds + H_P + (tid >> 3) * PP + 16 * (tid & 7));
        if (tid < 32) *(u32x4*)(img + HIMG_D + tid * 16) = *(const LAS u32x4*)(lds + H_D + 16 * tid);
    }
#undef HG_LOADP
    __syncthreads();
}

__device__ __forceinline__ void hgrn_scan(const Params& p, LAS unsigned char* lds, int chain) {
    int tid_o = tid_of(p.wave_id);
    const int tid = tid_o, lane = tid & 63, wave = __builtin_amdgcn_readfirstlane(tid >> 6);
    const int li = lane & 15, g = lane >> 4, qq = li >> 2, pp = li & 3;
    const int dir = chain / (BATCH * NHEAD), b = (chain / NHEAD) % BATCH, h = chain % NHEAD;
    const bf16* IA = (const bf16*)(p.ws + WS_IA) + h * HD;
    bf16* O = ((bf16*)p.out + (dir == 0 ? 0 : (size_t)ML * WA)) + h * HD + 16 * wave + li;
    const long ost = dir ? -(long)WA : (long)WA;
    const unsigned char* img0 = p.ws + WS_HIMG + (size_t)chain * NCH * HIMG_BYTES;
    f32x4 S[8];
#pragma unroll
    for (int i = 0; i < 8; ++i) S[i] = (f32x4){0.f, 0.f, 0.f, 0.f};
    u32x4 rq[2][2], rk[2][2], rp[2], rd[2], rv[2][2];
#define HS_LOAD(c_, set_) do { const int cc_ = (c_); const unsigned char* im_ = img0 + (size_t)cc_ * HIMG_BYTES; \
        if (cc_ >= 4) { rq[set_][0] = *(const u32x4*)(im_ + HIMG_QD + tid * 16); rq[set_][1] = *(const u32x4*)(im_ + HIMG_QD + (tid + 512) * 16); rp[set_] = *(const u32x4*)(im_ + HIMG_P + tid * 16); } \
        rk[set_][0] = *(const u32x4*)(im_ + HIMG_KD + tid * 16); rk[set_][1] = *(const u32x4*)(im_ + HIMG_KD + (tid + 512) * 16); \
        if (tid < 32) rd[set_] = *(const u32x4*)(im_ + HIMG_D + tid * 16); \
        _Pragma("unroll") for (int e = 0; e < 2; ++e) { const int idx_ = tid * 2 + e; const size_t row_ = hg_row(dir, b, 64 * cc_ + (idx_ >> 4)); rv[set_][e] = *(const u32x4*)(IA + row_ * WA + 8 * (idx_ & 15)); } } while (0)
#define HS_STORE(c_, set_) do { const int cc_ = (c_); LAS unsigned char* bb_ = lds + (cc_ & 1) * SB_BYTES; \
        if (cc_ >= 4) { *(LAS u32x4*)(bb_ + SB_QD + (tid >> 3) * HP + 16 * (tid & 7)) = rq[set_][0]; *(LAS u32x4*)(bb_ + SB_QD + ((tid >> 3) + 64) * HP + 16 * (tid & 7)) = rq[set_][1]; \
                        *(LAS u32x4*)(bb_ + SB_P + (tid >> 3) * PP + 16 * (tid & 7)) = rp[set_]; } \
        { LAS unsigned char* k0_ = bb_ + SB_KD + (tid >> 3) * HPK + 16 * (tid & 7); LAS unsigned char* k1_ = k0_ + 64 * HPK; \
          *(LAS u32x2*)k0_ = (u32x2){rk[set_][0].x, rk[set_][0].y}; *(LAS u32x2*)(k0_ + 8) = (u32x2){rk[set_][0].z, rk[set_][0].w}; *(LAS u32x2*)k1_ = (u32x2){rk[set_][1].x, rk[set_][1].y}; *(LAS u32x2*)(k1_ + 8) = (u32x2){rk[set_][1].z, rk[set_][1].w}; } \
        if (tid < 32) *(LAS u32x4*)(bb_ + SB_D + 16 * tid) = rd[set_]; \
        _Pragma("unroll") for (int e = 0; e < 2; ++e) { const int idx_ = tid * 2 + e; *(LAS u32x4*)(bb_ + SB_V + (idx_ >> 4) * VP + 16 * (idx_ & 15)) = rv[set_][e]; } } while (0)
    HS_LOAD(0, 0); HS_LOAD(1, 1);
    HS_STORE(0, 0);
    HS_LOAD(2, 0);
    ATT_BAR();
#pragma unroll 1
    for (int c2 = 0; c2 < NCH; c2 += 2) {
#pragma unroll
    for (int uu = 0; uu < 2; ++uu) { const int c = c2 + uu;
        const LAS unsigned char* bb = lds + (c & 1) * SB_BYTES;
        const bool lat = (c >= 4);
        bf16x8 vf[2];
#pragma unroll
        for (int sp = 0; sp < 2; ++sp) {
            const LAS unsigned char* vb0 = bb + SB_V + (32 * sp + 4 * g + qq) * VP + (16 * wave + 4 * pp) * 2;
            vf[sp] = cat8(lds_tr(vb0), lds_tr(vb0 + 16 * VP));
        }
        if (lat) {
            bf16x8 sb[4];
#pragma unroll
            for (int ks = 0; ks < 4; ++ks) sb[ks] = pack_p(S[2 * ks], S[2 * ks + 1]);
            bf16* orow = O + (long)hg_row(dir, b, 64 * c) * WA;
#pragma unroll
            for (int I = 0; I < 4; ++I) {
                f32x4 o = (f32x4){0.f, 0.f, 0.f, 0.f};
#pragma unroll
                for (int ks = 0; ks < 4; ++ks) {
                    const LAS unsigned char* ap = bb + SB_QD + (32 * ks + 4 * g + qq) * HP + (16 * I + 4 * pp) * 2;
                    o = __builtin_amdgcn_mfma_f32_16x16x32_bf16(cat8(lds_tr(ap), lds_tr(ap + 16 * HP)), sb[ks], o, 0, 0, 0);
                }
#pragma unroll
                for (int sp = 0; sp < 2; ++sp) {
                    if (2 * sp > I) break;
                    const LAS unsigned char* pr = bb + SB_P + (16 * I + li) * PP + (32 * sp + 4 * g) * 2;
                    const u32x2 lo = *(const LAS u32x2*)pr; u32x2 hi = (u32x2){0u, 0u};
                    if (2 * sp + 1 <= I) hi = *(const LAS u32x2*)(pr + 32);
                    o = __builtin_amdgcn_mfma_f32_16x16x32_bf16(cat8u(lo, hi), vf[sp], o, 0, 0, 0);
                }
#pragma unroll
                for (int j = 0; j < 4; ++j) orow[(long)(16 * I + 4 * g + j) * ost] = (bf16)f2bf(o[j]);
            }
        }
#pragma unroll
        for (int blk = 0; blk < 8; ++blk) {
            const f32x4 d4 = *(const LAS f32x4*)(bb + SB_D + (16 * blk + 4 * g) * 4);
            f32x4 s = S[blk] * d4;
#pragma unroll
            for (int sp = 0; sp < 2; ++sp) {
                const LAS unsigned char* kp = bb + SB_KD + (16 * blk + li) * HPK + (32 * sp + 4 * g) * 2;
                s = __builtin_amdgcn_mfma_f32_16x16x32_bf16(cat8u(*(const LAS u32x2*)kp, *(const LAS u32x2*)(kp + 32)), vf[sp], s, 0, 0, 0);
            }
            S[blk] = s;
        }
        if (c + 1 < NCH) HS_STORE(c + 1, (uu + 1) & 1);
        if (c + 3 < NCH) HS_LOAD(c + 3, (uu + 1) & 1);
        ATT_BAR();
    } }
#undef HS_LOAD
#undef HS_STORE
    __syncthreads();
}

__device__ __forceinline__ void phase_readout(const Params& p, int vb, int nb) {
    const int tid = tid_of(p.wave_id), lane = tid & 63, wave = p.wave_id;
    const bf16* OF = (const bf16*)p.out; const bf16* OB = OF + (size_t)ML * WA; const bf16* GA = (const bf16*)(p.ws + WS_GA);
    bf16* YA = (bf16*)p.out + (size_t)2 * ML * WA;
    f32x4 ng[4];
#pragma unroll
    for (int i = 0; i < 4; ++i) ng[i] = *(const f32x4*)(p.hgrn_norm_g + 16 * (lane & 7) + 4 * i);
    const int NGW = nb * 8;
    for (int row0 = vb * 8 + wave; row0 < ML; row0 += 2 * NGW) {
        u32x4 a[2][2], b[2][2], gg[2][2];
#pragma unroll
        for (int u = 0; u < 2; ++u) { const int row = row0 + u * NGW; if (row < ML) { const size_t off = (size_t)row * WA + 16 * lane;
            a[u][0] = *(const u32x4*)(OF + off); a[u][1] = *(const u32x4*)(OF + off + 8); b[u][0] = *(const u32x4*)(OB + off); b[u][1] = *(const u32x4*)(OB + off + 8);
            gg[u][0] = *(const u32x4*)(GA + off); gg[u][1] = *(const u32x4*)(GA + off + 8); } }
#pragma unroll
        for (int u = 0; u < 2; ++u) { const int row = row0 + u * NGW; if (row < ML) { const size_t off = (size_t)row * WA + 16 * lane;
            float o[16]; float ss = 0.f;
#pragma unroll
            for (int q = 0; q < 8; ++q) { const unsigned wa = a[u][q >> 2][q & 3], wb = b[u][q >> 2][q & 3]; o[2 * q] = bflo(wa) + bflo(wb); o[2 * q + 1] = bfhi(wa) + bfhi(wb); ss += o[2 * q] * o[2 * q] + o[2 * q + 1] * o[2 * q + 1]; }
            ss += __shfl_xor(ss, 1); ss += __shfl_xor(ss, 2); ss += __shfl_xor(ss, 4);
            const float rstd = __builtin_amdgcn_rsqf(ss * (1.0f / HD) + EPS);
            u32x4 w[2];
#pragma unroll
            for (int q = 0; q < 8; ++q) { const unsigned wg = gg[u][q >> 2][q & 3];
                w[q >> 2][q & 3] = pk2(o[2 * q] * rstd * ng[q >> 1][(2 * q) & 3] * bflo(wg), o[2 * q + 1] * rstd * ng[q >> 1][(2 * q + 1) & 3] * bfhi(wg)); }
            *(u32x4*)(YA + off) = w[0]; *(u32x4*)(YA + off + 8) = w[1]; } }
    }
}

__device__ __forceinline__ void phase_bias2(const Params& p, int vb, int nb) {
    const int tid = tid_of(p.wave_id); const float* mod = (const float*)(p.ws + WS_MOD); float* bias2 = (float*)(p.ws + WS_BIAS2);
    constexpr int NCC = 2 * FFN / 512, NKC = D_MODEL / 64;
    for (int item = vb; item < NCC * NKC; item += nb) {
        const int cc = item % NCC, kc = item / NCC; const int col = cc * 512 + tid;
        const float* W = (col < FFN) ? p.w1 + col : p.w3 + (col - FFN);
        float a0 = 0.f, a1 = 0.f, a2 = 0.f, a3 = 0.f;
#pragma unroll 8
        for (int k = kc * 64; k < kc * 64 + 64; ++k) { const float w = W[(size_t)k * FFN];
            a0 += w * mod[0 * IN_COLS + 3 * D_MODEL + k]; a1 += w * mod[1 * IN_COLS + 3 * D_MODEL + k]; a2 += w * mod[2 * IN_COLS + 3 * D_MODEL + k]; a3 += w * mod[3 * IN_COLS + 3 * D_MODEL + k]; }
        atomicAdd(bias2 + 0 * 2 * FFN + col, a0); atomicAdd(bias2 + 1 * 2 * FFN + col, a1); atomicAdd(bias2 + 2 * 2 * FFN + col, a2); atomicAdd(bias2 + 3 * 2 * FFN + col, a3);
    }
}

constexpr int LDS_MISC_OFF = 145408;
constexpr int LDS_BYTES = 146432;
static_assert(WS_BAR + XCD_BAR_WORDS * 4 <= WS_ROWSQ, "barrier words inside ctl");

#if defined(__HIP_DEVICE_COMPILE__)
#define LOAD_P() Params p; { const __attribute__((address_space(4))) Params* q_ = (const __attribute__((address_space(4))) Params*)__builtin_amdgcn_kernarg_segment_ptr(); asm volatile("" : "+s"(q_)); \
    p = *q_; p.wave_id = wave_id; } unsigned char* ws = p.ws; (void)ws
#else
#define LOAD_P() Params p = p_in; p.wave_id = wave_id; unsigned char* ws = p.ws; (void)ws
#endif
__global__ void __launch_bounds__(NTHREADS, 2) mega_fwd(Params p_in) {
    const int wave_id = __builtin_amdgcn_readfirstlane((int)(threadIdx.x >> 6));
    extern __shared__ __attribute__((aligned(16))) unsigned char lds_raw[];
    LAS unsigned char* lds = (LAS unsigned char*)lds_raw;
    const int nb = gridDim.x;
    const int vb = (nb % 8 == 0) ? ((int)(blockIdx.x % 8) * (nb / 8) + (int)(blockIdx.x / 8)) : (int)blockIdx.x;
    const int bx = blockIdx.x;
    volatile LAS unsigned* misc = (volatile LAS unsigned*)(lds + LDS_MISC_OFF);
    if (wave_id == 0) misc[lane_id()] = 0u;
    __syncthreads();
    XcdBarrier bar = xcd_barrier_post((unsigned*)(p_in.ws + WS_BAR), misc + 8, wave_id);
#define GRID_BAR() xcd_barrier(bar)

    { LOAD_P(); phase_mod(p, lds, vb, nb); __syncthreads(); phase_wconv_in(p, lds, vb * 8 + wave_id, nb * 8); }
    GRID_BAR();
    { LOAD_P(); phase_h(p, vb, nb); }
    GRID_BAR();
    { LOAD_P(); pg8::Gemm g{(const bf16*)(ws + WS_H), (const bf16*)(ws + WS_WINT), MT, IN_COLS, D_MODEL}; InProjOrder S; S.init(ML, IN_COLS, nb, bx);
      EpiInProj E{ws, lds, p.q_norm_g, p.k_norm_g}; pg8::gemm_phase<EpiInProj, InProjOrder, true, true>(lds, g, S, E, wave_id);
      const int nfree = nb - CTX_UNITS;
      if (nfree >= 64) { if (bx >= CTX_UNITS) phase_wconv_rest(p, lds, (bx - CTX_UNITS) * 8 + wave_id, nfree * 8); }
      else phase_wconv_rest(p, lds, bx * 8 + wave_id, nb * 8); }
    GRID_BAR();
    { LOAD_P(); hgrn_prep(p, lds, vb, nb); }
    GRID_BAR();
    { LOAD_P();
      if (bx < 2 * BATCH * NHEAD) hgrn_scan(p, lds, bx);
      __syncthreads();
      phase_attn(p, lds); }
    GRID_BAR();
    { LOAD_P(); phase_readout(p, vb, nb); }
    GRID_BAR();
    { LOAD_P(); pg8::Gemm g{(const bf16*)p.out + (size_t)2 * ML * WA, (const bf16*)(ws + WS_WAT), ML, D_MODEL, WA};
      MergeOrder S; S.init(ML, D_MODEL, nb, bx); S.A1 = (const bf16*)p.out + (size_t)3 * ML * WA; S.B1 = (const bf16*)(ws + WS_WBT);
      EpiMerge E{ws, (float*)(ws + WS_T1)}; pg8::gemm_phase<EpiMerge, MergeOrder, true, true>(lds, g, S, E, wave_id); }
    GRID_BAR();
    { LOAD_P(); pg8::Gemm g{(const bf16*)(ws + WS_Z), (const bf16*)(ws + WS_WOT), ML, D_MODEL, D_MODEL}; pg8::StaticOrder S; S.init(ML, D_MODEL, nb, bx);
      EpiOutProj E{ws, p.x, p.norm2_g, p.out}; pg8::gemm_phase<EpiOutProj, pg8::StaticOrder, true, true>(lds, g, S, E, wave_id); }
    GRID_BAR();
    { LOAD_P(); pg8::Gemm g{(const bf16*)(ws + WS_XMG), (const bf16*)(ws + WS_W13T), ML, 2 * FFN, D_MODEL}; pg8::StaticOrder S; S.init(ML, 2 * FFN, nb, bx);
      EpiFfnUp E{ws, lds, p.conv_w, p.conv_b}; pg8::gemm_phase<EpiFfnUp, pg8::StaticOrder, true, true>(lds, g, S, E, wave_id); }
    GRID_BAR();
    { LOAD_P(); { pg8::StaticOrder S0; S0.init(ML, D_MODEL, nb, bx); pg8::Unit u0; const int tid = tid_of(wave_id); for (int i = 0; S0.next(i, u0); ++i) halo_fix(p, u0.pm, tid); }
      asm volatile("s_waitcnt vmcnt(0)" ::: "memory"); __syncthreads();
      pg8::Gemm g{(const bf16*)(ws + WS_ACT), (const bf16*)(ws + WS_W2T), ML, D_MODEL, FFN}; pg8::StaticOrder S; S.init(ML, D_MODEL, nb, bx);
      EpiFfnDown E{ws, p.out}; pg8::gemm_phase<EpiFfnDown, pg8::StaticOrder, true, true>(lds, g, S, E, wave_id); }
#undef GRID_BAR
}

extern "C" void kernel_launch(void* const* d_in, const int* in_sizes, int n_in, void* d_out, int out_size, void* d_ws, size_t ws_size, hipStream_t stream) {
    static int grid = 0;
    if (grid == 0) {
        if (n_in != 22 || ws_size < WS_END || out_size != ML * D_MODEL) { fprintf(stderr, "kernel_launch: bad inputs (n_in %d, out %d, ws %zu, need %zu)\n", n_in, out_size, ws_size, (size_t)WS_END); grid = -1; return; }
        int dev = 0, cus = 0, per_cu = 0;
        if (hipGetDevice(&dev) != hipSuccess || hipDeviceGetAttribute(&cus, hipDeviceAttributeMultiprocessorCount, dev) != hipSuccess) { grid = -1; return; }
        if (hipFuncSetAttribute((const void*)mega_fwd, hipFuncAttributeMaxDynamicSharedMemorySize, LDS_BYTES) != hipSuccess) { fprintf(stderr, "kernel_launch: hipFuncSetAttribute failed\n"); grid = -1; return; }
        if (hipOccupancyMaxActiveBlocksPerMultiprocessor(&per_cu, (const void*)mega_fwd, NTHREADS, LDS_BYTES) != hipSuccess || per_cu < 1) { fprintf(stderr, "kernel_launch: occupancy query says %d blocks/CU\n", per_cu); (void)hipGetLastError(); grid = -1; return; }
        grid = cus;
        fprintf(stderr, "kernel_launch: grid %d (cus %d, occupancy %d/CU)\n", grid, cus, per_cu);
    }
    if (grid < 0) return;
    Params p{};
    const float** f = (const float**)&p;
    for (int i = 0; i < 22; ++i) f[i] = (const float*)d_in[i];
    p.out = (float*)d_out; p.ws = (unsigned char*)d_ws;
    (void)hipMemsetAsync((char*)d_ws + WS_CTL, 0, CTL_ZERO_BYTES, stream);
    hipLaunchKernelGGL(mega_fwd, dim3(grid), dim3(NTHREADS), LDS_BYTES, stream, p);
}
```

```cpp
#include <hip/hip_runtime.h>
#include <cstdio>
#include <cstdint>
#include <cmath>

__device__ __forceinline__ int lane_id() { int l; asm volatile("v_mbcnt_lo_u32_b32 %0, -1, 0\n\tv_mbcnt_hi_u32_b32 %0, -1, %0" : "=v"(l)); return l; }
__device__ __forceinline__ int tid_of(int wave_id) { int t = wave_id * 64 + lane_id(); asm volatile("" : "+v"(t)); return t; }
namespace pg8 {
#define PG8_LAS __attribute__((address_space(3)))
typedef unsigned short bf16_t;
typedef short bf16x8 __attribute__((ext_vector_type(8)));
typedef float f32x4 __attribute__((ext_vector_type(4)));
typedef unsigned u32x4 __attribute__((ext_vector_type(4)));
constexpr int BM = 256, BK = 64, HALF = 128, HTB = HALF * BK * 2  , STAGE_BYTES = 8 * HTB, NXCD = 8, WGM = 8;

__host__ __device__ __forceinline__ int lds_byte(int r, int c) { const int st = (r >> 4) * 2 + (c >> 5), rr = r & 15, cc = c & 31, ob = rr * 64 + cc * 2; return st * 1024 + (ob ^ (((ob >> 9) & 1) << 5)); }
__host__ __device__ __forceinline__ void stage_rc(int b, int& R, int& C) { const int st = b / 1024, sb = b % 1024, swz = sb ^ (((sb >> 9) & 1) << 5); R = (st >> 1) * 16 + swz / 64; C = (st & 1) * 32 + (swz % 64) / 2; }
__host__ __device__ __forceinline__ int perm32(int rho) { const int n = rho >> 4, i = rho & 15; return 8 * (i >> 2) + 4 * n + (i & 3); }

struct Unit { int pm, pn, br; };
struct Gemm { const bf16_t* A; const bf16_t* Bt; int M, N, K; };

struct StaticOrder {
    int nM, nN, nwg, G, c;
    __host__ __device__ void init(int M, int N, int G_, int c_) { nM = M / BM; nN = N / BM; nwg = nM * nN; G = G_; c = c_; }
    __host__ __device__ bool next(int i, Unit& u) const {
        const long L = (long)i * G + c; if (L >= nwg) return false;
        int wgid = (int)L; { const int q = nwg / NXCD, r = nwg % NXCD, xcd = wgid % NXCD, off = wgid / NXCD; wgid = (xcd < r ? xcd * (q + 1) : r * (q + 1) + (xcd - r) * q) + off; }
        const int nig = WGM * nN, gid = wgid / nig, fm = gid * WGM, gsz = (nM - fm) < WGM ? (nM - fm) : WGM;
        u.pm = fm + ((wgid % nig) % gsz); u.pn = (wgid % nig) / gsz; u.br = 0; return true;
    }
    __device__ __forceinline__ const char* a_base(const Gemm& g, const Unit& u, size_t tstep) const { return (const char*)g.A + (size_t)u.pm * tstep; }
    __device__ __forceinline__ const char* b_base(const Gemm& g, const Unit& u, size_t tstep) const { return (const char*)g.Bt + (size_t)u.pn * tstep; }
    __device__ __forceinline__ void a_ready(const Unit&) const {}
    __device__ __forceinline__ void done(const Unit&) const {}
};

template <class Epi, class Sched, bool ALIGN_EPI = false, bool SP2 = false>
__device__ __forceinline__ void gemm_phase(PG8_LAS unsigned char* lds, const Gemm g, const Sched& S, const Epi& E, const int wave_id_in) {
    int tid_o = tid_of(wave_id_in);
    const int tid = tid_o, wid = __builtin_amdgcn_readfirstlane(tid >> 6), lane = tid & 63, wr = wid >> 2, wc = wid & 3, fr = lane & 15, fq = lane >> 4;
    const int K = g.K, nt = K / BK;
    unsigned voffA[2], voffB[2];
#pragma unroll
    for (int i = 0; i < 2; ++i) { int R, C; stage_rc(tid * 16 + i * 8192, R, C); const int Rb = Epi::PERM ? ((R & ~31) + perm32(R & 31)) : R;
        voffA[i] = (unsigned)(R * K + C) * 2u; voffB[i] = (unsigned)(Rb * K + C) * 2u; }
    const size_t kstep = (size_t)(BK * 2);
    const size_t hstep = (size_t)HALF * K * 2;
    const size_t tstep = 2 * hstep;
    const unsigned ldsw = (unsigned)wid * 1024u;
    const int aoff = lds_byte(wr * 64 + fr, fq * 8), boff = lds_byte(wc * 32 + fr, fq * 8);
#define PG8_SA(b, h) (((b) * 2 + (h)) * HTB)
#define PG8_SB(b, h) ((4 + (b) * 2 + (h)) * HTB)
#define PG8_STAGE(bufoff, gbase, voff) do { _Pragma("unroll") for (int _i = 0; _i < 2; ++_i) \
        __builtin_amdgcn_global_load_lds((const unsigned*)((const char*)(gbase) + (voff)[_i]), (PG8_LAS unsigned*)(lds + (bufoff) + ldsw + _i * 8192), 16, 0, 0); } while (0)
#define PG8_LDA(dst, b, h) do { _Pragma("unroll") for (int m = 0; m < 4; ++m) _Pragma("unroll") for (int k = 0; k < 2; ++k) dst[m][k] = *(const PG8_LAS bf16x8*)(lds + PG8_SA(b, h) + aoff + m * 2048 + k * 1024); } while (0)
#define PG8_LDB(dst, b, h) do { _Pragma("unroll") for (int n = 0; n < 2; ++n) _Pragma("unroll") for (int k = 0; k < 2; ++k) dst[n][k] = *(const PG8_LAS bf16x8*)(lds + PG8_SB(b, h) + boff + n * 2048 + k * 1024); } while (0)
#define PG8_MMA(ai, bj, At, Bt) do { __builtin_amdgcn_s_setprio(1); _Pragma("unroll") for (int m = 0; m < 4; ++m) _Pragma("unroll") for (int n = 0; n < 2; ++n) _Pragma("unroll") for (int k = 0; k < 2; ++k) \
        acc[ai][bj][m][n] = __builtin_amdgcn_mfma_f32_16x16x32_bf16(Bt[n][k], At[m][k], acc[ai][bj][m][n], 0, 0, 0); __builtin_amdgcn_s_setprio(0); } while (0)
#define PG8_WAIT_V(n) asm volatile("s_waitcnt vmcnt(" #n ")" ::: "memory")
#define PG8_WAIT_L(n) asm volatile("s_waitcnt lgkmcnt(" #n ")" ::: "memory")
#define PG8_BAR __builtin_amdgcn_s_barrier()
#define PG8_SCHED __builtin_amdgcn_sched_barrier(0)
    Unit cur, nxt; int ui = 0;
    if (!S.next(0, cur)) return;
    f32x4 acc[2][2][4][2];
#pragma unroll
    for (int a = 0; a < 2; ++a)
#pragma unroll
        for (int b = 0; b < 2; ++b)
#pragma unroll
            for (int m = 0; m < 4; ++m)
#pragma unroll
                for (int n = 0; n < 2; ++n) acc[a][b][m][n] = (f32x4){0.f, 0.f, 0.f, 0.f};
    bf16x8 At[4][2], B0[2][2], B1[2][2];
    const char* cA = S.a_base(g, cur, tstep); const char* cB = S.b_base(g, cur, tstep);
    S.a_ready(cur);
    if constexpr (SP2) {
        PG8_STAGE(PG8_SB(0, 0), cB, voffB); PG8_STAGE(PG8_SB(0, 1), cB + hstep, voffB); PG8_STAGE(PG8_SA(0, 0), cA, voffA); PG8_STAGE(PG8_SA(0, 1), cA + hstep, voffA);
        if (wr == 1) PG8_BAR;
        PG8_WAIT_V(2); PG8_BAR;
        PG8_STAGE(PG8_SB(1, 0), cB + kstep, voffB); PG8_STAGE(PG8_SA(1, 0), cA + kstep, voffA); PG8_STAGE(PG8_SB(1, 1), cB + hstep + kstep, voffB);
        PG8_WAIT_V(6); PG8_BAR;
    } else {
        PG8_STAGE(PG8_SB(0, 0), cB, voffB); PG8_STAGE(PG8_SA(0, 0), cA, voffA); PG8_STAGE(PG8_SB(0, 1), cB + hstep, voffB); PG8_STAGE(PG8_SA(0, 1), cA + hstep, voffA);
        if (wr == 1) PG8_BAR;
        PG8_WAIT_V(4); PG8_BAR;
        PG8_STAGE(PG8_SB(1, 0), cB + kstep, voffB); PG8_STAGE(PG8_SA(1, 0), cA + kstep, voffA); PG8_STAGE(PG8_SB(1, 1), cB + hstep + kstep, voffB);
        PG8_WAIT_V(6); PG8_BAR;
    }
    for (;;) {
        const bool has_next = S.next(ui + 1, nxt);
        const char* nA = has_next ? S.a_base(g, nxt, tstep) : cA; const char* nB = has_next ? S.b_base(g, nxt, tstep) : cB;
        for (int t = 0; t < nt; t += 2) {
            const bool last = (t == nt - 2);
            const char* a1 = cA + (size_t)(t + 1) * kstep;
            const char* a2 = last ? nA : cA + (size_t)(t + 2) * kstep; const char* b2 = last ? nB : cB + (size_t)(t + 2) * kstep;
            const char* a3 = a2 + kstep; const char* b3 = b2 + kstep;
            if (last && has_next) S.a_ready(nxt);
            if constexpr (SP2) {
            PG8_LDB(B0, 0, 0); PG8_LDB(B1, 0, 1); PG8_SCHED; PG8_LDA(At, 0, 0); PG8_STAGE(PG8_SA(1, 1), a1 + hstep, voffA);
            PG8_WAIT_V(8); PG8_WAIT_L(0); PG8_BAR; PG8_MMA(0, 0, At, B0); PG8_MMA(0, 1, At, B1); PG8_BAR; PG8_SCHED;
            PG8_LDA(At, 0, 1); PG8_STAGE(PG8_SB(0, 0), b2, voffB); PG8_STAGE(PG8_SB(0, 1), b2 + hstep, voffB); PG8_STAGE(PG8_SA(0, 0), a2, voffA);
            PG8_WAIT_V(8); PG8_WAIT_L(0); PG8_BAR; PG8_MMA(1, 0, At, B0); PG8_MMA(1, 1, At, B1); PG8_BAR; PG8_SCHED;
            PG8_LDB(B0, 1, 0); PG8_LDB(B1, 1, 1); PG8_SCHED; PG8_LDA(At, 1, 0); PG8_STAGE(PG8_SA(0, 1), a2 + hstep, voffA);
            PG8_WAIT_V(8); PG8_WAIT_L(0); PG8_BAR; PG8_MMA(0, 0, At, B0); PG8_MMA(0, 1, At, B1); PG8_BAR; PG8_SCHED;
            PG8_LDA(At, 1, 1); PG8_STAGE(PG8_SB(1, 0), b3, voffB); PG8_STAGE(PG8_SB(1, 1), b3 + hstep, voffB); PG8_STAGE(PG8_SA(1, 0), a3, voffA);
            PG8_WAIT_V(8); PG8_WAIT_L(0); PG8_BAR; PG8_MMA(1, 0, At, B0); PG8_MMA(1, 1, At, B1); PG8_BAR; PG8_SCHED;
            } else {
            PG8_LDB(B0, 0, 0); PG8_SCHED; PG8_LDA(At, 0, 0); PG8_STAGE(PG8_SA(1, 1), a1 + hstep, voffA);
            PG8_WAIT_L(8); PG8_BAR; PG8_WAIT_L(0); PG8_MMA(0, 0, At, B0); PG8_BAR; PG8_SCHED;
            PG8_LDB(B1, 0, 1); PG8_STAGE(PG8_SB(0, 0), b2, voffB);
            PG8_BAR; PG8_WAIT_L(0); PG8_MMA(0, 1, At, B1); PG8_BAR;
            PG8_LDA(At, 0, 1); PG8_STAGE(PG8_SA(0, 0), a2, voffA);
            PG8_BAR; PG8_WAIT_L(0); PG8_MMA(1, 0, At, B0); PG8_BAR; PG8_SCHED;
            PG8_STAGE(PG8_SB(0, 1), b2 + hstep, voffB);
            PG8_WAIT_V(6); PG8_BAR; PG8_MMA(1, 1, At, B1); PG8_BAR;
            PG8_LDB(B0, 1, 0); PG8_SCHED; PG8_LDA(At, 1, 0); PG8_STAGE(PG8_SA(0, 1), a2 + hstep, voffA);
            PG8_WAIT_L(8); PG8_BAR; PG8_WAIT_L(0); PG8_MMA(0, 0, At, B0); PG8_BAR; PG8_SCHED;
            PG8_LDB(B1, 1, 1); PG8_STAGE(PG8_SB(1, 0), b3, voffB);
            PG8_BAR; PG8_WAIT_L(0); PG8_MMA(0, 1, At, B1); PG8_BAR;
            PG8_LDA(At, 1, 1); PG8_STAGE(PG8_SA(1, 0), a3, voffA);
            PG8_BAR; PG8_WAIT_L(0); PG8_MMA(1, 0, At, B0); PG8_BAR; PG8_SCHED;
            PG8_STAGE(PG8_SB(1, 1), b3 + hstep, voffB);
            PG8_WAIT_V(6); PG8_BAR; PG8_MMA(1, 1, At, B1); PG8_BAR;
            }
        }
        if constexpr (ALIGN_EPI) { if (wr == 0) PG8_BAR; }
        if constexpr (!Epi::AFTER_DRAIN) { E(acc, cur, wr, wc, fr, fq); S.done(cur); }
        if (!has_next) break;
#pragma unroll
        for (int a = 0; a < 2; ++a)
#pragma unroll
            for (int b = 0; b < 2; ++b)
#pragma unroll
                for (int m = 0; m < 4; ++m)
#pragma unroll
                    for (int n = 0; n < 2; ++n) acc[a][b][m][n] = (f32x4){0.f, 0.f, 0.f, 0.f};
        cur = nxt; cA = nA; cB = nB; ++ui;
        if constexpr (ALIGN_EPI) { if (wr == 1) PG8_BAR; }
    }
    PG8_WAIT_V(0);
    if constexpr (!ALIGN_EPI) { if (wr == 0) PG8_BAR; }
    PG8_BAR;
    if constexpr (Epi::AFTER_DRAIN) { E.fused(acc, cur, wr, wc, fr, fq, lds, wid, lane); S.done(cur); }
#undef PG8_SA
#undef PG8_SB
#undef PG8_STAGE
#undef PG8_LDA
#undef PG8_LDB
#undef PG8_MMA
#undef PG8_WAIT_V
#undef PG8_WAIT_L
#undef PG8_BAR
#undef PG8_SCHED
}
}

constexpr int D_MODEL = 2048, BATCH = 4, SEQ = 2048, CTX = 256, GRID_W = 64, NHEAD = 8, HD = 128, WA = 1024;
constexpr int FFN = 5632, IN_COLS = 12288, NMOD = 6;
constexpr int ML = BATCH * SEQ;
constexpr int MC = BATCH * CTX;
constexpr int MT = ML + MC;
constexpr float EPS = 1e-6f;
constexpr int NTHREADS = 512;
constexpr int VT_PITCH = SEQ + CTX;

typedef unsigned short bf16;
typedef float f32x4 __attribute__((ext_vector_type(4)));
typedef unsigned u32x2 __attribute__((ext_vector_type(2)));
typedef unsigned u32x4 __attribute__((ext_vector_type(4)));
#define LAS __attribute__((address_space(3)))

typedef float f32x2_t __attribute__((ext_vector_type(2)));
typedef __bf16 bf16x2_t __attribute__((ext_vector_type(2)));
__device__ __forceinline__ unsigned pk2(float lo, float hi) { const f32x2_t v = {lo, hi}; const bf16x2_t b = __builtin_convertvector(v, bf16x2_t); return __builtin_bit_cast(unsigned, b); }
__device__ __forceinline__ unsigned f2bf(float f) { return pk2(f, 0.f) & 0xffffu; }
__device__ __forceinline__ float bf2f(unsigned short h) { return __builtin_bit_cast(float, (unsigned)h << 16); }
__device__ __forceinline__ float bflo(unsigned w) { return __builtin_bit_cast(float, w << 16); }
__device__ __forceinline__ float bfhi(unsigned w) { return __builtin_bit_cast(float, w & 0xffff0000u); }
__device__ __forceinline__ float sigmoidf_(float x) { return __builtin_amdgcn_rcpf(1.0f + __expf(-x)); }
__device__ __forceinline__ float siluf_(float x) { return x * __builtin_amdgcn_rcpf(1.0f + __expf(-x)); }
__device__ __forceinline__ float wave_sum(float v) {
#pragma unroll
    for (int o = 1; o < 64; o <<= 1) v += __shfl_xor(v, o);
    return v;
}
__device__ __forceinline__ float wave_max(float v) {
#pragma unroll
    for (int o = 1; o < 64; o <<= 1) v = fmaxf(v, __shfl_xor(v, o));
    return v;
}

constexpr size_t al256(size_t x) { return (x + 255) & ~(size_t)255; }
constexpr size_t WS_CTL   = 0;
constexpr size_t CTL_ZERO_BYTES = 1u << 20;
constexpr size_t WS_ROWSQ = 64 * 1024;
constexpr size_t WS_BIAS2 = WS_ROWSQ + (size_t)ML * 4;
static_assert(WS_BIAS2 + (size_t)4 * 2 * FFN * 4 <= CTL_ZERO_BYTES, "ctl");
constexpr size_t WS_MOD   = CTL_ZERO_BYTES;
constexpr size_t WS_LB    = al256(WS_MOD + (size_t)5 * IN_COLS * 4);
constexpr size_t WS_ROPE  = al256(WS_LB + 2 * WA * 4);
constexpr size_t WS_SMALL_END = al256(WS_ROPE + 2 * 64 * 32 * 4);
constexpr size_t WS_W13T  = al256(WS_SMALL_END);
constexpr size_t WS_W2T   = WS_W13T + (size_t)2 * FFN * D_MODEL * 2;
constexpr size_t WS_WAT   = WS_W2T + (size_t)D_MODEL * FFN * 2;
constexpr size_t WS_WBT   = WS_WAT + (size_t)D_MODEL * WA * 2;
constexpr size_t WS_WOT   = WS_WBT + (size_t)D_MODEL * WA * 2;
constexpr size_t WS_A_END = WS_WOT + (size_t)D_MODEL * D_MODEL * 2;
constexpr size_t SEGB = (size_t)MT * WA * 2;
constexpr size_t WS_QA  = WS_A_END;
constexpr size_t WS_FW  = WS_QA + SEGB;
constexpr size_t WS_FB  = WS_FW + 2 * SEGB;
constexpr size_t WS_IA  = WS_FB + 2 * SEGB;
constexpr size_t WS_GA  = WS_IA + SEGB;
constexpr size_t WS_QN  = WS_GA + (size_t)ML * WA * 2;
constexpr size_t WS_KN  = WS_QN + (size_t)ML * WA * 2;
constexpr size_t WS_VN  = WS_KN + SEGB;
constexpr size_t WS_GTA = WS_VN + SEGB;
constexpr size_t WS_GTB = WS_GTA + (size_t)ML * D_MODEL * 2;
constexpr size_t WS_D_END = WS_GTB + (size_t)ML * D_MODEL * 2;
constexpr size_t WS_WINT = WS_D_END;
constexpr size_t WS_OF   = WS_WINT;
constexpr size_t WS_OB   = WS_OF + (size_t)ML * WA * 2;
constexpr size_t WS_B_END = WS_WINT + (size_t)IN_COLS * D_MODEL * 2;
static_assert(WS_OB + (size_t)ML * WA * 2 <= WS_B_END, "B");
constexpr size_t WS_H   = WS_B_END;
constexpr size_t WS_YA  = WS_H;
constexpr size_t WS_YB  = WS_YA + (size_t)ML * WA * 2;
constexpr size_t WS_C_END = WS_H + (size_t)MT * D_MODEL * 2;
constexpr size_t WS_ACT_END = WS_D_END + (size_t)ML * FFN * 2;
constexpr size_t WS_HIMG = WS_WINT;
constexpr size_t WS_HIMG_END = WS_HIMG + (size_t)64 * 36 * 41472;
constexpr size_t WS_T1 = WS_WINT;
constexpr size_t WS_END0 = WS_C_END > WS_ACT_END ? WS_C_END : WS_ACT_END;
constexpr size_t WS_END = WS_END0 > WS_HIMG_END ? WS_END0 : WS_HIMG_END;
static_assert(WS_END <= 445000000, "ws budget");
constexpr size_t WS_Z   = WS_QA;
constexpr size_t WS_XMG = WS_GTB;
constexpr size_t WS_HALO = WS_QA;
static_assert(WS_HALO + (size_t)32 * 6 * FFN * 4 <= WS_XMG, "HALO overlay");
constexpr size_t WS_ACT = WS_WINT;
static_assert(WS_ACT + (size_t)ML * FFN * 2 <= WS_END, "ACT overlay");

struct Params {
    const float *x, *c, *ctx, *c_ctx, *ada_w, *ada_b, *norm1_g, *norm2_g, *w_in, *lb_logits, *hgrn_norm_g, *q_norm_g, *k_norm_g, *rel_bias,
                *w_a, *w_b, *w_o, *w1, *w3, *conv_w, *conv_b, *w2;
    float* out;
    unsigned char* ws;
    int wave_id, pad;
};

template <bool QKPERM, bool BIAS>
__device__ __forceinline__ void transpose_item(const float* W, int K, int N, bf16* WT, int row_off, LAS float* scr, int item, int lane, const float* sh2 = nullptr, float* bias2 = nullptr) {
    const int nblk = N / 32, kb = item / nblk, nb = item % nblk, k0 = 64 * kb, n0 = 32 * nb;
    if (BIAS) row_off += (n0 >> 7) * 128;
    float wv[32];
#pragma unroll
    for (int i = 0; i < 32; ++i) wv[i] = __builtin_nontemporal_load(W + (size_t)(k0 + 2 * i + (lane >> 5)) * N + n0 + (lane & 31));
#pragma unroll
    for (int i = 0; i < 32; ++i) scr[(2 * i + (lane >> 5)) * 33 + (lane & 31)] = wv[i];
    if (BIAS) {
        float a0 = 0.f, a1 = 0.f, a2 = 0.f, a3 = 0.f;
#pragma unroll
        for (int i = 0; i < 32; ++i) { const int k = k0 + 2 * i + (lane >> 5); const float w = wv[i];
            a0 += w * sh2[0 * IN_COLS + k]; a1 += w * sh2[1 * IN_COLS + k]; a2 += w * sh2[2 * IN_COLS + k]; a3 += w * sh2[3 * IN_COLS + k]; }
        a0 += __shfl_xor(a0, 32); a1 += __shfl_xor(a1, 32); a2 += __shfl_xor(a2, 32); a3 += __shfl_xor(a3, 32);
        if (lane < 32) { float* bp = bias2 + row_off + n0 + lane; atomicAdd(bp, a0); atomicAdd(bp + 2 * FFN, a1); atomicAdd(bp + 4 * FFN, a2); atomicAdd(bp + 6 * FFN, a3); }
    }
    asm volatile("s_waitcnt lgkmcnt(0)" ::: "memory");
    const int c = lane & 7;
#pragma unroll
    for (int j = 0; j < 4; ++j) { const int n = (lane >> 3) + 8 * j; const LAS float* s = scr + (8 * c) * 33 + n;
        u32x4 o; o.x = pk2(s[0 * 33], s[1 * 33]); o.y = pk2(s[2 * 33], s[3 * 33]); o.z = pk2(s[4 * 33], s[5 * 33]); o.w = pk2(s[6 * 33], s[7 * 33]);
        int cdst = n0 + n;
        if (QKPERM && cdst >= 5 * WA && cdst < 7 * WA) cdst = (cdst & ~0x30) | ((cdst & 0x10) << 1) | ((cdst & 0x20) >> 1);
        *(u32x4*)(WT + (size_t)(row_off + cdst) * K + k0 + 8 * c) = o; }
    asm volatile("s_waitcnt lgkmcnt(0)" ::: "memory");
}
__device__ __forceinline__ void phase_wconv_in(const Params& p, LAS unsigned char* lds, int gw, int NGW) {
    const int lane = lane_id(), wave = p.wave_id;
    LAS float* scr = (LAS float*)(lds + wave * 16384);
    constexpr int I_IN = (D_MODEL / 64) * (IN_COLS / 32);
    for (int it = gw; it < I_IN; it += NGW) transpose_item<true, false>(p.w_in, D_MODEL, IN_COLS, (bf16*)(p.ws + WS_WINT), 0, scr, it, lane);
}
__device__ __forceinline__ void phase_wconv_rest(const Params& p, LAS unsigned char* lds, int gw, int NGW) {
    const int lane = lane_id(), wave = p.wave_id;
    LAS float* scr = (LAS float*)(lds + 16384 + wave * 16384);
    constexpr int I_A = (WA / 64) * (D_MODEL / 32), I_O = (D_MODEL / 64) * (D_MODEL / 32), I_1 = (D_MODEL / 64) * (FFN / 32), I_2 = (FFN / 64) * (D_MODEL / 32);
    constexpr int NITEMS = 2 * I_A + I_O + 2 * I_1 + I_2;
    unsigned char* ws = p.ws;
    const float* sh2 = (const float*)(ws + WS_MOD) + 3 * D_MODEL; float* b2 = (float*)(ws + WS_BIAS2);
    for (int it = gw; it < NITEMS; it += NGW) {
        int r = it;
        if (r < I_A) { transpose_item<false, false>(p.w_a, WA, D_MODEL, (bf16*)(ws + WS_WAT), 0, scr, r, lane); continue; } r -= I_A;
        if (r < I_A) { transpose_item<false, false>(p.w_b, WA, D_MODEL, (bf16*)(ws + WS_WBT), 0, scr, r, lane); continue; } r -= I_A;
        if (r < I_O) { transpose_item<false, false>(p.w_o, D_MODEL, D_MODEL, (bf16*)(ws + WS_WOT), 0, scr, r, lane); continue; } r -= I_O;
        if (r < I_1) { transpose_item<false, true>(p.w1, D_MODEL, FFN, (bf16*)(ws + WS_W13T), 0, scr, r, lane, sh2, b2); continue; } r -= I_1;
        if (r < I_1) { transpose_item<false, true>(p.w3, D_MODEL, FFN, (bf16*)(ws + WS_W13T), 128, scr, r, lane, sh2, b2); continue; } r -= I_1;
        transpose_item<false, false>(p.w2, FFN, D_MODEL, (bf16*)(ws + WS_W2T), 0, scr, r, lane);
    }
}

__device__ __forceinline__ void phase_mod(const Params& p, LAS unsigned char* lds, int vb, int nb) {
    const int tid = tid_of(p.wave_id);
    LAS float* sc = (LAS float*)lds;
    LAS float* red = (LAS float*)(lds + 5 * 2048 * 4);
    for (int i = tid; i < 5 * D_MODEL; i += NTHREADS) { const int r = i / D_MODEL, k = i % D_MODEL; const float v = (r < 4) ? p.c[r * D_MODEL + k] : p.c_ctx[k]; sc[i] = siluf_(v); }
    __syncthreads();
    float* mod = (float*)(p.ws + WS_MOD);
    const int c4 = tid & 15, kp = tid >> 4;
    for (int item = vb; item < IN_COLS / 64; item += nb) {
        const int n0 = item * 64 + c4 * 4;
        f32x4 acc[5];
#pragma unroll
        for (int r = 0; r < 5; ++r) acc[r] = (f32x4){0.f, 0.f, 0.f, 0.f};
#pragma unroll 8
        for (int k = kp; k < D_MODEL; k += 32) {
            const f32x4 w = __builtin_nontemporal_load((const f32x4*)(p.ada_w + (size_t)k * IN_COLS + n0));
#pragma unroll
            for (int r = 0; r < 5; ++r) acc[r] += w * sc[r * D_MODEL + k];
        }
#pragma unroll
        for (int r = 0; r < 5; ++r) *(LAS f32x4*)(red + (kp * 5 + r) * 64 + c4 * 4) = acc[r];
        __syncthreads();
        if (tid < 320) { const int r = tid / 64, cidx = tid % 64; float s = 0.f;
            for (int q = 0; q < 32; ++q) s += red[(q * 5 + r) * 64 + cidx];
            mod[r * IN_COLS + item * 64 + cidx] = s + p.ada_b[item * 64 + cidx]; }
        __syncthreads();
    }
    if (vb == nb - 1) { float* rt = (float*)(p.ws + WS_ROPE);
        for (int i = tid; i < 64 * 32; i += NTHREADS) { const int pos = i >> 5, j = i & 31; const float inv = exp2f(-(float)j * (13.287712379549449f / 32.0f)); float sn, cs; sincosf((float)pos * inv, &sn, &cs); rt[i] = cs; rt[2048 + i] = sn; } }
    if (vb == 0) { float* lb = (float*)(p.ws + WS_LB);
        for (int i = tid; i < 2 * WA; i += NTHREADS) { const int d = i / WA, cc = i % WA; const float l0 = p.lb_logits[d * 2 * WA + cc], l1 = p.lb_logits[d * 2 * WA + WA + cc]; lb[i] = 1.0f / (1.0f + expf(l1 - l0)); } }
}

__device__ __forceinline__ void phase_h(const Params& p, int vb, int nb) {
    const int tid = tid_of(p.wave_id), lane = tid & 63, wave = p.wave_id;
    const float* mod = (const float*)(p.ws + WS_MOD);
    bf16* H = (bf16*)(p.ws + WS_H);
    for (int m = vb * 8 + wave; m < MT; m += nb * 8) {
        const float* xr = (m < ML) ? p.x + (size_t)m * D_MODEL : p.ctx + (size_t)(m - ML) * D_MODEL;
        const int mr = (m < ML) ? (m / SEQ) : 4;
        const float* sh = mod + (size_t)mr * IN_COLS, *scl = sh + D_MODEL;
        f32x4 v[8]; float s = 0.f;
#pragma unroll
        for (int j = 0; j < 8; ++j) { v[j] = *(const f32x4*)(xr + 4 * lane + 256 * j); s += (v[j].x * v[j].x + v[j].y * v[j].y) + (v[j].z * v[j].z + v[j].w * v[j].w); }
        const float rstd = __builtin_amdgcn_rsqf(wave_sum(s) * (1.0f / D_MODEL) + EPS);
#pragma unroll
        for (int j = 0; j < 8; ++j) { const int k = 4 * lane + 256 * j;
            const f32x4 g = *(const f32x4*)(p.norm1_g + k), a = *(const f32x4*)(scl + k), b = *(const f32x4*)(sh + k);
            const f32x4 h = v[j] * rstd * g * (a + 1.0f) + b;
            u32x2 o; o.x = pk2(h.x, h.y); o.y = pk2(h.z, h.w);
            *(u32x2*)(H + (size_t)m * D_MODEL + k) = o; }
    }
}

#define EPI_LOOP_BEGIN \
    _Pragma("unroll") for (int ai = 0; ai < 2; ++ai) _Pragma("unroll") for (int m = 0; m < 4; ++m) { const int row = u.pm * 256 + ai * 128 + wr * 64 + m * 16 + fr; \
    _Pragma("unroll") for (int bj = 0; bj < 2; ++bj) _Pragma("unroll") for (int n = 0; n < 2; ++n) { const int col = u.pn * 256 + bj * 128 + wc * 32 + n * 16 + fq * 4; const f32x4 v = acc[ai][bj][m][n];
#define EPI_LOOP_END } }

struct EpiInProj {
    static constexpr bool PERM = false, AFTER_DRAIN = false;
    unsigned char* ws; LAS unsigned char* lds; const float* qg; const float* kg;
    __device__ __forceinline__ void operator()(const f32x4 (&acc)[2][2][4][2], const pg8::Unit& u, int wr, int wc, int fr, int fq) const {
        const int seg = u.pn >> 2;
        const bool ctxrow = u.pm >= ML / 256;
        const float* lb = (const float*)(ws + WS_LB);
        if (seg == 1 || seg == 2) {
            float* F = (float*)(ws + (seg == 1 ? WS_FW : WS_FB)); const float* lbd = lb + (seg - 1) * WA;
            f32x4 lbv[2][2];
#pragma unroll
            for (int bj = 0; bj < 2; ++bj)
#pragma unroll
                for (int n = 0; n < 2; ++n) lbv[bj][n] = *(const f32x4*)(lbd + u.pn * 256 + bj * 128 + wc * 32 + n * 16 + fq * 4 - seg * WA);
            EPI_LOOP_BEGIN
                const int c = col - seg * WA; const f32x4 l = lbv[bj][n]; f32x4 o;
                o.x = __logf(l.x + (1.0f - l.x) * sigmoidf_(v.x)); o.y = __logf(l.y + (1.0f - l.y) * sigmoidf_(v.y));
                o.z = __logf(l.z + (1.0f - l.z) * sigmoidf_(v.z)); o.w = __logf(l.w + (1.0f - l.w) * sigmoidf_(v.w));
                *(f32x4*)(F + (size_t)row * WA + c) = o;
            EPI_LOOP_END
        } else if (seg == 7) {
            bf16* VT = (bf16*)(ws + WS_VN);
            EPI_LOOP_BEGIN
                const int c = col - 7 * WA; const int hh = c >> 7, d = c & 127;
                int bb, tok; if (row < ML) { bb = row / SEQ; tok = row % SEQ; } else { bb = (row - ML) / CTX; tok = SEQ + (row - ML) % CTX; }
                bf16* o = VT + ((size_t)(bb * NHEAD + hh) * HD + d) * VT_PITCH + tok;
                o[0] = (bf16)f2bf(v.x); o[VT_PITCH] = (bf16)f2bf(v.y); o[2 * VT_PITCH] = (bf16)f2bf(v.z); o[3 * VT_PITCH] = (bf16)f2bf(v.w);
            EPI_LOOP_END
        } else if (seg == 5 || seg == 6) {
            if (ctxrow && seg == 5) return;
            LAS float* ssq = (LAS float*)(lds + 131072);
            const float* gn = (seg == 5) ? qg : kg; const float* rt = (const float*)(ws + WS_ROPE);
            bf16* O = (bf16*)(ws + (seg == 5 ? WS_QN : WS_KN));
#pragma unroll
            for (int ai = 0; ai < 2; ++ai)
#pragma unroll
                for (int m = 0; m < 4; ++m)
#pragma unroll
                    for (int bj = 0; bj < 2; ++bj) { const f32x4 a = acc[ai][bj][m][0], b = acc[ai][bj][m][1];
                        float sq = (a.x * a.x + a.y * a.y) + (a.z * a.z + a.w * a.w) + (b.x * b.x + b.y * b.y) + (b.z * b.z + b.w * b.w);
                        sq += __shfl_xor(sq, 16); sq += __shfl_xor(sq, 32);
                        if (fq == 0) ssq[((ai * 128 + wr * 64 + m * 16 + fr) * 2 + bj) * 4 + wc] = sq; }
            asm volatile("s_waitcnt lgkmcnt(0)" ::: "memory"); __builtin_amdgcn_s_barrier(); asm volatile("" ::: "memory");
            const int H = wc >> 1, jj = 16 * (wc & 1) + 4 * fq;
            const f32x4 g0 = *(const f32x4*)(gn + 64 * H + jj), g1 = *(const f32x4*)(gn + 64 * H + 32 + jj);
#pragma unroll
            for (int ai = 0; ai < 2; ++ai)
#pragma unroll
                for (int m = 0; m < 4; ++m) { const int rl = ai * 128 + wr * 64 + m * 16 + fr; const int row = u.pm * 256 + rl;
                    f32x4 cs = (f32x4){1.f, 1.f, 1.f, 1.f}, sn = (f32x4){0.f, 0.f, 0.f, 0.f};
                    if (!ctxrow) { const int t = row & (SEQ - 1); const int pos = (H == 0) ? (t >> 6) : (t & 63); cs = *(const f32x4*)(rt + pos * 32 + jj); sn = *(const f32x4*)(rt + 2048 + pos * 32 + jj); }
#pragma unroll
                    for (int bj = 0; bj < 2; ++bj) { const f32x4 s4 = *(const LAS f32x4*)(ssq + (rl * 2 + bj) * 4);
                        const float rstd = __builtin_amdgcn_rsqf(((s4.x + s4.y) + (s4.z + s4.w)) * (1.0f / HD) + EPS);
                        const f32x4 u1 = acc[ai][bj][m][0] * rstd * g0, u2 = acc[ai][bj][m][1] * rstd * g1;
                        const f32x4 o1 = u1 * cs - u2 * sn, o2 = u1 * sn + u2 * cs;
                        bf16* op = O + (size_t)row * WA + (u.pn & 3) * 256 + bj * 128 + wc * 32 + fq * 4;
                        u32x2 w1; w1.x = pk2(o1.x, o1.y); w1.y = pk2(o1.z, o1.w); *(u32x2*)op = w1;
                        u32x2 w2; w2.x = pk2(o2.x, o2.y); w2.y = pk2(o2.z, o2.w); *(u32x2*)(op + 16) = w2; }
                    asm volatile("" ::: "memory"); }
            asm volatile("s_waitcnt lgkmcnt(0)" ::: "memory"); __builtin_amdgcn_s_barrier(); asm volatile("" ::: "memory");
        } else if (seg == 0 || seg == 3) {
            if (ctxrow && seg == 0) return;
            bf16* O = (bf16*)(ws + (seg == 0 ? WS_QA : WS_IA));
            EPI_LOOP_BEGIN
                const int c = col - seg * WA; u32x2 o; o.x = pk2(v.x, v.y); o.y = pk2(v.z, v.w);
                *(u32x2*)(O + (size_t)row * WA + c) = o;
            EPI_LOOP_END
        } else if (seg == 4) {
            if (ctxrow) return;
            bf16* O = (bf16*)(ws + WS_GA);
            EPI_LOOP_BEGIN
                const int c = col - seg * WA; u32x2 o; o.x = pk2(siluf_(v.x), siluf_(v.y)); o.y = pk2(siluf_(v.z), siluf_(v.w));
                *(u32x2*)(O + (size_t)row * WA + c) = o;
            EPI_LOOP_END
        } else {
            if (ctxrow) return;
            const bool isa = seg < 10;
            bf16* O = (bf16*)(ws + (isa ? WS_GTA : WS_GTB)); const int cbase = isa ? 8 * WA : 10 * WA;
            EPI_LOOP_BEGIN
                const int c = col - cbase; u32x2 o; o.x = pk2(sigmoidf_(v.x), sigmoidf_(v.y)); o.y = pk2(sigmoidf_(v.z), sigmoidf_(v.w));
                *(u32x2*)(O + (size_t)row * D_MODEL + c) = o;
            EPI_LOOP_END
        }
    }
};

constexpr int CTX_UNITS = (MC / 256) * 20;
struct InProjOrder : pg8::StaticOrder {
    __device__ bool next(int i, pg8::Unit& u) const {
        if (pg8::StaticOrder::next(i, u)) return true;
        const long L = (long)i * G + c - nwg; if (L < 0 || L >= CTX_UNITS) return false;
        const int t = (int)L, j = t % 20; u.pm = ML / 256 + t / 20; u.pn = (j < 12) ? 4 + j : 12 + j; u.br = 0; return true; }
};
struct MergeOrder : pg8::StaticOrder {
    const bf16* A1; const bf16* B1;
    __device__ bool next(int i, pg8::Unit& u) const { if (!pg8::StaticOrder::next(i >> 1, u)) return false; u.br = i & 1; return true; }
    __device__ __forceinline__ const char* a_base(const pg8::Gemm& g, const pg8::Unit& u, size_t tstep) const { return (const char*)(u.br ? A1 : g.A) + (size_t)u.pm * tstep; }
    __device__ __forceinline__ const char* b_base(const pg8::Gemm& g, const pg8::Unit& u, size_t tstep) const { return (const char*)(u.br ? B1 : g.Bt) + (size_t)u.pn * tstep; }
};
#define EPI_BATCH_BEGIN _Pragma("unroll") for (int ai = 0; ai < 2; ++ai) _Pragma("unroll") for (int mh = 0; mh < 4; mh += 2) {
#define EPI_BATCH_END }
#define EPI_VEC_LOOP _Pragma("unroll") for (int m2 = 0; m2 < 2; ++m2) _Pragma("unroll") for (int bj = 0; bj < 2; ++bj) _Pragma("unroll") for (int n = 0; n < 2; ++n)
#define EPI_VEC_IDX const int m = mh + m2, vi = (m2 * 2 + bj) * 2 + n; const int row = u.pm * 256 + ai * 128 + wr * 64 + m * 16 + fr, col = u.pn * 256 + bj * 128 + wc * 32 + n * 16 + fq * 4; (void)vi
struct EpiMerge {
    static constexpr bool PERM = false, AFTER_DRAIN = false;
    unsigned char* ws; float* tmp;
    __device__ __forceinline__ void operator()(const f32x4 (&acc)[2][2][4][2], const pg8::Unit& u, int wr, int wc, int fr, int fq) const {
        if (u.br == 0) {
            const bf16* G = (const bf16*)(ws + WS_GTA);
            EPI_BATCH_BEGIN
                u32x2 gv[8];
                EPI_VEC_LOOP { EPI_VEC_IDX; gv[vi] = *(const u32x2*)(G + (size_t)row * D_MODEL + col); }
                EPI_VEC_LOOP { EPI_VEC_IDX; const u32x2 g = gv[vi]; const f32x4 v = acc[ai][bj][m][n];
                    f32x4 o; o.x = bflo(g.x) * v.x; o.y = bfhi(g.x) * v.y; o.z = bflo(g.y) * v.z; o.w = bfhi(g.y) * v.w;
                    *(f32x4*)(tmp + (size_t)row * D_MODEL + col) = o; }
            EPI_BATCH_END
        } else {
            const bf16* G = (const bf16*)(ws + WS_GTB); bf16* Z = (bf16*)(ws + WS_Z);
            EPI_BATCH_BEGIN
                u32x2 gv[8]; f32x4 tv[8];
                EPI_VEC_LOOP { EPI_VEC_IDX; gv[vi] = *(const u32x2*)(G + (size_t)row * D_MODEL + col); tv[vi] = *(const f32x4*)(tmp + (size_t)row * D_MODEL + col); }
                EPI_VEC_LOOP { EPI_VEC_IDX; const u32x2 g = gv[vi]; const f32x4 t = tv[vi], v = acc[ai][bj][m][n];
                    u32x2 o; o.x = pk2(t.x + bflo(g.x) * v.x, t.y + bfhi(g.x) * v.y); o.y = pk2(t.z + bflo(g.y) * v.z, t.w + bfhi(g.y) * v.w);
                    *(u32x2*)(Z + (size_t)row * D_MODEL + col) = o; }
            EPI_BATCH_END
        }
    }
};
struct EpiOutProj {
    static constexpr bool PERM = false, AFTER_DRAIN = false;
    unsigned char* ws; const float* x; const float* norm2_g; float* out;
    __device__ __forceinline__ void operator()(const f32x4 (&acc)[2][2][4][2], const pg8::Unit& u, int wr, int wc, int fr, int fq) const {
        const float* mod = (const float*)(ws + WS_MOD); bf16* XMG = (bf16*)(ws + WS_XMG); float* rowsq = (float*)(ws + WS_ROWSQ);
        const int b = (u.pm * 256) / SEQ;
        const float* g1 = mod + (size_t)b * IN_COLS + 2 * D_MODEL, *sc2 = mod + (size_t)b * IN_COLS + 4 * D_MODEL;
        f32x4 cg[2][2], ch[2][2];
#pragma unroll
        for (int bj = 0; bj < 2; ++bj)
#pragma unroll
            for (int n = 0; n < 2; ++n) { const int col = u.pn * 256 + bj * 128 + wc * 32 + n * 16 + fq * 4; cg[bj][n] = *(const f32x4*)(g1 + col); ch[bj][n] = *(const f32x4*)(norm2_g + col) * (*(const f32x4*)(sc2 + col) + 1.0f); }
        EPI_BATCH_BEGIN
            f32x4 xv[8];
            EPI_VEC_LOOP { EPI_VEC_IDX; xv[vi] = *(const f32x4*)(x + (size_t)row * D_MODEL + col); }
            float ss[2] = {0.f, 0.f};
            EPI_VEC_LOOP { EPI_VEC_IDX; const f32x4 xm = xv[vi] + cg[bj][n] * acc[ai][bj][m][n];
                *(f32x4*)(out + (size_t)row * D_MODEL + col) = xm;
                ss[m2] += (xm.x * xm.x + xm.y * xm.y) + (xm.z * xm.z + xm.w * xm.w);
                const f32x4 h = xm * ch[bj][n];
                u32x2 o; o.x = pk2(h.x, h.y); o.y = pk2(h.z, h.w);
                *(u32x2*)(XMG + (size_t)row * D_MODEL + col) = o; }
#pragma unroll
            for (int m2 = 0; m2 < 2; ++m2) { float t = ss[m2]; t += __shfl_xor(t, 16); t += __shfl_xor(t, 32);
                if (fq == 0) atomicAdd(rowsq + u.pm * 256 + ai * 128 + wr * 64 + (mh + m2) * 16 + fr, t); }
        EPI_BATCH_END
    }
};
__device__ __forceinline__ float dpp_ror1(float v) { return __builtin_bit_cast(float, __builtin_amdgcn_update_dpp(0, __builtin_bit_cast(int, v), 0x121, 0xf, 0xf, false)); }
__device__ __forceinline__ float dpp_rol1(float v) { return __builtin_bit_cast(float, __builtin_amdgcn_update_dpp(0, __builtin_bit_cast(int, v), 0x12f, 0xf, 0xf, false)); }
__device__ __forceinline__ f32x4 ror1_4(const f32x4 v) { return (f32x4){dpp_ror1(v.x), dpp_ror1(v.y), dpp_ror1(v.z), dpp_ror1(v.w)}; }
__device__ __forceinline__ f32x4 rol1_4(const f32x4 v) { return (f32x4){dpp_rol1(v.x), dpp_rol1(v.y), dpp_rol1(v.z), dpp_rol1(v.w)}; }
struct EpiFfnUp {
    static constexpr bool PERM = false, AFTER_DRAIN = false;
    unsigned char* ws; LAS unsigned char* lds; const float* cw; const float* cb;
    __device__ __forceinline__ void operator()(const f32x4 (&acc_c)[2][2][4][2], const pg8::Unit& u, int wr, int wc, int fr, int fq) const {
        f32x4 (&acc)[2][2][4][2] = const_cast<f32x4 (&)[2][2][4][2]>(acc_c);
        const float* rowsq = (const float*)(ws + WS_ROWSQ); bf16* ACT = (bf16*)(ws + WS_ACT); float* HALO = (float*)(ws + WS_HALO) + (size_t)u.pm * 6 * FFN;
        const int b = (u.pm * 256) / SEQ; const float* bias2 = (const float*)(ws + WS_BIAS2) + (size_t)b * 2 * FFN + u.pn * 256;
        const int cl = wc * 32 + fq * 4, ch0 = u.pn * 128 + cl;
        LAS float* X = (LAS float*)(lds + 131072);
#pragma unroll
        for (int ai = 0; ai < 2; ++ai)
#pragma unroll
            for (int m = 0; m < 4; ++m) { const int row = u.pm * 256 + ai * 128 + wr * 64 + m * 16 + fr;
                const float rstd = __builtin_amdgcn_rsqf(rowsq[row] * (1.0f / D_MODEL) + EPS);
#pragma unroll
                for (int bj = 0; bj < 2; ++bj)
#pragma unroll
                    for (int n = 0; n < 2; ++n) acc[ai][bj][m][n] = acc[ai][bj][m][n] * rstd + *(const f32x4*)(bias2 + bj * 128 + cl + 16 * n); }
#pragma unroll
        for (int ai = 0; ai < 2; ++ai) { const int bi = 2 * ai + wr;
            if (fr == 0) {
#pragma unroll
                for (int n = 0; n < 2; ++n) *(LAS f32x4*)(X + (bi * 2 + 0) * 128 + cl + 16 * n) = acc[ai][0][0][n]; }
            if (fr == 15) {
#pragma unroll
                for (int n = 0; n < 2; ++n) *(LAS f32x4*)(X + (bi * 2 + 1) * 128 + cl + 16 * n) = acc[ai][0][3][n]; } }
        asm volatile("s_waitcnt lgkmcnt(0)" ::: "memory"); __builtin_amdgcn_s_barrier(); asm volatile("" ::: "memory");
        if (wr == 0 && fr < 2) {
#pragma unroll
            for (int n = 0; n < 2; ++n) { *(f32x4*)(HALO + (size_t)fr * FFN + ch0 + 16 * n) = acc[0][0][0][n]; if (fr == 0) *(f32x4*)(HALO + (size_t)4 * FFN + ch0 + 16 * n) = acc[0][1][0][n]; } }
        if (wr == 1 && fr >= 14) {
#pragma unroll
            for (int n = 0; n < 2; ++n) { *(f32x4*)(HALO + (size_t)(fr - 12) * FFN + ch0 + 16 * n) = acc[1][0][3][n]; if (fr == 15) *(f32x4*)(HALO + (size_t)5 * FFN + ch0 + 16 * n) = acc[1][1][3][n]; } }
#pragma unroll
        for (int n = 0; n < 2; ++n) {
            const f32x4 w0 = *(const f32x4*)(cw + ch0 + 16 * n), w1 = *(const f32x4*)(cw + FFN + ch0 + 16 * n), w2 = *(const f32x4*)(cw + 2 * FFN + ch0 + 16 * n), cbv = *(const f32x4*)(cb + ch0 + 16 * n);
#pragma unroll
            for (int ai = 0; ai < 2; ++ai) { const int bi = 2 * ai + wr;
                const f32x4 xprev = (bi > 0) ? *(const LAS f32x4*)(X + ((bi - 1) * 2 + 1) * 128 + cl + 16 * n) : (f32x4){0.f, 0.f, 0.f, 0.f};
                const f32x4 xnext = (bi < 3) ? *(const LAS f32x4*)(X + ((bi + 1) * 2 + 0) * 128 + cl + 16 * n) : (f32x4){0.f, 0.f, 0.f, 0.f};
#pragma unroll
                for (int m = 0; m < 4; ++m) { const f32x4 cur = acc[ai][0][m][n];
                    const f32x4 pu = (m > 0) ? ror1_4(acc[ai][0][m > 0 ? m - 1 : 0][n]) : xprev; const f32x4 ps = ror1_4(cur);
                    const f32x4 nd = (m < 3) ? rol1_4(acc[ai][0][m < 3 ? m + 1 : 3][n]) : xnext; const f32x4 ns = rol1_4(cur);
                    const f32x4 prev = (fr > 0) ? ps : pu, next = (fr < 15) ? ns : nd;
                    const f32x4 uu = w0 * prev + w1 * cur + w2 * next + cbv; const f32x4 gt = acc[ai][1][m][n];
                    f32x4 r; r.x = siluf_(uu.x) * gt.x; r.y = siluf_(uu.y) * gt.y; r.z = siluf_(uu.z) * gt.z; r.w = siluf_(uu.w) * gt.w;
                    const int rl = ai * 128 + wr * 64 + m * 16 + fr;
                    if (rl != 0 && rl != 255) { u32x2 o; o.x = pk2(r.x, r.y); o.y = pk2(r.z, r.w); *(u32x2*)(ACT + (size_t)(u.pm * 256 + rl) * FFN + ch0 + 16 * n) = o; } } } }
    }
};
__device__ __forceinline__ void halo_fix(const Params& p, int pm, int tid) {
    const float* HB = (const float*)(p.ws + WS_HALO); const float* H = HB + (size_t)pm * 6 * FFN; bf16* ACT = (bf16*)(p.ws + WS_ACT);
    for (int ch = tid; ch < FFN; ch += NTHREADS) {
        const float w0 = p.conv_w[ch], w1 = p.conv_w[FFN + ch], w2 = p.conv_w[2 * FFN + ch], cbv = p.conv_b[ch];
        const float pv = (pm & 7) ? HB[((size_t)(pm - 1) * 6 + 3) * FFN + ch] : 0.f; const float nx = ((pm & 7) != 7) ? HB[((size_t)(pm + 1) * 6 + 0) * FFN + ch] : 0.f;
        const float ut = w0 * pv + w1 * H[ch] + w2 * H[FFN + ch] + cbv; const float ub = w0 * H[2 * FFN + ch] + w1 * H[3 * FFN + ch] + w2 * nx + cbv;
        ACT[(size_t)(pm * 256) * FFN + ch] = (bf16)f2bf(siluf_(ut) * H[4 * FFN + ch]); ACT[(size_t)(pm * 256 + 255) * FFN + ch] = (bf16)f2bf(siluf_(ub) * H[5 * FFN + ch]);
    }
}
struct EpiFfnDown {
    static constexpr bool PERM = false, AFTER_DRAIN = false;
    unsigned char* ws; float* out;
    __device__ __forceinline__ void operator()(const f32x4 (&acc)[2][2][4][2], const pg8::Unit& u, int wr, int wc, int fr, int fq) const {
        const float* mod = (const float*)(ws + WS_MOD); const int b = (u.pm * 256) / SEQ; const float* g2 = mod + (size_t)b * IN_COLS + 5 * D_MODEL;
        f32x4 cg[2][2];
#pragma unroll
        for (int bj = 0; bj < 2; ++bj)
#pragma unroll
            for (int n = 0; n < 2; ++n) cg[bj][n] = *(const f32x4*)(g2 + u.pn * 256 + bj * 128 + wc * 32 + n * 16 + fq * 4);
        EPI_BATCH_BEGIN
            f32x4 xv[8];
            EPI_VEC_LOOP { EPI_VEC_IDX; xv[vi] = *(const f32x4*)(out + (size_t)row * D_MODEL + col); }
            EPI_VEC_LOOP { EPI_VEC_IDX; *(f32x4*)(out + (size_t)row * D_MODEL + col) = xv[vi] + cg[bj][n] * acc[ai][bj][m][n]; }
        EPI_BATCH_END
    }
};

#define XB_TMO      128
#define XB_XCNT(j)  (256  + 64 * (j))
#define XB_XSUB(j)  (1280 + 64 * (j))
#define XB_XGEN(j)  (2304 + 64 * (j))
#define XB_TOP      3328
#define XB_TOPGEN   3392
#define XCD_BAR_WORDS 3456
#define XB_SPIN_CAP (1u << 18)

__device__ __forceinline__ unsigned xb_ld(unsigned* p)              { return __hip_atomic_load(p, __ATOMIC_RELAXED, __HIP_MEMORY_SCOPE_AGENT); }
__device__ __forceinline__ unsigned xb_add(unsigned* p, unsigned v) { return __hip_atomic_fetch_add(p, v, __ATOMIC_RELAXED, __HIP_MEMORY_SCOPE_AGENT); }
__device__ __forceinline__ unsigned xb_xcc_id() { return (unsigned)__builtin_amdgcn_s_getreg((3 << 11) | 20) & 0xFu; }
#define XB_SPIN(cond, bar) do { unsigned _sp = 0; while (cond) { __builtin_amdgcn_s_sleep(1); \
    if ((++_sp & 255u) == 0u) { if (xb_ld(&(bar)[XB_TMO])) break; if (_sp > XB_SPIN_CAP) { atomicAdd(&(bar)[XB_TMO], 1u); break; } } } } while (0)

struct XcdBarrier {
    unsigned* bar; unsigned x; int wave;
    volatile LAS unsigned* st;
};

__device__ __forceinline__ XcdBarrier xcd_barrier_post(unsigned* bar, volatile LAS unsigned* st, int wave_id) {
    XcdBarrier b; b.bar = bar; b.x = xb_xcc_id(); b.st = st; b.wave = wave_id;
    if (wave_id == 0 && lane_id() == 0) (void)xb_add(&bar[XB_XCNT(b.x)], 1u);
    return b;
}
__device__ __forceinline__ void xcd_barrier_complete(unsigned* bar, unsigned x, unsigned& nloc, unsigned& nx) {
    const unsigned G = gridDim.x * gridDim.y * gridDim.z;
    unsigned sum, cnt, mine, sp = 0u;
    for (;;) {
        sum = 0u; cnt = 0u; mine = 0u;
#pragma unroll
        for (unsigned j = 0; j < 16; ++j) { const unsigned c = xb_ld(&bar[XB_XCNT(j)]); sum += c; cnt += (c > 0u) ? 1u : 0u; mine = (j == x) ? c : mine; }
        if (sum == G) break;
        __builtin_amdgcn_s_sleep(1);
        if ((++sp & 255u) == 0u) { if (xb_ld(&bar[XB_TMO])) break; if (sp > XB_SPIN_CAP) { atomicAdd(&bar[XB_TMO], 1u); break; } }
    }
    nloc = mine > 0u ? mine : 1u; nx = cnt > 0u ? cnt : 1u;
}

__device__ __forceinline__ void xcd_barrier(const XcdBarrier& b) {
    asm volatile("s_waitcnt vmcnt(0)" ::: "memory");
    __syncthreads();
    if (b.wave == 0 && lane_id() == 0) {
        unsigned* bar = b.bar;
        __builtin_amdgcn_s_waitcnt(0);
        unsigned nloc = b.st[0], nx = b.st[1];
        if (nloc == 0u) { xcd_barrier_complete(bar, b.x, nloc, nx); b.st[0] = nloc; b.st[1] = nx; }
        const unsigned old = xb_add(&bar[XB_XSUB(b.x)], 1u);
        const unsigned gen = old / nloc;
        if (old + 1u == (gen + 1u) * nloc) {
            __builtin_amdgcn_fence(__ATOMIC_RELEASE, "agent");
            asm volatile("s_waitcnt vmcnt(0)" ::: "memory");
            const unsigned og = xb_add(&bar[XB_TOP], 1u);
            const unsigned tg = og / nx;
            if (og + 1u == (tg + 1u) * nx) xb_add(&bar[XB_TOPGEN], 1u);
            else XB_SPIN(xb_ld(&bar[XB_TOPGEN]) == tg, bar);
            __builtin_amdgcn_fence(__ATOMIC_ACQUIRE, "agent");
            xb_add(&bar[XB_XGEN(b.x)], 1u);
            asm volatile("s_waitcnt vmcnt(0)" ::: "memory");
        } else {
            XB_SPIN(xb_ld(&bar[XB_XGEN(b.x)]) == gen, bar);
            __builtin_amdgcn_fence(__ATOMIC_ACQUIRE, "agent");
            asm volatile("s_waitcnt vmcnt(0)" ::: "memory");
        }
    }
    __syncthreads();
}

constexpr size_t WS_BAR = 8192;

typedef short bf16x8 __attribute__((ext_vector_type(8)));
typedef short s16x4 __attribute__((ext_vector_type(4)));

__device__ __forceinline__ bf16x8 cat8u(const u32x2 a, const u32x2 b) { const u32x4 w = (u32x4){a.x, a.y, b.x, b.y}; return __builtin_bit_cast(bf16x8, w); }
__device__ __forceinline__ bf16x8 pack_p(const f32x4 a, const f32x4 b) {
    u32x4 w; w.x = pk2(a.x, a.y); w.y = pk2(a.z, a.w); w.z = pk2(b.x, b.y); w.w = pk2(b.z, b.w);
    return __builtin_bit_cast(bf16x8, w);
}

constexpr int A_TILE = 32768, A_KOFF = 0, A_VOFF = 16384;
constexpr int A_BIAS = 4 * A_TILE;
constexpr int A_ITEM = A_BIAS + 2048;
static_assert(A_ITEM + 64 <= 145408, "attention LDS");
constexpr size_t WS_ATTCTR = 32768;
static_assert(WS_ATTCTR >= WS_BAR + XCD_BAR_WORDS * 4 && WS_ATTCTR + 8 * 256 <= WS_ROWSQ, "attn counters (8 x 256 B apart) inside ctl");
#define ATT_BAR() do { asm volatile("s_waitcnt lgkmcnt(0)" ::: "memory"); __builtin_amdgcn_s_barrier(); asm volatile("" ::: "memory"); } while (0)
__device__ __forceinline__ void glds16(const void* gsrc, unsigned lds_dst) { unsigned keep;
    asm volatile("s_mov_b32 %0, m0\n\ts_mov_b32 m0, %2\n\ts_nop 0\n\tglobal_load_lds_dwordx4 %1, off\n\ts_mov_b32 m0, %0" : "=&s"(keep) : "v"(gsrc), "s"(lds_dst) : "memory"); }
__device__ __forceinline__ unsigned lds_addr(LAS const void* p) { return (unsigned)__builtin_amdgcn_readfirstlane((int)(unsigned)(unsigned long long)p); }

__device__ __forceinline__ void phase_attn(const Params& p, LAS unsigned char* lds) {
    int tid_o = tid_of(p.wave_id);
    const int tid = tid_o, lane = tid & 63, wave = __builtin_amdgcn_readfirstlane(tid >> 6);
    const int qb = wave & 3, rw = wave >> 2, li = lane & 15, g = lane >> 4;
    const bf16* QN = (const bf16*)(p.ws + WS_QN); const bf16* KN = (const bf16*)(p.ws + WS_KN); const bf16* VT = (const bf16*)(p.ws + WS_VN);
    bf16* YB = (bf16*)p.out + (size_t)3 * ML * WA;
    unsigned* ctr = (unsigned*)(p.ws + WS_ATTCTR);
    LAS float* btab = (LAS float*)(lds + A_BIAS);
    const float scale = 0.08838834764831845f;
    int krow_l[2], kch_l[2], vrow_l[2], vch_l[2];
#pragma unroll
    for (int e = 0; e < 2; ++e) { const int pk = 2 * wave + e; krow_l[e] = 4 * pk + (lane >> 4); kch_l[e] = (lane & 15) ^ (krow_l[e] & 15);
        vrow_l[e] = 8 * pk + (lane >> 3); vch_l[e] = (lane & 7) ^ ((vrow_l[e] >> 1) & 7); }
    const int myx = (int)(xb_xcc_id() & 7u);
    int qoff = 0;
    for (;;) {
        if (tid == 0) { unsigned v = 0xffffffffu;
            while (qoff < 8) { const int qx = (myx + qoff) & 7; const unsigned n = atomicAdd(ctr + 64 * qx, 1u); if (n < 64u) { v = (unsigned)((qx + 8 * (n >> 4)) * 16 + (n & 15)); break; } ++qoff; }
            *(LAS unsigned*)(lds + A_ITEM) = v; }
        __syncthreads();
        const unsigned itu = *(LAS unsigned*)(lds + A_ITEM);
        if (itu == 0xffffffffu) break;
        const int it = (int)itu;
        const int rp = it & 15, h = (it >> 4) & 7, b = it >> 7;
        const int r = 2 * rp + rw;
        const int rs = min(max(r - 4, 0), 24), ks0 = min(max(16 * qb - 8, 0), 32);
        const int kr0 = min(max(2 * rp - 4, 0), 24), nband = min(max(2 * rp + 1 - 4, 0), 24) + 8 - kr0, NT = nband + 4;
        const int cq = 16 * qb + li, cs = min(max(cq - 8, 0), 48);
        const size_t qrow = (size_t)b * SEQ + r * GRID_W + cq;
        if (tid < 15 * 31) btab[tid] = p.rel_bias[h * 465 + tid];
        bf16x8 qf[4];
#pragma unroll
        for (int ks = 0; ks < 4; ++ks) qf[ks] = *(const bf16x8*)(QN + qrow * WA + h * HD + 32 * ks + 8 * g);
        asm volatile("s_waitcnt vmcnt(0)" ::: "memory");
        const bf16* kg0 = KN + (size_t)h * HD + (size_t)krow_l[0] * WA + 8 * kch_l[0]; const bf16* kg1 = KN + (size_t)h * HD + (size_t)krow_l[1] * WA + 8 * kch_l[1];
        const bf16* vg0 = VT + ((size_t)(b * NHEAD + h) * HD + vrow_l[0]) * VT_PITCH + 8 * vch_l[0]; const bf16* vg1 = VT + ((size_t)(b * NHEAD + h) * HD + vrow_l[1]) * VT_PITCH + 8 * vch_l[1];
#define ATT_DMA(ti_) do { const int t_ = (ti_) < NT ? (ti_) : NT - 1; const unsigned la_ = lds_addr(lds + ((ti_) & 3) * A_TILE + wave * 2048); \
            const size_t krow0 = (t_ < nband) ? ((size_t)b * SEQ + (kr0 + t_) * GRID_W) : ((size_t)ML + b * CTX + 64 * (t_ - nband)); \
            const int tok0 = (t_ < nband) ? ((kr0 + t_) * GRID_W) : (SEQ + 64 * (t_ - nband)); \
            glds16(kg0 + krow0 * WA, la_ + A_KOFF); glds16(kg1 + krow0 * WA, la_ + A_KOFF + 1024); glds16(vg0 + tok0, la_ + A_VOFF); glds16(vg1 + tok0, la_ + A_VOFF + 1024); } while (0)
        ATT_DMA(0); ATT_DMA(1); ATT_DMA(2);
        f32x4 ot[8];
#pragma unroll
        for (int db = 0; db < 8; ++db) ot[db] = (f32x4){0.f, 0.f, 0.f, 0.f};
        float mrun = -1e30f, l = 0.f;
        const int kx = (ks0 + li) & 15, vy = (li >> 1) & 7;
        int koff[4];
#pragma unroll
        for (int ks = 0; ks < 4; ++ks) koff[ks] = A_KOFF + (ks0 + li) * 256 + (((4 * ks + g) ^ kx) << 4);
        const int vrow_off = A_VOFF + li * 128 + 8 * (g & 1);
        const int gq = g >> 1;
#pragma unroll 1
        for (int ti = 0; ti < NT; ++ti) {
            asm volatile("s_waitcnt vmcnt(8)" ::: "memory");
            ATT_BAR();
            ATT_DMA(ti + 3);
            const LAS unsigned char* tb = lds + (ti & 3) * A_TILE;
            if (ti < nband) {
                const int kr = kr0 + ti;
                if (kr >= rs && kr < rs + 8) {
                    f32x4 st[2];
#pragma unroll
                    for (int kb = 0; kb < 2; ++kb) { f32x4 a = (f32x4){0.f, 0.f, 0.f, 0.f};
#pragma unroll
                        for (int ks = 0; ks < 4; ++ks) a = __builtin_amdgcn_mfma_f32_16x16x32_bf16(*(const LAS bf16x8*)(tb + koff[ks] + kb * 4096), qf[ks], a, 0, 0, 0);
                        st[kb] = a; }
                    const int dr = kr - r + 7; float gm = -1e30f;
#pragma unroll
                    for (int kb = 0; kb < 2; ++kb)
#pragma unroll
                        for (int j = 0; j < 4; ++j) { const int kcol = ks0 + 16 * kb + 4 * g + j; const bool valid = (kcol >= cs) && (kcol < cs + 16);
                            const int bi = valid ? (dr * 31 + (kcol - cq + 15)) : 0;
                            const float sv = valid ? (st[kb][j] * scale + btab[bi]) : -1e30f; st[kb][j] = sv; gm = fmaxf(gm, sv); }
                    gm = fmaxf(gm, __shfl_xor(gm, 16)); gm = fmaxf(gm, __shfl_xor(gm, 32));
                    const float mnew = fmaxf(mrun, gm); const float alpha = __expf(mrun - mnew); mrun = mnew; l *= alpha;
#pragma unroll
                    for (int db = 0; db < 8; ++db) ot[db] = ot[db] * alpha;
#pragma unroll
                    for (int kb = 0; kb < 2; ++kb)
#pragma unroll
                        for (int j = 0; j < 4; ++j) { const float sv = st[kb][j]; const float e = (sv > -1e29f) ? __expf(sv - mnew) : 0.f; st[kb][j] = e; l += e; }
                    const bf16x8 pb = pack_p(st[0], st[1]);
                    const int c0 = (ks0 >> 3) + gq;
#pragma unroll
                    for (int db = 0; db < 8; ++db) { const LAS unsigned char* vp = tb + vrow_off + db * 2048;
                        ot[db] = __builtin_amdgcn_mfma_f32_16x16x32_bf16(cat8u(*(const LAS u32x2*)(vp + ((c0 ^ vy) << 4)), *(const LAS u32x2*)(vp + (((c0 + 2) ^ vy) << 4))), pb, ot[db], 0, 0, 0); }
                }
            } else {
                f32x4 st[4];
#pragma unroll
                for (int kb = 0; kb < 4; ++kb) { f32x4 a = (f32x4){0.f, 0.f, 0.f, 0.f};
#pragma unroll
                    for (int ks = 0; ks < 4; ++ks) a = __builtin_amdgcn_mfma_f32_16x16x32_bf16(*(const LAS bf16x8*)(tb + A_KOFF + (16 * kb + li) * 256 + (((4 * ks + g) ^ li) << 4)), qf[ks], a, 0, 0, 0);
                    st[kb] = a * scale; }
                float gm = -1e30f;
#pragma unroll
                for (int kb = 0; kb < 4; ++kb) gm = fmaxf(fmaxf(gm, fmaxf(st[kb][0], st[kb][1])), fmaxf(st[kb][2], st[kb][3]));
                gm = fmaxf(gm, __shfl_xor(gm, 16)); gm = fmaxf(gm, __shfl_xor(gm, 32));
                const float mnew = fmaxf(mrun, gm); const float alpha = __expf(mrun - mnew); mrun = mnew; l *= alpha;
#pragma unroll
                for (int db = 0; db < 8; ++db) ot[db] = ot[db] * alpha;
#pragma unroll
                for (int kb = 0; kb < 4; ++kb)
#pragma unroll
                    for (int j = 0; j < 4; ++j) { const float e = __expf(st[kb][j] - mnew); st[kb][j] = e; l += e; }
#pragma unroll
                for (int kp2 = 0; kp2 < 2; ++kp2) { const bf16x8 pb = pack_p(st[2 * kp2], st[2 * kp2 + 1]);
                    const int c0 = 4 * kp2 + gq;
#pragma unroll
                    for (int db = 0; db < 8; ++db) { const LAS unsigned char* vp = tb + vrow_off + db * 2048;
                        ot[db] = __builtin_amdgcn_mfma_f32_16x16x32_bf16(cat8u(*(const LAS u32x2*)(vp + ((c0 ^ vy) << 4)), *(const LAS u32x2*)(vp + (((c0 + 2) ^ vy) << 4))), pb, ot[db], 0, 0, 0); } }
            }
        }
        asm volatile("s_waitcnt vmcnt(0)" ::: "memory");
        l += __shfl_xor(l, 16); l += __shfl_xor(l, 32);
        const float inv = 1.0f / l;
#pragma unroll
        for (int db = 0; db < 8; ++db) { const f32x4 o = ot[db] * inv; u32x2 w; w.x = pk2(o.x, o.y); w.y = pk2(o.z, o.w);
            *(u32x2*)(YB + qrow * WA + h * HD + 16 * db + 4 * g) = w; }
#undef ATT_DMA
    }
}

constexpr int HP = 160;
constexpr int H_QH = 0, H_KH = 20480, H_KE = 40960, H_QD = 61440, H_KD = 81920;
constexpr int HP2 = 48;
constexpr int H_Q2 = 102400, H_K2 = 108544;
constexpr int PP = 144;
constexpr int H_P = 114688;
constexpr int H_T = 123904;
constexpr int H_D = 125952;
constexpr int HIMG_QD = 0, HIMG_KD = 16384, HIMG_P = 32768, HIMG_D = 40960, HIMG_BYTES = 41472;
constexpr int NCH = (CTX + SEQ) / 64;
constexpr int VP = 288;
constexpr int HPK = 136;
constexpr int SB_QD = 0, SB_KD = 20480, SB_P = 40960, SB_D = 50176, SB_V = 50688, SB_BYTES = 69120;
static_assert(2 * SB_BYTES <= 145408, "scan buffers");

__device__ __forceinline__ s16x4 lds_tr(LAS const unsigned char* p) {
    return __builtin_bit_cast(s16x4, __builtin_amdgcn_ds_read_tr16_b64_v4i16((LAS s16x4*)p));
}
__device__ __forceinline__ bf16x8 cat8(const s16x4 a, const s16x4 b) { return __builtin_shufflevector(a, b, 0, 1, 2, 3, 4, 5, 6, 7); }

__device__ __forceinline__ size_t hg_row(int dir, int b, int tau) {
    if (tau < CTX) return (size_t)ML + b * CTX + (dir == 0 ? tau : CTX - 1 - tau);
    const int t = tau - CTX; return (size_t)b * SEQ + (dir == 0 ? t : SEQ - 1 - t);
}

__device__ __forceinline__ void hgrn_prep(const Params& p, LAS unsigned char* lds, int vb, int nb) {
    int tid_o = tid_of(p.wave_id);
    const int tid = tid_o, lane = tid & 63, wave = __builtin_amdgcn_readfirstlane(tid >> 6);
    const int k = tid & 127, J = __builtin_amdgcn_readfirstlane(tid >> 7);
    const int li = lane & 15, g = lane >> 4, qq = li >> 2, pp = li & 3;
    LAS float* Tl = (LAS float*)(lds + H_T); LAS float* Dl = (LAS float*)(lds + H_D);
    float lf[16]; unsigned qv[16];
#define HG_LOADP(idx_) do { const int id_ = (idx_); const int ch_ = id_ / NCH, cc_ = id_ % NCH; const int dir_ = ch_ / (BATCH * NHEAD), b_ = (ch_ / NHEAD) % BATCH, h_ = ch_ % NHEAD; \
        const size_t row0_ = hg_row(dir_, b_, 64 * cc_ + 16 * J); const long st_ = dir_ ? -(long)WA : (long)WA; \
        const float* lfp_ = (const float*)(p.ws + (dir_ == 0 ? WS_FW : WS_FB)) + row0_ * WA + h_ * HD + k; const bf16* qp_ = (const bf16*)(p.ws + WS_QA) + row0_ * WA + h_ * HD + k; \
        _Pragma("unroll") for (int i = 0; i < 16; ++i) { lf[i] = lfp_[(long)i * st_]; qv[i] = (cc_ >= 4) ? (unsigned)qp_[(long)i * st_] : 0u; } } while (0)
    if (vb < 64 * NCH) HG_LOADP(vb);
    for (int idx = vb; idx < 64 * NCH; idx += nb) {
        const int c = idx % NCH;
        float cum[16]; float run = 0.f;
#pragma unroll
        for (int i = 0; i < 16; ++i) { run += lf[i]; cum[i] = run; }
        Tl[J * 128 + k] = run;
        ATT_BAR();
        const float T0 = Tl[k], T1 = Tl[128 + k], T2 = Tl[256 + k], T3 = Tl[384 + k];
        const float bJ = (J > 0 ? T0 : 0.f) + (J > 1 ? T1 : 0.f) + (J > 2 ? T2 : 0.f);
        const float tail = (J < 1 ? T1 : 0.f) + (J < 2 ? T2 : 0.f) + (J < 3 ? T3 : 0.f);
        const float eb = __expf(bJ), et = __expf(tail), eT = __expf(run);
        const float x2 = (J == 3) ? __expf(T2) : __expf(T1);
        float qh[16], kh[16];
#pragma unroll
        for (int i = 0; i < 16; ++i) { const float e1 = __expf(cum[i]); const float r1 = __builtin_amdgcn_rcpf(e1); const float kk = 1.0f - __expf(lf[i]);
            qh[i] = __builtin_bit_cast(float, qv[i] << 16) * e1; kh[i] = kk * r1; }
        {
            LAS unsigned char* rowp = lds + k * HP + 32 * J;
            u32x4 w0, w1;
#define HG_WRITE(OFF, EXPR) do { \
            { float v0_, v1_; \
              { const int i = 0; v0_ = (EXPR); } { const int i = 1; v1_ = (EXPR); } w0.x = pk2(v0_, v1_); \
              { const int i = 2; v0_ = (EXPR); } { const int i = 3; v1_ = (EXPR); } w0.y = pk2(v0_, v1_); \
              { const int i = 4; v0_ = (EXPR); } { const int i = 5; v1_ = (EXPR); } w0.z = pk2(v0_, v1_); \
              { const int i = 6; v0_ = (EXPR); } { const int i = 7; v1_ = (EXPR); } w0.w = pk2(v0_, v1_); \
              { const int i = 8; v0_ = (EXPR); } { const int i = 9; v1_ = (EXPR); } w1.x = pk2(v0_, v1_); \
              { const int i = 10; v0_ = (EXPR); } { const int i = 11; v1_ = (EXPR); } w1.y = pk2(v0_, v1_); \
              { const int i = 12; v0_ = (EXPR); } { const int i = 13; v1_ = (EXPR); } w1.z = pk2(v0_, v1_); \
              { const int i = 14; v0_ = (EXPR); } { const int i = 15; v1_ = (EXPR); } w1.w = pk2(v0_, v1_); } \
            *(LAS u32x4*)(OFF) = w0; *(LAS u32x4*)((OFF) + 16) = w1; } while (0)
            HG_WRITE(rowp + H_QH, qh[i]);
            HG_WRITE(rowp + H_KH, kh[i]);
            HG_WRITE(rowp + H_KE, kh[i] * eT);
            HG_WRITE(rowp + H_QD, qh[i] * eb);
            HG_WRITE(rowp + H_KD, kh[i] * (eT * et));
            if (J == 3) { HG_WRITE(lds + H_Q2 + k * HP2, qh[i] * x2); }
            if (J == 0) { HG_WRITE(lds + H_K2 + k * HP2, kh[i] * (eT * x2)); }
#undef HG_WRITE
            if (J == 3) Dl[k] = __expf(bJ + run);
        }
        if (idx + nb < 64 * NCH) HG_LOADP(idx + nb);
        ATT_BAR();
        const bool lat = (c >= 4);
        if (lat) {
#pragma unroll
            for (int rep = 0; rep < 2; ++rep) {
                int I, Jb;
                if (rep == 0) { I = (wave < 4) ? wave : (wave == 4 ? 1 : (wave == 7 ? 3 : 2)); Jb = (wave < 4) ? wave : (wave == 4 ? 0 : (wave == 5 ? 0 : (wave == 6 ? 1 : 2))); }
                else { if (wave >= 2) break; I = 3; Jb = wave; }
                int aoff, apitch, acol, boff, bpitch, bcol;
                if (I == Jb) { aoff = H_KH; apitch = HP; acol = 16 * Jb; boff = H_QH; bpitch = HP; bcol = 16 * I; }
                else if (I == Jb + 1 && I != 2) { aoff = H_KE; apitch = HP; acol = 16 * Jb; boff = H_QH; bpitch = HP; bcol = 16 * I; }
                else if (I == 2) { if (Jb == 0) { aoff = H_K2; apitch = HP2; acol = 0; } else { aoff = H_KE; apitch = HP; acol = 16; } boff = H_QH; bpitch = HP; bcol = 32; }
                else { if (Jb == 0) { aoff = H_K2; apitch = HP2; acol = 0; } else { aoff = H_KE; apitch = HP; acol = 16; } boff = H_Q2; bpitch = HP2; bcol = 0; }
                f32x4 pt = (f32x4){0.f, 0.f, 0.f, 0.f};
#pragma unroll
                for (int ks = 0; ks < 4; ++ks) {
                    const int r0 = 32 * ks + 4 * g + qq;
                    const bf16x8 a = cat8(lds_tr(lds + aoff + r0 * apitch + (acol + 4 * pp) * 2), lds_tr(lds + aoff + (r0 + 16) * apitch + (acol + 4 * pp) * 2));
                    const bf16x8 bb = cat8(lds_tr(lds + boff + r0 * bpitch + (bcol + 4 * pp) * 2), lds_tr(lds + boff + (r0 + 16) * bpitch + (bcol + 4 * pp) * 2));
                    pt = __builtin_amdgcn_mfma_f32_16x16x32_bf16(a, bb, pt, 0, 0, 0);
                }
                if (I == Jb) {
#pragma unroll
                    for (int j = 0; j < 4; ++j) if (4 * g + j > li) pt[j] = 0.f;
                }
                u32x2 w; w.x = pk2(pt.x, pt.y); w.y = pk2(pt.z, pt.w);
                *(LAS u32x2*)(lds + H_P + (16 * I + li) * PP + (16 * Jb + 4 * g) * 2) = w;
            }
        }
        ATT_BAR();
        unsigned char* img = p.ws + WS_HIMG + (size_t)idx * HIMG_BYTES;
#pragma unroll
        for (int e = 0; e < 2; ++e) { const int id = tid + 512 * e; const int kr = id >> 3, part = id & 7;
            if (lat) *(u32x4*)(img + HIMG_QD + id * 16) = *(const LAS u32x4*)(lds + H_QD + kr * HP + 16 * part);
            *(u32x4*)(img + HIMG_KD + id * 16) = *(const LAS u32x4*)(lds + H_KD + kr * HP + 16 * part); }
        if (lat) *(u32x4*)(img + HIMG_P + tid * 16) = *(const LAS u32x4*)(lds + H_P + (tid >> 3) * PP + 16 * (tid & 7));
        if (tid < 32) *(u32x4*)(img + HIMG_D + tid * 16) = *(const LAS u32x4*)(lds + H_D + 16 * tid);
    }
#undef HG_LOADP
    __syncthreads();
}

__device__ __forceinline__ void hgrn_scan(const Params& p, LAS unsigned char* lds, int chain) {
    int tid_o = tid_of(p.wave_id);
    const int tid = tid_o, lane = tid & 63, wave = __builtin_amdgcn_readfirstlane(tid >> 6);
    const int li = lane & 15, g = lane >> 4, qq = li >> 2, pp = li & 3;
    const int dir = chain / (BATCH * NHEAD), b = (chain / NHEAD) % BATCH, h = chain % NHEAD;
    const bf16* IA = (const bf16*)(p.ws + WS_IA) + h * HD;
    bf16* O = ((bf16*)p.out + (dir == 0 ? 0 : (size_t)ML * WA)) + h * HD + 16 * wave + li;
    const long ost = dir ? -(long)WA : (long)WA;
    const unsigned char* img0 = p.ws + WS_HIMG + (size_t)chain * NCH * HIMG_BYTES;
    f32x4 S[8];
#pragma unroll
    for (int i = 0; i < 8; ++i) S[i] = (f32x4){0.f, 0.f, 0.f, 0.f};
    u32x4 rq[2][2], rk[2][2], rp[2], rd[2], rv[2][2];
#define HS_LOAD(c_, set_) do { const int cc_ = (c_); const unsigned char* im_ = img0 + (size_t)cc_ * HIMG_BYTES; \
        if (cc_ >= 4) { rq[set_][0] = *(const u32x4*)(im_ + HIMG_QD + tid * 16); rq[set_][1] = *(const u32x4*)(im_ + HIMG_QD + (tid + 512) * 16); rp[set_] = *(const u32x4*)(im_ + HIMG_P + tid * 16); } \
        rk[set_][0] = *(const u32x4*)(im_ + HIMG_KD + tid * 16); rk[set_][1] = *(const u32x4*)(im_ + HIMG_KD + (tid + 512) * 16); \
        if (tid < 32) rd[set_] = *(const u32x4*)(im_ + HIMG_D + tid * 16); \
        _Pragma("unroll") for (int e = 0; e < 2; ++e) { const int idx_ = tid * 2 + e; const size_t row_ = hg_row(dir, b, 64 * cc_ + (idx_ >> 4)); rv[set_][e] = *(const u32x4*)(IA + row_ * WA + 8 * (idx_ & 15)); } } while (0)
#define HS_STORE(c_, set_) do { const int cc_ = (c_); LAS unsigned char* bb_ = lds + (cc_ & 1) * SB_BYTES; \
        if (cc_ >= 4) { *(LAS u32x4*)(bb_ + SB_QD + (tid >> 3) * HP + 16 * (tid & 7)) = rq[set_][0]; *(LAS u32x4*)(bb_ + SB_QD + ((tid >> 3) + 64) * HP + 16 * (tid & 7)) = rq[set_][1]; \
                        *(LAS u32x4*)(bb_ + SB_P + (tid >> 3) * PP + 16 * (tid & 7)) = rp[set_]; } \
        { LAS unsigned char* k0_ = bb_ + SB_KD + (tid >> 3) * HPK + 16 * (tid & 7); LAS unsigned char* k1_ = k0_ + 64 * HPK; \
          *(LAS u32x2*)k0_ = (u32x2){rk[set_][0].x, rk[set_][0].y}; *(LAS u32x2*)(k0_ + 8) = (u32x2){rk[set_][0].z, rk[set_][0].w}; *(LAS u32x2*)k1_ = (u32x2){rk[set_][1].x, rk[set_][1].y}; *(LAS u32x2*)(k1_ + 8) = (u32x2){rk[set_][1].z, rk[set_][1].w}; } \
        if (tid < 32) *(LAS u32x4*)(bb_ + SB_D + 16 * tid) = rd[set_]; \
        _Pragma("unroll") for (int e = 0; e < 2; ++e) { const int idx_ = tid * 2 + e; *(LAS u32x4*)(bb_ + SB_V + (idx_ >> 4) * VP + 16 * (idx_ & 15)) = rv[set_][e]; } } while (0)
    HS_LOAD(0, 0); HS_LOAD(1, 1);
    HS_STORE(0, 0);
    HS_LOAD(2, 0);
    ATT_BAR();
#pragma unroll 1
    for (int c2 = 0; c2 < NCH; c2 += 2) {
#pragma unroll
    for (int uu = 0; uu < 2; ++uu) { const int c = c2 + uu;
        const LAS unsigned char* bb = lds + (c & 1) * SB_BYTES;
        const bool lat = (c >= 4);
        bf16x8 vf[2];
#pragma unroll
        for (int sp = 0; sp < 2; ++sp) {
            const LAS unsigned char* vb0 = bb + SB_V + (32 * sp + 4 * g + qq) * VP + (16 * wave + 4 * pp) * 2;
            vf[sp] = cat8(lds_tr(vb0), lds_tr(vb0 + 16 * VP));
        }
        if (lat) {
            bf16x8 sb[4];
#pragma unroll
            for (int ks = 0; ks < 4; ++ks) sb[ks] = pack_p(S[2 * ks], S[2 * ks + 1]);
            bf16* orow = O + (long)hg_row(dir, b, 64 * c) * WA;
#pragma unroll
            for (int I = 0; I < 4; ++I) {
                f32x4 o = (f32x4){0.f, 0.f, 0.f, 0.f};
#pragma unroll
                for (int ks = 0; ks < 4; ++ks) {
                    const LAS unsigned char* ap = bb + SB_QD + (32 * ks + 4 * g + qq) * HP + (16 * I + 4 * pp) * 2;
                    o = __builtin_amdgcn_mfma_f32_16x16x32_bf16(cat8(lds_tr(ap), lds_tr(ap + 16 * HP)), sb[ks], o, 0, 0, 0);
                }
#pragma unroll
                for (int sp = 0; sp < 2; ++sp) {
                    if (2 * sp > I) break;
                    const LAS unsigned char* pr = bb + SB_P + (16 * I + li) * PP + (32 * sp + 4 * g) * 2;
                    const u32x2 lo = *(const LAS u32x2*)pr; u32x2 hi = (u32x2){0u, 0u};
                    if (2 * sp + 1 <= I) hi = *(const LAS u32x2*)(pr + 32);
                    o = __builtin_amdgcn_mfma_f32_16x16x32_bf16(cat8u(lo, hi), vf[sp], o, 0, 0, 0);
                }
#pragma unroll
                for (int j = 0; j < 4; ++j) orow[(long)(16 * I + 4 * g + j) * ost] = (bf16)f2bf(o[j]);
            }
        }
#pragma unroll
        for (int blk = 0; blk < 8; ++blk) {
            const f32x4 d4 = *(const LAS f32x4*)(bb + SB_D + (16 * blk + 4 * g) * 4);
            f32x4 s = S[blk] * d4;
#pragma unroll
            for (int sp = 0; sp < 2; ++sp) {
                const LAS unsigned char* kp = bb + SB_KD + (16 * blk + li) * HPK + (32 * sp + 4 * g) * 2;
                s = __builtin_amdgcn_mfma_f32_16x16x32_bf16(cat8u(*(const LAS u32x2*)kp, *(const LAS u32x2*)(kp + 32)), vf[sp], s, 0, 0, 0);
            }
            S[blk] = s;
        }
        if (c + 1 < NCH) HS_STORE(c + 1, (uu + 1) & 1);
        if (c + 3 < NCH) HS_LOAD(c + 3, (uu + 1) & 1);
        ATT_BAR();
    } }
#undef HS_LOAD
#undef HS_STORE
    __syncthreads();
}

__device__ __forceinline__ void phase_readout(const Params& p, int vb, int nb) {
    const int tid = tid_of(p.wave_id), lane = tid & 63, wave = p.wave_id;
    const bf16* OF = (const bf16*)p.out; const bf16* OB = OF + (size_t)ML * WA; const bf16* GA = (const bf16*)(p.ws + WS_GA);
    bf16* YA = (bf16*)p.out + (size_t)2 * ML * WA;
    f32x4 ng[4];
#pragma unroll
    for (int i = 0; i < 4; ++i) ng[i] = *(const f32x4*)(p.hgrn_norm_g + 16 * (lane & 7) + 4 * i);
    const int NGW = nb * 8;
    for (int row0 = vb * 8 + wave; row0 < ML; row0 += 2 * NGW) {
        u32x4 a[2][2], b[2][2], gg[2][2];
#pragma unroll
        for (int u = 0; u < 2; ++u) { const int row = row0 + u * NGW; if (row < ML) { const size_t off = (size_t)row * WA + 16 * lane;
            a[u][0] = *(const u32x4*)(OF + off); a[u][1] = *(const u32x4*)(OF + off + 8); b[u][0] = *(const u32x4*)(OB + off); b[u][1] = *(const u32x4*)(OB + off + 8);
            gg[u][0] = *(const u32x4*)(GA + off); gg[u][1] = *(const u32x4*)(GA + off + 8); } }
#pragma unroll
        for (int u = 0; u < 2; ++u) { const int row = row0 + u * NGW; if (row < ML) { const size_t off = (size_t)row * WA + 16 * lane;
            float o[16]; float ss = 0.f;
#pragma unroll
            for (int q = 0; q < 8; ++q) { const unsigned wa = a[u][q >> 2][q & 3], wb = b[u][q >> 2][q & 3]; o[2 * q] = bflo(wa) + bflo(wb); o[2 * q + 1] = bfhi(wa) + bfhi(wb); ss += o[2 * q] * o[2 * q] + o[2 * q + 1] * o[2 * q + 1]; }
            ss += __shfl_xor(ss, 1); ss += __shfl_xor(ss, 2); ss += __shfl_xor(ss, 4);
            const float rstd = __builtin_amdgcn_rsqf(ss * (1.0f / HD) + EPS);
            u32x4 w[2];
#pragma unroll
            for (int q = 0; q < 8; ++q) { const unsigned wg = gg[u][q >> 2][q & 3];
                w[q >> 2][q & 3] = pk2(o[2 * q] * rstd * ng[q >> 1][(2 * q) & 3] * bflo(wg), o[2 * q + 1] * rstd * ng[q >> 1][(2 * q + 1) & 3] * bfhi(wg)); }
            *(u32x4*)(YA + off) = w[0]; *(u32x4*)(YA + off + 8) = w[1]; } }
    }
}

__device__ __forceinline__ void phase_bias2(const Params& p, int vb, int nb) {
    const int tid = tid_of(p.wave_id); const float* mod = (const float*)(p.ws + WS_MOD); float* bias2 = (float*)(p.ws + WS_BIAS2);
    constexpr int NCC = 2 * FFN / 512, NKC = D_MODEL / 64;
    for (int item = vb; item < NCC * NKC; item += nb) {
        const int cc = item % NCC, kc = item / NCC; const int col = cc * 512 + tid;
        const float* W = (col < FFN) ? p.w1 + col : p.w3 + (col - FFN);
        float a0 = 0.f, a1 = 0.f, a2 = 0.f, a3 = 0.f;
#pragma unroll 8
        for (int k = kc * 64; k < kc * 64 + 64; ++k) { const float w = W[(size_t)k * FFN];
            a0 += w * mod[0 * IN_COLS + 3 * D_MODEL + k]; a1 += w * mod[1 * IN_COLS + 3 * D_MODEL + k]; a2 += w * mod[2 * IN_COLS + 3 * D_MODEL + k]; a3 += w * mod[3 * IN_COLS + 3 * D_MODEL + k]; }
        atomicAdd(bias2 + 0 * 2 * FFN + col, a0); atomicAdd(bias2 + 1 * 2 * FFN + col, a1); atomicAdd(bias2 + 2 * 2 * FFN + col, a2); atomicAdd(bias2 + 3 * 2 * FFN + col, a3);
    }
}

constexpr int LDS_MISC_OFF = 145408;
constexpr int LDS_BYTES = 146432;
static_assert(WS_BAR + XCD_BAR_WORDS * 4 <= WS_ROWSQ, "barrier words inside ctl");

#if defined(__HIP_DEVICE_COMPILE__)
#define LOAD_P() Params p; { const __attribute__((address_space(4))) Params* q_ = (const __attribute__((address_space(4))) Params*)__builtin_amdgcn_kernarg_segment_ptr(); asm volatile("" : "+s"(q_)); \
    p = *q_; p.wave_id = wave_id; } unsigned char* ws = p.ws; (void)ws
#else
#define LOAD_P() Params p = p_in; p.wave_id = wave_id; unsigned char* ws = p.ws; (void)ws
#endif
__global__ void __launch_bounds__(NTHREADS, 2) mega_fwd(Params p_in) {
    const int wave_id = __builtin_amdgcn_readfirstlane((int)(threadIdx.x >> 6));
    extern __shared__ __attribute__((aligned(16))) unsigned char lds_raw[];
    LAS unsigned char* lds = (LAS unsigned char*)lds_raw;
    const int nb = gridDim.x;
    const int vb = (nb % 8 == 0) ? ((int)(blockIdx.x % 8) * (nb / 8) + (int)(blockIdx.x / 8)) : (int)blockIdx.x;
    const int bx = blockIdx.x;
    volatile LAS unsigned* misc = (volatile LAS unsigned*)(lds + LDS_MISC_OFF);
    if (wave_id == 0) misc[lane_id()] = 0u;
    __syncthreads();
    XcdBarrier bar = xcd_barrier_post((unsigned*)(p_in.ws + WS_BAR), misc + 8, wave_id);
#define GRID_BAR() xcd_barrier(bar)

    { LOAD_P(); phase_mod(p, lds, vb, nb); __syncthreads(); phase_wconv_in(p, lds, vb * 8 + wave_id, nb * 8); }
    GRID_BAR();
    { LOAD_P(); phase_h(p, vb, nb); }
    GRID_BAR();
    { LOAD_P(); pg8::Gemm g{(const bf16*)(ws + WS_H), (const bf16*)(ws + WS_WINT), MT, IN_COLS, D_MODEL}; InProjOrder S; S.init(ML, IN_COLS, nb, bx);
      EpiInProj E{ws, lds, p.q_norm_g, p.k_norm_g}; pg8::gemm_phase<EpiInProj, InProjOrder, true, true>(lds, g, S, E, wave_id);
      const int nfree = nb - CTX_UNITS;
      if (nfree >= 64) { if (bx >= CTX_UNITS) phase_wconv_rest(p, lds, (bx - CTX_UNITS) * 8 + wave_id, nfree * 8); }
      else phase_wconv_rest(p, lds, bx * 8 + wave_id, nb * 8); }
    GRID_BAR();
    { LOAD_P(); hgrn_prep(p, lds, vb, nb); }
    GRID_BAR();
    { LOAD_P();
      if (bx < 2 * BATCH * NHEAD) hgrn_scan(p, lds, bx);
      __syncthreads();
      phase_attn(p, lds); }
    GRID_BAR();
    { LOAD_P(); phase_readout(p, vb, nb); }
    GRID_BAR();
    { LOAD_P(); pg8::Gemm g{(const bf16*)p.out + (size_t)2 * ML * WA, (const bf16*)(ws + WS_WAT), ML, D_MODEL, WA};
      MergeOrder S; S.init(ML, D_MODEL, nb, bx); S.A1 = (const bf16*)p.out + (size_t)3 * ML * WA; S.B1 = (const bf16*)(ws + WS_WBT);
      EpiMerge E{ws, (float*)(ws + WS_T1)}; pg8::gemm_phase<EpiMerge, MergeOrder, true, true>(lds, g, S, E, wave_id); }
    GRID_BAR();
    { LOAD_P(); pg8::Gemm g{(const bf16*)(ws + WS_Z), (const bf16*)(ws + WS_WOT), ML, D_MODEL, D_MODEL}; pg8::StaticOrder S; S.init(ML, D_MODEL, nb, bx);
      EpiOutProj E{ws, p.x, p.norm2_g, p.out}; pg8::gemm_phase<EpiOutProj, pg8::StaticOrder, true, true>(lds, g, S, E, wave_id); }
    GRID_BAR();
    { LOAD_P(); pg8::Gemm g{(const bf16*)(ws + WS_XMG), (const bf16*)(ws + WS_W13T), ML, 2 * FFN, D_MODEL}; pg8::StaticOrder S; S.init(ML, 2 * FFN, nb, bx);
      EpiFfnUp E{ws, lds, p.conv_w, p.conv_b}; pg8::gemm_phase<EpiFfnUp, pg8::StaticOrder, true, true>(lds, g, S, E, wave_id); }
    GRID_BAR();
    { LOAD_P(); { pg8::StaticOrder S0; S0.init(ML, D_MODEL, nb, bx); pg8::Unit u0; const int tid = tid_of(wave_id); for (int i = 0; S0.next(i, u0); ++i) halo_fix(p, u0.pm, tid); }
      asm volatile("s_waitcnt vmcnt(0)" ::: "memory"); __syncthreads();
      pg8::Gemm g{(const bf16*)(ws + WS_ACT), (const bf16*)(ws + WS_W2T), ML, D_MODEL, FFN}; pg8::StaticOrder S; S.init(ML, D_MODEL, nb, bx);
      EpiFfnDown E{ws, p.out}; pg8::gemm_phase<EpiFfnDown, pg8::StaticOrder, true, true>(lds, g, S, E, wave_id); }
#undef GRID_BAR
}

extern "C" void kernel_launch(void* const* d_in, const int* in_sizes, int n_in, void* d_out, int out_size, void* d_ws, size_t ws_size, hipStream_t stream) {
    static int grid = 0;
    if (grid == 0) {
        if (n_in != 22 || ws_size < WS_END || out_size != ML * D_MODEL) { fprintf(stderr, "kernel_launch: bad inputs (n_in %d, out %d, ws %zu, need %zu)\n", n_in, out_size, ws_size, (size_t)WS_END); grid = -1; return; }
        int dev = 0, cus = 0, per_cu = 0;
        if (hipGetDevice(&dev) != hipSuccess || hipDeviceGetAttribute(&cus, hipDeviceAttributeMultiprocessorCount, dev) != hipSuccess) { grid = -1; return; }
        if (hipFuncSetAttribute((const void*)mega_fwd, hipFuncAttributeMaxDynamicSharedMemorySize, LDS_BYTES) != hipSuccess) { fprintf(stderr, "kernel_launch: hipFuncSetAttribute failed\n"); grid = -1; return; }
        if (hipOccupancyMaxActiveBlocksPerMultiprocessor(&per_cu, (const void*)mega_fwd, NTHREADS, LDS_BYTES) != hipSuccess || per_cu < 1) { fprintf(stderr, "kernel_launch: occupancy query says %d blocks/CU\n", per_cu); (void)hipGetLastError(); grid = -1; return; }
        grid = cus;
        fprintf(stderr, "kernel_launch: grid %d (cus %d, occupancy %d/CU)\n", grid, cus, per_cu);
    }
    if (grid < 0) return;
    Params p{};
    const float** f = (const float**)&p;
    for (int i = 0; i < 22; ++i) f[i] = (const float*)d_in[i];
    p.out = (float*)d_out; p.ws = (unsigned char*)d_ws;
    (void)hipMemsetAsync((char*)d_ws + WS_CTL, 0, CTL_ZERO_BYTES, stream);
    hipLaunchKernelGGL(mega_fwd, dim3(grid), dim3(NTHREADS), LDS_BYTES, stream, p);
}
```

```cpp
#include <hip/hip_runtime.h>
#include <cstdio>
#include <cstdint>
#include <cmath>

__device__ __forceinline__ int lane_id() { int l; asm volatile("v_mbcnt_lo_u32_b32 %0, -1, 0\n\tv_mbcnt_hi_u32_b32 %0, -1, %0" : "=v"(l)); return l; }
__device__ __forceinline__ int tid_of(int wave_id) { int t = wave_id * 64 + lane_id(); asm volatile("" : "+v"(t)); return t; }
namespace pg8 {
#define PG8_LAS __attribute__((address_space(3)))
typedef unsigned short bf16_t;
typedef short bf16x8 __attribute__((ext_vector_type(8)));
typedef float f32x4 __attribute__((ext_vector_type(4)));
typedef unsigned u32x4 __attribute__((ext_vector_type(4)));
constexpr int BM = 256, BK = 64, HALF = 128, HTB = HALF * BK * 2  , STAGE_BYTES = 8 * HTB, NXCD = 8, WGM = 8;

__host__ __device__ __forceinline__ int lds_byte(int r, int c) { const int st = (r >> 4) * 2 + (c >> 5), rr = r & 15, cc = c & 31, ob = rr * 64 + cc * 2; return st * 1024 + (ob ^ (((ob >> 9) & 1) << 5)); }
__host__ __device__ __forceinline__ void stage_rc(int b, int& R, int& C) { const int st = b / 1024, sb = b % 1024, swz = sb ^ (((sb >> 9) & 1) << 5); R = (st >> 1) * 16 + swz / 64; C = (st & 1) * 32 + (swz % 64) / 2; }
__host__ __device__ __forceinline__ int perm32(int rho) { const int n = rho >> 4, i = rho & 15; return 8 * (i >> 2) + 4 * n + (i & 3); }

struct Unit { int pm, pn, br; };
struct Gemm { const bf16_t* A; const bf16_t* Bt; int M, N, K; };

struct StaticOrder {
    int nM, nN, nwg, G, c;
    __host__ __device__ void init(int M, int N, int G_, int c_) { nM = M / BM; nN = N / BM; nwg = nM * nN; G = G_; c = c_; }
    __host__ __device__ bool next(int i, Unit& u) const {
        const long L = (long)i * G + c; if (L >= nwg) return false;
        int wgid = (int)L; { const int q = nwg / NXCD, r = nwg % NXCD, xcd = wgid % NXCD, off = wgid / NXCD; wgid = (xcd < r ? xcd * (q + 1) : r * (q + 1) + (xcd - r) * q) + off; }
        const int nig = WGM * nN, gid = wgid / nig, fm = gid * WGM, gsz = (nM - fm) < WGM ? (nM - fm) : WGM;
        u.pm = fm + ((wgid % nig) % gsz); u.pn = (wgid % nig) / gsz; u.br = 0; return true;
    }
    __device__ __forceinline__ const char* a_base(const Gemm& g, const Unit& u, size_t tstep) const { return (const char*)g.A + (size_t)u.pm * tstep; }
    __device__ __forceinline__ const char* b_base(const Gemm& g, const Unit& u, size_t tstep) const { return (const char*)g.Bt + (size_t)u.pn * tstep; }
    __device__ __forceinline__ void a_ready(const Unit&) const {}
    __device__ __forceinline__ void done(const Unit&) const {}
};

template <class Epi, class Sched, bool ALIGN_EPI = false, bool SP2 = false>
__device__ __forceinline__ void gemm_phase(PG8_LAS unsigned char* lds, const Gemm g, const Sched& S, const Epi& E, const int wave_id_in) {
    int tid_o = tid_of(wave_id_in);
    const int tid = tid_o, wid = __builtin_amdgcn_readfirstlane(tid >> 6), lane = tid & 63, wr = wid >> 2, wc = wid & 3, fr = lane & 15, fq = lane >> 4;
    const int K = g.K, nt = K / BK;
    unsigned voffA[2], voffB[2];
#pragma unroll
    for (int i = 0; i < 2; ++i) { int R, C; stage_rc(tid * 16 + i * 8192, R, C); const int Rb = Epi::PERM ? ((R & ~31) + perm32(R & 31)) : R;
        voffA[i] = (unsigned)(R * K + C) * 2u; voffB[i] = (unsigned)(Rb * K + C) * 2u; }
    const size_t kstep = (size_t)(BK * 2);
    const size_t hstep = (size_t)HALF * K * 2;
    const size_t tstep = 2 * hstep;
    const unsigned ldsw = (unsigned)wid * 1024u;
    const int aoff = lds_byte(wr * 64 + fr, fq * 8), boff = lds_byte(wc * 32 + fr, fq * 8);
#define PG8_SA(b, h) (((b) * 2 + (h)) * HTB)
#define PG8_SB(b, h) ((4 + (b) * 2 + (h)) * HTB)
#define PG8_STAGE(bufoff, gbase, voff) do { _Pragma("unroll") for (int _i = 0; _i < 2; ++_i) \
        __builtin_amdgcn_global_load_lds((const unsigned*)((const char*)(gbase) + (voff)[_i]), (PG8_LAS unsigned*)(lds + (bufoff) + ldsw + _i * 8192), 16, 0, 0); } while (0)
#define PG8_LDA(dst, b, h) do { _Pragma("unroll") for (int m = 0; m < 4; ++m) _Pragma("unroll") for (int k = 0; k < 2; ++k) dst[m][k] = *(const PG8_LAS bf16x8*)(lds + PG8_SA(b, h) + aoff + m * 2048 + k * 1024); } while (0)
#define PG8_LDB(dst, b, h) do { _Pragma("unroll") for (int n = 0; n < 2; ++n) _Pragma("unroll") for (int k = 0; k < 2; ++k) dst[n][k] = *(const PG8_LAS bf16x8*)(lds + PG8_SB(b, h) + boff + n * 2048 + k * 1024); } while (0)
#define PG8_MMA(ai, bj, At, Bt) do { __builtin_amdgcn_s_setprio(1); _Pragma("unroll") for (int m = 0; m < 4; ++m) _Pragma("unroll") for (int n = 0; n < 2; ++n) _Pragma("unroll") for (int k = 0; k < 2; ++k) \
        acc[ai][bj][m][n] = __builtin_amdgcn_mfma_f32_16x16x32_bf16(Bt[n][k], At[m][k], acc[ai][bj][m][n], 0, 0, 0); __builtin_amdgcn_s_setprio(0); } while (0)
#define PG8_WAIT_V(n) asm volatile("s_waitcnt vmcnt(" #n ")" ::: "memory")
#define PG8_WAIT_L(n) asm volatile("s_waitcnt lgkmcnt(" #n ")" ::: "memory")
#define PG8_BAR __builtin_amdgcn_s_barrier()
#define PG8_SCHED __builtin_amdgcn_sched_barrier(0)
    Unit cur, nxt; int ui = 0;
    if (!S.next(0, cur)) return;
    f32x4 acc[2][2][4][2];
#pragma unroll
    for (int a = 0; a < 2; ++a)
#pragma unroll
        for (int b = 0; b < 2; ++b)
#pragma unroll
            for (int m = 0; m < 4; ++m)
#pragma unroll
                for (int n = 0; n < 2; ++n) acc[a][b][m][n] = (f32x4){0.f, 0.f, 0.f, 0.f};
    bf16x8 At[4][2], B0[2][2], B1[2][2];
    const char* cA = S.a_base(g, cur, tstep); const char* cB = S.b_base(g, cur, tstep);
    S.a_ready(cur);
    if constexpr (SP2) {
        PG8_STAGE(PG8_SB(0, 0), cB, voffB); PG8_STAGE(PG8_SB(0, 1), cB + hstep, voffB); PG8_STAGE(PG8_SA(0, 0), cA, voffA); PG8_STAGE(PG8_SA(0, 1), cA + hstep, voffA);
        if (wr == 1) PG8_BAR;
        PG8_WAIT_V(2); PG8_BAR;
        PG8_STAGE(PG8_SB(1, 0), cB + kstep, voffB); PG8_STAGE(PG8_SA(1, 0), cA + kstep, voffA); PG8_STAGE(PG8_SB(1, 1), cB + hstep + kstep, voffB);
        PG8_WAIT_V(6); PG8_BAR;
    } else {
        PG8_STAGE(PG8_SB(0, 0), cB, voffB); PG8_STAGE(PG8_SA(0, 0), cA, voffA); PG8_STAGE(PG8_SB(0, 1), cB + hstep, voffB); PG8_STAGE(PG8_SA(0, 1), cA + hstep, voffA);
        if (wr == 1) PG8_BAR;
        PG8_WAIT_V(4); PG8_BAR;
        PG8_STAGE(PG8_SB(1, 0), cB + kstep, voffB); PG8_STAGE(PG8_SA(1, 0), cA + kstep, voffA); PG8_STAGE(PG8_SB(1, 1), cB + hstep + kstep, voffB);
        PG8_WAIT_V(6); PG8_BAR;
    }
    for (;;) {
        const bool has_next = S.next(ui + 1, nxt);
        const char* nA = has_next ? S.a_base(g, nxt, tstep) : cA; const char* nB = has_next ? S.b_base(g, nxt, tstep) : cB;
        for (int t = 0; t < nt; t += 2) {
            const bool last = (t == nt - 2);
            const char* a1 = cA + (size_t)(t + 1) * kstep;
            const char* a2 = last ? nA : cA + (size_t)(t + 2) * kstep; const char* b2 = last ? nB : cB + (size_t)(t + 2) * kstep;
            const char* a3 = a2 + kstep; const char* b3 = b2 + kstep;
            if (last && has_next) S.a_ready(nxt);
            if constexpr (SP2) {
            PG8_LDB(B0, 0, 0); PG8_LDB(B1, 0, 1); PG8_SCHED; PG8_LDA(At, 0, 0); PG8_STAGE(PG8_SA(1, 1), a1 + hstep, voffA);
            PG8_WAIT_V(8); PG8_WAIT_L(0); PG8_BAR; PG8_MMA(0, 0, At, B0); PG8_MMA(0, 1, At, B1); PG8_BAR; PG8_SCHED;
            PG8_LDA(At, 0, 1); PG8_STAGE(PG8_SB(0, 0), b2, voffB); PG8_STAGE(PG8_SB(0, 1), b2 + hstep, voffB); PG8_STAGE(PG8_SA(0, 0), a2, voffA);
            PG8_WAIT_V(8); PG8_WAIT_L(0); PG8_BAR; PG8_MMA(1, 0, At, B0); PG8_MMA(1, 1, At, B1); PG8_BAR; PG8_SCHED;
            PG8_LDB(B0, 1, 0); PG8_LDB(B1, 1, 1); PG8_SCHED; PG8_LDA(At, 1, 0); PG8_STAGE(PG8_SA(0, 1), a2 + hstep, voffA);
            PG8_WAIT_V(8); PG8_WAIT_L(0); PG8_BAR; PG8_MMA(0, 0, At, B0); PG8_MMA(0, 1, At, B1); PG8_BAR; PG8_SCHED;
            PG8_LDA(At, 1, 1); PG8_STAGE(PG8_SB(1, 0), b3, voffB); PG8_STAGE(PG8_SB(1, 1), b3 + hstep, voffB); PG8_STAGE(PG8_SA(1, 0), a3, voffA);
            PG8_WAIT_V(8); PG8_WAIT_L(0); PG8_BAR; PG8_MMA(1, 0, At, B0); PG8_MMA(1, 1, At, B1); PG8_BAR; PG8_SCHED;
            } else {
            PG8_LDB(B0, 0, 0); PG8_SCHED; PG8_LDA(At, 0, 0); PG8_STAGE(PG8_SA(1, 1), a1 + hstep, voffA);
            PG8_WAIT_L(8); PG8_BAR; PG8_WAIT_L(0); PG8_MMA(0, 0, At, B0); PG8_BAR; PG8_SCHED;
            PG8_LDB(B1, 0, 1); PG8_STAGE(PG8_SB(0, 0), b2, voffB);
            PG8_BAR; PG8_WAIT_L(0); PG8_MMA(0, 1, At, B1); PG8_BAR;
            PG8_LDA(At, 0, 1); PG8_STAGE(PG8_SA(0, 0), a2, voffA);
            PG8_BAR; PG8_WAIT_L(0); PG8_MMA(1, 0, At, B0); PG8_BAR; PG8_SCHED;
            PG8_STAGE(PG8_SB(0, 1), b2 + hstep, voffB);
            PG8_WAIT_V(6); PG8_BAR; PG8_MMA(1, 1, At, B1); PG8_BAR;
            PG8_LDB(B0, 1, 0); PG8_SCHED; PG8_LDA(At, 1, 0); PG8_STAGE(PG8_SA(0, 1), a2 + hstep, voffA);
            PG8_WAIT_L(8); PG8_BAR; PG8_WAIT_L(0); PG8_MMA(0, 0, At, B0); PG8_BAR; PG8_SCHED;
            PG8_LDB(B1, 1, 1); PG8_STAGE(PG8_SB(1, 0), b3, voffB);
            PG8_BAR; PG8_WAIT_L(0); PG8_MMA(0, 1, At, B1); PG8_BAR;
            PG8_LDA(At, 1, 1); PG8_STAGE(PG8_SA(1, 0), a3, voffA);
            PG8_BAR; PG8_WAIT_L(0); PG8_MMA(1, 0, At, B0); PG8_BAR; PG8_SCHED;
            PG8_STAGE(PG8_SB(1, 1), b3 + hstep, voffB);
            PG8_WAIT_V(6); PG8_BAR; PG8_MMA(1, 1, At, B1); PG8_BAR;
            }
        }
        if constexpr (ALIGN_EPI) { if (wr == 0) PG8_BAR; }
        if constexpr (!Epi::AFTER_DRAIN) { E(acc, cur, wr, wc, fr, fq); S.done(cur); }
        if (!has_next) break;
#pragma unroll
        for (int a = 0; a < 2; ++a)
#pragma unroll
            for (int b = 0; b < 2; ++b)
#pragma unroll
                for (int m = 0; m < 4; ++m)
#pragma unroll
                    for (int n = 0; n < 2; ++n) acc[a][b][m][n] = (f32x4){0.f, 0.f, 0.f, 0.f};
        cur = nxt; cA = nA; cB = nB; ++ui;
        if constexpr (ALIGN_EPI) { if (wr == 1) PG8_BAR; }
    }
    PG8_WAIT_V(0);
    if constexpr (!ALIGN_EPI) { if (wr == 0) PG8_BAR; }
    PG8_BAR;
    if constexpr (Epi::AFTER_DRAIN) { E.fused(acc, cur, wr, wc, fr, fq, lds, wid, lane); S.done(cur); }
#undef PG8_SA
#undef PG8_SB
#undef PG8_STAGE
#undef PG8_LDA
#undef PG8_LDB
#undef PG8_MMA
#undef PG8_WAIT_V
#undef PG8_WAIT_L
#undef PG8_BAR
#undef PG8_SCHED
}
}

constexpr int D_MODEL = 2048, BATCH = 4, SEQ = 2048, CTX = 256, GRID_W = 64, NHEAD = 8, HD = 128, WA = 1024;
constexpr int FFN = 5632, IN_COLS = 12288, NMOD = 6;
constexpr int ML = BATCH * SEQ;
constexpr int MC = BATCH * CTX;
constexpr int MT = ML + MC;
constexpr float EPS = 1e-6f;
constexpr int NTHREADS = 512;
constexpr int VT_PITCH = SEQ + CTX;

typedef unsigned short bf16;
typedef float f32x4 __attribute__((ext_vector_type(4)));
typedef unsigned u32x2 __attribute__((ext_vector_type(2)));
typedef unsigned u32x4 __attribute__((ext_vector_type(4)));
#define LAS __attribute__((address_space(3)))

typedef float f32x2_t __attribute__((ext_vector_type(2)));
typedef __bf16 bf16x2_t __attribute__((ext_vector_type(2)));
__device__ __forceinline__ unsigned pk2(float lo, float hi) { const f32x2_t v = {lo, hi}; const bf16x2_t b = __builtin_convertvector(v, bf16x2_t); return __builtin_bit_cast(unsigned, b); }
__device__ __forceinline__ unsigned f2bf(float f) { return pk2(f, 0.f) & 0xffffu; }
__device__ __forceinline__ float bf2f(unsigned short h) { return __builtin_bit_cast(float, (unsigned)h << 16); }
__device__ __forceinline__ float bflo(unsigned w) { return __builtin_bit_cast(float, w << 16); }
__device__ __forceinline__ float bfhi(unsigned w) { return __builtin_bit_cast(float, w & 0xffff0000u); }
__device__ __forceinline__ float sigmoidf_(float x) { return __builtin_amdgcn_rcpf(1.0f + __expf(-x)); }
__device__ __forceinline__ float siluf_(float x) { return x * __builtin_amdgcn_rcpf(1.0f + __expf(-x)); }
__device__ __forceinline__ float wave_sum(float v) {
#pragma unroll
    for (int o = 1; o < 64; o <<= 1) v += __shfl_xor(v, o);
    return v;
}
__device__ __forceinline__ float wave_max(float v) {
#pragma unroll
    for (int o = 1; o < 64; o <<= 1) v = fmaxf(v, __shfl_xor(v, o));
    return v;
}

constexpr size_t al256(size_t x) { return (x + 255) & ~(size_t)255; }
constexpr size_t WS_CTL   = 0;
constexpr size_t CTL_ZERO_BYTES = 1u << 20;
constexpr size_t WS_ROWSQ = 64 * 1024;
constexpr size_t WS_BIAS2 = WS_ROWSQ + (size_t)ML * 4;
static_assert(WS_BIAS2 + (size_t)4 * 2 * FFN * 4 <= CTL_ZERO_BYTES, "ctl");
constexpr size_t WS_MOD   = CTL_ZERO_BYTES;
constexpr size_t WS_LB    = al256(WS_MOD + (size_t)5 * IN_COLS * 4);
constexpr size_t WS_ROPE  = al256(WS_LB + 2 * WA * 4);
constexpr size_t WS_SMALL_END = al256(WS_ROPE + 2 * 64 * 32 * 4);
constexpr size_t WS_W13T  = al256(WS_SMALL_END);
constexpr size_t WS_W2T   = WS_W13T + (size_t)2 * FFN * D_MODEL * 2;
constexpr size_t WS_WAT   = WS_W2T + (size_t)D_MODEL * FFN * 2;
constexpr size_t WS_WBT   = WS_WAT + (size_t)D_MODEL * WA * 2;
constexpr size_t WS_WOT   = WS_WBT + (size_t)D_MODEL * WA * 2;
constexpr size_t WS_A_END = WS_WOT + (size_t)D_MODEL * D_MODEL * 2;
constexpr size_t SEGB = (size_t)MT * WA * 2;
constexpr size_t WS_QA  = WS_A_END;
constexpr size_t WS_FW  = WS_QA + SEGB;
constexpr size_t WS_FB  = WS_FW + 2 * SEGB;
constexpr size_t WS_IA  = WS_FB + 2 * SEGB;
constexpr size_t WS_GA  = WS_IA + SEGB;
constexpr size_t WS_QN  = WS_GA + (size_t)ML * WA * 2;
constexpr size_t WS_KN  = WS_QN + (size_t)ML * WA * 2;
constexpr size_t WS_VN  = WS_KN + SEGB;
constexpr size_t WS_GTA = WS_VN + SEGB;
constexpr size_t WS_GTB = WS_GTA + (size_t)ML * D_MODEL * 2;
constexpr size_t WS_D_END = WS_GTB + (size_t)ML * D_MODEL * 2;
constexpr size_t WS_WINT = WS_D_END;
constexpr size_t WS_OF   = WS_WINT;
constexpr size_t WS_OB   = WS_OF + (size_t)ML * WA * 2;
constexpr size_t WS_B_END = WS_WINT + (size_t)IN_COLS * D_MODEL * 2;
static_assert(WS_OB + (size_t)ML * WA * 2 <= WS_B_END, "B");
constexpr size_t WS_H   = WS_B_END;
constexpr size_t WS_YA  = WS_H;
constexpr size_t WS_YB  = WS_YA + (size_t)ML * WA * 2;
constexpr size_t WS_C_END = WS_H + (size_t)MT * D_MODEL * 2;
constexpr size_t WS_ACT_END = WS_D_END + (size_t)ML * FFN * 2;
constexpr size_t WS_HIMG = WS_WINT;
constexpr size_t WS_HIMG_END = WS_HIMG + (size_t)64 * 36 * 41472;
constexpr size_t WS_T1 = WS_WINT;
constexpr size_t WS_END0 = WS_C_END > WS_ACT_END ? WS_C_END : WS_ACT_END;
constexpr size_t WS_END = WS_END0 > WS_HIMG_END ? WS_END0 : WS_HIMG_END;
static_assert(WS_END <= 445000000, "ws budget");
constexpr size_t WS_Z   = WS_QA;
constexpr size_t WS_XMG = WS_GTB;
constexpr size_t WS_HALO = WS_QA;
static_assert(WS_HALO + (size_t)32 * 6 * FFN * 4 <= WS_XMG, "HALO overlay");
constexpr size_t WS_ACT = WS_WINT;
static_assert(WS_ACT + (size_t)ML * FFN * 2 <= WS_END, "ACT overlay");

struct Params {
    const float *x, *c, *ctx, *c_ctx, *ada_w, *ada_b, *norm1_g, *norm2_g, *w_in, *lb_logits, *hgrn_norm_g, *q_norm_g, *k_norm_g, *rel_bias,
                *w_a, *w_b, *w_o, *w1, *w3, *conv_w, *conv_b, *w2;
    float* out;
    unsigned char* ws;
    int wave_id, pad;
};

template <bool QKPERM, bool BIAS>
__device__ __forceinline__ void transpose_item(const float* W, int K, int N, bf16* WT, int row_off, LAS float* scr, int item, int lane, const float* sh2 = nullptr, float* bias2 = nullptr) {
    const int nblk = N / 32, kb = item / nblk, nb = item % nblk, k0 = 64 * kb, n0 = 32 * nb;
    if (BIAS) row_off += (n0 >> 7) * 128;
    float wv[32];
#pragma unroll
    for (int i = 0; i < 32; ++i) wv[i] = __builtin_nontemporal_load(W + (size_t)(k0 + 2 * i + (lane >> 5)) * N + n0 + (lane & 31));
#pragma unroll
    for (int i = 0; i < 32; ++i) scr[(2 * i + (lane >> 5)) * 33 + (lane & 31)] = wv[i];
    if (BIAS) {
        float a0 = 0.f, a1 = 0.f, a2 = 0.f, a3 = 0.f;
#pragma unroll
        for (int i = 0; i < 32; ++i) { const int k = k0 + 2 * i + (lane >> 5); const float w = wv[i];
            a0 += w * sh2[0 * IN_COLS + k]; a1 += w * sh2[1 * IN_COLS + k]; a2 += w * sh2[2 * IN_COLS + k]; a3 += w * sh2[3 * IN_COLS + k]; }
        a0 += __shfl_xor(a0, 32); a1 += __shfl_xor(a1, 32); a2 += __shfl_xor(a2, 32); a3 += __shfl_xor(a3, 32);
        if (lane < 32) { float* bp = bias2 + row_off + n0 + lane; atomicAdd(bp, a0); atomicAdd(bp + 2 * FFN, a1); atomicAdd(bp + 4 * FFN, a2); atomicAdd(bp + 6 * FFN, a3); }
    }
    asm volatile("s_waitcnt lgkmcnt(0)" ::: "memory");
    const int c = lane & 7;
#pragma unroll
    for (int j = 0; j < 4; ++j) { const int n = (lane >> 3) + 8 * j; const LAS float* s = scr + (8 * c) * 33 + n;
        u32x4 o; o.x = pk2(s[0 * 33], s[1 * 33]); o.y = pk2(s[2 * 33], s[3 * 33]); o.z = pk2(s[4 * 33], s[5 * 33]); o.w = pk2(s[6 * 33], s[7 * 33]);
        int cdst = n0 + n;
        if (QKPERM && cdst >= 5 * WA && cdst < 7 * WA) cdst = (cdst & ~0x30) | ((cdst & 0x10) << 1) | ((cdst & 0x20) >> 1);
        if (BIAS || !QKPERM) __builtin_nontemporal_store(o, (u32x4*)(WT + (size_t)(row_off + cdst) * K + k0 + 8 * c)); else *(u32x4*)(WT + (size_t)(row_off + cdst) * K + k0 + 8 * c) = o; }
    asm volatile("s_waitcnt lgkmcnt(0)" ::: "memory");
}
__device__ __forceinline__ void phase_wconv_in(const Params& p, LAS unsigned char* lds, int gw, int NGW) {
    const int lane = lane_id(), wave = p.wave_id;
    LAS float* scr = (LAS float*)(lds + wave * 16384);
    constexpr int I_IN = (D_MODEL / 64) * (IN_COLS / 32);
    for (int it = gw; it < I_IN; it += NGW) transpose_item<true, false>(p.w_in, D_MODEL, IN_COLS, (bf16*)(p.ws + WS_WINT), 0, scr, it, lane);
}
__device__ __forceinline__ void phase_wconv_rest(const Params& p, LAS unsigned char* lds, int gw, int NGW) {
    const int lane = lane_id(), wave = p.wave_id;
    LAS float* scr = (LAS float*)(lds + 16384 + wave * 16384);
    constexpr int I_A = (WA / 64) * (D_MODEL / 32), I_O = (D_MODEL / 64) * (D_MODEL / 32), I_1 = (D_MODEL / 64) * (FFN / 32), I_2 = (FFN / 64) * (D_MODEL / 32);
    constexpr int NITEMS = 2 * I_A + I_O + 2 * I_1 + I_2;
    unsigned char* ws = p.ws;
    const float* sh2 = (const float*)(ws + WS_MOD) + 3 * D_MODEL; float* b2 = (float*)(ws + WS_BIAS2);
    for (int it = gw; it < NITEMS; it += NGW) {
        int r = it;
        if (r < I_A) { transpose_item<false, false>(p.w_a, WA, D_MODEL, (bf16*)(ws + WS_WAT), 0, scr, r, lane); continue; } r -= I_A;
        if (r < I_A) { transpose_item<false, false>(p.w_b, WA, D_MODEL, (bf16*)(ws + WS_WBT), 0, scr, r, lane); continue; } r -= I_A;
        if (r < I_O) { transpose_item<false, false>(p.w_o, D_MODEL, D_MODEL, (bf16*)(ws + WS_WOT), 0, scr, r, lane); continue; } r -= I_O;
        if (r < I_1) { transpose_item<false, true>(p.w1, D_MODEL, FFN, (bf16*)(ws + WS_W13T), 0, scr, r, lane, sh2, b2); continue; } r -= I_1;
        if (r < I_1) { transpose_item<false, true>(p.w3, D_MODEL, FFN, (bf16*)(ws + WS_W13T), 128, scr, r, lane, sh2, b2); continue; } r -= I_1;
        transpose_item<false, false>(p.w2, FFN, D_MODEL, (bf16*)(ws + WS_W2T), 0, scr, r, lane);
    }
}

__device__ __forceinline__ void phase_mod(const Params& p, LAS unsigned char* lds, int vb, int nb) {
    const int tid = tid_of(p.wave_id);
    LAS float* sc = (LAS float*)lds;
    LAS float* red = (LAS float*)(lds + 5 * 2048 * 4);
    for (int i = tid; i < 5 * D_MODEL; i += NTHREADS) { const int r = i / D_MODEL, k = i % D_MODEL; const float v = (r < 4) ? p.c[r * D_MODEL + k] : p.c_ctx[k]; sc[i] = siluf_(v); }
    __syncthreads();
    float* mod = (float*)(p.ws + WS_MOD);
    const int c4 = tid & 15, kp = tid >> 4;
    for (int item = vb; item < IN_COLS / 64; item += nb) {
        const int n0 = item * 64 + c4 * 4;
        f32x4 acc[5];
#pragma unroll
        for (int r = 0; r < 5; ++r) acc[r] = (f32x4){0.f, 0.f, 0.f, 0.f};
#pragma unroll 8
        for (int k = kp; k < D_MODEL; k += 32) {
            const f32x4 w = __builtin_nontemporal_load((const f32x4*)(p.ada_w + (size_t)k * IN_COLS + n0));
#pragma unroll
            for (int r = 0; r < 5; ++r) acc[r] += w * sc[r * D_MODEL + k];
        }
#pragma unroll
        for (int r = 0; r < 5; ++r) *(LAS f32x4*)(red + (kp * 5 + r) * 64 + c4 * 4) = acc[r];
        __syncthreads();
        if (tid < 320) { const int r = tid / 64, cidx = tid % 64; float s = 0.f;
            for (int q = 0; q < 32; ++q) s += red[(q * 5 + r) * 64 + cidx];
            mod[r * IN_COLS + item * 64 + cidx] = s + p.ada_b[item * 64 + cidx]; }
        __syncthreads();
    }
    if (vb == nb - 1) { float* rt = (float*)(p.ws + WS_ROPE);
        for (int i = tid; i < 64 * 32; i += NTHREADS) { const int pos = i >> 5, j = i & 31; const float inv = exp2f(-(float)j * (13.287712379549449f / 32.0f)); float sn, cs; sincosf((float)pos * inv, &sn, &cs); rt[i] = cs; rt[2048 + i] = sn; } }
    if (vb == 0) { float* lb = (float*)(p.ws + WS_LB);
        for (int i = tid; i < 2 * WA; i += NTHREADS) { const int d = i / WA, cc = i % WA; const float l0 = p.lb_logits[d * 2 * WA + cc], l1 = p.lb_logits[d * 2 * WA + WA + cc]; lb[i] = 1.0f / (1.0f + expf(l1 - l0)); } }
}

__device__ __forceinline__ void phase_h(const Params& p, int vb, int nb) {
    const int tid = tid_of(p.wave_id), lane = tid & 63, wave = p.wave_id;
    const float* mod = (const float*)(p.ws + WS_MOD);
    bf16* H = (bf16*)(p.ws + WS_H);
    for (int m = vb * 8 + wave; m < MT; m += nb * 8) {
        const float* xr = (m < ML) ? p.x + (size_t)m * D_MODEL : p.ctx + (size_t)(m - ML) * D_MODEL;
        const int mr = (m < ML) ? (m / SEQ) : 4;
        const float* sh = mod + (size_t)mr * IN_COLS, *scl = sh + D_MODEL;
        f32x4 v[8]; float s = 0.f;
#pragma unroll
        for (int j = 0; j < 8; ++j) { v[j] = *(const f32x4*)(xr + 4 * lane + 256 * j); s += (v[j].x * v[j].x + v[j].y * v[j].y) + (v[j].z * v[j].z + v[j].w * v[j].w); }
        const float rstd = __builtin_amdgcn_rsqf(wave_sum(s) * (1.0f / D_MODEL) + EPS);
#pragma unroll
        for (int j = 0; j < 8; ++j) { const int k = 4 * lane + 256 * j;
            const f32x4 g = *(const f32x4*)(p.norm1_g + k), a = *(const f32x4*)(scl + k), b = *(const f32x4*)(sh + k);
            const f32x4 h = v[j] * rstd * g * (a + 1.0f) + b;
            u32x2 o; o.x = pk2(h.x, h.y); o.y = pk2(h.z, h.w);
            *(u32x2*)(H + (size_t)m * D_MODEL + k) = o; }
    }
}

#define EPI_LOOP_BEGIN \
    _Pragma("unroll") for (int ai = 0; ai < 2; ++ai) _Pragma("unroll") for (int m = 0; m < 4; ++m) { const int row = u.pm * 256 + ai * 128 + wr * 64 + m * 16 + fr; \
    _Pragma("unroll") for (int bj = 0; bj < 2; ++bj) _Pragma("unroll") for (int n = 0; n < 2; ++n) { const int col = u.pn * 256 + bj * 128 + wc * 32 + n * 16 + fq * 4; const f32x4 v = acc[ai][bj][m][n];
#define EPI_LOOP_END } }

struct EpiInProj {
    static constexpr bool PERM = false, AFTER_DRAIN = false;
    unsigned char* ws; LAS unsigned char* lds; const float* qg; const float* kg;
    __device__ __forceinline__ void operator()(const f32x4 (&acc)[2][2][4][2], const pg8::Unit& u, int wr, int wc, int fr, int fq) const {
        const int seg = u.pn >> 2;
        const bool ctxrow = u.pm >= ML / 256;
        const float* lb = (const float*)(ws + WS_LB);
        if (seg == 1 || seg == 2) {
            float* F = (float*)(ws + (seg == 1 ? WS_FW : WS_FB)); const float* lbd = lb + (seg - 1) * WA;
            f32x4 lbv[2][2];
#pragma unroll
            for (int bj = 0; bj < 2; ++bj)
#pragma unroll
                for (int n = 0; n < 2; ++n) lbv[bj][n] = *(const f32x4*)(lbd + u.pn * 256 + bj * 128 + wc * 32 + n * 16 + fq * 4 - seg * WA);
            EPI_LOOP_BEGIN
                const int c = col - seg * WA; const f32x4 l = lbv[bj][n]; f32x4 o;
                o.x = __logf(l.x + (1.0f - l.x) * sigmoidf_(v.x)); o.y = __logf(l.y + (1.0f - l.y) * sigmoidf_(v.y));
                o.z = __logf(l.z + (1.0f - l.z) * sigmoidf_(v.z)); o.w = __logf(l.w + (1.0f - l.w) * sigmoidf_(v.w));
                *(f32x4*)(F + (size_t)row * WA + c) = o;
            EPI_LOOP_END
        } else if (seg == 7) {
            bf16* VT = (bf16*)(ws + WS_VN);
            EPI_LOOP_BEGIN
                const int c = col - 7 * WA; const int hh = c >> 7, d = c & 127;
                int bb, tok; if (row < ML) { bb = row / SEQ; tok = row % SEQ; } else { bb = (row - ML) / CTX; tok = SEQ + (row - ML) % CTX; }
                bf16* o = VT + ((size_t)(bb * NHEAD + hh) * HD + d) * VT_PITCH + tok;
                o[0] = (bf16)f2bf(v.x); o[VT_PITCH] = (bf16)f2bf(v.y); o[2 * VT_PITCH] = (bf16)f2bf(v.z); o[3 * VT_PITCH] = (bf16)f2bf(v.w);
            EPI_LOOP_END
        } else if (seg == 5 || seg == 6) {
            if (ctxrow && seg == 5) return;
            LAS float* ssq = (LAS float*)(lds + 131072);
            const float* gn = (seg == 5) ? qg : kg; const float* rt = (const float*)(ws + WS_ROPE);
            bf16* O = (bf16*)(ws + (seg == 5 ? WS_QN : WS_KN));
#pragma unroll
            for (int ai = 0; ai < 2; ++ai)
#pragma unroll
                for (int m = 0; m < 4; ++m)
#pragma unroll
                    for (int bj = 0; bj < 2; ++bj) { const f32x4 a = acc[ai][bj][m][0], b = acc[ai][bj][m][1];
                        float sq = (a.x * a.x + a.y * a.y) + (a.z * a.z + a.w * a.w) + (b.x * b.x + b.y * b.y) + (b.z * b.z + b.w * b.w);
                        sq += __shfl_xor(sq, 16); sq += __shfl_xor(sq, 32);
                        if (fq == 0) ssq[((ai * 128 + wr * 64 + m * 16 + fr) * 2 + bj) * 4 + wc] = sq; }
            asm volatile("s_waitcnt lgkmcnt(0)" ::: "memory"); __builtin_amdgcn_s_barrier(); asm volatile("" ::: "memory");
            const int H = wc >> 1, jj = 16 * (wc & 1) + 4 * fq;
            const f32x4 g0 = *(const f32x4*)(gn + 64 * H + jj), g1 = *(const f32x4*)(gn + 64 * H + 32 + jj);
#pragma unroll
            for (int ai = 0; ai < 2; ++ai)
#pragma unroll
                for (int m = 0; m < 4; ++m) { const int rl = ai * 128 + wr * 64 + m * 16 + fr; const int row = u.pm * 256 + rl;
                    f32x4 cs = (f32x4){1.f, 1.f, 1.f, 1.f}, sn = (f32x4){0.f, 0.f, 0.f, 0.f};
                    if (!ctxrow) { const int t = row & (SEQ - 1); const int pos = (H == 0) ? (t >> 6) : (t & 63); cs = *(const f32x4*)(rt + pos * 32 + jj); sn = *(const f32x4*)(rt + 2048 + pos * 32 + jj); }
#pragma unroll
                    for (int bj = 0; bj < 2; ++bj) { const f32x4 s4 = *(const LAS f32x4*)(ssq + (rl * 2 + bj) * 4);
                        const float rstd = __builtin_amdgcn_rsqf(((s4.x + s4.y) + (s4.z + s4.w)) * (1.0f / HD) + EPS);
                        const f32x4 u1 = acc[ai][bj][m][0] * rstd * g0, u2 = acc[ai][bj][m][1] * rstd * g1;
                        const f32x4 o1 = u1 * cs - u2 * sn, o2 = u1 * sn + u2 * cs;
                        bf16* op = O + (size_t)row * WA + (u.pn & 3) * 256 + bj * 128 + wc * 32 + fq * 4;
                        u32x2 w1; w1.x = pk2(o1.x, o1.y); w1.y = pk2(o1.z, o1.w); *(u32x2*)op = w1;
                        u32x2 w2; w2.x = pk2(o2.x, o2.y); w2.y = pk2(o2.z, o2.w); *(u32x2*)(op + 16) = w2; }
                    asm volatile("" ::: "memory"); }
            asm volatile("s_waitcnt lgkmcnt(0)" ::: "memory"); __builtin_amdgcn_s_barrier(); asm volatile("" ::: "memory");
        } else if (seg == 0 || seg == 3) {
            if (ctxrow && seg == 0) return;
            bf16* O = (bf16*)(ws + (seg == 0 ? WS_QA : WS_IA));
            EPI_LOOP_BEGIN
                const int c = col - seg * WA; u32x2 o; o.x = pk2(v.x, v.y); o.y = pk2(v.z, v.w);
                *(u32x2*)(O + (size_t)row * WA + c) = o;
            EPI_LOOP_END
        } else if (seg == 4) {
            if (ctxrow) return;
            bf16* O = (bf16*)(ws + WS_GA);
            EPI_LOOP_BEGIN
                const int c = col - seg * WA; u32x2 o; o.x = pk2(siluf_(v.x), siluf_(v.y)); o.y = pk2(siluf_(v.z), siluf_(v.w));
                *(u32x2*)(O + (size_t)row * WA + c) = o;
            EPI_LOOP_END
        } else {
            if (ctxrow) return;
            const bool isa = seg < 10;
            bf16* O = (bf16*)(ws + (isa ? WS_GTA : WS_GTB)); const int cbase = isa ? 8 * WA : 10 * WA;
            EPI_LOOP_BEGIN
                const int c = col - cbase; u32x2 o; o.x = pk2(sigmoidf_(v.x), sigmoidf_(v.y)); o.y = pk2(sigmoidf_(v.z), sigmoidf_(v.w));
                *(u32x2*)(O + (size_t)row * D_MODEL + c) = o;
            EPI_LOOP_END
        }
    }
};

constexpr int CTX_UNITS = (MC / 256) * 20;
struct InProjOrder : pg8::StaticOrder {
    __device__ bool next(int i, pg8::Unit& u) const {
        if (pg8::StaticOrder::next(i, u)) return true;
        const long L = (long)i * G + c - nwg; if (L < 0 || L >= CTX_UNITS) return false;
        const int t = (int)L, j = t % 20; u.pm = ML / 256 + t / 20; u.pn = (j < 12) ? 4 + j : 12 + j; u.br = 0; return true; }
};
struct MergeOrder : pg8::StaticOrder {
    const bf16* A1; const bf16* B1;
    __device__ bool next(int i, pg8::Unit& u) const { if (!pg8::StaticOrder::next(i >> 1, u)) return false; u.br = i & 1; return true; }
    __device__ __forceinline__ const char* a_base(const pg8::Gemm& g, const pg8::Unit& u, size_t tstep) const { return (const char*)(u.br ? A1 : g.A) + (size_t)u.pm * tstep; }
    __device__ __forceinline__ const char* b_base(const pg8::Gemm& g, const pg8::Unit& u, size_t tstep) const { return (const char*)(u.br ? B1 : g.Bt) + (size_t)u.pn * tstep; }
};
#define EPI_BATCH_BEGIN _Pragma("unroll") for (int ai = 0; ai < 2; ++ai) _Pragma("unroll") for (int mh = 0; mh < 4; mh += 2) {
#define EPI_BATCH_END }
#define EPI_VEC_LOOP _Pragma("unroll") for (int m2 = 0; m2 < 2; ++m2) _Pragma("unroll") for (int bj = 0; bj < 2; ++bj) _Pragma("unroll") for (int n = 0; n < 2; ++n)
#define EPI_VEC_IDX const int m = mh + m2, vi = (m2 * 2 + bj) * 2 + n; const int row = u.pm * 256 + ai * 128 + wr * 64 + m * 16 + fr, col = u.pn * 256 + bj * 128 + wc * 32 + n * 16 + fq * 4; (void)vi
struct EpiMerge {
    static constexpr bool PERM = false, AFTER_DRAIN = false;
    unsigned char* ws; float* tmp;
    __device__ __forceinline__ void operator()(const f32x4 (&acc)[2][2][4][2], const pg8::Unit& u, int wr, int wc, int fr, int fq) const {
        if (u.br == 0) {
            const bf16* G = (const bf16*)(ws + WS_GTA);
            EPI_BATCH_BEGIN
                u32x2 gv[8];
                EPI_VEC_LOOP { EPI_VEC_IDX; gv[vi] = *(const u32x2*)(G + (size_t)row * D_MODEL + col); }
                EPI_VEC_LOOP { EPI_VEC_IDX; const u32x2 g = gv[vi]; const f32x4 v = acc[ai][bj][m][n];
                    f32x4 o; o.x = bflo(g.x) * v.x; o.y = bfhi(g.x) * v.y; o.z = bflo(g.y) * v.z; o.w = bfhi(g.y) * v.w;
                    *(f32x4*)(tmp + (size_t)row * D_MODEL + col) = o; }
            EPI_BATCH_END
        } else {
            const bf16* G = (const bf16*)(ws + WS_GTB); bf16* Z = (bf16*)(ws + WS_Z);
            EPI_BATCH_BEGIN
                u32x2 gv[8]; f32x4 tv[8];
                EPI_VEC_LOOP { EPI_VEC_IDX; gv[vi] = *(const u32x2*)(G + (size_t)row * D_MODEL + col); tv[vi] = *(const f32x4*)(tmp + (size_t)row * D_MODEL + col); }
                EPI_VEC_LOOP { EPI_VEC_IDX; const u32x2 g = gv[vi]; const f32x4 t = tv[vi], v = acc[ai][bj][m][n];
                    u32x2 o; o.x = pk2(t.x + bflo(g.x) * v.x, t.y + bfhi(g.x) * v.y); o.y = pk2(t.z + bflo(g.y) * v.z, t.w + bfhi(g.y) * v.w);
                    *(u32x2*)(Z + (size_t)row * D_MODEL + col) = o; }
            EPI_BATCH_END
        }
    }
};
struct EpiOutProj {
    static constexpr bool PERM = false, AFTER_DRAIN = false;
    unsigned char* ws; const float* x; const float* norm2_g; float* out;
    __device__ __forceinline__ void operator()(const f32x4 (&acc)[2][2][4][2], const pg8::Unit& u, int wr, int wc, int fr, int fq) const {
        const float* mod = (const float*)(ws + WS_MOD); bf16* XMG = (bf16*)(ws + WS_XMG); float* rowsq = (float*)(ws + WS_ROWSQ);
        const int b = (u.pm * 256) / SEQ;
        const float* g1 = mod + (size_t)b * IN_COLS + 2 * D_MODEL, *sc2 = mod + (size_t)b * IN_COLS + 4 * D_MODEL;
        f32x4 cg[2][2], ch[2][2];
#pragma unroll
        for (int bj = 0; bj < 2; ++bj)
#pragma unroll
            for (int n = 0; n < 2; ++n) { const int col = u.pn * 256 + bj * 128 + wc * 32 + n * 16 + fq * 4; cg[bj][n] = *(const f32x4*)(g1 + col); ch[bj][n] = *(const f32x4*)(norm2_g + col) * (*(const f32x4*)(sc2 + col) + 1.0f); }
        EPI_BATCH_BEGIN
            f32x4 xv[8];
            EPI_VEC_LOOP { EPI_VEC_IDX; xv[vi] = *(const f32x4*)(x + (size_t)row * D_MODEL + col); }
            float ss[2] = {0.f, 0.f};
            EPI_VEC_LOOP { EPI_VEC_IDX; const f32x4 xm = xv[vi] + cg[bj][n] * acc[ai][bj][m][n];
                *(f32x4*)(out + (size_t)row * D_MODEL + col) = xm;
                ss[m2] += (xm.x * xm.x + xm.y * xm.y) + (xm.z * xm.z + xm.w * xm.w);
                const f32x4 h = xm * ch[bj][n];
                u32x2 o; o.x = pk2(h.x, h.y); o.y = pk2(h.z, h.w);
                *(u32x2*)(XMG + (size_t)row * D_MODEL + col) = o; }
#pragma unroll
            for (int m2 = 0; m2 < 2; ++m2) { float t = ss[m2]; t += __shfl_xor(t, 16); t += __shfl_xor(t, 32);
                if (fq == 0) atomicAdd(rowsq + u.pm * 256 + ai * 128 + wr * 64 + (mh + m2) * 16 + fr, t); }
        EPI_BATCH_END
    }
};
__device__ __forceinline__ float dpp_ror1(float v) { return __builtin_bit_cast(float, __builtin_amdgcn_update_dpp(0, __builtin_bit_cast(int, v), 0x121, 0xf, 0xf, false)); }
__device__ __forceinline__ float dpp_rol1(float v) { return __builtin_bit_cast(float, __builtin_amdgcn_update_dpp(0, __builtin_bit_cast(int, v), 0x12f, 0xf, 0xf, false)); }
__device__ __forceinline__ f32x4 ror1_4(const f32x4 v) { return (f32x4){dpp_ror1(v.x), dpp_ror1(v.y), dpp_ror1(v.z), dpp_ror1(v.w)}; }
__device__ __forceinline__ f32x4 rol1_4(const f32x4 v) { return (f32x4){dpp_rol1(v.x), dpp_rol1(v.y), dpp_rol1(v.z), dpp_rol1(v.w)}; }
struct EpiFfnUp {
    static constexpr bool PERM = false, AFTER_DRAIN = false;
    unsigned char* ws; LAS unsigned char* lds; const float* cw; const float* cb;
    __device__ __forceinline__ void operator()(const f32x4 (&acc_c)[2][2][4][2], const pg8::Unit& u, int wr, int wc, int fr, int fq) const {
        f32x4 (&acc)[2][2][4][2] = const_cast<f32x4 (&)[2][2][4][2]>(acc_c);
        const float* rowsq = (const float*)(ws + WS_ROWSQ); bf16* ACT = (bf16*)(ws + WS_ACT); float* HALO = (float*)(ws + WS_HALO) + (size_t)u.pm * 6 * FFN;
        const int b = (u.pm * 256) / SEQ; const float* bias2 = (const float*)(ws + WS_BIAS2) + (size_t)b * 2 * FFN + u.pn * 256;
        const int cl = wc * 32 + fq * 4, ch0 = u.pn * 128 + cl;
        LAS float* X = (LAS float*)(lds + 131072);
#pragma unroll
        for (int ai = 0; ai < 2; ++ai)
#pragma unroll
            for (int m = 0; m < 4; ++m) { const int row = u.pm * 256 + ai * 128 + wr * 64 + m * 16 + fr;
                const float rstd = __builtin_amdgcn_rsqf(rowsq[row] * (1.0f / D_MODEL) + EPS);
#pragma unroll
                for (int bj = 0; bj < 2; ++bj)
#pragma unroll
                    for (int n = 0; n < 2; ++n) acc[ai][bj][m][n] = acc[ai][bj][m][n] * rstd + *(const f32x4*)(bias2 + bj * 128 + cl + 16 * n); }
#pragma unroll
        for (int ai = 0; ai < 2; ++ai) { const int bi = 2 * ai + wr;
            if (fr == 0) {
#pragma unroll
                for (int n = 0; n < 2; ++n) *(LAS f32x4*)(X + (bi * 2 + 0) * 128 + cl + 16 * n) = acc[ai][0][0][n]; }
            if (fr == 15) {
#pragma unroll
                for (int n = 0; n < 2; ++n) *(LAS f32x4*)(X + (bi * 2 + 1) * 128 + cl + 16 * n) = acc[ai][0][3][n]; } }
        asm volatile("s_waitcnt lgkmcnt(0)" ::: "memory"); __builtin_amdgcn_s_barrier(); asm volatile("" ::: "memory");
        if (wr == 0 && fr < 2) {
#pragma unroll
            for (int n = 0; n < 2; ++n) { *(f32x4*)(HALO + (size_t)fr * FFN + ch0 + 16 * n) = acc[0][0][0][n]; if (fr == 0) *(f32x4*)(HALO + (size_t)4 * FFN + ch0 + 16 * n) = acc[0][1][0][n]; } }
        if (wr == 1 && fr >= 14) {
#pragma unroll
            for (int n = 0; n < 2; ++n) { *(f32x4*)(HALO + (size_t)(fr - 12) * FFN + ch0 + 16 * n) = acc[1][0][3][n]; if (fr == 15) *(f32x4*)(HALO + (size_t)5 * FFN + ch0 + 16 * n) = acc[1][1][3][n]; } }
#pragma unroll
        for (int n = 0; n < 2; ++n) {
            const f32x4 w0 = *(const f32x4*)(cw + ch0 + 16 * n), w1 = *(const f32x4*)(cw + FFN + ch0 + 16 * n), w2 = *(const f32x4*)(cw + 2 * FFN + ch0 + 16 * n), cbv = *(const f32x4*)(cb + ch0 + 16 * n);
#pragma unroll
            for (int ai = 0; ai < 2; ++ai) { const int bi = 2 * ai + wr;
                const f32x4 xprev = (bi > 0) ? *(const LAS f32x4*)(X + ((bi - 1) * 2 + 1) * 128 + cl + 16 * n) : (f32x4){0.f, 0.f, 0.f, 0.f};
                const f32x4 xnext = (bi < 3) ? *(const LAS f32x4*)(X + ((bi + 1) * 2 + 0) * 128 + cl + 16 * n) : (f32x4){0.f, 0.f, 0.f, 0.f};
#pragma unroll
                for (int m = 0; m < 4; ++m) { const f32x4 cur = acc[ai][0][m][n];
                    const f32x4 pu = (m > 0) ? ror1_4(acc[ai][0][m > 0 ? m - 1 : 0][n]) : xprev; const f32x4 ps = ror1_4(cur);
                    const f32x4 nd = (m < 3) ? rol1_4(acc[ai][0][m < 3 ? m + 1 : 3][n]) : xnext; const f32x4 ns = rol1_4(cur);
                    const f32x4 prev = (fr > 0) ? ps : pu, next = (fr < 15) ? ns : nd;
                    const f32x4 uu = w0 * prev + w1 * cur + w2 * next + cbv; const f32x4 gt = acc[ai][1][m][n];
                    f32x4 r; r.x = siluf_(uu.x) * gt.x; r.y = siluf_(uu.y) * gt.y; r.z = siluf_(uu.z) * gt.z; r.w = siluf_(uu.w) * gt.w;
                    const int rl = ai * 128 + wr * 64 + m * 16 + fr;
                    if (rl != 0 && rl != 255) { u32x2 o; o.x = pk2(r.x, r.y); o.y = pk2(r.z, r.w); *(u32x2*)(ACT + (size_t)(u.pm * 256 + rl) * FFN + ch0 + 16 * n) = o; } } } }
    }
};
__device__ __forceinline__ void halo_fix(const Params& p, int pm, int tid) {
    const float* HB = (const float*)(p.ws + WS_HALO); const float* H = HB + (size_t)pm * 6 * FFN; bf16* ACT = (bf16*)(p.ws + WS_ACT);
    for (int ch = tid; ch < FFN; ch += NTHREADS) {
        const float w0 = p.conv_w[ch], w1 = p.conv_w[FFN + ch], w2 = p.conv_w[2 * FFN + ch], cbv = p.conv_b[ch];
        const float pv = (pm & 7) ? HB[((size_t)(pm - 1) * 6 + 3) * FFN + ch] : 0.f; const float nx = ((pm & 7) != 7) ? HB[((size_t)(pm + 1) * 6 + 0) * FFN + ch] : 0.f;
        const float ut = w0 * pv + w1 * H[ch] + w2 * H[FFN + ch] + cbv; const float ub = w0 * H[2 * FFN + ch] + w1 * H[3 * FFN + ch] + w2 * nx + cbv;
        ACT[(size_t)(pm * 256) * FFN + ch] = (bf16)f2bf(siluf_(ut) * H[4 * FFN + ch]); ACT[(size_t)(pm * 256 + 255) * FFN + ch] = (bf16)f2bf(siluf_(ub) * H[5 * FFN + ch]);
    }
}
struct EpiFfnDown {
    static constexpr bool PERM = false, AFTER_DRAIN = false;
    unsigned char* ws; float* out;
    __device__ __forceinline__ void operator()(const f32x4 (&acc)[2][2][4][2], const pg8::Unit& u, int wr, int wc, int fr, int fq) const {
        const float* mod = (const float*)(ws + WS_MOD); const int b = (u.pm * 256) / SEQ; const float* g2 = mod + (size_t)b * IN_COLS + 5 * D_MODEL;
        f32x4 cg[2][2];
#pragma unroll
        for (int bj = 0; bj < 2; ++bj)
#pragma unroll
            for (int n = 0; n < 2; ++n) cg[bj][n] = *(const f32x4*)(g2 + u.pn * 256 + bj * 128 + wc * 32 + n * 16 + fq * 4);
        EPI_BATCH_BEGIN
            f32x4 xv[8];
            EPI_VEC_LOOP { EPI_VEC_IDX; xv[vi] = *(const f32x4*)(out + (size_t)row * D_MODEL + col); }
            EPI_VEC_LOOP { EPI_VEC_IDX; *(f32x4*)(out + (size_t)row * D_MODEL + col) = xv[vi] + cg[bj][n] * acc[ai][bj][m][n]; }
        EPI_BATCH_END
    }
};

#define XB_TMO      128
#define XB_XCNT(j)  (256  + 64 * (j))
#define XB_XSUB(j)  (1280 + 64 * (j))
#define XB_XGEN(j)  (2304 + 64 * (j))
#define XB_TOP      3328
#define XB_TOPGEN   3392
#define XCD_BAR_WORDS 3456
#define XB_SPIN_CAP (1u << 18)

__device__ __forceinline__ unsigned xb_ld(unsigned* p)              { return __hip_atomic_load(p, __ATOMIC_RELAXED, __HIP_MEMORY_SCOPE_AGENT); }
__device__ __forceinline__ unsigned xb_add(unsigned* p, unsigned v) { return __hip_atomic_fetch_add(p, v, __ATOMIC_RELAXED, __HIP_MEMORY_SCOPE_AGENT); }
__device__ __forceinline__ unsigned xb_xcc_id() { return (unsigned)__builtin_amdgcn_s_getreg((3 << 11) | 20) & 0xFu; }
#define XB_SPIN(cond, bar) do { unsigned _sp = 0; while (cond) { __builtin_amdgcn_s_sleep(1); \
    if ((++_sp & 255u) == 0u) { if (xb_ld(&(bar)[XB_TMO])) break; if (_sp > XB_SPIN_CAP) { atomicAdd(&(bar)[XB_TMO], 1u); break; } } } } while (0)

struct XcdBarrier {
    unsigned* bar; unsigned x; int wave;
    volatile LAS unsigned* st;
};

__device__ __forceinline__ XcdBarrier xcd_barrier_post(unsigned* bar, volatile LAS unsigned* st, int wave_id) {
    XcdBarrier b; b.bar = bar; b.x = xb_xcc_id(); b.st = st; b.wave = wave_id;
    if (wave_id == 0 && lane_id() == 0) (void)xb_add(&bar[XB_XCNT(b.x)], 1u);
    return b;
}
__device__ __forceinline__ void xcd_barrier_complete(unsigned* bar, unsigned x, unsigned& nloc, unsigned& nx) {
    const unsigned G = gridDim.x * gridDim.y * gridDim.z;
    unsigned sum, cnt, mine, sp = 0u;
    for (;;) {
        sum = 0u; cnt = 0u; mine = 0u;
#pragma unroll
        for (unsigned j = 0; j < 16; ++j) { const unsigned c = xb_ld(&bar[XB_XCNT(j)]); sum += c; cnt += (c > 0u) ? 1u : 0u; mine = (j == x) ? c : mine; }
        if (sum == G) break;
        __builtin_amdgcn_s_sleep(1);
        if ((++sp & 255u) == 0u) { if (xb_ld(&bar[XB_TMO])) break; if (sp > XB_SPIN_CAP) { atomicAdd(&bar[XB_TMO], 1u); break; } }
    }
    nloc = mine > 0u ? mine : 1u; nx = cnt > 0u ? cnt : 1u;
}

__device__ __forceinline__ void xcd_barrier(const XcdBarrier& b) {
    asm volatile("s_waitcnt vmcnt(0)" ::: "memory");
    __syncthreads();
    if (b.wave == 0 && lane_id() == 0) {
        unsigned* bar = b.bar;
        __builtin_amdgcn_s_waitcnt(0);
        unsigned nloc = b.st[0], nx = b.st[1];
        if (nloc == 0u) { xcd_barrier_complete(bar, b.x, nloc, nx); b.st[0] = nloc; b.st[1] = nx; }
        const unsigned old = xb_add(&bar[XB_XSUB(b.x)], 1u);
        const unsigned gen = old / nloc;
        if (old + 1u == (gen + 1u) * nloc) {
            __builtin_amdgcn_fence(__ATOMIC_RELEASE, "agent");
            asm volatile("s_waitcnt vmcnt(0)" ::: "memory");
            const unsigned og = xb_add(&bar[XB_TOP], 1u);
            const unsigned tg = og / nx;
            if (og + 1u == (tg + 1u) * nx) xb_add(&bar[XB_TOPGEN], 1u);
            else XB_SPIN(xb_ld(&bar[XB_TOPGEN]) == tg, bar);
            __builtin_amdgcn_fence(__ATOMIC_ACQUIRE, "agent");
            xb_add(&bar[XB_XGEN(b.x)], 1u);
            asm volatile("s_waitcnt vmcnt(0)" ::: "memory");
        } else {
            XB_SPIN(xb_ld(&bar[XB_XGEN(b.x)]) == gen, bar);
            __builtin_amdgcn_fence(__ATOMIC_ACQUIRE, "agent");
            asm volatile("s_waitcnt vmcnt(0)" ::: "memory");
        }
    }
    __syncthreads();
}

constexpr size_t WS_BAR = 8192;

typedef short bf16x8 __attribute__((ext_vector_type(8)));
typedef short s16x4 __attribute__((ext_vector_type(4)));

__device__ __forceinline__ bf16x8 cat8u(const u32x2 a, const u32x2 b) { const u32x4 w = (u32x4){a.x, a.y, b.x, b.y}; return __builtin_bit_cast(bf16x8, w); }
__device__ __forceinline__ bf16x8 pack_p(const f32x4 a, const f32x4 b) {
    u32x4 w; w.x = pk2(a.x, a.y); w.y = pk2(a.z, a.w); w.z = pk2(b.x, b.y); w.w = pk2(b.z, b.w);
    return __builtin_bit_cast(bf16x8, w);
}

constexpr int A_TILE = 32768, A_KOFF = 0, A_VOFF = 16384;
constexpr int A_BIAS = 4 * A_TILE;
constexpr int A_ITEM = A_BIAS + 2048;
static_assert(A_ITEM + 64 <= 145408, "attention LDS");
constexpr size_t WS_ATTCTR = 32768;
static_assert(WS_ATTCTR >= WS_BAR + XCD_BAR_WORDS * 4 && WS_ATTCTR + 8 * 256 <= WS_ROWSQ, "attn counters (8 x 256 B apart) inside ctl");
#define ATT_BAR() do { asm volatile("s_waitcnt lgkmcnt(0)" ::: "memory"); __builtin_amdgcn_s_barrier(); asm volatile("" ::: "memory"); } while (0)
__device__ __forceinline__ void glds16(const void* gsrc, unsigned lds_dst) { unsigned keep;
    asm volatile("s_mov_b32 %0, m0\n\ts_mov_b32 m0, %2\n\ts_nop 0\n\tglobal_load_lds_dwordx4 %1, off\n\ts_mov_b32 m0, %0" : "=&s"(keep) : "v"(gsrc), "s"(lds_dst) : "memory"); }
__device__ __forceinline__ unsigned lds_addr(LAS const void* p) { return (unsigned)__builtin_amdgcn_readfirstlane((int)(unsigned)(unsigned long long)p); }

__device__ __forceinline__ void phase_attn(const Params& p, LAS unsigned char* lds) {
    int tid_o = tid_of(p.wave_id);
    const int tid = tid_o, lane = tid & 63, wave = __builtin_amdgcn_readfirstlane(tid >> 6);
    const int qb = wave & 3, rw = wave >> 2, li = lane & 15, g = lane >> 4;
    const bf16* QN = (const bf16*)(p.ws + WS_QN); const bf16* KN = (const bf16*)(p.ws + WS_KN); const bf16* VT = (const bf16*)(p.ws + WS_VN);
    bf16* YB = (bf16*)p.out + (size_t)3 * ML * WA;
    unsigned* ctr = (unsigned*)(p.ws + WS_ATTCTR);
    LAS float* btab = (LAS float*)(lds + A_BIAS);
    const float scale = 0.08838834764831845f;
    int krow_l[2], kch_l[2], vrow_l[2], vch_l[2];
#pragma unroll
    for (int e = 0; e < 2; ++e) { const int pk = 2 * wave + e; krow_l[e] = 4 * pk + (lane >> 4); kch_l[e] = (lane & 15) ^ (krow_l[e] & 15);
        vrow_l[e] = 8 * pk + (lane >> 3); vch_l[e] = (lane & 7) ^ ((vrow_l[e] >> 1) & 7); }
    const int myx = (int)(xb_xcc_id() & 7u);
    int qoff = 0;
    for (;;) {
        if (tid == 0) { unsigned v = 0xffffffffu;
            while (qoff < 8) { const int qx = (myx + qoff) & 7; const unsigned n = atomicAdd(ctr + 64 * qx, 1u); if (n < 64u) { v = (unsigned)((qx + 8 * (n >> 4)) * 16 + (n & 15)); break; } ++qoff; }
            *(LAS unsigned*)(lds + A_ITEM) = v; }
        __syncthreads();
        const unsigned itu = *(LAS unsigned*)(lds + A_ITEM);
        if (itu == 0xffffffffu) break;
        const int it = (int)itu;
        const int rp = it & 15, h = (it >> 4) & 7, b = it >> 7;
        const int r = 2 * rp + rw;
        const int rs = min(max(r - 4, 0), 24), ks0 = min(max(16 * qb - 8, 0), 32);
        const int kr0 = min(max(2 * rp - 4, 0), 24), nband = min(max(2 * rp + 1 - 4, 0), 24) + 8 - kr0, NT = nband + 4;
        const int cq = 16 * qb + li, cs = min(max(cq - 8, 0), 48);
        const size_t qrow = (size_t)b * SEQ + r * GRID_W + cq;
        if (tid < 15 * 31) btab[tid] = p.rel_bias[h * 465 + tid];
        bf16x8 qf[4];
#pragma unroll
        for (int ks = 0; ks < 4; ++ks) qf[ks] = *(const bf16x8*)(QN + qrow * WA + h * HD + 32 * ks + 8 * g);
        asm volatile("s_waitcnt vmcnt(0)" ::: "memory");
        const bf16* kg0 = KN + (size_t)h * HD + (size_t)krow_l[0] * WA + 8 * kch_l[0]; const bf16* kg1 = KN + (size_t)h * HD + (size_t)krow_l[1] * WA + 8 * kch_l[1];
        const bf16* vg0 = VT + ((size_t)(b * NHEAD + h) * HD + vrow_l[0]) * VT_PITCH + 8 * vch_l[0]; const bf16* vg1 = VT + ((size_t)(b * NHEAD + h) * HD + vrow_l[1]) * VT_PITCH + 8 * vch_l[1];
#define ATT_DMA(ti_) do { const int t_ = (ti_) < NT ? (ti_) : NT - 1; const unsigned la_ = lds_addr(lds + ((ti_) & 3) * A_TILE + wave * 2048); \
            const size_t krow0 = (t_ < nband) ? ((size_t)b * SEQ + (kr0 + t_) * GRID_W) : ((size_t)ML + b * CTX + 64 * (t_ - nband)); \
            const int tok0 = (t_ < nband) ? ((kr0 + t_) * GRID_W) : (SEQ + 64 * (t_ - nband)); \
            glds16(kg0 + krow0 * WA, la_ + A_KOFF); glds16(kg1 + krow0 * WA, la_ + A_KOFF + 1024); glds16(vg0 + tok0, la_ + A_VOFF); glds16(vg1 + tok0, la_ + A_VOFF + 1024); } while (0)
        ATT_DMA(0); ATT_DMA(1); ATT_DMA(2);
        f32x4 ot[8];
#pragma unroll
        for (int db = 0; db < 8; ++db) ot[db] = (f32x4){0.f, 0.f, 0.f, 0.f};
        float mrun = -1e30f, l = 0.f;
        const int kx = (ks0 + li) & 15, vy = (li >> 1) & 7;
        int koff[4];
#pragma unroll
        for (int ks = 0; ks < 4; ++ks) koff[ks] = A_KOFF + (ks0 + li) * 256 + (((4 * ks + g) ^ kx) << 4);
        const int vrow_off = A_VOFF + li * 128 + 8 * (g & 1);
        const int gq = g >> 1;
#pragma unroll 1
        for (int ti = 0; ti < NT; ++ti) {
            asm volatile("s_waitcnt vmcnt(8)" ::: "memory");
            ATT_BAR();
            ATT_DMA(ti + 3);
            const LAS unsigned char* tb = lds + (ti & 3) * A_TILE;
            if (ti < nband) {
                const int kr = kr0 + ti;
                if (kr >= rs && kr < rs + 8) {
                    f32x4 st[2];
#pragma unroll
                    for (int kb = 0; kb < 2; ++kb) { f32x4 a = (f32x4){0.f, 0.f, 0.f, 0.f};
#pragma unroll
                        for (int ks = 0; ks < 4; ++ks) a = __builtin_amdgcn_mfma_f32_16x16x32_bf16(*(const LAS bf16x8*)(tb + koff[ks] + kb * 4096), qf[ks], a, 0, 0, 0);
                        st[kb] = a; }
                    const int dr = kr - r + 7; float gm = -1e30f;
#pragma unroll
                    for (int kb = 0; kb < 2; ++kb)
#pragma unroll
                        for (int j = 0; j < 4; ++j) { const int kcol = ks0 + 16 * kb + 4 * g + j; const bool valid = (kcol >= cs) && (kcol < cs + 16);
                            const int bi = valid ? (dr * 31 + (kcol - cq + 15)) : 0;
                            const float sv = valid ? (st[kb][j] * scale + btab[bi]) : -1e30f; st[kb][j] = sv; gm = fmaxf(gm, sv); }
                    gm = fmaxf(gm, __shfl_xor(gm, 16)); gm = fmaxf(gm, __shfl_xor(gm, 32));
                    const float mnew = fmaxf(mrun, gm); const float alpha = __expf(mrun - mnew); mrun = mnew; l *= alpha;
#pragma unroll
                    for (int db = 0; db < 8; ++db) ot[db] = ot[db] * alpha;
#pragma unroll
                    for (int kb = 0; kb < 2; ++kb)
#pragma unroll
                        for (int j = 0; j < 4; ++j) { const float sv = st[kb][j]; const float e = (sv > -1e29f) ? __expf(sv - mnew) : 0.f; st[kb][j] = e; l += e; }
                    const bf16x8 pb = pack_p(st[0], st[1]);
                    const int c0 = (ks0 >> 3) + gq;
#pragma unroll
                    for (int db = 0; db < 8; ++db) { const LAS unsigned char* vp = tb + vrow_off + db * 2048;
                        ot[db] = __builtin_amdgcn_mfma_f32_16x16x32_bf16(cat8u(*(const LAS u32x2*)(vp + ((c0 ^ vy) << 4)), *(const LAS u32x2*)(vp + (((c0 + 2) ^ vy) << 4))), pb, ot[db], 0, 0, 0); }
                }
            } else {
                f32x4 st[4];
#pragma unroll
                for (int kb = 0; kb < 4; ++kb) { f32x4 a = (f32x4){0.f, 0.f, 0.f, 0.f};
#pragma unroll
                    for (int ks = 0; ks < 4; ++ks) a = __builtin_amdgcn_mfma_f32_16x16x32_bf16(*(const LAS bf16x8*)(tb + A_KOFF + (16 * kb + li) * 256 + (((4 * ks + g) ^ li) << 4)), qf[ks], a, 0, 0, 0);
                    st[kb] = a * scale; }
                float gm = -1e30f;
#pragma unroll
                for (int kb = 0; kb < 4; ++kb) gm = fmaxf(fmaxf(gm, fmaxf(st[kb][0], st[kb][1])), fmaxf(st[kb][2], st[kb][3]));
                gm = fmaxf(gm, __shfl_xor(gm, 16)); gm = fmaxf(gm, __shfl_xor(gm, 32));
                const float mnew = fmaxf(mrun, gm); const float alpha = __expf(mrun - mnew); mrun = mnew; l *= alpha;
#pragma unroll
                for (int db = 0; db < 8; ++db) ot[db] = ot[db] * alpha;
#pragma unroll
                for (int kb = 0; kb < 4; ++kb)
#pragma unroll
                    for (int j = 0; j < 4; ++j) { const float e = __expf(st[kb][j] - mnew); st[kb][j] = e; l += e; }
#pragma unroll
                for (int kp2 = 0; kp2 < 2; ++kp2) { const bf16x8 pb = pack_p(st[2 * kp2], st[2 * kp2 + 1]);
                    const int c0 = 4 * kp2 + gq;
#pragma unroll
                    for (int db = 0; db < 8; ++db) { const LAS unsigned char* vp = tb + vrow_off + db * 2048;
                        ot[db] = __builtin_amdgcn_mfma_f32_16x16x32_bf16(cat8u(*(const LAS u32x2*)(vp + ((c0 ^ vy) << 4)), *(const LAS u32x2*)(vp + (((c0 + 2) ^ vy) << 4))), pb, ot[db], 0, 0, 0); } }
            }
        }
        asm volatile("s_waitcnt vmcnt(0)" ::: "memory");
        l += __shfl_xor(l, 16); l += __shfl_xor(l, 32);
        const float inv = 1.0f / l;
#pragma unroll
        for (int db = 0; db < 8; ++db) { const f32x4 o = ot[db] * inv; u32x2 w; w.x = pk2(o.x, o.y); w.y = pk2(o.z, o.w);
            *(u32x2*)(YB + qrow * WA + h * HD + 16 * db + 4 * g) = w; }
#undef ATT_DMA
    }
}

constexpr int HP = 160;
constexpr int H_QH = 0, H_KH = 20480, H_KE = 40960, H_QD = 61440, H_KD = 81920;
constexpr int HP2 = 48;
constexpr int H_Q2 = 102400, H_K2 = 108544;
constexpr int PP = 144;
constexpr int H_P = 114688;
constexpr int H_T = 123904;
constexpr int H_D = 125952;
constexpr int HIMG_QD = 0, HIMG_KD = 16384, HIMG_P = 32768, HIMG_D = 40960, HIMG_BYTES = 41472;
constexpr int NCH = (CTX + SEQ) / 64;
constexpr int VP = 288;
constexpr int HPK = 136;
constexpr int SB_QD = 0, SB_KD = 20480, SB_P = 40960, SB_D = 50176, SB_V = 50688, SB_BYTES = 69120;
static_assert(2 * SB_BYTES <= 145408, "scan buffers");

__device__ __forceinline__ s16x4 lds_tr(LAS const unsigned char* p) {
    return __builtin_bit_cast(s16x4, __builtin_amdgcn_ds_read_tr16_b64_v4i16((LAS s16x4*)p));
}
__device__ __forceinline__ bf16x8 cat8(const s16x4 a, const s16x4 b) { return __builtin_shufflevector(a, b, 0, 1, 2, 3, 4, 5, 6, 7); }

__device__ __forceinline__ size_t hg_row(int dir, int b, int tau) {
    if (tau < CTX) return (size_t)ML + b * CTX + (dir == 0 ? tau : CTX - 1 - tau);
    const int t = tau - CTX; return (size_t)b * SEQ + (dir == 0 ? t : SEQ - 1 - t);
}

__device__ __forceinline__ void hgrn_prep(const Params& p, LAS unsigned char* lds, int vb, int nb) {
    int tid_o = tid_of(p.wave_id);
    const int tid = tid_o, lane = tid & 63, wave = __builtin_amdgcn_readfirstlane(tid >> 6);
    const int k = tid & 127, J = __builtin_amdgcn_readfirstlane(tid >> 7);
    const int li = lane & 15, g = lane >> 4, qq = li >> 2, pp = li & 3;
    LAS float* Tl = (LAS float*)(lds + H_T); LAS float* Dl = (LAS float*)(lds + H_D);
    float lf[16]; unsigned qv[16];
#define HG_LOADP(idx_) do { const int id_ = (idx_); const int ch_ = id_ / NCH, cc_ = id_ % NCH; const int dir_ = ch_ / (BATCH * NHEAD), b_ = (ch_ / NHEAD) % BATCH, h_ = ch_ % NHEAD; \
        const size_t row0_ = hg_row(dir_, b_, 64 * cc_ + 16 * J); const long st_ = dir_ ? -(long)WA : (long)WA; \
        const float* lfp_ = (const float*)(p.ws + (dir_ == 0 ? WS_FW : WS_FB)) + row0_ * WA + h_ * HD + k; const bf16* qp_ = (const bf16*)(p.ws + WS_QA) + row0_ * WA + h_ * HD + k; \
        _Pragma("unroll") for (int i = 0; i < 16; ++i) { lf[i] = lfp_[(long)i * st_]; qv[i] = (cc_ >= 4) ? (unsigned)qp_[(long)i * st_] : 0u; } } while (0)
    if (vb < 64 * NCH) HG_LOADP(vb);
    for (int idx = vb; idx < 64 * NCH; idx += nb) {
        const int c = idx % NCH;
        float cum[16]; float run = 0.f;
#pragma unroll
        for (int i = 0; i < 16; ++i) { run += lf[i]; cum[i] = run; }
        Tl[J * 128 + k] = run;
        ATT_BAR();
        const float T0 = Tl[k], T1 = Tl[128 + k], T2 = Tl[256 + k], T3 = Tl[384 + k];
        const float bJ = (J > 0 ? T0 : 0.f) + (J > 1 ? T1 : 0.f) + (J > 2 ? T2 : 0.f);
        const float tail = (J < 1 ? T1 : 0.f) + (J < 2 ? T2 : 0.f) + (J < 3 ? T3 : 0.f);
        const float eb = __expf(bJ), et = __expf(tail), eT = __expf(run);
        const float x2 = (J == 3) ? __expf(T2) : __expf(T1);
        float qh[16], kh[16];
#pragma unroll
        for (int i = 0; i < 16; ++i) { const float e1 = __expf(cum[i]); const float r1 = __builtin_amdgcn_rcpf(e1); const float kk = 1.0f - __expf(lf[i]);
            qh[i] = __builtin_bit_cast(float, qv[i] << 16) * e1; kh[i] = kk * r1; }
        {
            LAS unsigned char* rowp = lds + k * HP + 32 * J;
            u32x4 w0, w1;
#define HG_WRITE(OFF, EXPR) do { \
            { float v0_, v1_; \
              { const int i = 0; v0_ = (EXPR); } { const int i = 1; v1_ = (EXPR); } w0.x = pk2(v0_, v1_); \
              { const int i = 2; v0_ = (EXPR); } { const int i = 3; v1_ = (EXPR); } w0.y = pk2(v0_, v1_); \
              { const int i = 4; v0_ = (EXPR); } { const int i = 5; v1_ = (EXPR); } w0.z = pk2(v0_, v1_); \
              { const int i = 6; v0_ = (EXPR); } { const int i = 7; v1_ = (EXPR); } w0.w = pk2(v0_, v1_); \
              { const int i = 8; v0_ = (EXPR); } { const int i = 9; v1_ = (EXPR); } w1.x = pk2(v0_, v1_); \
              { const int i = 10; v0_ = (EXPR); } { const int i = 11; v1_ = (EXPR); } w1.y = pk2(v0_, v1_); \
              { const int i = 12; v0_ = (EXPR); } { const int i = 13; v1_ = (EXPR); } w1.z = pk2(v0_, v1_); \
              { const int i = 14; v0_ = (EXPR); } { const int i = 15; v1_ = (EXPR); } w1.w = pk2(v0_, v1_); } \
            *(LAS u32x4*)(OFF) = w0; *(LAS u32x4*)((OFF) + 16) = w1; } while (0)
            HG_WRITE(rowp + H_QH, qh[i]);
            HG_WRITE(rowp + H_KH, kh[i]);
            HG_WRITE(rowp + H_KE, kh[i] * eT);
            HG_WRITE(rowp + H_QD, qh[i] * eb);
            HG_WRITE(rowp + H_KD, kh[i] * (eT * et));
            if (J == 3) { HG_WRITE(lds + H_Q2 + k * HP2, qh[i] * x2); }
            if (J == 0) { HG_WRITE(lds + H_K2 + k * HP2, kh[i] * (eT * x2)); }
#undef HG_WRITE
            if (J == 3) Dl[k] = __expf(bJ + run);
        }
        if (idx + nb < 64 * NCH) HG_LOADP(idx + nb);
        ATT_BAR();
        const bool lat = (c >= 4);
        if (lat) {
#pragma unroll
            for (int rep = 0; rep < 2; ++rep) {
                int I, Jb;
                if (rep == 0) { I = (wave < 4) ? wave : (wave == 4 ? 1 : (wave == 7 ? 3 : 2)); Jb = (wave < 4) ? wave : (wave == 4 ? 0 : (wave == 5 ? 0 : (wave == 6 ? 1 : 2))); }
                else { if (wave >= 2) break; I = 3; Jb = wave; }
                int aoff, apitch, acol, boff, bpitch, bcol;
                if (I == Jb) { aoff = H_KH; apitch = HP; acol = 16 * Jb; boff = H_QH; bpitch = HP; bcol = 16 * I; }
                else if (I == Jb + 1 && I != 2) { aoff = H_KE; apitch = HP; acol = 16 * Jb; boff = H_QH; bpitch = HP; bcol = 16 * I; }
                else if (I == 2) { if (Jb == 0) { aoff = H_K2; apitch = HP2; acol = 0; } else { aoff = H_KE; apitch = HP; acol = 16; } boff = H_QH; bpitch = HP; bcol = 32; }
                else { if (Jb == 0) { aoff = H_K2; apitch = HP2; acol = 0; } else { aoff = H_KE; apitch = HP; acol = 16; } boff = H_Q2; bpitch = HP2; bcol = 0; }
                f32x4 pt = (f32x4){0.f, 0.f, 0.f, 0.f};
#pragma unroll
                for (int ks = 0; ks < 4; ++ks) {
                    const int r0 = 32 * ks + 4 * g + qq;
                    const bf16x8 a = cat8(lds_tr(lds + aoff + r0 * apitch + (acol + 4 * pp) * 2), lds_tr(lds + aoff + (r0 + 16) * apitch + (acol + 4 * pp) * 2));
                    const bf16x8 bb = cat8(lds_tr(lds + boff + r0 * bpitch + (bcol + 4 * pp) * 2), lds_tr(lds + boff + (r0 + 16) * bpitch + (bcol + 4 * pp) * 2));
                    pt = __builtin_amdgcn_mfma_f32_16x16x32_bf16(a, bb, pt, 0, 0, 0);
                }
                if (I == Jb) {
#pragma unroll
                    for (int j = 0; j < 4; ++j) if (4 * g + j > li) pt[j] = 0.f;
                }
                u32x2 w; w.x = pk2(pt.x, pt.y); w.y = pk2(pt.z, pt.w);
                *(LAS u32x2*)(lds + H_P + (16 * I + li) * PP + (16 * Jb + 4 * g) * 2) = w;
            }
        }
        ATT_BAR();
        unsigned char* img = p.ws + WS_HIMG + (size_t)idx * HIMG_BYTES;
#pragma unroll
        for (int e = 0; e < 2; ++e) { const int id = tid + 512 * e; const int kr = id >> 3, part = id & 7;
            if (lat) *(u32x4*)(img + HIMG_QD + id * 16) = *(const LAS u32x4*)(lds + H_QD + kr * HP + 16 * part);
            *(u32x4*)(img + HIMG_KD + id * 16) = *(const LAS u32x4*)(lds + H_KD + kr * HP + 16 * part); }
        if (lat) *(u32x4*)(img + HIMG_P + tid * 16) = *(const LAS u32x4*)(lds + H_P + (tid >> 3) * PP + 16 * (tid & 7));
        if (tid < 32) *(u32x4*)(img + HIMG_D + tid * 16) = *(const LAS u32x4*)(lds + H_D + 16 * tid);
    }
#undef HG_LOADP
    __syncthreads();
}

__device__ __forceinline__ void hgrn_scan(const Params& p, LAS unsigned char* lds, int chain) {
    int tid_o = tid_of(p.wave_id);
    const int tid = tid_o, lane = tid & 63, wave = __builtin_amdgcn_readfirstlane(tid >> 6);
    const int li = lane & 15, g = lane >> 4, qq = li >> 2, pp = li & 3;
    const int dir = chain / (BATCH * NHEAD), b = (chain / NHEAD) % BATCH, h = chain % NHEAD;
    const bf16* IA = (const bf16*)(p.ws + WS_IA) + h * HD;
    bf16* O = ((bf16*)p.out + (dir == 0 ? 0 : (size_t)ML * WA)) + h * HD + 16 * wave + li;
    const long ost = dir ? -(long)WA : (long)WA;
    const unsigned char* img0 = p.ws + WS_HIMG + (size_t)chain * NCH * HIMG_BYTES;
    f32x4 S[8];
#pragma unroll
    for (int i = 0; i < 8; ++i) S[i] = (f32x4){0.f, 0.f, 0.f, 0.f};
    u32x4 rq[2][2], rk[2][2], rp[2], rd[2], rv[2][2];
#define HS_LOAD(c_, set_) do { const int cc_ = (c_); const unsigned char* im_ = img0 + (size_t)cc_ * HIMG_BYTES; \
        if (cc_ >= 4) { rq[set_][0] = *(const u32x4*)(im_ + HIMG_QD + tid * 16); rq[set_][1] = *(const u32x4*)(im_ + HIMG_QD + (tid + 512) * 16); rp[set_] = *(const u32x4*)(im_ + HIMG_P + tid * 16); } \
        rk[set_][0] = *(const u32x4*)(im_ + HIMG_KD + tid * 16); rk[set_][1] = *(const u32x4*)(im_ + HIMG_KD + (tid + 512) * 16); \
        if (tid < 32) rd[set_] = *(const u32x4*)(im_ + HIMG_D + tid * 16); \
        _Pragma("unroll") for (int e = 0; e < 2; ++e) { const int idx_ = tid * 2 + e; const size_t row_ = hg_row(dir, b, 64 * cc_ + (idx_ >> 4)); rv[set_][e] = *(const u32x4*)(IA + row_ * WA + 8 * (idx_ & 15)); } } while (0)
#define HS_STORE(c_, set_) do { const int cc_ = (c_); LAS unsigned char* bb_ = lds + (cc_ & 1) * SB_BYTES; \
        if (cc_ >= 4) { *(LAS u32x4*)(bb_ + SB_QD + (tid >> 3) * HP + 16 * (tid & 7)) = rq[set_][0]; *(LAS u32x4*)(bb_ + SB_QD + ((tid >> 3) + 64) * HP + 16 * (tid & 7)) = rq[set_][1]; \
                        *(LAS u32x4*)(bb_ + SB_P + (tid >> 3) * PP + 16 * (tid & 7)) = rp[set_]; } \
        { LAS unsigned char* k0_ = bb_ + SB_KD + (tid >> 3) * HPK + 16 * (tid & 7); LAS unsigned char* k1_ = k0_ + 64 * HPK; \
          *(LAS u32x2*)k0_ = (u32x2){rk[set_][0].x, rk[set_][0].y}; *(LAS u32x2*)(k0_ + 8) = (u32x2){rk[set_][0].z, rk[set_][0].w}; *(LAS u32x2*)k1_ = (u32x2){rk[set_][1].x, rk[set_][1].y}; *(LAS u32x2*)(k1_ + 8) = (u32x2){rk[set_][1].z, rk[set_][1].w}; } \
        if (tid < 32) *(LAS u32x4*)(bb_ + SB_D + 16 * tid) = rd[set_]; \
        _Pragma("unroll") for (int e = 0; e < 2; ++e) { const int idx_ = tid * 2 + e; *(LAS u32x4*)(bb_ + SB_V + (idx_ >> 4) * VP + 16 * (idx_ & 15)) = rv[set_][e]; } } while (0)
    HS_LOAD(0, 0); HS_LOAD(1, 1);
    HS_STORE(0, 0);
    HS_LOAD(2, 0);
    ATT_BAR();
#pragma unroll 1
    for (int c2 = 0; c2 < NCH; c2 += 2) {
#pragma unroll
    for (int uu = 0; uu < 2; ++uu) { const int c = c2 + uu;
        const LAS unsigned char* bb = lds + (c & 1) * SB_BYTES;
        const bool lat = (c >= 4);
        bf16x8 vf[2];
#pragma unroll
        for (int sp = 0; sp < 2; ++sp) {
            const LAS unsigned char* vb0 = bb + SB_V + (32 * sp + 4 * g + qq) * VP + (16 * wave + 4 * pp) * 2;
            vf[sp] = cat8(lds_tr(vb0), lds_tr(vb0 + 16 * VP));
        }
        if (lat) {
            bf16x8 sb[4];
#pragma unroll
            for (int ks = 0; ks < 4; ++ks) sb[ks] = pack_p(S[2 * ks], S[2 * ks + 1]);
            bf16* orow = O + (long)hg_row(dir, b, 64 * c) * WA;
#pragma unroll
            for (int I = 0; I < 4; ++I) {
                f32x4 o = (f32x4){0.f, 0.f, 0.f, 0.f};
#pragma unroll
                for (int ks = 0; ks < 4; ++ks) {
                    const LAS unsigned char* ap = bb + SB_QD + (32 * ks + 4 * g + qq) * HP + (16 * I + 4 * pp) * 2;
                    o = __builtin_amdgcn_mfma_f32_16x16x32_bf16(cat8(lds_tr(ap), lds_tr(ap + 16 * HP)), sb[ks], o, 0, 0, 0);
                }
#pragma unroll
                for (int sp = 0; sp < 2; ++sp) {
                    if (2 * sp > I) break;
                    const LAS unsigned char* pr = bb + SB_P + (16 * I + li) * PP + (32 * sp + 4 * g) * 2;
                    const u32x2 lo = *(const LAS u32x2*)pr; u32x2 hi = (u32x2){0u, 0u};
                    if (2 * sp + 1 <= I) hi = *(const LAS u32x2*)(pr + 32);
                    o = __builtin_amdgcn_mfma_f32_16x16x32_bf16(cat8u(lo, hi), vf[sp], o, 0, 0, 0);
                }
#pragma unroll
                for (int j = 0; j < 4; ++j) orow[(long)(16 * I + 4 * g + j) * ost] = (bf16)f2bf(o[j]);
            }
        }
#pragma unroll
        for (int blk = 0; blk < 8; ++blk) {
            const f32x4 d4 = *(const LAS f32x4*)(bb + SB_D + (16 * blk + 4 * g) * 4);
            f32x4 s = S[blk] * d4;
#pragma unroll
            for (int sp = 0; sp < 2; ++sp) {
                const LAS unsigned char* kp = bb + SB_KD + (16 * blk + li) * HPK + (32 * sp + 4 * g) * 2;
                s = __builtin_amdgcn_mfma_f32_16x16x32_bf16(cat8u(*(const LAS u32x2*)kp, *(const LAS u32x2*)(kp + 32)), vf[sp], s, 0, 0, 0);
            }
            S[blk] = s;
        }
        if (c + 1 < NCH) HS_STORE(c + 1, (uu + 1) & 1);
        if (c + 3 < NCH) HS_LOAD(c + 3, (uu + 1) & 1);
        ATT_BAR();
    } }
#undef HS_LOAD
#undef HS_STORE
    __syncthreads();
}

__device__ __forceinline__ void phase_readout(const Params& p, int vb, int nb) {
    const int tid = tid_of(p.wave_id), lane = tid & 63, wave = p.wave_id;
    const bf16* OF = (const bf16*)p.out; const bf16* OB = OF + (size_t)ML * WA; const bf16* GA = (const bf16*)(p.ws + WS_GA);
    bf16* YA = (bf16*)p.out + (size_t)2 * ML * WA;
    f32x4 ng[4];
#pragma unroll
    for (int i = 0; i < 4; ++i) ng[i] = *(const f32x4*)(p.hgrn_norm_g + 16 * (lane & 7) + 4 * i);
    const int NGW = nb * 8;
    for (int row0 = vb * 8 + wave; row0 < ML; row0 += 2 * NGW) {
        u32x4 a[2][2], b[2][2], gg[2][2];
#pragma unroll
        for (int u = 0; u < 2; ++u) { const int row = row0 + u * NGW; if (row < ML) { const size_t off = (size_t)row * WA + 16 * lane;
            a[u][0] = *(const u32x4*)(OF + off); a[u][1] = *(const u32x4*)(OF + off + 8); b[u][0] = *(const u32x4*)(OB + off); b[u][1] = *(const u32x4*)(OB + off + 8);
            gg[u][0] = *(const u32x4*)(GA + off); gg[u][1] = *(const u32x4*)(GA + off + 8); } }
#pragma unroll
        for (int u = 0; u < 2; ++u) { const int row = row0 + u * NGW; if (row < ML) { const size_t off = (size_t)row * WA + 16 * lane;
            float o[16]; float ss = 0.f;
#pragma unroll
            for (int q = 0; q < 8; ++q) { const unsigned wa = a[u][q >> 2][q & 3], wb = b[u][q >> 2][q & 3]; o[2 * q] = bflo(wa) + bflo(wb); o[2 * q + 1] = bfhi(wa) + bfhi(wb); ss += o[2 * q] * o[2 * q] + o[2 * q + 1] * o[2 * q + 1]; }
            ss += __shfl_xor(ss, 1); ss += __shfl_xor(ss, 2); ss += __shfl_xor(ss, 4);
            const float rstd = __builtin_amdgcn_rsqf(ss * (1.0f / HD) + EPS);
            u32x4 w[2];
#pragma unroll
            for (int q = 0; q < 8; ++q) { const unsigned wg = gg[u][q >> 2][q & 3];
                w[q >> 2][q & 3] = pk2(o[2 * q] * rstd * ng[q >> 1][(2 * q) & 3] * bflo(wg), o[2 * q + 1] * rstd * ng[q >> 1][(2 * q + 1) & 3] * bfhi(wg)); }
            *(u32x4*)(YA + off) = w[0]; *(u32x4*)(YA + off + 8) = w[1]; } }
    }
}

__device__ __forceinline__ void phase_bias2(const Params& p, int vb, int nb) {
    const int tid = tid_of(p.wave_id); const float* mod = (const float*)(p.ws + WS_MOD); float* bias2 = (float*)(p.ws + WS_BIAS2);
    constexpr int NCC = 2 * FFN / 512, NKC = D_MODEL / 64;
    for (int item = vb; item < NCC * NKC; item += nb) {
        const int cc = item % NCC, kc = item / NCC; const int col = cc * 512 + tid;
        const float* W = (col < FFN) ? p.w1 + col : p.w3 + (col - FFN);
        float a0 = 0.f, a1 = 0.f, a2 = 0.f, a3 = 0.f;
#pragma unroll 8
        for (int k = kc * 64; k < kc * 64 + 64; ++k) { const float w = W[(size_t)k * FFN];
            a0 += w * mod[0 * IN_COLS + 3 * D_MODEL + k]; a1 += w * mod[1 * IN_COLS + 3 * D_MODEL + k]; a2 += w * mod[2 * IN_COLS + 3 * D_MODEL + k]; a3 += w * mod[3 * IN_COLS + 3 * D_MODEL + k]; }
        atomicAdd(bias2 + 0 * 2 * FFN + col, a0); atomicAdd(bias2 + 1 * 2 * FFN + col, a1); atomicAdd(bias2 + 2 * 2 * FFN + col, a2); atomicAdd(bias2 + 3 * 2 * FFN + col, a3);
    }
}

constexpr int LDS_MISC_OFF = 145408;
constexpr int LDS_BYTES = 146432;
static_assert(WS_BAR + XCD_BAR_WORDS * 4 <= WS_ROWSQ, "barrier words inside ctl");

#if defined(__HIP_DEVICE_COMPILE__)
#define LOAD_P() Params p; { const __attribute__((address_space(4))) Params* q_ = (const __attribute__((address_space(4))) Params*)__builtin_amdgcn_kernarg_segment_ptr(); asm volatile("" : "+s"(q_)); \
    p = *q_; p.wave_id = wave_id; } unsigned char* ws = p.ws; (void)ws
#else
#define LOAD_P() Params p = p_in; p.wave_id = wave_id; unsigned char* ws = p.ws; (void)ws
#endif
__global__ void __launch_bounds__(NTHREADS, 2) mega_fwd(Params p_in) {
    const int wave_id = __builtin_amdgcn_readfirstlane((int)(threadIdx.x >> 6));
    extern __shared__ __attribute__((aligned(16))) unsigned char lds_raw[];
    LAS unsigned char* lds = (LAS unsigned char*)lds_raw;
    const int nb = gridDim.x;
    const int vb = (nb % 8 == 0) ? ((int)(blockIdx.x % 8) * (nb / 8) + (int)(blockIdx.x / 8)) : (int)blockIdx.x;
    const int bx = blockIdx.x;
    volatile LAS unsigned* misc = (volatile LAS unsigned*)(lds + LDS_MISC_OFF);
    if (wave_id == 0) misc[lane_id()] = 0u;
    __syncthreads();
    XcdBarrier bar = xcd_barrier_post((unsigned*)(p_in.ws + WS_BAR), misc + 8, wave_id);
#define GRID_BAR() xcd_barrier(bar)

    { LOAD_P(); phase_mod(p, lds, vb, nb); __syncthreads(); phase_wconv_in(p, lds, vb * 8 + wave_id, nb * 8); }
    GRID_BAR();
    { LOAD_P(); phase_h(p, vb, nb); }
    GRID_BAR();
    { LOAD_P(); pg8::Gemm g{(const bf16*)(ws + WS_H), (const bf16*)(ws + WS_WINT), MT, IN_COLS, D_MODEL}; InProjOrder S; S.init(ML, IN_COLS, nb, bx);
      EpiInProj E{ws, lds, p.q_norm_g, p.k_norm_g}; pg8::gemm_phase<EpiInProj, InProjOrder, true, true>(lds, g, S, E, wave_id);
      const int nfree = nb - CTX_UNITS;
      if (nfree >= 64) { if (bx >= CTX_UNITS) phase_wconv_rest(p, lds, (bx - CTX_UNITS) * 8 + wave_id, nfree * 8); }
      else phase_wconv_rest(p, lds, bx * 8 + wave_id, nb * 8); }
    GRID_BAR();
    { LOAD_P(); hgrn_prep(p, lds, vb, nb); }
    GRID_BAR();
    { LOAD_P();
      if (bx < 2 * BATCH * NHEAD) hgrn_scan(p, lds, bx);
      __syncthreads();
      phase_attn(p, lds); }
    GRID_BAR();
    { LOAD_P(); phase_readout(p, vb, nb); }
    GRID_BAR();
    { LOAD_P(); pg8::Gemm g{(const bf16*)p.out + (size_t)2 * ML * WA, (const bf16*)(ws + WS_WAT), ML, D_MODEL, WA};
      MergeOrder S; S.init(ML, D_MODEL, nb, bx); S.A1 = (const bf16*)p.out + (size_t)3 * ML * WA; S.B1 = (const bf16*)(ws + WS_WBT);
      EpiMerge E{ws, (float*)(ws + WS_T1)}; pg8::gemm_phase<EpiMerge, MergeOrder, true, true>(lds, g, S, E, wave_id); }
    GRID_BAR();
    { LOAD_P(); pg8::Gemm g{(const bf16*)(ws + WS_Z), (const bf16*)(ws + WS_WOT), ML, D_MODEL, D_MODEL}; pg8::StaticOrder S; S.init(ML, D_MODEL, nb, bx);
      EpiOutProj E{ws, p.x, p.norm2_g, p.out}; pg8::gemm_phase<EpiOutProj, pg8::StaticOrder, true, true>(lds, g, S, E, wave_id); }
    GRID_BAR();
    { LOAD_P(); pg8::Gemm g{(const bf16*)(ws + WS_XMG), (const bf16*)(ws + WS_W13T), ML, 2 * FFN, D_MODEL}; pg8::StaticOrder S; S.init(ML, 2 * FFN, nb, bx);
      EpiFfnUp E{ws, lds, p.conv_w, p.conv_b}; pg8::gemm_phase<EpiFfnUp, pg8::StaticOrder, true, true>(lds, g, S, E, wave_id); }
    GRID_BAR();
    { LOAD_P(); { pg8::StaticOrder S0; S0.init(ML, D_MODEL, nb, bx); pg8::Unit u0; const int tid = tid_of(wave_id); for (int i = 0; S0.next(i, u0); ++i) halo_fix(p, u0.pm, tid); }
      asm volatile("s_waitcnt vmcnt(0)" ::: "memory"); __syncthreads();
      pg8::Gemm g{(const bf16*)(ws + WS_ACT), (const bf16*)(ws + WS_W2T), ML, D_MODEL, FFN}; pg8::StaticOrder S; S.init(ML, D_MODEL, nb, bx);
      EpiFfnDown E{ws, p.out}; pg8::gemm_phase<EpiFfnDown, pg8::StaticOrder, true, true>(lds, g, S, E, wave_id); }
#undef GRID_BAR
}

extern "C" void kernel_launch(void* const* d_in, const int* in_sizes, int n_in, void* d_out, int out_size, void* d_ws, size_t ws_size, hipStream_t stream) {
    static int grid = 0;
    if (grid == 0) {
        if (n_in != 22 || ws_size < WS_END || out_size != ML * D_MODEL) { fprintf(stderr, "kernel_launch: bad inputs (n_in %d, out %d, ws %zu, need %zu)\n", n_in, out_size, ws_size, (size_t)WS_END); grid = -1; return; }
        int dev = 0, cus = 0, per_cu = 0;
        if (hipGetDevice(&dev) != hipSuccess || hipDeviceGetAttribute(&cus, hipDeviceAttributeMultiprocessorCount, dev) != hipSuccess) { grid = -1; return; }
        if (hipFuncSetAttribute((const void*)mega_fwd, hipFuncAttributeMaxDynamicSharedMemorySize, LDS_BYTES) != hipSuccess) { fprintf(stderr, "kernel_launch: hipFuncSetAttribute failed\n"); grid = -1; return; }
        if (hipOccupancyMaxActiveBlocksPerMultiprocessor(&per_cu, (const void*)mega_fwd, NTHREADS, LDS_BYTES) != hipSuccess || per_cu < 1) { fprintf(stderr, "kernel_launch: occupancy query says %d blocks/CU\n", per_cu); (void)hipGetLastError(); grid = -1; return; }
        grid = cus;
        fprintf(stderr, "kernel_launch: grid %d (cus %d, occupancy %d/CU)\n", grid, cus, per_cu);
    }
    if (grid < 0) return;
    Params p{};
    const float** f = (const float**)&p;
    for (int i = 0; i < 22; ++i) f[i] = (const float*)d_in[i];
    p.out = (float*)d_out; p.ws = (unsigned char*)d_ws;
    (void)hipMemsetAsync((char*)d_ws + WS_CTL, 0, CTL_ZERO_BYTES, stream);
    hipLaunchKernelGGL(mega_fwd, dim3(grid), dim3(NTHREADS), LDS_BYTES, stream, p);
}
```

```cpp
#include <hip/hip_runtime.h>
#include <cstdio>
#include <cstdint>
#include <cmath>

__device__ __forceinline__ int lane_id() { int l; asm volatile("v_mbcnt_lo_u32_b32 %0, -1, 0\n\tv_mbcnt_hi_u32_b32 %0, -1, %0" : "=v"(l)); return l; }
__device__ __forceinline__ int tid_of(int wave_id) { int t = wave_id * 64 + lane_id(); asm volatile("" : "+v"(t)); return t; }
namespace pg8 {
#define PG8_LAS __attribute__((address_space(3)))
typedef unsigned short bf16_t;
typedef short bf16x8 __attribute__((ext_vector_type(8)));
typedef float f32x4 __attribute__((ext_vector_type(4)));
typedef unsigned u32x4 __attribute__((ext_vector_type(4)));
constexpr int BM = 256, BK = 64, HALF = 128, HTB = HALF * BK * 2  , STAGE_BYTES = 8 * HTB, NXCD = 8, WGM = 8;

__host__ __device__ __forceinline__ int lds_byte(int r, int c) { const int st = (r >> 4) * 2 + (c >> 5), rr = r & 15, cc = c & 31, ob = rr * 64 + cc * 2; return st * 1024 + (ob ^ (((ob >> 9) & 1) << 5)); }
__host__ __device__ __forceinline__ void stage_rc(int b, int& R, int& C) { const int st = b / 1024, sb = b % 1024, swz = sb ^ (((sb >> 9) & 1) << 5); R = (st >> 1) * 16 + swz / 64; C = (st & 1) * 32 + (swz % 64) / 2; }
__host__ __device__ __forceinline__ int perm32(int rho) { const int n = rho >> 4, i = rho & 15; return 8 * (i >> 2) + 4 * n + (i & 3); }

struct Unit { int pm, pn, br; };
struct Gemm { const bf16_t* A; const bf16_t* Bt; int M, N, K; };

struct StaticOrder {
    int nM, nN, nwg, G, c;
    __host__ __device__ void init(int M, int N, int G_, int c_) { nM = M / BM; nN = N / BM; nwg = nM * nN; G = G_; c = c_; }
    __host__ __device__ bool next(int i, Unit& u) const {
        const long L = (long)i * G + c; if (L >= nwg) return false;
        int wgid = (int)L; { const int q = nwg / NXCD, r = nwg % NXCD, xcd = wgid % NXCD, off = wgid / NXCD; wgid = (xcd < r ? xcd * (q + 1) : r * (q + 1) + (xcd - r) * q) + off; }
        const int nig = WGM * nN, gid = wgid / nig, fm = gid * WGM, gsz = (nM - fm) < WGM ? (nM - fm) : WGM;
        u.pm = fm + ((wgid % nig) % gsz); u.pn = (wgid % nig) / gsz; u.br = 0; return true;
    }
    __device__ __forceinline__ const char* a_base(const Gemm& g, const Unit& u, size_t tstep) const { return (const char*)g.A + (size_t)u.pm * tstep; }
    __device__ __forceinline__ const char* b_base(const Gemm& g, const Unit& u, size_t tstep) const { return (const char*)g.Bt + (size_t)u.pn * tstep; }
    __device__ __forceinline__ void a_ready(const Unit&) const {}
    __device__ __forceinline__ void done(const Unit&) const {}
};

template <class Epi, class Sched, bool ALIGN_EPI = false, bool SP2 = false>
__device__ __forceinline__ void gemm_phase(PG8_LAS unsigned char* lds, const Gemm g, const Sched& S, const Epi& E, const int wave_id_in) {
    int tid_o = tid_of(wave_id_in);
    const int tid = tid_o, wid = __builtin_amdgcn_readfirstlane(tid >> 6), lane = tid & 63, wr = wid >> 2, wc = wid & 3, fr = lane & 15, fq = lane >> 4;
    const int K = g.K, nt = K / BK;
    unsigned voffA[2], voffB[2];
#pragma unroll
    for (int i = 0; i < 2; ++i) { int R, C; stage_rc(tid * 16 + i * 8192, R, C); const int Rb = Epi::PERM ? ((R & ~31) + perm32(R & 31)) : R;
        voffA[i] = (unsigned)(R * K + C) * 2u; voffB[i] = (unsigned)(Rb * K + C) * 2u; }
    const size_t kstep = (size_t)(BK * 2);
    const size_t hstep = (size_t)HALF * K * 2;
    const size_t tstep = 2 * hstep;
    const unsigned ldsw = (unsigned)wid * 1024u;
    const int aoff = lds_byte(wr * 64 + fr, fq * 8), boff = lds_byte(wc * 32 + fr, fq * 8);
#define PG8_SA(b, h) (((b) * 2 + (h)) * HTB)
#define PG8_SB(b, h) ((4 + (b) * 2 + (h)) * HTB)
#define PG8_STAGE(bufoff, gbase, voff) do { _Pragma("unroll") for (int _i = 0; _i < 2; ++_i) \
        __builtin_amdgcn_global_load_lds((const unsigned*)((const char*)(gbase) + (voff)[_i]), (PG8_LAS unsigned*)(lds + (bufoff) + ldsw + _i * 8192), 16, 0, 0); } while (0)
#define PG8_LDA(dst, b, h) do { _Pragma("unroll") for (int m = 0; m < 4; ++m) _Pragma("unroll") for (int k = 0; k < 2; ++k) dst[m][k] = *(const PG8_LAS bf16x8*)(lds + PG8_SA(b, h) + aoff + m * 2048 + k * 1024); } while (0)
#define PG8_LDB(dst, b, h) do { _Pragma("unroll") for (int n = 0; n < 2; ++n) _Pragma("unroll") for (int k = 0; k < 2; ++k) dst[n][k] = *(const PG8_LAS bf16x8*)(lds + PG8_SB(b, h) + boff + n * 2048 + k * 1024); } while (0)
#define PG8_MMA(ai, bj, At, Bt) do { __builtin_amdgcn_s_setprio(1); _Pragma("unroll") for (int m = 0; m < 4; ++m) _Pragma("unroll") for (int n = 0; n < 2; ++n) _Pragma("unroll") for (int k = 0; k < 2; ++k) \
        acc[ai][bj][m][n] = __builtin_amdgcn_mfma_f32_16x16x32_bf16(Bt[n][k], At[m][k], acc[ai][bj][m][n], 0, 0, 0); __builtin_amdgcn_s_setprio(0); } while (0)
#define PG8_WAIT_V(n) asm volatile("s_waitcnt vmcnt(" #n ")" ::: "memory")
#define PG8_WAIT_L(n) asm volatile("s_waitcnt lgkmcnt(" #n ")" ::: "memory")
#define PG8_BAR __builtin_amdgcn_s_barrier()
#define PG8_SCHED __builtin_amdgcn_sched_barrier(0)
    Unit cur, nxt; int ui = 0;
    if (!S.next(0, cur)) return;
    f32x4 acc[2][2][4][2];
#pragma unroll
    for (int a = 0; a < 2; ++a)
#pragma unroll
        for (int b = 0; b < 2; ++b)
#pragma unroll
            for (int m = 0; m < 4; ++m)
#pragma unroll
                for (int n = 0; n < 2; ++n) acc[a][b][m][n] = (f32x4){0.f, 0.f, 0.f, 0.f};
    bf16x8 At[4][2], B0[2][2], B1[2][2];
    const char* cA = S.a_base(g, cur, tstep); const char* cB = S.b_base(g, cur, tstep);
    S.a_ready(cur);
    if constexpr (SP2) {
        PG8_STAGE(PG8_SB(0, 0), cB, voffB); PG8_STAGE(PG8_SB(0, 1), cB + hstep, voffB); PG8_STAGE(PG8_SA(0, 0), cA, voffA); PG8_STAGE(PG8_SA(0, 1), cA + hstep, voffA);
        if (wr == 1) PG8_BAR;
        PG8_WAIT_V(2); PG8_BAR;
        PG8_STAGE(PG8_SB(1, 0), cB + kstep, voffB); PG8_STAGE(PG8_SA(1, 0), cA + kstep, voffA); PG8_STAGE(PG8_SB(1, 1), cB + hstep + kstep, voffB);
        PG8_WAIT_V(6); PG8_BAR;
    } else {
        PG8_STAGE(PG8_SB(0, 0), cB, voffB); PG8_STAGE(PG8_SA(0, 0), cA, voffA); PG8_STAGE(PG8_SB(0, 1), cB + hstep, voffB); PG8_STAGE(PG8_SA(0, 1), cA + hstep, voffA);
        if (wr == 1) PG8_BAR;
        PG8_WAIT_V(4); PG8_BAR;
        PG8_STAGE(PG8_SB(1, 0), cB + kstep, voffB); PG8_STAGE(PG8_SA(1, 0), cA + kstep, voffA); PG8_STAGE(PG8_SB(1, 1), cB + hstep + kstep, voffB);
        PG8_WAIT_V(6); PG8_BAR;
    }
    for (;;) {
        const bool has_next = S.next(ui + 1, nxt);
        const char* nA = has_next ? S.a_base(g, nxt, tstep) : cA; const char* nB = has_next ? S.b_base(g, nxt, tstep) : cB;
        for (int t = 0; t < nt; t += 2) {
            const bool last = (t == nt - 2);
            const char* a1 = cA + (size_t)(t + 1) * kstep;
            const char* a2 = last ? nA : cA + (size_t)(t + 2) * kstep; const char* b2 = last ? nB : cB + (size_t)(t + 2) * kstep;
            const char* a3 = a2 + kstep; const char* b3 = b2 + kstep;
            if (last && has_next) S.a_ready(nxt);
            if constexpr (SP2) {
            PG8_LDB(B0, 0, 0); PG8_LDB(B1, 0, 1); PG8_SCHED; PG8_LDA(At, 0, 0); PG8_STAGE(PG8_SA(1, 1), a1 + hstep, voffA);
            PG8_WAIT_V(8); PG8_WAIT_L(0); PG8_BAR; PG8_MMA(0, 0, At, B0); PG8_MMA(0, 1, At, B1); PG8_BAR; PG8_SCHED;
            PG8_LDA(At, 0, 1); PG8_STAGE(PG8_SB(0, 0), b2, voffB); PG8_STAGE(PG8_SB(0, 1), b2 + hstep, voffB); PG8_STAGE(PG8_SA(0, 0), a2, voffA);
            PG8_WAIT_V(8); PG8_WAIT_L(0); PG8_BAR; PG8_MMA(1, 0, At, B0); PG8_MMA(1, 1, At, B1); PG8_BAR; PG8_SCHED;
            PG8_LDB(B0, 1, 0); PG8_LDB(B1, 1, 1); PG8_SCHED; PG8_LDA(At, 1, 0); PG8_STAGE(PG8_SA(0, 1), a2 + hstep, voffA);
            PG8_WAIT_V(8); PG8_WAIT_L(0); PG8_BAR; PG8_MMA(0, 0, At, B0); PG8_MMA(0, 1, At, B1); PG8_BAR; PG8_SCHED;
            PG8_LDA(At, 1, 1); PG8_STAGE(PG8_SB(1, 0), b3, voffB); PG8_STAGE(PG8_SB(1, 1), b3 + hstep, voffB); PG8_STAGE(PG8_SA(1, 0), a3, voffA);
            PG8_WAIT_V(8); PG8_WAIT_L(0); PG8_BAR; PG8_MMA(1, 0, At, B0); PG8_MMA(1, 1, At, B1); PG8_BAR; PG8_SCHED;
            } else {
            PG8_LDB(B0, 0, 0); PG8_SCHED; PG8_LDA(At, 0, 0); PG8_STAGE(PG8_SA(1, 1), a1 + hstep, voffA);
            PG8_WAIT_L(8); PG8_BAR; PG8_WAIT_L(0); PG8_MMA(0, 0, At, B0); PG8_BAR; PG8_SCHED;
            PG8_LDB(B1, 0, 1); PG8_STAGE(PG8_SB(0, 0), b2, voffB);
            PG8_BAR; PG8_WAIT_L(0); PG8_MMA(0, 1, At, B1); PG8_BAR;
            PG8_LDA(At, 0, 1); PG8_STAGE(PG8_SA(0, 0), a2, voffA);
            PG8_BAR; PG8_WAIT_L(0); PG8_MMA(1, 0, At, B0); PG8_BAR; PG8_SCHED;
            PG8_STAGE(PG8_SB(0, 1), b2 + hstep, voffB);
            PG8_WAIT_V(6); PG8_BAR; PG8_MMA(1, 1, At, B1); PG8_BAR;
            PG8_LDB(B0, 1, 0); PG8_SCHED; PG8_LDA(At, 1, 0); PG8_STAGE(PG8_SA(0, 1), a2 + hstep, voffA);
            PG8_WAIT_L(8); PG8_BAR; PG8_WAIT_L(0); PG8_MMA(0, 0, At, B0); PG8_BAR; PG8_SCHED;
            PG8_LDB(B1, 1, 1); PG8_STAGE(PG8_SB(1, 0), b3, voffB);
            PG8_BAR; PG8_WAIT_L(0); PG8_MMA(0, 1, At, B1); PG8_BAR;
            PG8_LDA(At, 1, 1); PG8_STAGE(PG8_SA(1, 0), a3, voffA);
            PG8_BAR; PG8_WAIT_L(0); PG8_MMA(1, 0, At, B0); PG8_BAR; PG8_SCHED;
            PG8_STAGE(PG8_SB(1, 1), b3 + hstep, voffB);
            PG8_WAIT_V(6); PG8_BAR; PG8_MMA(1, 1, At, B1); PG8_BAR;
            }
        }
        if constexpr (ALIGN_EPI) { if (wr == 0) PG8_BAR; }
        if constexpr (!Epi::AFTER_DRAIN) { E(acc, cur, wr, wc, fr, fq); S.done(cur); }
        if (!has_next) break;
#pragma unroll
        for (int a = 0; a < 2; ++a)
#pragma unroll
            for (int b = 0; b < 2; ++b)
#pragma unroll
                for (int m = 0; m < 4; ++m)
#pragma unroll
                    for (int n = 0; n < 2; ++n) acc[a][b][m][n] = (f32x4){0.f, 0.f, 0.f, 0.f};
        cur = nxt; cA = nA; cB = nB; ++ui;
        if constexpr (ALIGN_EPI) { if (wr == 1) PG8_BAR; }
    }
    PG8_WAIT_V(0);
    if constexpr (!ALIGN_EPI) { if (wr == 0) PG8_BAR; }
    PG8_BAR;
    if constexpr (Epi::AFTER_DRAIN) { E.fused(acc, cur, wr, wc, fr, fq, lds, wid, lane); S.done(cur); }
#undef PG8_SA
#undef PG8_SB
#undef PG8_STAGE
#undef PG8_LDA
#undef PG8_LDB
#undef PG8_MMA
#undef PG8_WAIT_V
#undef PG8_WAIT_L
#undef PG8_BAR
#undef PG8_SCHED
}
}

constexpr int D_MODEL = 2048, BATCH = 4, SEQ = 2048, CTX = 256, GRID_W = 64, NHEAD = 8, HD = 128, WA = 1024;
constexpr int FFN = 5632, IN_COLS = 12288, NMOD = 6;
constexpr int ML = BATCH * SEQ;
constexpr int MC = BATCH * CTX;
constexpr int MT = ML + MC;
constexpr float EPS = 1e-6f;
constexpr int NTHREADS = 512;
constexpr int VT_PITCH = SEQ + CTX;

typedef unsigned short bf16;
typedef float f32x4 __attribute__((ext_vector_type(4)));
typedef unsigned u32x2 __attribute__((ext_vector_type(2)));
typedef unsigned u32x4 __attribute__((ext_vector_type(4)));
#define LAS __attribute__((address_space(3)))

typedef float f32x2_t __attribute__((ext_vector_type(2)));
typedef __bf16 bf16x2_t __attribute__((ext_vector_type(2)));
__device__ __forceinline__ unsigned pk2(float lo, float hi) { const f32x2_t v = {lo, hi}; const bf16x2_t b = __builtin_convertvector(v, bf16x2_t); return __builtin_bit_cast(unsigned, b); }
__device__ __forceinline__ unsigned f2bf(float f) { return pk2(f, 0.f) & 0xffffu; }
__device__ __forceinline__ float bf2f(unsigned short h) { return __builtin_bit_cast(float, (unsigned)h << 16); }
__device__ __forceinline__ float bflo(unsigned w) { return __builtin_bit_cast(float, w << 16); }
__device__ __forceinline__ float bfhi(unsigned w) { return __builtin_bit_cast(float, w & 0xffff0000u); }
__device__ __forceinline__ float sigmoidf_(float x) { return __builtin_amdgcn_rcpf(1.0f + __expf(-x)); }
__device__ __forceinline__ float siluf_(float x) { return x * __builtin_amdgcn_rcpf(1.0f + __expf(-x)); }
__device__ __forceinline__ float wave_sum(float v) {
#pragma unroll
    for (int o = 1; o < 64; o <<= 1) v += __shfl_xor(v, o);
    return v;
}
__device__ __forceinline__ float wave_max(float v) {
#pragma unroll
    for (int o = 1; o < 64; o <<= 1) v = fmaxf(v, __shfl_xor(v, o));
    return v;
}

constexpr size_t al256(size_t x) { return (x + 255) & ~(size_t)255; }
constexpr size_t WS_CTL   = 0;
constexpr size_t CTL_ZERO_BYTES = 1u << 20;
constexpr size_t WS_ROWSQ = 64 * 1024;
constexpr size_t WS_BIAS2 = WS_ROWSQ + (size_t)ML * 4;
static_assert(WS_BIAS2 + (size_t)4 * 2 * FFN * 4 <= CTL_ZERO_BYTES, "ctl");
constexpr size_t WS_MOD   = CTL_ZERO_BYTES;
constexpr size_t WS_LB    = al256(WS_MOD + (size_t)5 * IN_COLS * 4);
constexpr size_t WS_ROPE  = al256(WS_LB + 2 * WA * 4);
constexpr size_t WS_SMALL_END = al256(WS_ROPE + 2 * 64 * 32 * 4);
constexpr size_t WS_W13T  = al256(WS_SMALL_END);
constexpr size_t WS_W2T   = WS_W13T + (size_t)2 * FFN * D_MODEL * 2;
constexpr size_t WS_WAT   = WS_W2T + (size_t)D_MODEL * FFN * 2;
constexpr size_t WS_WBT   = WS_WAT + (size_t)D_MODEL * WA * 2;
constexpr size_t WS_WOT   = WS_WBT + (size_t)D_MODEL * WA * 2;
constexpr size_t WS_A_END = WS_WOT + (size_t)D_MODEL * D_MODEL * 2;
constexpr size_t SEGB = (size_t)MT * WA * 2;
constexpr size_t WS_QA  = WS_A_END;
constexpr size_t WS_FW  = WS_QA + SEGB;
constexpr size_t WS_FB  = WS_FW + 2 * SEGB;
constexpr size_t WS_IA  = WS_FB + 2 * SEGB;
constexpr size_t WS_GA  = WS_IA + SEGB;
constexpr size_t WS_QN  = WS_GA + (size_t)ML * WA * 2;
constexpr size_t WS_KN  = WS_QN + (size_t)ML * WA * 2;
constexpr size_t WS_VN  = WS_KN + SEGB;
constexpr size_t WS_GTA = WS_VN + SEGB;
constexpr size_t WS_GTB = WS_GTA + (size_t)ML * D_MODEL * 2;
constexpr size_t WS_D_END = WS_GTB + (size_t)ML * D_MODEL * 2;
constexpr size_t WS_WINT = WS_D_END;
constexpr size_t WS_OF   = WS_WINT;
constexpr size_t WS_OB   = WS_OF + (size_t)ML * WA * 2;
constexpr size_t WS_B_END = WS_WINT + (size_t)IN_COLS * D_MODEL * 2;
static_assert(WS_OB + (size_t)ML * WA * 2 <= WS_B_END, "B");
constexpr size_t WS_H   = WS_B_END;
constexpr size_t WS_YA  = WS_H;
constexpr size_t WS_YB  = WS_YA + (size_t)ML * WA * 2;
constexpr size_t WS_C_END = WS_H + (size_t)MT * D_MODEL * 2;
constexpr size_t WS_ACT_END = WS_D_END + (size_t)ML * FFN * 2;
constexpr size_t WS_HIMG = WS_WINT;
constexpr size_t WS_HIMG_END = WS_HIMG + (size_t)64 * 36 * 41472;
constexpr size_t WS_T1 = WS_WINT;
constexpr size_t WS_END0 = WS_C_END > WS_ACT_END ? WS_C_END : WS_ACT_END;
constexpr size_t WS_END = WS_END0 > WS_HIMG_END ? WS_END0 : WS_HIMG_END;
static_assert(WS_END <= 445000000, "ws budget");
constexpr size_t WS_Z   = WS_QA;
constexpr size_t WS_XMG = WS_GTB;
constexpr size_t WS_HALO = WS_QA;
static_assert(WS_HALO + (size_t)32 * 6 * FFN * 4 <= WS_XMG, "HALO overlay");
constexpr size_t WS_ACT = WS_WINT;
static_assert(WS_ACT + (size_t)ML * FFN * 2 <= WS_END, "ACT overlay");

struct Params {
    const float *x, *c, *ctx, *c_ctx, *ada_w, *ada_b, *norm1_g, *norm2_g, *w_in, *lb_logits, *hgrn_norm_g, *q_norm_g, *k_norm_g, *rel_bias,
                *w_a, *w_b, *w_o, *w1, *w3, *conv_w, *conv_b, *w2;
    float* out;
    unsigned char* ws;
    int wave_id, pad;
};

template <bool QKPERM, bool BIAS>
__device__ __forceinline__ void transpose_item(const float* W, int K, int N, bf16* WT, int row_off, LAS float* scr, int item, int lane, const float* sh2 = nullptr, float* bias2 = nullptr) {
    const int nblk = N / 32, kb = item / nblk, nb = item % nblk, k0 = 64 * kb, n0 = 32 * nb;
    if (BIAS) row_off += (n0 >> 7) * 128;
    float wv[32];
#pragma unroll
    for (int i = 0; i < 32; ++i) wv[i] = __builtin_nontemporal_load(W + (size_t)(k0 + 2 * i + (lane >> 5)) * N + n0 + (lane & 31));
#pragma unroll
    for (int i = 0; i < 32; ++i) scr[(2 * i + (lane >> 5)) * 33 + (lane & 31)] = wv[i];
    if (BIAS) {
        float a0 = 0.f, a1 = 0.f, a2 = 0.f, a3 = 0.f;
#pragma unroll
        for (int i = 0; i < 32; ++i) { const int k = k0 + 2 * i + (lane >> 5); const float w = wv[i];
            a0 += w * sh2[0 * IN_COLS + k]; a1 += w * sh2[1 * IN_COLS + k]; a2 += w * sh2[2 * IN_COLS + k]; a3 += w * sh2[3 * IN_COLS + k]; }
        a0 += __shfl_xor(a0, 32); a1 += __shfl_xor(a1, 32); a2 += __shfl_xor(a2, 32); a3 += __shfl_xor(a3, 32);
        if (lane < 32) { float* bp = bias2 + row_off + n0 + lane; atomicAdd(bp, a0); atomicAdd(bp + 2 * FFN, a1); atomicAdd(bp + 4 * FFN, a2); atomicAdd(bp + 6 * FFN, a3); }
    }
    asm volatile("s_waitcnt lgkmcnt(0)" ::: "memory");
    const int c = lane & 7;
#pragma unroll
    for (int j = 0; j < 4; ++j) { const int n = (lane >> 3) + 8 * j; const LAS float* s = scr + (8 * c) * 33 + n;
        u32x4 o; o.x = pk2(s[0 * 33], s[1 * 33]); o.y = pk2(s[2 * 33], s[3 * 33]); o.z = pk2(s[4 * 33], s[5 * 33]); o.w = pk2(s[6 * 33], s[7 * 33]);
        int cdst = n0 + n;
        if (QKPERM && cdst >= 5 * WA && cdst < 7 * WA) cdst = (cdst & ~0x30) | ((cdst & 0x10) << 1) | ((cdst & 0x20) >> 1);
        *(u32x4*)(WT + (size_t)(row_off + cdst) * K + k0 + 8 * c) = o; }
    asm volatile("s_waitcnt lgkmcnt(0)" ::: "memory");
}
__device__ __forceinline__ void phase_wconv_in(const Params& p, LAS unsigned char* lds, int gw, int NGW) {
    const int lane = lane_id(), wave = p.wave_id;
    LAS float* scr = (LAS float*)(lds + wave * 16384);
    constexpr int I_IN = (D_MODEL / 64) * (IN_COLS / 32);
    for (int it = gw; it < I_IN; it += NGW) transpose_item<true, false>(p.w_in, D_MODEL, IN_COLS, (bf16*)(p.ws + WS_WINT), 0, scr, it, lane);
}
__device__ __forceinline__ void phase_wconv_rest(const Params& p, LAS unsigned char* lds, int gw, int NGW) {
    const int lane = lane_id(), wave = p.wave_id;
    LAS float* scr = (LAS float*)(lds + 16384 + wave * 16384);
    constexpr int I_A = (WA / 64) * (D_MODEL / 32), I_O = (D_MODEL / 64) * (D_MODEL / 32), I_1 = (D_MODEL / 64) * (FFN / 32), I_2 = (FFN / 64) * (D_MODEL / 32);
    constexpr int NITEMS = 2 * I_A + I_O + 2 * I_1 + I_2;
    unsigned char* ws = p.ws;
    const float* sh2 = (const float*)(ws + WS_MOD) + 3 * D_MODEL; float* b2 = (float*)(ws + WS_BIAS2);
    for (int it = gw; it < NITEMS; it += NGW) {
        int r = it;
        if (r < I_A) { transpose_item<false, false>(p.w_a, WA, D_MODEL, (bf16*)(ws + WS_WAT), 0, scr, r, lane); continue; } r -= I_A;
        if (r < I_A) { transpose_item<false, false>(p.w_b, WA, D_MODEL, (bf16*)(ws + WS_WBT), 0, scr, r, lane); continue; } r -= I_A;
        if (r < I_O) { transpose_item<false, false>(p.w_o, D_MODEL, D_MODEL, (bf16*)(ws + WS_WOT), 0, scr, r, lane); continue; } r -= I_O;
        if (r < I_1) { transpose_item<false, true>(p.w1, D_MODEL, FFN, (bf16*)(ws + WS_W13T), 0, scr, r, lane, sh2, b2); continue; } r -= I_1;
        if (r < I_1) { transpose_item<false, true>(p.w3, D_MODEL, FFN, (bf16*)(ws + WS_W13T), 128, scr, r, lane, sh2, b2); continue; } r -= I_1;
        transpose_item<false, false>(p.w2, FFN, D_MODEL, (bf16*)(ws + WS_W2T), 0, scr, r, lane);
    }
}

__device__ __forceinline__ void phase_mod(const Params& p, LAS unsigned char* lds, int vb, int nb) {
    const int tid = tid_of(p.wave_id);
    LAS float* sc = (LAS float*)lds;
    LAS float* red = (LAS float*)(lds + 5 * 2048 * 4);
    for (int i = tid; i < 5 * D_MODEL; i += NTHREADS) { const int r = i / D_MODEL, k = i % D_MODEL; const float v = (r < 4) ? p.c[r * D_MODEL + k] : p.c_ctx[k]; sc[i] = siluf_(v); }
    __syncthreads();
    float* mod = (float*)(p.ws + WS_MOD);
    const int c4 = tid & 15, kp = tid >> 4;
    for (int item = vb; item < IN_COLS / 64; item += nb) {
        const int n0 = item * 64 + c4 * 4;
        f32x4 acc[5];
#pragma unroll
        for (int r = 0; r < 5; ++r) acc[r] = (f32x4){0.f, 0.f, 0.f, 0.f};
#pragma unroll 8
        for (int k = kp; k < D_MODEL; k += 32) {
            const f32x4 w = __builtin_nontemporal_load((const f32x4*)(p.ada_w + (size_t)k * IN_COLS + n0));
#pragma unroll
            for (int r = 0; r < 5; ++r) acc[r] += w * sc[r * D_MODEL + k];
        }
#pragma unroll
        for (int r = 0; r < 5; ++r) *(LAS f32x4*)(red + (kp * 5 + r) * 64 + c4 * 4) = acc[r];
        __syncthreads();
        if (tid < 320) { const int r = tid / 64, cidx = tid % 64; float s = 0.f;
            for (int q = 0; q < 32; ++q) s += red[(q * 5 + r) * 64 + cidx];
            mod[r * IN_COLS + item * 64 + cidx] = s + p.ada_b[item * 64 + cidx]; }
        __syncthreads();
    }
    if (vb == nb - 1) { float* rt = (float*)(p.ws + WS_ROPE);
        for (int i = tid; i < 64 * 32; i += NTHREADS) { const int pos = i >> 5, j = i & 31; const float inv = exp2f(-(float)j * (13.287712379549449f / 32.0f)); float sn, cs; sincosf((float)pos * inv, &sn, &cs); rt[i] = cs; rt[2048 + i] = sn; } }
    if (vb == 0) { float* lb = (float*)(p.ws + WS_LB);
        for (int i = tid; i < 2 * WA; i += NTHREADS) { const int d = i / WA, cc = i % WA; const float l0 = p.lb_logits[d * 2 * WA + cc], l1 = p.lb_logits[d * 2 * WA + WA + cc]; lb[i] = 1.0f / (1.0f + expf(l1 - l0)); } }
}

__device__ __forceinline__ void phase_h(const Params& p, int vb, int nb) {
    const int tid = tid_of(p.wave_id), lane = tid & 63, wave = p.wave_id;
    const float* mod = (const float*)(p.ws + WS_MOD);
    bf16* H = (bf16*)(p.ws + WS_H);
    for (int m = vb * 8 + wave; m < MT; m += nb * 8) {
        const float* xr = (m < ML) ? p.x + (size_t)m * D_MODEL : p.ctx + (size_t)(m - ML) * D_MODEL;
        const int mr = (m < ML) ? (m / SEQ) : 4;
        const float* sh = mod + (size_t)mr * IN_COLS, *scl = sh + D_MODEL;
        f32x4 v[8]; float s = 0.f;
#pragma unroll
        for (int j = 0; j < 8; ++j) { v[j] = *(const f32x4*)(xr + 4 * lane + 256 * j); s += (v[j].x * v[j].x + v[j].y * v[j].y) + (v[j].z * v[j].z + v[j].w * v[j].w); }
        const float rstd = __builtin_amdgcn_rsqf(wave_sum(s) * (1.0f / D_MODEL) + EPS);
#pragma unroll
        for (int j = 0; j < 8; ++j) { const int k = 4 * lane + 256 * j;
            const f32x4 g = *(const f32x4*)(p.norm1_g + k), a = *(const f32x4*)(scl + k), b = *(const f32x4*)(sh + k);
            const f32x4 h = v[j] * rstd * g * (a + 1.0f) + b;
            u32x2 o; o.x = pk2(h.x, h.y); o.y = pk2(h.z, h.w);
            *(u32x2*)(H + (size_t)m * D_MODEL + k) = o; }
    }
}

#define EPI_LOOP_BEGIN \
    _Pragma("unroll") for (int ai = 0; ai < 2; ++ai) _Pragma("unroll") for (int m = 0; m < 4; ++m) { const int row = u.pm * 256 + ai * 128 + wr * 64 + m * 16 + fr; \
    _Pragma("unroll") for (int bj = 0; bj < 2; ++bj) _Pragma("unroll") for (int n = 0; n < 2; ++n) { const int col = u.pn * 256 + bj * 128 + wc * 32 + n * 16 + fq * 4; const f32x4 v = acc[ai][bj][m][n];
#define EPI_LOOP_END } }

struct EpiInProj {
    static constexpr bool PERM = false, AFTER_DRAIN = false;
    unsigned char* ws; LAS unsigned char* lds; const float* qg; const float* kg;
    __device__ __forceinline__ void operator()(const f32x4 (&acc)[2][2][4][2], const pg8::Unit& u, int wr, int wc, int fr, int fq) const {
        const int seg = u.pn >> 2;
        const bool ctxrow = u.pm >= ML / 256;
        const float* lb = (const float*)(ws + WS_LB);
        if (seg == 1 || seg == 2) {
            float* F = (float*)(ws + (seg == 1 ? WS_FW : WS_FB)); const float* lbd = lb + (seg - 1) * WA;
            f32x4 lbv[2][2];
#pragma unroll
            for (int bj = 0; bj < 2; ++bj)
#pragma unroll
                for (int n = 0; n < 2; ++n) lbv[bj][n] = *(const f32x4*)(lbd + u.pn * 256 + bj * 128 + wc * 32 + n * 16 + fq * 4 - seg * WA);
            EPI_LOOP_BEGIN
                const int c = col - seg * WA; const f32x4 l = lbv[bj][n]; f32x4 o;
                o.x = __logf(l.x + (1.0f - l.x) * sigmoidf_(v.x)); o.y = __logf(l.y + (1.0f - l.y) * sigmoidf_(v.y));
                o.z = __logf(l.z + (1.0f - l.z) * sigmoidf_(v.z)); o.w = __logf(l.w + (1.0f - l.w) * sigmoidf_(v.w));
                *(f32x4*)(F + (size_t)row * WA + c) = o;
            EPI_LOOP_END
        } else if (seg == 7) {
            bf16* VT = (bf16*)(ws + WS_VN);
            EPI_LOOP_BEGIN
                const int c = col - 7 * WA; const int hh = c >> 7, d = c & 127;
                int bb, tok; if (row < ML) { bb = row / SEQ; tok = row % SEQ; } else { bb = (row - ML) / CTX; tok = SEQ + (row - ML) % CTX; }
                bf16* o = VT + ((size_t)(bb * NHEAD + hh) * HD + d) * VT_PITCH + tok;
                o[0] = (bf16)f2bf(v.x); o[VT_PITCH] = (bf16)f2bf(v.y); o[2 * VT_PITCH] = (bf16)f2bf(v.z); o[3 * VT_PITCH] = (bf16)f2bf(v.w);
            EPI_LOOP_END
        } else if (seg == 5 || seg == 6) {
            if (ctxrow && seg == 5) return;
            LAS float* ssq = (LAS float*)(lds + 131072);
            const float* gn = (seg == 5) ? qg : kg; const float* rt = (const float*)(ws + WS_ROPE);
            bf16* O = (bf16*)(ws + (seg == 5 ? WS_QN : WS_KN));
#pragma unroll
            for (int ai = 0; ai < 2; ++ai)
#pragma unroll
                for (int m = 0; m < 4; ++m)
#pragma unroll
                    for (int bj = 0; bj < 2; ++bj) { const f32x4 a = acc[ai][bj][m][0], b = acc[ai][bj][m][1];
                        float sq = (a.x * a.x + a.y * a.y) + (a.z * a.z + a.w * a.w) + (b.x * b.x + b.y * b.y) + (b.z * b.z + b.w * b.w);
                        sq += __shfl_xor(sq, 16); sq += __shfl_xor(sq, 32);
                        if (fq == 0) ssq[((ai * 128 + wr * 64 + m * 16 + fr) * 2 + bj) * 4 + wc] = sq; }
            asm volatile("s_waitcnt lgkmcnt(0)" ::: "memory"); __builtin_amdgcn_s_barrier(); asm volatile("" ::: "memory");
            const int H = wc >> 1, jj = 16 * (wc & 1) + 4 * fq;
            const f32x4 g0 = *(const f32x4*)(gn + 64 * H + jj), g1 = *(const f32x4*)(gn + 64 * H + 32 + jj);
#pragma unroll
            for (int ai = 0; ai < 2; ++ai)
#pragma unroll
                for (int m = 0; m < 4; ++m) { const int rl = ai * 128 + wr * 64 + m * 16 + fr; const int row = u.pm * 256 + rl;
                    f32x4 cs = (f32x4){1.f, 1.f, 1.f, 1.f}, sn = (f32x4){0.f, 0.f, 0.f, 0.f};
                    if (!ctxrow) { const int t = row & (SEQ - 1); const int pos = (H == 0) ? (t >> 6) : (t & 63); cs = *(const f32x4*)(rt + pos * 32 + jj); sn = *(const f32x4*)(rt + 2048 + pos * 32 + jj); }
#pragma unroll
                    for (int bj = 0; bj < 2; ++bj) { const f32x4 s4 = *(const LAS f32x4*)(ssq + (rl * 2 + bj) * 4);
                        const float rstd = __builtin_amdgcn_rsqf(((s4.x + s4.y) + (s4.z + s4.w)) * (1.0f / HD) + EPS);
                        const f32x4 u1 = acc[ai][bj][m][0] * rstd * g0, u2 = acc[ai][bj][m][1] * rstd * g1;
                        const f32x4 o1 = u1 * cs - u2 * sn, o2 = u1 * sn + u2 * cs;
                        bf16* op = O + (size_t)row * WA + (u.pn & 3) * 256 + bj * 128 + wc * 32 + fq * 4;
                        u32x2 w1; w1.x = pk2(o1.x, o1.y); w1.y = pk2(o1.z, o1.w); *(u32x2*)op = w1;
                        u32x2 w2; w2.x = pk2(o2.x, o2.y); w2.y = pk2(o2.z, o2.w); *(u32x2*)(op + 16) = w2; }
                    asm volatile("" ::: "memory"); }
            asm volatile("s_waitcnt lgkmcnt(0)" ::: "memory"); __builtin_amdgcn_s_barrier(); asm volatile("" ::: "memory");
        } else if (seg == 0 || seg == 3) {
            if (ctxrow && seg == 0) return;
            bf16* O = (bf16*)(ws + (seg == 0 ? WS_QA : WS_IA));
            EPI_LOOP_BEGIN
                const int c = col - seg * WA; u32x2 o; o.x = pk2(v.x, v.y); o.y = pk2(v.z, v.w);
                *(u32x2*)(O + (size_t)row * WA + c) = o;
            EPI_LOOP_END
        } else if (seg == 4) {
            if (ctxrow) return;
            bf16* O = (bf16*)(ws + WS_GA);
            EPI_LOOP_BEGIN
                const int c = col - seg * WA; u32x2 o; o.x = pk2(siluf_(v.x), siluf_(v.y)); o.y = pk2(siluf_(v.z), siluf_(v.w));
                *(u32x2*)(O + (size_t)row * WA + c) = o;
            EPI_LOOP_END
        } else {
            if (ctxrow) return;
            const bool isa = seg < 10;
            bf16* O = (bf16*)(ws + (isa ? WS_GTA : WS_GTB)); const int cbase = isa ? 8 * WA : 10 * WA;
            EPI_LOOP_BEGIN
                const int c = col - cbase; u32x2 o; o.x = pk2(sigmoidf_(v.x), sigmoidf_(v.y)); o.y = pk2(sigmoidf_(v.z), sigmoidf_(v.w));
                *(u32x2*)(O + (size_t)row * D_MODEL + c) = o;
            EPI_LOOP_END
        }
    }
};

constexpr int CTX_UNITS = (MC / 256) * 20;
struct InProjOrder : pg8::StaticOrder {
    __device__ bool next(int i, pg8::Unit& u) const {
        if (pg8::StaticOrder::next(i, u)) return true;
        const long L = (long)i * G + c - nwg; if (L < 0 || L >= CTX_UNITS) return false;
        const int t = (int)L, j = t % 20; u.pm = ML / 256 + t / 20; u.pn = (j < 12) ? 4 + j : 12 + j; u.br = 0; return true; }
};
struct MergeOrder : pg8::StaticOrder {
    const bf16* A1; const bf16* B1;
    __device__ bool next(int i, pg8::Unit& u) const { if (!pg8::StaticOrder::next(i >> 1, u)) return false; u.br = i & 1; return true; }
    __device__ __forceinline__ const char* a_base(const pg8::Gemm& g, const pg8::Unit& u, size_t tstep) const { return (const char*)(u.br ? A1 : g.A) + (size_t)u.pm * tstep; }
    __device__ __forceinline__ const char* b_base(const pg8::Gemm& g, const pg8::Unit& u, size_t tstep) const { return (const char*)(u.br ? B1 : g.Bt) + (size_t)u.pn * tstep; }
};
#define EPI_BATCH_BEGIN _Pragma("unroll") for (int ai = 0; ai < 2; ++ai) _Pragma("unroll") for (int mh = 0; mh < 4; mh += 2) {
#define EPI_BATCH_END }
#define EPI_VEC_LOOP _Pragma("unroll") for (int m2 = 0; m2 < 2; ++m2) _Pragma("unroll") for (int bj = 0; bj < 2; ++bj) _Pragma("unroll") for (int n = 0; n < 2; ++n)
#define EPI_VEC_IDX const int m = mh + m2, vi = (m2 * 2 + bj) * 2 + n; const int row = u.pm * 256 + ai * 128 + wr * 64 + m * 16 + fr, col = u.pn * 256 + bj * 128 + wc * 32 + n * 16 + fq * 4; (void)vi
#define EPI_WVEC_LOOP _Pragma("unroll") for (int m2 = 0; m2 < 2; ++m2) _Pragma("unroll") for (int bj = 0; bj < 2; ++bj)
#define EPI_WVEC_IDX const int m = mh + m2, wi = m2 * 2 + bj; const int row = u.pm * 256 + ai * 128 + wr * 64 + m * 16 + fr, col = u.pn * 256 + bj * 128 + wc * 32 + fq * 8; (void)wi
struct EpiMerge {
    static constexpr bool PERM = true, AFTER_DRAIN = false;
    unsigned char* ws; float* tmp;
    __device__ __forceinline__ void operator()(const f32x4 (&acc)[2][2][4][2], const pg8::Unit& u, int wr, int wc, int fr, int fq) const {
        if (u.br == 0) {
            const bf16* G = (const bf16*)(ws + WS_GTA);
            EPI_BATCH_BEGIN
                u32x4 gv[4];
                EPI_WVEC_LOOP { EPI_WVEC_IDX; gv[wi] = *(const u32x4*)(G + (size_t)row * D_MODEL + col); }
                EPI_WVEC_LOOP { EPI_WVEC_IDX; const u32x4 g = gv[wi]; const f32x4 v0 = acc[ai][bj][m][0], v1 = acc[ai][bj][m][1];
                    f32x4 o0, o1; o0.x = bflo(g.x) * v0.x; o0.y = bfhi(g.x) * v0.y; o0.z = bflo(g.y) * v0.z; o0.w = bfhi(g.y) * v0.w;
                    o1.x = bflo(g.z) * v1.x; o1.y = bfhi(g.z) * v1.y; o1.z = bflo(g.w) * v1.z; o1.w = bfhi(g.w) * v1.w;
                    *(f32x4*)(tmp + (size_t)row * D_MODEL + col) = o0; *(f32x4*)(tmp + (size_t)row * D_MODEL + col + 4) = o1; }
            EPI_BATCH_END
        } else {
            const bf16* G = (const bf16*)(ws + WS_GTB); bf16* Z = (bf16*)(ws + WS_Z);
            EPI_BATCH_BEGIN
                u32x4 gv[4]; f32x4 tv[4][2];
                EPI_WVEC_LOOP { EPI_WVEC_IDX; gv[wi] = *(const u32x4*)(G + (size_t)row * D_MODEL + col); tv[wi][0] = *(const f32x4*)(tmp + (size_t)row * D_MODEL + col); tv[wi][1] = *(const f32x4*)(tmp + (size_t)row * D_MODEL + col + 4); }
                EPI_WVEC_LOOP { EPI_WVEC_IDX; const u32x4 g = gv[wi]; const f32x4 t0 = tv[wi][0], t1 = tv[wi][1], v0 = acc[ai][bj][m][0], v1 = acc[ai][bj][m][1];
                    u32x4 o; o.x = pk2(t0.x + bflo(g.x) * v0.x, t0.y + bfhi(g.x) * v0.y); o.y = pk2(t0.z + bflo(g.y) * v0.z, t0.w + bfhi(g.y) * v0.w);
                    o.z = pk2(t1.x + bflo(g.z) * v1.x, t1.y + bfhi(g.z) * v1.y); o.w = pk2(t1.z + bflo(g.w) * v1.z, t1.w + bfhi(g.w) * v1.w);
                    *(u32x4*)(Z + (size_t)row * D_MODEL + col) = o; }
            EPI_BATCH_END
        }
    }
};
struct EpiOutProj {
    static constexpr bool PERM = true, AFTER_DRAIN = false;
    unsigned char* ws; const float* x; const float* norm2_g; float* out;
    __device__ __forceinline__ void operator()(const f32x4 (&acc)[2][2][4][2], const pg8::Unit& u, int wr, int wc, int fr, int fq) const {
        const float* mod = (const float*)(ws + WS_MOD); bf16* XMG = (bf16*)(ws + WS_XMG); float* rowsq = (float*)(ws + WS_ROWSQ);
        const int b = (u.pm * 256) / SEQ;
        const float* g1 = mod + (size_t)b * IN_COLS + 2 * D_MODEL, *sc2 = mod + (size_t)b * IN_COLS + 4 * D_MODEL;
        f32x4 cg[2][2], ch[2][2];
#pragma unroll
        for (int bj = 0; bj < 2; ++bj)
#pragma unroll
            for (int n = 0; n < 2; ++n) { const int col = u.pn * 256 + bj * 128 + wc * 32 + fq * 8 + 4 * n; cg[bj][n] = *(const f32x4*)(g1 + col); ch[bj][n] = *(const f32x4*)(norm2_g + col) * (*(const f32x4*)(sc2 + col) + 1.0f); }
        EPI_BATCH_BEGIN
            f32x4 xv[4][2];
            EPI_WVEC_LOOP { EPI_WVEC_IDX; xv[wi][0] = *(const f32x4*)(x + (size_t)row * D_MODEL + col); xv[wi][1] = *(const f32x4*)(x + (size_t)row * D_MODEL + col + 4); }
            float ss[2] = {0.f, 0.f};
            EPI_WVEC_LOOP { EPI_WVEC_IDX; const f32x4 xm0 = xv[wi][0] + cg[bj][0] * acc[ai][bj][m][0], xm1 = xv[wi][1] + cg[bj][1] * acc[ai][bj][m][1];
                *(f32x4*)(out + (size_t)row * D_MODEL + col) = xm0; *(f32x4*)(out + (size_t)row * D_MODEL + col + 4) = xm1;
                ss[m2] += ((xm0.x * xm0.x + xm0.y * xm0.y) + (xm0.z * xm0.z + xm0.w * xm0.w)) + ((xm1.x * xm1.x + xm1.y * xm1.y) + (xm1.z * xm1.z + xm1.w * xm1.w));
                const f32x4 h0 = xm0 * ch[bj][0], h1 = xm1 * ch[bj][1];
                u32x4 o; o.x = pk2(h0.x, h0.y); o.y = pk2(h0.z, h0.w); o.z = pk2(h1.x, h1.y); o.w = pk2(h1.z, h1.w);
                *(u32x4*)(XMG + (size_t)row * D_MODEL + col) = o; }
#pragma unroll
            for (int m2 = 0; m2 < 2; ++m2) { float t = ss[m2]; t += __shfl_xor(t, 16); t += __shfl_xor(t, 32);
                if (fq == 0) atomicAdd(rowsq + u.pm * 256 + ai * 128 + wr * 64 + (mh + m2) * 16 + fr, t); }
        EPI_BATCH_END
    }
};
__device__ __forceinline__ float dpp_ror1(float v) { return __builtin_bit_cast(float, __builtin_amdgcn_update_dpp(0, __builtin_bit_cast(int, v), 0x121, 0xf, 0xf, false)); }
__device__ __forceinline__ float dpp_rol1(float v) { return __builtin_bit_cast(float, __builtin_amdgcn_update_dpp(0, __builtin_bit_cast(int, v), 0x12f, 0xf, 0xf, false)); }
__device__ __forceinline__ f32x4 ror1_4(const f32x4 v) { return (f32x4){dpp_ror1(v.x), dpp_ror1(v.y), dpp_ror1(v.z), dpp_ror1(v.w)}; }
__device__ __forceinline__ f32x4 rol1_4(const f32x4 v) { return (f32x4){dpp_rol1(v.x), dpp_rol1(v.y), dpp_rol1(v.z), dpp_rol1(v.w)}; }
struct EpiFfnUp {
    static constexpr bool PERM = true, AFTER_DRAIN = false;
    unsigned char* ws; LAS unsigned char* lds; const float* cw; const float* cb;
    __device__ __forceinline__ void operator()(const f32x4 (&acc_c)[2][2][4][2], const pg8::Unit& u, int wr, int wc, int fr, int fq) const {
        f32x4 (&acc)[2][2][4][2] = const_cast<f32x4 (&)[2][2][4][2]>(acc_c);
        asm volatile("" : "+v"(fr), "+v"(fq));
        const float* rowsq = (const float*)(ws + WS_ROWSQ); bf16* ACT = (bf16*)(ws + WS_ACT); float* HALO = (float*)(ws + WS_HALO) + (size_t)u.pm * 6 * FFN;
        const int b = (u.pm * 256) / SEQ; const float* bias2 = (const float*)(ws + WS_BIAS2) + (size_t)b * 2 * FFN + u.pn * 256;
        const int cl = wc * 32 + fq * 8, ch0 = u.pn * 128 + cl;
        LAS float* X = (LAS float*)(lds + 131072);
#pragma unroll
        for (int ai = 0; ai < 2; ++ai)
#pragma unroll
            for (int m = 0; m < 4; ++m) { const int row = u.pm * 256 + ai * 128 + wr * 64 + m * 16 + fr;
                const float rstd = __builtin_amdgcn_rsqf(rowsq[row] * (1.0f / D_MODEL) + EPS);
#pragma unroll
                for (int bj = 0; bj < 2; ++bj)
#pragma unroll
                    for (int n = 0; n < 2; ++n) acc[ai][bj][m][n] = acc[ai][bj][m][n] * rstd + *(const f32x4*)(bias2 + bj * 128 + cl + 4 * n); }
#pragma unroll
        for (int ai = 0; ai < 2; ++ai) { const int bi = 2 * ai + wr;
            if (fr == 0) {
#pragma unroll
                for (int n = 0; n < 2; ++n) *(LAS f32x4*)(X + (bi * 2 + 0) * 128 + cl + 4 * n) = acc[ai][0][0][n]; }
            if (fr == 15) {
#pragma unroll
                for (int n = 0; n < 2; ++n) *(LAS f32x4*)(X + (bi * 2 + 1) * 128 + cl + 4 * n) = acc[ai][0][3][n]; } }
        asm volatile("s_waitcnt lgkmcnt(0)" ::: "memory"); __builtin_amdgcn_s_barrier(); asm volatile("" ::: "memory");
        if (wr == 0 && fr < 2) {
#pragma unroll
            for (int n = 0; n < 2; ++n) { *(f32x4*)(HALO + (size_t)fr * FFN + ch0 + 4 * n) = acc[0][0][0][n]; if (fr == 0) *(f32x4*)(HALO + (size_t)4 * FFN + ch0 + 4 * n) = acc[0][1][0][n]; } }
        if (wr == 1 && fr >= 14) {
#pragma unroll
            for (int n = 0; n < 2; ++n) { *(f32x4*)(HALO + (size_t)(fr - 12) * FFN + ch0 + 4 * n) = acc[1][0][3][n]; if (fr == 15) *(f32x4*)(HALO + (size_t)5 * FFN + ch0 + 4 * n) = acc[1][1][3][n]; } }
        f32x4 w0[2], w1[2], w2[2], cbv[2];
#pragma unroll
        for (int n = 0; n < 2; ++n) { w0[n] = *(const f32x4*)(cw + ch0 + 4 * n); w1[n] = *(const f32x4*)(cw + FFN + ch0 + 4 * n); w2[n] = *(const f32x4*)(cw + 2 * FFN + ch0 + 4 * n); cbv[n] = *(const f32x4*)(cb + ch0 + 4 * n); }
#pragma unroll
        for (int ai = 0; ai < 2; ++ai) { const int bi = 2 * ai + wr;
#pragma unroll
            for (int m = 0; m < 4; ++m) { u32x4 o;
#pragma unroll
                for (int n = 0; n < 2; ++n) { const f32x4 cur = acc[ai][0][m][n];
                    f32x4 pu, nd;
                    if (m > 0) pu = ror1_4(acc[ai][0][m > 0 ? m - 1 : 0][n]); else pu = (bi > 0) ? *(const LAS f32x4*)(X + ((bi - 1) * 2 + 1) * 128 + cl + 4 * n) : (f32x4){0.f, 0.f, 0.f, 0.f};
                    if (m < 3) nd = rol1_4(acc[ai][0][m < 3 ? m + 1 : 3][n]); else nd = (bi < 3) ? *(const LAS f32x4*)(X + ((bi + 1) * 2 + 0) * 128 + cl + 4 * n) : (f32x4){0.f, 0.f, 0.f, 0.f};
                    const f32x4 ps = ror1_4(cur), ns = rol1_4(cur);
                    const f32x4 prev = (fr > 0) ? ps : pu, next = (fr < 15) ? ns : nd;
                    const f32x4 uu = w0[n] * prev + w1[n] * cur + w2[n] * next + cbv[n]; const f32x4 gt = acc[ai][1][m][n];
                    f32x4 r; r.x = siluf_(uu.x) * gt.x; r.y = siluf_(uu.y) * gt.y; r.z = siluf_(uu.z) * gt.z; r.w = siluf_(uu.w) * gt.w;
                    if (n == 0) { o.x = pk2(r.x, r.y); o.y = pk2(r.z, r.w); } else { o.z = pk2(r.x, r.y); o.w = pk2(r.z, r.w); } }
                const int rl = ai * 128 + wr * 64 + m * 16 + fr;
                if (rl != 0 && rl != 255) *(u32x4*)(ACT + (size_t)(u.pm * 256 + rl) * FFN + ch0) = o; } }
    }
};
__device__ __forceinline__ void halo_fix(const Params& p, int pm, int tid) {
    const float* HB = (const float*)(p.ws + WS_HALO); const float* H = HB + (size_t)pm * 6 * FFN; bf16* ACT = (bf16*)(p.ws + WS_ACT);
    for (int ch = tid; ch < FFN; ch += NTHREADS) {
        const float w0 = p.conv_w[ch], w1 = p.conv_w[FFN + ch], w2 = p.conv_w[2 * FFN + ch], cbv = p.conv_b[ch];
        const float pv = (pm & 7) ? HB[((size_t)(pm - 1) * 6 + 3) * FFN + ch] : 0.f; const float nx = ((pm & 7) != 7) ? HB[((size_t)(pm + 1) * 6 + 0) * FFN + ch] : 0.f;
        const float ut = w0 * pv + w1 * H[ch] + w2 * H[FFN + ch] + cbv; const float ub = w0 * H[2 * FFN + ch] + w1 * H[3 * FFN + ch] + w2 * nx + cbv;
        ACT[(size_t)(pm * 256) * FFN + ch] = (bf16)f2bf(siluf_(ut) * H[4 * FFN + ch]); ACT[(size_t)(pm * 256 + 255) * FFN + ch] = (bf16)f2bf(siluf_(ub) * H[5 * FFN + ch]);
    }
}
struct EpiFfnDown {
    static constexpr bool PERM = true, AFTER_DRAIN = false;
    unsigned char* ws; float* out;
    __device__ __forceinline__ void operator()(const f32x4 (&acc)[2][2][4][2], const pg8::Unit& u, int wr, int wc, int fr, int fq) const {
        const float* mod = (const float*)(ws + WS_MOD); const int b = (u.pm * 256) / SEQ; const float* g2 = mod + (size_t)b * IN_COLS + 5 * D_MODEL;
        f32x4 cg[2][2];
#pragma unroll
        for (int bj = 0; bj < 2; ++bj)
#pragma unroll
            for (int n = 0; n < 2; ++n) cg[bj][n] = *(const f32x4*)(g2 + u.pn * 256 + bj * 128 + wc * 32 + fq * 8 + 4 * n);
        EPI_BATCH_BEGIN
            f32x4 xv[4][2];
            EPI_WVEC_LOOP { EPI_WVEC_IDX; xv[wi][0] = *(const f32x4*)(out + (size_t)row * D_MODEL + col); xv[wi][1] = *(const f32x4*)(out + (size_t)row * D_MODEL + col + 4); }
            EPI_WVEC_LOOP { EPI_WVEC_IDX; *(f32x4*)(out + (size_t)row * D_MODEL + col) = xv[wi][0] + cg[bj][0] * acc[ai][bj][m][0]; *(f32x4*)(out + (size_t)row * D_MODEL + col + 4) = xv[wi][1] + cg[bj][1] * acc[ai][bj][m][1]; }
        EPI_BATCH_END
    }
};

#define XB_TMO      128
#define XB_XCNT(j)  (256  + 64 * (j))
#define XB_XSUB(j)  (1280 + 64 * (j))
#define XB_XGEN(j)  (2304 + 64 * (j))
#define XB_TOP      3328
#define XB_TOPGEN   3392
#define XCD_BAR_WORDS 3456
#define XB_SPIN_CAP (1u << 18)

__device__ __forceinline__ unsigned xb_ld(unsigned* p)              { return __hip_atomic_load(p, __ATOMIC_RELAXED, __HIP_MEMORY_SCOPE_AGENT); }
__device__ __forceinline__ unsigned xb_add(unsigned* p, unsigned v) { return __hip_atomic_fetch_add(p, v, __ATOMIC_RELAXED, __HIP_MEMORY_SCOPE_AGENT); }
__device__ __forceinline__ unsigned xb_xcc_id() { return (unsigned)__builtin_amdgcn_s_getreg((3 << 11) | 20) & 0xFu; }
#define XB_SPIN(cond, bar) do { unsigned _sp = 0; while (cond) { __builtin_amdgcn_s_sleep(1); \
    if ((++_sp & 255u) == 0u) { if (xb_ld(&(bar)[XB_TMO])) break; if (_sp > XB_SPIN_CAP) { atomicAdd(&(bar)[XB_TMO], 1u); break; } } } } while (0)

struct XcdBarrier {
    unsigned* bar; unsigned x; int wave;
    volatile LAS unsigned* st;
};

__device__ __forceinline__ XcdBarrier xcd_barrier_post(unsigned* bar, volatile LAS unsigned* st, int wave_id) {
    XcdBarrier b; b.bar = bar; b.x = xb_xcc_id(); b.st = st; b.wave = wave_id;
    if (wave_id == 0 && lane_id() == 0) (void)xb_add(&bar[XB_XCNT(b.x)], 1u);
    return b;
}
__device__ __forceinline__ void xcd_barrier_complete(unsigned* bar, unsigned x, unsigned& nloc, unsigned& nx) {
    const unsigned G = gridDim.x * gridDim.y * gridDim.z;
    unsigned sum, cnt, mine, sp = 0u;
    for (;;) {
        sum = 0u; cnt = 0u; mine = 0u;
#pragma unroll
        for (unsigned j = 0; j < 16; ++j) { const unsigned c = xb_ld(&bar[XB_XCNT(j)]); sum += c; cnt += (c > 0u) ? 1u : 0u; mine = (j == x) ? c : mine; }
        if (sum == G) break;
        __builtin_amdgcn_s_sleep(1);
        if ((++sp & 255u) == 0u) { if (xb_ld(&bar[XB_TMO])) break; if (sp > XB_SPIN_CAP) { atomicAdd(&bar[XB_TMO], 1u); break; } }
    }
    nloc = mine > 0u ? mine : 1u; nx = cnt > 0u ? cnt : 1u;
}

__device__ __forceinline__ void xcd_barrier(const XcdBarrier& b) {
    asm volatile("s_waitcnt vmcnt(0)" ::: "memory");
    __syncthreads();
    if (b.wave == 0 && lane_id() == 0) {
        unsigned* bar = b.bar;
        __builtin_amdgcn_s_waitcnt(0);
        unsigned nloc = b.st[0], nx = b.st[1];
        if (nloc == 0u) { xcd_barrier_complete(bar, b.x, nloc, nx); b.st[0] = nloc; b.st[1] = nx; }
        const unsigned old = xb_add(&bar[XB_XSUB(b.x)], 1u);
        const unsigned gen = old / nloc;
        if (old + 1u == (gen + 1u) * nloc) {
            __builtin_amdgcn_fence(__ATOMIC_RELEASE, "agent");
            asm volatile("s_waitcnt vmcnt(0)" ::: "memory");
            const unsigned og = xb_add(&bar[XB_TOP], 1u);
            const unsigned tg = og / nx;
            if (og + 1u == (tg + 1u) * nx) xb_add(&bar[XB_TOPGEN], 1u);
            else XB_SPIN(xb_ld(&bar[XB_TOPGEN]) == tg, bar);
            __builtin_amdgcn_fence(__ATOMIC_ACQUIRE, "agent");
            xb_add(&bar[XB_XGEN(b.x)], 1u);
            asm volatile("s_waitcnt vmcnt(0)" ::: "memory");
        } else {
            XB_SPIN(xb_ld(&bar[XB_XGEN(b.x)]) == gen, bar);
            __builtin_amdgcn_fence(__ATOMIC_ACQUIRE, "agent");
            asm volatile("s_waitcnt vmcnt(0)" ::: "memory");
        }
    }
    __syncthreads();
}

constexpr size_t WS_BAR = 8192;

typedef short bf16x8 __attribute__((ext_vector_type(8)));
typedef short s16x4 __attribute__((ext_vector_type(4)));

__device__ __forceinline__ bf16x8 cat8u(const u32x2 a, const u32x2 b) { const u32x4 w = (u32x4){a.x, a.y, b.x, b.y}; return __builtin_bit_cast(bf16x8, w); }
__device__ __forceinline__ bf16x8 pack_p(const f32x4 a, const f32x4 b) {
    u32x4 w; w.x = pk2(a.x, a.y); w.y = pk2(a.z, a.w); w.z = pk2(b.x, b.y); w.w = pk2(b.z, b.w);
    return __builtin_bit_cast(bf16x8, w);
}

constexpr int A_TILE = 32768, A_KOFF = 0, A_VOFF = 16384;
constexpr int A_BIAS = 4 * A_TILE;
constexpr int A_ITEM = A_BIAS + 2048;
static_assert(A_ITEM + 64 <= 145408, "attention LDS");
constexpr size_t WS_ATTCTR = 32768;
static_assert(WS_ATTCTR >= WS_BAR + XCD_BAR_WORDS * 4 && WS_ATTCTR + 8 * 256 <= WS_ROWSQ, "attn counters (8 x 256 B apart) inside ctl");
#define ATT_BAR() do { asm volatile("s_waitcnt lgkmcnt(0)" ::: "memory"); __builtin_amdgcn_s_barrier(); asm volatile("" ::: "memory"); } while (0)
__device__ __forceinline__ void glds16(const void* gsrc, unsigned lds_dst) { unsigned keep;
    asm volatile("s_mov_b32 %0, m0\n\ts_mov_b32 m0, %2\n\ts_nop 0\n\tglobal_load_lds_dwordx4 %1, off\n\ts_mov_b32 m0, %0" : "=&s"(keep) : "v"(gsrc), "s"(lds_dst) : "memory"); }
__device__ __forceinline__ unsigned lds_addr(LAS const void* p) { return (unsigned)__builtin_amdgcn_readfirstlane((int)(unsigned)(unsigned long long)p); }

__device__ __forceinline__ void phase_attn(const Params& p, LAS unsigned char* lds) {
    int tid_o = tid_of(p.wave_id);
    const int tid = tid_o, lane = tid & 63, wave = __builtin_amdgcn_readfirstlane(tid >> 6);
    const int qb = wave & 3, rw = wave >> 2, li = lane & 15, g = lane >> 4;
    const bf16* QN = (const bf16*)(p.ws + WS_QN); const bf16* KN = (const bf16*)(p.ws + WS_KN); const bf16* VT = (const bf16*)(p.ws + WS_VN);
    bf16* YB = (bf16*)p.out + (size_t)3 * ML * WA;
    unsigned* ctr = (unsigned*)(p.ws + WS_ATTCTR);
    LAS float* btab = (LAS float*)(lds + A_BIAS);
    const float scale = 0.08838834764831845f;
    int krow_l[2], kch_l[2], vrow_l[2], vch_l[2];
#pragma unroll
    for (int e = 0; e < 2; ++e) { const int pk = 2 * wave + e; krow_l[e] = 4 * pk + (lane >> 4); kch_l[e] = (lane & 15) ^ (krow_l[e] & 15);
        vrow_l[e] = 8 * pk + (lane >> 3); vch_l[e] = (lane & 7) ^ ((vrow_l[e] >> 1) & 7); }
    const int myx = (int)(xb_xcc_id() & 7u);
    int qoff = 0;
    for (;;) {
        if (tid == 0) { unsigned v = 0xffffffffu;
            while (qoff < 8) { const int qx = (myx + qoff) & 7; const unsigned n = atomicAdd(ctr + 64 * qx, 1u); if (n < 64u) { v = (unsigned)((qx + 8 * (n >> 4)) * 16 + (n & 15)); break; } ++qoff; }
            *(LAS unsigned*)(lds + A_ITEM) = v; }
        __syncthreads();
        const unsigned itu = *(LAS unsigned*)(lds + A_ITEM);
        if (itu == 0xffffffffu) break;
        const int it = (int)itu;
        const int rp = it & 15, h = (it >> 4) & 7, b = it >> 7;
        const int r = 2 * rp + rw;
        const int rs = min(max(r - 4, 0), 24), ks0 = min(max(16 * qb - 8, 0), 32);
        const int kr0 = min(max(2 * rp - 4, 0), 24), nband = min(max(2 * rp + 1 - 4, 0), 24) + 8 - kr0, NT = nband + 4;
        const int cq = 16 * qb + li, cs = min(max(cq - 8, 0), 48);
        const size_t qrow = (size_t)b * SEQ + r * GRID_W + cq;
        if (tid < 15 * 31) btab[tid] = p.rel_bias[h * 465 + tid];
        bf16x8 qf[4];
#pragma unroll
        for (int ks = 0; ks < 4; ++ks) qf[ks] = *(const bf16x8*)(QN + qrow * WA + h * HD + 32 * ks + 8 * g);
        asm volatile("s_waitcnt vmcnt(0)" ::: "memory");
        const bf16* kg0 = KN + (size_t)h * HD + (size_t)krow_l[0] * WA + 8 * kch_l[0]; const bf16* kg1 = KN + (size_t)h * HD + (size_t)krow_l[1] * WA + 8 * kch_l[1];
        const bf16* vg0 = VT + ((size_t)(b * NHEAD + h) * HD + vrow_l[0]) * VT_PITCH + 8 * vch_l[0]; const bf16* vg1 = VT + ((size_t)(b * NHEAD + h) * HD + vrow_l[1]) * VT_PITCH + 8 * vch_l[1];
#define ATT_DMA(ti_) do { const int t_ = (ti_) < NT ? (ti_) : NT - 1; const unsigned la_ = lds_addr(lds + ((ti_) & 3) * A_TILE + wave * 2048); \
            const size_t krow0 = (t_ < nband) ? ((size_t)b * SEQ + (kr0 + t_) * GRID_W) : ((size_t)ML + b * CTX + 64 * (t_ - nband)); \
            const int tok0 = (t_ < nband) ? ((kr0 + t_) * GRID_W) : (SEQ + 64 * (t_ - nband)); \
            glds16(kg0 + krow0 * WA, la_ + A_KOFF); glds16(kg1 + krow0 * WA, la_ + A_KOFF + 1024); glds16(vg0 + tok0, la_ + A_VOFF); glds16(vg1 + tok0, la_ + A_VOFF + 1024); } while (0)
        ATT_DMA(0); ATT_DMA(1); ATT_DMA(2);
        f32x4 ot[8];
#pragma unroll
        for (int db = 0; db < 8; ++db) ot[db] = (f32x4){0.f, 0.f, 0.f, 0.f};
        float mrun = -1e30f, l = 0.f;
        const int kx = (ks0 + li) & 15, vy = (li >> 1) & 7;
        int koff[4];
#pragma unroll
        for (int ks = 0; ks < 4; ++ks) koff[ks] = A_KOFF + (ks0 + li) * 256 + (((4 * ks + g) ^ kx) << 4);
        const int vrow_off = A_VOFF + li * 128 + 8 * (g & 1);
        const int gq = g >> 1;
#pragma unroll 1
        for (int ti = 0; ti < NT; ++ti) {
            asm volatile("s_waitcnt vmcnt(8)" ::: "memory");
            ATT_BAR();
            ATT_DMA(ti + 3);
            const LAS unsigned char* tb = lds + (ti & 3) * A_TILE;
            if (ti < nband) {
                const int kr = kr0 + ti;
                if (kr >= rs && kr < rs + 8) {
                    f32x4 st[2];
#pragma unroll
                    for (int kb = 0; kb < 2; ++kb) { f32x4 a = (f32x4){0.f, 0.f, 0.f, 0.f};
#pragma unroll
                        for (int ks = 0; ks < 4; ++ks) a = __builtin_amdgcn_mfma_f32_16x16x32_bf16(*(const LAS bf16x8*)(tb + koff[ks] + kb * 4096), qf[ks], a, 0, 0, 0);
                        st[kb] = a; }
                    const int dr = kr - r + 7; float gm = -1e30f;
#pragma unroll
                    for (int kb = 0; kb < 2; ++kb)
#pragma unroll
                        for (int j = 0; j < 4; ++j) { const int kcol = ks0 + 16 * kb + 4 * g + j; const bool valid = (kcol >= cs) && (kcol < cs + 16);
                            const int bi = valid ? (dr * 31 + (kcol - cq + 15)) : 0;
                            const float sv = valid ? (st[kb][j] * scale + btab[bi]) : -1e30f; st[kb][j] = sv; gm = fmaxf(gm, sv); }
                    gm = fmaxf(gm, __shfl_xor(gm, 16)); gm = fmaxf(gm, __shfl_xor(gm, 32));
                    const float mnew = fmaxf(mrun, gm); const float alpha = __expf(mrun - mnew); mrun = mnew; l *= alpha;
#pragma unroll
                    for (int db = 0; db < 8; ++db) ot[db] = ot[db] * alpha;
#pragma unroll
                    for (int kb = 0; kb < 2; ++kb)
#pragma unroll
                        for (int j = 0; j < 4; ++j) { const float sv = st[kb][j]; const float e = (sv > -1e29f) ? __expf(sv - mnew) : 0.f; st[kb][j] = e; l += e; }
                    const bf16x8 pb = pack_p(st[0], st[1]);
                    const int c0 = (ks0 >> 3) + gq;
#pragma unroll
                    for (int db = 0; db < 8; ++db) { const LAS unsigned char* vp = tb + vrow_off + db * 2048;
                        ot[db] = __builtin_amdgcn_mfma_f32_16x16x32_bf16(cat8u(*(const LAS u32x2*)(vp + ((c0 ^ vy) << 4)), *(const LAS u32x2*)(vp + (((c0 + 2) ^ vy) << 4))), pb, ot[db], 0, 0, 0); }
                }
            } else {
                f32x4 st[4];
#pragma unroll
                for (int kb = 0; kb < 4; ++kb) { f32x4 a = (f32x4){0.f, 0.f, 0.f, 0.f};
#pragma unroll
                    for (int ks = 0; ks < 4; ++ks) a = __builtin_amdgcn_mfma_f32_16x16x32_bf16(*(const LAS bf16x8*)(tb + A_KOFF + (16 * kb + li) * 256 + (((4 * ks + g) ^ li) << 4)), qf[ks], a, 0, 0, 0);
                    st[kb] = a * scale; }
                float gm = -1e30f;
#pragma unroll
                for (int kb = 0; kb < 4; ++kb) gm = fmaxf(fmaxf(gm, fmaxf(st[kb][0], st[kb][1])), fmaxf(st[kb][2], st[kb][3]));
                gm = fmaxf(gm, __shfl_xor(gm, 16)); gm = fmaxf(gm, __shfl_xor(gm, 32));
                const float mnew = fmaxf(mrun, gm); const float alpha = __expf(mrun - mnew); mrun = mnew; l *= alpha;
#pragma unroll
                for (int db = 0; db < 8; ++db) ot[db] = ot[db] * alpha;
#pragma unroll
                for (int kb = 0; kb < 4; ++kb)
#pragma unroll
                    for (int j = 0; j < 4; ++j) { const float e = __expf(st[kb][j] - mnew); st[kb][j] = e; l += e; }
#pragma unroll
                for (int kp2 = 0; kp2 < 2; ++kp2) { const bf16x8 pb = pack_p(st[2 * kp2], st[2 * kp2 + 1]);
                    const int c0 = 4 * kp2 + gq;
#pragma unroll
                    for (int db = 0; db < 8; ++db) { const LAS unsigned char* vp = tb + vrow_off + db * 2048;
                        ot[db] = __builtin_amdgcn_mfma_f32_16x16x32_bf16(cat8u(*(const LAS u32x2*)(vp + ((c0 ^ vy) << 4)), *(const LAS u32x2*)(vp + (((c0 + 2) ^ vy) << 4))), pb, ot[db], 0, 0, 0); } }
            }
        }
        asm volatile("s_waitcnt vmcnt(0)" ::: "memory");
        l += __shfl_xor(l, 16); l += __shfl_xor(l, 32);
        const float inv = 1.0f / l;
#pragma unroll
        for (int db = 0; db < 8; ++db) { const f32x4 o = ot[db] * inv; u32x2 w; w.x = pk2(o.x, o.y); w.y = pk2(o.z, o.w);
            *(u32x2*)(YB + qrow * WA + h * HD + 16 * db + 4 * g) = w; }
#undef ATT_DMA
    }
}

constexpr int HP = 160;
constexpr int H_QH = 0, H_KH = 20480, H_KE = 40960, H_QD = 61440, H_KD = 81920;
constexpr int HP2 = 48;
constexpr int H_Q2 = 102400, H_K2 = 108544;
constexpr int PP = 144;
constexpr int H_P = 114688;
constexpr int H_T = 123904;
constexpr int H_D = 125952;
constexpr int HIMG_QD = 0, HIMG_KD = 16384, HIMG_P = 32768, HIMG_D = 40960, HIMG_BYTES = 41472;
constexpr int NCH = (CTX + SEQ) / 64;
constexpr int VP = 288;
constexpr int HPK = 136;
constexpr int SB_QD = 0, SB_KD = 20480, SB_P = 40960, SB_D = 50176, SB_V = 50688, SB_BYTES = 69120;
static_assert(2 * SB_BYTES <= 145408, "scan buffers");

__device__ __forceinline__ s16x4 lds_tr(LAS const unsigned char* p) {
    return __builtin_bit_cast(s16x4, __builtin_amdgcn_ds_read_tr16_b64_v4i16((LAS s16x4*)p));
}
__device__ __forceinline__ bf16x8 cat8(const s16x4 a, const s16x4 b) { return __builtin_shufflevector(a, b, 0, 1, 2, 3, 4, 5, 6, 7); }

__device__ __forceinline__ size_t hg_row(int dir, int b, int tau) {
    if (tau < CTX) return (size_t)ML + b * CTX + (dir == 0 ? tau : CTX - 1 - tau);
    const int t = tau - CTX; return (size_t)b * SEQ + (dir == 0 ? t : SEQ - 1 - t);
}

__device__ __forceinline__ void hgrn_prep(const Params& p, LAS unsigned char* lds, int vb, int nb) {
    int tid_o = tid_of(p.wave_id);
    const int tid = tid_o, lane = tid & 63, wave = __builtin_amdgcn_readfirstlane(tid >> 6);
    const int k = tid & 127, J = __builtin_amdgcn_readfirstlane(tid >> 7);
    const int li = lane & 15, g = lane >> 4, qq = li >> 2, pp = li & 3;
    LAS float* Tl = (LAS float*)(lds + H_T); LAS float* Dl = (LAS float*)(lds + H_D);
    float lf[16]; unsigned qv[16];
#define HG_LOADP(idx_) do { const int id_ = (idx_); const int ch_ = id_ / NCH, cc_ = id_ % NCH; const int dir_ = ch_ / (BATCH * NHEAD), b_ = (ch_ / NHEAD) % BATCH, h_ = ch_ % NHEAD; \
        const size_t row0_ = hg_row(dir_, b_, 64 * cc_ + 16 * J); const long st_ = dir_ ? -(long)WA : (long)WA; \
        const float* lfp_ = (const float*)(p.ws + (dir_ == 0 ? WS_FW : WS_FB)) + row0_ * WA + h_ * HD + k; const bf16* qp_ = (const bf16*)(p.ws + WS_QA) + row0_ * WA + h_ * HD + k; \
        _Pragma("unroll") for (int i = 0; i < 16; ++i) { lf[i] = lfp_[(long)i * st_]; qv[i] = (cc_ >= 4) ? (unsigned)qp_[(long)i * st_] : 0u; } } while (0)
    if (vb < 64 * NCH) HG_LOADP(vb);
    for (int idx = vb; idx < 64 * NCH; idx += nb) {
        const int c = idx % NCH;
        float cum[16]; float run = 0.f;
#pragma unroll
        for (int i = 0; i < 16; ++i) { run += lf[i]; cum[i] = run; }
        Tl[J * 128 + k] = run;
        ATT_BAR();
        const float T0 = Tl[k], T1 = Tl[128 + k], T2 = Tl[256 + k], T3 = Tl[384 + k];
        const float bJ = (J > 0 ? T0 : 0.f) + (J > 1 ? T1 : 0.f) + (J > 2 ? T2 : 0.f);
        const float tail = (J < 1 ? T1 : 0.f) + (J < 2 ? T2 : 0.f) + (J < 3 ? T3 : 0.f);
        const float eb = __expf(bJ), et = __expf(tail), eT = __expf(run);
        const float x2 = (J == 3) ? __expf(T2) : __expf(T1);
        float qh[16], kh[16];
#pragma unroll
        for (int i = 0; i < 16; ++i) { const float e1 = __expf(cum[i]); const float r1 = __builtin_amdgcn_rcpf(e1); const float kk = 1.0f - __expf(lf[i]);
            qh[i] = __builtin_bit_cast(float, qv[i] << 16) * e1; kh[i] = kk * r1; }
        {
            LAS unsigned char* rowp = lds + k * HP + 32 * J;
            u32x4 w0, w1;
#define HG_WRITE(OFF, EXPR) do { \
            { float v0_, v1_; \
              { const int i = 0; v0_ = (EXPR); } { const int i = 1; v1_ = (EXPR); } w0.x = pk2(v0_, v1_); \
              { const int i = 2; v0_ = (EXPR); } { const int i = 3; v1_ = (EXPR); } w0.y = pk2(v0_, v1_); \
              { const int i = 4; v0_ = (EXPR); } { const int i = 5; v1_ = (EXPR); } w0.z = pk2(v0_, v1_); \
              { const int i = 6; v0_ = (EXPR); } { const int i = 7; v1_ = (EXPR); } w0.w = pk2(v0_, v1_); \
              { const int i = 8; v0_ = (EXPR); } { const int i = 9; v1_ = (EXPR); } w1.x = pk2(v0_, v1_); \
              { const int i = 10; v0_ = (EXPR); } { const int i = 11; v1_ = (EXPR); } w1.y = pk2(v0_, v1_); \
              { const int i = 12; v0_ = (EXPR); } { const int i = 13; v1_ = (EXPR); } w1.z = pk2(v0_, v1_); \
              { const int i = 14; v0_ = (EXPR); } { const int i = 15; v1_ = (EXPR); } w1.w = pk2(v0_, v1_); } \
            *(LAS u32x4*)(OFF) = w0; *(LAS u32x4*)((OFF) + 16) = w1; } while (0)
            HG_WRITE(rowp + H_QH, qh[i]);
            HG_WRITE(rowp + H_KH, kh[i]);
            HG_WRITE(rowp + H_KE, kh[i] * eT);
            HG_WRITE(rowp + H_QD, qh[i] * eb);
            HG_WRITE(rowp + H_KD, kh[i] * (eT * et));
            if (J == 3) { HG_WRITE(lds + H_Q2 + k * HP2, qh[i] * x2); }
            if (J == 0) { HG_WRITE(lds + H_K2 + k * HP2, kh[i] * (eT * x2)); }
#undef HG_WRITE
            if (J == 3) Dl[k] = __expf(bJ + run);
        }
        if (idx + nb < 64 * NCH) HG_LOADP(idx + nb);
        ATT_BAR();
        const bool lat = (c >= 4);
        if (lat) {
#pragma unroll
            for (int rep = 0; rep < 2; ++rep) {
                int I, Jb;
                if (rep == 0) { I = (wave < 4) ? wave : (wave == 4 ? 1 : (wave == 7 ? 3 : 2)); Jb = (wave < 4) ? wave : (wave == 4 ? 0 : (wave == 5 ? 0 : (wave == 6 ? 1 : 2))); }
                else { if (wave >= 2) break; I = 3; Jb = wave; }
                int aoff, apitch, acol, boff, bpitch, bcol;
                if (I == Jb) { aoff = H_KH; apitch = HP; acol = 16 * Jb; boff = H_QH; bpitch = HP; bcol = 16 * I; }
                else if (I == Jb + 1 && I != 2) { aoff = H_KE; apitch = HP; acol = 16 * Jb; boff = H_QH; bpitch = HP; bcol = 16 * I; }
                else if (I == 2) { if (Jb == 0) { aoff = H_K2; apitch = HP2; acol = 0; } else { aoff = H_KE; apitch = HP; acol = 16; } boff = H_QH; bpitch = HP; bcol = 32; }
                else { if (Jb == 0) { aoff = H_K2; apitch = HP2; acol = 0; } else { aoff = H_KE; apitch = HP; acol = 16; } boff = H_Q2; bpitch = HP2; bcol = 0; }
                f32x4 pt = (f32x4){0.f, 0.f, 0.f, 0.f};
#pragma unroll
                for (int ks = 0; ks < 4; ++ks) {
                    const int r0 = 32 * ks + 4 * g + qq;
                    const bf16x8 a = cat8(lds_tr(lds + aoff + r0 * apitch + (acol + 4 * pp) * 2), lds_tr(lds + aoff + (r0 + 16) * apitch + (acol + 4 * pp) * 2));
                    const bf16x8 bb = cat8(lds_tr(lds + boff + r0 * bpitch + (bcol + 4 * pp) * 2), lds_tr(lds + boff + (r0 + 16) * bpitch + (bcol + 4 * pp) * 2));
                    pt = __builtin_amdgcn_mfma_f32_16x16x32_bf16(a, bb, pt, 0, 0, 0);
                }
                if (I == Jb) {
#pragma unroll
                    for (int j = 0; j < 4; ++j) if (4 * g + j > li) pt[j] = 0.f;
                }
                u32x2 w; w.x = pk2(pt.x, pt.y); w.y = pk2(pt.z, pt.w);
                *(LAS u32x2*)(lds + H_P + (16 * I + li) * PP + (16 * Jb + 4 * g) * 2) = w;
            }
        }
        ATT_BAR();
        unsigned char* img = p.ws + WS_HIMG + (size_t)idx * HIMG_BYTES;
#pragma unroll
        for (int e = 0; e < 2; ++e) { const int id = tid + 512 * e; const int kr = id >> 3, part = id & 7;
            if (lat) *(u32x4*)(img + HIMG_QD + id * 16) = *(const LAS u32x4*)(lds + H_QD + kr * HP + 16 * part);
            *(u32x4*)(img + HIMG_KD + id * 16) = *(const LAS u32x4*)(lds + H_KD + kr * HP + 16 * part); }
        if (lat) *(u32x4*)(img + HIMG_P + tid * 16) = *(const LAS u32x4*)(lds + H_P + (tid >> 3) * PP + 16 * (tid & 7));
        if (tid < 32) *(u32x4*)(img + HIMG_D + tid * 16) = *(const LAS u32x4*)(lds + H_D + 16 * tid);
    }
#undef HG_LOADP
    __syncthreads();
}

__device__ __forceinline__ void hgrn_scan(const Params& p, LAS unsigned char* lds, int chain) {
    int tid_o = tid_of(p.wave_id);
    const int tid = tid_o, lane = tid & 63, wave = __builtin_amdgcn_readfirstlane(tid >> 6);
    const int li = lane & 15, g = lane >> 4, qq = li >> 2, pp = li & 3;
    const int dir = chain / (BATCH * NHEAD), b = (chain / NHEAD) % BATCH, h = chain % NHEAD;
    const bf16* IA = (const bf16*)(p.ws + WS_IA) + h * HD;
    bf16* O = ((bf16*)p.out + (dir == 0 ? 0 : (size_t)ML * WA)) + h * HD + 16 * wave + li;
    const long ost = dir ? -(long)WA : (long)WA;
    const unsigned char* img0 = p.ws + WS_HIMG + (size_t)chain * NCH * HIMG_BYTES;
    f32x4 S[8];
#pragma unroll
    for (int i = 0; i < 8; ++i) S[i] = (f32x4){0.f, 0.f, 0.f, 0.f};
    u32x4 rq[2][2], rk[2][2], rp[2], rd[2], rv[2][2];
#define HS_LOAD(c_, set_) do { const int cc_ = (c_); const unsigned char* im_ = img0 + (size_t)cc_ * HIMG_BYTES; \
        if (cc_ >= 4) { rq[set_][0] = *(const u32x4*)(im_ + HIMG_QD + tid * 16); rq[set_][1] = *(const u32x4*)(im_ + HIMG_QD + (tid + 512) * 16); rp[set_] = *(const u32x4*)(im_ + HIMG_P + tid * 16); } \
        rk[set_][0] = *(const u32x4*)(im_ + HIMG_KD + tid * 16); rk[set_][1] = *(const u32x4*)(im_ + HIMG_KD + (tid + 512) * 16); \
        if (tid < 32) rd[set_] = *(const u32x4*)(im_ + HIMG_D + tid * 16); \
        _Pragma("unroll") for (int e = 0; e < 2; ++e) { const int idx_ = tid * 2 + e; const size_t row_ = hg_row(dir, b, 64 * cc_ + (idx_ >> 4)); rv[set_][e] = *(const u32x4*)(IA + row_ * WA + 8 * (idx_ & 15)); } } while (0)
#define HS_STORE(c_, set_) do { const int cc_ = (c_); LAS unsigned char* bb_ = lds + (cc_ & 1) * SB_BYTES; \
        if (cc_ >= 4) { *(LAS u32x4*)(bb_ + SB_QD + (tid >> 3) * HP + 16 * (tid & 7)) = rq[set_][0]; *(LAS u32x4*)(bb_ + SB_QD + ((tid >> 3) + 64) * HP + 16 * (tid & 7)) = rq[set_][1]; \
                        *(LAS u32x4*)(bb_ + SB_P + (tid >> 3) * PP + 16 * (tid & 7)) = rp[set_]; } \
        { LAS unsigned char* k0_ = bb_ + SB_KD + (tid >> 3) * HPK + 16 * (tid & 7); LAS unsigned char* k1_ = k0_ + 64 * HPK; \
          *(LAS u32x2*)k0_ = (u32x2){rk[set_][0].x, rk[set_][0].y}; *(LAS u32x2*)(k0_ + 8) = (u32x2){rk[set_][0].z, rk[set_][0].w}; *(LAS u32x2*)k1_ = (u32x2){rk[set_][1].x, rk[set_][1].y}; *(LAS u32x2*)(k1_ + 8) = (u32x2){rk[set_][1].z, rk[set_][1].w}; } \
        if (tid < 32) *(LAS u32x4*)(bb_ + SB_D + 16 * tid) = rd[set_]; \
        _Pragma("unroll") for (int e = 0; e < 2; ++e) { const int idx_ = tid * 2 + e; *(LAS u32x4*)(bb_ + SB_V + (idx_ >> 4) * VP + 16 * (idx_ & 15)) = rv[set_][e]; } } while (0)
    HS_LOAD(0, 0); HS_LOAD(1, 1);
    HS_STORE(0, 0);
    HS_LOAD(2, 0);
    ATT_BAR();
#pragma unroll 1
    for (int c2 = 0; c2 < NCH; c2 += 2) {
#pragma unroll
    for (int uu = 0; uu < 2; ++uu) { const int c = c2 + uu;
        const LAS unsigned char* bb = lds + (c & 1) * SB_BYTES;
        const bool lat = (c >= 4);
        bf16x8 vf[2];
#pragma unroll
        for (int sp = 0; sp < 2; ++sp) {
            const LAS unsigned char* vb0 = bb + SB_V + (32 * sp + 4 * g + qq) * VP + (16 * wave + 4 * pp) * 2;
            vf[sp] = cat8(lds_tr(vb0), lds_tr(vb0 + 16 * VP));
        }
        if (lat) {
            bf16x8 sb[4];
#pragma unroll
            for (int ks = 0; ks < 4; ++ks) sb[ks] = pack_p(S[2 * ks], S[2 * ks + 1]);
            bf16* orow = O + (long)hg_row(dir, b, 64 * c) * WA;
#pragma unroll
            for (int I = 0; I < 4; ++I) {
                f32x4 o = (f32x4){0.f, 0.f, 0.f, 0.f};
#pragma unroll
                for (int ks = 0; ks < 4; ++ks) {
                    const LAS unsigned char* ap = bb + SB_QD + (32 * ks + 4 * g + qq) * HP + (16 * I + 4 * pp) * 2;
                    o = __builtin_amdgcn_mfma_f32_16x16x32_bf16(cat8(lds_tr(ap), lds_tr(ap + 16 * HP)), sb[ks], o, 0, 0, 0);
                }
#pragma unroll
                for (int sp = 0; sp < 2; ++sp) {
                    if (2 * sp > I) break;
                    const LAS unsigned char* pr = bb + SB_P + (16 * I + li) * PP + (32 * sp + 4 * g) * 2;
                    const u32x2 lo = *(const LAS u32x2*)pr; u32x2 hi = (u32x2){0u, 0u};
                    if (2 * sp + 1 <= I) hi = *(const LAS u32x2*)(pr + 32);
                    o = __builtin_amdgcn_mfma_f32_16x16x32_bf16(cat8u(lo, hi), vf[sp], o, 0, 0, 0);
                }
#pragma unroll
                for (int j = 0; j < 4; ++j) orow[(long)(16 * I + 4 * g + j) * ost] = (bf16)f2bf(o[j]);
            }
        }
#pragma unroll
        for (int blk = 0; blk < 8; ++blk) {
            const f32x4 d4 = *(const LAS f32x4*)(bb + SB_D + (16 * blk + 4 * g) * 4);
            f32x4 s = S[blk] * d4;
#pragma unroll
            for (int sp = 0; sp < 2; ++sp) {
                const LAS unsigned char* kp = bb + SB_KD + (16 * blk + li) * HPK + (32 * sp + 4 * g) * 2;
                s = __builtin_amdgcn_mfma_f32_16x16x32_bf16(cat8u(*(const LAS u32x2*)kp, *(const LAS u32x2*)(kp + 32)), vf[sp], s, 0, 0, 0);
            }
            S[blk] = s;
        }
        if (c + 1 < NCH) HS_STORE(c + 1, (uu + 1) & 1);
        if (c + 3 < NCH) HS_LOAD(c + 3, (uu + 1) & 1);
        ATT_BAR();
    } }
#undef HS_LOAD
#undef HS_STORE
    __syncthreads();
}

__device__ __forceinline__ void phase_readout(const Params& p, int vb, int nb) {
    const int tid = tid_of(p.wave_id), lane = tid & 63, wave = p.wave_id;
    const bf16* OF = (const bf16*)p.out; const bf16* OB = OF + (size_t)ML * WA; const bf16* GA = (const bf16*)(p.ws + WS_GA);
    bf16* YA = (bf16*)p.out + (size_t)2 * ML * WA;
    f32x4 ng[4];
#pragma unroll
    for (int i = 0; i < 4; ++i) ng[i] = *(const f32x4*)(p.hgrn_norm_g + 16 * (lane & 7) + 4 * i);
    const int NGW = nb * 8;
    for (int row0 = vb * 8 + wave; row0 < ML; row0 += 2 * NGW) {
        u32x4 a[2][2], b[2][2], gg[2][2];
#pragma unroll
        for (int u = 0; u < 2; ++u) { const int row = row0 + u * NGW; if (row < ML) { const size_t off = (size_t)row * WA + 16 * lane;
            a[u][0] = *(const u32x4*)(OF + off); a[u][1] = *(const u32x4*)(OF + off + 8); b[u][0] = *(const u32x4*)(OB + off); b[u][1] = *(const u32x4*)(OB + off + 8);
            gg[u][0] = *(const u32x4*)(GA + off); gg[u][1] = *(const u32x4*)(GA + off + 8); } }
#pragma unroll
        for (int u = 0; u < 2; ++u) { const int row = row0 + u * NGW; if (row < ML) { const size_t off = (size_t)row * WA + 16 * lane;
            float o[16]; float ss = 0.f;
#pragma unroll
            for (int q = 0; q < 8; ++q) { const unsigned wa = a[u][q >> 2][q & 3], wb = b[u][q >> 2][q & 3]; o[2 * q] = bflo(wa) + bflo(wb); o[2 * q + 1] = bfhi(wa) + bfhi(wb); ss += o[2 * q] * o[2 * q] + o[2 * q + 1] * o[2 * q + 1]; }
            ss += __shfl_xor(ss, 1); ss += __shfl_xor(ss, 2); ss += __shfl_xor(ss, 4);
            const float rstd = __builtin_amdgcn_rsqf(ss * (1.0f / HD) + EPS);
            u32x4 w[2];
#pragma unroll
            for (int q = 0; q < 8; ++q) { const unsigned wg = gg[u][q >> 2][q & 3];
                w[q >> 2][q & 3] = pk2(o[2 * q] * rstd * ng[q >> 1][(2 * q) & 3] * bflo(wg), o[2 * q + 1] * rstd * ng[q >> 1][(2 * q + 1) & 3] * bfhi(wg)); }
            *(u32x4*)(YA + off) = w[0]; *(u32x4*)(YA + off + 8) = w[1]; } }
    }
}

__device__ __forceinline__ void phase_bias2(const Params& p, int vb, int nb) {
    const int tid = tid_of(p.wave_id); const float* mod = (const float*)(p.ws + WS_MOD); float* bias2 = (float*)(p.ws + WS_BIAS2);
    constexpr int NCC = 2 * FFN / 512, NKC = D_MODEL / 64;
    for (int item = vb; item < NCC * NKC; item += nb) {
        const int cc = item % NCC, kc = item / NCC; const int col = cc * 512 + tid;
        const float* W = (col < FFN) ? p.w1 + col : p.w3 + (col - FFN);
        float a0 = 0.f, a1 = 0.f, a2 = 0.f, a3 = 0.f;
#pragma unroll 8
        for (int k = kc * 64; k < kc * 64 + 64; ++k) { const float w = W[(size_t)k * FFN];
            a0 += w * mod[0 * IN_COLS + 3 * D_MODEL + k]; a1 += w * mod[1 * IN_COLS + 3 * D_MODEL + k]; a2 += w * mod[2 * IN_COLS + 3 * D_MODEL + k]; a3 += w * mod[3 * IN_COLS + 3 * D_MODEL + k]; }
        atomicAdd(bias2 + 0 * 2 * FFN + col, a0); atomicAdd(bias2 + 1 * 2 * FFN + col, a1); atomicAdd(bias2 + 2 * 2 * FFN + col, a2); atomicAdd(bias2 + 3 * 2 * FFN + col, a3);
    }
}

constexpr int LDS_MISC_OFF = 145408;
constexpr int LDS_BYTES = 146432;
static_assert(WS_BAR + XCD_BAR_WORDS * 4 <= WS_ROWSQ, "barrier words inside ctl");

#if defined(__HIP_DEVICE_COMPILE__)
#define LOAD_P() Params p; { const __attribute__((address_space(4))) Params* q_ = (const __attribute__((address_space(4))) Params*)__builtin_amdgcn_kernarg_segment_ptr(); asm volatile("" : "+s"(q_)); \
    p = *q_; p.wave_id = wave_id; } unsigned char* ws = p.ws; (void)ws
#else
#define LOAD_P() Params p = p_in; p.wave_id = wave_id; unsigned char* ws = p.ws; (void)ws
#endif
__global__ void __launch_bounds__(NTHREADS, 2) mega_fwd(Params p_in) {
    const int wave_id = __builtin_amdgcn_readfirstlane((int)(threadIdx.x >> 6));
    extern __shared__ __attribute__((aligned(16))) unsigned char lds_raw[];
    LAS unsigned char* lds = (LAS unsigned char*)lds_raw;
    const int nb = gridDim.x;
    const int vb = (nb % 8 == 0) ? ((int)(blockIdx.x % 8) * (nb / 8) + (int)(blockIdx.x / 8)) : (int)blockIdx.x;
    const int bx = blockIdx.x;
    volatile LAS unsigned* misc = (volatile LAS unsigned*)(lds + LDS_MISC_OFF);
    if (wave_id == 0) misc[lane_id()] = 0u;
    __syncthreads();
    XcdBarrier bar = xcd_barrier_post((unsigned*)(p_in.ws + WS_BAR), misc + 8, wave_id);
#define GRID_BAR() xcd_barrier(bar)

    { LOAD_P(); phase_mod(p, lds, vb, nb); __syncthreads(); phase_wconv_in(p, lds, vb * 8 + wave_id, nb * 8); }
    GRID_BAR();
    { LOAD_P(); phase_h(p, vb, nb); }
    GRID_BAR();
    { LOAD_P(); pg8::Gemm g{(const bf16*)(ws + WS_H), (const bf16*)(ws + WS_WINT), MT, IN_COLS, D_MODEL}; InProjOrder S; S.init(ML, IN_COLS, nb, bx);
      EpiInProj E{ws, lds, p.q_norm_g, p.k_norm_g}; pg8::gemm_phase<EpiInProj, InProjOrder, true, true>(lds, g, S, E, wave_id);
      const int nfree = nb - CTX_UNITS;
      if (nfree >= 64) { if (bx >= CTX_UNITS) phase_wconv_rest(p, lds, (bx - CTX_UNITS) * 8 + wave_id, nfree * 8); }
      else phase_wconv_rest(p, lds, bx * 8 + wave_id, nb * 8); }
    GRID_BAR();
    { LOAD_P(); hgrn_prep(p, lds, vb, nb); }
    GRID_BAR();
    { LOAD_P();
      if (bx < 2 * BATCH * NHEAD) hgrn_scan(p, lds, bx);
      __syncthreads();
      phase_attn(p, lds); }
    GRID_BAR();
    { LOAD_P(); phase_readout(p, vb, nb); }
    GRID_BAR();
    { LOAD_P(); pg8::Gemm g{(const bf16*)p.out + (size_t)2 * ML * WA, (const bf16*)(ws + WS_WAT), ML, D_MODEL, WA};
      MergeOrder S; S.init(ML, D_MODEL, nb, bx); S.A1 = (const bf16*)p.out + (size_t)3 * ML * WA; S.B1 = (const bf16*)(ws + WS_WBT);
      EpiMerge E{ws, (float*)(ws + WS_T1)}; pg8::gemm_phase<EpiMerge, MergeOrder, true, true>(lds, g, S, E, wave_id); }
    GRID_BAR();
    { LOAD_P(); pg8::Gemm g{(const bf16*)(ws + WS_Z), (const bf16*)(ws + WS_WOT), ML, D_MODEL, D_MODEL}; pg8::StaticOrder S; S.init(ML, D_MODEL, nb, bx);
      EpiOutProj E{ws, p.x, p.norm2_g, p.out}; pg8::gemm_phase<EpiOutProj, pg8::StaticOrder, true, true>(lds, g, S, E, wave_id); }
    GRID_BAR();
    { LOAD_P(); pg8::Gemm g{(const bf16*)(ws + WS_XMG), (const bf16*)(ws + WS_W13T), ML, 2 * FFN, D_MODEL}; pg8::StaticOrder S; S.init(ML, 2 * FFN, nb, bx);
      EpiFfnUp E{ws, lds, p.conv_w, p.conv_b}; pg8::gemm_phase<EpiFfnUp, pg8::StaticOrder, true, true>(lds, g, S, E, wave_id); }
    GRID_BAR();
    { LOAD_P(); { pg8::StaticOrder S0; S0.init(ML, D_MODEL, nb, bx); pg8::Unit u0; const int tid = tid_of(wave_id); for (int i = 0; S0.next(i, u0); ++i) halo_fix(p, u0.pm, tid); }
      asm volatile("s_waitcnt vmcnt(0)" ::: "memory"); __syncthreads();
      pg8::Gemm g{(const bf16*)(ws + WS_ACT), (const bf16*)(ws + WS_W2T), ML, D_MODEL, FFN}; pg8::StaticOrder S; S.init(ML, D_MODEL, nb, bx);
      EpiFfnDown E{ws, p.out}; pg8::gemm_phase<EpiFfnDown, pg8::StaticOrder, true, true>(lds, g, S, E, wave_id); }
#undef GRID_BAR
}

extern "C" void kernel_launch(void* const* d_in, const int* in_sizes, int n_in, void* d_out, int out_size, void* d_ws, size_t ws_size, hipStream_t stream) {
    static int grid = 0;
    if (grid == 0) {
        if (n_in != 22 || ws_size < WS_END || out_size != ML * D_MODEL) { fprintf(stderr, "kernel_launch: bad inputs (n_in %d, out %d, ws %zu, need %zu)\n", n_in, out_size, ws_size, (size_t)WS_END); grid = -1; return; }
        int dev = 0, cus = 0, per_cu = 0;
        if (hipGetDevice(&dev) != hipSuccess || hipDeviceGetAttribute(&cus, hipDeviceAttributeMultiprocessorCount, dev) != hipSuccess) { grid = -1; return; }
        if (hipFuncSetAttribute((const void*)mega_fwd, hipFuncAttributeMaxDynamicSharedMemorySize, LDS_BYTES) != hipSuccess) { fprintf(stderr, "kernel_launch: hipFuncSetAttribute failed\n"); grid = -1; return; }
        if (hipOccupancyMaxActiveBlocksPerMultiprocessor(&per_cu, (const void*)mega_fwd, NTHREADS, LDS_BYTES) != hipSuccess || per_cu < 1) { fprintf(stderr, "kernel_launch: occupancy query says %d blocks/CU\n", per_cu); (void)hipGetLastError(); grid = -1; return; }
        grid = cus;
        fprintf(stderr, "kernel_launch: grid %d (cus %d, occupancy %d/CU)\n", grid, cus, per_cu);
    }
    if (grid < 0) return;
    Params p{};
    const float** f = (const float**)&p;
    for (int i = 0; i < 22; ++i) f[i] = (const float*)d_in[i];
    p.out = (float*)d_out; p.ws = (unsigned char*)d_ws;
    (void)hipMemsetAsync((char*)d_ws + WS_CTL, 0, CTL_ZERO_BYTES, stream);
    hipLaunchKernelGGL(mega_fwd, dim3(grid), dim3(NTHREADS), LDS_BYTES, stream, p);
}
```

```cpp
#include <hip/hip_runtime.h>
#include <cstdio>
#include <cstdint>
#include <cmath>

__device__ __forceinline__ int lane_id() { int l; asm volatile("v_mbcnt_lo_u32_b32 %0, -1, 0\n\tv_mbcnt_hi_u32_b32 %0, -1, %0" : "=v"(l)); return l; }
__device__ __forceinline__ int tid_of(int wave_id) { int t = wave_id * 64 + lane_id(); asm volatile("" : "+v"(t)); return t; }
namespace pg8 {
#define PG8_LAS __attribute__((address_space(3)))
typedef unsigned short bf16_t;
typedef short bf16x8 __attribute__((ext_vector_type(8)));
typedef float f32x4 __attribute__((ext_vector_type(4)));
typedef unsigned u32x4 __attribute__((ext_vector_type(4)));
constexpr int BM = 256, BK = 64, HALF = 128, HTB = HALF * BK * 2  , STAGE_BYTES = 8 * HTB, NXCD = 8, WGM = 8;

__host__ __device__ __forceinline__ int lds_byte(int r, int c) { const int st = (r >> 4) * 2 + (c >> 5), rr = r & 15, cc = c & 31, ob = rr * 64 + cc * 2; return st * 1024 + (ob ^ (((ob >> 9) & 1) << 5)); }
__host__ __device__ __forceinline__ void stage_rc(int b, int& R, int& C) { const int st = b / 1024, sb = b % 1024, swz = sb ^ (((sb >> 9) & 1) << 5); R = (st >> 1) * 16 + swz / 64; C = (st & 1) * 32 + (swz % 64) / 2; }
__host__ __device__ __forceinline__ int perm32(int rho) { const int n = rho >> 4, i = rho & 15; return 8 * (i >> 2) + 4 * n + (i & 3); }

struct Unit { int pm, pn, br; };
struct Gemm { const bf16_t* A; const bf16_t* Bt; int M, N, K; };

struct StaticOrder {
    int nM, nN, nwg, G, c;
    __host__ __device__ void init(int M, int N, int G_, int c_) { nM = M / BM; nN = N / BM; nwg = nM * nN; G = G_; c = c_; }
    __host__ __device__ bool next(int i, Unit& u) const {
        const long L = (long)i * G + c; if (L >= nwg) return false;
        int wgid = (int)L; { const int q = nwg / NXCD, r = nwg % NXCD, xcd = wgid % NXCD, off = wgid / NXCD; wgid = (xcd < r ? xcd * (q + 1) : r * (q + 1) + (xcd - r) * q) + off; }
        const int nig = WGM * nN, gid = wgid / nig, fm = gid * WGM, gsz = (nM - fm) < WGM ? (nM - fm) : WGM;
        u.pm = fm + ((wgid % nig) % gsz); u.pn = (wgid % nig) / gsz; u.br = 0; return true;
    }
    __device__ __forceinline__ const char* a_base(const Gemm& g, const Unit& u, size_t tstep) const { return (const char*)g.A + (size_t)u.pm * tstep; }
    __device__ __forceinline__ const char* b_base(const Gemm& g, const Unit& u, size_t tstep) const { return (const char*)g.Bt + (size_t)u.pn * tstep; }
    __device__ __forceinline__ void a_ready(const Unit&) const {}
    __device__ __forceinline__ void done(const Unit&) const {}
};

template <class Epi, class Sched, bool ALIGN_EPI = false, bool SP2 = false>
__device__ __forceinline__ void gemm_phase(PG8_LAS unsigned char* lds, const Gemm g, const Sched& S, const Epi& E, const int wave_id_in) {
    int tid_o = tid_of(wave_id_in);
    const int tid = tid_o, wid = __builtin_amdgcn_readfirstlane(tid >> 6), lane = tid & 63, wr = wid >> 2, wc = wid & 3, fr = lane & 15, fq = lane >> 4;
    const int K = g.K, nt = K / BK;
    unsigned voffA[2], voffB[2];
#pragma unroll
    for (int i = 0; i < 2; ++i) { int R, C; stage_rc(tid * 16 + i * 8192, R, C); const int Rb = Epi::PERM ? ((R & ~31) + perm32(R & 31)) : R;
        voffA[i] = (unsigned)(R * K + C) * 2u; voffB[i] = (unsigned)(Rb * K + C) * 2u; }
    const size_t kstep = (size_t)(BK * 2);
    const size_t hstep = (size_t)HALF * K * 2;
    const size_t tstep = 2 * hstep;
    const unsigned ldsw = (unsigned)wid * 1024u;
    const int aoff = lds_byte(wr * 64 + fr, fq * 8), boff = lds_byte(wc * 32 + fr, fq * 8);
#define PG8_SA(b, h) (((b) * 2 + (h)) * HTB)
#define PG8_SB(b, h) ((4 + (b) * 2 + (h)) * HTB)
#define PG8_STAGE(bufoff, gbase, voff) do { _Pragma("unroll") for (int _i = 0; _i < 2; ++_i) \
        __builtin_amdgcn_global_load_lds((const unsigned*)((const char*)(gbase) + (voff)[_i]), (PG8_LAS unsigned*)(lds + (bufoff) + ldsw + _i * 8192), 16, 0, 0); } while (0)
#define PG8_LDA(dst, b, h) do { _Pragma("unroll") for (int m = 0; m < 4; ++m) _Pragma("unroll") for (int k = 0; k < 2; ++k) dst[m][k] = *(const PG8_LAS bf16x8*)(lds + PG8_SA(b, h) + aoff + m * 2048 + k * 1024); } while (0)
#define PG8_LDB(dst, b, h) do { _Pragma("unroll") for (int n = 0; n < 2; ++n) _Pragma("unroll") for (int k = 0; k < 2; ++k) dst[n][k] = *(const PG8_LAS bf16x8*)(lds + PG8_SB(b, h) + boff + n * 2048 + k * 1024); } while (0)
#define PG8_MMA(ai, bj, At, Bt) do { __builtin_amdgcn_s_setprio(1); _Pragma("unroll") for (int m = 0; m < 4; ++m) _Pragma("unroll") for (int n = 0; n < 2; ++n) _Pragma("unroll") for (int k = 0; k < 2; ++k) \
        acc[ai][bj][m][n] = __builtin_amdgcn_mfma_f32_16x16x32_bf16(Bt[n][k], At[m][k], acc[ai][bj][m][n], 0, 0, 0); __builtin_amdgcn_s_setprio(0); } while (0)
#define PG8_WAIT_V(n) asm volatile("s_waitcnt vmcnt(" #n ")" ::: "memory")
#define PG8_WAIT_L(n) asm volatile("s_waitcnt lgkmcnt(" #n ")" ::: "memory")
#define PG8_BAR __builtin_amdgcn_s_barrier()
#define PG8_SCHED __builtin_amdgcn_sched_barrier(0)
    Unit cur, nxt; int ui = 0;
    if (!S.next(0, cur)) return;
    f32x4 acc[2][2][4][2];
#pragma unroll
    for (int a = 0; a < 2; ++a)
#pragma unroll
        for (int b = 0; b < 2; ++b)
#pragma unroll
            for (int m = 0; m < 4; ++m)
#pragma unroll
                for (int n = 0; n < 2; ++n) acc[a][b][m][n] = (f32x4){0.f, 0.f, 0.f, 0.f};
    bf16x8 At[4][2], B0[2][2], B1[2][2];
    const char* cA = S.a_base(g, cur, tstep); const char* cB = S.b_base(g, cur, tstep);
    S.a_ready(cur);
    if constexpr (SP2) {
        PG8_STAGE(PG8_SB(0, 0), cB, voffB); PG8_STAGE(PG8_SB(0, 1), cB + hstep, voffB); PG8_STAGE(PG8_SA(0, 0), cA, voffA); PG8_STAGE(PG8_SA(0, 1), cA + hstep, voffA);
        if (wr == 1) PG8_BAR;
        PG8_WAIT_V(2); PG8_BAR;
        PG8_STAGE(PG8_SB(1, 0), cB + kstep, voffB); PG8_STAGE(PG8_SA(1, 0), cA + kstep, voffA); PG8_STAGE(PG8_SB(1, 1), cB + hstep + kstep, voffB);
        PG8_WAIT_V(6); PG8_BAR;
    } else {
        PG8_STAGE(PG8_SB(0, 0), cB, voffB); PG8_STAGE(PG8_SA(0, 0), cA, voffA); PG8_STAGE(PG8_SB(0, 1), cB + hstep, voffB); PG8_STAGE(PG8_SA(0, 1), cA + hstep, voffA);
        if (wr == 1) PG8_BAR;
        PG8_WAIT_V(4); PG8_BAR;
        PG8_STAGE(PG8_SB(1, 0), cB + kstep, voffB); PG8_STAGE(PG8_SA(1, 0), cA + kstep, voffA); PG8_STAGE(PG8_SB(1, 1), cB + hstep + kstep, voffB);
        PG8_WAIT_V(6); PG8_BAR;
    }
    for (;;) {
        const bool has_next = S.next(ui + 1, nxt);
        const char* nA = has_next ? S.a_base(g, nxt, tstep) : cA; const char* nB = has_next ? S.b_base(g, nxt, tstep) : cB;
        for (int t = 0; t < nt; t += 2) {
            const bool last = (t == nt - 2);
            const char* a1 = cA + (size_t)(t + 1) * kstep;
            const char* a2 = last ? nA : cA + (size_t)(t + 2) * kstep; const char* b2 = last ? nB : cB + (size_t)(t + 2) * kstep;
            const char* a3 = a2 + kstep; const char* b3 = b2 + kstep;
            if (last && has_next) S.a_ready(nxt);
            if constexpr (SP2) {
            PG8_LDB(B0, 0, 0); PG8_LDB(B1, 0, 1); PG8_SCHED; PG8_LDA(At, 0, 0); PG8_STAGE(PG8_SA(1, 1), a1 + hstep, voffA);
            PG8_WAIT_V(8); PG8_WAIT_L(0); PG8_BAR; PG8_MMA(0, 0, At, B0); PG8_MMA(0, 1, At, B1); PG8_BAR; PG8_SCHED;
            PG8_LDA(At, 0, 1); PG8_STAGE(PG8_SB(0, 0), b2, voffB); PG8_STAGE(PG8_SB(0, 1), b2 + hstep, voffB); PG8_STAGE(PG8_SA(0, 0), a2, voffA);
            PG8_WAIT_V(8); PG8_WAIT_L(0); PG8_BAR; PG8_MMA(1, 0, At, B0); PG8_MMA(1, 1, At, B1); PG8_BAR; PG8_SCHED;
            PG8_LDB(B0, 1, 0); PG8_LDB(B1, 1, 1); PG8_SCHED; PG8_LDA(At, 1, 0); PG8_STAGE(PG8_SA(0, 1), a2 + hstep, voffA);
            PG8_WAIT_V(8); PG8_WAIT_L(0); PG8_BAR; PG8_MMA(0, 0, At, B0); PG8_MMA(0, 1, At, B1); PG8_BAR; PG8_SCHED;
            PG8_LDA(At, 1, 1); PG8_STAGE(PG8_SB(1, 0), b3, voffB); PG8_STAGE(PG8_SB(1, 1), b3 + hstep, voffB); PG8_STAGE(PG8_SA(1, 0), a3, voffA);
            PG8_WAIT_V(8); PG8_WAIT_L(0); PG8_BAR; PG8_MMA(1, 0, At, B0); PG8_MMA(1, 1, At, B1); PG8_BAR; PG8_SCHED;
            } else {
            PG8_LDB(B0, 0, 0); PG8_SCHED; PG8_LDA(At, 0, 0); PG8_STAGE(PG8_SA(1, 1), a1 + hstep, voffA);
            PG8_WAIT_L(8); PG8_BAR; PG8_WAIT_L(0); PG8_MMA(0, 0, At, B0); PG8_BAR; PG8_SCHED;
            PG8_LDB(B1, 0, 1); PG8_STAGE(PG8_SB(0, 0), b2, voffB);
            PG8_BAR; PG8_WAIT_L(0); PG8_MMA(0, 1, At, B1); PG8_BAR;
            PG8_LDA(At, 0, 1); PG8_STAGE(PG8_SA(0, 0), a2, voffA);
            PG8_BAR; PG8_WAIT_L(0); PG8_MMA(1, 0, At, B0); PG8_BAR; PG8_SCHED;
            PG8_STAGE(PG8_SB(0, 1), b2 + hstep, voffB);
            PG8_WAIT_V(6); PG8_BAR; PG8_MMA(1, 1, At, B1); PG8_BAR;
            PG8_LDB(B0, 1, 0); PG8_SCHED; PG8_LDA(At, 1, 0); PG8_STAGE(PG8_SA(0, 1), a2 + hstep, voffA);
            PG8_WAIT_L(8); PG8_BAR; PG8_WAIT_L(0); PG8_MMA(0, 0, At, B0); PG8_BAR; PG8_SCHED;
            PG8_LDB(B1, 1, 1); PG8_STAGE(PG8_SB(1, 0), b3, voffB);
            PG8_BAR; PG8_WAIT_L(0); PG8_MMA(0, 1, At, B1); PG8_BAR;
            PG8_LDA(At, 1, 1); PG8_STAGE(PG8_SA(1, 0), a3, voffA);
            PG8_BAR; PG8_WAIT_L(0); PG8_MMA(1, 0, At, B0); PG8_BAR; PG8_SCHED;
            PG8_STAGE(PG8_SB(1, 1), b3 + hstep, voffB);
            PG8_WAIT_V(6); PG8_BAR; PG8_MMA(1, 1, At, B1); PG8_BAR;
            }
        }
        if constexpr (ALIGN_EPI) { if (wr == 0) PG8_BAR; }
        if constexpr (!Epi::AFTER_DRAIN) { E(acc, cur, wr, wc, fr, fq); S.done(cur); }
        if (!has_next) break;
#pragma unroll
        for (int a = 0; a < 2; ++a)
#pragma unroll
            for (int b = 0; b < 2; ++b)
#pragma unroll
                for (int m = 0; m < 4; ++m)
#pragma unroll
                    for (int n = 0; n < 2; ++n) acc[a][b][m][n] = (f32x4){0.f, 0.f, 0.f, 0.f};
        cur = nxt; cA = nA; cB = nB; ++ui;
        if constexpr (ALIGN_EPI) { if (wr == 1) PG8_BAR; }
    }
    PG8_WAIT_V(0);
    if constexpr (!ALIGN_EPI) { if (wr == 0) PG8_BAR; }
    PG8_BAR;
    if constexpr (Epi::AFTER_DRAIN) { E.fused(acc, cur, wr, wc, fr, fq, lds, wid, lane); S.done(cur); }
#undef PG8_SA
#undef PG8_SB
#undef PG8_STAGE
#undef PG8_LDA
#undef PG8_LDB
#undef PG8_MMA
#undef PG8_WAIT_V
#undef PG8_WAIT_L
#undef PG8_BAR
#undef PG8_SCHED
}
}

constexpr int D_MODEL = 2048, BATCH = 4, SEQ = 2048, CTX = 256, GRID_W = 64, NHEAD = 8, HD = 128, WA = 1024;
constexpr int FFN = 5632, IN_COLS = 12288, NMOD = 6;
constexpr int ML = BATCH * SEQ;
constexpr int MC = BATCH * CTX;
constexpr int MT = ML + MC;
constexpr float EPS = 1e-6f;
constexpr int NTHREADS = 512;
constexpr int VT_PITCH = SEQ + CTX;

typedef unsigned short bf16;
typedef float f32x4 __attribute__((ext_vector_type(4)));
typedef unsigned u32x2 __attribute__((ext_vector_type(2)));
typedef unsigned u32x4 __attribute__((ext_vector_type(4)));
#define LAS __attribute__((address_space(3)))

typedef float f32x2_t __attribute__((ext_vector_type(2)));
typedef __bf16 bf16x2_t __attribute__((ext_vector_type(2)));
__device__ __forceinline__ unsigned pk2(float lo, float hi) { const f32x2_t v = {lo, hi}; const bf16x2_t b = __builtin_convertvector(v, bf16x2_t); return __builtin_bit_cast(unsigned, b); }
__device__ __forceinline__ unsigned f2bf(float f) { return pk2(f, 0.f) & 0xffffu; }
__device__ __forceinline__ float bf2f(unsigned short h) { return __builtin_bit_cast(float, (unsigned)h << 16); }
__device__ __forceinline__ float bflo(unsigned w) { return __builtin_bit_cast(float, w << 16); }
__device__ __forceinline__ float bfhi(unsigned w) { return __builtin_bit_cast(float, w & 0xffff0000u); }
__device__ __forceinline__ float sigmoidf_(float x) { return __builtin_amdgcn_rcpf(1.0f + __expf(-x)); }
__device__ __forceinline__ float siluf_(float x) { return x * __builtin_amdgcn_rcpf(1.0f + __expf(-x)); }
__device__ __forceinline__ float wave_sum(float v) {
#pragma unroll
    for (int o = 1; o < 64; o <<= 1) v += __shfl_xor(v, o);
    return v;
}
__device__ __forceinline__ float wave_max(float v) {
#pragma unroll
    for (int o = 1; o < 64; o <<= 1) v = fmaxf(v, __shfl_xor(v, o));
    return v;
}

constexpr size_t al256(size_t x) { return (x + 255) & ~(size_t)255; }
constexpr size_t WS_CTL   = 0;
constexpr size_t CTL_ZERO_BYTES = 1u << 20;
constexpr size_t WS_ROWSQ = 64 * 1024;
constexpr size_t WS_BIAS2 = WS_ROWSQ + (size_t)ML * 4;
static_assert(WS_BIAS2 + (size_t)4 * 2 * FFN * 4 <= CTL_ZERO_BYTES, "ctl");
constexpr size_t WS_MOD   = CTL_ZERO_BYTES;
constexpr size_t WS_LB    = al256(WS_MOD + (size_t)5 * IN_COLS * 4);
constexpr size_t WS_ROPE  = al256(WS_LB + 2 * WA * 4);
constexpr size_t WS_SMALL_END = al256(WS_ROPE + 2 * 64 * 32 * 4);
constexpr size_t WS_W13T  = al256(WS_SMALL_END);
constexpr size_t WS_W2T   = WS_W13T + (size_t)2 * FFN * D_MODEL * 2;
constexpr size_t WS_WAT   = WS_W2T + (size_t)D_MODEL * FFN * 2;
constexpr size_t WS_WBT   = WS_WAT + (size_t)D_MODEL * WA * 2;
constexpr size_t WS_WOT   = WS_WBT + (size_t)D_MODEL * WA * 2;
constexpr size_t WS_A_END = WS_WOT + (size_t)D_MODEL * D_MODEL * 2;
constexpr size_t SEGB = (size_t)MT * WA * 2;
constexpr size_t WS_QA  = WS_A_END;
constexpr size_t WS_FW  = WS_QA + SEGB;
constexpr size_t WS_FB  = WS_FW + 2 * SEGB;
constexpr size_t WS_IA  = WS_FB + 2 * SEGB;
constexpr size_t WS_GA  = WS_IA + SEGB;
constexpr size_t WS_QN  = WS_GA + (size_t)ML * WA * 2;
constexpr size_t WS_KN  = WS_QN + (size_t)ML * WA * 2;
constexpr size_t WS_VN  = WS_KN + SEGB;
constexpr size_t WS_GTA = WS_VN + SEGB;
constexpr size_t WS_GTB = WS_GTA + (size_t)ML * D_MODEL * 2;
constexpr size_t WS_D_END = WS_GTB + (size_t)ML * D_MODEL * 2;
constexpr size_t WS_WINT = WS_D_END;
constexpr size_t WS_OF   = WS_WINT;
constexpr size_t WS_OB   = WS_OF + (size_t)ML * WA * 2;
constexpr size_t WS_B_END = WS_WINT + (size_t)IN_COLS * D_MODEL * 2;
static_assert(WS_OB + (size_t)ML * WA * 2 <= WS_B_END, "B");
constexpr size_t WS_H   = WS_B_END;
constexpr size_t WS_YA  = WS_H;
constexpr size_t WS_YB  = WS_YA + (size_t)ML * WA * 2;
constexpr size_t WS_C_END = WS_H + (size_t)MT * D_MODEL * 2;
constexpr size_t WS_ACT_END = WS_D_END + (size_t)ML * FFN * 2;
constexpr size_t WS_HIMG = WS_WINT;
constexpr size_t WS_HIMG_END = WS_HIMG + (size_t)64 * 36 * 41472;
constexpr size_t WS_T1 = WS_WINT;
constexpr size_t WS_END0 = WS_C_END > WS_ACT_END ? WS_C_END : WS_ACT_END;
constexpr size_t WS_END = WS_END0 > WS_HIMG_END ? WS_END0 : WS_HIMG_END;
static_assert(WS_END <= 445000000, "ws budget");
constexpr size_t WS_Z   = WS_QA;
constexpr size_t WS_XMG = WS_GTB;
constexpr size_t WS_HALO = WS_QA;
static_assert(WS_HALO + (size_t)32 * 6 * FFN * 4 <= WS_XMG, "HALO overlay");
constexpr size_t WS_ACT = WS_WINT;
static_assert(WS_ACT + (size_t)ML * FFN * 2 <= WS_END, "ACT overlay");

struct Params {
    const float *x, *c, *ctx, *c_ctx, *ada_w, *ada_b, *norm1_g, *norm2_g, *w_in, *lb_logits, *hgrn_norm_g, *q_norm_g, *k_norm_g, *rel_bias,
                *w_a, *w_b, *w_o, *w1, *w3, *conv_w, *conv_b, *w2;
    float* out;
    unsigned char* ws;
    int wave_id, pad;
};

template <bool QKPERM, bool BIAS>
__device__ __forceinline__ void transpose_item(const float* W, int K, int N, bf16* WT, int row_off, LAS float* scr, int item, int lane, const float* sh2 = nullptr, float* bias2 = nullptr) {
    const int nblk = N / 32, kb = item / nblk, nb = item % nblk, k0 = 64 * kb, n0 = 32 * nb;
    if (BIAS) row_off += (n0 >> 7) * 128;
    float wv[32];
#pragma unroll
    for (int i = 0; i < 32; ++i) wv[i] = __builtin_nontemporal_load(W + (size_t)(k0 + 2 * i + (lane >> 5)) * N + n0 + (lane & 31));
#pragma unroll
    for (int i = 0; i < 32; ++i) scr[(2 * i + (lane >> 5)) * 33 + (lane & 31)] = wv[i];
    if (BIAS) {
        float a0 = 0.f, a1 = 0.f, a2 = 0.f, a3 = 0.f;
#pragma unroll
        for (int i = 0; i < 32; ++i) { const int k = k0 + 2 * i + (lane >> 5); const float w = wv[i];
            a0 += w * sh2[0 * IN_COLS + k]; a1 += w * sh2[1 * IN_COLS + k]; a2 += w * sh2[2 * IN_COLS + k]; a3 += w * sh2[3 * IN_COLS + k]; }
        a0 += __shfl_xor(a0, 32); a1 += __shfl_xor(a1, 32); a2 += __shfl_xor(a2, 32); a3 += __shfl_xor(a3, 32);
        if (lane < 32) { float* bp = bias2 + row_off + n0 + lane; atomicAdd(bp, a0); atomicAdd(bp + 2 * FFN, a1); atomicAdd(bp + 4 * FFN, a2); atomicAdd(bp + 6 * FFN, a3); }
    }
    asm volatile("s_waitcnt lgkmcnt(0)" ::: "memory");
    const int c = lane & 7;
#pragma unroll
    for (int j = 0; j < 4; ++j) { const int n = (lane >> 3) + 8 * j; const LAS float* s = scr + (8 * c) * 33 + n;
        u32x4 o; o.x = pk2(s[0 * 33], s[1 * 33]); o.y = pk2(s[2 * 33], s[3 * 33]); o.z = pk2(s[4 * 33], s[5 * 33]); o.w = pk2(s[6 * 33], s[7 * 33]);
        int cdst = n0 + n;
        if (QKPERM && cdst >= 5 * WA && cdst < 7 * WA) cdst = (cdst & ~0x30) | ((cdst & 0x10) << 1) | ((cdst & 0x20) >> 1);
        *(u32x4*)(WT + (size_t)(row_off + cdst) * K + k0 + 8 * c) = o; }
    asm volatile("s_waitcnt lgkmcnt(0)" ::: "memory");
}
__device__ __forceinline__ void phase_wconv_in(const Params& p, LAS unsigned char* lds, int gw, int NGW) {
    const int lane = lane_id(), wave = p.wave_id;
    LAS float* scr = (LAS float*)(lds + wave * 16384);
    constexpr int I_IN = (D_MODEL / 64) * (IN_COLS / 32);
    for (int it = gw; it < I_IN; it += NGW) transpose_item<true, false>(p.w_in, D_MODEL, IN_COLS, (bf16*)(p.ws + WS_WINT), 0, scr, it, lane);
}
__device__ __forceinline__ void phase_wconv_rest(const Params& p, LAS unsigned char* lds, int gw, int NGW) {
    const int lane = lane_id(), wave = p.wave_id;
    LAS float* scr = (LAS float*)(lds + 16384 + wave * 16384);
    constexpr int I_A = (WA / 64) * (D_MODEL / 32), I_O = (D_MODEL / 64) * (D_MODEL / 32), I_1 = (D_MODEL / 64) * (FFN / 32), I_2 = (FFN / 64) * (D_MODEL / 32);
    constexpr int NITEMS = 2 * I_A + I_O + 2 * I_1 + I_2;
    unsigned char* ws = p.ws;
    const float* sh2 = (const float*)(ws + WS_MOD) + 3 * D_MODEL; float* b2 = (float*)(ws + WS_BIAS2);
    for (int it = gw; it < NITEMS; it += NGW) {
        int r = it;
        if (r < I_A) { transpose_item<false, false>(p.w_a, WA, D_MODEL, (bf16*)(ws + WS_WAT), 0, scr, r, lane); continue; } r -= I_A;
        if (r < I_A) { transpose_item<false, false>(p.w_b, WA, D_MODEL, (bf16*)(ws + WS_WBT), 0, scr, r, lane); continue; } r -= I_A;
        if (r < I_O) { transpose_item<false, false>(p.w_o, D_MODEL, D_MODEL, (bf16*)(ws + WS_WOT), 0, scr, r, lane); continue; } r -= I_O;
        if (r < I_1) { transpose_item<false, true>(p.w1, D_MODEL, FFN, (bf16*)(ws + WS_W13T), 0, scr, r, lane, sh2, b2); continue; } r -= I_1;
        if (r < I_1) { transpose_item<false, true>(p.w3, D_MODEL, FFN, (bf16*)(ws + WS_W13T), 128, scr, r, lane, sh2, b2); continue; } r -= I_1;
        transpose_item<false, false>(p.w2, FFN, D_MODEL, (bf16*)(ws + WS_W2T), 0, scr, r, lane);
    }
}

__device__ __forceinline__ void phase_mod(const Params& p, LAS unsigned char* lds, int vb, int nb) {
    const int tid = tid_of(p.wave_id);
    LAS float* sc = (LAS float*)lds;
    LAS float* red = (LAS float*)(lds + 5 * 2048 * 4);
    for (int i = tid; i < 5 * D_MODEL; i += NTHREADS) { const int r = i / D_MODEL, k = i % D_MODEL; const float v = (r < 4) ? p.c[r * D_MODEL + k] : p.c_ctx[k]; sc[i] = siluf_(v); }
    __syncthreads();
    float* mod = (float*)(p.ws + WS_MOD);
    const int c4 = tid & 15, kp = tid >> 4;
    for (int item = vb; item < IN_COLS / 64; item += nb) {
        const int n0 = item * 64 + c4 * 4;
        f32x4 acc[5];
#pragma unroll
        for (int r = 0; r < 5; ++r) acc[r] = (f32x4){0.f, 0.f, 0.f, 0.f};
#pragma unroll 8
        for (int k = kp; k < D_MODEL; k += 32) {
            const f32x4 w = __builtin_nontemporal_load((const f32x4*)(p.ada_w + (size_t)k * IN_COLS + n0));
#pragma unroll
            for (int r = 0; r < 5; ++r) acc[r] += w * sc[r * D_MODEL + k];
        }
#pragma unroll
        for (int r = 0; r < 5; ++r) *(LAS f32x4*)(red + (kp * 5 + r) * 64 + c4 * 4) = acc[r];
        __syncthreads();
        if (tid < 320) { const int r = tid / 64, cidx = tid % 64; float s = 0.f;
            for (int q = 0; q < 32; ++q) s += red[(q * 5 + r) * 64 + cidx];
            const int gc = item * 64 + cidx; float v = s + p.ada_b[gc];
            if (gc >= 4 * D_MODEL && gc < 5 * D_MODEL) v = p.norm2_g[gc - 4 * D_MODEL] * (1.0f + v);
            mod[r * IN_COLS + gc] = v; }
        __syncthreads();
    }
    if (vb == nb - 1) { float* rt = (float*)(p.ws + WS_ROPE);
        for (int i = tid; i < 64 * 32; i += NTHREADS) { const int pos = i >> 5, j = i & 31; const float inv = exp2f(-(float)j * (13.287712379549449f / 32.0f)); float sn, cs; sincosf((float)pos * inv, &sn, &cs); rt[i] = cs; rt[2048 + i] = sn; } }
    if (vb == 0) { float* lb = (float*)(p.ws + WS_LB);
        for (int i = tid; i < 2 * WA; i += NTHREADS) { const int d = i / WA, cc = i % WA; const float l0 = p.lb_logits[d * 2 * WA + cc], l1 = p.lb_logits[d * 2 * WA + WA + cc]; lb[i] = 1.0f / (1.0f + expf(l1 - l0)); } }
}

__device__ __forceinline__ void phase_h(const Params& p, int vb, int nb) {
    const int tid = tid_of(p.wave_id), lane = tid & 63, wave = p.wave_id;
    const float* mod = (const float*)(p.ws + WS_MOD);
    bf16* H = (bf16*)(p.ws + WS_H);
    for (int m = vb * 8 + wave; m < MT; m += nb * 8) {
        const float* xr = (m < ML) ? p.x + (size_t)m * D_MODEL : p.ctx + (size_t)(m - ML) * D_MODEL;
        const int mr = (m < ML) ? (m / SEQ) : 4;
        const float* sh = mod + (size_t)mr * IN_COLS, *scl = sh + D_MODEL;
        f32x4 v[8]; float s = 0.f;
#pragma unroll
        for (int j = 0; j < 8; ++j) { v[j] = *(const f32x4*)(xr + 4 * lane + 256 * j); s += (v[j].x * v[j].x + v[j].y * v[j].y) + (v[j].z * v[j].z + v[j].w * v[j].w); }
        const float rstd = __builtin_amdgcn_rsqf(wave_sum(s) * (1.0f / D_MODEL) + EPS);
#pragma unroll
        for (int j = 0; j < 8; ++j) { const int k = 4 * lane + 256 * j;
            const f32x4 g = *(const f32x4*)(p.norm1_g + k), a = *(const f32x4*)(scl + k), b = *(const f32x4*)(sh + k);
            const f32x4 h = v[j] * rstd * g * (a + 1.0f) + b;
            u32x2 o; o.x = pk2(h.x, h.y); o.y = pk2(h.z, h.w);
            *(u32x2*)(H + (size_t)m * D_MODEL + k) = o; }
    }
}

#define EPI_LOOP_BEGIN \
    _Pragma("unroll") for (int ai = 0; ai < 2; ++ai) _Pragma("unroll") for (int m = 0; m < 4; ++m) { const int row = u.pm * 256 + ai * 128 + wr * 64 + m * 16 + fr; \
    _Pragma("unroll") for (int bj = 0; bj < 2; ++bj) _Pragma("unroll") for (int n = 0; n < 2; ++n) { const int col = u.pn * 256 + bj * 128 + wc * 32 + n * 16 + fq * 4; const f32x4 v = acc[ai][bj][m][n];
#define EPI_LOOP_END } }

struct EpiInProj {
    static constexpr bool PERM = false, AFTER_DRAIN = false;
    unsigned char* ws; LAS unsigned char* lds; const float* qg; const float* kg;
    __device__ __forceinline__ void operator()(const f32x4 (&acc)[2][2][4][2], const pg8::Unit& u, int wr, int wc, int fr, int fq) const {
        { const int l_ = lane_id(); fr = l_ & 15; fq = l_ >> 4; }
        const int seg = u.pn >> 2;
        const bool ctxrow = u.pm >= ML / 256;
        const float* lb = (const float*)(ws + WS_LB);
        if (seg == 1 || seg == 2) {
            float* F = (float*)(ws + (seg == 1 ? WS_FW : WS_FB)); const float* lbd = lb + (seg - 1) * WA;
            f32x4 lbv[2][2];
#pragma unroll
            for (int bj = 0; bj < 2; ++bj)
#pragma unroll
                for (int n = 0; n < 2; ++n) lbv[bj][n] = *(const f32x4*)(lbd + u.pn * 256 + bj * 128 + wc * 32 + n * 16 + fq * 4 - seg * WA);
            EPI_LOOP_BEGIN
                const int c = col - seg * WA; const f32x4 l = lbv[bj][n]; f32x4 o;
                o.x = __logf(l.x + (1.0f - l.x) * sigmoidf_(v.x)); o.y = __logf(l.y + (1.0f - l.y) * sigmoidf_(v.y));
                o.z = __logf(l.z + (1.0f - l.z) * sigmoidf_(v.z)); o.w = __logf(l.w + (1.0f - l.w) * sigmoidf_(v.w));
                *(f32x4*)(F + (size_t)row * WA + c) = o;
            EPI_LOOP_END
        } else if (seg == 7) {
            bf16* VT = (bf16*)(ws + WS_VN);
            EPI_LOOP_BEGIN
                const int c = col - 7 * WA; const int hh = c >> 7, d = c & 127;
                int bb, tok; if (row < ML) { bb = row / SEQ; tok = row % SEQ; } else { bb = (row - ML) / CTX; tok = SEQ + (row - ML) % CTX; }
                bf16* o = VT + ((size_t)(bb * NHEAD + hh) * HD + d) * VT_PITCH + tok;
                o[0] = (bf16)f2bf(v.x); o[VT_PITCH] = (bf16)f2bf(v.y); o[2 * VT_PITCH] = (bf16)f2bf(v.z); o[3 * VT_PITCH] = (bf16)f2bf(v.w);
            EPI_LOOP_END
        } else if (seg == 5 || seg == 6) {
            if (ctxrow && seg == 5) return;
            LAS float* ssq = (LAS float*)(lds + 131072);
            const float* gn = (seg == 5) ? qg : kg; const float* rt = (const float*)(ws + WS_ROPE);
            bf16* O = (bf16*)(ws + (seg == 5 ? WS_QN : WS_KN));
#pragma unroll
            for (int ai = 0; ai < 2; ++ai)
#pragma unroll
                for (int m = 0; m < 4; ++m)
#pragma unroll
                    for (int bj = 0; bj < 2; ++bj) { const f32x4 a = acc[ai][bj][m][0], b = acc[ai][bj][m][1];
                        float sq = (a.x * a.x + a.y * a.y) + (a.z * a.z + a.w * a.w) + (b.x * b.x + b.y * b.y) + (b.z * b.z + b.w * b.w);
                        sq += __shfl_xor(sq, 16); sq += __shfl_xor(sq, 32);
                        if (fq == 0) ssq[((ai * 128 + wr * 64 + m * 16 + fr) * 2 + bj) * 4 + wc] = sq; }
            asm volatile("s_waitcnt lgkmcnt(0)" ::: "memory"); __builtin_amdgcn_s_barrier(); asm volatile("" ::: "memory");
            const int H = wc >> 1, jj = 16 * (wc & 1) + 4 * fq;
            const f32x4 g0 = *(const f32x4*)(gn + 64 * H + jj), g1 = *(const f32x4*)(gn + 64 * H + 32 + jj);
#pragma unroll
            for (int ai = 0; ai < 2; ++ai)
#pragma unroll
                for (int m = 0; m < 4; ++m) { const int rl = ai * 128 + wr * 64 + m * 16 + fr; const int row = u.pm * 256 + rl;
                    f32x4 cs = (f32x4){1.f, 1.f, 1.f, 1.f}, sn = (f32x4){0.f, 0.f, 0.f, 0.f};
                    if (!ctxrow) { const int t = row & (SEQ - 1); const int pos = (H == 0) ? (t >> 6) : (t & 63); cs = *(const f32x4*)(rt + pos * 32 + jj); sn = *(const f32x4*)(rt + 2048 + pos * 32 + jj); }
#pragma unroll
                    for (int bj = 0; bj < 2; ++bj) { const f32x4 s4 = *(const LAS f32x4*)(ssq + (rl * 2 + bj) * 4);
                        const float rstd = __builtin_amdgcn_rsqf(((s4.x + s4.y) + (s4.z + s4.w)) * (1.0f / HD) + EPS);
                        const f32x4 u1 = acc[ai][bj][m][0] * rstd * g0, u2 = acc[ai][bj][m][1] * rstd * g1;
                        const f32x4 o1 = u1 * cs - u2 * sn, o2 = u1 * sn + u2 * cs;
                        bf16* op = O + (size_t)row * WA + (u.pn & 3) * 256 + bj * 128 + wc * 32 + fq * 4;
                        u32x2 w1; w1.x = pk2(o1.x, o1.y); w1.y = pk2(o1.z, o1.w); *(u32x2*)op = w1;
                        u32x2 w2; w2.x = pk2(o2.x, o2.y); w2.y = pk2(o2.z, o2.w); *(u32x2*)(op + 16) = w2; }
                    asm volatile("" ::: "memory"); }
            asm volatile("s_waitcnt lgkmcnt(0)" ::: "memory"); __builtin_amdgcn_s_barrier(); asm volatile("" ::: "memory");
        } else if (seg == 0 || seg == 3) {
            if (ctxrow && seg == 0) return;
            bf16* O = (bf16*)(ws + (seg == 0 ? WS_QA : WS_IA));
            EPI_LOOP_BEGIN
                const int c = col - seg * WA; u32x2 o; o.x = pk2(v.x, v.y); o.y = pk2(v.z, v.w);
                *(u32x2*)(O + (size_t)row * WA + c) = o;
            EPI_LOOP_END
        } else if (seg == 4) {
            if (ctxrow) return;
            bf16* O = (bf16*)(ws + WS_GA);
            EPI_LOOP_BEGIN
                const int c = col - seg * WA; u32x2 o; o.x = pk2(siluf_(v.x), siluf_(v.y)); o.y = pk2(siluf_(v.z), siluf_(v.w));
                *(u32x2*)(O + (size_t)row * WA + c) = o;
            EPI_LOOP_END
        } else {
            if (ctxrow) return;
            const bool isa = seg < 10;
            bf16* O = (bf16*)(ws + (isa ? WS_GTA : WS_GTB)); const int cbase = isa ? 8 * WA : 10 * WA;
            EPI_LOOP_BEGIN
                const int c = col - cbase; u32x2 o; o.x = pk2(sigmoidf_(v.x), sigmoidf_(v.y)); o.y = pk2(sigmoidf_(v.z), sigmoidf_(v.w));
                *(u32x2*)(O + (size_t)row * D_MODEL + c) = o;
            EPI_LOOP_END
        }
    }
};

constexpr int CTX_UNITS = (MC / 256) * 20;
struct InProjOrder : pg8::StaticOrder {
    __device__ bool next(int i, pg8::Unit& u) const {
        if (pg8::StaticOrder::next(i, u)) return true;
        const long L = (long)i * G + c - nwg; if (L < 0 || L >= CTX_UNITS) return false;
        const int t = (int)L, j = t % 20; u.pm = ML / 256 + t / 20; u.pn = (j < 12) ? 4 + j : 12 + j; u.br = 0; return true; }
};
struct MergeOrder : pg8::StaticOrder {
    const bf16* A1; const bf16* B1;
    __device__ bool next(int i, pg8::Unit& u) const { if (!pg8::StaticOrder::next(i >> 1, u)) return false; u.br = i & 1; return true; }
    __device__ __forceinline__ const char* a_base(const pg8::Gemm& g, const pg8::Unit& u, size_t tstep) const { return (const char*)(u.br ? A1 : g.A) + (size_t)u.pm * tstep; }
    __device__ __forceinline__ const char* b_base(const pg8::Gemm& g, const pg8::Unit& u, size_t tstep) const { return (const char*)(u.br ? B1 : g.Bt) + (size_t)u.pn * tstep; }
};
#define EPI_BATCH_BEGIN _Pragma("unroll") for (int ai = 0; ai < 2; ++ai) _Pragma("unroll") for (int mh = 0; mh < 4; mh += 2) {
#define EPI_BATCH_END }
#define EPI_VEC_LOOP _Pragma("unroll") for (int m2 = 0; m2 < 2; ++m2) _Pragma("unroll") for (int bj = 0; bj < 2; ++bj) _Pragma("unroll") for (int n = 0; n < 2; ++n)
#define EPI_VEC_IDX const int m = mh + m2, vi = (m2 * 2 + bj) * 2 + n; const int row = u.pm * 256 + ai * 128 + wr * 64 + m * 16 + fr, col = u.pn * 256 + bj * 128 + wc * 32 + n * 16 + fq * 4; (void)vi
#define EPI_WVEC_LOOP _Pragma("unroll") for (int m2 = 0; m2 < 2; ++m2) _Pragma("unroll") for (int bj = 0; bj < 2; ++bj)
#define EPI_WVEC_IDX const int m = mh + m2, wi = m2 * 2 + bj; const int row = u.pm * 256 + ai * 128 + wr * 64 + m * 16 + fr, col = u.pn * 256 + bj * 128 + wc * 32 + fq * 8; const unsigned off = (unsigned)(row * D_MODEL + col); (void)wi; (void)off
#define EPI_PIPE_IDX(b_) const int ai = (b_) >> 1, mh = 2 * ((b_) & 1); (void)ai; (void)mh
struct EpiMerge {
    static constexpr bool PERM = true, AFTER_DRAIN = false;
    unsigned char* ws; bf16* tmp;
    __device__ __forceinline__ void operator()(const f32x4 (&acc)[2][2][4][2], const pg8::Unit& u, int wr, int wc, int fr, int fq) const {
        { const int l_ = lane_id(); fr = l_ & 15; fq = l_ >> 4; }
        if (u.br == 0) {
            const bf16* G = (const bf16*)(ws + WS_GTA);
            u32x4 gv[4][4];
#pragma unroll
            for (int b = 0; b < 4; ++b) { EPI_PIPE_IDX(b); EPI_WVEC_LOOP { EPI_WVEC_IDX; gv[b][wi] = *(const u32x4*)(G + off); } }
#pragma unroll
            for (int b = 0; b < 4; ++b) { EPI_PIPE_IDX(b); EPI_WVEC_LOOP { EPI_WVEC_IDX; const u32x4 g = gv[b][wi]; const f32x4 v0 = acc[ai][bj][m][0], v1 = acc[ai][bj][m][1];
                    u32x4 o; o.x = pk2(bflo(g.x) * v0.x, bfhi(g.x) * v0.y); o.y = pk2(bflo(g.y) * v0.z, bfhi(g.y) * v0.w);
                    o.z = pk2(bflo(g.z) * v1.x, bfhi(g.z) * v1.y); o.w = pk2(bflo(g.w) * v1.z, bfhi(g.w) * v1.w);
                    *(u32x4*)(tmp + off) = o; } }
        } else {
            const bf16* G = (const bf16*)(ws + WS_GTB); bf16* Z = (bf16*)(ws + WS_Z);
            u32x4 gv[2][4], tv[2][4];
            { EPI_PIPE_IDX(0); EPI_WVEC_LOOP { EPI_WVEC_IDX; gv[0][wi] = *(const u32x4*)(G + off); tv[0][wi] = *(const u32x4*)(tmp + off); } }
#pragma unroll
            for (int b = 0; b < 4; ++b) {
                if (b < 3) { EPI_PIPE_IDX(b + 1); EPI_WVEC_LOOP { EPI_WVEC_IDX; gv[(b + 1) & 1][wi] = *(const u32x4*)(G + off); tv[(b + 1) & 1][wi] = *(const u32x4*)(tmp + off); } }
                { EPI_PIPE_IDX(b); EPI_WVEC_LOOP { EPI_WVEC_IDX; const u32x4 g = gv[b & 1][wi], t = tv[b & 1][wi]; const f32x4 v0 = acc[ai][bj][m][0], v1 = acc[ai][bj][m][1];
                    u32x4 o; o.x = pk2(bflo(t.x) + bflo(g.x) * v0.x, bfhi(t.x) + bfhi(g.x) * v0.y); o.y = pk2(bflo(t.y) + bflo(g.y) * v0.z, bfhi(t.y) + bfhi(g.y) * v0.w);
                    o.z = pk2(bflo(t.z) + bflo(g.z) * v1.x, bfhi(t.z) + bfhi(g.z) * v1.y); o.w = pk2(bflo(t.w) + bflo(g.w) * v1.z, bfhi(t.w) + bfhi(g.w) * v1.w);
                    *(u32x4*)(Z + off) = o; } }
            }
        }
    }
};
struct EpiOutProj {
    static constexpr bool PERM = true, AFTER_DRAIN = false;
    unsigned char* ws; const float* x; const float* norm2_g; float* out;
    __device__ __forceinline__ void operator()(const f32x4 (&acc)[2][2][4][2], const pg8::Unit& u, int wr, int wc, int fr, int fq) const {
        { const int l_ = lane_id(); fr = l_ & 15; fq = l_ >> 4; }
        const float* mod = (const float*)(ws + WS_MOD); bf16* XMG = (bf16*)(ws + WS_XMG); float* rowsq = (float*)(ws + WS_ROWSQ);
        const int bb = (u.pm * 256) / SEQ;
        const float* g1 = mod + (size_t)bb * IN_COLS + 2 * D_MODEL, *sc2 = mod + (size_t)bb * IN_COLS + 4 * D_MODEL;
        float ss[2][4];
#pragma unroll
        for (int ai = 0; ai < 2; ++ai)
#pragma unroll
            for (int m = 0; m < 4; ++m) ss[ai][m] = 0.f;
#pragma unroll
        for (int bj = 0; bj < 2; ++bj) {
            const int col = u.pn * 256 + bj * 128 + wc * 32 + fq * 8;
            const f32x4 cg0 = *(const f32x4*)(g1 + col), cg1 = *(const f32x4*)(g1 + col + 4), ch0 = *(const f32x4*)(sc2 + col), ch1 = *(const f32x4*)(sc2 + col + 4);
            f32x4 xv[2][4][2];
#pragma unroll
            for (int ai = 0; ai < 2; ++ai)
#pragma unroll
                for (int m = 0; m < 4; ++m) { const unsigned off = (unsigned)((u.pm * 256 + ai * 128 + wr * 64 + m * 16 + fr) * D_MODEL + col); xv[ai][m][0] = *(const f32x4*)((const char*)x + off * 4u); xv[ai][m][1] = *(const f32x4*)((const char*)x + off * 4u + 16); }
#pragma unroll
            for (int ai = 0; ai < 2; ++ai)
#pragma unroll
                for (int m = 0; m < 4; ++m) { const unsigned off = (unsigned)((u.pm * 256 + ai * 128 + wr * 64 + m * 16 + fr) * D_MODEL + col);
                    const f32x4 xm0 = xv[ai][m][0] + cg0 * acc[ai][bj][m][0], xm1 = xv[ai][m][1] + cg1 * acc[ai][bj][m][1];
                    *(f32x4*)((char*)out + off * 4u) = xm0; *(f32x4*)((char*)out + off * 4u + 16) = xm1;
                    ss[ai][m] += ((xm0.x * xm0.x + xm0.y * xm0.y) + (xm0.z * xm0.z + xm0.w * xm0.w)) + ((xm1.x * xm1.x + xm1.y * xm1.y) + (xm1.z * xm1.z + xm1.w * xm1.w));
                    const f32x4 h0 = xm0 * ch0, h1 = xm1 * ch1;
                    u32x4 o; o.x = pk2(h0.x, h0.y); o.y = pk2(h0.z, h0.w); o.z = pk2(h1.x, h1.y); o.w = pk2(h1.z, h1.w);
                    *(u32x4*)((char*)XMG + off * 2u) = o; }
        }
#pragma unroll
        for (int ai = 0; ai < 2; ++ai)
#pragma unroll
            for (int m = 0; m < 4; ++m) { float t = ss[ai][m]; t += __shfl_xor(t, 16); t += __shfl_xor(t, 32);
                if (fq == 0) atomicAdd(rowsq + u.pm * 256 + ai * 128 + wr * 64 + m * 16 + fr, t); }
    }
};
__device__ __forceinline__ float dpp_ror1(float v) { return __builtin_bit_cast(float, __builtin_amdgcn_update_dpp(0, __builtin_bit_cast(int, v), 0x121, 0xf, 0xf, false)); }
__device__ __forceinline__ float dpp_rol1(float v) { return __builtin_bit_cast(float, __builtin_amdgcn_update_dpp(0, __builtin_bit_cast(int, v), 0x12f, 0xf, 0xf, false)); }
__device__ __forceinline__ f32x4 ror1_4(const f32x4 v) { return (f32x4){dpp_ror1(v.x), dpp_ror1(v.y), dpp_ror1(v.z), dpp_ror1(v.w)}; }
__device__ __forceinline__ f32x4 rol1_4(const f32x4 v) { return (f32x4){dpp_rol1(v.x), dpp_rol1(v.y), dpp_rol1(v.z), dpp_rol1(v.w)}; }
struct EpiFfnUp {
    static constexpr bool PERM = true, AFTER_DRAIN = false;
    unsigned char* ws; LAS unsigned char* lds; const float* cw; const float* cb;
    __device__ __forceinline__ void operator()(const f32x4 (&acc_c)[2][2][4][2], const pg8::Unit& u, int wr, int wc, int fr, int fq) const {
        f32x4 (&acc)[2][2][4][2] = const_cast<f32x4 (&)[2][2][4][2]>(acc_c);
        { const int l_ = lane_id(); fr = l_ & 15; fq = l_ >> 4; }
        const float* rowsq = (const float*)(ws + WS_ROWSQ); bf16* ACT = (bf16*)(ws + WS_ACT); float* HALO = (float*)(ws + WS_HALO) + (size_t)u.pm * 6 * FFN;
        const int b = (u.pm * 256) / SEQ; const float* bias2 = (const float*)(ws + WS_BIAS2) + (size_t)b * 2 * FFN + u.pn * 256;
        const int cl = wc * 32 + fq * 8, ch0 = u.pn * 128 + cl;
        LAS float* X = (LAS float*)(lds + 131072);
#pragma unroll
        for (int ai = 0; ai < 2; ++ai)
#pragma unroll
            for (int m = 0; m < 4; ++m) { const int row = u.pm * 256 + ai * 128 + wr * 64 + m * 16 + fr;
                const float rstd = __builtin_amdgcn_rsqf(rowsq[row] * (1.0f / D_MODEL) + EPS);
#pragma unroll
                for (int bj = 0; bj < 2; ++bj)
#pragma unroll
                    for (int n = 0; n < 2; ++n) acc[ai][bj][m][n] = acc[ai][bj][m][n] * rstd + *(const f32x4*)(bias2 + bj * 128 + cl + 4 * n); }
#pragma unroll
        for (int ai = 0; ai < 2; ++ai) { const int bi = 2 * ai + wr;
            if (fr == 0) {
#pragma unroll
                for (int n = 0; n < 2; ++n) *(LAS f32x4*)(X + (bi * 2 + 0) * 128 + cl + 4 * n) = acc[ai][0][0][n]; }
            if (fr == 15) {
#pragma unroll
                for (int n = 0; n < 2; ++n) *(LAS f32x4*)(X + (bi * 2 + 1) * 128 + cl + 4 * n) = acc[ai][0][3][n]; } }
        asm volatile("s_waitcnt lgkmcnt(0)" ::: "memory"); __builtin_amdgcn_s_barrier(); asm volatile("" ::: "memory");
        if (wr == 0 && fr < 2) {
#pragma unroll
            for (int n = 0; n < 2; ++n) { *(f32x4*)(HALO + (size_t)fr * FFN + ch0 + 4 * n) = acc[0][0][0][n]; if (fr == 0) *(f32x4*)(HALO + (size_t)4 * FFN + ch0 + 4 * n) = acc[0][1][0][n]; } }
        if (wr == 1 && fr >= 14) {
#pragma unroll
            for (int n = 0; n < 2; ++n) { *(f32x4*)(HALO + (size_t)(fr - 12) * FFN + ch0 + 4 * n) = acc[1][0][3][n]; if (fr == 15) *(f32x4*)(HALO + (size_t)5 * FFN + ch0 + 4 * n) = acc[1][1][3][n]; } }
        f32x4 w0[2], w1[2], w2[2], cbv[2];
#pragma unroll
        for (int n = 0; n < 2; ++n) { w0[n] = *(const f32x4*)(cw + ch0 + 4 * n); w1[n] = *(const f32x4*)(cw + FFN + ch0 + 4 * n); w2[n] = *(const f32x4*)(cw + 2 * FFN + ch0 + 4 * n); cbv[n] = *(const f32x4*)(cb + ch0 + 4 * n); }
#pragma unroll
        for (int ai = 0; ai < 2; ++ai) { const int bi = 2 * ai + wr;
#pragma unroll
            for (int m = 0; m < 4; ++m) { u32x4 o;
#pragma unroll
                for (int n = 0; n < 2; ++n) { const f32x4 cur = acc[ai][0][m][n];
                    f32x4 pu, nd;
                    if (m > 0) pu = ror1_4(acc[ai][0][m > 0 ? m - 1 : 0][n]); else pu = (bi > 0) ? *(const LAS f32x4*)(X + ((bi - 1) * 2 + 1) * 128 + cl + 4 * n) : (f32x4){0.f, 0.f, 0.f, 0.f};
                    if (m < 3) nd = rol1_4(acc[ai][0][m < 3 ? m + 1 : 3][n]); else nd = (bi < 3) ? *(const LAS f32x4*)(X + ((bi + 1) * 2 + 0) * 128 + cl + 4 * n) : (f32x4){0.f, 0.f, 0.f, 0.f};
                    const f32x4 ps = ror1_4(cur), ns = rol1_4(cur);
                    const f32x4 prev = (fr > 0) ? ps : pu, next = (fr < 15) ? ns : nd;
                    const f32x4 uu = w0[n] * prev + w1[n] * cur + w2[n] * next + cbv[n]; const f32x4 gt = acc[ai][1][m][n];
                    f32x4 r; r.x = siluf_(uu.x) * gt.x; r.y = siluf_(uu.y) * gt.y; r.z = siluf_(uu.z) * gt.z; r.w = siluf_(uu.w) * gt.w;
                    if (n == 0) { o.x = pk2(r.x, r.y); o.y = pk2(r.z, r.w); } else { o.z = pk2(r.x, r.y); o.w = pk2(r.z, r.w); } }
                const int rl = ai * 128 + wr * 64 + m * 16 + fr;
                if (rl != 0 && rl != 255) *(u32x4*)(ACT + (size_t)(u.pm * 256 + rl) * FFN + ch0) = o; } }
    }
};
__device__ __forceinline__ void halo_fix(const Params& p, int pm, int tid) {
    const float* HB = (const float*)(p.ws + WS_HALO); const float* H = HB + (size_t)pm * 6 * FFN; bf16* ACT = (bf16*)(p.ws + WS_ACT);
    for (int ch = tid; ch < FFN; ch += NTHREADS) {
        const float w0 = p.conv_w[ch], w1 = p.conv_w[FFN + ch], w2 = p.conv_w[2 * FFN + ch], cbv = p.conv_b[ch];
        const float pv = (pm & 7) ? HB[((size_t)(pm - 1) * 6 + 3) * FFN + ch] : 0.f; const float nx = ((pm & 7) != 7) ? HB[((size_t)(pm + 1) * 6 + 0) * FFN + ch] : 0.f;
        const float ut = w0 * pv + w1 * H[ch] + w2 * H[FFN + ch] + cbv; const float ub = w0 * H[2 * FFN + ch] + w1 * H[3 * FFN + ch] + w2 * nx + cbv;
        ACT[(size_t)(pm * 256) * FFN + ch] = (bf16)f2bf(siluf_(ut) * H[4 * FFN + ch]); ACT[(size_t)(pm * 256 + 255) * FFN + ch] = (bf16)f2bf(siluf_(ub) * H[5 * FFN + ch]);
    }
}
struct EpiFfnDown {
    static constexpr bool PERM = true, AFTER_DRAIN = false;
    unsigned char* ws; float* out;
    __device__ __forceinline__ void operator()(const f32x4 (&acc)[2][2][4][2], const pg8::Unit& u, int wr, int wc, int fr, int fq) const {
        { const int l_ = lane_id(); fr = l_ & 15; fq = l_ >> 4; }
        const float* mod = (const float*)(ws + WS_MOD); const int bb = (u.pm * 256) / SEQ; const float* g2 = mod + (size_t)bb * IN_COLS + 5 * D_MODEL;
        f32x4 cg[2][2];
#pragma unroll
        for (int bj = 0; bj < 2; ++bj)
#pragma unroll
            for (int n = 0; n < 2; ++n) cg[bj][n] = *(const f32x4*)(g2 + u.pn * 256 + bj * 128 + wc * 32 + fq * 8 + 4 * n);
        f32x4 xv[2][4][2];
        { EPI_PIPE_IDX(0); EPI_WVEC_LOOP { EPI_WVEC_IDX; xv[0][wi][0] = *(const f32x4*)(out + off); xv[0][wi][1] = *(const f32x4*)(out + off + 4); } }
#pragma unroll
        for (int b = 0; b < 4; ++b) {
            if (b < 3) { EPI_PIPE_IDX(b + 1); EPI_WVEC_LOOP { EPI_WVEC_IDX; xv[(b + 1) & 1][wi][0] = *(const f32x4*)(out + off); xv[(b + 1) & 1][wi][1] = *(const f32x4*)(out + off + 4); } }
            EPI_PIPE_IDX(b);
            EPI_WVEC_LOOP { EPI_WVEC_IDX; *(f32x4*)(out + off) = xv[b & 1][wi][0] + cg[bj][0] * acc[ai][bj][m][0]; *(f32x4*)(out + off + 4) = xv[b & 1][wi][1] + cg[bj][1] * acc[ai][bj][m][1]; }
        }
    }
};

#define XB_TMO      128
#define XB_XCNT(j)  (256  + 64 * (j))
#define XB_XSUB(j)  (1280 + 64 * (j))
#define XB_XGEN(j)  (2304 + 64 * (j))
#define XB_TOP      3328
#define XB_TOPGEN   3392
#define XCD_BAR_WORDS 3456
#define XB_SPIN_CAP (1u << 18)

__device__ __forceinline__ unsigned xb_ld(unsigned* p)              { return __hip_atomic_load(p, __ATOMIC_RELAXED, __HIP_MEMORY_SCOPE_AGENT); }
__device__ __forceinline__ unsigned xb_add(unsigned* p, unsigned v) { return __hip_atomic_fetch_add(p, v, __ATOMIC_RELAXED, __HIP_MEMORY_SCOPE_AGENT); }
__device__ __forceinline__ unsigned xb_xcc_id() { return (unsigned)__builtin_amdgcn_s_getreg((3 << 11) | 20) & 0xFu; }
#define XB_SPIN(cond, bar) do { unsigned _sp = 0; while (cond) { __builtin_amdgcn_s_sleep(1); \
    if ((++_sp & 255u) == 0u) { if (xb_ld(&(bar)[XB_TMO])) break; if (_sp > XB_SPIN_CAP) { atomicAdd(&(bar)[XB_TMO], 1u); break; } } } } while (0)

struct XcdBarrier {
    unsigned* bar; unsigned x; int wave;
    volatile LAS unsigned* st;
};

__device__ __forceinline__ XcdBarrier xcd_barrier_post(unsigned* bar, volatile LAS unsigned* st, int wave_id) {
    XcdBarrier b; b.bar = bar; b.x = xb_xcc_id(); b.st = st; b.wave = wave_id;
    if (wave_id == 0 && lane_id() == 0) (void)xb_add(&bar[XB_XCNT(b.x)], 1u);
    return b;
}
__device__ __forceinline__ void xcd_barrier_complete(unsigned* bar, unsigned x, unsigned& nloc, unsigned& nx) {
    const unsigned G = gridDim.x * gridDim.y * gridDim.z;
    unsigned sum, cnt, mine, sp = 0u;
    for (;;) {
        sum = 0u; cnt = 0u; mine = 0u;
#pragma unroll
        for (unsigned j = 0; j < 16; ++j) { const unsigned c = xb_ld(&bar[XB_XCNT(j)]); sum += c; cnt += (c > 0u) ? 1u : 0u; mine = (j == x) ? c : mine; }
        if (sum == G) break;
        __builtin_amdgcn_s_sleep(1);
        if ((++sp & 255u) == 0u) { if (xb_ld(&bar[XB_TMO])) break; if (sp > XB_SPIN_CAP) { atomicAdd(&bar[XB_TMO], 1u); break; } }
    }
    nloc = mine > 0u ? mine : 1u; nx = cnt > 0u ? cnt : 1u;
}

__device__ __forceinline__ void xcd_barrier(const XcdBarrier& b) {
    asm volatile("s_waitcnt vmcnt(0)" ::: "memory");
    __syncthreads();
    if (b.wave == 0 && lane_id() == 0) {
        unsigned* bar = b.bar;
        __builtin_amdgcn_s_waitcnt(0);
        unsigned nloc = b.st[0], nx = b.st[1];
        if (nloc == 0u) { xcd_barrier_complete(bar, b.x, nloc, nx); b.st[0] = nloc; b.st[1] = nx; }
        const unsigned old = xb_add(&bar[XB_XSUB(b.x)], 1u);
        const unsigned gen = old / nloc;
        if (old + 1u == (gen + 1u) * nloc) {
            __builtin_amdgcn_fence(__ATOMIC_RELEASE, "agent");
            asm volatile("s_waitcnt vmcnt(0)" ::: "memory");
            const unsigned og = xb_add(&bar[XB_TOP], 1u);
            const unsigned tg = og / nx;
            if (og + 1u == (tg + 1u) * nx) xb_add(&bar[XB_TOPGEN], 1u);
            else XB_SPIN(xb_ld(&bar[XB_TOPGEN]) == tg, bar);
            __builtin_amdgcn_fence(__ATOMIC_ACQUIRE, "agent");
            xb_add(&bar[XB_XGEN(b.x)], 1u);
            asm volatile("s_waitcnt vmcnt(0)" ::: "memory");
        } else {
            XB_SPIN(xb_ld(&bar[XB_XGEN(b.x)]) == gen, bar);
            __builtin_amdgcn_fence(__ATOMIC_ACQUIRE, "agent");
            asm volatile("s_waitcnt vmcnt(0)" ::: "memory");
        }
    }
    __syncthreads();
}

constexpr size_t WS_BAR = 8192;

typedef short bf16x8 __attribute__((ext_vector_type(8)));
typedef short s16x4 __attribute__((ext_vector_type(4)));

__device__ __forceinline__ bf16x8 cat8u(const u32x2 a, const u32x2 b) { const u32x4 w = (u32x4){a.x, a.y, b.x, b.y}; return __builtin_bit_cast(bf16x8, w); }
__device__ __forceinline__ bf16x8 pack_p(const f32x4 a, const f32x4 b) {
    u32x4 w; w.x = pk2(a.x, a.y); w.y = pk2(a.z, a.w); w.z = pk2(b.x, b.y); w.w = pk2(b.z, b.w);
    return __builtin_bit_cast(bf16x8, w);
}

constexpr int A_TILE = 32768, A_KOFF = 0, A_VOFF = 16384;
constexpr int A_BIAS = 4 * A_TILE;
constexpr int A_ITEM = A_BIAS + 2048;
static_assert(A_ITEM + 64 <= 145408, "attention LDS");
constexpr size_t WS_ATTCTR = 32768;
static_assert(WS_ATTCTR >= WS_BAR + XCD_BAR_WORDS * 4 && WS_ATTCTR + 8 * 256 <= WS_ROWSQ, "attn counters (8 x 256 B apart) inside ctl");
#define ATT_BAR() do { asm volatile("s_waitcnt lgkmcnt(0)" ::: "memory"); __builtin_amdgcn_s_barrier(); asm volatile("" ::: "memory"); } while (0)
__device__ __forceinline__ void glds16(const void* gsrc, unsigned lds_dst) { unsigned keep;
    asm volatile("s_mov_b32 %0, m0\n\ts_mov_b32 m0, %2\n\ts_nop 0\n\tglobal_load_lds_dwordx4 %1, off\n\ts_mov_b32 m0, %0" : "=&s"(keep) : "v"(gsrc), "s"(lds_dst) : "memory"); }
__device__ __forceinline__ unsigned lds_addr(LAS const void* p) { return (unsigned)__builtin_amdgcn_readfirstlane((int)(unsigned)(unsigned long long)p); }

__device__ __forceinline__ void phase_attn(const Params& p, LAS unsigned char* lds) {
    int tid_o = tid_of(p.wave_id);
    const int tid = tid_o, lane = tid & 63, wave = __builtin_amdgcn_readfirstlane(tid >> 6);
    const int qb = wave & 3, rw = wave >> 2, li = lane & 15, g = lane >> 4;
    const bf16* QN = (const bf16*)(p.ws + WS_QN); const bf16* KN = (const bf16*)(p.ws + WS_KN); const bf16* VT = (const bf16*)(p.ws + WS_VN);
    bf16* YB = (bf16*)p.out + (size_t)3 * ML * WA;
    unsigned* ctr = (unsigned*)(p.ws + WS_ATTCTR);
    LAS float* btab = (LAS float*)(lds + A_BIAS);
    const float scale = 0.08838834764831845f;
    int krow_l[2], kch_l[2], vrow_l[2], vch_l[2];
#pragma unroll
    for (int e = 0; e < 2; ++e) { const int pk = 2 * wave + e; krow_l[e] = 4 * pk + (lane >> 4); kch_l[e] = (lane & 15) ^ (krow_l[e] & 15);
        vrow_l[e] = 8 * pk + (lane >> 3); vch_l[e] = (lane & 7) ^ ((vrow_l[e] >> 1) & 7); }
    const int myx = (int)(xb_xcc_id() & 7u);
    int qoff = 0;
    for (;;) {
        if (tid == 0) { unsigned v = 0xffffffffu;
            while (qoff < 8) { const int qx = (myx + qoff) & 7; const unsigned n = atomicAdd(ctr + 64 * qx, 1u); if (n < 64u) { v = (unsigned)((qx + 8 * (n >> 4)) * 16 + (n & 15)); break; } ++qoff; }
            *(LAS unsigned*)(lds + A_ITEM) = v; }
        __syncthreads();
        const unsigned itu = *(LAS unsigned*)(lds + A_ITEM);
        if (itu == 0xffffffffu) break;
        const int it = (int)itu;
        const int rp = it & 15, h = (it >> 4) & 7, b = it >> 7;
        const int r = 2 * rp + rw;
        const int rs = min(max(r - 4, 0), 24), ks0 = min(max(16 * qb - 8, 0), 32);
        const int kr0 = min(max(2 * rp - 4, 0), 24), nband = min(max(2 * rp + 1 - 4, 0), 24) + 8 - kr0, NT = nband + 4;
        const int cq = 16 * qb + li, cs = min(max(cq - 8, 0), 48);
        const size_t qrow = (size_t)b * SEQ + r * GRID_W + cq;
        if (tid < 15 * 31) btab[tid] = p.rel_bias[h * 465 + tid];
        bf16x8 qf[4];
#pragma unroll
        for (int ks = 0; ks < 4; ++ks) qf[ks] = *(const bf16x8*)(QN + qrow * WA + h * HD + 32 * ks + 8 * g);
        asm volatile("s_waitcnt vmcnt(0)" ::: "memory");
        const bf16* kg0 = KN + (size_t)h * HD + (size_t)krow_l[0] * WA + 8 * kch_l[0]; const bf16* kg1 = KN + (size_t)h * HD + (size_t)krow_l[1] * WA + 8 * kch_l[1];
        const bf16* vg0 = VT + ((size_t)(b * NHEAD + h) * HD + vrow_l[0]) * VT_PITCH + 8 * vch_l[0]; const bf16* vg1 = VT + ((size_t)(b * NHEAD + h) * HD + vrow_l[1]) * VT_PITCH + 8 * vch_l[1];
#define ATT_DMA(ti_) do { const int t_ = (ti_) < NT ? (ti_) : NT - 1; const unsigned la_ = lds_addr(lds + ((ti_) & 3) * A_TILE + wave * 2048); \
            const size_t krow0 = (t_ < nband) ? ((size_t)b * SEQ + (kr0 + t_) * GRID_W) : ((size_t)ML + b * CTX + 64 * (t_ - nband)); \
            const int tok0 = (t_ < nband) ? ((kr0 + t_) * GRID_W) : (SEQ + 64 * (t_ - nband)); \
            glds16(kg0 + krow0 * WA, la_ + A_KOFF); glds16(kg1 + krow0 * WA, la_ + A_KOFF + 1024); glds16(vg0 + tok0, la_ + A_VOFF); glds16(vg1 + tok0, la_ + A_VOFF + 1024); } while (0)
        ATT_DMA(0); ATT_DMA(1); ATT_DMA(2);
        f32x4 ot[8];
#pragma unroll
        for (int db = 0; db < 8; ++db) ot[db] = (f32x4){0.f, 0.f, 0.f, 0.f};
        float mrun = -1e30f, l = 0.f;
        const int kx = (ks0 + li) & 15, vy = (li >> 1) & 7;
        int koff[4];
#pragma unroll
        for (int ks = 0; ks < 4; ++ks) koff[ks] = A_KOFF + (ks0 + li) * 256 + (((4 * ks + g) ^ kx) << 4);
        const int vrow_off = A_VOFF + li * 128 + 8 * (g & 1);
        const int gq = g >> 1;
#pragma unroll 1
        for (int ti = 0; ti < NT; ++ti) {
            asm volatile("s_waitcnt vmcnt(8)" ::: "memory");
            ATT_BAR();
            ATT_DMA(ti + 3);
            const LAS unsigned char* tb = lds + (ti & 3) * A_TILE;
            if (ti < nband) {
                const int kr = kr0 + ti;
                if (kr >= rs && kr < rs + 8) {
                    f32x4 st[2];
#pragma unroll
                    for (int kb = 0; kb < 2; ++kb) { f32x4 a = (f32x4){0.f, 0.f, 0.f, 0.f};
#pragma unroll
                        for (int ks = 0; ks < 4; ++ks) a = __builtin_amdgcn_mfma_f32_16x16x32_bf16(*(const LAS bf16x8*)(tb + koff[ks] + kb * 4096), qf[ks], a, 0, 0, 0);
                        st[kb] = a; }
                    const int dr = kr - r + 7; float gm = -1e30f;
#pragma unroll
                    for (int kb = 0; kb < 2; ++kb)
#pragma unroll
                        for (int j = 0; j < 4; ++j) { const int kcol = ks0 + 16 * kb + 4 * g + j; const bool valid = (kcol >= cs) && (kcol < cs + 16);
                            const int bi = valid ? (dr * 31 + (kcol - cq + 15)) : 0;
                            const float sv = valid ? (st[kb][j] * scale + btab[bi]) : -1e30f; st[kb][j] = sv; gm = fmaxf(gm, sv); }
                    gm = fmaxf(gm, __shfl_xor(gm, 16)); gm = fmaxf(gm, __shfl_xor(gm, 32));
                    const float mnew = fmaxf(mrun, gm); const float alpha = __expf(mrun - mnew); mrun = mnew; l *= alpha;
#pragma unroll
                    for (int db = 0; db < 8; ++db) ot[db] = ot[db] * alpha;
#pragma unroll
                    for (int kb = 0; kb < 2; ++kb)
#pragma unroll
                        for (int j = 0; j < 4; ++j) { const float sv = st[kb][j]; const float e = (sv > -1e29f) ? __expf(sv - mnew) : 0.f; st[kb][j] = e; l += e; }
                    const bf16x8 pb = pack_p(st[0], st[1]);
                    const int c0 = (ks0 >> 3) + gq;
#pragma unroll
                    for (int db = 0; db < 8; ++db) { const LAS unsigned char* vp = tb + vrow_off + db * 2048;
                        ot[db] = __builtin_amdgcn_mfma_f32_16x16x32_bf16(cat8u(*(const LAS u32x2*)(vp + ((c0 ^ vy) << 4)), *(const LAS u32x2*)(vp + (((c0 + 2) ^ vy) << 4))), pb, ot[db], 0, 0, 0); }
                }
            } else {
                f32x4 st[4];
#pragma unroll
                for (int kb = 0; kb < 4; ++kb) { f32x4 a = (f32x4){0.f, 0.f, 0.f, 0.f};
#pragma unroll
                    for (int ks = 0; ks < 4; ++ks) a = __builtin_amdgcn_mfma_f32_16x16x32_bf16(*(const LAS bf16x8*)(tb + A_KOFF + (16 * kb + li) * 256 + (((4 * ks + g) ^ li) << 4)), qf[ks], a, 0, 0, 0);
                    st[kb] = a * scale; }
                float gm = -1e30f;
#pragma unroll
                for (int kb = 0; kb < 4; ++kb) gm = fmaxf(fmaxf(gm, fmaxf(st[kb][0], st[kb][1])), fmaxf(st[kb][2], st[kb][3]));
                gm = fmaxf(gm, __shfl_xor(gm, 16)); gm = fmaxf(gm, __shfl_xor(gm, 32));
                const float mnew = fmaxf(mrun, gm); const float alpha = __expf(mrun - mnew); mrun = mnew; l *= alpha;
#pragma unroll
                for (int db = 0; db < 8; ++db) ot[db] = ot[db] * alpha;
#pragma unroll
                for (int kb = 0; kb < 4; ++kb)
#pragma unroll
                    for (int j = 0; j < 4; ++j) { const float e = __expf(st[kb][j] - mnew); st[kb][j] = e; l += e; }
#pragma unroll
                for (int kp2 = 0; kp2 < 2; ++kp2) { const bf16x8 pb = pack_p(st[2 * kp2], st[2 * kp2 + 1]);
                    const int c0 = 4 * kp2 + gq;
#pragma unroll
                    for (int db = 0; db < 8; ++db) { const LAS unsigned char* vp = tb + vrow_off + db * 2048;
                        ot[db] = __builtin_amdgcn_mfma_f32_16x16x32_bf16(cat8u(*(const LAS u32x2*)(vp + ((c0 ^ vy) << 4)), *(const LAS u32x2*)(vp + (((c0 + 2) ^ vy) << 4))), pb, ot[db], 0, 0, 0); } }
            }
        }
        asm volatile("s_waitcnt vmcnt(0)" ::: "memory");
        l += __shfl_xor(l, 16); l += __shfl_xor(l, 32);
        const float inv = 1.0f / l;
#pragma unroll
        for (int db = 0; db < 8; ++db) { const f32x4 o = ot[db] * inv; u32x2 w; w.x = pk2(o.x, o.y); w.y = pk2(o.z, o.w);
            *(u32x2*)(YB + qrow * WA + h * HD + 16 * db + 4 * g) = w; }
#undef ATT_DMA
    }
}

constexpr int HP = 160;
constexpr int H_QH = 0, H_KH = 20480, H_KE = 40960, H_QD = 61440, H_KD = 81920;
constexpr int HP2 = 48;
constexpr int H_Q2 = 102400, H_K2 = 108544;
constexpr int PP = 144;
constexpr int H_P = 114688;
constexpr int H_T = 123904;
constexpr int H_D = 125952;
constexpr int HIMG_QD = 0, HIMG_KD = 16384, HIMG_P = 32768, HIMG_D = 40960, HIMG_BYTES = 41472;
constexpr int NCH = (CTX + SEQ) / 64;
constexpr int VP = 288;
constexpr int HPK = 136;
constexpr int SB_QD = 0, SB_KD = 20480, SB_P = 40960, SB_D = 50176, SB_V = 50688, SB_BYTES = 69120;
static_assert(2 * SB_BYTES <= 145408, "scan buffers");

__device__ __forceinline__ s16x4 lds_tr(LAS const unsigned char* p) {
    return __builtin_bit_cast(s16x4, __builtin_amdgcn_ds_read_tr16_b64_v4i16((LAS s16x4*)p));
}
__device__ __forceinline__ bf16x8 cat8(const s16x4 a, const s16x4 b) { return __builtin_shufflevector(a, b, 0, 1, 2, 3, 4, 5, 6, 7); }

__device__ __forceinline__ size_t hg_row(int dir, int b, int tau) {
    if (tau < CTX) return (size_t)ML + b * CTX + (dir == 0 ? tau : CTX - 1 - tau);
    const int t = tau - CTX; return (size_t)b * SEQ + (dir == 0 ? t : SEQ - 1 - t);
}

__device__ __forceinline__ void hgrn_prep(const Params& p, LAS unsigned char* lds, int vb, int nb) {
    int tid_o = tid_of(p.wave_id);
    const int tid = tid_o, lane = tid & 63, wave = __builtin_amdgcn_readfirstlane(tid >> 6);
    const int k = tid & 127, J = __builtin_amdgcn_readfirstlane(tid >> 7);
    const int li = lane & 15, g = lane >> 4, qq = li >> 2, pp = li & 3;
    LAS float* Tl = (LAS float*)(lds + H_T); LAS float* Dl = (LAS float*)(lds + H_D);
    float lf[16]; unsigned qv[16];
#define HG_LOADP(idx_) do { const int id_ = (idx_); const int ch_ = id_ / NCH, cc_ = id_ % NCH; const int dir_ = ch_ / (BATCH * NHEAD), b_ = (ch_ / NHEAD) % BATCH, h_ = ch_ % NHEAD; \
        const size_t row0_ = hg_row(dir_, b_, 64 * cc_ + 16 * J); const long st_ = dir_ ? -(long)WA : (long)WA; \
        const float* lfp_ = (const float*)(p.ws + (dir_ == 0 ? WS_FW : WS_FB)) + row0_ * WA + h_ * HD + k; const bf16* qp_ = (const bf16*)(p.ws + WS_QA) + row0_ * WA + h_ * HD + k; \
        _Pragma("unroll") for (int i = 0; i < 16; ++i) { lf[i] = lfp_[(long)i * st_]; qv[i] = (cc_ >= 4) ? (unsigned)qp_[(long)i * st_] : 0u; } } while (0)
    if (vb < 64 * NCH) HG_LOADP(vb);
    for (int idx = vb; idx < 64 * NCH; idx += nb) {
        const int c = idx % NCH;
        float cum[16]; float run = 0.f;
#pragma unroll
        for (int i = 0; i < 16; ++i) { run += lf[i]; cum[i] = run; }
        Tl[J * 128 + k] = run;
        ATT_BAR();
        const float T0 = Tl[k], T1 = Tl[128 + k], T2 = Tl[256 + k], T3 = Tl[384 + k];
        const float bJ = (J > 0 ? T0 : 0.f) + (J > 1 ? T1 : 0.f) + (J > 2 ? T2 : 0.f);
        const float tail = (J < 1 ? T1 : 0.f) + (J < 2 ? T2 : 0.f) + (J < 3 ? T3 : 0.f);
        const float eb = __expf(bJ), et = __expf(tail), eT = __expf(run);
        const float x2 = (J == 3) ? __expf(T2) : __expf(T1);
        float qh[16], kh[16];
#pragma unroll
        for (int i = 0; i < 16; ++i) { const float e1 = __expf(cum[i]); const float r1 = __builtin_amdgcn_rcpf(e1); const float kk = 1.0f - __expf(lf[i]);
            qh[i] = __builtin_bit_cast(float, qv[i] << 16) * e1; kh[i] = kk * r1; }
        {
            LAS unsigned char* rowp = lds + k * HP + 32 * J;
            u32x4 w0, w1;
#define HG_WRITE(OFF, EXPR) do { \
            { float v0_, v1_; \
              { const int i = 0; v0_ = (EXPR); } { const int i = 1; v1_ = (EXPR); } w0.x = pk2(v0_, v1_); \
              { const int i = 2; v0_ = (EXPR); } { const int i = 3; v1_ = (EXPR); } w0.y = pk2(v0_, v1_); \
              { const int i = 4; v0_ = (EXPR); } { const int i = 5; v1_ = (EXPR); } w0.z = pk2(v0_, v1_); \
              { const int i = 6; v0_ = (EXPR); } { const int i = 7; v1_ = (EXPR); } w0.w = pk2(v0_, v1_); \
              { const int i = 8; v0_ = (EXPR); } { const int i = 9; v1_ = (EXPR); } w1.x = pk2(v0_, v1_); \
              { const int i = 10; v0_ = (EXPR); } { const int i = 11; v1_ = (EXPR); } w1.y = pk2(v0_, v1_); \
              { const int i = 12; v0_ = (EXPR); } { const int i = 13; v1_ = (EXPR); } w1.z = pk2(v0_, v1_); \
              { const int i = 14; v0_ = (EXPR); } { const int i = 15; v1_ = (EXPR); } w1.w = pk2(v0_, v1_); } \
            *(LAS u32x4*)(OFF) = w0; *(LAS u32x4*)((OFF) + 16) = w1; } while (0)
            HG_WRITE(rowp + H_QH, qh[i]);
            HG_WRITE(rowp + H_KH, kh[i]);
            HG_WRITE(rowp + H_KE, kh[i] * eT);
            HG_WRITE(rowp + H_QD, qh[i] * eb);
            HG_WRITE(rowp + H_KD, kh[i] * (eT * et));
            if (J == 3) { HG_WRITE(lds + H_Q2 + k * HP2, qh[i] * x2); }
            if (J == 0) { HG_WRITE(lds + H_K2 + k * HP2, kh[i] * (eT * x2)); }
#undef HG_WRITE
            if (J == 3) Dl[k] = __expf(bJ + run);
        }
        if (idx + nb < 64 * NCH) HG_LOADP(idx + nb);
        ATT_BAR();
        const bool lat = (c >= 4);
        if (lat) {
#pragma unroll
            for (int rep = 0; rep < 2; ++rep) {
                int I, Jb;
                if (rep == 0) { I = (wave < 4) ? wave : (wave == 4 ? 1 : (wave == 7 ? 3 : 2)); Jb = (wave < 4) ? wave : (wave == 4 ? 0 : (wave == 5 ? 0 : (wave == 6 ? 1 : 2))); }
                else { if (wave >= 2) break; I = 3; Jb = wave; }
                int aoff, apitch, acol, boff, bpitch, bcol;
                if (I == Jb) { aoff = H_KH; apitch = HP; acol = 16 * Jb; boff = H_QH; bpitch = HP; bcol = 16 * I; }
                else if (I == Jb + 1 && I != 2) { aoff = H_KE; apitch = HP; acol = 16 * Jb; boff = H_QH; bpitch = HP; bcol = 16 * I; }
                else if (I == 2) { if (Jb == 0) { aoff = H_K2; apitch = HP2; acol = 0; } else { aoff = H_KE; apitch = HP; acol = 16; } boff = H_QH; bpitch = HP; bcol = 32; }
                else { if (Jb == 0) { aoff = H_K2; apitch = HP2; acol = 0; } else { aoff = H_KE; apitch = HP; acol = 16; } boff = H_Q2; bpitch = HP2; bcol = 0; }
                f32x4 pt = (f32x4){0.f, 0.f, 0.f, 0.f};
#pragma unroll
                for (int ks = 0; ks < 4; ++ks) {
                    const int r0 = 32 * ks + 4 * g + qq;
                    const bf16x8 a = cat8(lds_tr(lds + aoff + r0 * apitch + (acol + 4 * pp) * 2), lds_tr(lds + aoff + (r0 + 16) * apitch + (acol + 4 * pp) * 2));
                    const bf16x8 bb = cat8(lds_tr(lds + boff + r0 * bpitch + (bcol + 4 * pp) * 2), lds_tr(lds + boff + (r0 + 16) * bpitch + (bcol + 4 * pp) * 2));
                    pt = __builtin_amdgcn_mfma_f32_16x16x32_bf16(a, bb, pt, 0, 0, 0);
                }
                if (I == Jb) {
#pragma unroll
                    for (int j = 0; j < 4; ++j) if (4 * g + j > li) pt[j] = 0.f;
                }
                u32x2 w; w.x = pk2(pt.x, pt.y); w.y = pk2(pt.z, pt.w);
                *(LAS u32x2*)(lds + H_P + (16 * I + li) * PP + (16 * Jb + 4 * g) * 2) = w;
            }
        }
        ATT_BAR();
        unsigned char* img = p.ws + WS_HIMG + (size_t)idx * HIMG_BYTES;
#pragma unroll
        for (int e = 0; e < 2; ++e) { const int id = tid + 512 * e; const int kr = id >> 3, part = id & 7;
            if (lat) *(u32x4*)(img + HIMG_QD + id * 16) = *(const LAS u32x4*)(lds + H_QD + kr * HP + 16 * part);
            *(u32x4*)(img + HIMG_KD + id * 16) = *(const LAS u32x4*)(lds + H_KD + kr * HP + 16 * part); }
        if (lat) *(u32x4*)(img + HIMG_P + tid * 16) = *(const LAS u32x4*)(lds + H_P + (tid >> 3) * PP + 16 * (tid & 7));
        if (tid < 32) *(u32x4*)(img + HIMG_D + tid * 16) = *(const LAS u32x4*)(lds + H_D + 16 * tid);
    }
#undef HG_LOADP
    __syncthreads();
}

__device__ __forceinline__ void hgrn_scan(const Params& p, LAS unsigned char* lds, int chain) {
    int tid_o = tid_of(p.wave_id);
    const int tid = tid_o, lane = tid & 63, wave = __builtin_amdgcn_readfirstlane(tid >> 6);
    const int li = lane & 15, g = lane >> 4, qq = li >> 2, pp = li & 3;
    const int dir = chain / (BATCH * NHEAD), b = (chain / NHEAD) % BATCH, h = chain % NHEAD;
    const bf16* IA = (const bf16*)(p.ws + WS_IA) + h * HD;
    bf16* O = ((bf16*)p.out + (dir == 0 ? 0 : (size_t)ML * WA)) + h * HD + 16 * wave + li;
    const long ost = dir ? -(long)WA : (long)WA;
    const unsigned char* img0 = p.ws + WS_HIMG + (size_t)chain * NCH * HIMG_BYTES;
    f32x4 S[8];
#pragma unroll
    for (int i = 0; i < 8; ++i) S[i] = (f32x4){0.f, 0.f, 0.f, 0.f};
    u32x4 rq[2][2], rk[2][2], rp[2], rd[2], rv[2][2];
#define HS_LOAD(c_, set_) do { const int cc_ = (c_); const unsigned char* im_ = img0 + (size_t)cc_ * HIMG_BYTES; \
        if (cc_ >= 4) { rq[set_][0] = *(const u32x4*)(im_ + HIMG_QD + tid * 16); rq[set_][1] = *(const u32x4*)(im_ + HIMG_QD + (tid + 512) * 16); rp[set_] = *(const u32x4*)(im_ + HIMG_P + tid * 16); } \
        rk[set_][0] = *(const u32x4*)(im_ + HIMG_KD + tid * 16); rk[set_][1] = *(const u32x4*)(im_ + HIMG_KD + (tid + 512) * 16); \
        if (tid < 32) rd[set_] = *(const u32x4*)(im_ + HIMG_D + tid * 16); \
        _Pragma("unroll") for (int e = 0; e < 2; ++e) { const int idx_ = tid * 2 + e; const size_t row_ = hg_row(dir, b, 64 * cc_ + (idx_ >> 4)); rv[set_][e] = *(const u32x4*)(IA + row_ * WA + 8 * (idx_ & 15)); } } while (0)
#define HS_STORE(c_, set_) do { const int cc_ = (c_); LAS unsigned char* bb_ = lds + (cc_ & 1) * SB_BYTES; \
        if (cc_ >= 4) { *(LAS u32x4*)(bb_ + SB_QD + (tid >> 3) * HP + 16 * (tid & 7)) = rq[set_][0]; *(LAS u32x4*)(bb_ + SB_QD + ((tid >> 3) + 64) * HP + 16 * (tid & 7)) = rq[set_][1]; \
                        *(LAS u32x4*)(bb_ + SB_P + (tid >> 3) * PP + 16 * (tid & 7)) = rp[set_]; } \
        { LAS unsigned char* k0_ = bb_ + SB_KD + (tid >> 3) * HPK + 16 * (tid & 7); LAS unsigned char* k1_ = k0_ + 64 * HPK; \
          *(LAS u32x2*)k0_ = (u32x2){rk[set_][0].x, rk[set_][0].y}; *(LAS u32x2*)(k0_ + 8) = (u32x2){rk[set_][0].z, rk[set_][0].w}; *(LAS u32x2*)k1_ = (u32x2){rk[set_][1].x, rk[set_][1].y}; *(LAS u32x2*)(k1_ + 8) = (u32x2){rk[set_][1].z, rk[set_][1].w}; } \
        if (tid < 32) *(LAS u32x4*)(bb_ + SB_D + 16 * tid) = rd[set_]; \
        _Pragma("unroll") for (int e = 0; e < 2; ++e) { const int idx_ = tid * 2 + e; *(LAS u32x4*)(bb_ + SB_V + (idx_ >> 4) * VP + 16 * (idx_ & 15)) = rv[set_][e]; } } while (0)
    HS_LOAD(0, 0); HS_LOAD(1, 1);
    HS_STORE(0, 0);
    HS_LOAD(2, 0);
    ATT_BAR();
#pragma unroll 1
    for (int c2 = 0; c2 < NCH; c2 += 2) {
#pragma unroll
    for (int uu = 0; uu < 2; ++uu) { const int c = c2 + uu;
        const LAS unsigned char* bb = lds + (c & 1) * SB_BYTES;
        const bool lat = (c >= 4);
        bf16x8 vf[2];
#pragma unroll
        for (int sp = 0; sp < 2; ++sp) {
            const LAS unsigned char* vb0 = bb + SB_V + (32 * sp + 4 * g + qq) * VP + (16 * wave + 4 * pp) * 2;
            vf[sp] = cat8(lds_tr(vb0), lds_tr(vb0 + 16 * VP));
        }
        if (lat) {
            bf16x8 sb[4];
#pragma unroll
            for (int ks = 0; ks < 4; ++ks) sb[ks] = pack_p(S[2 * ks], S[2 * ks + 1]);
            bf16* orow = O + (long)hg_row(dir, b, 64 * c) * WA;
#pragma unroll
            for (int I = 0; I < 4; ++I) {
                f32x4 o = (f32x4){0.f, 0.f, 0.f, 0.f};
#pragma unroll
                for (int ks = 0; ks < 4; ++ks) {
                    const LAS unsigned char* ap = bb + SB_QD + (32 * ks + 4 * g + qq) * HP + (16 * I + 4 * pp) * 2;
                    o = __builtin_amdgcn_mfma_f32_16x16x32_bf16(cat8(lds_tr(ap), lds_tr(ap + 16 * HP)), sb[ks], o, 0, 0, 0);
                }
#pragma unroll
                for (int sp = 0; sp < 2; ++sp) {
                    if (2 * sp > I) break;
                    const LAS unsigned char* pr = bb + SB_P + (16 * I + li) * PP + (32 * sp + 4 * g) * 2;
                    const u32x2 lo = *(const LAS u32x2*)pr; u32x2 hi = (u32x2){0u, 0u};
                    if (2 * sp + 1 <= I) hi = *(const LAS u32x2*)(pr + 32);
                    o = __builtin_amdgcn_mfma_f32_16x16x32_bf16(cat8u(lo, hi), vf[sp], o, 0, 0, 0);
                }
#pragma unroll
                for (int j = 0; j < 4; ++j) orow[(long)(16 * I + 4 * g + j) * ost] = (bf16)f2bf(o[j]);
            }
        }
#pragma unroll
        for (int blk = 0; blk < 8; ++blk) {
            const f32x4 d4 = *(const LAS f32x4*)(bb + SB_D + (16 * blk + 4 * g) * 4);
            f32x4 s = S[blk] * d4;
#pragma unroll
            for (int sp = 0; sp < 2; ++sp) {
                const LAS unsigned char* kp = bb + SB_KD + (16 * blk + li) * HPK + (32 * sp + 4 * g) * 2;
                s = __builtin_amdgcn_mfma_f32_16x16x32_bf16(cat8u(*(const LAS u32x2*)kp, *(const LAS u32x2*)(kp + 32)), vf[sp], s, 0, 0, 0);
            }
            S[blk] = s;
        }
        if (c + 1 < NCH) HS_STORE(c + 1, (uu + 1) & 1);
        if (c + 3 < NCH) HS_LOAD(c + 3, (uu + 1) & 1);
        ATT_BAR();
    } }
#undef HS_LOAD
#undef HS_STORE
    __syncthreads();
}

__device__ __forceinline__ void phase_readout(const Params& p, int vb, int nb) {
    const int tid = tid_of(p.wave_id), lane = tid & 63, wave = p.wave_id;
    const bf16* OF = (const bf16*)p.out; const bf16* OB = OF + (size_t)ML * WA; const bf16* GA = (const bf16*)(p.ws + WS_GA);
    bf16* YA = (bf16*)p.out + (size_t)2 * ML * WA;
    f32x4 ng[4];
#pragma unroll
    for (int i = 0; i < 4; ++i) ng[i] = *(const f32x4*)(p.hgrn_norm_g + 16 * (lane & 7) + 4 * i);
    const int NGW = nb * 8;
    for (int row0 = vb * 8 + wave; row0 < ML; row0 += 2 * NGW) {
        u32x4 a[2][2], b[2][2], gg[2][2];
#pragma unroll
        for (int u = 0; u < 2; ++u) { const int row = row0 + u * NGW; if (row < ML) { const size_t off = (size_t)row * WA + 16 * lane;
            a[u][0] = *(const u32x4*)(OF + off); a[u][1] = *(const u32x4*)(OF + off + 8); b[u][0] = *(const u32x4*)(OB + off); b[u][1] = *(const u32x4*)(OB + off + 8);
            gg[u][0] = *(const u32x4*)(GA + off); gg[u][1] = *(const u32x4*)(GA + off + 8); } }
#pragma unroll
        for (int u = 0; u < 2; ++u) { const int row = row0 + u * NGW; if (row < ML) { const size_t off = (size_t)row * WA + 16 * lane;
            float o[16]; float ss = 0.f;
#pragma unroll
            for (int q = 0; q < 8; ++q) { const unsigned wa = a[u][q >> 2][q & 3], wb = b[u][q >> 2][q & 3]; o[2 * q] = bflo(wa) + bflo(wb); o[2 * q + 1] = bfhi(wa) + bfhi(wb); ss += o[2 * q] * o[2 * q] + o[2 * q + 1] * o[2 * q + 1]; }
            ss += __shfl_xor(ss, 1); ss += __shfl_xor(ss, 2); ss += __shfl_xor(ss, 4);
            const float rstd = __builtin_amdgcn_rsqf(ss * (1.0f / HD) + EPS);
            u32x4 w[2];
#pragma unroll
            for (int q = 0; q < 8; ++q) { const unsigned wg = gg[u][q >> 2][q & 3];
                w[q >> 2][q & 3] = pk2(o[2 * q] * rstd * ng[q >> 1][(2 * q) & 3] * bflo(wg), o[2 * q + 1] * rstd * ng[q >> 1][(2 * q + 1) & 3] * bfhi(wg)); }
            *(u32x4*)(YA + off) = w[0]; *(u32x4*)(YA + off + 8) = w[1]; } }
    }
}

__device__ __forceinline__ void phase_bias2(const Params& p, int vb, int nb) {
    const int tid = tid_of(p.wave_id); const float* mod = (const float*)(p.ws + WS_MOD); float* bias2 = (float*)(p.ws + WS_BIAS2);
    constexpr int NCC = 2 * FFN / 512, NKC = D_MODEL / 64;
    for (int item = vb; item < NCC * NKC; item += nb) {
        const int cc = item % NCC, kc = item / NCC; const int col = cc * 512 + tid;
        const float* W = (col < FFN) ? p.w1 + col : p.w3 + (col - FFN);
        float a0 = 0.f, a1 = 0.f, a2 = 0.f, a3 = 0.f;
#pragma unroll 8
        for (int k = kc * 64; k < kc * 64 + 64; ++k) { const float w = W[(size_t)k * FFN];
            a0 += w * mod[0 * IN_COLS + 3 * D_MODEL + k]; a1 += w * mod[1 * IN_COLS + 3 * D_MODEL + k]; a2 += w * mod[2 * IN_COLS + 3 * D_MODEL + k]; a3 += w * mod[3 * IN_COLS + 3 * D_MODEL + k]; }
        atomicAdd(bias2 + 0 * 2 * FFN + col, a0); atomicAdd(bias2 + 1 * 2 * FFN + col, a1); atomicAdd(bias2 + 2 * 2 * FFN + col, a2); atomicAdd(bias2 + 3 * 2 * FFN + col, a3);
    }
}

constexpr int LDS_MISC_OFF = 145408;
constexpr int LDS_BYTES = 146432;
static_assert(WS_BAR + XCD_BAR_WORDS * 4 <= WS_ROWSQ, "barrier words inside ctl");

#if defined(__HIP_DEVICE_COMPILE__)
#define LOAD_P() Params p; { const __attribute__((address_space(4))) Params* q_ = (const __attribute__((address_space(4))) Params*)__builtin_amdgcn_kernarg_segment_ptr(); asm volatile("" : "+s"(q_)); \
    p = *q_; p.wave_id = wave_id; } unsigned char* ws = p.ws; (void)ws
#else
#define LOAD_P() Params p = p_in; p.wave_id = wave_id; unsigned char* ws = p.ws; (void)ws
#endif
__global__ void __launch_bounds__(NTHREADS, 2) mega_fwd(Params p_in) {
    const int wave_id = __builtin_amdgcn_readfirstlane((int)(threadIdx.x >> 6));
    extern __shared__ __attribute__((aligned(16))) unsigned char lds_raw[];
    LAS unsigned char* lds = (LAS unsigned char*)lds_raw;
    const int nb = gridDim.x;
    const int vb = (nb % 8 == 0) ? ((int)(blockIdx.x % 8) * (nb / 8) + (int)(blockIdx.x / 8)) : (int)blockIdx.x;
    const int bx = blockIdx.x;
    volatile LAS unsigned* misc = (volatile LAS unsigned*)(lds + LDS_MISC_OFF);
    if (wave_id == 0) misc[lane_id()] = 0u;
    __syncthreads();
    XcdBarrier bar = xcd_barrier_post((unsigned*)(p_in.ws + WS_BAR), misc + 8, wave_id);
#define GRID_BAR() xcd_barrier(bar)

    { LOAD_P(); phase_mod(p, lds, vb, nb); __syncthreads(); phase_wconv_in(p, lds, vb * 8 + wave_id, nb * 8); }
    GRID_BAR();
    { LOAD_P(); phase_h(p, vb, nb); }
    GRID_BAR();
    { LOAD_P(); pg8::Gemm g{(const bf16*)(ws + WS_H), (const bf16*)(ws + WS_WINT), MT, IN_COLS, D_MODEL}; InProjOrder S; S.init(ML, IN_COLS, nb, bx);
      EpiInProj E{ws, lds, p.q_norm_g, p.k_norm_g}; pg8::gemm_phase<EpiInProj, InProjOrder, true, true>(lds, g, S, E, wave_id);
      const int nfree = nb - CTX_UNITS;
      if (nfree >= 64) { if (bx >= CTX_UNITS) phase_wconv_rest(p, lds, (bx - CTX_UNITS) * 8 + wave_id, nfree * 8); }
      else phase_wconv_rest(p, lds, bx * 8 + wave_id, nb * 8); }
    GRID_BAR();
    { LOAD_P(); hgrn_prep(p, lds, vb, nb); }
    GRID_BAR();
    { LOAD_P();
      if (bx < 2 * BATCH * NHEAD) hgrn_scan(p, lds, bx);
      __syncthreads();
      phase_attn(p, lds); }
    GRID_BAR();
    { LOAD_P(); phase_readout(p, vb, nb); }
    GRID_BAR();
    { LOAD_P(); pg8::Gemm g{(const bf16*)p.out + (size_t)2 * ML * WA, (const bf16*)(ws + WS_WAT), ML, D_MODEL, WA};
      MergeOrder S; S.init(ML, D_MODEL, nb, bx); S.A1 = (const bf16*)p.out + (size_t)3 * ML * WA; S.B1 = (const bf16*)(ws + WS_WBT);
      EpiMerge E{ws, (bf16*)(ws + WS_T1)}; pg8::gemm_phase<EpiMerge, MergeOrder, true, true>(lds, g, S, E, wave_id); }
    GRID_BAR();
    { LOAD_P(); pg8::Gemm g{(const bf16*)(ws + WS_Z), (const bf16*)(ws + WS_WOT), ML, D_MODEL, D_MODEL}; pg8::StaticOrder S; S.init(ML, D_MODEL, nb, bx);
      EpiOutProj E{ws, p.x, p.norm2_g, p.out}; pg8::gemm_phase<EpiOutProj, pg8::StaticOrder, true, true>(lds, g, S, E, wave_id); }
    GRID_BAR();
    { LOAD_P(); pg8::Gemm g{(const bf16*)(ws + WS_XMG), (const bf16*)(ws + WS_W13T), ML, 2 * FFN, D_MODEL}; pg8::StaticOrder S; S.init(ML, 2 * FFN, nb, bx);
      EpiFfnUp E{ws, lds, p.conv_w, p.conv_b}; pg8::gemm_phase<EpiFfnUp, pg8::StaticOrder, true, true>(lds, g, S, E, wave_id); }
    GRID_BAR();
    { LOAD_P(); { pg8::StaticOrder S0; S0.init(ML, D_MODEL, nb, bx); pg8::Unit u0; const int tid = tid_of(wave_id); for (int i = 0; S0.next(i, u0); ++i) halo_fix(p, u0.pm, tid); }
      asm volatile("s_waitcnt vmcnt(0)" ::: "memory"); __syncthreads();
      pg8::Gemm g{(const bf16*)(ws + WS_ACT), (const bf16*)(ws + WS_W2T), ML, D_MODEL, FFN}; pg8::StaticOrder S; S.init(ML, D_MODEL, nb, bx);
      EpiFfnDown E{ws, p.out}; pg8::gemm_phase<EpiFfnDown, pg8::StaticOrder, true, true>(lds, g, S, E, wave_id); }
#undef GRID_BAR
}

extern "C" void kernel_launch(void* const* d_in, const int* in_sizes, int n_in, void* d_out, int out_size, void* d_ws, size_t ws_size, hipStream_t stream) {
    static int grid = 0;
    if (grid == 0) {
        if (n_in != 22 || ws_size < WS_END || out_size != ML * D_MODEL) { fprintf(stderr, "kernel_launch: bad inputs (n_in %d, out %d, ws %zu, need %zu)\n", n_in, out_size, ws_size, (size_t)WS_END); grid = -1; return; }
        int dev = 0, cus = 0, per_cu = 0;
        if (hipGetDevice(&dev) != hipSuccess || hipDeviceGetAttribute(&cus, hipDeviceAttributeMultiprocessorCount, dev) != hipSuccess) { grid = -1; return; }
        if (hipFuncSetAttribute((const void*)mega_fwd, hipFuncAttributeMaxDynamicSharedMemorySize, LDS_BYTES) != hipSuccess) { fprintf(stderr, "kernel_launch: hipFuncSetAttribute failed\n"); grid = -1; return; }
        if (hipOccupancyMaxActiveBlocksPerMultiprocessor(&per_cu, (const void*)mega_fwd, NTHREADS, LDS_BYTES) != hipSuccess || per_cu < 1) { fprintf(stderr, "kernel_launch: occupancy query says %d blocks/CU\n", per_cu); (void)hipGetLastError(); grid = -1; return; }
        grid = cus;
        fprintf(stderr, "kernel_launch: grid %d (cus %d, occupancy %d/CU)\n", grid, cus, per_cu);
    }
    if (grid < 0) return;
    Params p{};
    const float** f = (const float**)&p;
    for (int i = 0; i < 22; ++i) f[i] = (const float*)d_in[i];
    p.out = (float*)d_out; p.ws = (unsigned char*)d_ws;
    (void)hipMemsetAsync((char*)d_ws + WS_CTL, 0, CTL_ZERO_BYTES, stream);
    hipLaunchKernelGGL(mega_fwd, dim3(grid), dim3(NTHREADS), LDS_BYTES, stream, p);
}
```

```cpp
#include <hip/hip_runtime.h>
#include <cstdio>
#include <cstdint>
#include <cmath>

__device__ __forceinline__ int lane_id() { int l; asm volatile("v_mbcnt_lo_u32_b32 %0, -1, 0\n\tv_mbcnt_hi_u32_b32 %0, -1, %0" : "=v"(l)); return l; }
__device__ __forceinline__ int tid_of(int wave_id) { int t = wave_id * 64 + lane_id(); asm volatile("" : "+v"(t)); return t; }
namespace pg8 {
#define PG8_LAS __attribute__((address_space(3)))
typedef unsigned short bf16_t;
typedef short bf16x8 __attribute__((ext_vector_type(8)));
typedef float f32x4 __attribute__((ext_vector_type(4)));
typedef unsigned u32x4 __attribute__((ext_vector_type(4)));
constexpr int BM = 256, BK = 64, HALF = 128, HTB = HALF * BK * 2  , STAGE_BYTES = 8 * HTB, NXCD = 8, WGM = 8;

__host__ __device__ __forceinline__ int lds_byte(int r, int c) { const int st = (r >> 4) * 2 + (c >> 5), rr = r & 15, cc = c & 31, ob = rr * 64 + cc * 2; return st * 1024 + (ob ^ (((ob >> 9) & 1) << 5)); }
__host__ __device__ __forceinline__ void stage_rc(int b, int& R, int& C) { const int st = b / 1024, sb = b % 1024, swz = sb ^ (((sb >> 9) & 1) << 5); R = (st >> 1) * 16 + swz / 64; C = (st & 1) * 32 + (swz % 64) / 2; }
__host__ __device__ __forceinline__ int perm32(int rho) { const int n = rho >> 4, i = rho & 15; return 8 * (i >> 2) + 4 * n + (i & 3); }

struct Unit { int pm, pn, br; };
struct Gemm { const bf16_t* A; const bf16_t* Bt; int M, N, K; };

struct StaticOrder {
    int nM, nN, nwg, G, c;
    __host__ __device__ void init(int M, int N, int G_, int c_) { nM = M / BM; nN = N / BM; nwg = nM * nN; G = G_; c = c_; }
    __host__ __device__ bool next(int i, Unit& u) const {
        const long L = (long)i * G + c; if (L >= nwg) return false;
        int wgid = (int)L; { const int q = nwg / NXCD, r = nwg % NXCD, xcd = wgid % NXCD, off = wgid / NXCD; wgid = (xcd < r ? xcd * (q + 1) : r * (q + 1) + (xcd - r) * q) + off; }
        const int nig = WGM * nN, gid = wgid / nig, fm = gid * WGM, gsz = (nM - fm) < WGM ? (nM - fm) : WGM;
        u.pm = fm + ((wgid % nig) % gsz); u.pn = (wgid % nig) / gsz; u.br = 0; return true;
    }
    __device__ __forceinline__ const char* a_base(const Gemm& g, const Unit& u, size_t tstep) const { return (const char*)g.A + (size_t)u.pm * tstep; }
    __device__ __forceinline__ const char* b_base(const Gemm& g, const Unit& u, size_t tstep) const { return (const char*)g.Bt + (size_t)u.pn * tstep; }
    __device__ __forceinline__ void a_ready(const Unit&) const {}
    __device__ __forceinline__ void done(const Unit&) const {}
};

template <class Epi, class Sched, bool ALIGN_EPI = false, bool SP2 = false>
__device__ __forceinline__ void gemm_phase(PG8_LAS unsigned char* lds, const Gemm g, const Sched& S, const Epi& E, const int wave_id_in) {
    int tid_o = tid_of(wave_id_in);
    const int tid = tid_o, wid = __builtin_amdgcn_readfirstlane(tid >> 6), lane = tid & 63, wr = wid >> 2, wc = wid & 3, fr = lane & 15, fq = lane >> 4;
    const int K = g.K, nt = K / BK;
    unsigned voffA[2], voffB[2];
#pragma unroll
    for (int i = 0; i < 2; ++i) { int R, C; stage_rc(tid * 16 + i * 8192, R, C); const int Rb = Epi::PERM ? ((R & ~31) + perm32(R & 31)) : R;
        voffA[i] = (unsigned)(R * K + C) * 2u; voffB[i] = (unsigned)(Rb * K + C) * 2u; }
    const size_t kstep = (size_t)(BK * 2);
    const size_t hstep = (size_t)HALF * K * 2;
    const size_t tstep = 2 * hstep;
    const unsigned ldsw = (unsigned)wid * 1024u;
    const int aoff = lds_byte(wr * 64 + fr, fq * 8), boff = lds_byte(wc * 32 + fr, fq * 8);
#define PG8_SA(b, h) (((b) * 2 + (h)) * HTB)
#define PG8_SB(b, h) ((4 + (b) * 2 + (h)) * HTB)
#define PG8_STAGE(bufoff, gbase, voff) do { _Pragma("unroll") for (int _i = 0; _i < 2; ++_i) \
        __builtin_amdgcn_global_load_lds((const unsigned*)((const char*)(gbase) + (voff)[_i]), (PG8_LAS unsigned*)(lds + (bufoff) + ldsw + _i * 8192), 16, 0, 0); } while (0)
#define PG8_LDA(dst, b, h) do { _Pragma("unroll") for (int m = 0; m < 4; ++m) _Pragma("unroll") for (int k = 0; k < 2; ++k) dst[m][k] = *(const PG8_LAS bf16x8*)(lds + PG8_SA(b, h) + aoff + m * 2048 + k * 1024); } while (0)
#define PG8_LDB(dst, b, h) do { _Pragma("unroll") for (int n = 0; n < 2; ++n) _Pragma("unroll") for (int k = 0; k < 2; ++k) dst[n][k] = *(const PG8_LAS bf16x8*)(lds + PG8_SB(b, h) + boff + n * 2048 + k * 1024); } while (0)
#define PG8_MMA(ai, bj, At, Bt) do { __builtin_amdgcn_s_setprio(1); _Pragma("unroll") for (int m = 0; m < 4; ++m) _Pragma("unroll") for (int n = 0; n < 2; ++n) _Pragma("unroll") for (int k = 0; k < 2; ++k) \
        acc[ai][bj][m][n] = __builtin_amdgcn_mfma_f32_16x16x32_bf16(Bt[n][k], At[m][k], acc[ai][bj][m][n], 0, 0, 0); __builtin_amdgcn_s_setprio(0); } while (0)
#define PG8_WAIT_V(n) asm volatile("s_waitcnt vmcnt(" #n ")" ::: "memory")
#define PG8_WAIT_L(n) asm volatile("s_waitcnt lgkmcnt(" #n ")" ::: "memory")
#define PG8_BAR __builtin_amdgcn_s_barrier()
#define PG8_SCHED __builtin_amdgcn_sched_barrier(0)
    Unit cur, nxt; int ui = 0;
    if (!S.next(0, cur)) return;
    f32x4 acc[2][2][4][2];
#pragma unroll
    for (int a = 0; a < 2; ++a)
#pragma unroll
        for (int b = 0; b < 2; ++b)
#pragma unroll
            for (int m = 0; m < 4; ++m)
#pragma unroll
                for (int n = 0; n < 2; ++n) acc[a][b][m][n] = (f32x4){0.f, 0.f, 0.f, 0.f};
    bf16x8 At[4][2], B0[2][2], B1[2][2];
    const char* cA = S.a_base(g, cur, tstep); const char* cB = S.b_base(g, cur, tstep);
    S.a_ready(cur);
    if constexpr (SP2) {
        PG8_STAGE(PG8_SB(0, 0), cB, voffB); PG8_STAGE(PG8_SB(0, 1), cB + hstep, voffB); PG8_STAGE(PG8_SA(0, 0), cA, voffA); PG8_STAGE(PG8_SA(0, 1), cA + hstep, voffA);
        if (wr == 1) PG8_BAR;
        PG8_WAIT_V(2); PG8_BAR;
        PG8_STAGE(PG8_SB(1, 0), cB + kstep, voffB); PG8_STAGE(PG8_SA(1, 0), cA + kstep, voffA); PG8_STAGE(PG8_SB(1, 1), cB + hstep + kstep, voffB);
        PG8_WAIT_V(6); PG8_BAR;
    } else {
        PG8_STAGE(PG8_SB(0, 0), cB, voffB); PG8_STAGE(PG8_SA(0, 0), cA, voffA); PG8_STAGE(PG8_SB(0, 1), cB + hstep, voffB); PG8_STAGE(PG8_SA(0, 1), cA + hstep, voffA);
        if (wr == 1) PG8_BAR;
        PG8_WAIT_V(4); PG8_BAR;
        PG8_STAGE(PG8_SB(1, 0), cB + kstep, voffB); PG8_STAGE(PG8_SA(1, 0), cA + kstep, voffA); PG8_STAGE(PG8_SB(1, 1), cB + hstep + kstep, voffB);
        PG8_WAIT_V(6); PG8_BAR;
    }
    for (;;) {
        const bool has_next = S.next(ui + 1, nxt);
        const char* nA = has_next ? S.a_base(g, nxt, tstep) : cA; const char* nB = has_next ? S.b_base(g, nxt, tstep) : cB;
        for (int t = 0; t < nt; t += 2) {
            const bool last = (t == nt - 2);
            const char* a1 = cA + (size_t)(t + 1) * kstep;
            const char* a2 = last ? nA : cA + (size_t)(t + 2) * kstep; const char* b2 = last ? nB : cB + (size_t)(t + 2) * kstep;
            const char* a3 = a2 + kstep; const char* b3 = b2 + kstep;
            if (last && has_next) S.a_ready(nxt);
            if constexpr (SP2) {
            PG8_LDB(B0, 0, 0); PG8_LDB(B1, 0, 1); PG8_SCHED; PG8_LDA(At, 0, 0); PG8_STAGE(PG8_SA(1, 1), a1 + hstep, voffA);
            PG8_WAIT_V(8); PG8_WAIT_L(0); PG8_BAR; PG8_MMA(0, 0, At, B0); PG8_MMA(0, 1, At, B1); PG8_BAR; PG8_SCHED;
            PG8_LDA(At, 0, 1); PG8_STAGE(PG8_SB(0, 0), b2, voffB); PG8_STAGE(PG8_SB(0, 1), b2 + hstep, voffB); PG8_STAGE(PG8_SA(0, 0), a2, voffA);
            PG8_WAIT_V(8); PG8_WAIT_L(0); PG8_BAR; PG8_MMA(1, 0, At, B0); PG8_MMA(1, 1, At, B1); PG8_BAR; PG8_SCHED;
            PG8_LDB(B0, 1, 0); PG8_LDB(B1, 1, 1); PG8_SCHED; PG8_LDA(At, 1, 0); PG8_STAGE(PG8_SA(0, 1), a2 + hstep, voffA);
            PG8_WAIT_V(8); PG8_WAIT_L(0); PG8_BAR; PG8_MMA(0, 0, At, B0); PG8_MMA(0, 1, At, B1); PG8_BAR; PG8_SCHED;
            PG8_LDA(At, 1, 1); PG8_STAGE(PG8_SB(1, 0), b3, voffB); PG8_STAGE(PG8_SB(1, 1), b3 + hstep, voffB); PG8_STAGE(PG8_SA(1, 0), a3, voffA);
            PG8_WAIT_V(8); PG8_WAIT_L(0); PG8_BAR; PG8_MMA(1, 0, At, B0); PG8_MMA(1, 1, At, B1); PG8_BAR; PG8_SCHED;
            } else {
            PG8_LDB(B0, 0, 0); PG8_SCHED; PG8_LDA(At, 0, 0); PG8_STAGE(PG8_SA(1, 1), a1 + hstep, voffA);
            PG8_WAIT_L(8); PG8_BAR; PG8_WAIT_L(0); PG8_MMA(0, 0, At, B0); PG8_BAR; PG8_SCHED;
            PG8_LDB(B1, 0, 1); PG8_STAGE(PG8_SB(0, 0), b2, voffB);
            PG8_BAR; PG8_WAIT_L(0); PG8_MMA(0, 1, At, B1); PG8_BAR;
            PG8_LDA(At, 0, 1); PG8_STAGE(PG8_SA(0, 0), a2, voffA);
            PG8_BAR; PG8_WAIT_L(0); PG8_MMA(1, 0, At, B0); PG8_BAR; PG8_SCHED;
            PG8_STAGE(PG8_SB(0, 1), b2 + hstep, voffB);
            PG8_WAIT_V(6); PG8_BAR; PG8_MMA(1, 1, At, B1); PG8_BAR;
            PG8_LDB(B0, 1, 0); PG8_SCHED; PG8_LDA(At, 1, 0); PG8_STAGE(PG8_SA(0, 1), a2 + hstep, voffA);
            PG8_WAIT_L(8); PG8_BAR; PG8_WAIT_L(0); PG8_MMA(0, 0, At, B0); PG8_BAR; PG8_SCHED;
            PG8_LDB(B1, 1, 1); PG8_STAGE(PG8_SB(1, 0), b3, voffB);
            PG8_BAR; PG8_WAIT_L(0); PG8_MMA(0, 1, At, B1); PG8_BAR;
            PG8_LDA(At, 1, 1); PG8_STAGE(PG8_SA(1, 0), a3, voffA);
            PG8_BAR; PG8_WAIT_L(0); PG8_MMA(1, 0, At, B0); PG8_BAR; PG8_SCHED;
            PG8_STAGE(PG8_SB(1, 1), b3 + hstep, voffB);
            PG8_WAIT_V(6); PG8_BAR; PG8_MMA(1, 1, At, B1); PG8_BAR;
            }
        }
        if constexpr (ALIGN_EPI) { if (wr == 0) PG8_BAR; }
        if constexpr (!Epi::AFTER_DRAIN) { E(acc, cur, wr, wc, fr, fq); S.done(cur); }
        if (!has_next) break;
#pragma unroll
        for (int a = 0; a < 2; ++a)
#pragma unroll
            for (int b = 0; b < 2; ++b)
#pragma unroll
                for (int m = 0; m < 4; ++m)
#pragma unroll
                    for (int n = 0; n < 2; ++n) acc[a][b][m][n] = (f32x4){0.f, 0.f, 0.f, 0.f};
        cur = nxt; cA = nA; cB = nB; ++ui;
        if constexpr (ALIGN_EPI) { if (wr == 1) PG8_BAR; }
    }
    PG8_WAIT_V(0);
    if constexpr (!ALIGN_EPI) { if (wr == 0) PG8_BAR; }
    PG8_BAR;
    if constexpr (Epi::AFTER_DRAIN) { E.fused(acc, cur, wr, wc, fr, fq, lds, wid, lane); S.done(cur); }
#undef PG8_SA
#undef PG8_SB
#undef PG8_STAGE
#undef PG8_LDA
#undef PG8_LDB
#undef PG8_MMA
#undef PG8_WAIT_V
#undef PG8_WAIT_L
#undef PG8_BAR
#undef PG8_SCHED
}
}

constexpr int D_MODEL = 2048, BATCH = 4, SEQ = 2048, CTX = 256, GRID_W = 64, NHEAD = 8, HD = 128, WA = 1024;
constexpr int FFN = 5632, IN_COLS = 12288, NMOD = 6;
constexpr int ML = BATCH * SEQ;
constexpr int MC = BATCH * CTX;
constexpr int MT = ML + MC;
constexpr float EPS = 1e-6f;
constexpr int NTHREADS = 512;
constexpr int VT_PITCH = SEQ + CTX;

typedef unsigned short bf16;
typedef float f32x4 __attribute__((ext_vector_type(4)));
typedef unsigned u32x2 __attribute__((ext_vector_type(2)));
typedef unsigned u32x4 __attribute__((ext_vector_type(4)));
#define LAS __attribute__((address_space(3)))

typedef float f32x2_t __attribute__((ext_vector_type(2)));
typedef __bf16 bf16x2_t __attribute__((ext_vector_type(2)));
__device__ __forceinline__ unsigned pk2(float lo, float hi) { const f32x2_t v = {lo, hi}; const bf16x2_t b = __builtin_convertvector(v, bf16x2_t); return __builtin_bit_cast(unsigned, b); }
__device__ __forceinline__ unsigned f2bf(float f) { return pk2(f, 0.f) & 0xffffu; }
__device__ __forceinline__ float bf2f(unsigned short h) { return __builtin_bit_cast(float, (unsigned)h << 16); }
__device__ __forceinline__ float bflo(unsigned w) { return __builtin_bit_cast(float, w << 16); }
__device__ __forceinline__ float bfhi(unsigned w) { return __builtin_bit_cast(float, w & 0xffff0000u); }
__device__ __forceinline__ float sigmoidf_(float x) { return __builtin_amdgcn_rcpf(1.0f + __expf(-x)); }
__device__ __forceinline__ float siluf_(float x) { return x * __builtin_amdgcn_rcpf(1.0f + __expf(-x)); }
__device__ __forceinline__ float wave_sum(float v) {
#pragma unroll
    for (int o = 1; o < 64; o <<= 1) v += __shfl_xor(v, o);
    return v;
}
__device__ __forceinline__ float wave_max(float v) {
#pragma unroll
    for (int o = 1; o < 64; o <<= 1) v = fmaxf(v, __shfl_xor(v, o));
    return v;
}

constexpr size_t al256(size_t x) { return (x + 255) & ~(size_t)255; }
constexpr size_t WS_CTL   = 0;
constexpr size_t CTL_ZERO_BYTES = 1u << 20;
constexpr size_t WS_ROWSQ = 64 * 1024;
constexpr size_t WS_BIAS2 = WS_ROWSQ + (size_t)ML * 4;
static_assert(WS_BIAS2 + (size_t)4 * 2 * FFN * 4 <= CTL_ZERO_BYTES, "ctl");
constexpr size_t WS_MOD   = CTL_ZERO_BYTES;
constexpr size_t WS_LB    = al256(WS_MOD + (size_t)5 * IN_COLS * 4);
constexpr size_t WS_ROPE  = al256(WS_LB + 2 * WA * 4);
constexpr size_t WS_SMALL_END = al256(WS_ROPE + 2 * 64 * 32 * 4);
constexpr size_t WS_W13T  = al256(WS_SMALL_END);
constexpr size_t WS_W2T   = WS_W13T + (size_t)2 * FFN * D_MODEL * 2;
constexpr size_t WS_WAT   = WS_W2T + (size_t)D_MODEL * FFN * 2;
constexpr size_t WS_WBT   = WS_WAT + (size_t)D_MODEL * WA * 2;
constexpr size_t WS_WOT   = WS_WBT + (size_t)D_MODEL * WA * 2;
constexpr size_t WS_A_END = WS_WOT + (size_t)D_MODEL * D_MODEL * 2;
constexpr size_t SEGB = (size_t)MT * WA * 2;
constexpr size_t WS_QA  = WS_A_END;
constexpr size_t WS_FW  = WS_QA + SEGB;
constexpr size_t WS_FB  = WS_FW + 2 * SEGB;
constexpr size_t WS_IA  = WS_FB + 2 * SEGB;
constexpr size_t WS_GA  = WS_IA + SEGB;
constexpr size_t WS_QN  = WS_GA + (size_t)ML * WA * 2;
constexpr size_t WS_KN  = WS_QN + (size_t)ML * WA * 2;
constexpr size_t WS_VN  = WS_KN + SEGB;
constexpr size_t WS_GTA = WS_VN + SEGB;
constexpr size_t WS_GTB = WS_GTA + (size_t)ML * D_MODEL * 2;
constexpr size_t WS_D_END = WS_GTB + (size_t)ML * D_MODEL * 2;
constexpr size_t WS_WINT = WS_D_END;
constexpr size_t WS_OF   = WS_WINT;
constexpr size_t WS_OB   = WS_OF + (size_t)ML * WA * 2;
constexpr size_t WS_B_END = WS_WINT + (size_t)IN_COLS * D_MODEL * 2;
static_assert(WS_OB + (size_t)ML * WA * 2 <= WS_B_END, "B");
constexpr size_t WS_H   = WS_B_END;
constexpr size_t WS_YA  = WS_H;
constexpr size_t WS_YB  = WS_YA + (size_t)ML * WA * 2;
constexpr size_t WS_C_END = WS_H + (size_t)MT * D_MODEL * 2;
constexpr size_t WS_ACT_END = WS_D_END + (size_t)ML * FFN * 2;
constexpr size_t WS_HIMG = WS_WINT;
constexpr size_t WS_HIMG_END = WS_HIMG + (size_t)64 * 36 * 41472;
constexpr size_t WS_T1 = WS_WINT;
constexpr size_t WS_END0 = WS_C_END > WS_ACT_END ? WS_C_END : WS_ACT_END;
constexpr size_t WS_END = WS_END0 > WS_HIMG_END ? WS_END0 : WS_HIMG_END;
static_assert(WS_END <= 445000000, "ws budget");
constexpr size_t WS_Z   = WS_QA;
constexpr size_t WS_XM16 = WS_GTA;
constexpr size_t WS_XMG = WS_GTB;
constexpr size_t WS_HALO = WS_QA;
static_assert(WS_HALO + (size_t)32 * 6 * FFN * 4 <= WS_XMG, "HALO overlay");
constexpr size_t WS_ACT = WS_WINT;
static_assert(WS_ACT + (size_t)ML * FFN * 2 <= WS_END, "ACT overlay");

struct Params {
    const float *x, *c, *ctx, *c_ctx, *ada_w, *ada_b, *norm1_g, *norm2_g, *w_in, *lb_logits, *hgrn_norm_g, *q_norm_g, *k_norm_g, *rel_bias,
                *w_a, *w_b, *w_o, *w1, *w3, *conv_w, *conv_b, *w2;
    float* out;
    unsigned char* ws;
    int wave_id, pad;
};

template <bool QKPERM, bool BIAS>
__device__ __forceinline__ void transpose_item(const float* W, int K, int N, bf16* WT, int row_off, LAS float* scr, int item, int lane, const float* sh2 = nullptr, float* bias2 = nullptr) {
    const int nblk = N / 32, kb = item / nblk, nb = item % nblk, k0 = 64 * kb, n0 = 32 * nb;
    if (BIAS) row_off += (n0 >> 7) * 128;
    float wv[32];
#pragma unroll
    for (int i = 0; i < 32; ++i) wv[i] = __builtin_nontemporal_load(W + (size_t)(k0 + 2 * i + (lane >> 5)) * N + n0 + (lane & 31));
#pragma unroll
    for (int i = 0; i < 32; ++i) scr[(2 * i + (lane >> 5)) * 33 + (lane & 31)] = wv[i];
    if (BIAS) {
        float a0 = 0.f, a1 = 0.f, a2 = 0.f, a3 = 0.f;
#pragma unroll
        for (int i = 0; i < 32; ++i) { const int k = k0 + 2 * i + (lane >> 5); const float w = wv[i];
            a0 += w * sh2[0 * IN_COLS + k]; a1 += w * sh2[1 * IN_COLS + k]; a2 += w * sh2[2 * IN_COLS + k]; a3 += w * sh2[3 * IN_COLS + k]; }
        a0 += __shfl_xor(a0, 32); a1 += __shfl_xor(a1, 32); a2 += __shfl_xor(a2, 32); a3 += __shfl_xor(a3, 32);
        if (lane < 32) { float* bp = bias2 + row_off + n0 + lane; atomicAdd(bp, a0); atomicAdd(bp + 2 * FFN, a1); atomicAdd(bp + 4 * FFN, a2); atomicAdd(bp + 6 * FFN, a3); }
    }
    asm volatile("s_waitcnt lgkmcnt(0)" ::: "memory");
    const int c = lane & 7;
#pragma unroll
    for (int j = 0; j < 4; ++j) { const int n = (lane >> 3) + 8 * j; const LAS float* s = scr + (8 * c) * 33 + n;
        u32x4 o; o.x = pk2(s[0 * 33], s[1 * 33]); o.y = pk2(s[2 * 33], s[3 * 33]); o.z = pk2(s[4 * 33], s[5 * 33]); o.w = pk2(s[6 * 33], s[7 * 33]);
        int cdst = n0 + n;
        if (QKPERM && cdst >= 5 * WA && cdst < 7 * WA) cdst = (cdst & ~0x30) | ((cdst & 0x10) << 1) | ((cdst & 0x20) >> 1);
        *(u32x4*)(WT + (size_t)(row_off + cdst) * K + k0 + 8 * c) = o; }
    asm volatile("s_waitcnt lgkmcnt(0)" ::: "memory");
}
__device__ __forceinline__ void phase_wconv_in(const Params& p, LAS unsigned char* lds, int gw, int NGW) {
    const int lane = lane_id(), wave = p.wave_id;
    LAS float* scr = (LAS float*)(lds + wave * 16384);
    constexpr int I_IN = (D_MODEL / 64) * (IN_COLS / 32);
    for (int it = gw; it < I_IN; it += NGW) transpose_item<true, false>(p.w_in, D_MODEL, IN_COLS, (bf16*)(p.ws + WS_WINT), 0, scr, it, lane);
}
__device__ __forceinline__ void phase_wconv_rest(const Params& p, LAS unsigned char* lds, int gw, int NGW) {
    const int lane = lane_id(), wave = p.wave_id;
    LAS float* scr = (LAS float*)(lds + 16384 + wave * 16384);
    constexpr int I_A = (WA / 64) * (D_MODEL / 32), I_O = (D_MODEL / 64) * (D_MODEL / 32), I_1 = (D_MODEL / 64) * (FFN / 32), I_2 = (FFN / 64) * (D_MODEL / 32);
    constexpr int NITEMS = 2 * I_A + I_O + 2 * I_1 + I_2;
    unsigned char* ws = p.ws;
    const float* sh2 = (const float*)(ws + WS_MOD) + 3 * D_MODEL; float* b2 = (float*)(ws + WS_BIAS2);
    for (int it = gw; it < NITEMS; it += NGW) {
        int r = it;
        if (r < I_A) { transpose_item<false, false>(p.w_a, WA, D_MODEL, (bf16*)(ws + WS_WAT), 0, scr, r, lane); continue; } r -= I_A;
        if (r < I_A) { transpose_item<false, false>(p.w_b, WA, D_MODEL, (bf16*)(ws + WS_WBT), 0, scr, r, lane); continue; } r -= I_A;
        if (r < I_O) { transpose_item<false, false>(p.w_o, D_MODEL, D_MODEL, (bf16*)(ws + WS_WOT), 0, scr, r, lane); continue; } r -= I_O;
        if (r < I_1) { transpose_item<false, true>(p.w1, D_MODEL, FFN, (bf16*)(ws + WS_W13T), 0, scr, r, lane, sh2, b2); continue; } r -= I_1;
        if (r < I_1) { transpose_item<false, true>(p.w3, D_MODEL, FFN, (bf16*)(ws + WS_W13T), 128, scr, r, lane, sh2, b2); continue; } r -= I_1;
        transpose_item<false, false>(p.w2, FFN, D_MODEL, (bf16*)(ws + WS_W2T), 0, scr, r, lane);
    }
}

__device__ __forceinline__ void phase_mod(const Params& p, LAS unsigned char* lds, int vb, int nb) {
    const int tid = tid_of(p.wave_id);
    LAS float* sc = (LAS float*)lds;
    LAS float* red = (LAS float*)(lds + 5 * 2048 * 4);
    for (int i = tid; i < 5 * D_MODEL; i += NTHREADS) { const int r = i / D_MODEL, k = i % D_MODEL; const float v = (r < 4) ? p.c[r * D_MODEL + k] : p.c_ctx[k]; sc[i] = siluf_(v); }
    __syncthreads();
    float* mod = (float*)(p.ws + WS_MOD);
    const int c4 = tid & 15, kp = tid >> 4;
    for (int item = vb; item < IN_COLS / 64; item += nb) {
        const int n0 = item * 64 + c4 * 4;
        f32x4 acc[5];
#pragma unroll
        for (int r = 0; r < 5; ++r) acc[r] = (f32x4){0.f, 0.f, 0.f, 0.f};
#pragma unroll 8
        for (int k = kp; k < D_MODEL; k += 32) {
            const f32x4 w = __builtin_nontemporal_load((const f32x4*)(p.ada_w + (size_t)k * IN_COLS + n0));
#pragma unroll
            for (int r = 0; r < 5; ++r) acc[r] += w * sc[r * D_MODEL + k];
        }
#pragma unroll
        for (int r = 0; r < 5; ++r) *(LAS f32x4*)(red + (kp * 5 + r) * 64 + c4 * 4) = acc[r];
        __syncthreads();
        if (tid < 320) { const int r = tid / 64, cidx = tid % 64; float s = 0.f;
            for (int q = 0; q < 32; ++q) s += red[(q * 5 + r) * 64 + cidx];
            const int gc = item * 64 + cidx; float v = s + p.ada_b[gc];
            if (gc >= 4 * D_MODEL && gc < 5 * D_MODEL) v = p.norm2_g[gc - 4 * D_MODEL] * (1.0f + v);
            mod[r * IN_COLS + gc] = v; }
        __syncthreads();
    }
    if (vb == nb - 1) { float* rt = (float*)(p.ws + WS_ROPE);
        for (int i = tid; i < 64 * 32; i += NTHREADS) { const int pos = i >> 5, j = i & 31; const float inv = exp2f(-(float)j * (13.287712379549449f / 32.0f)); float sn, cs; sincosf((float)pos * inv, &sn, &cs); rt[i] = cs; rt[2048 + i] = sn; } }
    if (vb == 0) { float* lb = (float*)(p.ws + WS_LB);
        for (int i = tid; i < 2 * WA; i += NTHREADS) { const int d = i / WA, cc = i % WA; const float l0 = p.lb_logits[d * 2 * WA + cc], l1 = p.lb_logits[d * 2 * WA + WA + cc]; lb[i] = 1.0f / (1.0f + expf(l1 - l0)); } }
}

__device__ __forceinline__ void phase_h(const Params& p, int vb, int nb) {
    const int tid = tid_of(p.wave_id), lane = tid & 63, wave = p.wave_id;
    const float* mod = (const float*)(p.ws + WS_MOD);
    bf16* H = (bf16*)(p.ws + WS_H);
    for (int m = vb * 8 + wave; m < MT; m += nb * 8) {
        const float* xr = (m < ML) ? p.x + (size_t)m * D_MODEL : p.ctx + (size_t)(m - ML) * D_MODEL;
        const int mr = (m < ML) ? (m / SEQ) : 4;
        const float* sh = mod + (size_t)mr * IN_COLS, *scl = sh + D_MODEL;
        f32x4 v[8]; float s = 0.f;
#pragma unroll
        for (int j = 0; j < 8; ++j) { v[j] = *(const f32x4*)(xr + 4 * lane + 256 * j); s += (v[j].x * v[j].x + v[j].y * v[j].y) + (v[j].z * v[j].z + v[j].w * v[j].w); }
        const float rstd = __builtin_amdgcn_rsqf(wave_sum(s) * (1.0f / D_MODEL) + EPS);
#pragma unroll
        for (int j = 0; j < 8; ++j) { const int k = 4 * lane + 256 * j;
            const f32x4 g = *(const f32x4*)(p.norm1_g + k), a = *(const f32x4*)(scl + k), b = *(const f32x4*)(sh + k);
            const f32x4 h = v[j] * rstd * g * (a + 1.0f) + b;
            u32x2 o; o.x = pk2(h.x, h.y); o.y = pk2(h.z, h.w);
            *(u32x2*)(H + (size_t)m * D_MODEL + k) = o; }
    }
}

#define EPI_LOOP_BEGIN \
    _Pragma("unroll") for (int ai = 0; ai < 2; ++ai) _Pragma("unroll") for (int m = 0; m < 4; ++m) { const int row = u.pm * 256 + ai * 128 + wr * 64 + m * 16 + fr; \
    _Pragma("unroll") for (int bj = 0; bj < 2; ++bj) _Pragma("unroll") for (int n = 0; n < 2; ++n) { const int col = u.pn * 256 + bj * 128 + wc * 32 + n * 16 + fq * 4; const f32x4 v = acc[ai][bj][m][n];
#define EPI_LOOP_END } }

struct EpiInProj {
    static constexpr bool PERM = false, AFTER_DRAIN = false;
    unsigned char* ws; LAS unsigned char* lds; const float* qg; const float* kg;
    __device__ __forceinline__ void operator()(const f32x4 (&acc)[2][2][4][2], const pg8::Unit& u, int wr, int wc, int fr, int fq) const {
        { const int l_ = lane_id(); fr = l_ & 15; fq = l_ >> 4; }
        const int seg = u.pn >> 2;
        const bool ctxrow = u.pm >= ML / 256;
        const float* lb = (const float*)(ws + WS_LB);
        if (seg == 1 || seg == 2) {
            float* F = (float*)(ws + (seg == 1 ? WS_FW : WS_FB)); const float* lbd = lb + (seg - 1) * WA;
            f32x4 lbv[2][2];
#pragma unroll
            for (int bj = 0; bj < 2; ++bj)
#pragma unroll
                for (int n = 0; n < 2; ++n) lbv[bj][n] = *(const f32x4*)(lbd + u.pn * 256 + bj * 128 + wc * 32 + n * 16 + fq * 4 - seg * WA);
            EPI_LOOP_BEGIN
                const int c = col - seg * WA; const f32x4 l = lbv[bj][n]; f32x4 o;
                o.x = __logf(l.x + (1.0f - l.x) * sigmoidf_(v.x)); o.y = __logf(l.y + (1.0f - l.y) * sigmoidf_(v.y));
                o.z = __logf(l.z + (1.0f - l.z) * sigmoidf_(v.z)); o.w = __logf(l.w + (1.0f - l.w) * sigmoidf_(v.w));
                *(f32x4*)(F + (size_t)row * WA + c) = o;
            EPI_LOOP_END
        } else if (seg == 7) {
            bf16* VT = (bf16*)(ws + WS_VN);
            EPI_LOOP_BEGIN
                const int c = col - 7 * WA; const int hh = c >> 7, d = c & 127;
                int bb, tok; if (row < ML) { bb = row / SEQ; tok = row % SEQ; } else { bb = (row - ML) / CTX; tok = SEQ + (row - ML) % CTX; }
                bf16* o = VT + ((size_t)(bb * NHEAD + hh) * HD + d) * VT_PITCH + tok;
                o[0] = (bf16)f2bf(v.x); o[VT_PITCH] = (bf16)f2bf(v.y); o[2 * VT_PITCH] = (bf16)f2bf(v.z); o[3 * VT_PITCH] = (bf16)f2bf(v.w);
            EPI_LOOP_END
        } else if (seg == 5 || seg == 6) {
            if (ctxrow && seg == 5) return;
            LAS float* ssq = (LAS float*)(lds + 131072);
            const float* gn = (seg == 5) ? qg : kg; const float* rt = (const float*)(ws + WS_ROPE);
            bf16* O = (bf16*)(ws + (seg == 5 ? WS_QN : WS_KN));
            const int H = wc >> 1, jj = 16 * (wc & 1) + 4 * fq;
            const f32x4 g0 = *(const f32x4*)(gn + 64 * H + jj), g1 = *(const f32x4*)(gn + 64 * H + 32 + jj);
            f32x4 csv[2][4], snv[2][4];
#pragma unroll
            for (int ai = 0; ai < 2; ++ai)
#pragma unroll
                for (int m = 0; m < 4; ++m) { csv[ai][m] = (f32x4){1.f, 1.f, 1.f, 1.f}; snv[ai][m] = (f32x4){0.f, 0.f, 0.f, 0.f};
                    if (!ctxrow) { const int t = (u.pm * 256 + ai * 128 + wr * 64 + m * 16 + fr) & (SEQ - 1); const int pos = (H == 0) ? (t >> 6) : (t & 63);
                        csv[ai][m] = *(const f32x4*)(rt + pos * 32 + jj); snv[ai][m] = *(const f32x4*)(rt + 2048 + pos * 32 + jj); } }
#pragma unroll
            for (int ai = 0; ai < 2; ++ai)
#pragma unroll
                for (int m = 0; m < 4; ++m)
#pragma unroll
                    for (int bj = 0; bj < 2; ++bj) { const f32x4 a = acc[ai][bj][m][0], b = acc[ai][bj][m][1];
                        float sq = (a.x * a.x + a.y * a.y) + (a.z * a.z + a.w * a.w) + (b.x * b.x + b.y * b.y) + (b.z * b.z + b.w * b.w);
                        sq += __shfl_xor(sq, 16); sq += __shfl_xor(sq, 32);
                        if (fq == 0) ssq[((ai * 128 + wr * 64 + m * 16 + fr) * 2 + bj) * 4 + wc] = sq; }
            asm volatile("s_waitcnt lgkmcnt(0)" ::: "memory"); __builtin_amdgcn_s_barrier(); asm volatile("" ::: "memory");
#pragma unroll
            for (int ai = 0; ai < 2; ++ai)
#pragma unroll
                for (int m = 0; m < 4; ++m) { const int rl = ai * 128 + wr * 64 + m * 16 + fr; const int row = u.pm * 256 + rl;
                    const f32x4 cs = csv[ai][m], sn = snv[ai][m];
#pragma unroll
                    for (int bj = 0; bj < 2; ++bj) { const f32x4 s4 = *(const LAS f32x4*)(ssq + (rl * 2 + bj) * 4);
                        const float rstd = __builtin_amdgcn_rsqf(((s4.x + s4.y) + (s4.z + s4.w)) * (1.0f / HD) + EPS);
                        const f32x4 u1 = acc[ai][bj][m][0] * rstd * g0, u2 = acc[ai][bj][m][1] * rstd * g1;
                        const f32x4 o1 = u1 * cs - u2 * sn, o2 = u1 * sn + u2 * cs;
                        bf16* op = O + (size_t)row * WA + (u.pn & 3) * 256 + bj * 128 + wc * 32 + fq * 4;
                        u32x2 w1; w1.x = pk2(o1.x, o1.y); w1.y = pk2(o1.z, o1.w); *(u32x2*)op = w1;
                        u32x2 w2; w2.x = pk2(o2.x, o2.y); w2.y = pk2(o2.z, o2.w); *(u32x2*)(op + 16) = w2; }
                    asm volatile("" ::: "memory"); }
            asm volatile("s_waitcnt lgkmcnt(0)" ::: "memory"); __builtin_amdgcn_s_barrier(); asm volatile("" ::: "memory");
        } else if (seg == 0 || seg == 3) {
            if (ctxrow && seg == 0) return;
            bf16* O = (bf16*)(ws + (seg == 0 ? WS_QA : WS_IA));
            EPI_LOOP_BEGIN
                const int c = col - seg * WA; u32x2 o; o.x = pk2(v.x, v.y); o.y = pk2(v.z, v.w);
                *(u32x2*)(O + (size_t)row * WA + c) = o;
            EPI_LOOP_END
        } else if (seg == 4) {
            if (ctxrow) return;
            bf16* O = (bf16*)(ws + WS_GA);
            EPI_LOOP_BEGIN
                const int c = col - seg * WA; u32x2 o; o.x = pk2(siluf_(v.x), siluf_(v.y)); o.y = pk2(siluf_(v.z), siluf_(v.w));
                *(u32x2*)(O + (size_t)row * WA + c) = o;
            EPI_LOOP_END
        } else {
            if (ctxrow) return;
            const bool isa = seg < 10;
            bf16* O = (bf16*)(ws + (isa ? WS_GTA : WS_GTB)); const int cbase = isa ? 8 * WA : 10 * WA;
            EPI_LOOP_BEGIN
                const int c = col - cbase; u32x2 o; o.x = pk2(sigmoidf_(v.x), sigmoidf_(v.y)); o.y = pk2(sigmoidf_(v.z), sigmoidf_(v.w));
                *(u32x2*)(O + (size_t)row * D_MODEL + c) = o;
            EPI_LOOP_END
        }
    }
};

constexpr int CTX_UNITS = (MC / 256) * 20;
struct InProjOrder : pg8::StaticOrder {
    __device__ bool next(int i, pg8::Unit& u) const {
        if (pg8::StaticOrder::next(i, u)) return true;
        const long L = (long)i * G + c - nwg; if (L < 0 || L >= CTX_UNITS) return false;
        const int t = (int)L, j = t % 20; u.pm = ML / 256 + t / 20; u.pn = (j < 12) ? 4 + j : 12 + j; u.br = 0; return true; }
};
struct MergeOrder : pg8::StaticOrder {
    const bf16* A1; const bf16* B1;
    __device__ bool next(int i, pg8::Unit& u) const { if (!pg8::StaticOrder::next(i >> 1, u)) return false; u.br = i & 1; return true; }
    __device__ __forceinline__ const char* a_base(const pg8::Gemm& g, const pg8::Unit& u, size_t tstep) const { return (const char*)(u.br ? A1 : g.A) + (size_t)u.pm * tstep; }
    __device__ __forceinline__ const char* b_base(const pg8::Gemm& g, const pg8::Unit& u, size_t tstep) const { return (const char*)(u.br ? B1 : g.Bt) + (size_t)u.pn * tstep; }
};
#define EPI_BATCH_BEGIN _Pragma("unroll") for (int ai = 0; ai < 2; ++ai) _Pragma("unroll") for (int mh = 0; mh < 4; mh += 2) {
#define EPI_BATCH_END }
#define EPI_VEC_LOOP _Pragma("unroll") for (int m2 = 0; m2 < 2; ++m2) _Pragma("unroll") for (int bj = 0; bj < 2; ++bj) _Pragma("unroll") for (int n = 0; n < 2; ++n)
#define EPI_VEC_IDX const int m = mh + m2, vi = (m2 * 2 + bj) * 2 + n; const int row = u.pm * 256 + ai * 128 + wr * 64 + m * 16 + fr, col = u.pn * 256 + bj * 128 + wc * 32 + n * 16 + fq * 4; (void)vi
#define EPI_WVEC_LOOP _Pragma("unroll") for (int m2 = 0; m2 < 2; ++m2) _Pragma("unroll") for (int bj = 0; bj < 2; ++bj)
#define EPI_WVEC_IDX const int m = mh + m2, wi = m2 * 2 + bj; const int row = u.pm * 256 + ai * 128 + wr * 64 + m * 16 + fr, col = u.pn * 256 + bj * 128 + wc * 32 + fq * 8; const unsigned off = (unsigned)(row * D_MODEL + col); (void)wi; (void)off
#define EPI_PIPE_IDX(b_) const int ai = (b_) >> 1, mh = 2 * ((b_) & 1); (void)ai; (void)mh
struct EpiMerge {
    static constexpr bool PERM = true, AFTER_DRAIN = false;
    unsigned char* ws; bf16* tmp;
    __device__ __forceinline__ void operator()(const f32x4 (&acc)[2][2][4][2], const pg8::Unit& u, int wr, int wc, int fr, int fq) const {
        { const int l_ = lane_id(); fr = l_ & 15; fq = l_ >> 4; }
        if (u.br == 0) {
            const bf16* G = (const bf16*)(ws + WS_GTA);
            u32x4 gv[4][4];
#pragma unroll
            for (int b = 0; b < 4; ++b) { EPI_PIPE_IDX(b); EPI_WVEC_LOOP { EPI_WVEC_IDX; gv[b][wi] = *(const u32x4*)(G + off); } }
#pragma unroll
            for (int b = 0; b < 4; ++b) { EPI_PIPE_IDX(b); EPI_WVEC_LOOP { EPI_WVEC_IDX; const u32x4 g = gv[b][wi]; const f32x4 v0 = acc[ai][bj][m][0], v1 = acc[ai][bj][m][1];
                    u32x4 o; o.x = pk2(bflo(g.x) * v0.x, bfhi(g.x) * v0.y); o.y = pk2(bflo(g.y) * v0.z, bfhi(g.y) * v0.w);
                    o.z = pk2(bflo(g.z) * v1.x, bfhi(g.z) * v1.y); o.w = pk2(bflo(g.w) * v1.z, bfhi(g.w) * v1.w);
                    *(u32x4*)(tmp + off) = o; } }
        } else {
            const bf16* G = (const bf16*)(ws + WS_GTB); bf16* Z = (bf16*)(ws + WS_Z);
            u32x4 gv[2][4], tv[2][4];
            { EPI_PIPE_IDX(0); EPI_WVEC_LOOP { EPI_WVEC_IDX; gv[0][wi] = *(const u32x4*)(G + off); tv[0][wi] = *(const u32x4*)(tmp + off); } }
#pragma unroll
            for (int b = 0; b < 4; ++b) {
                if (b < 3) { EPI_PIPE_IDX(b + 1); EPI_WVEC_LOOP { EPI_WVEC_IDX; gv[(b + 1) & 1][wi] = *(const u32x4*)(G + off); tv[(b + 1) & 1][wi] = *(const u32x4*)(tmp + off); } }
                { EPI_PIPE_IDX(b); EPI_WVEC_LOOP { EPI_WVEC_IDX; const u32x4 g = gv[b & 1][wi], t = tv[b & 1][wi]; const f32x4 v0 = acc[ai][bj][m][0], v1 = acc[ai][bj][m][1];
                    u32x4 o; o.x = pk2(bflo(t.x) + bflo(g.x) * v0.x, bfhi(t.x) + bfhi(g.x) * v0.y); o.y = pk2(bflo(t.y) + bflo(g.y) * v0.z, bfhi(t.y) + bfhi(g.y) * v0.w);
                    o.z = pk2(bflo(t.z) + bflo(g.z) * v1.x, bfhi(t.z) + bfhi(g.z) * v1.y); o.w = pk2(bflo(t.w) + bflo(g.w) * v1.z, bfhi(t.w) + bfhi(g.w) * v1.w);
                    *(u32x4*)(Z + off) = o; } }
            }
        }
    }
};
struct EpiOutProj {
    static constexpr bool PERM = true, AFTER_DRAIN = false;
    unsigned char* ws; const float* x; const float* norm2_g; float* out;
    __device__ __forceinline__ void operator()(const f32x4 (&acc)[2][2][4][2], const pg8::Unit& u, int wr, int wc, int fr, int fq) const {
        { const int l_ = lane_id(); fr = l_ & 15; fq = l_ >> 4; }
        const float* mod = (const float*)(ws + WS_MOD); bf16* XMG = (bf16*)(ws + WS_XMG); bf16* XM = (bf16*)(ws + WS_XM16); float* rowsq = (float*)(ws + WS_ROWSQ);
        const int bb = (u.pm * 256) / SEQ;
        const float* g1 = mod + (size_t)bb * IN_COLS + 2 * D_MODEL, *sc2 = mod + (size_t)bb * IN_COLS + 4 * D_MODEL;
        float ss[2][4];
#pragma unroll
        for (int ai = 0; ai < 2; ++ai)
#pragma unroll
            for (int m = 0; m < 4; ++m) ss[ai][m] = 0.f;
#pragma unroll
        for (int bj = 0; bj < 2; ++bj) {
            const int col = u.pn * 256 + bj * 128 + wc * 32 + fq * 8;
            const f32x4 cg0 = *(const f32x4*)(g1 + col), cg1 = *(const f32x4*)(g1 + col + 4), ch0 = *(const f32x4*)(sc2 + col), ch1 = *(const f32x4*)(sc2 + col + 4);
            f32x4 xv[2][4][2];
#pragma unroll
            for (int ai = 0; ai < 2; ++ai)
#pragma unroll
                for (int m = 0; m < 4; ++m) { const unsigned off = (unsigned)((u.pm * 256 + ai * 128 + wr * 64 + m * 16 + fr) * D_MODEL + col); xv[ai][m][0] = *(const f32x4*)((const char*)x + off * 4u); xv[ai][m][1] = *(const f32x4*)((const char*)x + off * 4u + 16); }
#pragma unroll
            for (int ai = 0; ai < 2; ++ai)
#pragma unroll
                for (int m = 0; m < 4; ++m) { const unsigned off = (unsigned)((u.pm * 256 + ai * 128 + wr * 64 + m * 16 + fr) * D_MODEL + col);
                    const f32x4 xm0 = xv[ai][m][0] + cg0 * acc[ai][bj][m][0], xm1 = xv[ai][m][1] + cg1 * acc[ai][bj][m][1];
                    { u32x4 o; o.x = pk2(xm0.x, xm0.y); o.y = pk2(xm0.z, xm0.w); o.z = pk2(xm1.x, xm1.y); o.w = pk2(xm1.z, xm1.w); *(u32x4*)((char*)XM + off * 2u) = o; }
                    ss[ai][m] += ((xm0.x * xm0.x + xm0.y * xm0.y) + (xm0.z * xm0.z + xm0.w * xm0.w)) + ((xm1.x * xm1.x + xm1.y * xm1.y) + (xm1.z * xm1.z + xm1.w * xm1.w));
                    const f32x4 h0 = xm0 * ch0, h1 = xm1 * ch1;
                    u32x4 o; o.x = pk2(h0.x, h0.y); o.y = pk2(h0.z, h0.w); o.z = pk2(h1.x, h1.y); o.w = pk2(h1.z, h1.w);
                    *(u32x4*)((char*)XMG + off * 2u) = o; }
        }
#pragma unroll
        for (int ai = 0; ai < 2; ++ai)
#pragma unroll
            for (int m = 0; m < 4; ++m) { float t = ss[ai][m]; t += __shfl_xor(t, 16); t += __shfl_xor(t, 32);
                if (fq == 0) atomicAdd((float*)((char*)rowsq + (unsigned)(u.pm * 256 + ai * 128 + wr * 64 + m * 16 + fr) * 4u), t); }
    }
};
__device__ __forceinline__ float dpp_ror1(float v) { return __builtin_bit_cast(float, __builtin_amdgcn_update_dpp(0, __builtin_bit_cast(int, v), 0x121, 0xf, 0xf, false)); }
__device__ __forceinline__ float dpp_rol1(float v) { return __builtin_bit_cast(float, __builtin_amdgcn_update_dpp(0, __builtin_bit_cast(int, v), 0x12f, 0xf, 0xf, false)); }
__device__ __forceinline__ f32x4 ror1_4(const f32x4 v) { return (f32x4){dpp_ror1(v.x), dpp_ror1(v.y), dpp_ror1(v.z), dpp_ror1(v.w)}; }
__device__ __forceinline__ f32x4 rol1_4(const f32x4 v) { return (f32x4){dpp_rol1(v.x), dpp_rol1(v.y), dpp_rol1(v.z), dpp_rol1(v.w)}; }
struct EpiFfnUp {
    static constexpr bool PERM = true, AFTER_DRAIN = false;
    unsigned char* ws; LAS unsigned char* lds; const float* cw; const float* cb;
    __device__ __forceinline__ void operator()(const f32x4 (&acc_c)[2][2][4][2], const pg8::Unit& u, int wr, int wc, int fr, int fq) const {
        f32x4 (&acc)[2][2][4][2] = const_cast<f32x4 (&)[2][2][4][2]>(acc_c);
        { const int l_ = lane_id(); fr = l_ & 15; fq = l_ >> 4; }
        const float* rowsq = (const float*)(ws + WS_ROWSQ); bf16* ACT = (bf16*)(ws + WS_ACT); float* HALO = (float*)(ws + WS_HALO) + (size_t)u.pm * 6 * FFN;
        const int b = (u.pm * 256) / SEQ; const float* bias2 = (const float*)(ws + WS_BIAS2) + (size_t)b * 2 * FFN + u.pn * 256;
        const int cl = wc * 32 + fq * 8, ch0 = u.pn * 128 + cl;
        LAS float* X = (LAS float*)(lds + 131072);
#pragma unroll
        for (int ai = 0; ai < 2; ++ai)
#pragma unroll
            for (int m = 0; m < 4; ++m) { const int row = u.pm * 256 + ai * 128 + wr * 64 + m * 16 + fr;
                const float rstd = __builtin_amdgcn_rsqf(rowsq[row] * (1.0f / D_MODEL) + EPS);
#pragma unroll
                for (int bj = 0; bj < 2; ++bj)
#pragma unroll
                    for (int n = 0; n < 2; ++n) acc[ai][bj][m][n] = acc[ai][bj][m][n] * rstd + *(const f32x4*)(bias2 + bj * 128 + cl + 4 * n); }
        f32x4 w0[2], w1[2], w2[2], cbv[2];
#pragma unroll
        for (int n = 0; n < 2; ++n) { w0[n] = *(const f32x4*)(cw + ch0 + 4 * n); w1[n] = *(const f32x4*)(cw + FFN + ch0 + 4 * n); w2[n] = *(const f32x4*)(cw + 2 * FFN + ch0 + 4 * n); cbv[n] = *(const f32x4*)(cb + ch0 + 4 * n); }
#pragma unroll
        for (int ai = 0; ai < 2; ++ai) { const int bi = 2 * ai + wr;
            if (fr == 0) {
#pragma unroll
                for (int n = 0; n < 2; ++n) *(LAS f32x4*)(X + (bi * 2 + 0) * 128 + cl + 4 * n) = acc[ai][0][0][n]; }
            if (fr == 15) {
#pragma unroll
                for (int n = 0; n < 2; ++n) *(LAS f32x4*)(X + (bi * 2 + 1) * 128 + cl + 4 * n) = acc[ai][0][3][n]; } }
        asm volatile("s_waitcnt lgkmcnt(0)" ::: "memory"); __builtin_amdgcn_s_barrier(); asm volatile("" ::: "memory");
#pragma unroll
        for (int ai = 0; ai < 2; ++ai) { const int bi = 2 * ai + wr;
#pragma unroll
            for (int m = 0; m < 4; ++m) { u32x4 o;
#pragma unroll
                for (int n = 0; n < 2; ++n) { const f32x4 cur = acc[ai][0][m][n];
                    f32x4 pu, nd;
                    if (m > 0) pu = ror1_4(acc[ai][0][m > 0 ? m - 1 : 0][n]); else pu = (bi > 0) ? *(const LAS f32x4*)(X + ((bi - 1) * 2 + 1) * 128 + cl + 4 * n) : (f32x4){0.f, 0.f, 0.f, 0.f};
                    if (m < 3) nd = rol1_4(acc[ai][0][m < 3 ? m + 1 : 3][n]); else nd = (bi < 3) ? *(const LAS f32x4*)(X + ((bi + 1) * 2 + 0) * 128 + cl + 4 * n) : (f32x4){0.f, 0.f, 0.f, 0.f};
                    const f32x4 ps = ror1_4(cur), ns = rol1_4(cur);
                    const f32x4 prev = (fr > 0) ? ps : pu, next = (fr < 15) ? ns : nd;
                    const f32x4 uu = w0[n] * prev + w1[n] * cur + w2[n] * next + cbv[n]; const f32x4 gt = acc[ai][1][m][n];
                    f32x4 r; r.x = siluf_(uu.x) * gt.x; r.y = siluf_(uu.y) * gt.y; r.z = siluf_(uu.z) * gt.z; r.w = siluf_(uu.w) * gt.w;
                    if (n == 0) { o.x = pk2(r.x, r.y); o.y = pk2(r.z, r.w); } else { o.z = pk2(r.x, r.y); o.w = pk2(r.z, r.w); } }
                const int rl = ai * 128 + wr * 64 + m * 16 + fr;
                if (rl != 0 && rl != 255) *(u32x4*)(ACT + (size_t)(u.pm * 256 + rl) * FFN + ch0) = o; } }
        if (wr == 0 && fr < 2) {
#pragma unroll
            for (int n = 0; n < 2; ++n) { *(f32x4*)(HALO + (size_t)fr * FFN + ch0 + 4 * n) = acc[0][0][0][n]; if (fr == 0) *(f32x4*)(HALO + (size_t)4 * FFN + ch0 + 4 * n) = acc[0][1][0][n]; } }
        if (wr == 1 && fr >= 14) {
#pragma unroll
            for (int n = 0; n < 2; ++n) { *(f32x4*)(HALO + (size_t)(fr - 12) * FFN + ch0 + 4 * n) = acc[1][0][3][n]; if (fr == 15) *(f32x4*)(HALO + (size_t)5 * FFN + ch0 + 4 * n) = acc[1][1][3][n]; } }
    }
};
__device__ __forceinline__ void halo_fix(const Params& p, int pm, int tid) {
    const float* HB = (const float*)(p.ws + WS_HALO); const float* H = HB + (size_t)pm * 6 * FFN; bf16* ACT = (bf16*)(p.ws + WS_ACT);
    for (int ch = tid; ch < FFN; ch += NTHREADS) {
        const float w0 = p.conv_w[ch], w1 = p.conv_w[FFN + ch], w2 = p.conv_w[2 * FFN + ch], cbv = p.conv_b[ch];
        const float pv = (pm & 7) ? HB[((size_t)(pm - 1) * 6 + 3) * FFN + ch] : 0.f; const float nx = ((pm & 7) != 7) ? HB[((size_t)(pm + 1) * 6 + 0) * FFN + ch] : 0.f;
        const float ut = w0 * pv + w1 * H[ch] + w2 * H[FFN + ch] + cbv; const float ub = w0 * H[2 * FFN + ch] + w1 * H[3 * FFN + ch] + w2 * nx + cbv;
        ACT[(size_t)(pm * 256) * FFN + ch] = (bf16)f2bf(siluf_(ut) * H[4 * FFN + ch]); ACT[(size_t)(pm * 256 + 255) * FFN + ch] = (bf16)f2bf(siluf_(ub) * H[5 * FFN + ch]);
    }
}
struct EpiFfnDown {
    static constexpr bool PERM = true, AFTER_DRAIN = false;
    unsigned char* ws; float* out;
    __device__ __forceinline__ void operator()(const f32x4 (&acc)[2][2][4][2], const pg8::Unit& u, int wr, int wc, int fr, int fq) const {
        { const int l_ = lane_id(); fr = l_ & 15; fq = l_ >> 4; }
        const float* mod = (const float*)(ws + WS_MOD); const int bb = (u.pm * 256) / SEQ; const float* g2 = mod + (size_t)bb * IN_COLS + 5 * D_MODEL; const bf16* XM = (const bf16*)(ws + WS_XM16);
        f32x4 cg[2][2];
#pragma unroll
        for (int bj = 0; bj < 2; ++bj)
#pragma unroll
            for (int n = 0; n < 2; ++n) cg[bj][n] = *(const f32x4*)(g2 + u.pn * 256 + bj * 128 + wc * 32 + fq * 8 + 4 * n);
        u32x4 xv[4][4];
#pragma unroll
        for (int b = 0; b < 4; ++b) { EPI_PIPE_IDX(b); EPI_WVEC_LOOP { EPI_WVEC_IDX; xv[b][wi] = *(const u32x4*)((const char*)XM + off * 2u); } }
#pragma unroll
        for (int b = 0; b < 4; ++b) { EPI_PIPE_IDX(b);
            EPI_WVEC_LOOP { EPI_WVEC_IDX; const u32x4 xw = xv[b][wi];
                const f32x4 x0 = (f32x4){bflo(xw.x), bfhi(xw.x), bflo(xw.y), bfhi(xw.y)}, x1 = (f32x4){bflo(xw.z), bfhi(xw.z), bflo(xw.w), bfhi(xw.w)};
                *(f32x4*)((char*)out + off * 4u) = x0 + cg[bj][0] * acc[ai][bj][m][0]; *(f32x4*)((char*)out + off * 4u + 16) = x1 + cg[bj][1] * acc[ai][bj][m][1]; }
        }
    }
};

#define XB_TMO      128
#define XB_XCNT(j)  (256  + 64 * (j))
#define XB_XSUB(j)  (1280 + 64 * (j))
#define XB_XGEN(j)  (2304 + 64 * (j))
#define XB_TOP      3328
#define XB_TOPGEN   3392
#define XCD_BAR_WORDS 3456
#define XB_SPIN_CAP (1u << 18)

__device__ __forceinline__ unsigned xb_ld(unsigned* p)              { return __hip_atomic_load(p, __ATOMIC_RELAXED, __HIP_MEMORY_SCOPE_AGENT); }
__device__ __forceinline__ unsigned xb_add(unsigned* p, unsigned v) { return __hip_atomic_fetch_add(p, v, __ATOMIC_RELAXED, __HIP_MEMORY_SCOPE_AGENT); }
__device__ __forceinline__ unsigned xb_xcc_id() { return (unsigned)__builtin_amdgcn_s_getreg((3 << 11) | 20) & 0xFu; }
#define XB_SPIN(cond, bar) do { unsigned _sp = 0; while (cond) { __builtin_amdgcn_s_sleep(1); \
    if ((++_sp & 255u) == 0u) { if (xb_ld(&(bar)[XB_TMO])) break; if (_sp > XB_SPIN_CAP) { atomicAdd(&(bar)[XB_TMO], 1u); break; } } } } while (0)

struct XcdBarrier {
    unsigned* bar; unsigned x; int wave;
    volatile LAS unsigned* st;
};

__device__ __forceinline__ XcdBarrier xcd_barrier_post(unsigned* bar, volatile LAS unsigned* st, int wave_id) {
    XcdBarrier b; b.bar = bar; b.x = xb_xcc_id(); b.st = st; b.wave = wave_id;
    if (wave_id == 0 && lane_id() == 0) (void)xb_add(&bar[XB_XCNT(b.x)], 1u);
    return b;
}
__device__ __forceinline__ void xcd_barrier_complete(unsigned* bar, unsigned x, unsigned& nloc, unsigned& nx) {
    const unsigned G = gridDim.x * gridDim.y * gridDim.z;
    unsigned sum, cnt, mine, sp = 0u;
    for (;;) {
        sum = 0u; cnt = 0u; mine = 0u;
#pragma unroll
        for (unsigned j = 0; j < 16; ++j) { const unsigned c = xb_ld(&bar[XB_XCNT(j)]); sum += c; cnt += (c > 0u) ? 1u : 0u; mine = (j == x) ? c : mine; }
        if (sum == G) break;
        __builtin_amdgcn_s_sleep(1);
        if ((++sp & 255u) == 0u) { if (xb_ld(&bar[XB_TMO])) break; if (sp > XB_SPIN_CAP) { atomicAdd(&bar[XB_TMO], 1u); break; } }
    }
    nloc = mine > 0u ? mine : 1u; nx = cnt > 0u ? cnt : 1u;
}

__device__ __forceinline__ void xcd_barrier(const XcdBarrier& b) {
    asm volatile("s_waitcnt vmcnt(0)" ::: "memory");
    __syncthreads();
    if (b.wave == 0 && lane_id() == 0) {
        unsigned* bar = b.bar;
        __builtin_amdgcn_s_waitcnt(0);
        unsigned nloc = b.st[0], nx = b.st[1];
        if (nloc == 0u) { xcd_barrier_complete(bar, b.x, nloc, nx); b.st[0] = nloc; b.st[1] = nx; }
        const unsigned old = xb_add(&bar[XB_XSUB(b.x)], 1u);
        const unsigned gen = old / nloc;
        if (old + 1u == (gen + 1u) * nloc) {
            __builtin_amdgcn_fence(__ATOMIC_RELEASE, "agent");
            asm volatile("s_waitcnt vmcnt(0)" ::: "memory");
            const unsigned og = xb_add(&bar[XB_TOP], 1u);
            const unsigned tg = og / nx;
            if (og + 1u == (tg + 1u) * nx) xb_add(&bar[XB_TOPGEN], 1u);
            else XB_SPIN(xb_ld(&bar[XB_TOPGEN]) == tg, bar);
            __builtin_amdgcn_fence(__ATOMIC_ACQUIRE, "agent");
            xb_add(&bar[XB_XGEN(b.x)], 1u);
            asm volatile("s_waitcnt vmcnt(0)" ::: "memory");
        } else {
            XB_SPIN(xb_ld(&bar[XB_XGEN(b.x)]) == gen, bar);
            __builtin_amdgcn_fence(__ATOMIC_ACQUIRE, "agent");
            asm volatile("s_waitcnt vmcnt(0)" ::: "memory");
        }
    }
    __syncthreads();
}

constexpr size_t WS_BAR = 8192;

typedef short bf16x8 __attribute__((ext_vector_type(8)));
typedef short s16x4 __attribute__((ext_vector_type(4)));

__device__ __forceinline__ bf16x8 cat8u(const u32x2 a, const u32x2 b) { const u32x4 w = (u32x4){a.x, a.y, b.x, b.y}; return __builtin_bit_cast(bf16x8, w); }
__device__ __forceinline__ bf16x8 pack_p(const f32x4 a, const f32x4 b) {
    u32x4 w; w.x = pk2(a.x, a.y); w.y = pk2(a.z, a.w); w.z = pk2(b.x, b.y); w.w = pk2(b.z, b.w);
    return __builtin_bit_cast(bf16x8, w);
}

constexpr int A_TILE = 32768, A_KOFF = 0, A_VOFF = 16384;
constexpr int A_BIAS = 4 * A_TILE;
constexpr int A_ITEM = A_BIAS + 2048;
static_assert(A_ITEM + 64 <= 145408, "attention LDS");
constexpr size_t WS_ATTCTR = 32768;
static_assert(WS_ATTCTR >= WS_BAR + XCD_BAR_WORDS * 4 && WS_ATTCTR + 8 * 256 <= WS_ROWSQ, "attn counters (8 x 256 B apart) inside ctl");
#define ATT_BAR() do { asm volatile("s_waitcnt lgkmcnt(0)" ::: "memory"); __builtin_amdgcn_s_barrier(); asm volatile("" ::: "memory"); } while (0)
__device__ __forceinline__ void glds16(const void* gsrc, unsigned lds_dst) { unsigned keep;
    asm volatile("s_mov_b32 %0, m0\n\ts_mov_b32 m0, %2\n\ts_nop 0\n\tglobal_load_lds_dwordx4 %1, off\n\ts_mov_b32 m0, %0" : "=&s"(keep) : "v"(gsrc), "s"(lds_dst) : "memory"); }
__device__ __forceinline__ unsigned lds_addr(LAS const void* p) { return (unsigned)__builtin_amdgcn_readfirstlane((int)(unsigned)(unsigned long long)p); }

__device__ __forceinline__ void phase_attn(const Params& p, LAS unsigned char* lds) {
    int tid_o = tid_of(p.wave_id);
    const int tid = tid_o, lane = tid & 63, wave = __builtin_amdgcn_readfirstlane(tid >> 6);
    const int qb = wave & 3, rw = wave >> 2, li = lane & 15, g = lane >> 4;
    const bf16* QN = (const bf16*)(p.ws + WS_QN); const bf16* KN = (const bf16*)(p.ws + WS_KN); const bf16* VT = (const bf16*)(p.ws + WS_VN);
    bf16* YB = (bf16*)p.out + (size_t)3 * ML * WA;
    unsigned* ctr = (unsigned*)(p.ws + WS_ATTCTR);
    LAS float* btab = (LAS float*)(lds + A_BIAS);
    const float scale = 0.08838834764831845f;
    int krow_l[2], kch_l[2], vrow_l[2], vch_l[2];
#pragma unroll
    for (int e = 0; e < 2; ++e) { const int pk = 2 * wave + e; krow_l[e] = 4 * pk + (lane >> 4); kch_l[e] = (lane & 15) ^ (krow_l[e] & 15);
        vrow_l[e] = 8 * pk + (lane >> 3); vch_l[e] = (lane & 7) ^ ((vrow_l[e] >> 1) & 7); }
    const int myx = (int)(xb_xcc_id() & 7u);
    int qoff = 0;
    for (;;) {
        if (tid == 0) { unsigned v = 0xffffffffu;
            while (qoff < 8) { const int qx = (myx + qoff) & 7; const unsigned n = atomicAdd(ctr + 64 * qx, 1u); if (n < 64u) { v = (unsigned)((qx + 8 * (n >> 4)) * 16 + (n & 15)); break; } ++qoff; }
            *(LAS unsigned*)(lds + A_ITEM) = v; }
        __syncthreads();
        const unsigned itu = *(LAS unsigned*)(lds + A_ITEM);
        if (itu == 0xffffffffu) break;
        const int it = (int)itu;
        const int rp = it & 15, h = (it >> 4) & 7, b = it >> 7;
        const int r = 2 * rp + rw;
        const int rs = min(max(r - 4, 0), 24), ks0 = min(max(16 * qb - 8, 0), 32);
        const int kr0 = min(max(2 * rp - 4, 0), 24), nband = min(max(2 * rp + 1 - 4, 0), 24) + 8 - kr0, NT = nband + 4;
        const int cq = 16 * qb + li, cs = min(max(cq - 8, 0), 48);
        const size_t qrow = (size_t)b * SEQ + r * GRID_W + cq;
        if (tid < 15 * 31) btab[tid] = p.rel_bias[h * 465 + tid];
        bf16x8 qf[4];
#pragma unroll
        for (int ks = 0; ks < 4; ++ks) qf[ks] = *(const bf16x8*)(QN + qrow * WA + h * HD + 32 * ks + 8 * g);
        asm volatile("s_waitcnt vmcnt(0)" ::: "memory");
        const bf16* kg0 = KN + (size_t)h * HD + (size_t)krow_l[0] * WA + 8 * kch_l[0]; const bf16* kg1 = KN + (size_t)h * HD + (size_t)krow_l[1] * WA + 8 * kch_l[1];
        const bf16* vg0 = VT + ((size_t)(b * NHEAD + h) * HD + vrow_l[0]) * VT_PITCH + 8 * vch_l[0]; const bf16* vg1 = VT + ((size_t)(b * NHEAD + h) * HD + vrow_l[1]) * VT_PITCH + 8 * vch_l[1];
#define ATT_DMA(ti_) do { const int t_ = (ti_) < NT ? (ti_) : NT - 1; const unsigned la_ = lds_addr(lds + ((ti_) & 3) * A_TILE + wave * 2048); \
            const size_t krow0 = (t_ < nband) ? ((size_t)b * SEQ + (kr0 + t_) * GRID_W) : ((size_t)ML + b * CTX + 64 * (t_ - nband)); \
            const int tok0 = (t_ < nband) ? ((kr0 + t_) * GRID_W) : (SEQ + 64 * (t_ - nband)); \
            glds16(kg0 + krow0 * WA, la_ + A_KOFF); glds16(kg1 + krow0 * WA, la_ + A_KOFF + 1024); glds16(vg0 + tok0, la_ + A_VOFF); glds16(vg1 + tok0, la_ + A_VOFF + 1024); } while (0)
        ATT_DMA(0); ATT_DMA(1); ATT_DMA(2);
        f32x4 ot[8];
#pragma unroll
        for (int db = 0; db < 8; ++db) ot[db] = (f32x4){0.f, 0.f, 0.f, 0.f};
        float mrun = -1e30f, l = 0.f;
        const int kx = (ks0 + li) & 15, vy = (li >> 1) & 7;
        int koff[4];
#pragma unroll
        for (int ks = 0; ks < 4; ++ks) koff[ks] = A_KOFF + (ks0 + li) * 256 + (((4 * ks + g) ^ kx) << 4);
        const int vrow_off = A_VOFF + li * 128 + 8 * (g & 1);
        const int gq = g >> 1;
#pragma unroll 1
        for (int ti = 0; ti < NT; ++ti) {
            asm volatile("s_waitcnt vmcnt(8)" ::: "memory");
            ATT_BAR();
            ATT_DMA(ti + 3);
            const LAS unsigned char* tb = lds + (ti & 3) * A_TILE;
            if (ti < nband) {
                const int kr = kr0 + ti;
                if (kr >= rs && kr < rs + 8) {
                    f32x4 st[2];
#pragma unroll
                    for (int kb = 0; kb < 2; ++kb) { f32x4 a = (f32x4){0.f, 0.f, 0.f, 0.f};
#pragma unroll
                        for (int ks = 0; ks < 4; ++ks) a = __builtin_amdgcn_mfma_f32_16x16x32_bf16(*(const LAS bf16x8*)(tb + koff[ks] + kb * 4096), qf[ks], a, 0, 0, 0);
                        st[kb] = a; }
                    const int dr = kr - r + 7; float gm = -1e30f;
#pragma unroll
                    for (int kb = 0; kb < 2; ++kb)
#pragma unroll
                        for (int j = 0; j < 4; ++j) { const int kcol = ks0 + 16 * kb + 4 * g + j; const bool valid = (kcol >= cs) && (kcol < cs + 16);
                            const int bi = valid ? (dr * 31 + (kcol - cq + 15)) : 0;
                            const float sv = valid ? (st[kb][j] * scale + btab[bi]) : -1e30f; st[kb][j] = sv; gm = fmaxf(gm, sv); }
                    gm = fmaxf(gm, __shfl_xor(gm, 16)); gm = fmaxf(gm, __shfl_xor(gm, 32));
                    const float mnew = fmaxf(mrun, gm); const float alpha = __expf(mrun - mnew); mrun = mnew; l *= alpha;
#pragma unroll
                    for (int db = 0; db < 8; ++db) ot[db] = ot[db] * alpha;
#pragma unroll
                    for (int kb = 0; kb < 2; ++kb)
#pragma unroll
                        for (int j = 0; j < 4; ++j) { const float sv = st[kb][j]; const float e = (sv > -1e29f) ? __expf(sv - mnew) : 0.f; st[kb][j] = e; l += e; }
                    const bf16x8 pb = pack_p(st[0], st[1]);
                    const int c0 = (ks0 >> 3) + gq;
#pragma unroll
                    for (int db = 0; db < 8; ++db) { const LAS unsigned char* vp = tb + vrow_off + db * 2048;
                        ot[db] = __builtin_amdgcn_mfma_f32_16x16x32_bf16(cat8u(*(const LAS u32x2*)(vp + ((c0 ^ vy) << 4)), *(const LAS u32x2*)(vp + (((c0 + 2) ^ vy) << 4))), pb, ot[db], 0, 0, 0); }
                }
            } else {
                f32x4 st[4];
#pragma unroll
                for (int kb = 0; kb < 4; ++kb) { f32x4 a = (f32x4){0.f, 0.f, 0.f, 0.f};
#pragma unroll
                    for (int ks = 0; ks < 4; ++ks) a = __builtin_amdgcn_mfma_f32_16x16x32_bf16(*(const LAS bf16x8*)(tb + A_KOFF + (16 * kb + li) * 256 + (((4 * ks + g) ^ li) << 4)), qf[ks], a, 0, 0, 0);
                    st[kb] = a * scale; }
                float gm = -1e30f;
#pragma unroll
                for (int kb = 0; kb < 4; ++kb) gm = fmaxf(fmaxf(gm, fmaxf(st[kb][0], st[kb][1])), fmaxf(st[kb][2], st[kb][3]));
                gm = fmaxf(gm, __shfl_xor(gm, 16)); gm = fmaxf(gm, __shfl_xor(gm, 32));
                const float mnew = fmaxf(mrun, gm); const float alpha = __expf(mrun - mnew); mrun = mnew; l *= alpha;
#pragma unroll
                for (int db = 0; db < 8; ++db) ot[db] = ot[db] * alpha;
#pragma unroll
                for (int kb = 0; kb < 4; ++kb)
#pragma unroll
                    for (int j = 0; j < 4; ++j) { const float e = __expf(st[kb][j] - mnew); st[kb][j] = e; l += e; }
#pragma unroll
                for (int kp2 = 0; kp2 < 2; ++kp2) { const bf16x8 pb = pack_p(st[2 * kp2], st[2 * kp2 + 1]);
                    const int c0 = 4 * kp2 + gq;
#pragma unroll
                    for (int db = 0; db < 8; ++db) { const LAS unsigned char* vp = tb + vrow_off + db * 2048;
                        ot[db] = __builtin_amdgcn_mfma_f32_16x16x32_bf16(cat8u(*(const LAS u32x2*)(vp + ((c0 ^ vy) << 4)), *(const LAS u32x2*)(vp + (((c0 + 2) ^ vy) << 4))), pb, ot[db], 0, 0, 0); } }
            }
        }
        asm volatile("s_waitcnt vmcnt(0)" ::: "memory");
        l += __shfl_xor(l, 16); l += __shfl_xor(l, 32);
        const float inv = 1.0f / l;
#pragma unroll
        for (int db = 0; db < 8; ++db) { const f32x4 o = ot[db] * inv; u32x2 w; w.x = pk2(o.x, o.y); w.y = pk2(o.z, o.w);
            *(u32x2*)(YB + qrow * WA + h * HD + 16 * db + 4 * g) = w; }
#undef ATT_DMA
    }
}

constexpr int HP = 160;
constexpr int H_QH = 0, H_KH = 20480, H_KE = 40960, H_QD = 61440, H_KD = 81920;
constexpr int HP2 = 48;
constexpr int H_Q2 = 102400, H_K2 = 108544;
constexpr int PP = 144;
constexpr int H_P = 114688;
constexpr int H_T = 123904;
constexpr int H_D = 125952;
constexpr int HIMG_QD = 0, HIMG_KD = 16384, HIMG_P = 32768, HIMG_D = 40960, HIMG_BYTES = 41472;
constexpr int NCH = (CTX + SEQ) / 64;
constexpr int VP = 288;
constexpr int HPK = 136;
constexpr int SB_QD = 0, SB_KD = 20480, SB_P = 40960, SB_D = 50176, SB_V = 50688, SB_BYTES = 69120;
static_assert(2 * SB_BYTES <= 145408, "scan buffers");

__device__ __forceinline__ s16x4 lds_tr(LAS const unsigned char* p) {
    return __builtin_bit_cast(s16x4, __builtin_amdgcn_ds_read_tr16_b64_v4i16((LAS s16x4*)p));
}
__device__ __forceinline__ bf16x8 cat8(const s16x4 a, const s16x4 b) { return __builtin_shufflevector(a, b, 0, 1, 2, 3, 4, 5, 6, 7); }

__device__ __forceinline__ size_t hg_row(int dir, int b, int tau) {
    if (tau < CTX) return (size_t)ML + b * CTX + (dir == 0 ? tau : CTX - 1 - tau);
    const int t = tau - CTX; return (size_t)b * SEQ + (dir == 0 ? t : SEQ - 1 - t);
}

__device__ __forceinline__ void hgrn_prep(const Params& p, LAS unsigned char* lds, int vb, int nb) {
    int tid_o = tid_of(p.wave_id);
    const int tid = tid_o, lane = tid & 63, wave = __builtin_amdgcn_readfirstlane(tid >> 6);
    const int k = tid & 127, J = __builtin_amdgcn_readfirstlane(tid >> 7);
    const int li = lane & 15, g = lane >> 4, qq = li >> 2, pp = li & 3;
    LAS float* Tl = (LAS float*)(lds + H_T); LAS float* Dl = (LAS float*)(lds + H_D);
    float lf[16]; unsigned qv[16];
#define HG_LOADP(idx_) do { const int id_ = (idx_); const int ch_ = id_ / NCH, cc_ = id_ % NCH; const int dir_ = ch_ / (BATCH * NHEAD), b_ = (ch_ / NHEAD) % BATCH, h_ = ch_ % NHEAD; \
        const size_t row0_ = hg_row(dir_, b_, 64 * cc_ + 16 * J); const long st_ = dir_ ? -(long)WA : (long)WA; \
        const float* lfp_ = (const float*)(p.ws + (dir_ == 0 ? WS_FW : WS_FB)) + row0_ * WA + h_ * HD + k; const bf16* qp_ = (const bf16*)(p.ws + WS_QA) + row0_ * WA + h_ * HD + k; \
        _Pragma("unroll") for (int i = 0; i < 16; ++i) { lf[i] = lfp_[(long)i * st_]; qv[i] = (cc_ >= 4) ? (unsigned)qp_[(long)i * st_] : 0u; } } while (0)
    if (vb < 64 * NCH) HG_LOADP(vb);
    for (int idx = vb; idx < 64 * NCH; idx += nb) {
        const int c = idx % NCH;
        float cum[16]; float run = 0.f;
#pragma unroll
        for (int i = 0; i < 16; ++i) { run += lf[i]; cum[i] = run; }
        Tl[J * 128 + k] = run;
        ATT_BAR();
        const float T0 = Tl[k], T1 = Tl[128 + k], T2 = Tl[256 + k], T3 = Tl[384 + k];
        const float bJ = (J > 0 ? T0 : 0.f) + (J > 1 ? T1 : 0.f) + (J > 2 ? T2 : 0.f);
        const float tail = (J < 1 ? T1 : 0.f) + (J < 2 ? T2 : 0.f) + (J < 3 ? T3 : 0.f);
        const float eb = __expf(bJ), et = __expf(tail), eT = __expf(run);
        const float x2 = (J == 3) ? __expf(T2) : __expf(T1);
        float qh[16], kh[16];
#pragma unroll
        for (int i = 0; i < 16; ++i) { const float e1 = __expf(cum[i]); const float r1 = __builtin_amdgcn_rcpf(e1); const float kk = 1.0f - __expf(lf[i]);
            qh[i] = __builtin_bit_cast(float, qv[i] << 16) * e1; kh[i] = kk * r1; }
        {
            LAS unsigned char* rowp = lds + k * HP + 32 * J;
            u32x4 w0, w1;
#define HG_WRITE(OFF, EXPR) do { \
            { float v0_, v1_; \
              { const int i = 0; v0_ = (EXPR); } { const int i = 1; v1_ = (EXPR); } w0.x = pk2(v0_, v1_); \
              { const int i = 2; v0_ = (EXPR); } { const int i = 3; v1_ = (EXPR); } w0.y = pk2(v0_, v1_); \
              { const int i = 4; v0_ = (EXPR); } { const int i = 5; v1_ = (EXPR); } w0.z = pk2(v0_, v1_); \
              { const int i = 6; v0_ = (EXPR); } { const int i = 7; v1_ = (EXPR); } w0.w = pk2(v0_, v1_); \
              { const int i = 8; v0_ = (EXPR); } { const int i = 9; v1_ = (EXPR); } w1.x = pk2(v0_, v1_); \
              { const int i = 10; v0_ = (EXPR); } { const int i = 11; v1_ = (EXPR); } w1.y = pk2(v0_, v1_); \
              { const int i = 12; v0_ = (EXPR); } { const int i = 13; v1_ = (EXPR); } w1.z = pk2(v0_, v1_); \
              { const int i = 14; v0_ = (EXPR); } { const int i = 15; v1_ = (EXPR); } w1.w = pk2(v0_, v1_); } \
            *(LAS u32x4*)(OFF) = w0; *(LAS u32x4*)((OFF) + 16) = w1; } while (0)
            HG_WRITE(rowp + H_QH, qh[i]);
            HG_WRITE(rowp + H_KH, kh[i]);
            HG_WRITE(rowp + H_KE, kh[i] * eT);
            HG_WRITE(rowp + H_QD, qh[i] * eb);
            HG_WRITE(rowp + H_KD, kh[i] * (eT * et));
            if (J == 3) { HG_WRITE(lds + H_Q2 + k * HP2, qh[i] * x2); }
            if (J == 0) { HG_WRITE(lds + H_K2 + k * HP2, kh[i] * (eT * x2)); }
#undef HG_WRITE
            if (J == 3) Dl[k] = __expf(bJ + run);
        }
        if (idx + nb < 64 * NCH) HG_LOADP(idx + nb);
        ATT_BAR();
        const bool lat = (c >= 4);
        if (lat) {
#pragma unroll
            for (int rep = 0; rep < 2; ++rep) {
                int I, Jb;
                if (rep == 0) { I = (wave < 4) ? wave : (wave == 4 ? 1 : (wave == 7 ? 3 : 2)); Jb = (wave < 4) ? wave : (wave == 4 ? 0 : (wave == 5 ? 0 : (wave == 6 ? 1 : 2))); }
                else { if (wave >= 2) break; I = 3; Jb = wave; }
                int aoff, apitch, acol, boff, bpitch, bcol;
                if (I == Jb) { aoff = H_KH; apitch = HP; acol = 16 * Jb; boff = H_QH; bpitch = HP; bcol = 16 * I; }
                else if (I == Jb + 1 && I != 2) { aoff = H_KE; apitch = HP; acol = 16 * Jb; boff = H_QH; bpitch = HP; bcol = 16 * I; }
                else if (I == 2) { if (Jb == 0) { aoff = H_K2; apitch = HP2; acol = 0; } else { aoff = H_KE; apitch = HP; acol = 16; } boff = H_QH; bpitch = HP; bcol = 32; }
                else { if (Jb == 0) { aoff = H_K2; apitch = HP2; acol = 0; } else { aoff = H_KE; apitch = HP; acol = 16; } boff = H_Q2; bpitch = HP2; bcol = 0; }
                f32x4 pt = (f32x4){0.f, 0.f, 0.f, 0.f};
#pragma unroll
                for (int ks = 0; ks < 4; ++ks) {
                    const int r0 = 32 * ks + 4 * g + qq;
                    const bf16x8 a = cat8(lds_tr(lds + aoff + r0 * apitch + (acol + 4 * pp) * 2), lds_tr(lds + aoff + (r0 + 16) * apitch + (acol + 4 * pp) * 2));
                    const bf16x8 bb = cat8(lds_tr(lds + boff + r0 * bpitch + (bcol + 4 * pp) * 2), lds_tr(lds + boff + (r0 + 16) * bpitch + (bcol + 4 * pp) * 2));
                    pt = __builtin_amdgcn_mfma_f32_16x16x32_bf16(a, bb, pt, 0, 0, 0);
                }
                if (I == Jb) {
#pragma unroll
                    for (int j = 0; j < 4; ++j) if (4 * g + j > li) pt[j] = 0.f;
                }
                u32x2 w; w.x = pk2(pt.x, pt.y); w.y = pk2(pt.z, pt.w);
                *(LAS u32x2*)(lds + H_P + (16 * I + li) * PP + (16 * Jb + 4 * g) * 2) = w;
            }
        }
        ATT_BAR();
        unsigned char* img = p.ws + WS_HIMG + (size_t)idx * HIMG_BYTES;
#pragma unroll
        for (int e = 0; e < 2; ++e) { const int id = tid + 512 * e; const int kr = id >> 3, part = id & 7;
            if (lat) *(u32x4*)(img + HIMG_QD + id * 16) = *(const LAS u32x4*)(lds + H_QD + kr * HP + 16 * part);
            *(u32x4*)(img + HIMG_KD + id * 16) = *(const LAS u32x4*)(lds + H_KD + kr * HP + 16 * part); }
        if (lat) *(u32x4*)(img + HIMG_P + tid * 16) = *(const LAS u32x4*)(lds + H_P + (tid >> 3) * PP + 16 * (tid & 7));
        if (tid < 32) *(u32x4*)(img + HIMG_D + tid * 16) = *(const LAS u32x4*)(lds + H_D + 16 * tid);
    }
#undef HG_LOADP
    __syncthreads();
}

__device__ __forceinline__ void hgrn_scan(const Params& p, LAS unsigned char* lds, int chain) {
    int tid_o = tid_of(p.wave_id);
    const int tid = tid_o, lane = tid & 63, wave = __builtin_amdgcn_readfirstlane(tid >> 6);
    const int li = lane & 15, g = lane >> 4, qq = li >> 2, pp = li & 3;
    const int dir = chain / (BATCH * NHEAD), b = (chain / NHEAD) % BATCH, h = chain % NHEAD;
    const bf16* IA = (const bf16*)(p.ws + WS_IA) + h * HD;
    bf16* O = ((bf16*)p.out + (dir == 0 ? 0 : (size_t)ML * WA)) + h * HD + 16 * wave + li;
    const long ost = dir ? -(long)WA : (long)WA;
    const unsigned char* img0 = p.ws + WS_HIMG + (size_t)chain * NCH * HIMG_BYTES;
    f32x4 S[8];
#pragma unroll
    for (int i = 0; i < 8; ++i) S[i] = (f32x4){0.f, 0.f, 0.f, 0.f};
    u32x4 rq[2][2], rk[2][2], rp[2], rd[2], rv[2][2];
#define HS_LOAD(c_, set_) do { const int cc_ = (c_); const unsigned char* im_ = img0 + (size_t)cc_ * HIMG_BYTES; \
        if (cc_ >= 4) { rq[set_][0] = *(const u32x4*)(im_ + HIMG_QD + tid * 16); rq[set_][1] = *(const u32x4*)(im_ + HIMG_QD + (tid + 512) * 16); rp[set_] = *(const u32x4*)(im_ + HIMG_P + tid * 16); } \
        rk[set_][0] = *(const u32x4*)(im_ + HIMG_KD + tid * 16); rk[set_][1] = *(const u32x4*)(im_ + HIMG_KD + (tid + 512) * 16); \
        if (tid < 32) rd[set_] = *(const u32x4*)(im_ + HIMG_D + tid * 16); \
        _Pragma("unroll") for (int e = 0; e < 2; ++e) { const int idx_ = tid * 2 + e; const size_t row_ = hg_row(dir, b, 64 * cc_ + (idx_ >> 4)); rv[set_][e] = *(const u32x4*)(IA + row_ * WA + 8 * (idx_ & 15)); } } while (0)
#define HS_STORE(c_, set_) do { const int cc_ = (c_); LAS unsigned char* bb_ = lds + (cc_ & 1) * SB_BYTES; \
        if (cc_ >= 4) { *(LAS u32x4*)(bb_ + SB_QD + (tid >> 3) * HP + 16 * (tid & 7)) = rq[set_][0]; *(LAS u32x4*)(bb_ + SB_QD + ((tid >> 3) + 64) * HP + 16 * (tid & 7)) = rq[set_][1]; \
                        *(LAS u32x4*)(bb_ + SB_P + (tid >> 3) * PP + 16 * (tid & 7)) = rp[set_]; } \
        { LAS unsigned char* k0_ = bb_ + SB_KD + (tid >> 3) * HPK + 16 * (tid & 7); LAS unsigned char* k1_ = k0_ + 64 * HPK; \
          *(LAS u32x2*)k0_ = (u32x2){rk[set_][0].x, rk[set_][0].y}; *(LAS u32x2*)(k0_ + 8) = (u32x2){rk[set_][0].z, rk[set_][0].w}; *(LAS u32x2*)k1_ = (u32x2){rk[set_][1].x, rk[set_][1].y}; *(LAS u32x2*)(k1_ + 8) = (u32x2){rk[set_][1].z, rk[set_][1].w}; } \
        if (tid < 32) *(LAS u32x4*)(bb_ + SB_D + 16 * tid) = rd[set_]; \
        _Pragma("unroll") for (int e = 0; e < 2; ++e) { const int idx_ = tid * 2 + e; *(LAS u32x4*)(bb_ + SB_V + (idx_ >> 4) * VP + 16 * (idx_ & 15)) = rv[set_][e]; } } while (0)
    HS_LOAD(0, 0); HS_LOAD(1, 1);
    HS_STORE(0, 0);
    HS_LOAD(2, 0);
    ATT_BAR();
#pragma unroll 1
    for (int c2 = 0; c2 < NCH; c2 += 2) {
#pragma unroll
    for (int uu = 0; uu < 2; ++uu) { const int c = c2 + uu;
        const LAS unsigned char* bb = lds + (c & 1) * SB_BYTES;
        const bool lat = (c >= 4);
        bf16x8 vf[2];
#pragma unroll
        for (int sp = 0; sp < 2; ++sp) {
            const LAS unsigned char* vb0 = bb + SB_V + (32 * sp + 4 * g + qq) * VP + (16 * wave + 4 * pp) * 2;
            vf[sp] = cat8(lds_tr(vb0), lds_tr(vb0 + 16 * VP));
        }
        if (lat) {
            bf16x8 sb[4];
#pragma unroll
            for (int ks = 0; ks < 4; ++ks) sb[ks] = pack_p(S[2 * ks], S[2 * ks + 1]);
            bf16* orow = O + (long)hg_row(dir, b, 64 * c) * WA;
#pragma unroll
            for (int I = 0; I < 4; ++I) {
                f32x4 o = (f32x4){0.f, 0.f, 0.f, 0.f};
#pragma unroll
                for (int ks = 0; ks < 4; ++ks) {
                    const LAS unsigned char* ap = bb + SB_QD + (32 * ks + 4 * g + qq) * HP + (16 * I + 4 * pp) * 2;
                    o = __builtin_amdgcn_mfma_f32_16x16x32_bf16(cat8(lds_tr(ap), lds_tr(ap + 16 * HP)), sb[ks], o, 0, 0, 0);
                }
#pragma unroll
                for (int sp = 0; sp < 2; ++sp) {
                    if (2 * sp > I) break;
                    const LAS unsigned char* pr = bb + SB_P + (16 * I + li) * PP + (32 * sp + 4 * g) * 2;
                    const u32x2 lo = *(const LAS u32x2*)pr; u32x2 hi = (u32x2){0u, 0u};
                    if (2 * sp + 1 <= I) hi = *(const LAS u32x2*)(pr + 32);
                    o = __builtin_amdgcn_mfma_f32_16x16x32_bf16(cat8u(lo, hi), vf[sp], o, 0, 0, 0);
                }
#pragma unroll
                for (int j = 0; j < 4; ++j) orow[(long)(16 * I + 4 * g + j) * ost] = (bf16)f2bf(o[j]);
            }
        }
#pragma unroll
        for (int blk = 0; blk < 8; ++blk) {
            const f32x4 d4 = *(const LAS f32x4*)(bb + SB_D + (16 * blk + 4 * g) * 4);
            f32x4 s = S[blk] * d4;
#pragma unroll
            for (int sp = 0; sp < 2; ++sp) {
                const LAS unsigned char* kp = bb + SB_KD + (16 * blk + li) * HPK + (32 * sp + 4 * g) * 2;
                s = __builtin_amdgcn_mfma_f32_16x16x32_bf16(cat8u(*(const LAS u32x2*)kp, *(const LAS u32x2*)(kp + 32)), vf[sp], s, 0, 0, 0);
            }
            S[blk] = s;
        }
        if (c + 1 < NCH) HS_STORE(c + 1, (uu + 1) & 1);
        if (c + 3 < NCH) HS_LOAD(c + 3, (uu + 1) & 1);
        ATT_BAR();
    } }
#undef HS_LOAD
#undef HS_STORE
    __syncthreads();
}

__device__ __forceinline__ void phase_readout(const Params& p, int vb, int nb) {
    const int tid = tid_of(p.wave_id), lane = tid & 63, wave = p.wave_id;
    const bf16* OF = (const bf16*)p.out; const bf16* OB = OF + (size_t)ML * WA; const bf16* GA = (const bf16*)(p.ws + WS_GA);
    bf16* YA = (bf16*)p.out + (size_t)2 * ML * WA;
    f32x4 ng[4];
#pragma unroll
    for (int i = 0; i < 4; ++i) ng[i] = *(const f32x4*)(p.hgrn_norm_g + 16 * (lane & 7) + 4 * i);
    const int NGW = nb * 8;
    for (int row0 = vb * 8 + wave; row0 < ML; row0 += 2 * NGW) {
        u32x4 a[2][2], b[2][2], gg[2][2];
#pragma unroll
        for (int u = 0; u < 2; ++u) { const int row = row0 + u * NGW; if (row < ML) { const size_t off = (size_t)row * WA + 16 * lane;
            a[u][0] = *(const u32x4*)(OF + off); a[u][1] = *(const u32x4*)(OF + off + 8); b[u][0] = *(const u32x4*)(OB + off); b[u][1] = *(const u32x4*)(OB + off + 8);
            gg[u][0] = *(const u32x4*)(GA + off); gg[u][1] = *(const u32x4*)(GA + off + 8); } }
#pragma unroll
        for (int u = 0; u < 2; ++u) { const int row = row0 + u * NGW; if (row < ML) { const size_t off = (size_t)row * WA + 16 * lane;
            float o[16]; float ss = 0.f;
#pragma unroll
            for (int q = 0; q < 8; ++q) { const unsigned wa = a[u][q >> 2][q & 3], wb = b[u][q >> 2][q & 3]; o[2 * q] = bflo(wa) + bflo(wb); o[2 * q + 1] = bfhi(wa) + bfhi(wb); ss += o[2 * q] * o[2 * q] + o[2 * q + 1] * o[2 * q + 1]; }
            ss += __shfl_xor(ss, 1); ss += __shfl_xor(ss, 2); ss += __shfl_xor(ss, 4);
            const float rstd = __builtin_amdgcn_rsqf(ss * (1.0f / HD) + EPS);
            u32x4 w[2];
#pragma unroll
            for (int q = 0; q < 8; ++q) { const unsigned wg = gg[u][q >> 2][q & 3];
                w[q >> 2][q & 3] = pk2(o[2 * q] * rstd * ng[q >> 1][(2 * q) & 3] * bflo(wg), o[2 * q + 1] * rstd * ng[q >> 1][(2 * q + 1) & 3] * bfhi(wg)); }
            *(u32x4*)(YA + off) = w[0]; *(u32x4*)(YA + off + 8) = w[1]; } }
    }
}

__device__ __forceinline__ void phase_bias2(const Params& p, int vb, int nb) {
    const int tid = tid_of(p.wave_id); const float* mod = (const float*)(p.ws + WS_MOD); float* bias2 = (float*)(p.ws + WS_BIAS2);
    constexpr int NCC = 2 * FFN / 512, NKC = D_MODEL / 64;
    for (int item = vb; item < NCC * NKC; item += nb) {
        const int cc = item % NCC, kc = item / NCC; const int col = cc * 512 + tid;
        const float* W = (col < FFN) ? p.w1 + col : p.w3 + (col - FFN);
        float a0 = 0.f, a1 = 0.f, a2 = 0.f, a3 = 0.f;
#pragma unroll 8
        for (int k = kc * 64; k < kc * 64 + 64; ++k) { const float w = W[(size_t)k * FFN];
            a0 += w * mod[0 * IN_COLS + 3 * D_MODEL + k]; a1 += w * mod[1 * IN_COLS + 3 * D_MODEL + k]; a2 += w * mod[2 * IN_COLS + 3 * D_MODEL + k]; a3 += w * mod[3 * IN_COLS + 3 * D_MODEL + k]; }
        atomicAdd(bias2 + 0 * 2 * FFN + col, a0); atomicAdd(bias2 + 1 * 2 * FFN + col, a1); atomicAdd(bias2 + 2 * 2 * FFN + col, a2); atomicAdd(bias2 + 3 * 2 * FFN + col, a3);
    }
}

constexpr int LDS_MISC_OFF = 145408;
constexpr int LDS_BYTES = 146432;
static_assert(WS_BAR + XCD_BAR_WORDS * 4 <= WS_ROWSQ, "barrier words inside ctl");

#if defined(__HIP_DEVICE_COMPILE__)
#define LOAD_P() Params p; { const __attribute__((address_space(4))) Params* q_ = (const __attribute__((address_space(4))) Params*)__builtin_amdgcn_kernarg_segment_ptr(); asm volatile("" : "+s"(q_)); \
    p = *q_; p.wave_id = wave_id; } unsigned char* ws = p.ws; (void)ws
#else
#define LOAD_P() Params p = p_in; p.wave_id = wave_id; unsigned char* ws = p.ws; (void)ws
#endif
__global__ void __launch_bounds__(NTHREADS, 2) mega_fwd(Params p_in) {
    const int wave_id = __builtin_amdgcn_readfirstlane((int)(threadIdx.x >> 6));
    extern __shared__ __attribute__((aligned(16))) unsigned char lds_raw[];
    LAS unsigned char* lds = (LAS unsigned char*)lds_raw;
    const int nb = gridDim.x;
    const int vb = (nb % 8 == 0) ? ((int)(blockIdx.x % 8) * (nb / 8) + (int)(blockIdx.x / 8)) : (int)blockIdx.x;
    const int bx = blockIdx.x;
    volatile LAS unsigned* misc = (volatile LAS unsigned*)(lds + LDS_MISC_OFF);
    if (wave_id == 0) misc[lane_id()] = 0u;
    __syncthreads();
    XcdBarrier bar = xcd_barrier_post((unsigned*)(p_in.ws + WS_BAR), misc + 8, wave_id);
#define GRID_BAR() xcd_barrier(bar)

    { LOAD_P(); phase_mod(p, lds, vb, nb); __syncthreads(); phase_wconv_in(p, lds, vb * 8 + wave_id, nb * 8); }
    GRID_BAR();
    { LOAD_P(); phase_h(p, vb, nb); }
    GRID_BAR();
    { LOAD_P(); pg8::Gemm g{(const bf16*)(ws + WS_H), (const bf16*)(ws + WS_WINT), MT, IN_COLS, D_MODEL}; InProjOrder S; S.init(ML, IN_COLS, nb, bx);
      EpiInProj E{ws, lds, p.q_norm_g, p.k_norm_g}; pg8::gemm_phase<EpiInProj, InProjOrder, true, true>(lds, g, S, E, wave_id);
      const int nfree = nb - CTX_UNITS;
      if (nfree >= 64) { if (bx >= CTX_UNITS) phase_wconv_rest(p, lds, (bx - CTX_UNITS) * 8 + wave_id, nfree * 8); }
      else phase_wconv_rest(p, lds, bx * 8 + wave_id, nb * 8); }
    GRID_BAR();
    { LOAD_P(); hgrn_prep(p, lds, vb, nb); }
    GRID_BAR();
    { LOAD_P();
      if (bx < 2 * BATCH * NHEAD) hgrn_scan(p, lds, bx);
      __syncthreads();
      phase_attn(p, lds); }
    GRID_BAR();
    { LOAD_P(); phase_readout(p, vb, nb); }
    GRID_BAR();
    { LOAD_P(); pg8::Gemm g{(const bf16*)p.out + (size_t)2 * ML * WA, (const bf16*)(ws + WS_WAT), ML, D_MODEL, WA};
      MergeOrder S; S.init(ML, D_MODEL, nb, bx); S.A1 = (const bf16*)p.out + (size_t)3 * ML * WA; S.B1 = (const bf16*)(ws + WS_WBT);
      EpiMerge E{ws, (bf16*)(ws + WS_T1)}; pg8::gemm_phase<EpiMerge, MergeOrder, true, true>(lds, g, S, E, wave_id); }
    GRID_BAR();
    { LOAD_P(); pg8::Gemm g{(const bf16*)(ws + WS_Z), (const bf16*)(ws + WS_WOT), ML, D_MODEL, D_MODEL}; pg8::StaticOrder S; S.init(ML, D_MODEL, nb, bx);
      EpiOutProj E{ws, p.x, p.norm2_g, p.out}; pg8::gemm_phase<EpiOutProj, pg8::StaticOrder, true, true>(lds, g, S, E, wave_id); }
    GRID_BAR();
    { LOAD_P(); pg8::Gemm g{(const bf16*)(ws + WS_XMG), (const bf16*)(ws + WS_W13T), ML, 2 * FFN, D_MODEL}; pg8::StaticOrder S; S.init(ML, 2 * FFN, nb, bx);
      EpiFfnUp E{ws, lds, p.conv_w, p.conv_b}; pg8::gemm_phase<EpiFfnUp, pg8::StaticOrder, true, true>(lds, g, S, E, wave_id); }
    GRID_BAR();
    { LOAD_P(); { pg8::StaticOrder S0; S0.init(ML, D_MODEL, nb, bx); pg8::Unit u0; const int tid = tid_of(wave_id); for (int i = 0; S0.next(i, u0); ++i) halo_fix(p, u0.pm, tid); }
      asm volatile("s_waitcnt vmcnt(0)" ::: "memory"); __syncthreads();
      pg8::Gemm g{(const bf16*)(ws + WS_ACT), (const bf16*)(ws + WS_W2T), ML, D_MODEL, FFN}; pg8::StaticOrder S; S.init(ML, D_MODEL, nb, bx);
      EpiFfnDown E{ws, p.out}; pg8::gemm_phase<EpiFfnDown, pg8::StaticOrder, true, true>(lds, g, S, E, wave_id); }
#undef GRID_BAR
}

extern "C" void kernel_launch(void* const* d_in, const int* in_sizes, int n_in, void* d_out, int out_size, void* d_ws, size_t ws_size, hipStream_t stream) {
    static int grid = 0;
    if (grid == 0) {
        if (n_in != 22 || ws_size < WS_END || out_size != ML * D_MODEL) { fprintf(stderr, "kernel_launch: bad inputs (n_in %d, out %d, ws %zu, need %zu)\n", n_in, out_size, ws_size, (size_t)WS_END); grid = -1; return; }
        int dev = 0, cus = 0, per_cu = 0;
        if (hipGetDevice(&dev) != hipSuccess || hipDeviceGetAttribute(&cus, hipDeviceAttributeMultiprocessorCount, dev) != hipSuccess) { grid = -1; return; }
        if (hipFuncSetAttribute((const void*)mega_fwd, hipFuncAttributeMaxDynamicSharedMemorySize, LDS_BYTES) != hipSuccess) { fprintf(stderr, "kernel_launch: hipFuncSetAttribute failed\n"); grid = -1; return; }
        if (hipOccupancyMaxActiveBlocksPerMultiprocessor(&per_cu, (const void*)mega_fwd, NTHREADS, LDS_BYTES) != hipSuccess || per_cu < 1) { fprintf(stderr, "kernel_launch: occupancy query says %d blocks/CU\n", per_cu); (void)hipGetLastError(); grid = -1; return; }
        grid = cus;
        fprintf(stderr, "kernel_launch: grid %d (cus %d, occupancy %d/CU)\n", grid, cus, per_cu);
    }
    if (grid < 0) return;
    Params p{};
    const float** f = (const float**)&p;
    for (int i = 0; i < 22; ++i) f[i] = (const float*)d_in[i];
    p.out = (float*)d_out; p.ws = (unsigned char*)d_ws;
    (void)hipMemsetAsync((char*)d_ws + WS_CTL, 0, CTL_ZERO_BYTES, stream);
    hipLaunchKernelGGL(mega_fwd, dim3(grid), dim3(NTHREADS), LDS_BYTES, stream, p);
}
```

```cpp
#include <hip/hip_runtime.h>
#include <cstdio>
#include <cstdint>
#include <cmath>

__device__ __forceinline__ int lane_id() { int l; asm volatile("v_mbcnt_lo_u32_b32 %0, -1, 0\n\tv_mbcnt_hi_u32_b32 %0, -1, %0" : "=v"(l)); return l; }
__device__ __forceinline__ int tid_of(int wave_id) { int t = wave_id * 64 + lane_id(); asm volatile("" : "+v"(t)); return t; }
namespace pg8 {
#define PG8_LAS __attribute__((address_space(3)))
typedef unsigned short bf16_t;
typedef short bf16x8 __attribute__((ext_vector_type(8)));
typedef float f32x4 __attribute__((ext_vector_type(4)));
typedef unsigned u32x4 __attribute__((ext_vector_type(4)));
constexpr int BM = 256, BK = 64, HALF = 128, HTB = HALF * BK * 2  , STAGE_BYTES = 8 * HTB, NXCD = 8, WGM = 8;

__host__ __device__ __forceinline__ int lds_byte(int r, int c) { const int st = (r >> 4) * 2 + (c >> 5), rr = r & 15, cc = c & 31, ob = rr * 64 + cc * 2; return st * 1024 + (ob ^ (((ob >> 9) & 1) << 5)); }
__host__ __device__ __forceinline__ void stage_rc(int b, int& R, int& C) { const int st = b / 1024, sb = b % 1024, swz = sb ^ (((sb >> 9) & 1) << 5); R = (st >> 1) * 16 + swz / 64; C = (st & 1) * 32 + (swz % 64) / 2; }
__host__ __device__ __forceinline__ int perm32(int rho) { const int n = rho >> 4, i = rho & 15; return 8 * (i >> 2) + 4 * n + (i & 3); }

struct Unit { int pm, pn, br; };
struct Gemm { const bf16_t* A; const bf16_t* Bt; int M, N, K; };

struct StaticOrder {
    int nM, nN, nwg, G, c; int maxL = 0x7fffffff;
    __host__ __device__ void init(int M, int N, int G_, int c_) { nM = M / BM; nN = N / BM; nwg = nM * nN; G = G_; c = c_; }
    __host__ __device__ bool next(int i, Unit& u) const { const long L = (long)i * G + c; if (L >= maxL) return false; return unit_of(L, u); }
    __host__ __device__ bool unit_of(long L, Unit& u) const {
        if (L >= nwg) return false;
        int wgid = (int)L; { const int q = nwg / NXCD, r = nwg % NXCD, xcd = wgid % NXCD, off = wgid / NXCD; wgid = (xcd < r ? xcd * (q + 1) : r * (q + 1) + (xcd - r) * q) + off; }
        const int nig = WGM * nN, gid = wgid / nig, fm = gid * WGM, gsz = (nM - fm) < WGM ? (nM - fm) : WGM;
        u.pm = fm + ((wgid % nig) % gsz); u.pn = (wgid % nig) / gsz; u.br = 0; return true;
    }
    __device__ __forceinline__ const char* a_base(const Gemm& g, const Unit& u, size_t tstep) const { return (const char*)g.A + (size_t)u.pm * tstep; }
    __device__ __forceinline__ const char* b_base(const Gemm& g, const Unit& u, size_t tstep) const { return (const char*)g.Bt + (size_t)u.pn * tstep; }
    __device__ __forceinline__ void a_ready(const Unit&) const {}
    __device__ __forceinline__ void done(const Unit&) const {}
};

template <class Epi, class Sched, bool ALIGN_EPI = false, bool SP2 = false>
__device__ __forceinline__ void gemm_phase(PG8_LAS unsigned char* lds, const Gemm g, const Sched& S, const Epi& E, const int wave_id_in) {
    int tid_o = tid_of(wave_id_in);
    const int tid = tid_o, wid = __builtin_amdgcn_readfirstlane(tid >> 6), lane = tid & 63, wr = wid >> 2, wc = wid & 3, fr = lane & 15, fq = lane >> 4;
    const int K = g.K, nt = K / BK;
    unsigned voffA[2], voffB[2];
#pragma unroll
    for (int i = 0; i < 2; ++i) { int R, C; stage_rc(tid * 16 + i * 8192, R, C); const int Rb = Epi::PERM ? ((R & ~31) + perm32(R & 31)) : R;
        voffA[i] = (unsigned)(R * K + C) * 2u; voffB[i] = (unsigned)(Rb * K + C) * 2u; }
    const size_t kstep = (size_t)(BK * 2);
    const size_t hstep = (size_t)HALF * K * 2;
    const size_t tstep = 2 * hstep;
    const unsigned ldsw = (unsigned)wid * 1024u;
    const int aoff = lds_byte(wr * 64 + fr, fq * 8), boff = lds_byte(wc * 32 + fr, fq * 8);
#define PG8_SA(b, h) (((b) * 2 + (h)) * HTB)
#define PG8_SB(b, h) ((4 + (b) * 2 + (h)) * HTB)
#define PG8_STAGE(bufoff, gbase, voff) do { _Pragma("unroll") for (int _i = 0; _i < 2; ++_i) \
        __builtin_amdgcn_global_load_lds((const unsigned*)((const char*)(gbase) + (voff)[_i]), (PG8_LAS unsigned*)(lds + (bufoff) + ldsw + _i * 8192), 16, 0, 0); } while (0)
#define PG8_LDA(dst, b, h) do { _Pragma("unroll") for (int m = 0; m < 4; ++m) _Pragma("unroll") for (int k = 0; k < 2; ++k) dst[m][k] = *(const PG8_LAS bf16x8*)(lds + PG8_SA(b, h) + aoff + m * 2048 + k * 1024); } while (0)
#define PG8_LDB(dst, b, h) do { _Pragma("unroll") for (int n = 0; n < 2; ++n) _Pragma("unroll") for (int k = 0; k < 2; ++k) dst[n][k] = *(const PG8_LAS bf16x8*)(lds + PG8_SB(b, h) + boff + n * 2048 + k * 1024); } while (0)
#define PG8_MMA(ai, bj, At, Bt) do { _Pragma("unroll") for (int m = 0; m < 4; ++m) _Pragma("unroll") for (int n = 0; n < 2; ++n) _Pragma("unroll") for (int k = 0; k < 2; ++k) \
        acc[ai][bj][m][n] = __builtin_amdgcn_mfma_f32_16x16x32_bf16(Bt[n][k], At[m][k], acc[ai][bj][m][n], 0, 0, 0); } while (0)
#define PG8_WAIT_V(n) asm volatile("s_waitcnt vmcnt(" #n ")" ::: "memory")
#define PG8_WAIT_L(n) asm volatile("s_waitcnt lgkmcnt(" #n ")" ::: "memory")
#define PG8_BAR __builtin_amdgcn_s_barrier()
#define PG8_SCHED __builtin_amdgcn_sched_barrier(0)
    Unit cur, nxt; int ui = 0;
    if (!S.next(0, cur)) return;
    f32x4 acc[2][2][4][2];
#pragma unroll
    for (int a = 0; a < 2; ++a)
#pragma unroll
        for (int b = 0; b < 2; ++b)
#pragma unroll
            for (int m = 0; m < 4; ++m)
#pragma unroll
                for (int n = 0; n < 2; ++n) acc[a][b][m][n] = (f32x4){0.f, 0.f, 0.f, 0.f};
    bf16x8 At[4][2], B0[2][2], B1[2][2];
    const char* cA = S.a_base(g, cur, tstep); const char* cB = S.b_base(g, cur, tstep);
    S.a_ready(cur);
    if constexpr (Epi::PREF) E.prefetch(cur, wid);
    if constexpr (SP2) {
        PG8_STAGE(PG8_SB(0, 0), cB, voffB); PG8_STAGE(PG8_SB(0, 1), cB + hstep, voffB); PG8_STAGE(PG8_SA(0, 0), cA, voffA); PG8_STAGE(PG8_SA(0, 1), cA + hstep, voffA);
        if (wr == 1) PG8_BAR;
        PG8_WAIT_V(2); PG8_BAR;
        PG8_STAGE(PG8_SB(1, 0), cB + kstep, voffB); PG8_STAGE(PG8_SA(1, 0), cA + kstep, voffA); PG8_STAGE(PG8_SB(1, 1), cB + hstep + kstep, voffB);
        PG8_WAIT_V(6); PG8_BAR;
    } else {
        PG8_STAGE(PG8_SB(0, 0), cB, voffB); PG8_STAGE(PG8_SA(0, 0), cA, voffA); PG8_STAGE(PG8_SB(0, 1), cB + hstep, voffB); PG8_STAGE(PG8_SA(0, 1), cA + hstep, voffA);
        if (wr == 1) PG8_BAR;
        PG8_WAIT_V(4); PG8_BAR;
        PG8_STAGE(PG8_SB(1, 0), cB + kstep, voffB); PG8_STAGE(PG8_SA(1, 0), cA + kstep, voffA); PG8_STAGE(PG8_SB(1, 1), cB + hstep + kstep, voffB);
        PG8_WAIT_V(6); PG8_BAR;
    }
    for (;;) {
        const bool has_next = S.next(ui + 1, nxt);
        const char* nA = has_next ? S.a_base(g, nxt, tstep) : cA; const char* nB = has_next ? S.b_base(g, nxt, tstep) : cB;
        for (int t = 0; t < nt; t += 2) {
            const bool last = (t == nt - 2);
            const char* a1 = cA + (size_t)(t + 1) * kstep;
            const char* a2 = last ? nA : cA + (size_t)(t + 2) * kstep; const char* b2 = last ? nB : cB + (size_t)(t + 2) * kstep;
            const char* a3 = a2 + kstep; const char* b3 = b2 + kstep;
            if (last && has_next) S.a_ready(nxt);
            if constexpr (SP2) {
            PG8_LDB(B0, 0, 0); PG8_LDB(B1, 0, 1); PG8_SCHED; PG8_LDA(At, 0, 0); PG8_STAGE(PG8_SA(1, 1), a1 + hstep, voffA);
            PG8_WAIT_V(8); PG8_WAIT_L(0); PG8_BAR; __builtin_amdgcn_s_setprio(1); PG8_MMA(0, 0, At, B0); PG8_MMA(0, 1, At, B1); __builtin_amdgcn_s_setprio(0); PG8_BAR; PG8_SCHED;
            PG8_LDA(At, 0, 1); PG8_STAGE(PG8_SB(0, 0), b2, voffB); PG8_STAGE(PG8_SB(0, 1), b2 + hstep, voffB); PG8_STAGE(PG8_SA(0, 0), a2, voffA);
            PG8_WAIT_V(8); PG8_WAIT_L(0); PG8_BAR; __builtin_amdgcn_s_setprio(1); PG8_MMA(1, 0, At, B0); PG8_MMA(1, 1, At, B1); __builtin_amdgcn_s_setprio(0); PG8_BAR; PG8_SCHED;
            PG8_LDB(B0, 1, 0); PG8_LDB(B1, 1, 1); PG8_SCHED; PG8_LDA(At, 1, 0); PG8_STAGE(PG8_SA(0, 1), a2 + hstep, voffA);
            PG8_WAIT_V(8); PG8_WAIT_L(0); PG8_BAR; __builtin_amdgcn_s_setprio(1); PG8_MMA(0, 0, At, B0); PG8_MMA(0, 1, At, B1); __builtin_amdgcn_s_setprio(0); PG8_BAR; PG8_SCHED;
            PG8_LDA(At, 1, 1); PG8_STAGE(PG8_SB(1, 0), b3, voffB); PG8_STAGE(PG8_SB(1, 1), b3 + hstep, voffB); PG8_STAGE(PG8_SA(1, 0), a3, voffA);
            PG8_WAIT_V(8); PG8_WAIT_L(0); PG8_BAR; __builtin_amdgcn_s_setprio(1); PG8_MMA(1, 0, At, B0); PG8_MMA(1, 1, At, B1); __builtin_amdgcn_s_setprio(0); PG8_BAR; PG8_SCHED;
            } else {
            PG8_LDB(B0, 0, 0); PG8_SCHED; PG8_LDA(At, 0, 0); PG8_STAGE(PG8_SA(1, 1), a1 + hstep, voffA);
            PG8_WAIT_L(8); PG8_BAR; PG8_WAIT_L(0); PG8_MMA(0, 0, At, B0); PG8_BAR; PG8_SCHED;
            PG8_LDB(B1, 0, 1); PG8_STAGE(PG8_SB(0, 0), b2, voffB);
            PG8_BAR; PG8_WAIT_L(0); PG8_MMA(0, 1, At, B1); PG8_BAR;
            PG8_LDA(At, 0, 1); PG8_STAGE(PG8_SA(0, 0), a2, voffA);
            PG8_BAR; PG8_WAIT_L(0); PG8_MMA(1, 0, At, B0); PG8_BAR; PG8_SCHED;
            PG8_STAGE(PG8_SB(0, 1), b2 + hstep, voffB);
            PG8_WAIT_V(6); PG8_BAR; PG8_MMA(1, 1, At, B1); PG8_BAR;
            PG8_LDB(B0, 1, 0); PG8_SCHED; PG8_LDA(At, 1, 0); PG8_STAGE(PG8_SA(0, 1), a2 + hstep, voffA);
            PG8_WAIT_L(8); PG8_BAR; PG8_WAIT_L(0); PG8_MMA(0, 0, At, B0); PG8_BAR; PG8_SCHED;
            PG8_LDB(B1, 1, 1); PG8_STAGE(PG8_SB(1, 0), b3, voffB);
            PG8_BAR; PG8_WAIT_L(0); PG8_MMA(0, 1, At, B1); PG8_BAR;
            PG8_LDA(At, 1, 1); PG8_STAGE(PG8_SA(1, 0), a3, voffA);
            PG8_BAR; PG8_WAIT_L(0); PG8_MMA(1, 0, At, B0); PG8_BAR; PG8_SCHED;
            PG8_STAGE(PG8_SB(1, 1), b3 + hstep, voffB);
            PG8_WAIT_V(6); PG8_BAR; PG8_MMA(1, 1, At, B1); PG8_BAR;
            }
        }
        if constexpr (ALIGN_EPI) { if (wr == 0) PG8_BAR; }
        if constexpr (!Epi::AFTER_DRAIN) { E(acc, cur, wr, wc, fr, fq); if constexpr (Epi::PREF) { if (has_next) E.prefetch(nxt, wid); } S.done(cur); }
        if (!has_next) break;
        if constexpr (Epi::CARRY) {
            const float keep = (cur.br == 0) ? 1.0f : 0.0f;
#pragma unroll
            for (int a = 0; a < 2; ++a)
#pragma unroll
                for (int b = 0; b < 2; ++b)
#pragma unroll
                    for (int m = 0; m < 4; ++m)
#pragma unroll
                        for (int n = 0; n < 2; ++n) acc[a][b][m][n] = acc[a][b][m][n] * keep;
        } else {
#pragma unroll
        for (int a = 0; a < 2; ++a)
#pragma unroll
            for (int b = 0; b < 2; ++b)
#pragma unroll
                for (int m = 0; m < 4; ++m)
#pragma unroll
                    for (int n = 0; n < 2; ++n) acc[a][b][m][n] = (f32x4){0.f, 0.f, 0.f, 0.f};
        }
        cur = nxt; cA = nA; cB = nB; ++ui;
        if constexpr (ALIGN_EPI) { if (wr == 1) PG8_BAR; }
    }
    PG8_WAIT_V(0);
    if constexpr (!ALIGN_EPI) { if (wr == 0) PG8_BAR; }
    PG8_BAR;
    if constexpr (Epi::AFTER_DRAIN) { E.fused(acc, cur, wr, wc, fr, fq, lds, wid, lane); S.done(cur); }
}
template <class Epi>
__device__ __forceinline__ void gemm_half_phase(PG8_LAS unsigned char* lds, const Gemm g, const Unit cur, const Epi& E, const int wave_id_in) {
    int tid_o = tid_of(wave_id_in);
    const int tid = tid_o, wid = __builtin_amdgcn_readfirstlane(tid >> 6), lane = tid & 63, wr = wid >> 2, wc = wid & 3, fr = lane & 15, fq = lane >> 4;
    const int K = g.K, nt = K / BK;
    unsigned voffA[2], voffB[2];
#pragma unroll
    for (int i = 0; i < 2; ++i) { int R, C; stage_rc(tid * 16 + i * 8192, R, C); const int Rb = Epi::PERM ? ((R & ~31) + perm32(R & 31)) : R;
        voffA[i] = (unsigned)(R * K + C) * 2u; voffB[i] = (unsigned)(Rb * K + C) * 2u; }
    const size_t kstep = (size_t)(BK * 2), hstep = (size_t)HALF * K * 2, tstep = 2 * hstep;
    const unsigned ldsw = (unsigned)wid * 1024u;
    const int aoff = lds_byte(wr * 64 + fr, fq * 8), boff = lds_byte(wc * 32 + fr, fq * 8);
    f32x4 acc[2][2][4][2];
#pragma unroll
    for (int a = 0; a < 2; ++a)
#pragma unroll
        for (int b = 0; b < 2; ++b)
#pragma unroll
            for (int m = 0; m < 4; ++m)
#pragma unroll
                for (int n = 0; n < 2; ++n) acc[a][b][m][n] = (f32x4){0.f, 0.f, 0.f, 0.f};
    bf16x8 At[4][2], B0[2][2], B1[2][2];
    const char* cA = (const char*)g.A + (size_t)cur.pm * tstep + (size_t)cur.br * hstep; const char* cB = (const char*)g.Bt + (size_t)cur.pn * tstep;
    if constexpr (Epi::PREF) E.prefetch(cur, wid);
    PG8_STAGE(PG8_SB(0, 0), cB, voffB); PG8_STAGE(PG8_SB(0, 1), cB + hstep, voffB); PG8_STAGE(PG8_SA(0, 0), cA, voffA);
    if (wr == 1) PG8_BAR;
    PG8_WAIT_V(0); PG8_BAR;
    PG8_STAGE(PG8_SB(1, 0), cB + kstep, voffB); PG8_STAGE(PG8_SA(1, 0), cA + kstep, voffA); PG8_STAGE(PG8_SB(1, 1), cB + hstep + kstep, voffB);
    PG8_WAIT_V(6); PG8_BAR;
    for (int t = 0; t < nt; t += 2) {
        const bool last = (t == nt - 2);
        const char* a2 = last ? cA : cA + (size_t)(t + 2) * kstep; const char* b2 = last ? cB : cB + (size_t)(t + 2) * kstep;
        const char* a3 = a2 + kstep; const char* b3 = b2 + kstep;
        PG8_LDB(B0, 0, 0); PG8_LDB(B1, 0, 1); PG8_SCHED; PG8_LDA(At, 0, 0);
        PG8_WAIT_V(6); PG8_WAIT_L(0); PG8_BAR; __builtin_amdgcn_s_setprio(1); PG8_MMA(0, 0, At, B0); __builtin_amdgcn_s_setprio(0); PG8_BAR; PG8_SCHED;
        PG8_STAGE(PG8_SB(0, 0), b2, voffB); PG8_STAGE(PG8_SB(0, 1), b2 + hstep, voffB); PG8_STAGE(PG8_SA(0, 0), a2, voffA);
        PG8_WAIT_V(6); PG8_BAR; __builtin_amdgcn_s_setprio(1); PG8_MMA(0, 1, At, B1); __builtin_amdgcn_s_setprio(0); PG8_BAR; PG8_SCHED;
        PG8_LDB(B0, 1, 0); PG8_LDB(B1, 1, 1); PG8_SCHED; PG8_LDA(At, 1, 0);
        PG8_WAIT_V(6); PG8_WAIT_L(0); PG8_BAR; __builtin_amdgcn_s_setprio(1); PG8_MMA(0, 0, At, B0); __builtin_amdgcn_s_setprio(0); PG8_BAR; PG8_SCHED;
        PG8_STAGE(PG8_SB(1, 0), b3, voffB); PG8_STAGE(PG8_SB(1, 1), b3 + hstep, voffB); PG8_STAGE(PG8_SA(1, 0), a3, voffA);
        PG8_WAIT_V(6); PG8_BAR; __builtin_amdgcn_s_setprio(1); PG8_MMA(0, 1, At, B1); __builtin_amdgcn_s_setprio(0); PG8_BAR; PG8_SCHED;
    }
    if (wr == 0) PG8_BAR;
    E(acc, cur, wr, wc, fr, fq);
    PG8_WAIT_V(0);
    PG8_BAR;
#undef PG8_SA
#undef PG8_SB
#undef PG8_STAGE
#undef PG8_LDA
#undef PG8_LDB
#undef PG8_MMA
#undef PG8_WAIT_V
#undef PG8_WAIT_L
#undef PG8_BAR
#undef PG8_SCHED
}
}

constexpr int D_MODEL = 2048, BATCH = 4, SEQ = 2048, CTX = 256, GRID_W = 64, NHEAD = 8, HD = 128, WA = 1024;
constexpr int FFN = 5632, IN_COLS = 12288, NMOD = 6;
constexpr int ML = BATCH * SEQ;
constexpr int MC = BATCH * CTX;
constexpr int MT = ML + MC;
constexpr float EPS = 1e-6f;
constexpr int NTHREADS = 512;
constexpr int VT_PITCH = SEQ + CTX;

typedef unsigned short bf16;
typedef float f32x4 __attribute__((ext_vector_type(4)));
typedef unsigned u32x2 __attribute__((ext_vector_type(2)));
typedef unsigned u32x4 __attribute__((ext_vector_type(4)));
#define LAS __attribute__((address_space(3)))

typedef float f32x2_t __attribute__((ext_vector_type(2)));
typedef __bf16 bf16x2_t __attribute__((ext_vector_type(2)));
__device__ __forceinline__ unsigned pk2(float lo, float hi) { const f32x2_t v = {lo, hi}; const bf16x2_t b = __builtin_convertvector(v, bf16x2_t); return __builtin_bit_cast(unsigned, b); }
__device__ __forceinline__ unsigned f2bf(float f) { return pk2(f, 0.f) & 0xffffu; }
__device__ __forceinline__ float bf2f(unsigned short h) { return __builtin_bit_cast(float, (unsigned)h << 16); }
__device__ __forceinline__ float bflo(unsigned w) { return __builtin_bit_cast(float, w << 16); }
__device__ __forceinline__ float bfhi(unsigned w) { return __builtin_bit_cast(float, w & 0xffff0000u); }
__device__ __forceinline__ float sigmoidf_(float x) { return __builtin_amdgcn_rcpf(1.0f + __expf(-x)); }
__device__ __forceinline__ float siluf_(float x) { return x * __builtin_amdgcn_rcpf(1.0f + __expf(-x)); }
__device__ __forceinline__ float einvf_(float x) { return fminf(1.0f + __expf(-x), 1e30f); }
__device__ __forceinline__ float rows_max(float v) {
    { const unsigned u = __builtin_bit_cast(unsigned, v); const auto r = __builtin_amdgcn_permlane32_swap(u, u, false, false); v = fmaxf(__builtin_bit_cast(float, (unsigned)r[0]), __builtin_bit_cast(float, (unsigned)r[1])); }
    { const unsigned u = __builtin_bit_cast(unsigned, v); const auto r = __builtin_amdgcn_permlane16_swap(u, u, false, false); v = fmaxf(__builtin_bit_cast(float, (unsigned)r[0]), __builtin_bit_cast(float, (unsigned)r[1])); }
    return v; }
__device__ __forceinline__ float rows_sum(float v) {
    { const unsigned u = __builtin_bit_cast(unsigned, v); const auto r = __builtin_amdgcn_permlane32_swap(u, u, false, false); v = __builtin_bit_cast(float, (unsigned)r[0]) + __builtin_bit_cast(float, (unsigned)r[1]); }
    { const unsigned u = __builtin_bit_cast(unsigned, v); const auto r = __builtin_amdgcn_permlane16_swap(u, u, false, false); v = __builtin_bit_cast(float, (unsigned)r[0]) + __builtin_bit_cast(float, (unsigned)r[1]); }
    return v; }
template <int CTRL> __device__ __forceinline__ float dppf(float v) { return __builtin_bit_cast(float, __builtin_amdgcn_update_dpp(0, __builtin_bit_cast(int, v), CTRL, 0xf, 0xf, false)); }
__device__ __forceinline__ float oct_sum(float v) { v += dppf<0xB1>(v); v += dppf<0x4E>(v); v += dppf<0x141>(v); return v; }
__device__ __forceinline__ float wave_sum(float v) { v = oct_sum(v); v += dppf<0x140>(v); return rows_sum(v); }
__device__ __forceinline__ float wave_max(float v) {
    v = fmaxf(v, dppf<0xB1>(v)); v = fmaxf(v, dppf<0x4E>(v)); v = fmaxf(v, dppf<0x141>(v)); v = fmaxf(v, dppf<0x140>(v)); return rows_max(v);
}
__device__ __forceinline__ float half_swap_sum(float v) {
    const unsigned u = __builtin_bit_cast(unsigned, v); const auto r = __builtin_amdgcn_permlane32_swap(u, u, false, false); return __builtin_bit_cast(float, (unsigned)r[0]) + __builtin_bit_cast(float, (unsigned)r[1]); }

constexpr size_t al256(size_t x) { return (x + 255) & ~(size_t)255; }
constexpr size_t WS_CTL   = 0;
constexpr size_t CTL_ZERO_BYTES = 1u << 20;
constexpr size_t WS_MODCTR = 40448;
constexpr size_t WS_ROWSQ = 64 * 1024;
constexpr size_t WS_BIAS2 = WS_ROWSQ + (size_t)ML * 4;
static_assert(WS_BIAS2 + (size_t)4 * 2 * FFN * 4 <= CTL_ZERO_BYTES, "ctl");
constexpr size_t WS_MOD   = CTL_ZERO_BYTES;
constexpr size_t WS_LB    = al256(WS_MOD + (size_t)5 * IN_COLS * 4);
constexpr size_t WS_ROPE  = al256(WS_LB + 2 * WA * 4);
constexpr size_t WS_SMALL_END = al256(WS_ROPE + 2 * 64 * 32 * 4);
constexpr size_t WS_W13T  = al256(WS_SMALL_END);
constexpr size_t WS_W2T   = WS_W13T + (size_t)2 * FFN * D_MODEL * 2;
constexpr size_t WS_WAT   = WS_W2T + (size_t)D_MODEL * FFN * 2;
constexpr size_t WS_WBT   = WS_WAT + (size_t)D_MODEL * WA * 2;
constexpr size_t WS_WOT   = WS_WBT + (size_t)D_MODEL * WA * 2;
constexpr size_t WS_A_END = WS_WOT + (size_t)D_MODEL * D_MODEL * 2;
constexpr size_t SEGB = (size_t)MT * WA * 2;
constexpr size_t WS_QA  = WS_A_END;
constexpr size_t WS_FW  = WS_QA + SEGB;
constexpr size_t WS_FB  = WS_FW + 2 * SEGB;
constexpr size_t WS_IA  = WS_FB + 2 * SEGB;
constexpr size_t WS_GA  = WS_IA + SEGB;
constexpr size_t WS_QN  = WS_GA + (size_t)ML * WA * 2;
constexpr size_t WS_KN  = WS_QN + (size_t)ML * WA * 2;
constexpr size_t WS_VN  = WS_KN + SEGB;
constexpr size_t WS_GTA = WS_VN + SEGB;
constexpr size_t WS_GTB = WS_GTA + (size_t)ML * D_MODEL * 2;
constexpr size_t WS_D_END = WS_GTB + (size_t)ML * D_MODEL * 2;
constexpr size_t WS_WINT = WS_D_END;
constexpr size_t WS_OF   = WS_WINT;
constexpr size_t WS_OB   = WS_OF + (size_t)ML * WA * 2;
constexpr size_t WS_B_END = WS_WINT + (size_t)IN_COLS * D_MODEL * 2;
static_assert(WS_OB + (size_t)ML * WA * 2 <= WS_B_END, "B");
constexpr size_t WS_H   = WS_B_END;
constexpr size_t WS_YA  = WS_H;
constexpr size_t WS_YB  = WS_YA + (size_t)ML * WA * 2;
constexpr size_t WS_C_END = WS_H + (size_t)MT * D_MODEL * 2;
constexpr size_t WS_ACT_END = WS_D_END + (size_t)ML * FFN * 2;
constexpr size_t WS_HIMG = WS_WINT;
constexpr size_t WS_HIMG_END = WS_HIMG + (size_t)64 * 36 * 41472;
constexpr size_t WS_T1 = WS_WINT;
constexpr size_t WS_END0 = WS_C_END > WS_ACT_END ? WS_C_END : WS_ACT_END;
constexpr size_t WS_END = WS_END0 > WS_HIMG_END ? WS_END0 : WS_HIMG_END;
static_assert(WS_END <= 445000000, "ws budget");
constexpr size_t WS_Z   = WS_QA;
constexpr size_t WS_OF2 = WS_FW;
constexpr size_t WS_OB2 = WS_FB;
constexpr size_t WS_YB2 = WS_FB + (size_t)18 * 1024 * 1024;
constexpr size_t WS_YA2 = WS_IA;
static_assert(WS_YB2 + (size_t)ML * WA * 2 <= WS_IA, "YB overlay");
constexpr size_t WS_XM16 = WS_GTA;
constexpr size_t WS_XMG = WS_GTB;
constexpr size_t WS_HALO = WS_QA;
static_assert(WS_HALO + (size_t)32 * 6 * FFN * 4 <= WS_XMG, "HALO overlay");
constexpr size_t WS_SPLIT = 40960;
static_assert(WS_SPLIT + 32 * 44 * 4 <= WS_ROWSQ && WS_SPLIT >= 32768 + 8192, "split flags inside ctl (above the attention counters at 32768)");
constexpr size_t WS_HALO2 = WS_HALO + (size_t)8 * 1024 * 1024;
static_assert(WS_HALO2 + (size_t)32 * 6 * FFN * 4 <= WS_XM16, "HALO2 overlay");
constexpr size_t WS_ACT = WS_WINT;
static_assert(WS_ACT + (size_t)ML * FFN * 2 <= WS_END, "ACT overlay");

struct Params {
    const float *x, *c, *ctx, *c_ctx, *ada_w, *ada_b, *norm1_g, *norm2_g, *w_in, *lb_logits, *hgrn_norm_g, *q_norm_g, *k_norm_g, *rel_bias,
                *w_a, *w_b, *w_o, *w1, *w3, *conv_w, *conv_b, *w2;
    float* out;
    unsigned char* ws;
    int wave_id, pad;
};

template <bool QKPERM, bool BIAS>
__device__ __forceinline__ void transpose_item(const float* W, int K, int N, bf16* WT, int row_off, LAS float* scr, int item, int lane, const float* sh2 = nullptr, float* bias2 = nullptr) {
    const int nblk = N / 32, kb = item / nblk, nb = item % nblk, k0 = 64 * kb, n0 = 32 * nb;
    if (BIAS) row_off += (n0 >> 7) * 128;
    float wv[32];
#pragma unroll
    for (int i = 0; i < 32; ++i) wv[i] = __builtin_nontemporal_load(W + (size_t)(k0 + 2 * i + (lane >> 5)) * N + n0 + (lane & 31));
#pragma unroll
    for (int i = 0; i < 32; ++i) scr[(2 * i + (lane >> 5)) * 33 + (lane & 31)] = wv[i];
    if (BIAS) {
        float a0 = 0.f, a1 = 0.f, a2 = 0.f, a3 = 0.f;
#pragma unroll
        for (int i = 0; i < 32; ++i) { const int k = k0 + 2 * i + (lane >> 5); const float w = wv[i];
            a0 += w * sh2[0 * IN_COLS + k]; a1 += w * sh2[1 * IN_COLS + k]; a2 += w * sh2[2 * IN_COLS + k]; a3 += w * sh2[3 * IN_COLS + k]; }
        a0 = half_swap_sum(a0); a1 = half_swap_sum(a1); a2 = half_swap_sum(a2); a3 = half_swap_sum(a3);
        if (lane < 32) { float* bp = bias2 + row_off + n0 + lane; atomicAdd(bp, a0); atomicAdd(bp + 2 * FFN, a1); atomicAdd(bp + 4 * FFN, a2); atomicAdd(bp + 6 * FFN, a3); }
    }
    asm volatile("s_waitcnt lgkmcnt(0)" ::: "memory");
    const int c = lane & 7;
#pragma unroll
    for (int j = 0; j < 4; ++j) { const int n = (lane >> 3) + 8 * j; const LAS float* s = scr + (8 * c) * 33 + n;
        u32x4 o; o.x = pk2(s[0 * 33], s[1 * 33]); o.y = pk2(s[2 * 33], s[3 * 33]); o.z = pk2(s[4 * 33], s[5 * 33]); o.w = pk2(s[6 * 33], s[7 * 33]);
        int cdst = n0 + n;
        if (QKPERM && cdst >= 5 * WA && cdst < 7 * WA) cdst = (cdst & ~0x30) | ((cdst & 0x10) << 1) | ((cdst & 0x20) >> 1);
        *(u32x4*)(WT + (size_t)(row_off + cdst) * K + k0 + 8 * c) = o; }
    asm volatile("s_waitcnt lgkmcnt(0)" ::: "memory");
}
__device__ __forceinline__ void phase_wconv_in(const Params& p, LAS unsigned char* lds, int gw, int NGW) {
    const int lane = lane_id(), wave = p.wave_id;
    LAS float* scr = (LAS float*)(lds + wave * 16384);
    constexpr int I_IN = (D_MODEL / 64) * (IN_COLS / 32);
    for (int it = gw; it < I_IN; it += NGW) transpose_item<true, false>(p.w_in, D_MODEL, IN_COLS, (bf16*)(p.ws + WS_WINT), 0, scr, it, lane);
}
__device__ __forceinline__ void phase_wconv_rest(const Params& p, LAS unsigned char* lds, int gw, int NGW) {
    const int lane = lane_id(), wave = p.wave_id;
    LAS float* scr = (LAS float*)(lds + 16384 + wave * 16384);
    constexpr int I_A = (WA / 64) * (D_MODEL / 32), I_O = (D_MODEL / 64) * (D_MODEL / 32), I_1 = (D_MODEL / 64) * (FFN / 32), I_2 = (FFN / 64) * (D_MODEL / 32);
    constexpr int NITEMS = 2 * I_A + I_O + 2 * I_1 + I_2;
    unsigned char* ws = p.ws;
    const float* sh2 = (const float*)(ws + WS_MOD) + 3 * D_MODEL; float* b2 = (float*)(ws + WS_BIAS2);
    for (int it = gw; it < NITEMS; it += NGW) {
        int r = it;
        if (r < I_A) { transpose_item<false, false>(p.w_a, WA, D_MODEL, (bf16*)(ws + WS_WAT), 0, scr, r, lane); continue; } r -= I_A;
        if (r < I_A) { transpose_item<false, false>(p.w_b, WA, D_MODEL, (bf16*)(ws + WS_WBT), 0, scr, r, lane); continue; } r -= I_A;
        if (r < I_O) { transpose_item<false, false>(p.w_o, D_MODEL, D_MODEL, (bf16*)(ws + WS_WOT), 0, scr, r, lane); continue; } r -= I_O;
        if (r < I_1) { transpose_item<false, true>(p.w1, D_MODEL, FFN, (bf16*)(ws + WS_W13T), 0, scr, r, lane, sh2, b2); continue; } r -= I_1;
        if (r < I_1) { transpose_item<false, true>(p.w3, D_MODEL, FFN, (bf16*)(ws + WS_W13T), 128, scr, r, lane, sh2, b2); continue; } r -= I_1;
        transpose_item<false, false>(p.w2, FFN, D_MODEL, (bf16*)(ws + WS_W2T), 0, scr, r, lane);
    }
}

__device__ __forceinline__ void phase_mod(const Params& p, LAS unsigned char* lds, int vb, int nb) {
    const int tid = tid_of(p.wave_id);
    LAS float* sc = (LAS float*)lds;
    LAS float* red = (LAS float*)(lds + 5 * 2048 * 4);
    {
        static_assert(D_MODEL == 4 * NTHREADS, "one f32x4 per thread and row");
        f32x4 cv[5];
#pragma unroll
        for (int j = 0; j < 5; ++j) cv[j] = *(const f32x4*)((j < 4 ? p.c + j * D_MODEL : p.c_ctx) + 4 * tid);
#pragma unroll
        for (int j = 0; j < 5; ++j) { f32x4 o; o.x = siluf_(cv[j].x); o.y = siluf_(cv[j].y); o.z = siluf_(cv[j].z); o.w = siluf_(cv[j].w); *(LAS f32x4*)(sc + j * D_MODEL + 4 * tid) = o; } }
    __syncthreads();
    float* mod = (float*)(p.ws + WS_MOD);
    const int c4 = tid & 15, kp = tid >> 4;
    for (int item = vb; item < IN_COLS / 64; item += nb) {
        const int n0 = item * 64 + c4 * 4;
        f32x4 acc[5];
#pragma unroll
        for (int r = 0; r < 5; ++r) acc[r] = (f32x4){0.f, 0.f, 0.f, 0.f};
#pragma unroll 8
        for (int k = kp; k < D_MODEL; k += 32) {
            const f32x4 w = __builtin_nontemporal_load((const f32x4*)(p.ada_w + (size_t)k * IN_COLS + n0));
#pragma unroll
            for (int r = 0; r < 5; ++r) acc[r] += w * sc[r * D_MODEL + k];
        }
#pragma unroll
        for (int r = 0; r < 5; ++r) *(LAS f32x4*)(red + (kp * 5 + r) * 64 + c4 * 4) = acc[r];
        __syncthreads();
        if (tid < 320) { const int r = tid / 64, cidx = tid % 64; float s = 0.f;
            for (int q = 0; q < 32; ++q) s += red[(q * 5 + r) * 64 + cidx];
            const int gc = item * 64 + cidx; float v = s + p.ada_b[gc];
            if (gc >= 4 * D_MODEL && gc < 5 * D_MODEL) v = p.norm2_g[gc - 4 * D_MODEL] * (1.0f + v);
            __hip_atomic_store(&mod[r * IN_COLS + gc], v, __ATOMIC_RELAXED, __HIP_MEMORY_SCOPE_AGENT); }
        __syncthreads();
    }
    if (vb < IN_COLS / 64) { asm volatile("s_waitcnt vmcnt(0)" ::: "memory"); __syncthreads();
        if (tid == 0) (void)__hip_atomic_fetch_add((unsigned*)(p.ws + WS_MODCTR), 1u, __ATOMIC_RELAXED, __HIP_MEMORY_SCOPE_AGENT); }
    if (vb == nb - 1) { float* rt = (float*)(p.ws + WS_ROPE);
        for (int i = tid; i < 64 * 32; i += NTHREADS) { const int pos = i >> 5, j = i & 31; const float inv = exp2f(-(float)j * (13.287712379549449f / 32.0f)); float sn, cs; sincosf((float)pos * inv, &sn, &cs); rt[i] = cs; rt[2048 + i] = sn; } }
    if (vb == 0) { float* lb = (float*)(p.ws + WS_LB);
        for (int i = tid; i < 2 * WA; i += NTHREADS) { const int d = i / WA, cc = i % WA; const float l0 = p.lb_logits[d * 2 * WA + cc], l1 = p.lb_logits[d * 2 * WA + WA + cc]; lb[i] = 1.0f / (1.0f + expf(l1 - l0)); } }
}

__device__ __forceinline__ void phase_h(const Params& p, int vb, int nb) {
    const int tid = tid_of(p.wave_id), lane = tid & 63, wave = p.wave_id;
    const float* mod = (const float*)(p.ws + WS_MOD);
    bf16* H = (bf16*)(p.ws + WS_H);
    for (int m = vb * 8 + wave; m < MT; m += nb * 8) {
        const float* xr = (m < ML) ? p.x + (size_t)m * D_MODEL : p.ctx + (size_t)(m - ML) * D_MODEL;
        const int mr = (m < ML) ? (m / SEQ) : 4;
        const float* sh = mod + (size_t)mr * IN_COLS, *scl = sh + D_MODEL;
        f32x4 v[8]; float s = 0.f;
#pragma unroll
        for (int j = 0; j < 8; ++j) { v[j] = __builtin_nontemporal_load((const f32x4*)(xr + 4 * lane + 256 * j)); s += (v[j].x * v[j].x + v[j].y * v[j].y) + (v[j].z * v[j].z + v[j].w * v[j].w); }
        const float rstd = __builtin_amdgcn_rsqf(wave_sum(s) * (1.0f / D_MODEL) + EPS);
#pragma unroll
        for (int j = 0; j < 8; ++j) { const int k = 4 * lane + 256 * j;
            const f32x4 g = *(const f32x4*)(p.norm1_g + k), a = *(const f32x4*)(scl + k), b = *(const f32x4*)(sh + k);
            const f32x4 h = v[j] * rstd * g * (a + 1.0f) + b;
            u32x2 o; o.x = pk2(h.x, h.y); o.y = pk2(h.z, h.w);
            *(u32x2*)(H + (size_t)m * D_MODEL + k) = o; }
    }
}

#define EPI_LOOP_BEGIN \
    _Pragma("unroll") for (int ai = 0; ai < 2; ++ai) _Pragma("unroll") for (int m = 0; m < 4; ++m) { const int row = u.pm * 256 + ai * 128 + wr * 64 + m * 16 + fr; \
    _Pragma("unroll") for (int bj = 0; bj < 2; ++bj) _Pragma("unroll") for (int n = 0; n < 2; ++n) { const int col = u.pn * 256 + bj * 128 + wc * 32 + n * 16 + fq * 4; const f32x4 v = acc[ai][bj][m][n];
#define EPI_LOOP_END } }

struct EpiInProj {
    static constexpr bool PERM = false, AFTER_DRAIN = false, CARRY = false, PREF = false;
    unsigned char* ws; LAS unsigned char* lds; const float* qg; const float* kg;
    __device__ __forceinline__ void operator()(const f32x4 (&acc)[2][2][4][2], const pg8::Unit& u, int wr, int wc, int fr, int fq) const {
        { const int l_ = lane_id(); fr = l_ & 15; fq = l_ >> 4; }
        const int seg = u.pn >> 2;
        const bool ctxrow = u.pm >= ML / 256;
        const float* lb = (const float*)(ws + WS_LB);
        if (seg == 1 || seg == 2) {
            float* F = (float*)(ws + (seg == 1 ? WS_FW : WS_FB)); const float* lbd = lb + (seg - 1) * WA;
            f32x4 lbv[2][2];
#pragma unroll
            for (int bj = 0; bj < 2; ++bj)
#pragma unroll
                for (int n = 0; n < 2; ++n) lbv[bj][n] = *(const f32x4*)(lbd + u.pn * 256 + bj * 128 + wc * 32 + n * 16 + fq * 4 - seg * WA);
            EPI_LOOP_BEGIN
                const int c = col - seg * WA; const f32x4 l = lbv[bj][n]; f32x4 o;
                o.x = l.x + (1.0f - l.x) * sigmoidf_(v.x); o.y = l.y + (1.0f - l.y) * sigmoidf_(v.y);
                o.z = l.z + (1.0f - l.z) * sigmoidf_(v.z); o.w = l.w + (1.0f - l.w) * sigmoidf_(v.w);
                *(f32x4*)(F + (size_t)row * WA + c) = o;
            EPI_LOOP_END
        } else if (seg == 7) {
            bf16* VT = (bf16*)(ws + WS_VN);
            EPI_LOOP_BEGIN
                const int c = col - 7 * WA; const int hh = c >> 7, d = c & 127;
                int bb, tok; if (row < ML) { bb = row / SEQ; tok = row % SEQ; } else { bb = (row - ML) / CTX; tok = SEQ + (row - ML) % CTX; }
                bf16* o = VT + ((size_t)(bb * NHEAD + hh) * HD + d) * VT_PITCH + tok;
                o[0] = (bf16)f2bf(v.x); o[VT_PITCH] = (bf16)f2bf(v.y); o[2 * VT_PITCH] = (bf16)f2bf(v.z); o[3 * VT_PITCH] = (bf16)f2bf(v.w);
            EPI_LOOP_END
        } else if (seg == 5 || seg == 6) {
            if (ctxrow && seg == 5) return;
            LAS float* ssq = (LAS float*)(lds + 131072);
            const float* gn = (seg == 5) ? qg : kg; const float* rt = (const float*)(ws + WS_ROPE);
            bf16* O = (bf16*)(ws + (seg == 5 ? WS_QN : WS_KN));
            const int H = wc >> 1, jj = 16 * (wc & 1) + 4 * fq;
            const f32x4 g0 = *(const f32x4*)(gn + 64 * H + jj), g1 = *(const f32x4*)(gn + 64 * H + 32 + jj);
            f32x4 csv[2][4], snv[2][4];
#pragma unroll
            for (int ai = 0; ai < 2; ++ai)
#pragma unroll
                for (int m = 0; m < 4; ++m) { csv[ai][m] = (f32x4){1.f, 1.f, 1.f, 1.f}; snv[ai][m] = (f32x4){0.f, 0.f, 0.f, 0.f};
                    if (!ctxrow) { const int t = (u.pm * 256 + ai * 128 + wr * 64 + m * 16 + fr) & (SEQ - 1); const int pos = (H == 0) ? (t >> 6) : (t & 63);
                        csv[ai][m] = *(const f32x4*)(rt + pos * 32 + jj); snv[ai][m] = *(const f32x4*)(rt + 2048 + pos * 32 + jj); } }
#pragma unroll
            for (int ai = 0; ai < 2; ++ai)
#pragma unroll
                for (int m = 0; m < 4; ++m)
#pragma unroll
                    for (int bj = 0; bj < 2; ++bj) { const f32x4 a = acc[ai][bj][m][0], b = acc[ai][bj][m][1];
                        float sq = (a.x * a.x + a.y * a.y) + (a.z * a.z + a.w * a.w) + (b.x * b.x + b.y * b.y) + (b.z * b.z + b.w * b.w);
                        sq = rows_sum(sq);
                        if (fq == 0) ssq[((ai * 128 + wr * 64 + m * 16 + fr) * 2 + bj) * 4 + wc] = sq; }
            asm volatile("s_waitcnt lgkmcnt(0)" ::: "memory"); __builtin_amdgcn_s_barrier(); asm volatile("" ::: "memory");
#pragma unroll
            for (int ai = 0; ai < 2; ++ai)
#pragma unroll
                for (int m = 0; m < 4; ++m) { const int rl = ai * 128 + wr * 64 + m * 16 + fr; const int row = u.pm * 256 + rl;
                    const f32x4 cs = csv[ai][m], sn = snv[ai][m];
#pragma unroll
                    for (int bj = 0; bj < 2; ++bj) { const f32x4 s4 = *(const LAS f32x4*)(ssq + (rl * 2 + bj) * 4);
                        const float rstd = __builtin_amdgcn_rsqf(((s4.x + s4.y) + (s4.z + s4.w)) * (1.0f / HD) + EPS);
                        const f32x4 u1 = acc[ai][bj][m][0] * rstd * g0, u2 = acc[ai][bj][m][1] * rstd * g1;
                        const f32x4 o1 = u1 * cs - u2 * sn, o2 = u1 * sn + u2 * cs;
                        bf16* op = O + (size_t)row * WA + (u.pn & 3) * 256 + bj * 128 + wc * 32 + fq * 4;
                        u32x2 w1; w1.x = pk2(o1.x, o1.y); w1.y = pk2(o1.z, o1.w); *(u32x2*)op = w1;
                        u32x2 w2; w2.x = pk2(o2.x, o2.y); w2.y = pk2(o2.z, o2.w); *(u32x2*)(op + 16) = w2; }
                    asm volatile("" ::: "memory"); }
            asm volatile("s_waitcnt lgkmcnt(0)" ::: "memory"); __builtin_amdgcn_s_barrier(); asm volatile("" ::: "memory");
        } else if (seg == 0 || seg == 3) {
            if (ctxrow && seg == 0) return;
            bf16* O = (bf16*)(ws + (seg == 0 ? WS_QA : WS_IA));
            EPI_LOOP_BEGIN
                const int c = col - seg * WA; u32x2 o; o.x = pk2(v.x, v.y); o.y = pk2(v.z, v.w);
                *(u32x2*)(O + (size_t)row * WA + c) = o;
            EPI_LOOP_END
        } else if (seg == 4) {
            if (ctxrow) return;
            bf16* O = (bf16*)(ws + WS_GA);
            EPI_LOOP_BEGIN
                const int c = col - seg * WA; u32x2 o; o.x = pk2(v.x, v.y); o.y = pk2(v.z, v.w);
                *(u32x2*)(O + (size_t)row * WA + c) = o;
            EPI_LOOP_END
        } else {
            if (ctxrow) return;
            const bool isa = seg < 10;
            bf16* O = (bf16*)(ws + (isa ? WS_GTA : WS_GTB)); const int cbase = isa ? 8 * WA : 10 * WA;
            EPI_LOOP_BEGIN
                const int c = col - cbase; u32x2 o; o.x = pk2(einvf_(v.x), einvf_(v.y)); o.y = pk2(einvf_(v.z), einvf_(v.w));
                *(u32x2*)(O + (size_t)row * D_MODEL + c) = o;
            EPI_LOOP_END
        }
    }
};

constexpr int CTX_UNITS = (MC / 256) * 20;
struct InProjOrder : pg8::StaticOrder {
    __device__ bool next(int i, pg8::Unit& u) const {
        if (pg8::StaticOrder::next(i, u)) return true;
        const long L = (long)i * G + c - nwg; if (L < 0 || L >= CTX_UNITS) return false;
        const int t = (int)L, j = t % 20; u.pm = ML / 256 + t / 20; u.pn = (j < 12) ? 4 + j : 12 + j; u.br = 0; return true; }
};
struct MergeOrder : pg8::StaticOrder {
    const bf16* A1; const bf16* B1;
    unsigned* ya_ctr; unsigned ya_need;
    __device__ __forceinline__ void a_ready(const pg8::Unit& u) const {
        if (u.br == 1) { while (__hip_atomic_load(ya_ctr, __ATOMIC_RELAXED, __HIP_MEMORY_SCOPE_AGENT) < ya_need) __builtin_amdgcn_s_sleep(2);
            asm volatile("" ::: "memory"); } }
    __device__ bool next(int i, pg8::Unit& u) const { if (!pg8::StaticOrder::next(i >> 1, u)) return false; u.br = i & 1; return true; }
    __device__ __forceinline__ const char* a_base(const pg8::Gemm& g, const pg8::Unit& u, size_t tstep) const { return (const char*)(u.br ? A1 : g.A) + (size_t)u.pm * tstep; }
    __device__ __forceinline__ const char* b_base(const pg8::Gemm& g, const pg8::Unit& u, size_t tstep) const { return (const char*)(u.br ? B1 : g.Bt) + (size_t)u.pn * tstep; }
};
#define EPI_BATCH_BEGIN _Pragma("unroll") for (int ai = 0; ai < 2; ++ai) _Pragma("unroll") for (int mh = 0; mh < 4; mh += 2) {
#define EPI_BATCH_END }
#define EPI_VEC_LOOP _Pragma("unroll") for (int m2 = 0; m2 < 2; ++m2) _Pragma("unroll") for (int bj = 0; bj < 2; ++bj) _Pragma("unroll") for (int n = 0; n < 2; ++n)
#define EPI_VEC_IDX const int m = mh + m2, vi = (m2 * 2 + bj) * 2 + n; const int row = u.pm * 256 + ai * 128 + wr * 64 + m * 16 + fr, col = u.pn * 256 + bj * 128 + wc * 32 + n * 16 + fq * 4; (void)vi
#define EPI_WVEC_LOOP _Pragma("unroll") for (int m2 = 0; m2 < 2; ++m2) _Pragma("unroll") for (int bj = 0; bj < 2; ++bj)
#define EPI_WVEC_IDX const int m = mh + m2, wi = m2 * 2 + bj; const int row = u.pm * 256 + ai * 128 + wr * 64 + m * 16 + fr, col = u.pn * 256 + bj * 128 + wc * 32 + fq * 8; const unsigned off = (unsigned)(row * D_MODEL + col); (void)wi; (void)off
#define EPI_PIPE_IDX(b_) const int ai = (b_) >> 1, mh = 2 * ((b_) & 1); (void)ai; (void)mh
struct EpiMerge {
    static constexpr bool PERM = true, AFTER_DRAIN = false, CARRY = true, PREF = false;
    unsigned char* ws;
    __device__ __forceinline__ void operator()(const f32x4 (&acc_c)[2][2][4][2], const pg8::Unit& u, int wr, int wc, int fr, int fq) const {
        f32x4 (&acc)[2][2][4][2] = const_cast<f32x4 (&)[2][2][4][2]>(acc_c);
        { const int l_ = lane_id(); fr = l_ & 15; fq = l_ >> 4; }
        const bf16* GB = (const bf16*)(ws + WS_GTA);
        if (u.br == 0) {
            const bf16* GA = (const bf16*)(ws + WS_GTB);
#pragma unroll
            for (int ai = 0; ai < 2; ++ai) {
                u32x4 ga[2][4], gb[2][4];
#pragma unroll
                for (int hb = 0; hb < 2; ++hb) { const int mh = 2 * hb; EPI_WVEC_LOOP { EPI_WVEC_IDX; ga[hb][wi] = *(const u32x4*)((const char*)GA + off * 2u); gb[hb][wi] = *(const u32x4*)((const char*)GB + off * 2u); } }
#pragma unroll
                for (int hb = 0; hb < 2; ++hb) { const int mh = 2 * hb; EPI_WVEC_LOOP { EPI_WVEC_IDX; const u32x4 a = ga[hb][wi], b = gb[hb][wi];
#define MRG_R(A_, B_) ((B_) * __builtin_amdgcn_rcpf(A_))
                    f32x4 r0, r1;
                    r0.x = MRG_R(bflo(a.x), bflo(b.x)); r0.y = MRG_R(bfhi(a.x), bfhi(b.x)); r0.z = MRG_R(bflo(a.y), bflo(b.y)); r0.w = MRG_R(bfhi(a.y), bfhi(b.y));
                    r1.x = MRG_R(bflo(a.z), bflo(b.z)); r1.y = MRG_R(bfhi(a.z), bfhi(b.z)); r1.z = MRG_R(bflo(a.w), bflo(b.w)); r1.w = MRG_R(bfhi(a.w), bfhi(b.w));
#undef MRG_R
                    acc[ai][bj][m][0] = acc[ai][bj][m][0] * r0; acc[ai][bj][m][1] = acc[ai][bj][m][1] * r1; } }
            }
        } else {
            bf16* Z = (bf16*)(ws + WS_Z);
            u32x4 gv[4][4];
#pragma unroll
            for (int b = 0; b < 4; ++b) { EPI_PIPE_IDX(b); EPI_WVEC_LOOP { EPI_WVEC_IDX; gv[b][wi] = *(const u32x4*)((const char*)GB + off * 2u); } }
#pragma unroll
            for (int b = 0; b < 4; ++b) { EPI_PIPE_IDX(b); EPI_WVEC_LOOP { EPI_WVEC_IDX; const u32x4 g = gv[b][wi]; const f32x4 v0 = acc[ai][bj][m][0], v1 = acc[ai][bj][m][1];
#define MRG_G(B_) __builtin_amdgcn_rcpf(B_)
                    u32x4 o; o.x = pk2(MRG_G(bflo(g.x)) * v0.x, MRG_G(bfhi(g.x)) * v0.y); o.y = pk2(MRG_G(bflo(g.y)) * v0.z, MRG_G(bfhi(g.y)) * v0.w);
                    o.z = pk2(MRG_G(bflo(g.z)) * v1.x, MRG_G(bfhi(g.z)) * v1.y); o.w = pk2(MRG_G(bflo(g.w)) * v1.z, MRG_G(bfhi(g.w)) * v1.w);
#undef MRG_G
                    *(u32x4*)((char*)Z + off * 2u) = o; } }
        }
    }
};
struct EpiOutProj {
    static constexpr bool PERM = true, AFTER_DRAIN = false, CARRY = false, PREF = false;
    unsigned char* ws; const float* x; const float* norm2_g; float* out;
    __device__ __forceinline__ void operator()(const f32x4 (&acc)[2][2][4][2], const pg8::Unit& u, int wr, int wc, int fr, int fq) const {
        { const int l_ = lane_id(); fr = l_ & 15; fq = l_ >> 4; }
        const float* mod = (const float*)(ws + WS_MOD); bf16* XMG = (bf16*)(ws + WS_XMG); bf16* XM = (bf16*)(ws + WS_XM16); float* rowsq = (float*)(ws + WS_ROWSQ);
        const int bb = (u.pm * 256) / SEQ;
        const float* g1 = mod + (size_t)bb * IN_COLS + 2 * D_MODEL, *sc2 = mod + (size_t)bb * IN_COLS + 4 * D_MODEL;
        float ss[2][4];
#pragma unroll
        for (int ai = 0; ai < 2; ++ai)
#pragma unroll
            for (int m = 0; m < 4; ++m) ss[ai][m] = 0.f;
#pragma unroll
        for (int bj = 0; bj < 2; ++bj) {
            const int col = u.pn * 256 + bj * 128 + wc * 32 + fq * 8;
            const f32x4 cg0 = *(const f32x4*)(g1 + col), cg1 = *(const f32x4*)(g1 + col + 4), ch0 = *(const f32x4*)(sc2 + col), ch1 = *(const f32x4*)(sc2 + col + 4);
            f32x4 xv[2][4][2];
#pragma unroll
            for (int ai = 0; ai < 2; ++ai)
#pragma unroll
                for (int m = 0; m < 4; ++m) { const unsigned off = (unsigned)((u.pm * 256 + ai * 128 + wr * 64 + m * 16 + fr) * D_MODEL + col); xv[ai][m][0] = *(const f32x4*)((const char*)x + off * 4u); xv[ai][m][1] = *(const f32x4*)((const char*)x + off * 4u + 16); }
#pragma unroll
            for (int ai = 0; ai < 2; ++ai)
#pragma unroll
                for (int m = 0; m < 4; ++m) { const unsigned off = (unsigned)((u.pm * 256 + ai * 128 + wr * 64 + m * 16 + fr) * D_MODEL + col);
                    const f32x4 xm0 = xv[ai][m][0] + cg0 * acc[ai][bj][m][0], xm1 = xv[ai][m][1] + cg1 * acc[ai][bj][m][1];
                    { u32x4 o; o.x = pk2(xm0.x, xm0.y); o.y = pk2(xm0.z, xm0.w); o.z = pk2(xm1.x, xm1.y); o.w = pk2(xm1.z, xm1.w); *(u32x4*)((char*)XM + off * 2u) = o; }
                    ss[ai][m] += ((xm0.x * xm0.x + xm0.y * xm0.y) + (xm0.z * xm0.z + xm0.w * xm0.w)) + ((xm1.x * xm1.x + xm1.y * xm1.y) + (xm1.z * xm1.z + xm1.w * xm1.w));
                    const f32x4 h0 = xm0 * ch0, h1 = xm1 * ch1;
                    u32x4 o; o.x = pk2(h0.x, h0.y); o.y = pk2(h0.z, h0.w); o.z = pk2(h1.x, h1.y); o.w = pk2(h1.z, h1.w);
                    *(u32x4*)((char*)XMG + off * 2u) = o; }
        }
#pragma unroll
        for (int ai = 0; ai < 2; ++ai)
#pragma unroll
            for (int m = 0; m < 4; ++m) { const float t = rows_sum(ss[ai][m]);
                if (fq == 0) atomicAdd((float*)((char*)rowsq + (unsigned)(u.pm * 256 + ai * 128 + wr * 64 + m * 16 + fr) * 4u), t); }
    }
};
__device__ __forceinline__ float dpp_ror1(float v) { return __builtin_bit_cast(float, __builtin_amdgcn_update_dpp(0, __builtin_bit_cast(int, v), 0x121, 0xf, 0xf, false)); }
__device__ __forceinline__ float dpp_rol1(float v) { return __builtin_bit_cast(float, __builtin_amdgcn_update_dpp(0, __builtin_bit_cast(int, v), 0x12f, 0xf, 0xf, false)); }
__device__ __forceinline__ f32x4 ror1_4(const f32x4 v) { return (f32x4){dpp_ror1(v.x), dpp_ror1(v.y), dpp_ror1(v.z), dpp_ror1(v.w)}; }
__device__ __forceinline__ f32x4 rol1_4(const f32x4 v) { return (f32x4){dpp_rol1(v.x), dpp_rol1(v.y), dpp_rol1(v.z), dpp_rol1(v.w)}; }
constexpr int EPI_PF_BIAS = 131072 + 4096, EPI_PF_ROWSQ = 131072 + 5120;
struct EpiFfnUp {
    static constexpr bool PERM = true, AFTER_DRAIN = false, CARRY = false, PREF = true;
    unsigned char* ws; LAS unsigned char* lds; const float* cw; const float* cb;
    __device__ __forceinline__ void prefetch(const pg8::Unit& u, int wid) const {
        if (wid < 2) { const int l = lane_id(); const int b = (u.pm * 256) / SEQ;
            const float* src = (wid == 0) ? (const float*)(ws + WS_BIAS2) + (size_t)b * 2 * FFN + u.pn * 256 : (const float*)(ws + WS_ROWSQ) + u.pm * 256;
            __builtin_amdgcn_global_load_lds((const unsigned*)(src + 4 * l), (LAS unsigned*)(lds + (wid == 0 ? EPI_PF_BIAS : EPI_PF_ROWSQ)), 16, 0, 0); } }
    __device__ __forceinline__ void operator()(const f32x4 (&acc_c)[2][2][4][2], const pg8::Unit& u, int wr, int wc, int fr, int fq) const {
        f32x4 (&acc)[2][2][4][2] = const_cast<f32x4 (&)[2][2][4][2]>(acc_c);
        { const int l_ = lane_id(); fr = l_ & 15; fq = l_ >> 4; }
        const float* rowsq = (const float*)(ws + WS_ROWSQ); bf16* ACT = (bf16*)(ws + WS_ACT); float* HALO = (float*)(ws + WS_HALO) + (size_t)u.pm * 6 * FFN;
        const int cl = wc * 32 + fq * 8, ch0 = u.pn * 128 + cl;
        LAS float* X = (LAS float*)(lds + 131072);
        const LAS float* bias2 = (const LAS float*)(lds + EPI_PF_BIAS);
        const LAS float* rsq = (const LAS float*)(lds + EPI_PF_ROWSQ);
        (void)rowsq;
#pragma unroll
        for (int ai = 0; ai < 2; ++ai)
#pragma unroll
            for (int m = 0; m < 4; ++m) { const int rl = ai * 128 + wr * 64 + m * 16 + fr;
                const float rstd = __builtin_amdgcn_rsqf(rsq[rl] * (1.0f / D_MODEL) + EPS);
#pragma unroll
                for (int bj = 0; bj < 2; ++bj)
#pragma unroll
                    for (int n = 0; n < 2; ++n) acc[ai][bj][m][n] = acc[ai][bj][m][n] * rstd + *(const LAS f32x4*)(bias2 + bj * 128 + cl + 4 * n); }
        f32x4 w0[2], w1[2], w2[2], cbv[2];
#pragma unroll
        for (int n = 0; n < 2; ++n) { w0[n] = *(const f32x4*)(cw + ch0 + 4 * n); w1[n] = *(const f32x4*)(cw + FFN + ch0 + 4 * n); w2[n] = *(const f32x4*)(cw + 2 * FFN + ch0 + 4 * n); cbv[n] = *(const f32x4*)(cb + ch0 + 4 * n); }
#pragma unroll
        for (int ai = 0; ai < 2; ++ai) { const int bi = 2 * ai + wr;
            if (fr == 0) {
#pragma unroll
                for (int n = 0; n < 2; ++n) *(LAS f32x4*)(X + (bi * 2 + 0) * 128 + cl + 4 * n) = acc[ai][0][0][n]; }
            if (fr == 15) {
#pragma unroll
                for (int n = 0; n < 2; ++n) *(LAS f32x4*)(X + (bi * 2 + 1) * 128 + cl + 4 * n) = acc[ai][0][3][n]; } }
        asm volatile("s_waitcnt lgkmcnt(0)" ::: "memory"); __builtin_amdgcn_s_barrier(); asm volatile("" ::: "memory");
#pragma unroll
        for (int ai = 0; ai < 2; ++ai) { const int bi = 2 * ai + wr;
#pragma unroll
            for (int m = 0; m < 4; ++m) { u32x4 o;
#pragma unroll
                for (int n = 0; n < 2; ++n) { const f32x4 cur = acc[ai][0][m][n];
                    f32x4 pu, nd;
                    if (m > 0) pu = ror1_4(acc[ai][0][m > 0 ? m - 1 : 0][n]); else pu = (bi > 0) ? *(const LAS f32x4*)(X + ((bi - 1) * 2 + 1) * 128 + cl + 4 * n) : (f32x4){0.f, 0.f, 0.f, 0.f};
                    if (m < 3) nd = rol1_4(acc[ai][0][m < 3 ? m + 1 : 3][n]); else nd = (bi < 3) ? *(const LAS f32x4*)(X + ((bi + 1) * 2 + 0) * 128 + cl + 4 * n) : (f32x4){0.f, 0.f, 0.f, 0.f};
                    const f32x4 ps = ror1_4(cur), ns = rol1_4(cur);
                    const f32x4 prev = (fr > 0) ? ps : pu, next = (fr < 15) ? ns : nd;
                    const f32x4 uu = w0[n] * prev + w1[n] * cur + w2[n] * next + cbv[n]; const f32x4 gt = acc[ai][1][m][n];
                    f32x4 r; r.x = siluf_(uu.x) * gt.x; r.y = siluf_(uu.y) * gt.y; r.z = siluf_(uu.z) * gt.z; r.w = siluf_(uu.w) * gt.w;
                    if (n == 0) { o.x = pk2(r.x, r.y); o.y = pk2(r.z, r.w); } else { o.z = pk2(r.x, r.y); o.w = pk2(r.z, r.w); } }
                const int rl = ai * 128 + wr * 64 + m * 16 + fr;
                if (rl != 0 && rl != 255) *(u32x4*)(ACT + (size_t)(u.pm * 256 + rl) * FFN + ch0) = o; } }
        if (wr == 0 && fr < 2) {
#pragma unroll
            for (int n = 0; n < 2; ++n) { *(f32x4*)(HALO + (size_t)fr * FFN + ch0 + 4 * n) = acc[0][0][0][n]; if (fr == 0) *(f32x4*)(HALO + (size_t)4 * FFN + ch0 + 4 * n) = acc[0][1][0][n]; } }
        if (wr == 1 && fr >= 14) {
#pragma unroll
            for (int n = 0; n < 2; ++n) { *(f32x4*)(HALO + (size_t)(fr - 12) * FFN + ch0 + 4 * n) = acc[1][0][3][n]; if (fr == 15) *(f32x4*)(HALO + (size_t)5 * FFN + ch0 + 4 * n) = acc[1][1][3][n]; } }
    }
};
struct EpiFfnUpHalf {
    static constexpr bool PERM = true, AFTER_DRAIN = false, CARRY = false, PREF = true;
    unsigned char* ws; LAS unsigned char* lds; const float* cw; const float* cb;
    __device__ __forceinline__ void prefetch(const pg8::Unit& u, int wid) const {
        if (wid < 2) { const int l = lane_id(); const int b = (u.pm * 256) / SEQ;
            const float* src = (wid == 0) ? (const float*)(ws + WS_BIAS2) + (size_t)b * 2 * FFN + u.pn * 256 : (const float*)(ws + WS_ROWSQ) + u.pm * 256;
            __builtin_amdgcn_global_load_lds((const unsigned*)(src + 4 * l), (LAS unsigned*)(lds + (wid == 0 ? EPI_PF_BIAS : EPI_PF_ROWSQ)), 16, 0, 0); } }
    __device__ __forceinline__ void operator()(const f32x4 (&acc_c)[2][2][4][2], const pg8::Unit& u, int wr, int wc, int fr, int fq) const {
        f32x4 (&acc)[2][2][4][2] = const_cast<f32x4 (&)[2][2][4][2]>(acc_c);
        { const int l_ = lane_id(); fr = l_ & 15; fq = l_ >> 4; }
        const int half = u.br;
        bf16* ACT = (bf16*)(ws + WS_ACT); float* HALO = (float*)(ws + WS_HALO) + (size_t)u.pm * 6 * FFN; float* HALO2 = (float*)(ws + WS_HALO2) + (size_t)u.pm * 6 * FFN;
        const int cl = wc * 32 + fq * 8, ch0 = u.pn * 128 + cl;
        LAS float* X = (LAS float*)(lds + 131072);
        const LAS float* bias2 = (const LAS float*)(lds + EPI_PF_BIAS);
        const LAS float* rsq = (const LAS float*)(lds + EPI_PF_ROWSQ);
#pragma unroll
        for (int m = 0; m < 4; ++m) { const int rl = half * 128 + wr * 64 + m * 16 + fr;
            const float rstd = __builtin_amdgcn_rsqf(rsq[rl] * (1.0f / D_MODEL) + EPS);
#pragma unroll
            for (int bj = 0; bj < 2; ++bj)
#pragma unroll
                for (int n = 0; n < 2; ++n) acc[0][bj][m][n] = acc[0][bj][m][n] * rstd + *(const LAS f32x4*)(bias2 + bj * 128 + cl + 4 * n); }
        f32x4 w0[2], w1[2], w2[2], cbv[2];
#pragma unroll
        for (int n = 0; n < 2; ++n) { w0[n] = *(const f32x4*)(cw + ch0 + 4 * n); w1[n] = *(const f32x4*)(cw + FFN + ch0 + 4 * n); w2[n] = *(const f32x4*)(cw + 2 * FFN + ch0 + 4 * n); cbv[n] = *(const f32x4*)(cb + ch0 + 4 * n); }
        { const int bi = wr;
            if (fr == 0) {
#pragma unroll
                for (int n = 0; n < 2; ++n) *(LAS f32x4*)(X + (bi * 2 + 0) * 128 + cl + 4 * n) = acc[0][0][0][n]; }
            if (fr == 15) {
#pragma unroll
                for (int n = 0; n < 2; ++n) *(LAS f32x4*)(X + (bi * 2 + 1) * 128 + cl + 4 * n) = acc[0][0][3][n]; } }
        asm volatile("s_waitcnt lgkmcnt(0)" ::: "memory"); __builtin_amdgcn_s_barrier(); asm volatile("" ::: "memory");
        { const int bi = wr;
#pragma unroll
            for (int m = 0; m < 4; ++m) { u32x4 o;
#pragma unroll
                for (int n = 0; n < 2; ++n) { const f32x4 cur = acc[0][0][m][n];
                    f32x4 pu, nd;
                    if (m > 0) pu = ror1_4(acc[0][0][m > 0 ? m - 1 : 0][n]); else pu = (bi > 0) ? *(const LAS f32x4*)(X + ((bi - 1) * 2 + 1) * 128 + cl + 4 * n) : (f32x4){0.f, 0.f, 0.f, 0.f};
                    if (m < 3) nd = rol1_4(acc[0][0][m < 3 ? m + 1 : 3][n]); else nd = (bi < 1) ? *(const LAS f32x4*)(X + ((bi + 1) * 2 + 0) * 128 + cl + 4 * n) : (f32x4){0.f, 0.f, 0.f, 0.f};
                    const f32x4 ps = ror1_4(cur), ns = rol1_4(cur);
                    const f32x4 prev = (fr > 0) ? ps : pu, next = (fr < 15) ? ns : nd;
                    const f32x4 uu = w0[n] * prev + w1[n] * cur + w2[n] * next + cbv[n]; const f32x4 gt = acc[0][1][m][n];
                    f32x4 r; r.x = siluf_(uu.x) * gt.x; r.y = siluf_(uu.y) * gt.y; r.z = siluf_(uu.z) * gt.z; r.w = siluf_(uu.w) * gt.w;
                    if (n == 0) { o.x = pk2(r.x, r.y); o.y = pk2(r.z, r.w); } else { o.z = pk2(r.x, r.y); o.w = pk2(r.z, r.w); } }
                const int rh = wr * 64 + m * 16 + fr;
                if (rh != 0 && rh != 127) *(u32x4*)(ACT + (size_t)(u.pm * 256 + half * 128 + rh) * FFN + ch0) = o; } }
        if (half == 0 && wr == 0 && wc == 0 && fr == 0 && fq == 0) ((int*)(ws + WS_SPLIT))[u.pm * (2 * FFN / 256) + u.pn] = 1;
        if (wr == 0 && fr < 2) { float* dst = half ? HALO2 + (size_t)(3 + fr) * FFN : HALO + (size_t)fr * FFN; float* gd = half ? HALO2 + (size_t)5 * FFN : HALO + (size_t)4 * FFN;
#pragma unroll
            for (int n = 0; n < 2; ++n) { *(f32x4*)(dst + ch0 + 4 * n) = acc[0][0][0][n]; if (fr == 0) *(f32x4*)(gd + ch0 + 4 * n) = acc[0][1][0][n]; } }
        if (wr == 1 && fr >= 14) { float* dst = half ? HALO + (size_t)(fr - 12) * FFN : HALO2 + (size_t)(fr - 14) * FFN; float* gd = half ? HALO + (size_t)5 * FFN : HALO2 + (size_t)2 * FFN;
#pragma unroll
            for (int n = 0; n < 2; ++n) { *(f32x4*)(dst + ch0 + 4 * n) = acc[0][0][3][n]; if (fr == 15) *(f32x4*)(gd + ch0 + 4 * n) = acc[0][1][3][n]; } }
    }
};
__device__ __forceinline__ f32x4 halo_act4(const f32x4 w0, const f32x4 w1, const f32x4 w2, const f32x4 cbv, const f32x4 am, const f32x4 a0, const f32x4 ap, const f32x4 gt) {
    const f32x4 u = w0 * am + w1 * a0 + w2 * ap + cbv;
    return (f32x4){siluf_(u.x) * gt.x, siluf_(u.y) * gt.y, siluf_(u.z) * gt.z, siluf_(u.w) * gt.w};
}
__device__ __forceinline__ void halo_fix(const Params& p, int pm, int tid, int tail_first) {
    const float* HB = (const float*)(p.ws + WS_HALO); const float* H = HB + (size_t)pm * 6 * FFN; bf16* ACT = (bf16*)(p.ws + WS_ACT);
    const f32x4 z4 = (f32x4){0.f, 0.f, 0.f, 0.f};
    for (int q = tid; q < FFN / 4; q += NTHREADS) { const int ch = 4 * q;
        const f32x4 w0 = *(const f32x4*)(p.conv_w + ch), w1 = *(const f32x4*)(p.conv_w + FFN + ch), w2 = *(const f32x4*)(p.conv_w + 2 * FFN + ch), cbv = *(const f32x4*)(p.conv_b + ch);
        const f32x4 pv = (pm & 7) ? *(const f32x4*)(HB + ((size_t)(pm - 1) * 6 + 3) * FFN + ch) : z4; const f32x4 nx = ((pm & 7) != 7) ? *(const f32x4*)(HB + ((size_t)(pm + 1) * 6 + 0) * FFN + ch) : z4;
        const f32x4 h0 = *(const f32x4*)(H + ch), h1 = *(const f32x4*)(H + FFN + ch), h2 = *(const f32x4*)(H + 2 * FFN + ch), h3 = *(const f32x4*)(H + 3 * FFN + ch), h4 = *(const f32x4*)(H + 4 * FFN + ch), h5 = *(const f32x4*)(H + 5 * FFN + ch);
        const f32x4 rt = halo_act4(w0, w1, w2, cbv, pv, h0, h1, h4), rb = halo_act4(w0, w1, w2, cbv, h2, h3, nx, h5);
        u32x2 ot, ob; ot.x = pk2(rt.x, rt.y); ot.y = pk2(rt.z, rt.w); ob.x = pk2(rb.x, rb.y); ob.y = pk2(rb.z, rb.w);
        *(u32x2*)(ACT + (size_t)(pm * 256) * FFN + ch) = ot; *(u32x2*)(ACT + (size_t)(pm * 256 + 255) * FFN + ch) = ob;
    }
    if (tail_first >= 0) { const int* split = (const int*)(p.ws + WS_SPLIT) + pm * (2 * FFN / 256);
        const float* H2 = (const float*)(p.ws + WS_HALO2) + (size_t)pm * 6 * FFN;
        const int ln_ = tid & 63; unsigned long long sm = __ballot(ln_ < 2 * FFN / 256 && split[ln_ < 2 * FFN / 256 ? ln_ : 0] != 0);
        const int nsp = __builtin_popcountll(sm);
        if (tid < 32 * nsp) { int k = tid >> 5; unsigned long long m2 = sm; for (int i = 0; i < k; ++i) m2 &= m2 - 1; const int pn = __builtin_ctzll(m2); const int ch = pn * 128 + 4 * (tid & 31);
            const f32x4 w0 = *(const f32x4*)(p.conv_w + ch), w1 = *(const f32x4*)(p.conv_w + FFN + ch), w2 = *(const f32x4*)(p.conv_w + 2 * FFN + ch), cbv = *(const f32x4*)(p.conv_b + ch);
            const f32x4 a126 = *(const f32x4*)(H2 + ch), a127 = *(const f32x4*)(H2 + FFN + ch), g127 = *(const f32x4*)(H2 + 2 * FFN + ch), a128 = *(const f32x4*)(H2 + 3 * FFN + ch), a129 = *(const f32x4*)(H2 + 4 * FFN + ch), g128 = *(const f32x4*)(H2 + 5 * FFN + ch);
            const f32x4 r127 = halo_act4(w0, w1, w2, cbv, a126, a127, a128, g127), r128 = halo_act4(w0, w1, w2, cbv, a127, a128, a129, g128);
            u32x2 o7, o8; o7.x = pk2(r127.x, r127.y); o7.y = pk2(r127.z, r127.w); o8.x = pk2(r128.x, r128.y); o8.y = pk2(r128.z, r128.w);
            *(u32x2*)(ACT + (size_t)(pm * 256 + 127) * FFN + ch) = o7; *(u32x2*)(ACT + (size_t)(pm * 256 + 128) * FFN + ch) = o8; } }
}
struct EpiFfnDown {
    static constexpr bool PERM = true, AFTER_DRAIN = false, CARRY = false, PREF = false;
    unsigned char* ws; float* out;
    __device__ __forceinline__ void operator()(const f32x4 (&acc)[2][2][4][2], const pg8::Unit& u, int wr, int wc, int fr, int fq) const {
        { const int l_ = lane_id(); fr = l_ & 15; fq = l_ >> 4; }
        const float* mod = (const float*)(ws + WS_MOD); const int bb = (u.pm * 256) / SEQ; const float* g2 = mod + (size_t)bb * IN_COLS + 5 * D_MODEL; const bf16* XM = (const bf16*)(ws + WS_XM16);
        f32x4 cg[2][2];
#pragma unroll
        for (int bj = 0; bj < 2; ++bj)
#pragma unroll
            for (int n = 0; n < 2; ++n) cg[bj][n] = *(const f32x4*)(g2 + u.pn * 256 + bj * 128 + wc * 32 + fq * 8 + 4 * n);
        u32x4 xv[4][4];
#pragma unroll
        for (int b = 0; b < 4; ++b) { EPI_PIPE_IDX(b); EPI_WVEC_LOOP { EPI_WVEC_IDX; xv[b][wi] = *(const u32x4*)((const char*)XM + off * 2u); } }
#pragma unroll
        for (int b = 0; b < 4; ++b) { EPI_PIPE_IDX(b);
            EPI_WVEC_LOOP { EPI_WVEC_IDX; const u32x4 xw = xv[b][wi];
                const f32x4 x0 = (f32x4){bflo(xw.x), bfhi(xw.x), bflo(xw.y), bfhi(xw.y)}, x1 = (f32x4){bflo(xw.z), bfhi(xw.z), bflo(xw.w), bfhi(xw.w)};
                *(f32x4*)((char*)out + off * 4u) = x0 + cg[bj][0] * acc[ai][bj][m][0]; *(f32x4*)((char*)out + off * 4u + 16) = x1 + cg[bj][1] * acc[ai][bj][m][1]; }
        }
    }
};

#define XB_TMO      128
#define XB_XCNT(j)  (256  + 64 * (j))
#define XB_XSUB(j)  (1280 + 64 * (j))
#define XB_XGEN(j)  (2304 + 64 * (j))
#define XB_TOP      3328
#define XB_TOPGEN   3392
#define XCD_BAR_WORDS 3456
#define XB_SPIN_CAP (1u << 18)

__device__ __forceinline__ unsigned xb_ld(unsigned* p)              { return __hip_atomic_load(p, __ATOMIC_RELAXED, __HIP_MEMORY_SCOPE_AGENT); }
__device__ __forceinline__ unsigned xb_add(unsigned* p, unsigned v) { return __hip_atomic_fetch_add(p, v, __ATOMIC_RELAXED, __HIP_MEMORY_SCOPE_AGENT); }
__device__ __forceinline__ unsigned xb_xcc_id() { return (unsigned)__builtin_amdgcn_s_getreg((3 << 11) | 20) & 0xFu; }
#define XB_SPIN(cond, bar) do { unsigned _sp = 0; while (cond) { __builtin_amdgcn_s_sleep(1); \
    if ((++_sp & 255u) == 0u) { if (xb_ld(&(bar)[XB_TMO])) break; if (_sp > XB_SPIN_CAP) { atomicAdd(&(bar)[XB_TMO], 1u); break; } } } } while (0)

struct XcdBarrier {
    unsigned* bar; unsigned x; int wave;
    volatile LAS unsigned* st;
};

__device__ __forceinline__ XcdBarrier xcd_barrier_post(unsigned* bar, volatile LAS unsigned* st, int wave_id) {
    XcdBarrier b; b.bar = bar; b.x = xb_xcc_id(); b.st = st; b.wave = wave_id;
    if (wave_id == 0 && lane_id() == 0) (void)xb_add(&bar[XB_XCNT(b.x)], 1u);
    return b;
}
__device__ __forceinline__ void xcd_barrier_complete(unsigned* bar, unsigned x, unsigned& nloc, unsigned& nx) {
    const unsigned G = gridDim.x * gridDim.y * gridDim.z;
    unsigned sum, cnt, mine, sp = 0u;
    for (;;) {
        sum = 0u; cnt = 0u; mine = 0u;
#pragma unroll
        for (unsigned j = 0; j < 16; ++j) { const unsigned c = xb_ld(&bar[XB_XCNT(j)]); sum += c; cnt += (c > 0u) ? 1u : 0u; mine = (j == x) ? c : mine; }
        if (sum == G) break;
        __builtin_amdgcn_s_sleep(1);
        if ((++sp & 255u) == 0u) { if (xb_ld(&bar[XB_TMO])) break; if (sp > XB_SPIN_CAP) { atomicAdd(&bar[XB_TMO], 1u); break; } }
    }
    nloc = mine > 0u ? mine : 1u; nx = cnt > 0u ? cnt : 1u;
}

__device__ __forceinline__ void xcd_barrier(const XcdBarrier& b) {
    asm volatile("s_waitcnt vmcnt(0)" ::: "memory");
    __syncthreads();
    if (b.wave == 0 && lane_id() == 0) {
        unsigned* bar = b.bar;
        __builtin_amdgcn_s_waitcnt(0);
        unsigned nloc = b.st[0], nx = b.st[1];
        if (nloc == 0u) { xcd_barrier_complete(bar, b.x, nloc, nx); b.st[0] = nloc; b.st[1] = nx; }
        const unsigned old = xb_add(&bar[XB_XSUB(b.x)], 1u);
        const unsigned gen = old / nloc;
        if (old + 1u == (gen + 1u) * nloc) {
            __builtin_amdgcn_fence(__ATOMIC_RELEASE, "agent");
            asm volatile("s_waitcnt vmcnt(0)" ::: "memory");
            const unsigned og = xb_add(&bar[XB_TOP], 1u);
            const unsigned tg = og / nx;
            if (og + 1u == (tg + 1u) * nx) xb_add(&bar[XB_TOPGEN], 1u);
            else XB_SPIN(xb_ld(&bar[XB_TOPGEN]) == tg, bar);
            __builtin_amdgcn_fence(__ATOMIC_ACQUIRE, "agent");
            xb_add(&bar[XB_XGEN(b.x)], 1u);
            asm volatile("s_waitcnt vmcnt(0)" ::: "memory");
        } else {
            XB_SPIN(xb_ld(&bar[XB_XGEN(b.x)]) == gen, bar);
            __builtin_amdgcn_fence(__ATOMIC_ACQUIRE, "agent");
            asm volatile("s_waitcnt vmcnt(0)" ::: "memory");
        }
    }
    __syncthreads();
}

constexpr size_t WS_BAR = 8192;

typedef short bf16x8 __attribute__((ext_vector_type(8)));
typedef short s16x4 __attribute__((ext_vector_type(4)));

__device__ __forceinline__ bf16x8 cat8u(const u32x2 a, const u32x2 b) { const u32x4 w = (u32x4){a.x, a.y, b.x, b.y}; return __builtin_bit_cast(bf16x8, w); }
__device__ __forceinline__ bf16x8 pack_p(const f32x4 a, const f32x4 b) {
    u32x4 w; w.x = pk2(a.x, a.y); w.y = pk2(a.z, a.w); w.z = pk2(b.x, b.y); w.w = pk2(b.z, b.w);
    return __builtin_bit_cast(bf16x8, w);
}

constexpr int A_TILE = 32768, A_KOFF = 0, A_VOFF = 16384;
constexpr int A_BIAS = 4 * A_TILE;
constexpr int A_ITEM = A_BIAS + 2048;
static_assert(A_ITEM + 64 <= 145408, "attention LDS");
constexpr size_t WS_ATTCTR = 32768;
constexpr size_t WS_PREPCTR = 38912;
constexpr size_t WS_YACTR = 36864;
static_assert(WS_ATTCTR >= WS_BAR + XCD_BAR_WORDS * 4 && WS_ATTCTR + 8 * 256 <= WS_ROWSQ, "attn counters (8 x 256 B apart) inside ctl");
#define ATT_BAR() do { asm volatile("s_waitcnt lgkmcnt(0)" ::: "memory"); __builtin_amdgcn_s_barrier(); asm volatile("" ::: "memory"); } while (0)
__device__ __forceinline__ void glds16(const void* gsrc, unsigned lds_dst) { unsigned keep;
    asm volatile("s_mov_b32 %0, m0\n\ts_mov_b32 m0, %2\n\ts_nop 0\n\tglobal_load_lds_dwordx4 %1, off\n\ts_mov_b32 m0, %0" : "=&s"(keep) : "v"(gsrc), "s"(lds_dst) : "memory"); }
__device__ __forceinline__ unsigned lds_addr(LAS const void* p) { return (unsigned)__builtin_amdgcn_readfirstlane((int)(unsigned)(unsigned long long)p); }

__device__ __forceinline__ void phase_attn(const Params& p, LAS unsigned char* lds) {
    int tid_o = tid_of(p.wave_id);
    const int tid = tid_o, lane = tid & 63, wave = __builtin_amdgcn_readfirstlane(tid >> 6);
    const int qb = wave & 3, rw = wave >> 2, li = lane & 15, g = lane >> 4;
    const bf16* QN = (const bf16*)(p.ws + WS_QN); const bf16* KN = (const bf16*)(p.ws + WS_KN); const bf16* VT = (const bf16*)(p.ws + WS_VN);
    bf16* YB = (bf16*)p.out;
    unsigned* ctr = (unsigned*)(p.ws + WS_ATTCTR);
    LAS float* btab = (LAS float*)(lds + A_BIAS);
    const float scale = 0.08838834764831845f * 1.4426950408889634f;
    int krow_l[2], kch_l[2], vrow_l[2], vch_l[2];
#pragma unroll
    for (int e = 0; e < 2; ++e) { const int pk = 2 * wave + e; krow_l[e] = 4 * pk + (lane >> 4); kch_l[e] = (lane & 15) ^ (krow_l[e] & 15);
        vrow_l[e] = 8 * pk + (lane >> 3); vch_l[e] = (lane & 7) ^ ((vrow_l[e] >> 1) & 7); }
    const int myx = (int)(xb_xcc_id() & 7u);
    int qoff = 0;
    for (;;) {
        if (tid == 0) { unsigned v = 0xffffffffu;
            while (qoff < 8) { const int qx = (myx + qoff) & 7; const unsigned n = atomicAdd(ctr + 64 * qx, 1u); if (n < 64u) { v = (unsigned)((qx + 8 * (n >> 4)) * 16 + (n & 15)); break; } ++qoff; }
            *(LAS unsigned*)(lds + A_ITEM) = v; }
        __syncthreads();
        const unsigned itu = *(LAS unsigned*)(lds + A_ITEM);
        if (itu == 0xffffffffu) break;
        const int it = (int)itu;
        const int rp = it & 15, h = (it >> 4) & 7, b = it >> 7;
        const int r = 2 * rp + rw;
        const int rs = min(max(r - 4, 0), 24), ks0 = min(max(16 * qb - 8, 0), 32);
        const int kr0 = min(max(2 * rp - 4, 0), 24), nband = min(max(2 * rp + 1 - 4, 0), 24) + 8 - kr0, NT = nband + 4;
        const int cq = 16 * qb + li, cs = min(max(cq - 8, 0), 48);
        const size_t qrow = (size_t)b * SEQ + r * GRID_W + cq;
        float bvl = 0.f; if (tid < 15 * 31) bvl = p.rel_bias[h * 465 + tid];
        bf16x8 qf[4];
#pragma unroll
        for (int ks = 0; ks < 4; ++ks) qf[ks] = *(const bf16x8*)(QN + qrow * WA + h * HD + 32 * ks + 8 * g);
        const bf16* kg0 = KN + (size_t)h * HD + (size_t)krow_l[0] * WA + 8 * kch_l[0]; const bf16* kg1 = KN + (size_t)h * HD + (size_t)krow_l[1] * WA + 8 * kch_l[1];
        const bf16* vg0 = VT + ((size_t)(b * NHEAD + h) * HD + vrow_l[0]) * VT_PITCH + 8 * vch_l[0]; const bf16* vg1 = VT + ((size_t)(b * NHEAD + h) * HD + vrow_l[1]) * VT_PITCH + 8 * vch_l[1];
#define ATT_DMA(ti_) do { const int t_ = (ti_) < NT ? (ti_) : NT - 1; const unsigned la_ = lds_addr(lds + ((ti_) & 3) * A_TILE + wave * 2048); \
            const size_t krow0 = (t_ < nband) ? ((size_t)b * SEQ + (kr0 + t_) * GRID_W) : ((size_t)ML + b * CTX + 64 * (t_ - nband)); \
            const int tok0 = (t_ < nband) ? ((kr0 + t_) * GRID_W) : (SEQ + 64 * (t_ - nband)); \
            glds16(kg0 + krow0 * WA, la_ + A_KOFF); glds16(kg1 + krow0 * WA, la_ + A_KOFF + 1024); glds16(vg0 + tok0, la_ + A_VOFF); glds16(vg1 + tok0, la_ + A_VOFF + 1024); } while (0)
        ATT_DMA(0); ATT_DMA(1);
        asm volatile("s_waitcnt vmcnt(0)" :: "v"(qf[0]), "v"(qf[1]), "v"(qf[2]), "v"(qf[3]), "v"(bvl) : "memory");
        if (tid < 15 * 31) btab[tid] = bvl * 1.4426950408889634f;
        f32x4 ot[8];
#pragma unroll
        for (int db = 0; db < 8; ++db) ot[db] = (f32x4){0.f, 0.f, 0.f, 0.f};
        float mrun = -1e30f, l = 0.f;
        const int kx = (ks0 + li) & 15, vy = (li >> 1) & 7;
        int koff[4];
#pragma unroll
        for (int ks = 0; ks < 4; ++ks) koff[ks] = A_KOFF + (ks0 + li) * 256 + (((4 * ks + g) ^ kx) << 4);
        const int vrow_off = A_VOFF + li * 128 + 8 * (g & 1);
        const int gq = g >> 1;
        auto tile = [&](const int ti) __attribute__((always_inline)) {
                const LAS unsigned char* tb = lds + (ti & 3) * A_TILE;
                if (ti < nband) {
                    const int kr = kr0 + ti;
                    if (kr >= rs && kr < rs + 8) {
                        const int dr = kr - r + 7;
                        const LAS float* bp = btab + (dr * 31 + ks0 + 4 * g - cq + 15);
                        float bv[2][4];
    #pragma unroll
                        for (int kb = 0; kb < 2; ++kb)
    #pragma unroll
                            for (int j = 0; j < 4; ++j) bv[kb][j] = bp[16 * kb + j];
                        f32x4 st[2];
    #pragma unroll
                        for (int kb = 0; kb < 2; ++kb) { f32x4 a = (f32x4){0.f, 0.f, 0.f, 0.f};
    #pragma unroll
                            for (int ks = 0; ks < 4; ++ks) a = __builtin_amdgcn_mfma_f32_16x16x32_bf16(*(const LAS bf16x8*)(tb + koff[ks] + kb * 4096), qf[ks], a, 0, 0, 0);
                            st[kb] = a; }
                        float gm = -1e30f;
    #pragma unroll
                        for (int kb = 0; kb < 2; ++kb)
    #pragma unroll
                            for (int j = 0; j < 4; ++j) { const int kcol = ks0 + 16 * kb + 4 * g + j; const bool valid = (kcol >= cs) && (kcol < cs + 16);
                                const float sb = st[kb][j] * scale + bv[kb][j];
                                const float sv = valid ? sb : -1e30f; st[kb][j] = sv; gm = fmaxf(gm, sv); }
                        gm = rows_max(gm);
                        const float mnew = fmaxf(mrun, gm); const float alpha = __builtin_amdgcn_exp2f(mrun - mnew); mrun = mnew; l *= alpha;
    #pragma unroll
                        for (int db = 0; db < 8; ++db) ot[db] = ot[db] * alpha;
    #pragma unroll
                        for (int kb = 0; kb < 2; ++kb)
    #pragma unroll
                            for (int j = 0; j < 4; ++j) { const float e = __builtin_amdgcn_exp2f(st[kb][j] - mnew); st[kb][j] = e; l += e; }
                        const bf16x8 pb = pack_p(st[0], st[1]);
                        const int c0 = (ks0 >> 3) + gq;
    #pragma unroll
                        for (int db = 0; db < 8; ++db) { const LAS unsigned char* vp = tb + vrow_off + db * 2048;
                            ot[db] = __builtin_amdgcn_mfma_f32_16x16x32_bf16(cat8u(*(const LAS u32x2*)(vp + ((c0 ^ vy) << 4)), *(const LAS u32x2*)(vp + (((c0 + 2) ^ vy) << 4))), pb, ot[db], 0, 0, 0); }
                    }
                } else {
                    f32x4 st[4];
    #pragma unroll
                    for (int kb = 0; kb < 4; ++kb) { f32x4 a = (f32x4){0.f, 0.f, 0.f, 0.f};
    #pragma unroll
                        for (int ks = 0; ks < 4; ++ks) a = __builtin_amdgcn_mfma_f32_16x16x32_bf16(*(const LAS bf16x8*)(tb + A_KOFF + (16 * kb + li) * 256 + (((4 * ks + g) ^ li) << 4)), qf[ks], a, 0, 0, 0);
                        st[kb] = a * scale; }
                    float gm = -1e30f;
    #pragma unroll
                    for (int kb = 0; kb < 4; ++kb) gm = fmaxf(fmaxf(gm, fmaxf(st[kb][0], st[kb][1])), fmaxf(st[kb][2], st[kb][3]));
                    gm = rows_max(gm);
                    const float mnew = fmaxf(mrun, gm); const float alpha = __builtin_amdgcn_exp2f(mrun - mnew); mrun = mnew; l *= alpha;
    #pragma unroll
                    for (int db = 0; db < 8; ++db) ot[db] = ot[db] * alpha;
    #pragma unroll
                    for (int kb = 0; kb < 4; ++kb)
    #pragma unroll
                        for (int j = 0; j < 4; ++j) { const float e = __builtin_amdgcn_exp2f(st[kb][j] - mnew); st[kb][j] = e; l += e; }
    #pragma unroll
                    for (int kp2 = 0; kp2 < 2; ++kp2) { const bf16x8 pb = pack_p(st[2 * kp2], st[2 * kp2 + 1]);
                        const int c0 = 4 * kp2 + gq;
    #pragma unroll
                        for (int db = 0; db < 8; ++db) { const LAS unsigned char* vp = tb + vrow_off + db * 2048;
                            ot[db] = __builtin_amdgcn_mfma_f32_16x16x32_bf16(cat8u(*(const LAS u32x2*)(vp + ((c0 ^ vy) << 4)), *(const LAS u32x2*)(vp + (((c0 + 2) ^ vy) << 4))), pb, ot[db], 0, 0, 0); } }
                }
        };
#pragma unroll 1
        for (int ti = 0; ti < NT; ti += 2) {
            asm volatile("s_waitcnt vmcnt(0)" ::: "memory");
            ATT_BAR();
            ATT_DMA(ti + 2); ATT_DMA(ti + 3);
            tile(ti);
            if (ti + 1 < NT) tile(ti + 1);
        }
        asm volatile("s_waitcnt vmcnt(0)" ::: "memory");
        l = rows_sum(l);
        const float inv = 1.0f / l;
#pragma unroll
        for (int db = 0; db < 8; ++db) { const f32x4 o = ot[db] * inv; u32x2 w; w.x = pk2(o.x, o.y); w.y = pk2(o.z, o.w);
            *(u32x2*)(YB + qrow * WA + h * HD + 16 * db + 4 * g) = w; }
#undef ATT_DMA
    }
}

constexpr int HP = 160;
constexpr int H_QH = 0, H_KH = 20480, H_KE = 40960, H_QD = 61440, H_KD = 81920;
constexpr int HP2 = 48;
constexpr int H_Q2 = 102400, H_K2 = 108544;
constexpr int PP = 144;
constexpr int H_P = 114688;
constexpr int H_T = 123904;
constexpr int H_D = 125952;
constexpr int HIMG_QD = 0, HIMG_KD = 16384, HIMG_P = 32768, HIMG_D = 40960, HIMG_BYTES = 41472;
constexpr int NCH = (CTX + SEQ) / 64;
constexpr int VP = 288;
constexpr int HPK = 136;
constexpr int SB_QD = 0, SB_KD = 20480, SB_P = 40960, SB_D = 50176, SB_V = 50688, SB_BYTES = 69120;
static_assert(2 * SB_BYTES <= 145408, "scan buffers");

__device__ __forceinline__ s16x4 lds_tr(LAS const unsigned char* p) {
    return __builtin_bit_cast(s16x4, __builtin_amdgcn_ds_read_tr16_b64_v4i16((LAS s16x4*)p));
}
__device__ __forceinline__ bf16x8 cat8(const s16x4 a, const s16x4 b) { return __builtin_shufflevector(a, b, 0, 1, 2, 3, 4, 5, 6, 7); }

__device__ __forceinline__ size_t hg_row(int dir, int b, int tau) {
    if (tau < CTX) return (size_t)ML + b * CTX + (dir == 0 ? tau : CTX - 1 - tau);
    const int t = tau - CTX; return (size_t)b * SEQ + (dir == 0 ? t : SEQ - 1 - t);
}

__device__ __forceinline__ void quad_transpose4(unsigned (&a)[4], const int r) {
    const bool o1 = (r & 1) != 0, o2 = (r & 2) != 0;
    const unsigned sl = o1 ? a[0] : a[1], sh = o1 ? a[2] : a[3];
    const unsigned rl = (unsigned)__builtin_amdgcn_update_dpp(0, (int)sl, 0xB1, 0xf, 0xf, false), rh = (unsigned)__builtin_amdgcn_update_dpp(0, (int)sh, 0xB1, 0xf, 0xf, false);
    const unsigned c0 = o1 ? rl : a[0], c1 = o1 ? a[1] : rl, c2 = o1 ? rh : a[2], c3 = o1 ? a[3] : rh;
    const unsigned tl = o2 ? c0 : c2, th = o2 ? c1 : c3;
    const unsigned vl = (unsigned)__builtin_amdgcn_update_dpp(0, (int)tl, 0x4E, 0xf, 0xf, false), vh = (unsigned)__builtin_amdgcn_update_dpp(0, (int)th, 0x4E, 0xf, 0xf, false);
    a[0] = o2 ? vl : c0; a[1] = o2 ? vh : c1; a[2] = o2 ? c2 : vl; a[3] = o2 ? c3 : vh;
}
__device__ __forceinline__ void hgrn_prep(const Params& p, LAS unsigned char* lds, int vb, int nb) {
    int tid_o = tid_of(p.wave_id);
    const int tid = tid_o, lane = tid & 63, wave = __builtin_amdgcn_readfirstlane(tid >> 6);
    const int k = tid & 127, J = __builtin_amdgcn_readfirstlane(tid >> 7);
    const int li = lane & 15, g = lane >> 4, qq = li >> 2, pp = li & 3;
    LAS float* Tl = (LAS float*)(lds + H_T); LAS float* Dl = (LAS float*)(lds + H_D);
    float lf[16]; unsigned qv[16]; f32x4 lraw[4]; u32x2 qraw[4];
    const int q4_ = k >> 2, r4_ = k & 3;
#define HG_LOADP(idx_) do { const int id_ = (idx_); const int ch_ = id_ / NCH, cc_ = id_ % NCH; const int dir_ = ch_ / (BATCH * NHEAD), b_ = (ch_ / NHEAD) % BATCH, h_ = ch_ % NHEAD; \
        const size_t row0_ = hg_row(dir_, b_, 64 * cc_ + 16 * J); const long st_ = dir_ ? -(long)WA : (long)WA; \
        const float* lfp_ = (const float*)(p.ws + (dir_ == 0 ? WS_FW : WS_FB)) + row0_ * WA + h_ * HD + 4 * q4_; const bf16* qp_ = (const bf16*)(p.ws + WS_QA) + row0_ * WA + h_ * HD + 4 * q4_; \
        _Pragma("unroll") for (int j = 0; j < 4; ++j) { lraw[j] = *(const f32x4*)(lfp_ + (long)(4 * j + r4_) * st_); qraw[j] = (cc_ >= 4) ? *(const u32x2*)(qp_ + (long)(4 * j + r4_) * st_) : (u32x2){0u, 0u}; } } while (0)
#define HG_UNPACK() do { _Pragma("unroll") for (int j = 0; j < 4; ++j) { \
        const float f0_ = lraw[j].x, f1_ = lraw[j].y, f2_ = lraw[j].z, f3_ = lraw[j].w;        \
        unsigned av_[4] = {__float_as_uint(f0_), __float_as_uint(f1_), __float_as_uint(f2_), __float_as_uint(f3_)}; \
        quad_transpose4(av_, r4_); \
        _Pragma("unroll") for (int e = 0; e < 4; ++e) lf[4 * j + e] = __uint_as_float(av_[e]); \
        unsigned bv_[4] = {qraw[j][0] & 0xffffu, qraw[j][0] >> 16, qraw[j][1] & 0xffffu, qraw[j][1] >> 16}; \
        quad_transpose4(bv_, r4_); \
        _Pragma("unroll") for (int e = 0; e < 4; ++e) qv[4 * j + e] = bv_[e]; } } while (0)
    if (vb < 64 * NCH) { HG_LOADP(vb); HG_UNPACK(); }
    for (int idx = vb; idx < 64 * NCH; idx += nb) {
        const int c = idx % NCH;
        float ecum[16]; float e1r = 1.0f;
#pragma unroll
        for (int i = 0; i < 16; ++i) { e1r *= lf[i]; ecum[i] = e1r; }
        const float run = __logf(e1r);
        Tl[J * 128 + k] = run;
        ATT_BAR();
        const float T0 = Tl[k], T1 = Tl[128 + k], T2 = Tl[256 + k], T3 = Tl[384 + k];
        const float bJ = (J > 0 ? T0 : 0.f) + (J > 1 ? T1 : 0.f) + (J > 2 ? T2 : 0.f);
        const float tail = (J < 1 ? T1 : 0.f) + (J < 2 ? T2 : 0.f) + (J < 3 ? T3 : 0.f);
        const float eb = __expf(bJ), et = __expf(tail), eT = e1r;
        const float x2 = (J == 3) ? __expf(T2) : __expf(T1);
        float qh[16], kh[16];
#pragma unroll
        for (int i = 0; i < 16; ++i) { const float e1 = ecum[i]; const float r1 = __builtin_amdgcn_rcpf(e1); const float kk = 1.0f - lf[i];
            qh[i] = __builtin_bit_cast(float, qv[i] << 16) * e1; kh[i] = kk * r1; }
        {
            LAS unsigned char* rowp = lds + k * HP + 32 * J;
            u32x4 w0, w1;
#define HG_WRITE(OFF, EXPR) do { \
            { float v0_, v1_; \
              { const int i = 0; v0_ = (EXPR); } { const int i = 1; v1_ = (EXPR); } w0.x = pk2(v0_, v1_); \
              { const int i = 2; v0_ = (EXPR); } { const int i = 3; v1_ = (EXPR); } w0.y = pk2(v0_, v1_); \
              { const int i = 4; v0_ = (EXPR); } { const int i = 5; v1_ = (EXPR); } w0.z = pk2(v0_, v1_); \
              { const int i = 6; v0_ = (EXPR); } { const int i = 7; v1_ = (EXPR); } w0.w = pk2(v0_, v1_); \
              { const int i = 8; v0_ = (EXPR); } { const int i = 9; v1_ = (EXPR); } w1.x = pk2(v0_, v1_); \
              { const int i = 10; v0_ = (EXPR); } { const int i = 11; v1_ = (EXPR); } w1.y = pk2(v0_, v1_); \
              { const int i = 12; v0_ = (EXPR); } { const int i = 13; v1_ = (EXPR); } w1.z = pk2(v0_, v1_); \
              { const int i = 14; v0_ = (EXPR); } { const int i = 15; v1_ = (EXPR); } w1.w = pk2(v0_, v1_); } \
            *(LAS u32x4*)(OFF) = w0; *(LAS u32x4*)((OFF) + 16) = w1; } while (0)
            HG_WRITE(rowp + H_QH, qh[i]);
            HG_WRITE(rowp + H_KH, kh[i]);
            HG_WRITE(rowp + H_KE, kh[i] * eT);
            HG_WRITE(rowp + H_QD, qh[i] * eb);
            HG_WRITE(rowp + H_KD, kh[i] * (eT * et));
            if (J == 3) { HG_WRITE(lds + H_Q2 + k * HP2, qh[i] * x2); }
            if (J == 0) { HG_WRITE(lds + H_K2 + k * HP2, kh[i] * (eT * x2)); }
#undef HG_WRITE
            if (J == 3) Dl[k] = __expf(bJ + run);
        }
        if (idx + nb < 64 * NCH) HG_LOADP(idx + nb);
        ATT_BAR();
        const bool lat = (c >= 4);
        if (lat) {
#pragma unroll
            for (int rep = 0; rep < 2; ++rep) {
                int I, Jb;
                if (rep == 0) { I = (wave < 4) ? wave : (wave == 4 ? 1 : (wave == 7 ? 3 : 2)); Jb = (wave < 4) ? wave : (wave == 4 ? 0 : (wave == 5 ? 0 : (wave == 6 ? 1 : 2))); }
                else { if (wave >= 2) break; I = 3; Jb = wave; }
                int aoff, apitch, acol, boff, bpitch, bcol;
                if (I == Jb) { aoff = H_KH; apitch = HP; acol = 16 * Jb; boff = H_QH; bpitch = HP; bcol = 16 * I; }
                else if (I == Jb + 1 && I != 2) { aoff = H_KE; apitch = HP; acol = 16 * Jb; boff = H_QH; bpitch = HP; bcol = 16 * I; }
                else if (I == 2) { if (Jb == 0) { aoff = H_K2; apitch = HP2; acol = 0; } else { aoff = H_KE; apitch = HP; acol = 16; } boff = H_QH; bpitch = HP; bcol = 32; }
                else { if (Jb == 0) { aoff = H_K2; apitch = HP2; acol = 0; } else { aoff = H_KE; apitch = HP; acol = 16; } boff = H_Q2; bpitch = HP2; bcol = 0; }
                f32x4 pt = (f32x4){0.f, 0.f, 0.f, 0.f};
#pragma unroll
                for (int ks = 0; ks < 4; ++ks) {
                    const int r0 = 32 * ks + 4 * g + qq;
                    const bf16x8 a = cat8(lds_tr(lds + aoff + r0 * apitch + (acol + 4 * pp) * 2), lds_tr(lds + aoff + (r0 + 16) * apitch + (acol + 4 * pp) * 2));
                    const bf16x8 bb = cat8(lds_tr(lds + boff + r0 * bpitch + (bcol + 4 * pp) * 2), lds_tr(lds + boff + (r0 + 16) * bpitch + (bcol + 4 * pp) * 2));
                    pt = __builtin_amdgcn_mfma_f32_16x16x32_bf16(a, bb, pt, 0, 0, 0);
                }
                if (I == Jb) {
#pragma unroll
                    for (int j = 0; j < 4; ++j) if (4 * g + j > li) pt[j] = 0.f;
                }
                u32x2 w; w.x = pk2(pt.x, pt.y); w.y = pk2(pt.z, pt.w);
                *(LAS u32x2*)(lds + H_P + (16 * I + li) * PP + (16 * Jb + 4 * g) * 2) = w;
            }
        }
        ATT_BAR();
        if (idx + nb < 64 * NCH) HG_UNPACK();
        unsigned char* img = p.ws + WS_HIMG + (size_t)idx * HIMG_BYTES;
#pragma unroll
        for (int e = 0; e < 2; ++e) { const int id = tid + 512 * e; const int kr = id >> 3, part = id & 7;
            if (lat) *(u32x4*)(img + HIMG_QD + id * 16) = *(const LAS u32x4*)(lds + H_QD + kr * HP + 16 * part);
            *(u32x4*)(img + HIMG_KD + id * 16) = *(const LAS u32x4*)(lds + H_KD + kr * HP + 16 * part); }
        if (lat) *(u32x4*)(img + HIMG_P + tid * 16) = *(const LAS u32x4*)(lds + H_P + (tid >> 3) * PP + 16 * (tid & 7));
        if (tid < 32) *(u32x4*)(img + HIMG_D + tid * 16) = *(const LAS u32x4*)(lds + H_D + 16 * tid);
    }
#undef HG_LOADP
#undef HG_UNPACK
    __syncthreads();
}

__device__ __forceinline__ void hgrn_scan(const Params& p, LAS unsigned char* lds, int chain) {
    int tid_o = tid_of(p.wave_id);
    const int tid = tid_o, lane = tid & 63, wave = __builtin_amdgcn_readfirstlane(tid >> 6);
    const int li = lane & 15, g = lane >> 4, qq = li >> 2, pp = li & 3;
    const int dir = chain / (BATCH * NHEAD), b = (chain / NHEAD) % BATCH, h = chain % NHEAD;
    const bf16* IA = (const bf16*)(p.ws + WS_IA) + h * HD;
    bf16* O = (bf16*)(p.ws + (dir == 0 ? WS_OF2 : WS_OB2)) + h * HD + 16 * wave + 4 * g;
    const long ost = dir ? -(long)WA : (long)WA;
    const unsigned char* img0 = p.ws + WS_HIMG + (size_t)chain * NCH * HIMG_BYTES;
    f32x4 S[8];
#pragma unroll
    for (int i = 0; i < 8; ++i) S[i] = (f32x4){0.f, 0.f, 0.f, 0.f};
    u32x4 rq[2][2], rk[2][2], rp[2], rd[2], rv[2][2];
#define HS_LOAD(c_, set_) do { const int cc_ = (c_); const unsigned char* im_ = img0 + (size_t)cc_ * HIMG_BYTES; \
        if (cc_ >= 4) { rq[set_][0] = *(const u32x4*)(im_ + HIMG_QD + tid * 16); rq[set_][1] = *(const u32x4*)(im_ + HIMG_QD + (tid + 512) * 16); rp[set_] = *(const u32x4*)(im_ + HIMG_P + tid * 16); } \
        rk[set_][0] = *(const u32x4*)(im_ + HIMG_KD + tid * 16); rk[set_][1] = *(const u32x4*)(im_ + HIMG_KD + (tid + 512) * 16); \
        if (tid < 32) rd[set_] = *(const u32x4*)(im_ + HIMG_D + tid * 16); \
        _Pragma("unroll") for (int e = 0; e < 2; ++e) { const int idx_ = tid * 2 + e; const size_t row_ = hg_row(dir, b, 64 * cc_ + (idx_ >> 4)); rv[set_][e] = *(const u32x4*)(IA + row_ * WA + 8 * (idx_ & 15)); } } while (0)
#define HS_STORE(c_, set_) do { const int cc_ = (c_); LAS unsigned char* bb_ = lds + (cc_ & 1) * SB_BYTES; \
        if (cc_ >= 4) { *(LAS u32x4*)(bb_ + SB_QD + (tid >> 3) * HP + 16 * (tid & 7)) = rq[set_][0]; *(LAS u32x4*)(bb_ + SB_QD + ((tid >> 3) + 64) * HP + 16 * (tid & 7)) = rq[set_][1]; \
                        *(LAS u32x4*)(bb_ + SB_P + (tid >> 3) * PP + 16 * (tid & 7)) = rp[set_]; } \
        { LAS unsigned char* k0_ = bb_ + SB_KD + (tid >> 3) * HPK + 16 * (tid & 7); LAS unsigned char* k1_ = k0_ + 64 * HPK; \
          *(LAS u32x2*)k0_ = (u32x2){rk[set_][0].x, rk[set_][0].y}; *(LAS u32x2*)(k0_ + 8) = (u32x2){rk[set_][0].z, rk[set_][0].w}; *(LAS u32x2*)k1_ = (u32x2){rk[set_][1].x, rk[set_][1].y}; *(LAS u32x2*)(k1_ + 8) = (u32x2){rk[set_][1].z, rk[set_][1].w}; } \
        if (tid < 32) *(LAS u32x4*)(bb_ + SB_D + 16 * tid) = rd[set_]; \
        _Pragma("unroll") for (int e = 0; e < 2; ++e) { const int idx_ = tid * 2 + e; *(LAS u32x4*)(bb_ + SB_V + (idx_ >> 4) * VP + 16 * (idx_ & 15)) = rv[set_][e]; } } while (0)
    HS_LOAD(0, 0); HS_LOAD(1, 1);
    HS_STORE(0, 0);
    HS_LOAD(2, 0);
    ATT_BAR();
#pragma unroll 1
    for (int c2 = 0; c2 < NCH; c2 += 2) {
#pragma unroll
    for (int uu = 0; uu < 2; ++uu) { const int c = c2 + uu;
        const LAS unsigned char* bb = lds + (c & 1) * SB_BYTES;
        const bool lat = (c >= 4);
        bf16x8 vf[2];
#pragma unroll
        for (int sp = 0; sp < 2; ++sp) {
            const LAS unsigned char* vb0 = bb + SB_V + (32 * sp + 4 * g + qq) * VP + (16 * wave + 4 * pp) * 2;
            vf[sp] = cat8(lds_tr(vb0), lds_tr(vb0 + 16 * VP));
        }
        if (lat) {
            bf16x8 sb[4];
#pragma unroll
            for (int ks = 0; ks < 4; ++ks) sb[ks] = pack_p(S[2 * ks], S[2 * ks + 1]);
            bf16* orow = O + (long)hg_row(dir, b, 64 * c) * WA;
#pragma unroll
            for (int I = 0; I < 4; ++I) {
                f32x4 o = (f32x4){0.f, 0.f, 0.f, 0.f};
#pragma unroll
                for (int ks = 0; ks < 4; ++ks) {
                    const LAS unsigned char* ap = bb + SB_QD + (32 * ks + 4 * g + qq) * HP + (16 * I + 4 * pp) * 2;
                    o = __builtin_amdgcn_mfma_f32_16x16x32_bf16(sb[ks], cat8(lds_tr(ap), lds_tr(ap + 16 * HP)), o, 0, 0, 0);
                }
#pragma unroll
                for (int sp = 0; sp < 2; ++sp) {
                    if (2 * sp > I) break;
                    const LAS unsigned char* pr = bb + SB_P + (16 * I + li) * PP + (32 * sp + 4 * g) * 2;
                    const u32x2 lo = *(const LAS u32x2*)pr; u32x2 hi = (u32x2){0u, 0u};
                    if (2 * sp + 1 <= I) hi = *(const LAS u32x2*)(pr + 32);
                    o = __builtin_amdgcn_mfma_f32_16x16x32_bf16(vf[sp], cat8u(lo, hi), o, 0, 0, 0);
                }
                { u32x2 w; w.x = pk2(o.x, o.y); w.y = pk2(o.z, o.w); *(u32x2*)(orow + (long)(16 * I + li) * ost) = w; }
            }
        }
#pragma unroll
        for (int blk = 0; blk < 8; ++blk) {
            const f32x4 d4 = *(const LAS f32x4*)(bb + SB_D + (16 * blk + 4 * g) * 4);
            f32x4 s = S[blk] * d4;
#pragma unroll
            for (int sp = 0; sp < 2; ++sp) {
                const LAS unsigned char* kp = bb + SB_KD + (16 * blk + li) * HPK + (32 * sp + 4 * g) * 2;
                s = __builtin_amdgcn_mfma_f32_16x16x32_bf16(cat8u(*(const LAS u32x2*)kp, *(const LAS u32x2*)(kp + 32)), vf[sp], s, 0, 0, 0);
            }
            S[blk] = s;
        }
        if (c + 1 < NCH) HS_STORE(c + 1, (uu + 1) & 1);
        if (c + 3 < NCH) HS_LOAD(c + 3, (uu + 1) & 1);
        ATT_BAR();
    } }
#undef HS_LOAD
#undef HS_STORE
    __syncthreads();
}

__device__ __forceinline__ void phase_readout(const Params& p, int vb, int nb) {
    const int tid = tid_of(p.wave_id), lane = tid & 63, wave = p.wave_id;
    const bf16* OF = (const bf16*)(p.ws + WS_OF2); const bf16* OB = (const bf16*)(p.ws + WS_OB2); const bf16* GA = (const bf16*)(p.ws + WS_GA);
    bf16* YA = (bf16*)(p.ws + WS_YA2);
    f32x4 ng[4];
#pragma unroll
    for (int i = 0; i < 4; ++i) ng[i] = *(const f32x4*)(p.hgrn_norm_g + 16 * (lane & 7) + 4 * i);
    const int NGW = nb * 8;
    for (int row0 = vb * 8 + wave; row0 < ML; row0 += 2 * NGW) {
        u32x4 a[2][2], b[2][2], gg[2][2];
#pragma unroll
        for (int u = 0; u < 2; ++u) { const int row = row0 + u * NGW; if (row < ML) { const size_t off = (size_t)row * WA + 16 * lane;
            a[u][0] = *(const u32x4*)(OF + off); a[u][1] = *(const u32x4*)(OF + off + 8); b[u][0] = *(const u32x4*)(OB + off); b[u][1] = *(const u32x4*)(OB + off + 8);
            gg[u][0] = *(const u32x4*)(GA + off); gg[u][1] = *(const u32x4*)(GA + off + 8); } }
#pragma unroll
        for (int u = 0; u < 2; ++u) { const int row = row0 + u * NGW; if (row < ML) { const size_t off = (size_t)row * WA + 16 * lane;
            float o[16]; float ss = 0.f;
#pragma unroll
            for (int q = 0; q < 8; ++q) { const unsigned wa = a[u][q >> 2][q & 3], wb = b[u][q >> 2][q & 3]; o[2 * q] = bflo(wa) + bflo(wb); o[2 * q + 1] = bfhi(wa) + bfhi(wb); ss += o[2 * q] * o[2 * q] + o[2 * q + 1] * o[2 * q + 1]; }
            ss = oct_sum(ss);
            const float rstd = __builtin_amdgcn_rsqf(ss * (1.0f / HD) + EPS);
            u32x4 w[2];
#pragma unroll
            for (int q = 0; q < 8; ++q) { const unsigned wg = gg[u][q >> 2][q & 3];
                w[q >> 2][q & 3] = pk2(o[2 * q] * rstd * ng[q >> 1][(2 * q) & 3] * siluf_(bflo(wg)), o[2 * q + 1] * rstd * ng[q >> 1][(2 * q + 1) & 3] * siluf_(bfhi(wg))); }
            *(u32x4*)(YA + off) = w[0]; *(u32x4*)(YA + off + 8) = w[1]; } }
    }
}

__device__ __forceinline__ void phase_bias2(const Params& p, int vb, int nb) {
    const int tid = tid_of(p.wave_id); const float* mod = (const float*)(p.ws + WS_MOD); float* bias2 = (float*)(p.ws + WS_BIAS2);
    constexpr int NCC = 2 * FFN / 512, NKC = D_MODEL / 64;
    for (int item = vb; item < NCC * NKC; item += nb) {
        const int cc = item % NCC, kc = item / NCC; const int col = cc * 512 + tid;
        const float* W = (col < FFN) ? p.w1 + col : p.w3 + (col - FFN);
        float a0 = 0.f, a1 = 0.f, a2 = 0.f, a3 = 0.f;
#pragma unroll 8
        for (int k = kc * 64; k < kc * 64 + 64; ++k) { const float w = W[(size_t)k * FFN];
            a0 += w * mod[0 * IN_COLS + 3 * D_MODEL + k]; a1 += w * mod[1 * IN_COLS + 3 * D_MODEL + k]; a2 += w * mod[2 * IN_COLS + 3 * D_MODEL + k]; a3 += w * mod[3 * IN_COLS + 3 * D_MODEL + k]; }
        atomicAdd(bias2 + 0 * 2 * FFN + col, a0); atomicAdd(bias2 + 1 * 2 * FFN + col, a1); atomicAdd(bias2 + 2 * 2 * FFN + col, a2); atomicAdd(bias2 + 3 * 2 * FFN + col, a3);
    }
}

constexpr int LDS_MISC_OFF = 145408;
constexpr int LDS_BYTES = 146432;
static_assert(WS_BAR + XCD_BAR_WORDS * 4 <= WS_ROWSQ, "barrier words inside ctl");

#if defined(__HIP_DEVICE_COMPILE__)
#define LOAD_P() Params p; { const __attribute__((address_space(4))) Params* q_ = (const __attribute__((address_space(4))) Params*)__builtin_amdgcn_kernarg_segment_ptr(); asm volatile("" : "+s"(q_)); \
    p = *q_; p.wave_id = wave_id; } unsigned char* ws = p.ws; (void)ws
#else
#define LOAD_P() Params p = p_in; p.wave_id = wave_id; unsigned char* ws = p.ws; (void)ws
#endif
__global__ void __launch_bounds__(NTHREADS, 2) mega_fwd(Params p_in) {
    const int wave_id = __builtin_amdgcn_readfirstlane((int)(threadIdx.x >> 6));
    extern __shared__ __attribute__((aligned(16))) unsigned char lds_raw[];
    LAS unsigned char* lds = (LAS unsigned char*)lds_raw;
    const int nb = gridDim.x;
    const int vb = (nb % 8 == 0) ? ((int)(blockIdx.x % 8) * (nb / 8) + (int)(blockIdx.x / 8)) : (int)blockIdx.x;
    const int bx = blockIdx.x;
    volatile LAS unsigned* misc = (volatile LAS unsigned*)(lds + LDS_MISC_OFF);
    if (wave_id == 0) misc[lane_id()] = 0u;
    __syncthreads();
    XcdBarrier bar = xcd_barrier_post((unsigned*)(p_in.ws + WS_BAR), misc + 8, wave_id);
#define GRID_BAR() xcd_barrier(bar)

    { LOAD_P(); phase_mod(p, lds, vb, nb); __syncthreads(); phase_wconv_in(p, lds, vb * 8 + wave_id, nb * 8); }
    { LOAD_P(); if (wave_id == 0 && lane_id() == 0) { unsigned* mc = (unsigned*)(ws + WS_MODCTR); const unsigned need = (unsigned)(nb < IN_COLS / 64 ? nb : IN_COLS / 64);
        while (__hip_atomic_load(mc, __ATOMIC_RELAXED, __HIP_MEMORY_SCOPE_AGENT) < need) __builtin_amdgcn_s_sleep(2); }
      asm volatile("" ::: "memory"); __syncthreads();
      phase_h(p, vb, nb); }
    GRID_BAR();
    { LOAD_P(); pg8::Gemm g{(const bf16*)(ws + WS_H), (const bf16*)(ws + WS_WINT), MT, IN_COLS, D_MODEL}; InProjOrder S; S.init(ML, IN_COLS, nb, bx);
      EpiInProj E{ws, lds, p.q_norm_g, p.k_norm_g}; pg8::gemm_phase<EpiInProj, InProjOrder, true, true>(lds, g, S, E, wave_id);
      const int nfree = nb - CTX_UNITS;
      if (nfree >= 64) { if (bx >= CTX_UNITS) phase_wconv_rest(p, lds, (bx - CTX_UNITS) * 8 + wave_id, nfree * 8); }
      else phase_wconv_rest(p, lds, bx * 8 + wave_id, nb * 8); }
    GRID_BAR();
    { LOAD_P(); hgrn_prep(p, lds, vb, nb);
      asm volatile("s_waitcnt vmcnt(0)" ::: "memory"); __syncthreads();
      if (wave_id == 0 && lane_id() == 0) { unsigned* pc = (unsigned*)(ws + WS_PREPCTR); const unsigned nloc = bar.st[0];
        const unsigned old = __hip_atomic_fetch_add(pc + 16u * (1u + bar.x), 1u, __ATOMIC_RELAXED, __HIP_MEMORY_SCOPE_AGENT);
        if (old + 1u == nloc) { __builtin_amdgcn_fence(__ATOMIC_RELEASE, "agent"); asm volatile("s_waitcnt vmcnt(0)" ::: "memory");
            (void)__hip_atomic_fetch_add(pc, nloc, __ATOMIC_RELAXED, __HIP_MEMORY_SCOPE_AGENT); } } }
    { LOAD_P();
      if (bx < 2 * BATCH * NHEAD) {
        if (wave_id == 0 && lane_id() == 0) { unsigned* pc = (unsigned*)(ws + WS_PREPCTR); while (__hip_atomic_load(pc, __ATOMIC_RELAXED, __HIP_MEMORY_SCOPE_AGENT) < (unsigned)nb) __builtin_amdgcn_s_sleep(2); }
        asm volatile("" ::: "memory"); __syncthreads();
        hgrn_scan(p, lds, bx); }
      __syncthreads();
      phase_attn(p, lds); }
    GRID_BAR();
    { LOAD_P(); phase_readout(p, vb, nb); }
    asm volatile("s_waitcnt vmcnt(0)" ::: "memory"); __syncthreads();
    if (wave_id == 0 && lane_id() == 0) { LOAD_P();
        unsigned* yc = (unsigned*)(ws + WS_YACTR); const unsigned nloc = bar.st[0];
        const unsigned old = __hip_atomic_fetch_add(yc + 16u * (1u + bar.x), 1u, __ATOMIC_RELAXED, __HIP_MEMORY_SCOPE_AGENT);
        if (old + 1u == nloc) { __builtin_amdgcn_fence(__ATOMIC_RELEASE, "agent"); asm volatile("s_waitcnt vmcnt(0)" ::: "memory");
            (void)__hip_atomic_fetch_add(yc, nloc, __ATOMIC_RELAXED, __HIP_MEMORY_SCOPE_AGENT); } }
    { LOAD_P(); pg8::Gemm g{(const bf16*)p.out, (const bf16*)(ws + WS_WBT), ML, D_MODEL, WA};
      MergeOrder S; S.init(ML, D_MODEL, nb, bx); S.A1 = (const bf16*)(ws + WS_YA2); S.B1 = (const bf16*)(ws + WS_WAT); S.ya_ctr = (unsigned*)(ws + WS_YACTR); S.ya_need = (unsigned)nb;
      EpiMerge E{ws}; pg8::gemm_phase<EpiMerge, MergeOrder, true, true>(lds, g, S, E, wave_id); }
    GRID_BAR();
    { LOAD_P(); pg8::Gemm g{(const bf16*)(ws + WS_Z), (const bf16*)(ws + WS_WOT), ML, D_MODEL, D_MODEL}; pg8::StaticOrder S; S.init(ML, D_MODEL, nb, bx);
      EpiOutProj E{ws, p.x, p.norm2_g, p.out}; pg8::gemm_phase<EpiOutProj, pg8::StaticOrder, true, true>(lds, g, S, E, wave_id); }
    GRID_BAR();
    { LOAD_P(); pg8::Gemm g{(const bf16*)(ws + WS_XMG), (const bf16*)(ws + WS_W13T), ML, 2 * FFN, D_MODEL}; pg8::StaticOrder S; S.init(ML, 2 * FFN, nb, bx);
      const bool tail_split = (nb == 256) && ((S.nwg % nb) * 2 == nb);
      if (tail_split) S.maxL = (S.nwg / nb) * nb;
      const bool half_first = tail_split && (((bx >> 3) & 1) != 0);
      if (half_first) { pg8::Unit hu; S.unit_of((long)S.maxL + (bx >> 1), hu); hu.br = bx & 1;
        EpiFfnUpHalf EH{ws, lds, p.conv_w, p.conv_b}; pg8::gemm_half_phase<EpiFfnUpHalf>(lds, g, hu, EH, wave_id); }
      { EpiFfnUp E{ws, lds, p.conv_w, p.conv_b}; pg8::gemm_phase<EpiFfnUp, pg8::StaticOrder, true, true>(lds, g, S, E, wave_id); }
      if (tail_split && !half_first) { pg8::Unit hu; S.unit_of((long)S.maxL + (bx >> 1), hu); hu.br = bx & 1;
        EpiFfnUpHalf EH{ws, lds, p.conv_w, p.conv_b}; pg8::gemm_half_phase<EpiFfnUpHalf>(lds, g, hu, EH, wave_id); } }
    GRID_BAR();
    { LOAD_P(); { pg8::StaticOrder S0; S0.init(ML, D_MODEL, nb, bx); pg8::Unit u0; const int tid = tid_of(wave_id); const int tail_first = (nb == 256 && (((ML / 256) * (2 * FFN / 256)) % 256) * 2 == 256) ? (((ML / 256) * (2 * FFN / 256)) / 256) * 256 : -1;
      for (int i = 0; S0.next(i, u0); ++i) halo_fix(p, u0.pm, tid, tail_first); }
      asm volatile("s_waitcnt vmcnt(0)" ::: "memory"); __syncthreads();
      pg8::Gemm g{(const bf16*)(ws + WS_ACT), (const bf16*)(ws + WS_W2T), ML, D_MODEL, FFN}; pg8::StaticOrder S; S.init(ML, D_MODEL, nb, bx);
      EpiFfnDown E{ws, p.out}; pg8::gemm_phase<EpiFfnDown, pg8::StaticOrder, true, true>(lds, g, S, E, wave_id); }
#undef GRID_BAR
}

extern "C" void kernel_launch(void* const* d_in, const int* in_sizes, int n_in, void* d_out, int out_size, void* d_ws, size_t ws_size, hipStream_t stream) {
    static int grid = 0;
    if (grid == 0) {
        if (n_in != 22 || ws_size < WS_END || out_size != ML * D_MODEL) { fprintf(stderr, "kernel_launch: bad inputs (n_in %d, out %d, ws %zu, need %zu)\n", n_in, out_size, ws_size, (size_t)WS_END); grid = -1; return; }
        int dev = 0, cus = 0, per_cu = 0;
        if (hipGetDevice(&dev) != hipSuccess || hipDeviceGetAttribute(&cus, hipDeviceAttributeMultiprocessorCount, dev) != hipSuccess) { grid = -1; return; }
        if (hipFuncSetAttribute((const void*)mega_fwd, hipFuncAttributeMaxDynamicSharedMemorySize, LDS_BYTES) != hipSuccess) { fprintf(stderr, "kernel_launch: hipFuncSetAttribute failed\n"); grid = -1; return; }
        if (hipOccupancyMaxActiveBlocksPerMultiprocessor(&per_cu, (const void*)mega_fwd, NTHREADS, LDS_BYTES) != hipSuccess || per_cu < 1) { fprintf(stderr, "kernel_launch: occupancy query says %d blocks/CU\n", per_cu); (void)hipGetLastError(); grid = -1; return; }
        grid = cus;
        fprintf(stderr, "kernel_launch: grid %d (cus %d, occupancy %d/CU)\n", grid, cus, per_cu);
    }
    if (grid < 0) return;
    Params p{};
    const float** f = (const float**)&p;
    for (int i = 0; i < 22; ++i) f[i] = (const float*)d_in[i];
    p.out = (float*)d_out; p.ws = (unsigned char*)d_ws;
    (void)hipMemsetAsync((char*)d_ws + WS_CTL, 0, CTL_ZERO_BYTES, stream);
    hipLaunchKernelGGL(mega_fwd, dim3(grid), dim3(NTHREADS), LDS_BYTES, stream, p);
}
```
